# Optimizing an MI355X kernel written in HIP

```python
import math
import jax
import jax.numpy as jnp
from jax import lax
import numpy as np

D_MODEL = 1024
BATCH = 4
SEQ = 4096
DEPTH = 1

HG_HEADS = 4
HG_DK = 128
HG_DV = 128
HG_WIDTH = HG_HEADS * HG_DK
HG_CHUNK = 64
ATT_BRANCHES = ((128, 1), (512, 4), (2048, 16))
ATT_HEADS_PER_BRANCH = 4
ATT_HEAD_DIM = 64
ATT_HEADS = ATT_HEADS_PER_BRANCH * len(ATT_BRANCHES)
ATT_WIDTH = ATT_HEADS * ATT_HEAD_DIM
ATT_OUT_WIDTH = ATT_HEADS_PER_BRANCH * ATT_HEAD_DIM
REL_BUCKETS = 32
REL_MAX_DIST = 2048
N_EXPERTS = 256
TOP_K = 8
N_GROUPS = 8
TOPK_GROUPS = 4
EXPERT_DIM = 256
SHARED_DIM = 256
ROUTED_SCALE = 2.5
MOE_BLOCK = 128
DN_ALPHA = (2 * DEPTH) ** 0.25
DN_BETA = (8 * DEPTH) ** -0.25
LN_EPS = 1e-5
RMS_EPS = 1e-6
IN_WIDTH = 4 * HG_WIDTH + 3 * ATT_WIDTH
IN_SPLITS = (HG_WIDTH, 2 * HG_WIDTH, 3 * HG_WIDTH, 4 * HG_WIDTH,
             4 * HG_WIDTH + ATT_WIDTH, 4 * HG_WIDTH + 2 * ATT_WIDTH)
MIX_OUT = HG_WIDTH + ATT_OUT_WIDTH

kernel_name = 'hybrid_hgrn2_dilated_attn_moe_deepnorm'


def _layer_norm(x, gain=None, bias=None):
    xf = x.astype(jnp.float32)
    mu = xf.mean(-1, keepdims=True)
    var = jnp.square(xf - mu).mean(-1, keepdims=True)
    y = (xf - mu) * lax.rsqrt(var + LN_EPS)
    if gain is not None:
        y = y * gain.astype(jnp.float32) + bias.astype(jnp.float32)
    return y.astype(x.dtype)


def _t5_causal_bucket(dist):
    max_exact = REL_BUCKETS // 2
    n = jnp.maximum(dist, 0)
    nf = jnp.maximum(n, 1).astype(jnp.float32)
    large = max_exact + (jnp.log(nf / max_exact) / math.log(REL_MAX_DIST / max_exact)
                         * (REL_BUCKETS - max_exact)).astype(jnp.int32)
    large = jnp.minimum(large, REL_BUCKETS - 1)
    return jnp.where(n < max_exact, n, large)


def _hgrn2(q, f_logit, i, g, lb, norm_w):
    B, S, H, DK = q.shape
    DV = i.shape[-1]
    f32 = jnp.float32
    lb = lb.reshape(H, DK).astype(f32)
    z = f_logit.astype(f32)
    log_f = jnp.log(lb + (1.0 - lb) * jax.nn.sigmoid(z))
    k = (1.0 - lb) * jax.nn.sigmoid(-z)
    nc = S // HG_CHUNK

    def chunks(t):
        return t.astype(f32).reshape(B, nc, HG_CHUNK, H, t.shape[-1]).transpose(1, 0, 3, 2, 4)

    causal = jnp.tril(jnp.ones((HG_CHUNK, HG_CHUNK), bool))

    def step(state, xs):
        qc, kc, ic, lfc = xs
        b = jnp.cumsum(lfc, axis=2)
        inter = jnp.einsum('bhtd,bhde->bhte', qc * jnp.exp(b), state)
        diff = b[:, :, :, None, :] - b[:, :, None, :, :]
        decay = jnp.exp(jnp.where(causal[:, :, None], diff, -jnp.inf))
        scores = jnp.einsum('bhtd,bhsd,bhtsd->bhts', qc, kc, decay)
        intra = jnp.einsum('bhts,bhse->bhte', scores, ic)
        b_last = b[:, :, -1:]
        new_state = (jnp.exp(b_last[:, :, 0])[..., None] * state
                     + jnp.einsum('bhsd,bhse->bhde', kc * jnp.exp(b_last - b), ic))
        return new_state, inter + intra

    state0 = jnp.zeros((B, H, DK, DV), f32)
    _, o = lax.scan(step, state0, (chunks(q), chunks(k), chunks(i), chunks(log_f)))
    o = o.transpose(1, 0, 3, 2, 4).reshape(B, S, H, DV)
    o = o * lax.rsqrt(jnp.mean(o * o, -1, keepdims=True) + RMS_EPS)
    o = o.reshape(B, S, H * DV) * norm_w.astype(f32) * jax.nn.silu(g.astype(f32))
    return o.astype(q.dtype)


def _dilated_branch(q, k, v, rel_bias, window, dilation):
    B, S, H, Dh = q.shape
    W = window // dilation
    span = dilation * W
    S_pad = -(-S // span) * span
    L = S_pad // dilation
    nb = L // W

    def to_blocks(t):
        t = jnp.pad(t, ((0, 0), (0, S_pad - S), (0, 0), (0, 0)))
        t = t.reshape(B, L, dilation, H, Dh).transpose(0, 2, 3, 1, 4)
        return t.reshape(B, dilation, H, nb, W, Dh)

    def with_prev(t):
        prev = jnp.concatenate([jnp.zeros_like(t[:, :, :, :1]), t[:, :, :, :-1]], axis=3)
        return jnp.concatenate([prev, t], axis=4)

    qb = to_blocks(q)
    kk = with_prev(to_blocks(k))
    vv = with_prev(to_blocks(v))
    qi = jnp.arange(W)[:, None]
    ki = jnp.arange(2 * W)[None, :]
    m = W + qi - ki
    band = (m >= 0) & (m <= W)
    blk = jnp.arange(nb)[:, None, None]
    valid = band[None] & ((blk > 0) | (ki >= W)[None])
    bias = rel_bias[_t5_causal_bucket(m * dilation)].astype(jnp.float32).transpose(2, 0, 1)
    s = jnp.einsum('brhnqd,brhnkd->brhnqk', qb, kk).astype(jnp.float32) * (Dh ** -0.5)
    s = jnp.where(valid[None, None, None], s + bias[None, None, :, None], -jnp.inf)
    mx = s.max(-1, keepdims=True)
    p = jnp.exp(s - mx)
    l = p.sum(-1, keepdims=True)
    o = jnp.einsum('brhnqk,brhnkd->brhnqd', (p / l).astype(v.dtype), vv)
    lse = (mx + jnp.log(l))[..., 0]

    def from_blocks(t):
        extra = t.shape[5:]
        t = jnp.moveaxis(t.reshape((B, dilation, H, L) + extra), 3, 1)
        return t.reshape((B, S_pad, H) + extra)[:, :S]

    return from_blocks(o), from_blocks(lse)


def _dilated_mixture(q, k, v, rel_bias):
    B, S, _ = q.shape
    Hb = ATT_HEADS_PER_BRANCH
    outs, lses = [], []
    for g, (window, dilation) in enumerate(ATT_BRANCHES):
        lo, hi = g * Hb * ATT_HEAD_DIM, (g + 1) * Hb * ATT_HEAD_DIM
        qg = q[..., lo:hi].reshape(B, S, Hb, ATT_HEAD_DIM)
        kg = k[..., lo:hi].reshape(B, S, Hb, ATT_HEAD_DIM)
        vg = v[..., lo:hi].reshape(B, S, Hb, ATT_HEAD_DIM)
        o, lse = _dilated_branch(qg, kg, vg, rel_bias[:, g * Hb:(g + 1) * Hb], window, dilation)
        outs.append(o)
        lses.append(lse)
    wts = jax.nn.softmax(jnp.stack(lses, 0), axis=0)
    out = jnp.einsum('gbsh,gbshd->bshd', wts, jnp.stack(outs, 0).astype(jnp.float32))
    return out.reshape(B, S, ATT_OUT_WIDTH).astype(q.dtype)


def _moe(h, w_router, router_bias, w_e_gate, w_e_up, w_e_down, w_sh_gate, w_sh_up, w_sh_down):
    B, S, D = h.shape
    T = B * S
    xt = h.reshape(T, D)
    scores = jax.nn.sigmoid((xt @ w_router).astype(jnp.float32))
    biased = scores + router_bias.astype(jnp.float32)
    grp_score = lax.top_k(biased.reshape(T, N_GROUPS, N_EXPERTS // N_GROUPS), 2)[0].sum(-1)
    _, grp_idx = lax.top_k(grp_score, TOPK_GROUPS)
    grp_mask = jnp.any(grp_idx[..., None] == jnp.arange(N_GROUPS), axis=1)
    masked = jnp.where(jnp.repeat(grp_mask, N_EXPERTS // N_GROUPS, axis=1), biased, -jnp.inf)
    _, top_idx = lax.top_k(masked, TOP_K)
    top_w = jnp.take_along_axis(scores, top_idx, axis=1)
    top_w = top_w / top_w.sum(-1, keepdims=True) * ROUTED_SCALE
    A = T * TOP_K
    flat_e = top_idx.reshape(A)
    flat_w = top_w.reshape(A)
    order = jnp.argsort(flat_e)
    sorted_e = flat_e[order]
    counts = jnp.bincount(flat_e, length=N_EXPERTS)
    start = jnp.cumsum(counts) - counts
    padded = (counts + MOE_BLOCK - 1) // MOE_BLOCK * MOE_BLOCK
    pend = jnp.cumsum(padded)
    pstart = pend - padded
    dest = pstart[sorted_e] + jnp.arange(A, dtype=jnp.int32) - start[sorted_e]
    n_blocks = -(-A // MOE_BLOCK) + N_EXPERTS
    R = n_blocks * MOE_BLOCK
    row_token = jnp.zeros((R,), jnp.int32).at[dest].set((order // TOP_K).astype(jnp.int32))
    row_w = jnp.zeros((R,), jnp.float32).at[dest].set(flat_w[order])
    block_e = jnp.minimum(jnp.searchsorted(pend, jnp.arange(n_blocks) * MOE_BLOCK, side='right'),
                          N_EXPERTS - 1).astype(jnp.int32)

    def expert_block(args):
        e, tok, w = args
        xb = xt[tok]
        hb = jax.nn.silu(xb @ w_e_gate[e]) * (xb @ w_e_up[e])
        yb = hb @ w_e_down[e]
        return yb * w[:, None].astype(yb.dtype)

    y_rows = lax.map(expert_block, (block_e, row_token.reshape(n_blocks, MOE_BLOCK),
                                    row_w.reshape(n_blocks, MOE_BLOCK)))
    routed = jax.ops.segment_sum(y_rows.reshape(R, D), row_token, num_segments=T)
    shared = (jax.nn.silu(xt @ w_sh_gate) * (xt @ w_sh_up)) @ w_sh_down
    return (routed + shared).reshape(B, S, D)


def setup_inputs(seed: int = 0) -> dict:
    key = jax.random.key(seed)
    ks = jax.random.split(key, 24)
    f32 = jnp.float32

    def nrm(k, shape, scale):
        return jax.random.normal(k, shape, f32) * scale

    D = D_MODEL
    return {
        'x': nrm(ks[0], (BATCH, SEQ, D), 1.0),
        'c': nrm(ks[1], (BATCH, D), 1.0),
        'w_ada': nrm(ks[2], (DEPTH, D, 6 * D), 0.5 * D ** -0.5),
        'b_ada': nrm(ks[3], (DEPTH, 6 * D), 0.02),
        'w_in': nrm(ks[4], (DEPTH, D, IN_WIDTH), D ** -0.5),
        'hg_lower_bound': nrm(ks[5], (DEPTH + 1, HG_WIDTH), 0.5),
        'hg_norm_w': 1.0 + nrm(ks[6], (DEPTH, HG_WIDTH), 0.02),
        'rel_bias': nrm(ks[7], (REL_BUCKETS, ATT_HEADS), 0.5),
        'w_out': nrm(ks[8], (DEPTH, MIX_OUT, D), MIX_OUT ** -0.5 * DN_BETA),
        'ln1_g': 1.0 + nrm(ks[9], (DEPTH, D), 0.02),
        'ln1_b': nrm(ks[10], (DEPTH, D), 0.02),
        'w_router': nrm(ks[11], (DEPTH, D, N_EXPERTS), D ** -0.5),
        'router_bias': nrm(ks[12], (DEPTH, N_EXPERTS), 0.01),
        'w_e_gate': nrm(ks[13], (DEPTH, N_EXPERTS, D, EXPERT_DIM), D ** -0.5),
        'w_e_up': nrm(ks[14], (DEPTH, N_EXPERTS, D, EXPERT_DIM), D ** -0.5),
        'w_e_down': nrm(ks[15], (DEPTH, N_EXPERTS, EXPERT_DIM, D), EXPERT_DIM ** -0.5 * DN_BETA),
        'w_sh_gate': nrm(ks[16], (DEPTH, D, SHARED_DIM), D ** -0.5),
        'w_sh_up': nrm(ks[17], (DEPTH, D, SHARED_DIM), D ** -0.5),
        'w_sh_down': nrm(ks[18], (DEPTH, SHARED_DIM, D), SHARED_DIM ** -0.5 * DN_BETA),
        'ln2_g': 1.0 + nrm(ks[19], (DEPTH, D), 0.02),
        'ln2_b': nrm(ks[20], (DEPTH, D), 0.02),
    }


def reference(x, c, w_ada, b_ada, w_in, hg_lower_bound, hg_norm_w, rel_bias, w_out, ln1_g, ln1_b,
              w_router, router_bias, w_e_gate, w_e_up, w_e_down, w_sh_gate, w_sh_up, w_sh_down,
              ln2_g, ln2_b):
    B, S, D = x.shape
    lower_bounds = jnp.cumsum(jax.nn.softmax(hg_lower_bound.astype(jnp.float32), axis=0), axis=0)
    cond = jax.nn.silu(c)
    for l in range(DEPTH):
        mod = (cond @ w_ada[l] + b_ada[l])[:, None, :]
        sh1, sc1, g1, sh2, sc2, g2 = jnp.split(mod, 6, axis=-1)
        h = _layer_norm(x) * (1.0 + sc1) + sh1
        proj = h @ w_in[l]
        hq, hf, hi, hg, aq, ak, av = jnp.split(proj, IN_SPLITS, axis=-1)
        y_hg = _hgrn2(hq.reshape(B, S, HG_HEADS, HG_DK), hf.reshape(B, S, HG_HEADS, HG_DK),
                      hi.reshape(B, S, HG_HEADS, HG_DV), hg, lower_bounds[l], hg_norm_w[l])
        y_att = _dilated_mixture(aq, ak, av, rel_bias)
        mix = jnp.concatenate([y_hg, y_att], axis=-1) @ w_out[l]
        x = _layer_norm(DN_ALPHA * x + g1 * mix, ln1_g[l], ln1_b[l])
        h = _layer_norm(x) * (1.0 + sc2) + sh2
        ffn = _moe(h, w_router[l], router_bias[l], w_e_gate[l], w_e_up[l], w_e_down[l],
                   w_sh_gate[l], w_sh_up[l], w_sh_down[l])
        x = _layer_norm(DN_ALPHA * x + g2 * ffn, ln2_g[l], ln2_b[l])
    return x
```

```cpp
#include <hip/hip_runtime.h>
#include <stdint.h>
#include <stdio.h>

#ifndef ONE_LAUNCH
#define ONE_LAUNCH 1
#endif

constexpr int D = 1024, NBATCH = 4, S = 4096, T = NBATCH * S;
constexpr int INW = 4352;
constexpr int NE = 256, TOPK = 8, ED = 256;
constexpr int OFF_HQ = 0, OFF_HF = 512, OFF_HI = 1024, OFF_HG = 1536, OFF_AQ = 2048, OFF_AK = 2816, OFF_AV = 3584;
constexpr float ALPHA = 1.189207115002721f;
constexpr float LN_EPS = 1e-5f, RMS_EPS = 1e-6f;
constexpr int NTHREADS = 256;

typedef unsigned short bf16_t;
using bf16x8 = __attribute__((ext_vector_type(8))) short;
using f32x4 = __attribute__((ext_vector_type(4))) float;
using u32x4 = __attribute__((ext_vector_type(4))) unsigned int;

__device__ __forceinline__ unsigned short f2bf(float f) {
    uint32_t u = __float_as_uint(f);
    u += 0x7fffu + ((u >> 16) & 1u);
    return (unsigned short)(u >> 16);
}
__device__ __forceinline__ float bf2f(unsigned short h) { return __uint_as_float(((uint32_t)h) << 16); }
__device__ __forceinline__ uint32_t pack2(float a, float b) { return (uint32_t)f2bf(a) | ((uint32_t)f2bf(b) << 16); }
__device__ __forceinline__ float sigmoidf_(float v) { return 1.f / (1.f + __expf(-v)); }

struct Params {
    const float *x, *c, *w_ada, *b_ada, *w_in, *hg_lb, *hg_nw, *rel_bias, *w_out, *ln1_g, *ln1_b, *w_router, *router_bias,
        *w_eg, *w_eu, *w_ed, *w_sg, *w_su, *w_sd, *ln2_g, *ln2_b;
    float* out;
    unsigned* bar;
    int* cnt;
    float* mod;
    float* lbv;
    float* biasT;
    bf16_t* h1;
    bf16_t* proj;
    float* lgf;
    float* oraw;
    bf16_t* mixin;
    float* pre1;
    float* x1;
    bf16_t* h2;
    float* h2f;
    int* topi;
    float* topw;
    int* list;
    bf16_t* gbuf;
    bf16_t* gsh;
    bf16_t* ybuf;
};

#define XB_TMO      128
#define XB_XCNT(j)  (256  + 64 * (j))
#define XB_XSUB(j)  (1280 + 64 * (j))
#define XB_XGEN(j)  (2304 + 64 * (j))
#define XB_TOP      3328
#define XB_TOPGEN   3392
#define XCD_BAR_WORDS 3456
#define XB_SPIN_CAP (1u << 18)
#define LAS __attribute__((address_space(3)))

__device__ __forceinline__ unsigned xb_ld(unsigned* p)              { return __hip_atomic_load(p, __ATOMIC_RELAXED, __HIP_MEMORY_SCOPE_AGENT); }
__device__ __forceinline__ unsigned xb_add(unsigned* p, unsigned v) { return __hip_atomic_fetch_add(p, v, __ATOMIC_RELAXED, __HIP_MEMORY_SCOPE_AGENT); }
__device__ __forceinline__ unsigned xb_xcc_id() { return (unsigned)__builtin_amdgcn_s_getreg((3 << 11) | 20) & 0xFu; }
#define XB_SPIN(cond, bar) do { unsigned _sp = 0; while (cond) { __builtin_amdgcn_s_sleep(1); \
    if ((++_sp & 255u) == 0u) { if (xb_ld(&(bar)[XB_TMO])) break; if (_sp > XB_SPIN_CAP) { atomicAdd(&(bar)[XB_TMO], 1u); break; } } } } while (0)

struct XcdBarrier {
    unsigned* bar; unsigned x;
    volatile LAS unsigned* st;
};
__device__ __forceinline__ XcdBarrier xcd_barrier_post(unsigned* bar, volatile LAS unsigned* st) {
    XcdBarrier b; b.bar = bar; b.x = xb_xcc_id(); b.st = st;
    if (threadIdx.x == 0) (void)xb_add(&bar[XB_XCNT(b.x)], 1u);
    return b;
}
__device__ __forceinline__ void xcd_barrier_complete(unsigned* bar, unsigned x, unsigned& nloc, unsigned& nx) {
    const unsigned G = gridDim.x * gridDim.y * gridDim.z;
    unsigned sum, cnt, mine, sp = 0u;
    for (;;) {
        sum = 0u; cnt = 0u; mine = 0u;
#pragma unroll
        for (unsigned j = 0; j < 16; ++j) { const unsigned c = xb_ld(&bar[XB_XCNT(j)]); sum += c; cnt += (c > 0u) ? 1u : 0u; mine = (j == x) ? c : mine; }
        if (sum == G) break;
        __builtin_amdgcn_s_sleep(1);
        if ((++sp & 255u) == 0u) { if (xb_ld(&bar[XB_TMO])) break; if (sp > XB_SPIN_CAP) { atomicAdd(&bar[XB_TMO], 1u); break; } }
    }
    nloc = mine > 0u ? mine : 1u; nx = cnt > 0u ? cnt : 1u;
}
__device__ __forceinline__ void xcd_barrier(const XcdBarrier& b) {
    asm volatile("s_waitcnt vmcnt(0)" ::: "memory");
    __syncthreads();
    if (threadIdx.x == 0) {
        unsigned* bar = b.bar;
        __builtin_amdgcn_s_waitcnt(0);
        unsigned nloc = b.st[0], nx = b.st[1];
        if (nloc == 0u) { xcd_barrier_complete(bar, b.x, nloc, nx); b.st[0] = nloc; b.st[1] = nx; }
        const unsigned old = xb_add(&bar[XB_XSUB(b.x)], 1u);
        const unsigned gen = old / nloc;
        if (old + 1u == (gen + 1u) * nloc) {
            __builtin_amdgcn_fence(__ATOMIC_RELEASE, "agent");
            asm volatile("s_waitcnt vmcnt(0)" ::: "memory");
            const unsigned og = xb_add(&bar[XB_TOP], 1u);
            const unsigned tg = og / nx;
            if (og + 1u == (tg + 1u) * nx) xb_add(&bar[XB_TOPGEN], 1u);
            else XB_SPIN(xb_ld(&bar[XB_TOPGEN]) == tg, bar);
            __builtin_amdgcn_fence(__ATOMIC_ACQUIRE, "agent");
            xb_add(&bar[XB_XGEN(b.x)], 1u);
            asm volatile("s_waitcnt vmcnt(0)" ::: "memory");
        } else {
            XB_SPIN(xb_ld(&bar[XB_XGEN(b.x)]) == gen, bar);
            __builtin_amdgcn_fence(__ATOMIC_ACQUIRE, "agent");
            asm volatile("s_waitcnt vmcnt(0)" ::: "memory");
        }
    }
    __syncthreads();
}

constexpr int BK = 64;
__device__ __forceinline__ int swz(int row, int chunk) { return row * 128 + ((chunk ^ ((row >> 1) & 7)) << 4); }

template <class AF, class BF>
__device__ __forceinline__ void gemm_tile(char* smem, const int K, AF arow, BF bcol, const int ldb, f32x4 (&acc)[4][4]) {
    const int tid = threadIdx.x, lane = tid & 63, wid = tid >> 6, wr = wid >> 1, wc = wid & 1, fr = lane & 15, fq = lane >> 4;
    char* sA = smem;
    char* sB = smem + 16384;
    const bf16_t* ap[4];
#pragma unroll
    for (int i = 0; i < 4; ++i) ap[i] = arow((tid >> 3) + 32 * i) + (tid & 7) * 8;
    const int nq = tid & 31, kg = tid >> 5;
    const float* bp = bcol(nq * 4) + (size_t)(kg * 8) * ldb;
#pragma unroll
    for (int m = 0; m < 4; ++m)
#pragma unroll
        for (int n = 0; n < 4; ++n) acc[m][n] = f32x4{0.f, 0.f, 0.f, 0.f};
    u32x4 ra[4];
    f32x4 rb[8];
#pragma unroll
    for (int i = 0; i < 4; ++i) ra[i] = *(const u32x4*)(ap[i]);
#pragma unroll
    for (int j = 0; j < 8; ++j) rb[j] = *(const f32x4*)(bp + (size_t)j * ldb);
    for (int k0 = 0; k0 < K; k0 += BK) {
        __syncthreads();
#pragma unroll
        for (int i = 0; i < 4; ++i) *(u32x4*)(sA + swz((tid >> 3) + 32 * i, tid & 7)) = ra[i];
        {
            u32x4 v;
            v.x = pack2(rb[0].x, rb[1].x); v.y = pack2(rb[2].x, rb[3].x); v.z = pack2(rb[4].x, rb[5].x); v.w = pack2(rb[6].x, rb[7].x);
            *(u32x4*)(sB + swz(nq * 4 + 0, kg)) = v;
            v.x = pack2(rb[0].y, rb[1].y); v.y = pack2(rb[2].y, rb[3].y); v.z = pack2(rb[4].y, rb[5].y); v.w = pack2(rb[6].y, rb[7].y);
            *(u32x4*)(sB + swz(nq * 4 + 1, kg)) = v;
            v.x = pack2(rb[0].z, rb[1].z); v.y = pack2(rb[2].z, rb[3].z); v.z = pack2(rb[4].z, rb[5].z); v.w = pack2(rb[6].z, rb[7].z);
            *(u32x4*)(sB + swz(nq * 4 + 2, kg)) = v;
            v.x = pack2(rb[0].w, rb[1].w); v.y = pack2(rb[2].w, rb[3].w); v.z = pack2(rb[4].w, rb[5].w); v.w = pack2(rb[6].w, rb[7].w);
            *(u32x4*)(sB + swz(nq * 4 + 3, kg)) = v;
        }
        __syncthreads();
        if (k0 + BK < K) {
#pragma unroll
            for (int i = 0; i < 4; ++i) ra[i] = *(const u32x4*)(ap[i] + k0 + BK);
#pragma unroll
            for (int j = 0; j < 8; ++j) rb[j] = *(const f32x4*)(bp + (size_t)(k0 + BK + j) * ldb);
        }
#pragma unroll
        for (int ks = 0; ks < 2; ++ks) {
            bf16x8 af[4], bfr[4];
#pragma unroll
            for (int m = 0; m < 4; ++m) af[m] = *(const bf16x8*)(sA + swz(wr * 64 + m * 16 + fr, ks * 4 + fq));
#pragma unroll
            for (int n = 0; n < 4; ++n) bfr[n] = *(const bf16x8*)(sB + swz(wc * 64 + n * 16 + fr, ks * 4 + fq));
#pragma unroll
            for (int m = 0; m < 4; ++m)
#pragma unroll
                for (int n = 0; n < 4; ++n) acc[m][n] = __builtin_amdgcn_mfma_f32_16x16x32_bf16(af[m], bfr[n], acc[m][n], 0, 0, 0);
        }
    }
}

__device__ __forceinline__ float wave_sum(float v) {
#pragma unroll
    for (int o = 32; o > 0; o >>= 1) v += __shfl_xor(v, o, 64);
    return v;
}

__device__ __forceinline__ int t5_bucket(int n) {
    if (n < 16) return n;
    const float v = logf((float)n / 16.f) / logf(128.f) * 16.f;
    int large = 16 + (int)v;
    return large < 31 ? large : 31;
}

__device__ void ph_mod(const Params& p, char* smem) {
    const int tid = threadIdx.x;
    float* cond = (float*)smem;
    float* red = cond + 4096;
    for (int i = tid; i < 4096; i += NTHREADS) { const float v = p.c[i]; cond[i] = v / (1.f + __expf(-v)); }
    __syncthreads();
    const int NU = 192;
    for (int u = blockIdx.x; u < NU + 2; u += gridDim.x) {
        if (u < NU) {
            const int cl = tid & 31, kq = tid >> 5, n = u * 32 + cl;
            float a0 = 0.f, a1 = 0.f, a2 = 0.f, a3 = 0.f;
            for (int k = kq; k < 1024; k += 8) {
                const float w = p.w_ada[(size_t)k * 6144 + n];
                a0 += cond[k] * w; a1 += cond[1024 + k] * w; a2 += cond[2048 + k] * w; a3 += cond[3072 + k] * w;
            }
            __syncthreads();
            red[(kq * 4 + 0) * 32 + cl] = a0; red[(kq * 4 + 1) * 32 + cl] = a1; red[(kq * 4 + 2) * 32 + cl] = a2; red[(kq * 4 + 3) * 32 + cl] = a3;
            __syncthreads();
            if (tid < 128) {
                const int b = tid >> 5, c2 = tid & 31;
                float s = 0.f;
                for (int q = 0; q < 8; ++q) s += red[(q * 4 + b) * 32 + c2];
                p.mod[b * 6144 + u * 32 + c2] = s + p.b_ada[u * 32 + c2];
            }
        } else if (u == NU) {
            for (int j = tid; j < 512; j += NTHREADS) {
                const float a = p.hg_lb[j], b = p.hg_lb[512 + j];
                const float m = fmaxf(a, b);
                const float ea = expf(a - m), eb = expf(b - m);
                p.lbv[j] = ea / (ea + eb);
            }
        } else {
            for (int i = tid; i < 3 * 129 * 4; i += NTHREADS) {
                const int g = i / (129 * 4), m = (i >> 2) % 129, hh = i & 3;
                const int dil = (g == 0) ? 1 : (g == 1 ? 4 : 16);
                p.biasT[i] = p.rel_bias[t5_bucket(m * dil) * 12 + g * 4 + hh];
            }
        }
    }
}

__device__ void ph_ln0(const Params& p) {
    const int lane = threadIdx.x & 63, wid = threadIdx.x >> 6;
    for (int row = blockIdx.x * 4 + wid; row < T; row += gridDim.x * 4) {
        const float4* xr = (const float4*)(p.x + (size_t)row * D);
        float4 v[4];
        float s = 0.f;
#pragma unroll
        for (int i = 0; i < 4; ++i) { v[i] = xr[lane + 64 * i]; s += v[i].x + v[i].y + v[i].z + v[i].w; }
        const float mean = wave_sum(s) * (1.f / D);
        float q = 0.f;
#pragma unroll
        for (int i = 0; i < 4; ++i) {
            v[i].x -= mean; v[i].y -= mean; v[i].z -= mean; v[i].w -= mean;
            q += v[i].x * v[i].x + v[i].y * v[i].y + v[i].z * v[i].z + v[i].w * v[i].w;
        }
        const float rstd = rsqrtf(wave_sum(q) * (1.f / D) + LN_EPS);
        const int b = row >> 12;
        const float* sh = p.mod + b * 6144;
        const float* sc = sh + 1024;
#pragma unroll
        for (int i = 0; i < 4; ++i) {
            const int col = (lane + 64 * i) * 4;
            const float4 s4 = *(const float4*)(sc + col), h4 = *(const float4*)(sh + col);
            uint2 o;
            o.x = pack2(v[i].x * rstd * (1.f + s4.x) + h4.x, v[i].y * rstd * (1.f + s4.y) + h4.y);
            o.y = pack2(v[i].z * rstd * (1.f + s4.z) + h4.z, v[i].w * rstd * (1.f + s4.w) + h4.w);
            *(uint2*)(p.h1 + (size_t)row * D + col) = o;
        }
    }
}

__device__ void ph_inproj(const Params& p, char* smem) {
    const int tid = threadIdx.x, lane = tid & 63, wid = tid >> 6, wr = wid >> 1, wc = wid & 1, fr = lane & 15, fq = lane >> 4;
    const int NT = INW / 128;
    for (int u = blockIdx.x; u < (T / 128) * NT; u += gridDim.x) {
        const int mt = u / NT, nt = u % NT;
        const bf16_t* A = p.h1 + (size_t)mt * 128 * D;
        const float* W = p.w_in + nt * 128;
        f32x4 acc[4][4];
        gemm_tile(smem, D, [&](int r) { return A + (size_t)r * D; }, [&](int n) { return W + n; }, INW, acc);
        if (nt >= 4 && nt < 8) {
#pragma unroll
            for (int m = 0; m < 4; ++m)
#pragma unroll
                for (int n = 0; n < 4; ++n) {
                    const int c = nt * 128 - OFF_HF + wc * 64 + n * 16 + fr;
                    const float lb = p.lbv[c];
#pragma unroll
                    for (int j = 0; j < 4; ++j) {
                        const int row = mt * 128 + wr * 64 + m * 16 + fq * 4 + j;
                        const float f = lb + (1.f - lb) * (1.f / (1.f + expf(-acc[m][n][j])));
                        p.lgf[(size_t)row * 512 + c] = logf(f);
                    }
                }
        } else {
#pragma unroll
            for (int m = 0; m < 4; ++m)
#pragma unroll
                for (int n = 0; n < 4; ++n)
#pragma unroll
                    for (int j = 0; j < 4; ++j) {
                        const int row = mt * 128 + wr * 64 + m * 16 + fq * 4 + j;
                        p.proj[(size_t)row * INW + nt * 128 + wc * 64 + n * 16 + fr] = f2bf(acc[m][n][j]);
                    }
        }
    }
}

__device__ void ph_hgrn_naive(const Params& p, char* smem) {
    const int tid = threadIdx.x;
    float* qs = (float*)smem;
    float* fs = qs + 2048;
    float* ks = fs + 2048;
    float* is = ks + 2048;
    const int el = tid >> 2, dq = tid & 3;
    for (int u = blockIdx.x; u < 32; u += gridDim.x) {
        const int bh = u >> 1, b = bh >> 2, h = bh & 3, eh = u & 1;
        const int e = eh * 64 + el;
        float s[32];
#pragma unroll
        for (int i = 0; i < 32; ++i) s[i] = 0.f;
        for (int t0 = 0; t0 < S; t0 += 16) {
            __syncthreads();
            for (int i = tid; i < 2048; i += NTHREADS) {
                const int tt = i >> 7, d = i & 127;
                const size_t row = (size_t)b * S + t0 + tt;
                const float f = expf(p.lgf[row * 512 + h * 128 + d]);
                fs[i] = f; ks[i] = 1.f - f;
                qs[i] = bf2f(p.proj[row * INW + OFF_HQ + h * 128 + d]);
            }
            for (int i = tid; i < 1024; i += NTHREADS) {
                const int tt = i >> 6, ee = i & 63;
                is[i] = bf2f(p.proj[((size_t)b * S + t0 + tt) * INW + OFF_HI + h * 128 + eh * 64 + ee]);
            }
            __syncthreads();
            for (int tt = 0; tt < 16; ++tt) {
                const float iv = is[tt * 64 + el];
                float o = 0.f;
#pragma unroll
                for (int i = 0; i < 32; ++i) {
                    const int d = tt * 128 + i * 4 + dq;
                    s[i] = fs[d] * s[i] + ks[d] * iv;
                    o += qs[d] * s[i];
                }
                o += __shfl_xor(o, 1, 64);
                o += __shfl_xor(o, 2, 64);
                if (dq == 0) p.oraw[((size_t)b * S + t0 + tt) * 512 + h * 128 + e] = o;
            }
        }
    }
}

__device__ void ph_attn_naive(const Params& p) {
    const int tid = threadIdx.x;
    for (int u = blockIdx.x; u < 256; u += gridDim.x) {
        const int hh = u & 3, tb = u >> 2;
        const int row = tb * 256 + tid, b = row >> 12, t = row & (S - 1);
        float M = -INFINITY, L = 0.f;
        float O[64];
#pragma unroll
        for (int d = 0; d < 64; ++d) O[d] = 0.f;
        for (int g = 0; g < 3; ++g) {
            const int dil = (g == 0) ? 1 : (g == 1 ? 4 : 16);
            const int col = (g * 4 + hh) * 64;
            float q[64];
            {
                const uint4* qp = (const uint4*)(p.proj + (size_t)row * INW + OFF_AQ + col);
#pragma unroll
                for (int i = 0; i < 8; ++i) {
                    const uint4 w = qp[i];
                    q[i * 8 + 0] = __uint_as_float(w.x << 16) * 0.125f; q[i * 8 + 1] = __uint_as_float(w.x & 0xffff0000u) * 0.125f;
                    q[i * 8 + 2] = __uint_as_float(w.y << 16) * 0.125f; q[i * 8 + 3] = __uint_as_float(w.y & 0xffff0000u) * 0.125f;
                    q[i * 8 + 4] = __uint_as_float(w.z << 16) * 0.125f; q[i * 8 + 5] = __uint_as_float(w.z & 0xffff0000u) * 0.125f;
                    q[i * 8 + 6] = __uint_as_float(w.w << 16) * 0.125f; q[i * 8 + 7] = __uint_as_float(w.w & 0xffff0000u) * 0.125f;
                }
            }
            for (int m = 0; m <= 128; ++m) {
                const int tk = t - m * dil;
                if (tk < 0) break;
                const size_t krow = ((size_t)b * S + tk) * INW;
                const uint4* kp = (const uint4*)(p.proj + krow + OFF_AK + col);
                float sc = p.biasT[(g * 129 + m) * 4 + hh];
#pragma unroll
                for (int i = 0; i < 8; ++i) {
                    const uint4 w = kp[i];
                    sc += q[i * 8 + 0] * __uint_as_float(w.x << 16) + q[i * 8 + 1] * __uint_as_float(w.x & 0xffff0000u)
                        + q[i * 8 + 2] * __uint_as_float(w.y << 16) + q[i * 8 + 3] * __uint_as_float(w.y & 0xffff0000u)
                        + q[i * 8 + 4] * __uint_as_float(w.z << 16) + q[i * 8 + 5] * __uint_as_float(w.z & 0xffff0000u)
                        + q[i * 8 + 6] * __uint_as_float(w.w << 16) + q[i * 8 + 7] * __uint_as_float(w.w & 0xffff0000u);
                }
                float pe;
                if (sc > M) {
                    const float r = __expf(M - sc);
                    L *= r;
#pragma unroll
                    for (int d = 0; d < 64; ++d) O[d] *= r;
                    M = sc; pe = 1.f;
                } else pe = __expf(sc - M);
                L += pe;
                const uint4* vp = (const uint4*)(p.proj + krow + OFF_AV + col);
#pragma unroll
                for (int i = 0; i < 8; ++i) {
                    const uint4 w = vp[i];
                    O[i * 8 + 0] += pe * __uint_as_float(w.x << 16); O[i * 8 + 1] += pe * __uint_as_float(w.x & 0xffff0000u);
                    O[i * 8 + 2] += pe * __uint_as_float(w.y << 16); O[i * 8 + 3] += pe * __uint_as_float(w.y & 0xffff0000u);
                    O[i * 8 + 4] += pe * __uint_as_float(w.z << 16); O[i * 8 + 5] += pe * __uint_as_float(w.z & 0xffff0000u);
                    O[i * 8 + 6] += pe * __uint_as_float(w.w << 16); O[i * 8 + 7] += pe * __uint_as_float(w.w & 0xffff0000u);
                }
            }
        }
        const float inv = 1.f / L;
        uint4* op = (uint4*)(p.mixin + (size_t)row * 768 + 512 + hh * 64);
#pragma unroll
        for (int i = 0; i < 8; ++i) {
            uint4 w;
            w.x = pack2(O[i * 8 + 0] * inv, O[i * 8 + 1] * inv); w.y = pack2(O[i * 8 + 2] * inv, O[i * 8 + 3] * inv);
            w.z = pack2(O[i * 8 + 4] * inv, O[i * 8 + 5] * inv); w.w = pack2(O[i * 8 + 6] * inv, O[i * 8 + 7] * inv);
            op[i] = w;
        }
    }
}

__device__ void ph_hgrn_norm(const Params& p) {
    const int lane = threadIdx.x & 63, wid = threadIdx.x >> 6;
    for (int row = blockIdx.x * 4 + wid; row < T; row += gridDim.x * 4) {
        const int c0 = lane * 8;
        const float4 a = *(const float4*)(p.oraw + (size_t)row * 512 + c0);
        const float4 b = *(const float4*)(p.oraw + (size_t)row * 512 + c0 + 4);
        float o[8] = {a.x, a.y, a.z, a.w, b.x, b.y, b.z, b.w};
        float ss = 0.f;
#pragma unroll
        for (int i = 0; i < 8; ++i) ss += o[i] * o[i];
        ss += __shfl_xor(ss, 1, 64); ss += __shfl_xor(ss, 2, 64); ss += __shfl_xor(ss, 4, 64); ss += __shfl_xor(ss, 8, 64);
        const float r = rsqrtf(ss * (1.f / 128.f) + RMS_EPS);
        const uint4 gw = *(const uint4*)(p.proj + (size_t)row * INW + OFF_HG + c0);
        const float g[8] = {__uint_as_float(gw.x << 16), __uint_as_float(gw.x & 0xffff0000u), __uint_as_float(gw.y << 16), __uint_as_float(gw.y & 0xffff0000u),
                            __uint_as_float(gw.z << 16), __uint_as_float(gw.z & 0xffff0000u), __uint_as_float(gw.w << 16), __uint_as_float(gw.w & 0xffff0000u)};
        float y[8];
#pragma unroll
        for (int i = 0; i < 8; ++i) y[i] = o[i] * r * p.hg_nw[c0 + i] * (g[i] / (1.f + __expf(-g[i])));
        uint4 w;
        w.x = pack2(y[0], y[1]); w.y = pack2(y[2], y[3]); w.z = pack2(y[4], y[5]); w.w = pack2(y[6], y[7]);
        *(uint4*)(p.mixin + (size_t)row * 768 + c0) = w;
    }
}

__device__ void ph_outproj(const Params& p, char* smem) {
    const int tid = threadIdx.x, lane = tid & 63, wid = tid >> 6, wr = wid >> 1, wc = wid & 1, fr = lane & 15, fq = lane >> 4;
    for (int u = blockIdx.x; u < (T / 128) * 8; u += gridDim.x) {
        const int mt = u >> 3, nt = u & 7;
        const bf16_t* A = p.mixin + (size_t)mt * 128 * 768;
        const float* W = p.w_out + nt * 128;
        f32x4 acc[4][4];
        gemm_tile(smem, 768, [&](int r) { return A + (size_t)r * 768; }, [&](int n) { return W + n; }, D, acc);
        const int b = (mt * 128) >> 12;
        const float* g1 = p.mod + b * 6144 + 2048;
#pragma unroll
        for (int m = 0; m < 4; ++m)
#pragma unroll
            for (int n = 0; n < 4; ++n) {
                const int col = nt * 128 + wc * 64 + n * 16 + fr;
                const float gg = g1[col];
#pragma unroll
                for (int j = 0; j < 4; ++j) {
                    const size_t row = (size_t)mt * 128 + wr * 64 + m * 16 + fq * 4 + j;
                    p.pre1[row * D + col] = ALPHA * p.x[row * D + col] + gg * acc[m][n][j];
                }
            }
    }
}

__device__ void ph_ln1(const Params& p) {
    const int lane = threadIdx.x & 63, wid = threadIdx.x >> 6;
    for (int row = blockIdx.x * 4 + wid; row < T; row += gridDim.x * 4) {
        const float4* xr = (const float4*)(p.pre1 + (size_t)row * D);
        float4 v[4];
        float s = 0.f;
#pragma unroll
        for (int i = 0; i < 4; ++i) { v[i] = xr[lane + 64 * i]; s += v[i].x + v[i].y + v[i].z + v[i].w; }
        float mean = wave_sum(s) * (1.f / D);
        float q = 0.f;
#pragma unroll
        for (int i = 0; i < 4; ++i) {
            v[i].x -= mean; v[i].y -= mean; v[i].z -= mean; v[i].w -= mean;
            q += v[i].x * v[i].x + v[i].y * v[i].y + v[i].z * v[i].z + v[i].w * v[i].w;
        }
        float rstd = rsqrtf(wave_sum(q) * (1.f / D) + LN_EPS);
        s = 0.f;
#pragma unroll
        for (int i = 0; i < 4; ++i) {
            const int col = (lane + 64 * i) * 4;
            const float4 g4 = *(const float4*)(p.ln1_g + col), b4 = *(const float4*)(p.ln1_b + col);
            v[i].x = v[i].x * rstd * g4.x + b4.x; v[i].y = v[i].y * rstd * g4.y + b4.y;
            v[i].z = v[i].z * rstd * g4.z + b4.z; v[i].w = v[i].w * rstd * g4.w + b4.w;
            *(float4*)(p.x1 + (size_t)row * D + col) = v[i];
            s += v[i].x + v[i].y + v[i].z + v[i].w;
        }
        mean = wave_sum(s) * (1.f / D);
        q = 0.f;
#pragma unroll
        for (int i = 0; i < 4; ++i) {
            v[i].x -= mean; v[i].y -= mean; v[i].z -= mean; v[i].w -= mean;
            q += v[i].x * v[i].x + v[i].y * v[i].y + v[i].z * v[i].z + v[i].w * v[i].w;
        }
        rstd = rsqrtf(wave_sum(q) * (1.f / D) + LN_EPS);
        const int b = row >> 12;
        const float* sh = p.mod + b * 6144 + 3072;
        const float* sc = sh + 1024;
#pragma unroll
        for (int i = 0; i < 4; ++i) {
            const int col = (lane + 64 * i) * 4;
            const float4 s4 = *(const float4*)(sc + col), h4 = *(const float4*)(sh + col);
            float4 y;
            y.x = v[i].x * rstd * (1.f + s4.x) + h4.x; y.y = v[i].y * rstd * (1.f + s4.y) + h4.y;
            y.z = v[i].z * rstd * (1.f + s4.z) + h4.z; y.w = v[i].w * rstd * (1.f + s4.w) + h4.w;
            *(float4*)(p.h2f + (size_t)row * D + col) = y;
            uint2 o;
            o.x = pack2(y.x, y.y); o.y = pack2(y.z, y.w);
            *(uint2*)(p.h2 + (size_t)row * D + col) = o;
        }
    }
}

__device__ void ph_router(const Params& p, char* smem) {
    const int tid = threadIdx.x;
    float* hs = (float*)smem;
    float* lg = hs + 8192;
    float* bz = lg + 2048;
    float* selw = bz + 2048;
    for (int u = blockIdx.x; u < T / 8; u += gridDim.x) {
        const int t0 = u * 8;
        __syncthreads();
        for (int i = tid; i < 2048; i += NTHREADS) ((float4*)hs)[i] = ((const float4*)(p.h2f + (size_t)t0 * D))[i];
        __syncthreads();
        {
            float acc[8];
#pragma unroll
            for (int tt = 0; tt < 8; ++tt) acc[tt] = 0.f;
            const float* wp = p.w_router + tid;
            for (int k = 0; k < 1024; k += 4) {
                const float w0 = wp[(size_t)k * 256], w1 = wp[(size_t)(k + 1) * 256], w2 = wp[(size_t)(k + 2) * 256], w3 = wp[(size_t)(k + 3) * 256];
#pragma unroll
                for (int tt = 0; tt < 8; ++tt) {
                    const float4 h = *(const float4*)(hs + tt * 1024 + k);
                    acc[tt] += h.x * w0; acc[tt] += h.y * w1; acc[tt] += h.z * w2; acc[tt] += h.w * w3;
                }
            }
#pragma unroll
            for (int tt = 0; tt < 8; ++tt) lg[tt * 256 + tid] = acc[tt];
        }
        __syncthreads();
        if (tid < 8) {
            const int tok = t0 + tid;
            float* l = lg + tid * 256;
            float* z = bz + tid * 256;
            float gs[8];
#pragma unroll
            for (int g = 0; g < 8; ++g) {
                float m1 = -INFINITY, m2 = -INFINITY;
                for (int j = 0; j < 32; ++j) {
                    const int e = g * 32 + j;
                    const float sc = 1.f / (1.f + expf(-l[e]));
                    const float bv = sc + p.router_bias[e];
                    l[e] = sc; z[e] = bv;
                    if (bv > m1) { m2 = m1; m1 = bv; } else if (bv > m2) m2 = bv;
                }
                gs[g] = m1 + m2;
            }
            unsigned gmask = 0u;
#pragma unroll
            for (int r = 0; r < 4; ++r) {
                float best = -INFINITY; int bi = 0;
#pragma unroll
                for (int g = 0; g < 8; ++g) {
                    const bool ok = (((gmask >> g) & 1u) == 0u) && (gs[g] > best);
                    if (ok) { best = gs[g]; bi = g; }
                }
                gmask |= 1u << bi;
            }
            float wsum = 0.f;
            for (int r = 0; r < 8; ++r) {
                float best = -INFINITY; int bi = 0;
                for (int e = 0; e < 256; ++e) {
                    const float v = z[e];
                    if (((gmask >> (e >> 5)) & 1u) && v > best) { best = v; bi = e; }
                }
                z[bi] = -INFINITY;
                const float sc = l[bi];
                selw[tid * 8 + r] = sc;
                wsum += sc;
                p.topi[tok * 8 + r] = bi;
            }
            const float inv = 2.5f / wsum;
            for (int r = 0; r < 8; ++r) {
                p.topw[tok * 8 + r] = selw[tid * 8 + r] * inv;
                const int e = p.topi[tok * 8 + r];
                const int pos = atomicAdd(&p.cnt[e], 1);
                p.list[(size_t)e * T + pos] = tok * 8 + r;
            }
        }
    }
}

struct ExpMap { int* cnt; int* off; int* tile; };
__device__ __forceinline__ ExpMap exp_map(const Params& p, char* smem) {
    ExpMap m;
    m.cnt = (int*)(smem + 32768); m.off = m.cnt + 256; m.tile = m.off + 256;
    const int tid = threadIdx.x;
    __syncthreads();
    m.cnt[tid] = p.cnt[tid];
    __syncthreads();
    if (tid == 0) {
        int off = 0, tl = 0;
        for (int e = 0; e < NE; ++e) { m.off[e] = off; m.tile[e] = tl; const int c = m.cnt[e]; off += c; tl += (c + 127) >> 7; }
        m.tile[NE] = tl;
    }
    __syncthreads();
    return m;
}
__device__ __forceinline__ int find_expert(const int* tile, int rt) {
    int lo = 0, hi = NE;
    while (hi - lo > 1) { const int mid = (lo + hi) >> 1; if (tile[mid] <= rt) lo = mid; else hi = mid; }
    return lo;
}

__device__ void ph_gateup(const Params& p, char* smem) {
    const int tid = threadIdx.x, lane = tid & 63, wid = tid >> 6, wr = wid >> 1, wc = wid & 1, fr = lane & 15, fq = lane >> 4;
    const ExpMap em = exp_map(p, smem);
    const int ntile = em.tile[NE];
    for (int u = blockIdx.x; u < (ntile + T / 128) * 4; u += gridDim.x) {
        const int rt = u >> 2, nt = u & 3, c0 = nt * 64;
        f32x4 acc[4][4];
        if (rt < ntile) {
            const int e = find_expert(em.tile, rt);
            const int r0 = (rt - em.tile[e]) * 128, ne = em.cnt[e];
            const int* lst = p.list + (size_t)e * T;
            const float* Wg = p.w_eg + (size_t)e * D * ED;
            const float* Wu = p.w_eu + (size_t)e * D * ED;
            gemm_tile(smem, D,
                      [&](int r) { const int rr = r0 + r; const int a = lst[rr < ne ? rr : 0]; return p.h2 + (size_t)(a >> 3) * D; },
                      [&](int n) { const int t16 = n >> 4; return ((t16 & 1) ? Wu : Wg) + c0 + 16 * (t16 >> 1) + (n & 15); },
                      ED, acc);
            const size_t gbase = (size_t)em.off[e];
#pragma unroll
            for (int m = 0; m < 4; ++m)
#pragma unroll
                for (int n = 0; n < 4; n += 2) {
                    const int col = c0 + 16 * (2 * wc + (n >> 1)) + fr;
#pragma unroll
                    for (int j = 0; j < 4; ++j) {
                        const int rr = r0 + wr * 64 + m * 16 + fq * 4 + j;
                        if (rr < ne) {
                            const float g = acc[m][n][j], uu = acc[m][n + 1][j];
                            p.gbuf[(gbase + rr) * ED + col] = f2bf(g / (1.f + __expf(-g)) * uu);
                        }
                    }
                }
        } else {
            const int tb = (rt - ntile) * 128;
            const bf16_t* A = p.h2 + (size_t)tb * D;
            gemm_tile(smem, D,
                      [&](int r) { return A + (size_t)r * D; },
                      [&](int n) { const int t16 = n >> 4; return ((t16 & 1) ? p.w_su : p.w_sg) + c0 + 16 * (t16 >> 1) + (n & 15); },
                      ED, acc);
#pragma unroll
            for (int m = 0; m < 4; ++m)
#pragma unroll
                for (int n = 0; n < 4; n += 2) {
                    const int col = c0 + 16 * (2 * wc + (n >> 1)) + fr;
#pragma unroll
                    for (int j = 0; j < 4; ++j) {
                        const int row = tb + wr * 64 + m * 16 + fq * 4 + j;
                        const float g = acc[m][n][j], uu = acc[m][n + 1][j];
                        p.gsh[(size_t)row * ED + col] = f2bf(g / (1.f + __expf(-g)) * uu);
                    }
                }
        }
    }
}

__device__ void ph_down(const Params& p, char* smem) {
    const int tid = threadIdx.x, lane = tid & 63, wid = tid >> 6, wr = wid >> 1, wc = wid & 1, fr = lane & 15, fq = lane >> 4;
    const ExpMap em = exp_map(p, smem);
    const int ntile = em.tile[NE];
    for (int u = blockIdx.x; u < (ntile + T / 128) * 8; u += gridDim.x) {
        const int rt = u >> 3, nt = u & 7;
        f32x4 acc[4][4];
        if (rt < ntile) {
            const int e = find_expert(em.tile, rt);
            const int r0 = (rt - em.tile[e]) * 128, ne = em.cnt[e];
            const int* lst = p.list + (size_t)e * T;
            const bf16_t* A = p.gbuf + (size_t)em.off[e] * ED;
            const float* W = p.w_ed + (size_t)e * ED * D + nt * 128;
            gemm_tile(smem, ED,
                      [&](int r) { const int rr = r0 + r; return A + (size_t)(rr < ne ? rr : 0) * ED; },
                      [&](int n) { return W + n; }, D, acc);
#pragma unroll
            for (int m = 0; m < 4; ++m)
#pragma unroll
                for (int j = 0; j < 4; ++j) {
                    const int rr = r0 + wr * 64 + m * 16 + fq * 4 + j;
                    if (rr < ne) {
                        const int a = lst[rr];
                        const float w = p.topw[a];
                        bf16_t* yr = p.ybuf + ((size_t)(a >> 3) * 9 + (a & 7)) * D + nt * 128 + wc * 64 + fr;
#pragma unroll
                        for (int n = 0; n < 4; ++n) yr[n * 16] = f2bf(acc[m][n][j] * w);
                    }
                }
        } else {
            const int tb = (rt - ntile) * 128;
            const bf16_t* A = p.gsh + (size_t)tb * ED;
            const float* W = p.w_sd + nt * 128;
            gemm_tile(smem, ED, [&](int r) { return A + (size_t)r * ED; }, [&](int n) { return W + n; }, D, acc);
#pragma unroll
            for (int m = 0; m < 4; ++m)
#pragma unroll
                for (int j = 0; j < 4; ++j) {
                    const int row = tb + wr * 64 + m * 16 + fq * 4 + j;
                    bf16_t* yr = p.ybuf + ((size_t)row * 9 + 8) * D + nt * 128 + wc * 64 + fr;
#pragma unroll
                    for (int n = 0; n < 4; ++n) yr[n * 16] = f2bf(acc[m][n][j]);
                }
        }
    }
}

__device__ void ph_final(const Params& p) {
    const int lane = threadIdx.x & 63, wid = threadIdx.x >> 6;
    for (int row = blockIdx.x * 4 + wid; row < T; row += gridDim.x * 4) {
        const int b = row >> 12;
        const float* g2 = p.mod + b * 6144 + 5120;
        float4 v[4];
        float s = 0.f;
#pragma unroll
        for (int i = 0; i < 4; ++i) {
            const int col = (lane + 64 * i) * 4;
            float f0 = 0.f, f1 = 0.f, f2 = 0.f, f3 = 0.f;
#pragma unroll
            for (int k = 0; k < 9; ++k) {
                const uint2 w = *(const uint2*)(p.ybuf + ((size_t)row * 9 + k) * D + col);
                f0 += __uint_as_float(w.x << 16); f1 += __uint_as_float(w.x & 0xffff0000u);
                f2 += __uint_as_float(w.y << 16); f3 += __uint_as_float(w.y & 0xffff0000u);
            }
            const float4 xv = *(const float4*)(p.x1 + (size_t)row * D + col);
            const float4 g4 = *(const float4*)(g2 + col);
            v[i].x = ALPHA * xv.x + g4.x * f0; v[i].y = ALPHA * xv.y + g4.y * f1;
            v[i].z = ALPHA * xv.z + g4.z * f2; v[i].w = ALPHA * xv.w + g4.w * f3;
            s += v[i].x + v[i].y + v[i].z + v[i].w;
        }
        const float mean = wave_sum(s) * (1.f / D);
        float q = 0.f;
#pragma unroll
        for (int i = 0; i < 4; ++i) {
            v[i].x -= mean; v[i].y -= mean; v[i].z -= mean; v[i].w -= mean;
            q += v[i].x * v[i].x + v[i].y * v[i].y + v[i].z * v[i].z + v[i].w * v[i].w;
        }
        const float rstd = rsqrtf(wave_sum(q) * (1.f / D) + LN_EPS);
#pragma unroll
        for (int i = 0; i < 4; ++i) {
            const int col = (lane + 64 * i) * 4;
            const float4 g4 = *(const float4*)(p.ln2_g + col), b4 = *(const float4*)(p.ln2_b + col);
            float4 y;
            y.x = v[i].x * rstd * g4.x + b4.x; y.y = v[i].y * rstd * g4.y + b4.y;
            y.z = v[i].z * rstd * g4.z + b4.z; y.w = v[i].w * rstd * g4.w + b4.w;
            *(float4*)(p.out + (size_t)row * D + col) = y;
        }
    }
}

constexpr int LDS_BYTES = 65536;
constexpr int NPHASE = 11;

template <int PH>
__device__ __forceinline__ void run_phase(const Params& p, char* smem) {
    if (PH == 0) ph_mod(p, smem);
    if (PH == 1) ph_ln0(p);
    if (PH == 2) ph_inproj(p, smem);
    if (PH == 3) { ph_hgrn_naive(p, smem); ph_attn_naive(p); }
    if (PH == 4) ph_hgrn_norm(p);
    if (PH == 5) ph_outproj(p, smem);
    if (PH == 6) ph_ln1(p);
    if (PH == 7) ph_router(p, smem);
    if (PH == 8) ph_gateup(p, smem);
    if (PH == 9) ph_down(p, smem);
    if (PH == 10) ph_final(p);
}

template <int PH>
__global__ void __launch_bounds__(NTHREADS, 2) k_phase(Params p) {
    extern __shared__ __attribute__((aligned(16))) char smem[];
    run_phase<PH>(p, smem);
}

__global__ void __launch_bounds__(NTHREADS, 2) k_all(Params p) {
    extern __shared__ __attribute__((aligned(16))) char smem[];
    volatile LAS unsigned* st = (volatile LAS unsigned*)(smem + LDS_BYTES - 16);
    if (threadIdx.x == 0) { st[0] = 0u; st[1] = 0u; st[2] = 0u; st[3] = 0u; }
    __syncthreads();
    XcdBarrier bar = xcd_barrier_post(p.bar, st);
    run_phase<0>(p, smem); xcd_barrier(bar);
    run_phase<1>(p, smem); xcd_barrier(bar);
    run_phase<2>(p, smem); xcd_barrier(bar);
    run_phase<3>(p, smem); xcd_barrier(bar);
    run_phase<4>(p, smem); xcd_barrier(bar);
    run_phase<5>(p, smem); xcd_barrier(bar);
    run_phase<6>(p, smem); xcd_barrier(bar);
    run_phase<7>(p, smem); xcd_barrier(bar);
    run_phase<8>(p, smem); xcd_barrier(bar);
    run_phase<9>(p, smem); xcd_barrier(bar);
    run_phase<10>(p, smem);
}

template <int PH>
static void launch_phase(const Params& p, int grid, hipStream_t stream) {
    hipLaunchKernelGGL(k_phase<PH>, dim3(grid), dim3(NTHREADS), LDS_BYTES, stream, p);
}

extern "C" void kernel_launch(void* const* d_in, const int* in_sizes, int n_in, void* d_out, int out_size, void* d_ws, size_t ws_size,
                              hipStream_t stream) {
    (void)in_sizes; (void)n_in; (void)out_size;
    Params p{};
    const float** pin = (const float**)&p.x;
    for (int i = 0; i < 21; ++i) pin[i] = (const float*)d_in[i];
    p.out = (float*)d_out;
    char* ws = (char*)d_ws;
    size_t off = 0;
    auto carve = [&](size_t bytes) { char* r = ws + off; off += (bytes + 255) & ~(size_t)255; return r; };
    char* ctl = carve(65536);
    p.bar = (unsigned*)ctl;
    p.cnt = (int*)(ctl + 16384);
    p.mod = (float*)carve(4 * 6144 * 4);
    p.lbv = (float*)carve(512 * 4);
    p.biasT = (float*)carve(3 * 129 * 4 * 4);
    p.h1 = (bf16_t*)carve((size_t)T * D * 2);
    p.proj = (bf16_t*)carve((size_t)T * INW * 2);
    p.lgf = (float*)carve((size_t)T * 512 * 4);
    p.oraw = (float*)carve((size_t)T * 512 * 4);
    p.mixin = (bf16_t*)carve((size_t)T * 768 * 2);
    p.pre1 = (float*)carve((size_t)T * D * 4);
    p.x1 = (float*)carve((size_t)T * D * 4);
    p.h2 = (bf16_t*)carve((size_t)T * D * 2);
    p.h2f = (float*)carve((size_t)T * D * 4);
    p.topi = (int*)carve((size_t)T * 8 * 4);
    p.topw = (float*)carve((size_t)T * 8 * 4);
    p.list = (int*)carve((size_t)NE * T * 4);
    p.gbuf = (bf16_t*)carve((size_t)T * TOPK * ED * 2);
    p.gsh = (bf16_t*)carve((size_t)T * ED * 2);
    p.ybuf = (bf16_t*)carve((size_t)T * 9 * D * 2);
    if (off > ws_size) { fprintf(stderr, "kernel_launch: workspace too small: need %zu have %zu\n", off, ws_size); return; }

    static int grid = 0;
    if (grid == 0) {
        int dev = 0, cus = 0, per_cu = 0;
        hipGetDevice(&dev);
        hipDeviceGetAttribute(&cus, hipDeviceAttributeMultiprocessorCount, dev);
        hipOccupancyMaxActiveBlocksPerMultiprocessor(&per_cu, (const void*)k_all, NTHREADS, LDS_BYTES);
        if (per_cu < 1) per_cu = 1;
        grid = cus * (per_cu < 2 ? per_cu : 2);
        fprintf(stderr, "kernel_launch: cus %d per_cu %d grid %d ws need %zu have %zu\n", cus, per_cu, grid, off, ws_size);
    }
    hipMemsetAsync(ctl, 0, 65536, stream);
#if ONE_LAUNCH
    hipLaunchKernelGGL(k_all, dim3(grid), dim3(NTHREADS), LDS_BYTES, stream, p);
#else
    launch_phase<0>(p, grid, stream); launch_phase<1>(p, grid, stream); launch_phase<2>(p, grid, stream); launch_phase<3>(p, grid, stream);
    launch_phase<4>(p, grid, stream); launch_phase<5>(p, grid, stream); launch_phase<6>(p, grid, stream); launch_phase<7>(p, grid, stream);
    launch_phase<8>(p, grid, stream); launch_phase<9>(p, grid, stream); launch_phase<10>(p, grid, stream);
#endif
}
```

```cpp
#include <hip/hip_runtime.h>
#include <stdint.h>
#include <stdio.h>

#ifndef ONE_LAUNCH
#define ONE_LAUNCH 1
#endif

constexpr int D = 1024, NBATCH = 4, S = 4096, T = NBATCH * S;
constexpr int INW = 4352;
constexpr int NE = 256, TOPK = 8, ED = 256;
constexpr int OFF_HQ = 0, OFF_HF = 512, OFF_HI = 1024, OFF_HG = 1536, OFF_AQ = 2048, OFF_AK = 2816, OFF_AV = 3584;
constexpr float ALPHA = 1.189207115002721f;
constexpr float LN_EPS = 1e-5f, RMS_EPS = 1e-6f;
constexpr int NTHREADS = 256;

typedef unsigned short bf16_t;
using bf16x8 = __attribute__((ext_vector_type(8))) short;
using f32x4 = __attribute__((ext_vector_type(4))) float;
using u32x4 = __attribute__((ext_vector_type(4))) unsigned int;

typedef float v2f_t __attribute__((ext_vector_type(2)));
typedef __bf16 v2bf_t __attribute__((ext_vector_type(2)));
typedef short v4s __attribute__((ext_vector_type(4)));
__device__ __forceinline__ unsigned short f2bf(float f) { return __builtin_bit_cast(unsigned short, (__bf16)f); }
__device__ __forceinline__ float bf2f(unsigned short h) { return __uint_as_float(((uint32_t)h) << 16); }
__device__ __forceinline__ uint32_t pack2(float a, float b) {
    const v2f_t f = {a, b};
    return __builtin_bit_cast(uint32_t, __builtin_convertvector(f, v2bf_t));
}
__device__ __forceinline__ float sigmoidf_(float v) { return 1.f / (1.f + __expf(-v)); }

__device__ __forceinline__ int otid() { int t = threadIdx.x; asm volatile("" : "+v"(t)); return t; }

struct Params {
    const float *x, *c, *w_ada, *b_ada, *w_in, *hg_lb, *hg_nw, *rel_bias, *w_out, *ln1_g, *ln1_b, *w_router, *router_bias,
        *w_eg, *w_eu, *w_ed, *w_sg, *w_su, *w_sd, *ln2_g, *ln2_b;
    float* out;
    unsigned* bar;
    int* cnt;
    float* mod;
    float* lbv;
    float* biasT;
    bf16_t* h1;
    bf16_t* proj;
    float* lgf;
    float* oraw;
    bf16_t* mixin;
    float* pre1;
    float* x1;
    bf16_t* h2;
    float* h2f;
    int* topi;
    float* topw;
    int* list;
    bf16_t* gbuf;
    bf16_t* gsh;
    bf16_t* ybuf;
    float* kv;
    float* dec;
    bf16_t* sst;
};

#define XB_TMO      128
#define XB_XCNT(j)  (256  + 64 * (j))
#define XB_XSUB(j)  (1280 + 64 * (j))
#define XB_XGEN(j)  (2304 + 64 * (j))
#define XB_TOP      3328
#define XB_TOPGEN   3392
#define XCD_BAR_WORDS 3456
#define XB_SPIN_CAP (1u << 18)
#define LAS __attribute__((address_space(3)))

__device__ __forceinline__ unsigned xb_ld(unsigned* p)              { return __hip_atomic_load(p, __ATOMIC_RELAXED, __HIP_MEMORY_SCOPE_AGENT); }
__device__ __forceinline__ unsigned xb_add(unsigned* p, unsigned v) { return __hip_atomic_fetch_add(p, v, __ATOMIC_RELAXED, __HIP_MEMORY_SCOPE_AGENT); }
__device__ __forceinline__ unsigned xb_xcc_id() { return (unsigned)__builtin_amdgcn_s_getreg((3 << 11) | 20) & 0xFu; }
#define XB_SPIN(cond, bar) do { unsigned _sp = 0; while (cond) { __builtin_amdgcn_s_sleep(1); \
    if ((++_sp & 255u) == 0u) { if (xb_ld(&(bar)[XB_TMO])) break; if (_sp > XB_SPIN_CAP) { atomicAdd(&(bar)[XB_TMO], 1u); break; } } } } while (0)

struct XcdBarrier {
    unsigned* bar; unsigned x;
    volatile LAS unsigned* st;
};
__device__ __forceinline__ XcdBarrier xcd_barrier_post(unsigned* bar, volatile LAS unsigned* st) {
    XcdBarrier b; b.bar = bar; b.x = xb_xcc_id(); b.st = st;
    if (threadIdx.x == 0) (void)xb_add(&bar[XB_XCNT(b.x)], 1u);
    return b;
}
__device__ __forceinline__ void xcd_barrier_complete(unsigned* bar, unsigned x, unsigned& nloc, unsigned& nx) {
    const unsigned G = gridDim.x * gridDim.y * gridDim.z;
    unsigned sum, cnt, mine, sp = 0u;
    for (;;) {
        sum = 0u; cnt = 0u; mine = 0u;
#pragma unroll
        for (unsigned j = 0; j < 16; ++j) { const unsigned c = xb_ld(&bar[XB_XCNT(j)]); sum += c; cnt += (c > 0u) ? 1u : 0u; mine = (j == x) ? c : mine; }
        if (sum == G) break;
        __builtin_amdgcn_s_sleep(1);
        if ((++sp & 255u) == 0u) { if (xb_ld(&bar[XB_TMO])) break; if (sp > XB_SPIN_CAP) { atomicAdd(&bar[XB_TMO], 1u); break; } }
    }
    nloc = mine > 0u ? mine : 1u; nx = cnt > 0u ? cnt : 1u;
}
__device__ __forceinline__ void xcd_barrier(const XcdBarrier& b) {
    asm volatile("s_waitcnt vmcnt(0)" ::: "memory");
    __syncthreads();
    if (threadIdx.x == 0) {
        unsigned* bar = b.bar;
        __builtin_amdgcn_s_waitcnt(0);
        unsigned nloc = b.st[0], nx = b.st[1];
        if (nloc == 0u) { xcd_barrier_complete(bar, b.x, nloc, nx); b.st[0] = nloc; b.st[1] = nx; }
        const unsigned old = xb_add(&bar[XB_XSUB(b.x)], 1u);
        const unsigned gen = old / nloc;
        if (old + 1u == (gen + 1u) * nloc) {
            __builtin_amdgcn_fence(__ATOMIC_RELEASE, "agent");
            asm volatile("s_waitcnt vmcnt(0)" ::: "memory");
            const unsigned og = xb_add(&bar[XB_TOP], 1u);
            const unsigned tg = og / nx;
            if (og + 1u == (tg + 1u) * nx) xb_add(&bar[XB_TOPGEN], 1u);
            else XB_SPIN(xb_ld(&bar[XB_TOPGEN]) == tg, bar);
            __builtin_amdgcn_fence(__ATOMIC_ACQUIRE, "agent");
            xb_add(&bar[XB_XGEN(b.x)], 1u);
            asm volatile("s_waitcnt vmcnt(0)" ::: "memory");
        } else {
            XB_SPIN(xb_ld(&bar[XB_XGEN(b.x)]) == gen, bar);
            __builtin_amdgcn_fence(__ATOMIC_ACQUIRE, "agent");
            asm volatile("s_waitcnt vmcnt(0)" ::: "memory");
        }
    }
    __syncthreads();
}

constexpr int BK = 64;
__device__ __forceinline__ int swz(int row, int chunk) { return row * 128 + ((chunk ^ ((row >> 1) & 7)) << 4); }

template <class AF, class BF>
__device__ __forceinline__ void gemm_tile(char* smem, const int K, AF arow, BF bcol, const int ldb, f32x4 (&acc)[4][4]) {
    const int tid = otid(), lane = tid & 63, wid = tid >> 6, wr = wid >> 1, wc = wid & 1, fr = lane & 15, fq = lane >> 4;
    char* sA = smem;
    char* sB = smem + 16384;
    const bf16_t* ap[4];
#pragma unroll
    for (int i = 0; i < 4; ++i) ap[i] = arow((tid >> 3) + 32 * i) + (tid & 7) * 8;
    const int nq = tid & 31, kg = tid >> 5;
    const float* bp = bcol(nq * 4) + (size_t)(kg * 8) * ldb;
#pragma unroll
    for (int m = 0; m < 4; ++m)
#pragma unroll
        for (int n = 0; n < 4; ++n) acc[m][n] = f32x4{0.f, 0.f, 0.f, 0.f};
    u32x4 ra[4];
    f32x4 rb[8];
#pragma unroll
    for (int i = 0; i < 4; ++i) ra[i] = *(const u32x4*)(ap[i]);
#pragma unroll
    for (int j = 0; j < 8; ++j) rb[j] = *(const f32x4*)(bp + (size_t)j * ldb);
    for (int k0 = 0; k0 < K; k0 += BK) {
        __syncthreads();
#pragma unroll
        for (int i = 0; i < 4; ++i) *(u32x4*)(sA + swz((tid >> 3) + 32 * i, tid & 7)) = ra[i];
        {
            u32x4 v;
            v.x = pack2(rb[0].x, rb[1].x); v.y = pack2(rb[2].x, rb[3].x); v.z = pack2(rb[4].x, rb[5].x); v.w = pack2(rb[6].x, rb[7].x);
            *(u32x4*)(sB + swz(nq * 4 + 0, kg)) = v;
            v.x = pack2(rb[0].y, rb[1].y); v.y = pack2(rb[2].y, rb[3].y); v.z = pack2(rb[4].y, rb[5].y); v.w = pack2(rb[6].y, rb[7].y);
            *(u32x4*)(sB + swz(nq * 4 + 1, kg)) = v;
            v.x = pack2(rb[0].z, rb[1].z); v.y = pack2(rb[2].z, rb[3].z); v.z = pack2(rb[4].z, rb[5].z); v.w = pack2(rb[6].z, rb[7].z);
            *(u32x4*)(sB + swz(nq * 4 + 2, kg)) = v;
            v.x = pack2(rb[0].w, rb[1].w); v.y = pack2(rb[2].w, rb[3].w); v.z = pack2(rb[4].w, rb[5].w); v.w = pack2(rb[6].w, rb[7].w);
            *(u32x4*)(sB + swz(nq * 4 + 3, kg)) = v;
        }
        __syncthreads();
        if (k0 + BK < K) {
#pragma unroll
            for (int i = 0; i < 4; ++i) ra[i] = *(const u32x4*)(ap[i] + k0 + BK);
#pragma unroll
            for (int j = 0; j < 8; ++j) rb[j] = *(const f32x4*)(bp + (size_t)(k0 + BK + j) * ldb);
        }
#pragma unroll
        for (int ks = 0; ks < 2; ++ks) {
            bf16x8 af[4], bfr[4];
#pragma unroll
            for (int m = 0; m < 4; ++m) af[m] = *(const bf16x8*)(sA + swz(wr * 64 + m * 16 + fr, ks * 4 + fq));
#pragma unroll
            for (int n = 0; n < 4; ++n) bfr[n] = *(const bf16x8*)(sB + swz(wc * 64 + n * 16 + fr, ks * 4 + fq));
#pragma unroll
            for (int m = 0; m < 4; ++m)
#pragma unroll
                for (int n = 0; n < 4; ++n) acc[m][n] = __builtin_amdgcn_mfma_f32_16x16x32_bf16(af[m], bfr[n], acc[m][n], 0, 0, 0);
        }
    }
}

__device__ __forceinline__ float wave_sum(float v) {
#pragma unroll
    for (int o = 32; o > 0; o >>= 1) v += __shfl_xor(v, o, 64);
    return v;
}

__device__ __forceinline__ int t5_bucket(int n) {
    if (n < 16) return n;
    const float v = logf((float)n / 16.f) / logf(128.f) * 16.f;
    int large = 16 + (int)v;
    return large < 31 ? large : 31;
}

__device__ void ph_mod(const Params& p, char* smem) {
    const int tid = otid();
    float* cond = (float*)smem;
    float* red = cond + 4096;
    for (int i = tid; i < 4096; i += NTHREADS) { const float v = p.c[i]; cond[i] = v / (1.f + __expf(-v)); }
    __syncthreads();
    const int NU = 192;
    for (int u = blockIdx.x; u < NU + 2; u += gridDim.x) {
        if (u < NU) {
            const int cl = tid & 31, kq = tid >> 5, n = u * 32 + cl;
            float a0 = 0.f, a1 = 0.f, a2 = 0.f, a3 = 0.f;
            for (int k = kq; k < 1024; k += 8) {
                const float w = p.w_ada[(size_t)k * 6144 + n];
                a0 += cond[k] * w; a1 += cond[1024 + k] * w; a2 += cond[2048 + k] * w; a3 += cond[3072 + k] * w;
            }
            __syncthreads();
            red[(kq * 4 + 0) * 32 + cl] = a0; red[(kq * 4 + 1) * 32 + cl] = a1; red[(kq * 4 + 2) * 32 + cl] = a2; red[(kq * 4 + 3) * 32 + cl] = a3;
            __syncthreads();
            if (tid < 128) {
                const int b = tid >> 5, c2 = tid & 31;
                float s = 0.f;
                for (int q = 0; q < 8; ++q) s += red[(q * 4 + b) * 32 + c2];
                p.mod[b * 6144 + u * 32 + c2] = s + p.b_ada[u * 32 + c2];
            }
        } else if (u == NU) {
            for (int j = tid; j < 512; j += NTHREADS) {
                const float a = p.hg_lb[j], b = p.hg_lb[512 + j];
                const float m = fmaxf(a, b);
                const float ea = expf(a - m), eb = expf(b - m);
                p.lbv[j] = ea / (ea + eb);
            }
        } else {
            for (int i = tid; i < 3 * 129 * 4; i += NTHREADS) {
                const int g = i / (129 * 4), m = (i >> 2) % 129, hh = i & 3;
                const int dil = (g == 0) ? 1 : (g == 1 ? 4 : 16);
                p.biasT[i] = p.rel_bias[t5_bucket(m * dil) * 12 + g * 4 + hh];
            }
        }
    }
}

__device__ void ph_ln0(const Params& p) {
    const int tid = otid(), lane = tid & 63, wid = tid >> 6;
    for (int row = blockIdx.x * 4 + wid; row < T; row += gridDim.x * 4) {
        const float4* xr = (const float4*)(p.x + (size_t)row * D);
        float4 v[4];
        float s = 0.f;
#pragma unroll
        for (int i = 0; i < 4; ++i) { v[i] = xr[lane + 64 * i]; s += v[i].x + v[i].y + v[i].z + v[i].w; }
        const float mean = wave_sum(s) * (1.f / D);
        float q = 0.f;
#pragma unroll
        for (int i = 0; i < 4; ++i) {
            v[i].x -= mean; v[i].y -= mean; v[i].z -= mean; v[i].w -= mean;
            q += v[i].x * v[i].x + v[i].y * v[i].y + v[i].z * v[i].z + v[i].w * v[i].w;
        }
        const float rstd = rsqrtf(wave_sum(q) * (1.f / D) + LN_EPS);
        const int b = row >> 12;
        const float* sh = p.mod + b * 6144;
        const float* sc = sh + 1024;
#pragma unroll
        for (int i = 0; i < 4; ++i) {
            const int col = (lane + 64 * i) * 4;
            const float4 s4 = *(const float4*)(sc + col), h4 = *(const float4*)(sh + col);
            uint2 o;
            o.x = pack2(v[i].x * rstd * (1.f + s4.x) + h4.x, v[i].y * rstd * (1.f + s4.y) + h4.y);
            o.y = pack2(v[i].z * rstd * (1.f + s4.z) + h4.z, v[i].w * rstd * (1.f + s4.w) + h4.w);
            *(uint2*)(p.h1 + (size_t)row * D + col) = o;
        }
    }
}

__device__ void ph_inproj(const Params& p, char* smem) {
    const int tid = otid(), lane = tid & 63, wid = tid >> 6, wr = wid >> 1, wc = wid & 1, fr = lane & 15, fq = lane >> 4;
    const int NT = INW / 128;
    for (int u = blockIdx.x; u < (T / 128) * NT; u += gridDim.x) {
        const int mt = u / NT, nt = u % NT;
        const bf16_t* A = p.h1 + (size_t)mt * 128 * D;
        const float* W = p.w_in + nt * 128;
        f32x4 acc[4][4];
        gemm_tile(smem, D, [&](int r) { return A + (size_t)r * D; }, [&](int n) { return W + n; }, INW, acc);
        if (nt >= 4 && nt < 8) {
#pragma unroll
            for (int m = 0; m < 4; ++m)
#pragma unroll
                for (int n = 0; n < 4; ++n) {
                    const int c = nt * 128 - OFF_HF + wc * 64 + n * 16 + fr;
                    const float lb = p.lbv[c];
#pragma unroll
                    for (int j = 0; j < 4; ++j) {
                        const int row = mt * 128 + wr * 64 + m * 16 + fq * 4 + j;
                        const float f = lb + (1.f - lb) * (1.f / (1.f + expf(-acc[m][n][j])));
                        p.lgf[(size_t)row * 512 + c] = logf(f);
                    }
                }
        } else {
#pragma unroll
            for (int m = 0; m < 4; ++m)
#pragma unroll
                for (int n = 0; n < 4; ++n)
#pragma unroll
                    for (int j = 0; j < 4; ++j) {
                        const int row = mt * 128 + wr * 64 + m * 16 + fq * 4 + j;
                        p.proj[(size_t)row * INW + nt * 128 + wc * 64 + n * 16 + fr] = f2bf(acc[m][n][j]);
                    }
        }
    }
}


__device__ __forceinline__ int swz16(int row, int chunk) { return row * 256 + ((chunk ^ (row & 15)) << 4); }
__device__ __forceinline__ bf16x8 tr_frag16(const char* tile, int ks, int c) {
    const int lane = otid() & 63, g = lane >> 4, q = (lane & 15) >> 2, pp = lane & 3;
    const int r0 = 32 * ks + 8 * g + q, ch = 2 * c + (pp >> 1), bo = 8 * (pp & 1);
    const v4s lo = __builtin_amdgcn_ds_read_tr16_b64_v4i16((LAS v4s*)(tile + swz16(r0, ch) + bo));
    const v4s hi = __builtin_amdgcn_ds_read_tr16_b64_v4i16((LAS v4s*)(tile + swz16(r0 + 4, ch) + bo));
    return bf16x8{lo[0], lo[1], lo[2], lo[3], hi[0], hi[1], hi[2], hi[3]};
}

__device__ void ph_h1(const Params& p, char* smem) {
    const int tid = otid(), lane = tid & 63, wid = tid >> 6, wr = wid >> 1, wc = wid & 1, fr = lane & 15, fq = lane >> 4;
    char* sI = smem;
    char* sK = smem + 16384;
    float* sL = (float*)(smem + 32768);
    float* totS = (float*)(smem + 65536);
    const int d = tid & 127, half = tid >> 7;
    for (int u = blockIdx.x; u < 1024; u += gridDim.x) {
        const int bh = u >> 6, c = u & 63, b = bh >> 2, h = bh & 3;
        const size_t row0 = (size_t)b * S + c * 64;
        __syncthreads();
#pragma unroll
        for (int i = 0; i < 4; ++i) {
            const int idx = tid + 256 * i, r = idx >> 4, ch = idx & 15;
            *(u32x4*)(sI + swz16(r, ch)) = *(const u32x4*)(p.proj + (row0 + r) * INW + OFF_HI + h * 128 + ch * 8);
        }
#pragma unroll
        for (int i = 0; i < 8; ++i) {
            const int idx = tid + 256 * i, r = idx >> 5, c4 = idx & 31;
            *(f32x4*)(sL + r * 128 + c4 * 4) = *(const f32x4*)(p.lgf + (row0 + r) * 512 + h * 128 + c4 * 4);
        }
        __syncthreads();
        const float* lcol = sL + half * 32 * 128 + d;
        float tot = 0.f;
#pragma unroll
        for (int s = 0; s < 32; ++s) tot += lcol[s * 128];
        totS[half * 128 + d] = tot;
        __syncthreads();
        const float t0 = totS[d], bl = t0 + totS[128 + d];
        float run = half ? t0 : 0.f;
#pragma unroll 8
        for (int s = 0; s < 32; ++s) {
            const float lv = lcol[s * 128];
            run += lv;
            const float kt = (1.f - __expf(lv)) * __expf(bl - run);
            *(bf16_t*)(sK + swz16(half * 32 + s, d >> 3) + (d & 7) * 2) = f2bf(kt);
        }
        if (half == 0) p.dec[u * 128 + d] = __expf(bl);
        __syncthreads();
        f32x4 acc[4][4];
#pragma unroll
        for (int m = 0; m < 4; ++m)
#pragma unroll
            for (int n = 0; n < 4; ++n) acc[m][n] = f32x4{0.f, 0.f, 0.f, 0.f};
#pragma unroll
        for (int ks = 0; ks < 2; ++ks) {
            bf16x8 af[4], bfr[4];
#pragma unroll
            for (int m = 0; m < 4; ++m) af[m] = tr_frag16(sI, ks, wr * 4 + m);
#pragma unroll
            for (int n = 0; n < 4; ++n) bfr[n] = tr_frag16(sK, ks, wc * 4 + n);
#pragma unroll
            for (int m = 0; m < 4; ++m)
#pragma unroll
                for (int n = 0; n < 4; ++n) acc[m][n] = __builtin_amdgcn_mfma_f32_16x16x32_bf16(af[m], bfr[n], acc[m][n], 0, 0, 0);
        }
        float* kvu = p.kv + (size_t)u * 16384;
#pragma unroll
        for (int m = 0; m < 4; ++m)
#pragma unroll
            for (int n = 0; n < 4; ++n)
#pragma unroll
                for (int j = 0; j < 4; ++j) kvu[(wr * 64 + m * 16 + fq * 4 + j) * 128 + wc * 64 + n * 16 + fr] = acc[m][n][j];
    }
}

__device__ void ph_h2(const Params& p) {
    for (int it = blockIdx.x * NTHREADS + otid(); it < 16 * 8192; it += gridDim.x * NTHREADS) {
        const int bh = it >> 13, e2 = it & 8191, dv = e2 >> 6, dk = (e2 & 63) * 2;
        const size_t eoff = (size_t)dv * 128 + dk;
        float sx = 0.f, sy = 0.f;
#pragma unroll 8
        for (int c = 0; c < 64; ++c) {
            const size_t u = (size_t)bh * 64 + c;
            *(uint32_t*)(p.sst + u * 16384 + eoff) = pack2(sx, sy);
            const float2 kvv = *(const float2*)(p.kv + u * 16384 + eoff);
            const float2 dc = *(const float2*)(p.dec + u * 128 + dk);
            sx = dc.x * sx + kvv.x; sy = dc.y * sy + kvv.y;
        }
    }
}

__device__ void ph_h3(const Params& p, char* smem) {
    const int tid = otid(), lane = tid & 63, wid = tid >> 6, wr = wid >> 1, wc = wid & 1, fr = lane & 15, fq = lane >> 4;
    char* sQ = smem;
    char* sK = smem + 16384;
    char* sP = smem + 32768;
    float* sL = (float*)(smem + 32768);
    float* totS = (float*)(smem + 65536);
    const int d = tid & 127, half = tid >> 7;
    for (int u = blockIdx.x; u < 1024; u += gridDim.x) {
        const int bh = u >> 6, c = u & 63, b = bh >> 2, h = bh & 3;
        const size_t row0 = (size_t)b * S + c * 64;
        __syncthreads();
#pragma unroll
        for (int i = 0; i < 4; ++i) {
            const int idx = tid + 256 * i, r = idx >> 4, ch = idx & 15;
            *(u32x4*)(sQ + swz16(r, ch)) = *(const u32x4*)(p.proj + (row0 + r) * INW + OFF_HQ + h * 128 + ch * 8);
        }
#pragma unroll
        for (int i = 0; i < 8; ++i) {
            const int idx = tid + 256 * i, r = idx >> 5, c4 = idx & 31;
            *(f32x4*)(sL + r * 128 + c4 * 4) = *(const f32x4*)(p.lgf + (row0 + r) * 512 + h * 128 + c4 * 4);
        }
        __syncthreads();
        const float* lcol = sL + half * 32 * 128 + d;
        float tot = 0.f;
#pragma unroll
        for (int s = 0; s < 32; ++s) tot += lcol[s * 128];
        totS[half * 128 + d] = tot;
        __syncthreads();
        const float t0 = totS[d];
        float run = half ? t0 : 0.f;
#pragma unroll 8
        for (int s = 0; s < 32; ++s) {
            const float lv = lcol[s * 128];
            run += lv;
            const int o = swz16(half * 32 + s, d >> 3) + (d & 7) * 2;
            const float qm = bf2f(*(const bf16_t*)(sQ + o)) * __expf(run - t0);
            const float kh = (1.f - __expf(lv)) * __expf(t0 - run);
            *(bf16_t*)(sQ + o) = f2bf(qm);
            *(bf16_t*)(sK + o) = f2bf(kh);
        }
        __syncthreads();
        {
            f32x4 pa[2][2];
#pragma unroll
            for (int m = 0; m < 2; ++m)
#pragma unroll
                for (int n = 0; n < 2; ++n) pa[m][n] = f32x4{0.f, 0.f, 0.f, 0.f};
#pragma unroll
            for (int ks = 0; ks < 4; ++ks) {
                bf16x8 af[2], bfr[2];
#pragma unroll
                for (int m = 0; m < 2; ++m) af[m] = *(const bf16x8*)(sQ + swz16(wr * 32 + m * 16 + fr, ks * 4 + fq));
#pragma unroll
                for (int n = 0; n < 2; ++n) bfr[n] = *(const bf16x8*)(sK + swz16(wc * 32 + n * 16 + fr, ks * 4 + fq));
#pragma unroll
                for (int m = 0; m < 2; ++m)
#pragma unroll
                    for (int n = 0; n < 2; ++n) pa[m][n] = __builtin_amdgcn_mfma_f32_16x16x32_bf16(af[m], bfr[n], pa[m][n], 0, 0, 0);
            }
#pragma unroll
            for (int m = 0; m < 2; ++m)
#pragma unroll
                for (int n = 0; n < 2; ++n)
#pragma unroll
                    for (int j = 0; j < 4; ++j) {
                        const int t = wr * 32 + m * 16 + fq * 4 + j, s_ = wc * 32 + n * 16 + fr;
                        const float v = (s_ <= t) ? pa[m][n][j] : 0.f;
                        *(bf16_t*)(sP + swz(t, s_ >> 3) + (s_ & 7) * 2) = f2bf(v);
                    }
        }
        __syncthreads();
        f32x4 oa[8];
#pragma unroll
        for (int n = 0; n < 8; ++n) oa[n] = f32x4{0.f, 0.f, 0.f, 0.f};
        const int ch = tid & 7;
#pragma unroll
        for (int sub = 0; sub < 2; ++sub) {
            float sc[8];
#pragma unroll
            for (int j = 0; j < 8; ++j) sc[j] = __expf(totS[sub * 64 + ch * 8 + j]);
#pragma unroll
            for (int i = 0; i < 4; ++i) {
                const int r = (tid + 256 * i) >> 3;
                const u32x4 v = *(const u32x4*)(p.sst + (size_t)u * 16384 + r * 128 + sub * 64 + ch * 8);
                u32x4 w;
                w.x = pack2(__uint_as_float(v.x << 16) * sc[0], __uint_as_float(v.x & 0xffff0000u) * sc[1]);
                w.y = pack2(__uint_as_float(v.y << 16) * sc[2], __uint_as_float(v.y & 0xffff0000u) * sc[3]);
                w.z = pack2(__uint_as_float(v.z << 16) * sc[4], __uint_as_float(v.z & 0xffff0000u) * sc[5]);
                w.w = pack2(__uint_as_float(v.w << 16) * sc[6], __uint_as_float(v.w & 0xffff0000u) * sc[7]);
                *(u32x4*)(sK + swz(r, ch)) = w;
            }
            __syncthreads();
#pragma unroll
            for (int ks = 0; ks < 2; ++ks) {
                const bf16x8 af = *(const bf16x8*)(sQ + swz16(wid * 16 + fr, sub * 8 + ks * 4 + fq));
#pragma unroll
                for (int n = 0; n < 8; ++n) {
                    const bf16x8 bfr = *(const bf16x8*)(sK + swz(n * 16 + fr, ks * 4 + fq));
                    oa[n] = __builtin_amdgcn_mfma_f32_16x16x32_bf16(af, bfr, oa[n], 0, 0, 0);
                }
            }
            __syncthreads();
        }
#pragma unroll
        for (int i = 0; i < 4; ++i) {
            const int idx = tid + 256 * i, r = idx >> 4, c16 = idx & 15;
            *(u32x4*)(sK + swz16(r, c16)) = *(const u32x4*)(p.proj + (row0 + r) * INW + OFF_HI + h * 128 + c16 * 8);
        }
        __syncthreads();
#pragma unroll
        for (int ks = 0; ks < 2; ++ks) {
            const bf16x8 af = *(const bf16x8*)(sP + swz(wid * 16 + fr, ks * 4 + fq));
#pragma unroll
            for (int n = 0; n < 8; ++n) {
                const bf16x8 bfr = tr_frag16(sK, ks, n);
                oa[n] = __builtin_amdgcn_mfma_f32_16x16x32_bf16(af, bfr, oa[n], 0, 0, 0);
            }
        }
        float ss[4] = {0.f, 0.f, 0.f, 0.f};
#pragma unroll
        for (int n = 0; n < 8; ++n)
#pragma unroll
            for (int j = 0; j < 4; ++j) ss[j] += oa[n][j] * oa[n][j];
#pragma unroll
        for (int j = 0; j < 4; ++j) {
            ss[j] += __shfl_xor(ss[j], 1, 64); ss[j] += __shfl_xor(ss[j], 2, 64); ss[j] += __shfl_xor(ss[j], 4, 64); ss[j] += __shfl_xor(ss[j], 8, 64);
        }
#pragma unroll
        for (int j = 0; j < 4; ++j) {
            const size_t row = row0 + wid * 16 + fq * 4 + j;
            const float rstd = rsqrtf(ss[j] * (1.f / 128.f) + RMS_EPS);
#pragma unroll
            for (int n = 0; n < 8; ++n) {
                const int dv = n * 16 + fr;
                const float g = bf2f(p.proj[row * INW + OFF_HG + h * 128 + dv]);
                const float y = oa[n][j] * rstd * p.hg_nw[h * 128 + dv] * (g / (1.f + __expf(-g)));
                p.mixin[row * 768 + h * 128 + dv] = f2bf(y);
            }
        }
    }
}

__device__ void ph_hgrn_naive(const Params& p, char* smem) {
    const int tid = otid();
    float* qs = (float*)smem;
    float* fs = qs + 2048;
    float* ks = fs + 2048;
    float* is = ks + 2048;
    const int el = tid >> 2, dq = tid & 3;
    for (int u = blockIdx.x; u < 32; u += gridDim.x) {
        const int bh = u >> 1, b = bh >> 2, h = bh & 3, eh = u & 1;
        const int e = eh * 64 + el;
        float s[32];
#pragma unroll
        for (int i = 0; i < 32; ++i) s[i] = 0.f;
        for (int t0 = 0; t0 < S; t0 += 16) {
            __syncthreads();
            for (int i = tid; i < 2048; i += NTHREADS) {
                const int tt = i >> 7, d = i & 127;
                const size_t row = (size_t)b * S + t0 + tt;
                const float f = expf(p.lgf[row * 512 + h * 128 + d]);
                fs[i] = f; ks[i] = 1.f - f;
                qs[i] = bf2f(p.proj[row * INW + OFF_HQ + h * 128 + d]);
            }
            for (int i = tid; i < 1024; i += NTHREADS) {
                const int tt = i >> 6, ee = i & 63;
                is[i] = bf2f(p.proj[((size_t)b * S + t0 + tt) * INW + OFF_HI + h * 128 + eh * 64 + ee]);
            }
            __syncthreads();
            for (int tt = 0; tt < 16; ++tt) {
                const float iv = is[tt * 64 + el];
                float o = 0.f;
#pragma unroll
                for (int i = 0; i < 32; ++i) {
                    const int d = tt * 128 + i * 4 + dq;
                    s[i] = fs[d] * s[i] + ks[d] * iv;
                    o += qs[d] * s[i];
                }
                o += __shfl_xor(o, 1, 64);
                o += __shfl_xor(o, 2, 64);
                if (dq == 0) p.oraw[((size_t)b * S + t0 + tt) * 512 + h * 128 + e] = o;
            }
        }
    }
}

__device__ void ph_attn_naive(const Params& p) {
    const int tid = otid();
    for (int u = blockIdx.x; u < 256; u += gridDim.x) {
        const int hh = u & 3, tb = u >> 2;
        const int row = tb * 256 + tid, b = row >> 12, t = row & (S - 1);
        float M = -INFINITY, L = 0.f;
        float O[64];
#pragma unroll
        for (int d = 0; d < 64; ++d) O[d] = 0.f;
        for (int g = 0; g < 3; ++g) {
            const int dil = (g == 0) ? 1 : (g == 1 ? 4 : 16);
            const int col = (g * 4 + hh) * 64;
            float q[64];
            {
                const uint4* qp = (const uint4*)(p.proj + (size_t)row * INW + OFF_AQ + col);
#pragma unroll
                for (int i = 0; i < 8; ++i) {
                    const uint4 w = qp[i];
                    q[i * 8 + 0] = __uint_as_float(w.x << 16) * 0.125f; q[i * 8 + 1] = __uint_as_float(w.x & 0xffff0000u) * 0.125f;
                    q[i * 8 + 2] = __uint_as_float(w.y << 16) * 0.125f; q[i * 8 + 3] = __uint_as_float(w.y & 0xffff0000u) * 0.125f;
                    q[i * 8 + 4] = __uint_as_float(w.z << 16) * 0.125f; q[i * 8 + 5] = __uint_as_float(w.z & 0xffff0000u) * 0.125f;
                    q[i * 8 + 6] = __uint_as_float(w.w << 16) * 0.125f; q[i * 8 + 7] = __uint_as_float(w.w & 0xffff0000u) * 0.125f;
                }
            }
            for (int m = 0; m <= 128; ++m) {
                const int tk = t - m * dil;
                if (tk < 0) break;
                const size_t krow = ((size_t)b * S + tk) * INW;
                const uint4* kp = (const uint4*)(p.proj + krow + OFF_AK + col);
                float sc = p.biasT[(g * 129 + m) * 4 + hh];
#pragma unroll
                for (int i = 0; i < 8; ++i) {
                    const uint4 w = kp[i];
                    sc += q[i * 8 + 0] * __uint_as_float(w.x << 16) + q[i * 8 + 1] * __uint_as_float(w.x & 0xffff0000u)
                        + q[i * 8 + 2] * __uint_as_float(w.y << 16) + q[i * 8 + 3] * __uint_as_float(w.y & 0xffff0000u)
                        + q[i * 8 + 4] * __uint_as_float(w.z << 16) + q[i * 8 + 5] * __uint_as_float(w.z & 0xffff0000u)
                        + q[i * 8 + 6] * __uint_as_float(w.w << 16) + q[i * 8 + 7] * __uint_as_float(w.w & 0xffff0000u);
                }
                float pe;
                if (sc > M) {
                    const float r = __expf(M - sc);
                    L *= r;
#pragma unroll
                    for (int d = 0; d < 64; ++d) O[d] *= r;
                    M = sc; pe = 1.f;
                } else pe = __expf(sc - M);
                L += pe;
                const uint4* vp = (const uint4*)(p.proj + krow + OFF_AV + col);
#pragma unroll
                for (int i = 0; i < 8; ++i) {
                    const uint4 w = vp[i];
                    O[i * 8 + 0] += pe * __uint_as_float(w.x << 16); O[i * 8 + 1] += pe * __uint_as_float(w.x & 0xffff0000u);
                    O[i * 8 + 2] += pe * __uint_as_float(w.y << 16); O[i * 8 + 3] += pe * __uint_as_float(w.y & 0xffff0000u);
                    O[i * 8 + 4] += pe * __uint_as_float(w.z << 16); O[i * 8 + 5] += pe * __uint_as_float(w.z & 0xffff0000u);
                    O[i * 8 + 6] += pe * __uint_as_float(w.w << 16); O[i * 8 + 7] += pe * __uint_as_float(w.w & 0xffff0000u);
                }
            }
        }
        const float inv = 1.f / L;
        uint4* op = (uint4*)(p.mixin + (size_t)row * 768 + 512 + hh * 64);
#pragma unroll
        for (int i = 0; i < 8; ++i) {
            uint4 w;
            w.x = pack2(O[i * 8 + 0] * inv, O[i * 8 + 1] * inv); w.y = pack2(O[i * 8 + 2] * inv, O[i * 8 + 3] * inv);
            w.z = pack2(O[i * 8 + 4] * inv, O[i * 8 + 5] * inv); w.w = pack2(O[i * 8 + 6] * inv, O[i * 8 + 7] * inv);
            op[i] = w;
        }
    }
}

__device__ void ph_hgrn_norm(const Params& p) {
    const int tid = otid(), lane = tid & 63, wid = tid >> 6;
    for (int row = blockIdx.x * 4 + wid; row < T; row += gridDim.x * 4) {
        const int c0 = lane * 8;
        const float4 a = *(const float4*)(p.oraw + (size_t)row * 512 + c0);
        const float4 b = *(const float4*)(p.oraw + (size_t)row * 512 + c0 + 4);
        float o[8] = {a.x, a.y, a.z, a.w, b.x, b.y, b.z, b.w};
        float ss = 0.f;
#pragma unroll
        for (int i = 0; i < 8; ++i) ss += o[i] * o[i];
        ss += __shfl_xor(ss, 1, 64); ss += __shfl_xor(ss, 2, 64); ss += __shfl_xor(ss, 4, 64); ss += __shfl_xor(ss, 8, 64);
        const float r = rsqrtf(ss * (1.f / 128.f) + RMS_EPS);
        const uint4 gw = *(const uint4*)(p.proj + (size_t)row * INW + OFF_HG + c0);
        const float g[8] = {__uint_as_float(gw.x << 16), __uint_as_float(gw.x & 0xffff0000u), __uint_as_float(gw.y << 16), __uint_as_float(gw.y & 0xffff0000u),
                            __uint_as_float(gw.z << 16), __uint_as_float(gw.z & 0xffff0000u), __uint_as_float(gw.w << 16), __uint_as_float(gw.w & 0xffff0000u)};
        float y[8];
#pragma unroll
        for (int i = 0; i < 8; ++i) y[i] = o[i] * r * p.hg_nw[c0 + i] * (g[i] / (1.f + __expf(-g[i])));
        uint4 w;
        w.x = pack2(y[0], y[1]); w.y = pack2(y[2], y[3]); w.z = pack2(y[4], y[5]); w.w = pack2(y[6], y[7]);
        *(uint4*)(p.mixin + (size_t)row * 768 + c0) = w;
    }
}

__device__ void ph_outproj(const Params& p, char* smem) {
    const int tid = otid(), lane = tid & 63, wid = tid >> 6, wr = wid >> 1, wc = wid & 1, fr = lane & 15, fq = lane >> 4;
    for (int u = blockIdx.x; u < (T / 128) * 8; u += gridDim.x) {
        const int mt = u >> 3, nt = u & 7;
        const bf16_t* A = p.mixin + (size_t)mt * 128 * 768;
        const float* W = p.w_out + nt * 128;
        f32x4 acc[4][4];
        gemm_tile(smem, 768, [&](int r) { return A + (size_t)r * 768; }, [&](int n) { return W + n; }, D, acc);
        const int b = (mt * 128) >> 12;
        const float* g1 = p.mod + b * 6144 + 2048;
#pragma unroll
        for (int m = 0; m < 4; ++m)
#pragma unroll
            for (int n = 0; n < 4; ++n) {
                const int col = nt * 128 + wc * 64 + n * 16 + fr;
                const float gg = g1[col];
#pragma unroll
                for (int j = 0; j < 4; ++j) {
                    const size_t row = (size_t)mt * 128 + wr * 64 + m * 16 + fq * 4 + j;
                    p.pre1[row * D + col] = ALPHA * p.x[row * D + col] + gg * acc[m][n][j];
                }
            }
    }
}

__device__ void ph_ln1(const Params& p) {
    const int tid = otid(), lane = tid & 63, wid = tid >> 6;
    for (int row = blockIdx.x * 4 + wid; row < T; row += gridDim.x * 4) {
        const float4* xr = (const float4*)(p.pre1 + (size_t)row * D);
        float4 v[4];
        float s = 0.f;
#pragma unroll
        for (int i = 0; i < 4; ++i) { v[i] = xr[lane + 64 * i]; s += v[i].x + v[i].y + v[i].z + v[i].w; }
        float mean = wave_sum(s) * (1.f / D);
        float q = 0.f;
#pragma unroll
        for (int i = 0; i < 4; ++i) {
            v[i].x -= mean; v[i].y -= mean; v[i].z -= mean; v[i].w -= mean;
            q += v[i].x * v[i].x + v[i].y * v[i].y + v[i].z * v[i].z + v[i].w * v[i].w;
        }
        float rstd = rsqrtf(wave_sum(q) * (1.f / D) + LN_EPS);
        s = 0.f;
#pragma unroll
        for (int i = 0; i < 4; ++i) {
            const int col = (lane + 64 * i) * 4;
            const float4 g4 = *(const float4*)(p.ln1_g + col), b4 = *(const float4*)(p.ln1_b + col);
            v[i].x = v[i].x * rstd * g4.x + b4.x; v[i].y = v[i].y * rstd * g4.y + b4.y;
            v[i].z = v[i].z * rstd * g4.z + b4.z; v[i].w = v[i].w * rstd * g4.w + b4.w;
            *(float4*)(p.x1 + (size_t)row * D + col) = v[i];
            s += v[i].x + v[i].y + v[i].z + v[i].w;
        }
        mean = wave_sum(s) * (1.f / D);
        q = 0.f;
#pragma unroll
        for (int i = 0; i < 4; ++i) {
            v[i].x -= mean; v[i].y -= mean; v[i].z -= mean; v[i].w -= mean;
            q += v[i].x * v[i].x + v[i].y * v[i].y + v[i].z * v[i].z + v[i].w * v[i].w;
        }
        rstd = rsqrtf(wave_sum(q) * (1.f / D) + LN_EPS);
        const int b = row >> 12;
        const float* sh = p.mod + b * 6144 + 3072;
        const float* sc = sh + 1024;
#pragma unroll
        for (int i = 0; i < 4; ++i) {
            const int col = (lane + 64 * i) * 4;
            const float4 s4 = *(const float4*)(sc + col), h4 = *(const float4*)(sh + col);
            float4 y;
            y.x = v[i].x * rstd * (1.f + s4.x) + h4.x; y.y = v[i].y * rstd * (1.f + s4.y) + h4.y;
            y.z = v[i].z * rstd * (1.f + s4.z) + h4.z; y.w = v[i].w * rstd * (1.f + s4.w) + h4.w;
            *(float4*)(p.h2f + (size_t)row * D + col) = y;
            uint2 o;
            o.x = pack2(y.x, y.y); o.y = pack2(y.z, y.w);
            *(uint2*)(p.h2 + (size_t)row * D + col) = o;
        }
    }
}

__device__ void ph_router(const Params& p, char* smem) {
    const int tid = otid();
    float* hs = (float*)smem;
    float* lg = hs + 8192;
    float* bz = lg + 2048;
    float* selw = bz + 2048;
    for (int u = blockIdx.x; u < T / 8; u += gridDim.x) {
        const int t0 = u * 8;
        __syncthreads();
        for (int i = tid; i < 2048; i += NTHREADS) ((float4*)hs)[i] = ((const float4*)(p.h2f + (size_t)t0 * D))[i];
        __syncthreads();
        {
            float acc[8];
#pragma unroll
            for (int tt = 0; tt < 8; ++tt) acc[tt] = 0.f;
            const float* wp = p.w_router + tid;
            for (int k = 0; k < 1024; k += 4) {
                const float w0 = wp[(size_t)k * 256], w1 = wp[(size_t)(k + 1) * 256], w2 = wp[(size_t)(k + 2) * 256], w3 = wp[(size_t)(k + 3) * 256];
#pragma unroll
                for (int tt = 0; tt < 8; ++tt) {
                    const float4 h = *(const float4*)(hs + tt * 1024 + k);
                    acc[tt] += h.x * w0; acc[tt] += h.y * w1; acc[tt] += h.z * w2; acc[tt] += h.w * w3;
                }
            }
#pragma unroll
            for (int tt = 0; tt < 8; ++tt) lg[tt * 256 + tid] = acc[tt];
        }
        __syncthreads();
        if (tid < 8) {
            const int tok = t0 + tid;
            float* l = lg + tid * 256;
            float* z = bz + tid * 256;
            float gs[8];
#pragma unroll
            for (int g = 0; g < 8; ++g) {
                float m1 = -INFINITY, m2 = -INFINITY;
                for (int j = 0; j < 32; ++j) {
                    const int e = g * 32 + j;
                    const float sc = 1.f / (1.f + expf(-l[e]));
                    const float bv = sc + p.router_bias[e];
                    l[e] = sc; z[e] = bv;
                    if (bv > m1) { m2 = m1; m1 = bv; } else if (bv > m2) m2 = bv;
                }
                gs[g] = m1 + m2;
            }
            unsigned gmask = 0u;
#pragma unroll
            for (int r = 0; r < 4; ++r) {
                float best = -INFINITY; int bi = 0;
#pragma unroll
                for (int g = 0; g < 8; ++g) {
                    const bool ok = (((gmask >> g) & 1u) == 0u) && (gs[g] > best);
                    if (ok) { best = gs[g]; bi = g; }
                }
                gmask |= 1u << bi;
            }
            float wsum = 0.f;
            for (int r = 0; r < 8; ++r) {
                float best = -INFINITY; int bi = 0;
                for (int e = 0; e < 256; ++e) {
                    const float v = z[e];
                    if (((gmask >> (e >> 5)) & 1u) && v > best) { best = v; bi = e; }
                }
                z[bi] = -INFINITY;
                const float sc = l[bi];
                selw[tid * 8 + r] = sc;
                wsum += sc;
                p.topi[tok * 8 + r] = bi;
            }
            const float inv = 2.5f / wsum;
            for (int r = 0; r < 8; ++r) {
                p.topw[tok * 8 + r] = selw[tid * 8 + r] * inv;
                const int e = p.topi[tok * 8 + r];
                const int pos = atomicAdd(&p.cnt[e], 1);
                p.list[(size_t)e * T + pos] = tok * 8 + r;
            }
        }
    }
}

struct ExpMap { int* cnt; int* off; int* tile; };
__device__ __forceinline__ ExpMap exp_map(const Params& p, char* smem) {
    ExpMap m;
    m.cnt = (int*)(smem + 32768); m.off = m.cnt + 256; m.tile = m.off + 256;
    const int tid = otid();
    __syncthreads();
    m.cnt[tid] = p.cnt[tid];
    __syncthreads();
    if (tid == 0) {
        int off = 0, tl = 0;
        for (int e = 0; e < NE; ++e) { m.off[e] = off; m.tile[e] = tl; const int c = m.cnt[e]; off += c; tl += (c + 127) >> 7; }
        m.tile[NE] = tl;
    }
    __syncthreads();
    return m;
}
__device__ __forceinline__ int find_expert(const int* tile, int rt) {
    int lo = 0, hi = NE;
    while (hi - lo > 1) { const int mid = (lo + hi) >> 1; if (tile[mid] <= rt) lo = mid; else hi = mid; }
    return lo;
}

__device__ void ph_gateup(const Params& p, char* smem) {
    const int tid = otid(), lane = tid & 63, wid = tid >> 6, wr = wid >> 1, wc = wid & 1, fr = lane & 15, fq = lane >> 4;
    const ExpMap em = exp_map(p, smem);
    const int ntile = em.tile[NE];
    for (int u = blockIdx.x; u < (ntile + T / 128) * 4; u += gridDim.x) {
        const int rt = u >> 2, nt = u & 3, c0 = nt * 64;
        f32x4 acc[4][4];
        if (rt < ntile) {
            const int e = find_expert(em.tile, rt);
            const int r0 = (rt - em.tile[e]) * 128, ne = em.cnt[e];
            const int* lst = p.list + (size_t)e * T;
            const float* Wg = p.w_eg + (size_t)e * D * ED;
            const float* Wu = p.w_eu + (size_t)e * D * ED;
            gemm_tile(smem, D,
                      [&](int r) { const int rr = r0 + r; const int a = lst[rr < ne ? rr : 0]; return p.h2 + (size_t)(a >> 3) * D; },
                      [&](int n) { const int t16 = n >> 4; return ((t16 & 1) ? Wu : Wg) + c0 + 16 * (t16 >> 1) + (n & 15); },
                      ED, acc);
            const size_t gbase = (size_t)em.off[e];
#pragma unroll
            for (int m = 0; m < 4; ++m)
#pragma unroll
                for (int n = 0; n < 4; n += 2) {
                    const int col = c0 + 16 * (2 * wc + (n >> 1)) + fr;
#pragma unroll
                    for (int j = 0; j < 4; ++j) {
                        const int rr = r0 + wr * 64 + m * 16 + fq * 4 + j;
                        if (rr < ne) {
                            const float g = acc[m][n][j], uu = acc[m][n + 1][j];
                            p.gbuf[(gbase + rr) * ED + col] = f2bf(g / (1.f + __expf(-g)) * uu);
                        }
                    }
                }
        } else {
            const int tb = (rt - ntile) * 128;
            const bf16_t* A = p.h2 + (size_t)tb * D;
            gemm_tile(smem, D,
                      [&](int r) { return A + (size_t)r * D; },
                      [&](int n) { const int t16 = n >> 4; return ((t16 & 1) ? p.w_su : p.w_sg) + c0 + 16 * (t16 >> 1) + (n & 15); },
                      ED, acc);
#pragma unroll
            for (int m = 0; m < 4; ++m)
#pragma unroll
                for (int n = 0; n < 4; n += 2) {
                    const int col = c0 + 16 * (2 * wc + (n >> 1)) + fr;
#pragma unroll
                    for (int j = 0; j < 4; ++j) {
                        const int row = tb + wr * 64 + m * 16 + fq * 4 + j;
                        const float g = acc[m][n][j], uu = acc[m][n + 1][j];
                        p.gsh[(size_t)row * ED + col] = f2bf(g / (1.f + __expf(-g)) * uu);
                    }
                }
        }
    }
}

__device__ void ph_down(const Params& p, char* smem) {
    const int tid = otid(), lane = tid & 63, wid = tid >> 6, wr = wid >> 1, wc = wid & 1, fr = lane & 15, fq = lane >> 4;
    const ExpMap em = exp_map(p, smem);
    const int ntile = em.tile[NE];
    for (int u = blockIdx.x; u < (ntile + T / 128) * 8; u += gridDim.x) {
        const int rt = u >> 3, nt = u & 7;
        f32x4 acc[4][4];
        if (rt < ntile) {
            const int e = find_expert(em.tile, rt);
            const int r0 = (rt - em.tile[e]) * 128, ne = em.cnt[e];
            const int* lst = p.list + (size_t)e * T;
            const bf16_t* A = p.gbuf + (size_t)em.off[e] * ED;
            const float* W = p.w_ed + (size_t)e * ED * D + nt * 128;
            gemm_tile(smem, ED,
                      [&](int r) { const int rr = r0 + r; return A + (size_t)(rr < ne ? rr : 0) * ED; },
                      [&](int n) { return W + n; }, D, acc);
#pragma unroll
            for (int m = 0; m < 4; ++m)
#pragma unroll
                for (int j = 0; j < 4; ++j) {
                    const int rr = r0 + wr * 64 + m * 16 + fq * 4 + j;
                    if (rr < ne) {
                        const int a = lst[rr];
                        const float w = p.topw[a];
                        bf16_t* yr = p.ybuf + ((size_t)(a >> 3) * 9 + (a & 7)) * D + nt * 128 + wc * 64 + fr;
#pragma unroll
                        for (int n = 0; n < 4; ++n) yr[n * 16] = f2bf(acc[m][n][j] * w);
                    }
                }
        } else {
            const int tb = (rt - ntile) * 128;
            const bf16_t* A = p.gsh + (size_t)tb * ED;
            const float* W = p.w_sd + nt * 128;
            gemm_tile(smem, ED, [&](int r) { return A + (size_t)r * ED; }, [&](int n) { return W + n; }, D, acc);
#pragma unroll
            for (int m = 0; m < 4; ++m)
#pragma unroll
                for (int j = 0; j < 4; ++j) {
                    const int row = tb + wr * 64 + m * 16 + fq * 4 + j;
                    bf16_t* yr = p.ybuf + ((size_t)row * 9 + 8) * D + nt * 128 + wc * 64 + fr;
#pragma unroll
                    for (int n = 0; n < 4; ++n) yr[n * 16] = f2bf(acc[m][n][j]);
                }
        }
    }
}

__device__ void ph_final(const Params& p) {
    const int tid = otid(), lane = tid & 63, wid = tid >> 6;
    for (int row = blockIdx.x * 4 + wid; row < T; row += gridDim.x * 4) {
        const int b = row >> 12;
        const float* g2 = p.mod + b * 6144 + 5120;
        float4 v[4];
        float s = 0.f;
#pragma unroll
        for (int i = 0; i < 4; ++i) {
            const int col = (lane + 64 * i) * 4;
            float f0 = 0.f, f1 = 0.f, f2 = 0.f, f3 = 0.f;
#pragma unroll
            for (int k = 0; k < 9; ++k) {
                const uint2 w = *(const uint2*)(p.ybuf + ((size_t)row * 9 + k) * D + col);
                f0 += __uint_as_float(w.x << 16); f1 += __uint_as_float(w.x & 0xffff0000u);
                f2 += __uint_as_float(w.y << 16); f3 += __uint_as_float(w.y & 0xffff0000u);
            }
            const float4 xv = *(const float4*)(p.x1 + (size_t)row * D + col);
            const float4 g4 = *(const float4*)(g2 + col);
            v[i].x = ALPHA * xv.x + g4.x * f0; v[i].y = ALPHA * xv.y + g4.y * f1;
            v[i].z = ALPHA * xv.z + g4.z * f2; v[i].w = ALPHA * xv.w + g4.w * f3;
            s += v[i].x + v[i].y + v[i].z + v[i].w;
        }
        const float mean = wave_sum(s) * (1.f / D);
        float q = 0.f;
#pragma unroll
        for (int i = 0; i < 4; ++i) {
            v[i].x -= mean; v[i].y -= mean; v[i].z -= mean; v[i].w -= mean;
            q += v[i].x * v[i].x + v[i].y * v[i].y + v[i].z * v[i].z + v[i].w * v[i].w;
        }
        const float rstd = rsqrtf(wave_sum(q) * (1.f / D) + LN_EPS);
#pragma unroll
        for (int i = 0; i < 4; ++i) {
            const int col = (lane + 64 * i) * 4;
            const float4 g4 = *(const float4*)(p.ln2_g + col), b4 = *(const float4*)(p.ln2_b + col);
            float4 y;
            y.x = v[i].x * rstd * g4.x + b4.x; y.y = v[i].y * rstd * g4.y + b4.y;
            y.z = v[i].z * rstd * g4.z + b4.z; y.w = v[i].w * rstd * g4.w + b4.w;
            *(float4*)(p.out + (size_t)row * D + col) = y;
        }
    }
}

constexpr int LDS_BYTES = 67584;
constexpr int NPHASE = 12;

template <int PH>
__device__ __forceinline__ void run_phase(const Params& p, char* smem) {
    if (PH == 0) ph_mod(p, smem);
    if (PH == 1) ph_ln0(p);
    if (PH == 2) ph_inproj(p, smem);
    if (PH == 3) { ph_h1(p, smem); ph_attn_naive(p); }
    if (PH == 4) ph_h2(p);
    if (PH == 5) ph_h3(p, smem);
    if (PH == 6) ph_outproj(p, smem);
    if (PH == 7) ph_ln1(p);
    if (PH == 8) ph_router(p, smem);
    if (PH == 9) ph_gateup(p, smem);
    if (PH == 10) ph_down(p, smem);
    if (PH == 11) ph_final(p);
}

template <int PH>
__global__ void __launch_bounds__(NTHREADS, 2) k_phase(Params p) {
    extern __shared__ __attribute__((aligned(16))) char smem[];
    run_phase<PH>(p, smem);
}

__global__ void __launch_bounds__(NTHREADS, 2) k_all(Params p) {
    extern __shared__ __attribute__((aligned(16))) char smem[];
    volatile LAS unsigned* st = (volatile LAS unsigned*)(smem + LDS_BYTES - 16);
    if (threadIdx.x == 0) { st[0] = 0u; st[1] = 0u; st[2] = 0u; st[3] = 0u; }
    __syncthreads();
    XcdBarrier bar = xcd_barrier_post(p.bar, st);
    run_phase<0>(p, smem); xcd_barrier(bar);
    run_phase<1>(p, smem); xcd_barrier(bar);
    run_phase<2>(p, smem); xcd_barrier(bar);
    run_phase<3>(p, smem); xcd_barrier(bar);
    run_phase<4>(p, smem); xcd_barrier(bar);
    run_phase<5>(p, smem); xcd_barrier(bar);
    run_phase<6>(p, smem); xcd_barrier(bar);
    run_phase<7>(p, smem); xcd_barrier(bar);
    run_phase<8>(p, smem); xcd_barrier(bar);
    run_phase<9>(p, smem); xcd_barrier(bar);
    run_phase<10>(p, smem); xcd_barrier(bar);
    run_phase<11>(p, smem);
}

template <int PH>
static void launch_phase(const Params& p, int grid, hipStream_t stream) {
    hipLaunchKernelGGL(k_phase<PH>, dim3(grid), dim3(NTHREADS), LDS_BYTES, stream, p);
}

extern "C" void kernel_launch(void* const* d_in, const int* in_sizes, int n_in, void* d_out, int out_size, void* d_ws, size_t ws_size,
                              hipStream_t stream) {
    (void)in_sizes; (void)n_in; (void)out_size;
    Params p{};
    const float** pin = (const float**)&p.x;
    for (int i = 0; i < 21; ++i) pin[i] = (const float*)d_in[i];
    p.out = (float*)d_out;
    char* ws = (char*)d_ws;
    size_t off = 0;
    auto carve = [&](size_t bytes) { char* r = ws + off; off += (bytes + 255) & ~(size_t)255; return r; };
    char* ctl = carve(65536);
    p.bar = (unsigned*)ctl;
    p.cnt = (int*)(ctl + 16384);
    p.mod = (float*)carve(4 * 6144 * 4);
    p.lbv = (float*)carve(512 * 4);
    p.biasT = (float*)carve(3 * 129 * 4 * 4);
    p.h1 = (bf16_t*)carve((size_t)T * D * 2);
    p.proj = (bf16_t*)carve((size_t)T * INW * 2);
    p.lgf = (float*)carve((size_t)T * 512 * 4);
    p.oraw = (float*)carve((size_t)T * 512 * 4);
    p.mixin = (bf16_t*)carve((size_t)T * 768 * 2);
    p.pre1 = (float*)carve((size_t)T * D * 4);
    p.x1 = (float*)carve((size_t)T * D * 4);
    p.h2 = (bf16_t*)carve((size_t)T * D * 2);
    p.h2f = (float*)carve((size_t)T * D * 4);
    p.topi = (int*)carve((size_t)T * 8 * 4);
    p.topw = (float*)carve((size_t)T * 8 * 4);
    p.list = (int*)carve((size_t)NE * T * 4);
    p.gbuf = (bf16_t*)carve((size_t)T * TOPK * ED * 2);
    p.gsh = (bf16_t*)carve((size_t)T * ED * 2);
    p.ybuf = (bf16_t*)carve((size_t)T * 9 * D * 2);
    p.kv = (float*)p.ybuf;
    p.sst = (bf16_t*)((char*)p.ybuf + (size_t)1024 * 16384 * 4);
    p.dec = (float*)carve((size_t)1024 * 128 * 4);
    if (off > ws_size) { fprintf(stderr, "kernel_launch: workspace too small: need %zu have %zu\n", off, ws_size); return; }

    static int grid = 0;
    if (grid == 0) {
        int dev = 0, cus = 0, per_cu = 0;
        hipGetDevice(&dev);
        hipDeviceGetAttribute(&cus, hipDeviceAttributeMultiprocessorCount, dev);
        hipFuncSetAttribute((const void*)k_all, hipFuncAttributeMaxDynamicSharedMemorySize, LDS_BYTES);
        hipOccupancyMaxActiveBlocksPerMultiprocessor(&per_cu, (const void*)k_all, NTHREADS, LDS_BYTES);
        if (per_cu < 1) per_cu = 1;
        grid = cus * (per_cu < 2 ? per_cu : 2);
        fprintf(stderr, "kernel_launch: cus %d per_cu %d grid %d ws need %zu have %zu\n", cus, per_cu, grid, off, ws_size);
    }
    hipMemsetAsync(ctl, 0, 65536, stream);
#if ONE_LAUNCH
    hipLaunchKernelGGL(k_all, dim3(grid), dim3(NTHREADS), LDS_BYTES, stream, p);
#else
    launch_phase<0>(p, grid, stream); launch_phase<1>(p, grid, stream); launch_phase<2>(p, grid, stream); launch_phase<3>(p, grid, stream);
    launch_phase<4>(p, grid, stream); launch_phase<5>(p, grid, stream); launch_phase<6>(p, grid, stream); launch_phase<7>(p, grid, stream);
    launch_phase<8>(p, grid, stream); launch_phase<9>(p, grid, stream); launch_phase<10>(p, grid, stream); launch_phase<11>(p, grid, stream);
#endif
}
```

```cpp
#include <hip/hip_runtime.h>
#include <stdint.h>
#include <stdio.h>

#ifndef ONE_LAUNCH
#define ONE_LAUNCH 1
#endif

constexpr int D = 1024, NBATCH = 4, S = 4096, T = NBATCH * S;
constexpr int INW = 4352;
constexpr int NE = 256, TOPK = 8, ED = 256;
constexpr int OFF_HQ = 0, OFF_HF = 512, OFF_HI = 1024, OFF_HG = 1536, OFF_AQ = 2048, OFF_AK = 2816, OFF_AV = 3584;
constexpr float ALPHA = 1.189207115002721f;
constexpr float LN_EPS = 1e-5f, RMS_EPS = 1e-6f;
constexpr int NTHREADS = 256;

typedef unsigned short bf16_t;
using bf16x8 = __attribute__((ext_vector_type(8))) short;
using f32x4 = __attribute__((ext_vector_type(4))) float;
using u32x4 = __attribute__((ext_vector_type(4))) unsigned int;

typedef float v2f_t __attribute__((ext_vector_type(2)));
typedef __bf16 v2bf_t __attribute__((ext_vector_type(2)));
typedef short v4s __attribute__((ext_vector_type(4)));
__device__ __forceinline__ unsigned short f2bf(float f) { return __builtin_bit_cast(unsigned short, (__bf16)f); }
__device__ __forceinline__ float bf2f(unsigned short h) { return __uint_as_float(((uint32_t)h) << 16); }
__device__ __forceinline__ uint32_t pack2(float a, float b) {
    const v2f_t f = {a, b};
    return __builtin_bit_cast(uint32_t, __builtin_convertvector(f, v2bf_t));
}
__device__ __forceinline__ float sigmoidf_(float v) { return 1.f / (1.f + __expf(-v)); }

__device__ __forceinline__ int otid() { int t = threadIdx.x; asm volatile("" : "+v"(t)); return t; }

struct Params {
    const float *x, *c, *w_ada, *b_ada, *w_in, *hg_lb, *hg_nw, *rel_bias, *w_out, *ln1_g, *ln1_b, *w_router, *router_bias,
        *w_eg, *w_eu, *w_ed, *w_sg, *w_su, *w_sd, *ln2_g, *ln2_b;
    float* out;
    unsigned* bar;
    int* cnt;
    float* mod;
    float* lbv;
    float* biasT;
    bf16_t* h1;
    bf16_t* proj;
    float* lgf;
    float* ao;
    float* alse;
    bf16_t* mixin;
    float* pre1;
    float* x1;
    bf16_t* h2;
    float* h2f;
    int* topi;
    float* topw;
    int* list;
    bf16_t* gbuf;
    bf16_t* gsh;
    bf16_t* ybuf;
    float* kv;
    float* dec;
    bf16_t* sst;
};

#define XB_TMO      128
#define XB_XCNT(j)  (256  + 64 * (j))
#define XB_XSUB(j)  (1280 + 64 * (j))
#define XB_XGEN(j)  (2304 + 64 * (j))
#define XB_TOP      3328
#define XB_TOPGEN   3392
#define XCD_BAR_WORDS 3456
#define XB_SPIN_CAP (1u << 18)
#define LAS __attribute__((address_space(3)))

__device__ __forceinline__ unsigned xb_ld(unsigned* p)              { return __hip_atomic_load(p, __ATOMIC_RELAXED, __HIP_MEMORY_SCOPE_AGENT); }
__device__ __forceinline__ unsigned xb_add(unsigned* p, unsigned v) { return __hip_atomic_fetch_add(p, v, __ATOMIC_RELAXED, __HIP_MEMORY_SCOPE_AGENT); }
__device__ __forceinline__ unsigned xb_xcc_id() { return (unsigned)__builtin_amdgcn_s_getreg((3 << 11) | 20) & 0xFu; }
#define XB_SPIN(cond, bar) do { unsigned _sp = 0; while (cond) { __builtin_amdgcn_s_sleep(1); \
    if ((++_sp & 255u) == 0u) { if (xb_ld(&(bar)[XB_TMO])) break; if (_sp > XB_SPIN_CAP) { atomicAdd(&(bar)[XB_TMO], 1u); break; } } } } while (0)

struct XcdBarrier {
    unsigned* bar; unsigned x;
    volatile LAS unsigned* st;
};
__device__ __forceinline__ XcdBarrier xcd_barrier_post(unsigned* bar, volatile LAS unsigned* st) {
    XcdBarrier b; b.bar = bar; b.x = xb_xcc_id(); b.st = st;
    if (threadIdx.x == 0) (void)xb_add(&bar[XB_XCNT(b.x)], 1u);
    return b;
}
__device__ __forceinline__ void xcd_barrier_complete(unsigned* bar, unsigned x, unsigned& nloc, unsigned& nx) {
    const unsigned G = gridDim.x * gridDim.y * gridDim.z;
    unsigned sum, cnt, mine, sp = 0u;
    for (;;) {
        sum = 0u; cnt = 0u; mine = 0u;
#pragma unroll
        for (unsigned j = 0; j < 16; ++j) { const unsigned c = xb_ld(&bar[XB_XCNT(j)]); sum += c; cnt += (c > 0u) ? 1u : 0u; mine = (j == x) ? c : mine; }
        if (sum == G) break;
        __builtin_amdgcn_s_sleep(1);
        if ((++sp & 255u) == 0u) { if (xb_ld(&bar[XB_TMO])) break; if (sp > XB_SPIN_CAP) { atomicAdd(&bar[XB_TMO], 1u); break; } }
    }
    nloc = mine > 0u ? mine : 1u; nx = cnt > 0u ? cnt : 1u;
}
__device__ __forceinline__ void xcd_barrier(const XcdBarrier& b) {
    asm volatile("s_waitcnt vmcnt(0)" ::: "memory");
    __syncthreads();
    if (threadIdx.x == 0) {
        unsigned* bar = b.bar;
        __builtin_amdgcn_s_waitcnt(0);
        unsigned nloc = b.st[0], nx = b.st[1];
        if (nloc == 0u) { xcd_barrier_complete(bar, b.x, nloc, nx); b.st[0] = nloc; b.st[1] = nx; }
        const unsigned old = xb_add(&bar[XB_XSUB(b.x)], 1u);
        const unsigned gen = old / nloc;
        if (old + 1u == (gen + 1u) * nloc) {
            __builtin_amdgcn_fence(__ATOMIC_RELEASE, "agent");
            asm volatile("s_waitcnt vmcnt(0)" ::: "memory");
            const unsigned og = xb_add(&bar[XB_TOP], 1u);
            const unsigned tg = og / nx;
            if (og + 1u == (tg + 1u) * nx) xb_add(&bar[XB_TOPGEN], 1u);
            else XB_SPIN(xb_ld(&bar[XB_TOPGEN]) == tg, bar);
            __builtin_amdgcn_fence(__ATOMIC_ACQUIRE, "agent");
            xb_add(&bar[XB_XGEN(b.x)], 1u);
            asm volatile("s_waitcnt vmcnt(0)" ::: "memory");
        } else {
            XB_SPIN(xb_ld(&bar[XB_XGEN(b.x)]) == gen, bar);
            __builtin_amdgcn_fence(__ATOMIC_ACQUIRE, "agent");
            asm volatile("s_waitcnt vmcnt(0)" ::: "memory");
        }
    }
    __syncthreads();
}

constexpr int BK = 64;
__device__ __forceinline__ int swz(int row, int chunk) { return row * 128 + ((chunk ^ ((row >> 1) & 7)) << 4); }

template <class AF, class BF>
__device__ __forceinline__ void gemm_tile(char* smem, const int K, AF arow, BF bcol, const int ldb, f32x4 (&acc)[4][4]) {
    const int tid = otid(), lane = tid & 63, wid = tid >> 6, wr = wid >> 1, wc = wid & 1, fr = lane & 15, fq = lane >> 4;
    char* sA = smem;
    char* sB = smem + 16384;
    const bf16_t* ap[4];
#pragma unroll
    for (int i = 0; i < 4; ++i) ap[i] = arow((tid >> 3) + 32 * i) + (tid & 7) * 8;
    const int nq = tid & 31, kg = tid >> 5;
    const float* bp = bcol(nq * 4) + (size_t)(kg * 8) * ldb;
#pragma unroll
    for (int m = 0; m < 4; ++m)
#pragma unroll
        for (int n = 0; n < 4; ++n) acc[m][n] = f32x4{0.f, 0.f, 0.f, 0.f};
    u32x4 ra[4];
    f32x4 rb[8];
#pragma unroll
    for (int i = 0; i < 4; ++i) ra[i] = *(const u32x4*)(ap[i]);
#pragma unroll
    for (int j = 0; j < 8; ++j) rb[j] = *(const f32x4*)(bp + (size_t)j * ldb);
    for (int k0 = 0; k0 < K; k0 += BK) {
        __syncthreads();
#pragma unroll
        for (int i = 0; i < 4; ++i) *(u32x4*)(sA + swz((tid >> 3) + 32 * i, tid & 7)) = ra[i];
        {
            u32x4 v;
            v.x = pack2(rb[0].x, rb[1].x); v.y = pack2(rb[2].x, rb[3].x); v.z = pack2(rb[4].x, rb[5].x); v.w = pack2(rb[6].x, rb[7].x);
            *(u32x4*)(sB + swz(nq * 4 + 0, kg)) = v;
            v.x = pack2(rb[0].y, rb[1].y); v.y = pack2(rb[2].y, rb[3].y); v.z = pack2(rb[4].y, rb[5].y); v.w = pack2(rb[6].y, rb[7].y);
            *(u32x4*)(sB + swz(nq * 4 + 1, kg)) = v;
            v.x = pack2(rb[0].z, rb[1].z); v.y = pack2(rb[2].z, rb[3].z); v.z = pack2(rb[4].z, rb[5].z); v.w = pack2(rb[6].z, rb[7].z);
            *(u32x4*)(sB + swz(nq * 4 + 2, kg)) = v;
            v.x = pack2(rb[0].w, rb[1].w); v.y = pack2(rb[2].w, rb[3].w); v.z = pack2(rb[4].w, rb[5].w); v.w = pack2(rb[6].w, rb[7].w);
            *(u32x4*)(sB + swz(nq * 4 + 3, kg)) = v;
        }
        __syncthreads();
        if (k0 + BK < K) {
#pragma unroll
            for (int i = 0; i < 4; ++i) ra[i] = *(const u32x4*)(ap[i] + k0 + BK);
#pragma unroll
            for (int j = 0; j < 8; ++j) rb[j] = *(const f32x4*)(bp + (size_t)(k0 + BK + j) * ldb);
        }
#pragma unroll
        for (int ks = 0; ks < 2; ++ks) {
            bf16x8 af[4], bfr[4];
#pragma unroll
            for (int m = 0; m < 4; ++m) af[m] = *(const bf16x8*)(sA + swz(wr * 64 + m * 16 + fr, ks * 4 + fq));
#pragma unroll
            for (int n = 0; n < 4; ++n) bfr[n] = *(const bf16x8*)(sB + swz(wc * 64 + n * 16 + fr, ks * 4 + fq));
#pragma unroll
            for (int m = 0; m < 4; ++m)
#pragma unroll
                for (int n = 0; n < 4; ++n) acc[m][n] = __builtin_amdgcn_mfma_f32_16x16x32_bf16(af[m], bfr[n], acc[m][n], 0, 0, 0);
        }
    }
}

__device__ __forceinline__ float wave_sum(float v) {
#pragma unroll
    for (int o = 32; o > 0; o >>= 1) v += __shfl_xor(v, o, 64);
    return v;
}

__device__ __forceinline__ int t5_bucket(int n) {
    if (n < 16) return n;
    const float v = logf((float)n / 16.f) / logf(128.f) * 16.f;
    int large = 16 + (int)v;
    return large < 31 ? large : 31;
}

__device__ void ph_mod(const Params& p, char* smem) {
    const int tid = otid();
    float* cond = (float*)smem;
    float* red = cond + 4096;
    for (int i = tid; i < 4096; i += NTHREADS) { const float v = p.c[i]; cond[i] = v / (1.f + __expf(-v)); }
    __syncthreads();
    const int NU = 192;
    for (int u = blockIdx.x; u < NU + 2; u += gridDim.x) {
        if (u < NU) {
            const int cl = tid & 31, kq = tid >> 5, n = u * 32 + cl;
            float a0 = 0.f, a1 = 0.f, a2 = 0.f, a3 = 0.f;
            for (int k = kq; k < 1024; k += 8) {
                const float w = p.w_ada[(size_t)k * 6144 + n];
                a0 += cond[k] * w; a1 += cond[1024 + k] * w; a2 += cond[2048 + k] * w; a3 += cond[3072 + k] * w;
            }
            __syncthreads();
            red[(kq * 4 + 0) * 32 + cl] = a0; red[(kq * 4 + 1) * 32 + cl] = a1; red[(kq * 4 + 2) * 32 + cl] = a2; red[(kq * 4 + 3) * 32 + cl] = a3;
            __syncthreads();
            if (tid < 128) {
                const int b = tid >> 5, c2 = tid & 31;
                float s = 0.f;
                for (int q = 0; q < 8; ++q) s += red[(q * 4 + b) * 32 + c2];
                p.mod[b * 6144 + u * 32 + c2] = s + p.b_ada[u * 32 + c2];
            }
        } else if (u == NU) {
            for (int j = tid; j < 512; j += NTHREADS) {
                const float a = p.hg_lb[j], b = p.hg_lb[512 + j];
                const float m = fmaxf(a, b);
                const float ea = expf(a - m), eb = expf(b - m);
                p.lbv[j] = ea / (ea + eb);
            }
        } else {
            for (int i = tid; i < 3 * 129 * 4; i += NTHREADS) {
                const int g = i / (129 * 4), m = (i >> 2) % 129, hh = i & 3;
                const int dil = (g == 0) ? 1 : (g == 1 ? 4 : 16);
                p.biasT[i] = p.rel_bias[t5_bucket(m * dil) * 12 + g * 4 + hh];
            }
        }
    }
}

__device__ void ph_ln0(const Params& p) {
    const int tid = otid(), lane = tid & 63, wid = tid >> 6;
    for (int row = blockIdx.x * 4 + wid; row < T; row += gridDim.x * 4) {
        const float4* xr = (const float4*)(p.x + (size_t)row * D);
        float4 v[4];
        float s = 0.f;
#pragma unroll
        for (int i = 0; i < 4; ++i) { v[i] = xr[lane + 64 * i]; s += v[i].x + v[i].y + v[i].z + v[i].w; }
        const float mean = wave_sum(s) * (1.f / D);
        float q = 0.f;
#pragma unroll
        for (int i = 0; i < 4; ++i) {
            v[i].x -= mean; v[i].y -= mean; v[i].z -= mean; v[i].w -= mean;
            q += v[i].x * v[i].x + v[i].y * v[i].y + v[i].z * v[i].z + v[i].w * v[i].w;
        }
        const float rstd = rsqrtf(wave_sum(q) * (1.f / D) + LN_EPS);
        const int b = row >> 12;
        const float* sh = p.mod + b * 6144;
        const float* sc = sh + 1024;
#pragma unroll
        for (int i = 0; i < 4; ++i) {
            const int col = (lane + 64 * i) * 4;
            const float4 s4 = *(const float4*)(sc + col), h4 = *(const float4*)(sh + col);
            uint2 o;
            o.x = pack2(v[i].x * rstd * (1.f + s4.x) + h4.x, v[i].y * rstd * (1.f + s4.y) + h4.y);
            o.y = pack2(v[i].z * rstd * (1.f + s4.z) + h4.z, v[i].w * rstd * (1.f + s4.w) + h4.w);
            *(uint2*)(p.h1 + (size_t)row * D + col) = o;
        }
    }
}

__device__ void ph_inproj(const Params& p, char* smem) {
    const int tid = otid(), lane = tid & 63, wid = tid >> 6, wr = wid >> 1, wc = wid & 1, fr = lane & 15, fq = lane >> 4;
    const int NT = INW / 128;
    for (int u = blockIdx.x; u < (T / 128) * NT; u += gridDim.x) {
        const int mt = u / NT, nt = u % NT;
        const bf16_t* A = p.h1 + (size_t)mt * 128 * D;
        const float* W = p.w_in + nt * 128;
        f32x4 acc[4][4];
        gemm_tile(smem, D, [&](int r) { return A + (size_t)r * D; }, [&](int n) { return W + n; }, INW, acc);
        if (nt >= 4 && nt < 8) {
#pragma unroll
            for (int m = 0; m < 4; ++m)
#pragma unroll
                for (int n = 0; n < 4; ++n) {
                    const int c = nt * 128 - OFF_HF + wc * 64 + n * 16 + fr;
                    const float lb = p.lbv[c];
#pragma unroll
                    for (int j = 0; j < 4; ++j) {
                        const int row = mt * 128 + wr * 64 + m * 16 + fq * 4 + j;
                        const float f = lb + (1.f - lb) * (1.f / (1.f + expf(-acc[m][n][j])));
                        p.lgf[(size_t)row * 512 + c] = logf(f);
                    }
                }
        } else {
#pragma unroll
            for (int m = 0; m < 4; ++m)
#pragma unroll
                for (int n = 0; n < 4; ++n)
#pragma unroll
                    for (int j = 0; j < 4; ++j) {
                        const int row = mt * 128 + wr * 64 + m * 16 + fq * 4 + j;
                        p.proj[(size_t)row * INW + nt * 128 + wc * 64 + n * 16 + fr] = f2bf(acc[m][n][j]);
                    }
        }
    }
}


__device__ __forceinline__ int swz16(int row, int chunk) { return row * 256 + ((chunk ^ (row & 15)) << 4); }
__device__ __forceinline__ bf16x8 tr_frag16(const char* tile, int ks, int c) {
    const int lane = otid() & 63, g = lane >> 4, q = (lane & 15) >> 2, pp = lane & 3;
    const int r0 = 32 * ks + 8 * g + q, ch = 2 * c + (pp >> 1), bo = 8 * (pp & 1);
    const v4s lo = __builtin_amdgcn_ds_read_tr16_b64_v4i16((LAS v4s*)(tile + swz16(r0, ch) + bo));
    const v4s hi = __builtin_amdgcn_ds_read_tr16_b64_v4i16((LAS v4s*)(tile + swz16(r0 + 4, ch) + bo));
    return bf16x8{lo[0], lo[1], lo[2], lo[3], hi[0], hi[1], hi[2], hi[3]};
}

__device__ void ph_h1(const Params& p, char* smem) {
    const int tid = otid(), lane = tid & 63, wid = tid >> 6, wr = wid >> 1, wc = wid & 1, fr = lane & 15, fq = lane >> 4;
    char* sI = smem;
    char* sK = smem + 16384;
    float* sL = (float*)(smem + 32768);
    float* totS = (float*)(smem + 65536);
    const int d = tid & 127, half = tid >> 7;
    for (int u = blockIdx.x; u < 1024; u += gridDim.x) {
        const int bh = u >> 6, c = u & 63, b = bh >> 2, h = bh & 3;
        const size_t row0 = (size_t)b * S + c * 64;
        __syncthreads();
#pragma unroll
        for (int i = 0; i < 4; ++i) {
            const int idx = tid + 256 * i, r = idx >> 4, ch = idx & 15;
            *(u32x4*)(sI + swz16(r, ch)) = *(const u32x4*)(p.proj + (row0 + r) * INW + OFF_HI + h * 128 + ch * 8);
        }
#pragma unroll
        for (int i = 0; i < 8; ++i) {
            const int idx = tid + 256 * i, r = idx >> 5, c4 = idx & 31;
            *(f32x4*)(sL + r * 128 + c4 * 4) = *(const f32x4*)(p.lgf + (row0 + r) * 512 + h * 128 + c4 * 4);
        }
        __syncthreads();
        const float* lcol = sL + half * 32 * 128 + d;
        float tot = 0.f;
#pragma unroll
        for (int s = 0; s < 32; ++s) tot += lcol[s * 128];
        totS[half * 128 + d] = tot;
        __syncthreads();
        const float t0 = totS[d], bl = t0 + totS[128 + d];
        float run = half ? t0 : 0.f;
#pragma unroll 8
        for (int s = 0; s < 32; ++s) {
            const float lv = lcol[s * 128];
            run += lv;
            const float kt = (1.f - __expf(lv)) * __expf(bl - run);
            *(bf16_t*)(sK + swz16(half * 32 + s, d >> 3) + (d & 7) * 2) = f2bf(kt);
        }
        if (half == 0) p.dec[u * 128 + d] = __expf(bl);
        __syncthreads();
        f32x4 acc[4][4];
#pragma unroll
        for (int m = 0; m < 4; ++m)
#pragma unroll
            for (int n = 0; n < 4; ++n) acc[m][n] = f32x4{0.f, 0.f, 0.f, 0.f};
#pragma unroll
        for (int ks = 0; ks < 2; ++ks) {
            bf16x8 af[4], bfr[4];
#pragma unroll
            for (int m = 0; m < 4; ++m) af[m] = tr_frag16(sI, ks, wr * 4 + m);
#pragma unroll
            for (int n = 0; n < 4; ++n) bfr[n] = tr_frag16(sK, ks, wc * 4 + n);
#pragma unroll
            for (int m = 0; m < 4; ++m)
#pragma unroll
                for (int n = 0; n < 4; ++n) acc[m][n] = __builtin_amdgcn_mfma_f32_16x16x32_bf16(af[m], bfr[n], acc[m][n], 0, 0, 0);
        }
        float* kvu = p.kv + (size_t)u * 16384;
#pragma unroll
        for (int m = 0; m < 4; ++m)
#pragma unroll
            for (int n = 0; n < 4; ++n)
#pragma unroll
                for (int j = 0; j < 4; ++j) kvu[(wr * 64 + m * 16 + fq * 4 + j) * 128 + wc * 64 + n * 16 + fr] = acc[m][n][j];
    }
}

__device__ void ph_h2(const Params& p) {
    for (int it = blockIdx.x * NTHREADS + otid(); it < 16 * 8192; it += gridDim.x * NTHREADS) {
        const int bh = it >> 13, e2 = it & 8191, dv = e2 >> 6, dk = (e2 & 63) * 2;
        const size_t eoff = (size_t)dv * 128 + dk;
        float sx = 0.f, sy = 0.f;
#pragma unroll 8
        for (int c = 0; c < 64; ++c) {
            const size_t u = (size_t)bh * 64 + c;
            *(uint32_t*)(p.sst + u * 16384 + eoff) = pack2(sx, sy);
            const float2 kvv = *(const float2*)(p.kv + u * 16384 + eoff);
            const float2 dc = *(const float2*)(p.dec + u * 128 + dk);
            sx = dc.x * sx + kvv.x; sy = dc.y * sy + kvv.y;
        }
    }
}

__device__ void ph_h3(const Params& p, char* smem) {
    const int tid = otid(), lane = tid & 63, wid = tid >> 6, wr = wid >> 1, wc = wid & 1, fr = lane & 15, fq = lane >> 4;
    char* sQ = smem;
    char* sK = smem + 16384;
    char* sP = smem + 32768;
    float* sL = (float*)(smem + 32768);
    float* totS = (float*)(smem + 65536);
    const int d = tid & 127, half = tid >> 7;
    for (int u = blockIdx.x; u < 1024; u += gridDim.x) {
        const int bh = u >> 6, c = u & 63, b = bh >> 2, h = bh & 3;
        const size_t row0 = (size_t)b * S + c * 64;
        __syncthreads();
#pragma unroll
        for (int i = 0; i < 4; ++i) {
            const int idx = tid + 256 * i, r = idx >> 4, ch = idx & 15;
            *(u32x4*)(sQ + swz16(r, ch)) = *(const u32x4*)(p.proj + (row0 + r) * INW + OFF_HQ + h * 128 + ch * 8);
        }
#pragma unroll
        for (int i = 0; i < 8; ++i) {
            const int idx = tid + 256 * i, r = idx >> 5, c4 = idx & 31;
            *(f32x4*)(sL + r * 128 + c4 * 4) = *(const f32x4*)(p.lgf + (row0 + r) * 512 + h * 128 + c4 * 4);
        }
        __syncthreads();
        const float* lcol = sL + half * 32 * 128 + d;
        float tot = 0.f;
#pragma unroll
        for (int s = 0; s < 32; ++s) tot += lcol[s * 128];
        totS[half * 128 + d] = tot;
        __syncthreads();
        const float t0 = totS[d];
        float run = half ? t0 : 0.f;
#pragma unroll 8
        for (int s = 0; s < 32; ++s) {
            const float lv = lcol[s * 128];
            run += lv;
            const int o = swz16(half * 32 + s, d >> 3) + (d & 7) * 2;
            const float qm = bf2f(*(const bf16_t*)(sQ + o)) * __expf(run - t0);
            const float kh = (1.f - __expf(lv)) * __expf(t0 - run);
            *(bf16_t*)(sQ + o) = f2bf(qm);
            *(bf16_t*)(sK + o) = f2bf(kh);
        }
        __syncthreads();
        {
            f32x4 pa[2][2];
#pragma unroll
            for (int m = 0; m < 2; ++m)
#pragma unroll
                for (int n = 0; n < 2; ++n) pa[m][n] = f32x4{0.f, 0.f, 0.f, 0.f};
#pragma unroll
            for (int ks = 0; ks < 4; ++ks) {
                bf16x8 af[2], bfr[2];
#pragma unroll
                for (int m = 0; m < 2; ++m) af[m] = *(const bf16x8*)(sQ + swz16(wr * 32 + m * 16 + fr, ks * 4 + fq));
#pragma unroll
                for (int n = 0; n < 2; ++n) bfr[n] = *(const bf16x8*)(sK + swz16(wc * 32 + n * 16 + fr, ks * 4 + fq));
#pragma unroll
                for (int m = 0; m < 2; ++m)
#pragma unroll
                    for (int n = 0; n < 2; ++n) pa[m][n] = __builtin_amdgcn_mfma_f32_16x16x32_bf16(af[m], bfr[n], pa[m][n], 0, 0, 0);
            }
#pragma unroll
            for (int m = 0; m < 2; ++m)
#pragma unroll
                for (int n = 0; n < 2; ++n)
#pragma unroll
                    for (int j = 0; j < 4; ++j) {
                        const int t = wr * 32 + m * 16 + fq * 4 + j, s_ = wc * 32 + n * 16 + fr;
                        const float v = (s_ <= t) ? pa[m][n][j] : 0.f;
                        *(bf16_t*)(sP + swz(t, s_ >> 3) + (s_ & 7) * 2) = f2bf(v);
                    }
        }
        __syncthreads();
        f32x4 oa[8];
#pragma unroll
        for (int n = 0; n < 8; ++n) oa[n] = f32x4{0.f, 0.f, 0.f, 0.f};
        const int ch = tid & 7;
#pragma unroll
        for (int sub = 0; sub < 2; ++sub) {
            float sc[8];
#pragma unroll
            for (int j = 0; j < 8; ++j) sc[j] = __expf(totS[sub * 64 + ch * 8 + j]);
#pragma unroll
            for (int i = 0; i < 4; ++i) {
                const int r = (tid + 256 * i) >> 3;
                const u32x4 v = *(const u32x4*)(p.sst + (size_t)u * 16384 + r * 128 + sub * 64 + ch * 8);
                u32x4 w;
                w.x = pack2(__uint_as_float(v.x << 16) * sc[0], __uint_as_float(v.x & 0xffff0000u) * sc[1]);
                w.y = pack2(__uint_as_float(v.y << 16) * sc[2], __uint_as_float(v.y & 0xffff0000u) * sc[3]);
                w.z = pack2(__uint_as_float(v.z << 16) * sc[4], __uint_as_float(v.z & 0xffff0000u) * sc[5]);
                w.w = pack2(__uint_as_float(v.w << 16) * sc[6], __uint_as_float(v.w & 0xffff0000u) * sc[7]);
                *(u32x4*)(sK + swz(r, ch)) = w;
            }
            __syncthreads();
#pragma unroll
            for (int ks = 0; ks < 2; ++ks) {
                const bf16x8 af = *(const bf16x8*)(sQ + swz16(wid * 16 + fr, sub * 8 + ks * 4 + fq));
#pragma unroll
                for (int n = 0; n < 8; ++n) {
                    const bf16x8 bfr = *(const bf16x8*)(sK + swz(n * 16 + fr, ks * 4 + fq));
                    oa[n] = __builtin_amdgcn_mfma_f32_16x16x32_bf16(af, bfr, oa[n], 0, 0, 0);
                }
            }
            __syncthreads();
        }
#pragma unroll
        for (int i = 0; i < 4; ++i) {
            const int idx = tid + 256 * i, r = idx >> 4, c16 = idx & 15;
            *(u32x4*)(sK + swz16(r, c16)) = *(const u32x4*)(p.proj + (row0 + r) * INW + OFF_HI + h * 128 + c16 * 8);
        }
        __syncthreads();
#pragma unroll
        for (int ks = 0; ks < 2; ++ks) {
            const bf16x8 af = *(const bf16x8*)(sP + swz(wid * 16 + fr, ks * 4 + fq));
#pragma unroll
            for (int n = 0; n < 8; ++n) {
                const bf16x8 bfr = tr_frag16(sK, ks, n);
                oa[n] = __builtin_amdgcn_mfma_f32_16x16x32_bf16(af, bfr, oa[n], 0, 0, 0);
            }
        }
        float ss[4] = {0.f, 0.f, 0.f, 0.f};
#pragma unroll
        for (int n = 0; n < 8; ++n)
#pragma unroll
            for (int j = 0; j < 4; ++j) ss[j] += oa[n][j] * oa[n][j];
#pragma unroll
        for (int j = 0; j < 4; ++j) {
            ss[j] += __shfl_xor(ss[j], 1, 64); ss[j] += __shfl_xor(ss[j], 2, 64); ss[j] += __shfl_xor(ss[j], 4, 64); ss[j] += __shfl_xor(ss[j], 8, 64);
        }
#pragma unroll
        for (int j = 0; j < 4; ++j) {
            const size_t row = row0 + wid * 16 + fq * 4 + j;
            const float rstd = rsqrtf(ss[j] * (1.f / 128.f) + RMS_EPS);
#pragma unroll
            for (int n = 0; n < 8; ++n) {
                const int dv = n * 16 + fr;
                const float g = bf2f(p.proj[row * INW + OFF_HG + h * 128 + dv]);
                const float y = oa[n][j] * rstd * p.hg_nw[h * 128 + dv] * (g / (1.f + __expf(-g)));
                p.mixin[row * 768 + h * 128 + dv] = f2bf(y);
            }
        }
    }
}

__device__ __forceinline__ bf16x8 tr_frag8(const char* tile, int ks, int c) {
    const int lane = otid() & 63, g = lane >> 4, q = (lane & 15) >> 2, pp = lane & 3;
    const int r0 = 32 * ks + 8 * g + q, ch = 2 * c + (pp >> 1), bo = 8 * (pp & 1);
    const v4s lo = __builtin_amdgcn_ds_read_tr16_b64_v4i16((LAS v4s*)(tile + swz(r0, ch) + bo));
    const v4s hi = __builtin_amdgcn_ds_read_tr16_b64_v4i16((LAS v4s*)(tile + swz(r0 + 4, ch) + bo));
    return bf16x8{lo[0], lo[1], lo[2], lo[3], hi[0], hi[1], hi[2], hi[3]};
}

__device__ void ph_attn(const Params& p, char* smem) {
    const int tid = otid(), lane = tid & 63, wid = tid >> 6, fr = lane & 15, fq = lane >> 4;
    char* sQ = smem;
    char* sK = smem + 8192;
    char* sP = sK;
    char* sV = smem + 33792;
    float* sBias = (float*)(smem + 58368);
    for (int u = blockIdx.x; u < 3072; u += gridDim.x) {
        const int ti = u & 63, gq = u >> 6, g = gq % 3, bhh = gq / 3, hh = bhh & 3, b = bhh >> 2;
        const int lsh = (g == 0) ? 0 : (g == 1 ? 2 : 4), dl = 1 << lsh;
        const int tpr = (S >> lsh) >> 6;
        const int r = ti / tpr, j0 = (ti % tpr) * 64;
        const bf16_t* base = p.proj + (size_t)b * S * INW + (g * 4 + hh) * 64;
        __syncthreads();
#pragma unroll
        for (int i = 0; i < 2; ++i) {
            const int idx = tid + 256 * i, row = idx >> 3, ch = idx & 7;
            const int tok = (j0 + row) * dl + r;
            *(u32x4*)(sQ + swz(row, ch)) = *(const u32x4*)(base + (size_t)tok * INW + OFF_AQ + ch * 8);
        }
#pragma unroll
        for (int i = 0; i < 6; ++i) {
            const int idx = tid + 256 * i, row = idx >> 3, ch = idx & 7;
            const int j = j0 - 128 + row;
            u32x4 kx = {0u, 0u, 0u, 0u}, vx = {0u, 0u, 0u, 0u};
            if (j >= 0) {
                const size_t o = (size_t)(j * dl + r) * INW + ch * 8;
                kx = *(const u32x4*)(base + o + OFF_AK);
                vx = *(const u32x4*)(base + o + OFF_AV);
            }
            *(u32x4*)(sK + swz(row, ch)) = kx;
            *(u32x4*)(sV + swz(row, ch)) = vx;
        }
        if (tid < 129) sBias[tid] = p.biasT[(g * 129 + tid) * 4 + hh];
        __syncthreads();
        f32x4 sa[12];
#pragma unroll
        for (int n = 0; n < 12; ++n) sa[n] = f32x4{0.f, 0.f, 0.f, 0.f};
#pragma unroll
        for (int ks = 0; ks < 2; ++ks) {
            const bf16x8 af = *(const bf16x8*)(sQ + swz(wid * 16 + fr, ks * 4 + fq));
#pragma unroll
            for (int n = 0; n < 12; ++n) {
                const bf16x8 bfr = *(const bf16x8*)(sK + swz(n * 16 + fr, ks * 4 + fq));
                sa[n] = __builtin_amdgcn_mfma_f32_16x16x32_bf16(af, bfr, sa[n], 0, 0, 0);
            }
        }
        float mx[4] = {-INFINITY, -INFINITY, -INFINITY, -INFINITY};
#pragma unroll
        for (int n = 0; n < 12; ++n)
#pragma unroll
            for (int j = 0; j < 4; ++j) {
                const int jj = wid * 16 + fq * 4 + j, kk = n * 16 + fr, m = jj + 128 - kk;
                const bool valid = (m >= 0) && (m <= 128) && (j0 - 128 + kk >= 0);
                const int mc = m < 0 ? 0 : (m > 128 ? 128 : m);
                const float v = valid ? sa[n][j] * 0.125f + sBias[mc] : -INFINITY;
                sa[n][j] = v;
                mx[j] = fmaxf(mx[j], v);
            }
#pragma unroll
        for (int j = 0; j < 4; ++j) {
            mx[j] = fmaxf(mx[j], __shfl_xor(mx[j], 1, 64)); mx[j] = fmaxf(mx[j], __shfl_xor(mx[j], 2, 64));
            mx[j] = fmaxf(mx[j], __shfl_xor(mx[j], 4, 64)); mx[j] = fmaxf(mx[j], __shfl_xor(mx[j], 8, 64));
        }
        float ls[4] = {0.f, 0.f, 0.f, 0.f};
#pragma unroll
        for (int n = 0; n < 12; ++n)
#pragma unroll
            for (int j = 0; j < 4; ++j) { const float pe = __expf(sa[n][j] - mx[j]); sa[n][j] = pe; ls[j] += pe; }
#pragma unroll
        for (int j = 0; j < 4; ++j) {
            ls[j] += __shfl_xor(ls[j], 1, 64); ls[j] += __shfl_xor(ls[j], 2, 64); ls[j] += __shfl_xor(ls[j], 4, 64); ls[j] += __shfl_xor(ls[j], 8, 64);
        }
        __syncthreads();
#pragma unroll
        for (int n = 0; n < 12; ++n)
#pragma unroll
            for (int j = 0; j < 4; ++j) *(bf16_t*)(sP + (wid * 16 + fq * 4 + j) * 400 + (n * 16 + fr) * 2) = f2bf(sa[n][j]);
        f32x4 oa[4];
#pragma unroll
        for (int n = 0; n < 4; ++n) oa[n] = f32x4{0.f, 0.f, 0.f, 0.f};
#pragma unroll
        for (int ks = 0; ks < 6; ++ks) {
            const bf16x8 af = *(const bf16x8*)(sP + (wid * 16 + fr) * 400 + (ks * 4 + fq) * 16);
#pragma unroll
            for (int n = 0; n < 4; ++n) {
                const bf16x8 bfr = tr_frag8(sV, ks, n);
                oa[n] = __builtin_amdgcn_mfma_f32_16x16x32_bf16(af, bfr, oa[n], 0, 0, 0);
            }
        }
#pragma unroll
        for (int j = 0; j < 4; ++j) {
            const int jj = wid * 16 + fq * 4 + j;
            const size_t row = (size_t)g * T + (size_t)b * S + (j0 + jj) * dl + r;
            const float inv = 1.f / ls[j];
#pragma unroll
            for (int n = 0; n < 4; ++n) p.ao[row * 256 + hh * 64 + n * 16 + fr] = oa[n][j] * inv;
            if (fr == 0) p.alse[row * 4 + hh] = mx[j] + __logf(ls[j]);
        }
    }
}

__device__ void ph_attn_merge(const Params& p) {
    const int tid = otid(), lane = tid & 63, wid = tid >> 6;
    for (int row = blockIdx.x * 4 + wid; row < T; row += gridDim.x * 4) {
        const int hh = lane >> 4;
        const float l0 = p.alse[((size_t)0 * T + row) * 4 + hh], l1 = p.alse[((size_t)1 * T + row) * 4 + hh], l2 = p.alse[((size_t)2 * T + row) * 4 + hh];
        const float mxl = fmaxf(l0, fmaxf(l1, l2));
        float e0 = __expf(l0 - mxl), e1 = __expf(l1 - mxl), e2 = __expf(l2 - mxl);
        const float inv = 1.f / (e0 + e1 + e2);
        e0 *= inv; e1 *= inv; e2 *= inv;
        const f32x4 a0 = *(const f32x4*)(p.ao + ((size_t)0 * T + row) * 256 + lane * 4);
        const f32x4 a1 = *(const f32x4*)(p.ao + ((size_t)1 * T + row) * 256 + lane * 4);
        const f32x4 a2 = *(const f32x4*)(p.ao + ((size_t)2 * T + row) * 256 + lane * 4);
        uint2 o;
        o.x = pack2(a0[0] * e0 + a1[0] * e1 + a2[0] * e2, a0[1] * e0 + a1[1] * e1 + a2[1] * e2);
        o.y = pack2(a0[2] * e0 + a1[2] * e1 + a2[2] * e2, a0[3] * e0 + a1[3] * e1 + a2[3] * e2);
        *(uint2*)(p.mixin + (size_t)row * 768 + 512 + lane * 4) = o;
    }
}

__device__ void ph_outproj(const Params& p, char* smem) {
    const int tid = otid(), lane = tid & 63, wid = tid >> 6, wr = wid >> 1, wc = wid & 1, fr = lane & 15, fq = lane >> 4;
    for (int u = blockIdx.x; u < (T / 128) * 8; u += gridDim.x) {
        const int mt = u >> 3, nt = u & 7;
        const bf16_t* A = p.mixin + (size_t)mt * 128 * 768;
        const float* W = p.w_out + nt * 128;
        f32x4 acc[4][4];
        gemm_tile(smem, 768, [&](int r) { return A + (size_t)r * 768; }, [&](int n) { return W + n; }, D, acc);
        const int b = (mt * 128) >> 12;
        const float* g1 = p.mod + b * 6144 + 2048;
#pragma unroll
        for (int m = 0; m < 4; ++m)
#pragma unroll
            for (int n = 0; n < 4; ++n) {
                const int col = nt * 128 + wc * 64 + n * 16 + fr;
                const float gg = g1[col];
#pragma unroll
                for (int j = 0; j < 4; ++j) {
                    const size_t row = (size_t)mt * 128 + wr * 64 + m * 16 + fq * 4 + j;
                    p.pre1[row * D + col] = ALPHA * p.x[row * D + col] + gg * acc[m][n][j];
                }
            }
    }
}

__device__ void ph_ln1(const Params& p) {
    const int tid = otid(), lane = tid & 63, wid = tid >> 6;
    for (int row = blockIdx.x * 4 + wid; row < T; row += gridDim.x * 4) {
        const float4* xr = (const float4*)(p.pre1 + (size_t)row * D);
        float4 v[4];
        float s = 0.f;
#pragma unroll
        for (int i = 0; i < 4; ++i) { v[i] = xr[lane + 64 * i]; s += v[i].x + v[i].y + v[i].z + v[i].w; }
        float mean = wave_sum(s) * (1.f / D);
        float q = 0.f;
#pragma unroll
        for (int i = 0; i < 4; ++i) {
            v[i].x -= mean; v[i].y -= mean; v[i].z -= mean; v[i].w -= mean;
            q += v[i].x * v[i].x + v[i].y * v[i].y + v[i].z * v[i].z + v[i].w * v[i].w;
        }
        float rstd = rsqrtf(wave_sum(q) * (1.f / D) + LN_EPS);
        s = 0.f;
#pragma unroll
        for (int i = 0; i < 4; ++i) {
            const int col = (lane + 64 * i) * 4;
            const float4 g4 = *(const float4*)(p.ln1_g + col), b4 = *(const float4*)(p.ln1_b + col);
            v[i].x = v[i].x * rstd * g4.x + b4.x; v[i].y = v[i].y * rstd * g4.y + b4.y;
            v[i].z = v[i].z * rstd * g4.z + b4.z; v[i].w = v[i].w * rstd * g4.w + b4.w;
            *(float4*)(p.x1 + (size_t)row * D + col) = v[i];
            s += v[i].x + v[i].y + v[i].z + v[i].w;
        }
        mean = wave_sum(s) * (1.f / D);
        q = 0.f;
#pragma unroll
        for (int i = 0; i < 4; ++i) {
            v[i].x -= mean; v[i].y -= mean; v[i].z -= mean; v[i].w -= mean;
            q += v[i].x * v[i].x + v[i].y * v[i].y + v[i].z * v[i].z + v[i].w * v[i].w;
        }
        rstd = rsqrtf(wave_sum(q) * (1.f / D) + LN_EPS);
        const int b = row >> 12;
        const float* sh = p.mod + b * 6144 + 3072;
        const float* sc = sh + 1024;
#pragma unroll
        for (int i = 0; i < 4; ++i) {
            const int col = (lane + 64 * i) * 4;
            const float4 s4 = *(const float4*)(sc + col), h4 = *(const float4*)(sh + col);
            float4 y;
            y.x = v[i].x * rstd * (1.f + s4.x) + h4.x; y.y = v[i].y * rstd * (1.f + s4.y) + h4.y;
            y.z = v[i].z * rstd * (1.f + s4.z) + h4.z; y.w = v[i].w * rstd * (1.f + s4.w) + h4.w;
            *(float4*)(p.h2f + (size_t)row * D + col) = y;
            uint2 o;
            o.x = pack2(y.x, y.y); o.y = pack2(y.z, y.w);
            *(uint2*)(p.h2 + (size_t)row * D + col) = o;
        }
    }
}

__device__ void ph_router(const Params& p, char* smem) {
    const int tid = otid();
    float* hs = (float*)smem;
    float* lg = hs + 8192;
    float* bz = lg + 2048;
    float* selw = bz + 2048;
    for (int u = blockIdx.x; u < T / 8; u += gridDim.x) {
        const int t0 = u * 8;
        __syncthreads();
        for (int i = tid; i < 2048; i += NTHREADS) ((float4*)hs)[i] = ((const float4*)(p.h2f + (size_t)t0 * D))[i];
        __syncthreads();
        {
            float acc[8];
#pragma unroll
            for (int tt = 0; tt < 8; ++tt) acc[tt] = 0.f;
            const float* wp = p.w_router + tid;
            for (int k = 0; k < 1024; k += 4) {
                const float w0 = wp[(size_t)k * 256], w1 = wp[(size_t)(k + 1) * 256], w2 = wp[(size_t)(k + 2) * 256], w3 = wp[(size_t)(k + 3) * 256];
#pragma unroll
                for (int tt = 0; tt < 8; ++tt) {
                    const float4 h = *(const float4*)(hs + tt * 1024 + k);
                    acc[tt] += h.x * w0; acc[tt] += h.y * w1; acc[tt] += h.z * w2; acc[tt] += h.w * w3;
                }
            }
#pragma unroll
            for (int tt = 0; tt < 8; ++tt) lg[tt * 256 + tid] = acc[tt];
        }
        __syncthreads();
        if (tid < 8) {
            const int tok = t0 + tid;
            float* l = lg + tid * 256;
            float* z = bz + tid * 256;
            float gs[8];
#pragma unroll
            for (int g = 0; g < 8; ++g) {
                float m1 = -INFINITY, m2 = -INFINITY;
                for (int j = 0; j < 32; ++j) {
                    const int e = g * 32 + j;
                    const float sc = 1.f / (1.f + expf(-l[e]));
                    const float bv = sc + p.router_bias[e];
                    l[e] = sc; z[e] = bv;
                    if (bv > m1) { m2 = m1; m1 = bv; } else if (bv > m2) m2 = bv;
                }
                gs[g] = m1 + m2;
            }
            unsigned gmask = 0u;
#pragma unroll
            for (int r = 0; r < 4; ++r) {
                float best = -INFINITY; int bi = 0;
#pragma unroll
                for (int g = 0; g < 8; ++g) {
                    const bool ok = (((gmask >> g) & 1u) == 0u) && (gs[g] > best);
                    if (ok) { best = gs[g]; bi = g; }
                }
                gmask |= 1u << bi;
            }
            float wsum = 0.f;
            for (int r = 0; r < 8; ++r) {
                float best = -INFINITY; int bi = 0;
                for (int e = 0; e < 256; ++e) {
                    const float v = z[e];
                    if (((gmask >> (e >> 5)) & 1u) && v > best) { best = v; bi = e; }
                }
                z[bi] = -INFINITY;
                const float sc = l[bi];
                selw[tid * 8 + r] = sc;
                wsum += sc;
                p.topi[tok * 8 + r] = bi;
            }
            const float inv = 2.5f / wsum;
            for (int r = 0; r < 8; ++r) {
                p.topw[tok * 8 + r] = selw[tid * 8 + r] * inv;
                const int e = p.topi[tok * 8 + r];
                const int pos = atomicAdd(&p.cnt[e], 1);
                p.list[(size_t)e * T + pos] = tok * 8 + r;
            }
        }
    }
}

struct ExpMap { int* cnt; int* off; int* tile; };
__device__ __forceinline__ ExpMap exp_map(const Params& p, char* smem) {
    ExpMap m;
    m.cnt = (int*)(smem + 32768); m.off = m.cnt + 256; m.tile = m.off + 256;
    const int tid = otid();
    __syncthreads();
    m.cnt[tid] = p.cnt[tid];
    __syncthreads();
    if (tid == 0) {
        int off = 0, tl = 0;
        for (int e = 0; e < NE; ++e) { m.off[e] = off; m.tile[e] = tl; const int c = m.cnt[e]; off += c; tl += (c + 127) >> 7; }
        m.tile[NE] = tl;
    }
    __syncthreads();
    return m;
}
__device__ __forceinline__ int find_expert(const int* tile, int rt) {
    int lo = 0, hi = NE;
    while (hi - lo > 1) { const int mid = (lo + hi) >> 1; if (tile[mid] <= rt) lo = mid; else hi = mid; }
    return lo;
}

__device__ void ph_gateup(const Params& p, char* smem) {
    const int tid = otid(), lane = tid & 63, wid = tid >> 6, wr = wid >> 1, wc = wid & 1, fr = lane & 15, fq = lane >> 4;
    const ExpMap em = exp_map(p, smem);
    const int ntile = em.tile[NE];
    for (int u = blockIdx.x; u < (ntile + T / 128) * 4; u += gridDim.x) {
        const int rt = u >> 2, nt = u & 3, c0 = nt * 64;
        f32x4 acc[4][4];
        if (rt < ntile) {
            const int e = find_expert(em.tile, rt);
            const int r0 = (rt - em.tile[e]) * 128, ne = em.cnt[e];
            const int* lst = p.list + (size_t)e * T;
            const float* Wg = p.w_eg + (size_t)e * D * ED;
            const float* Wu = p.w_eu + (size_t)e * D * ED;
            gemm_tile(smem, D,
                      [&](int r) { const int rr = r0 + r; const int a = lst[rr < ne ? rr : 0]; return p.h2 + (size_t)(a >> 3) * D; },
                      [&](int n) { const int t16 = n >> 4; return ((t16 & 1) ? Wu : Wg) + c0 + 16 * (t16 >> 1) + (n & 15); },
                      ED, acc);
            const size_t gbase = (size_t)em.off[e];
#pragma unroll
            for (int m = 0; m < 4; ++m)
#pragma unroll
                for (int n = 0; n < 4; n += 2) {
                    const int col = c0 + 16 * (2 * wc + (n >> 1)) + fr;
#pragma unroll
                    for (int j = 0; j < 4; ++j) {
                        const int rr = r0 + wr * 64 + m * 16 + fq * 4 + j;
                        if (rr < ne) {
                            const float g = acc[m][n][j], uu = acc[m][n + 1][j];
                            p.gbuf[(gbase + rr) * ED + col] = f2bf(g / (1.f + __expf(-g)) * uu);
                        }
                    }
                }
        } else {
            const int tb = (rt - ntile) * 128;
            const bf16_t* A = p.h2 + (size_t)tb * D;
            gemm_tile(smem, D,
                      [&](int r) { return A + (size_t)r * D; },
                      [&](int n) { const int t16 = n >> 4; return ((t16 & 1) ? p.w_su : p.w_sg) + c0 + 16 * (t16 >> 1) + (n & 15); },
                      ED, acc);
#pragma unroll
            for (int m = 0; m < 4; ++m)
#pragma unroll
                for (int n = 0; n < 4; n += 2) {
                    const int col = c0 + 16 * (2 * wc + (n >> 1)) + fr;
#pragma unroll
                    for (int j = 0; j < 4; ++j) {
                        const int row = tb + wr * 64 + m * 16 + fq * 4 + j;
                        const float g = acc[m][n][j], uu = acc[m][n + 1][j];
                        p.gsh[(size_t)row * ED + col] = f2bf(g / (1.f + __expf(-g)) * uu);
                    }
                }
        }
    }
}

__device__ void ph_down(const Params& p, char* smem) {
    const int tid = otid(), lane = tid & 63, wid = tid >> 6, wr = wid >> 1, wc = wid & 1, fr = lane & 15, fq = lane >> 4;
    const ExpMap em = exp_map(p, smem);
    const int ntile = em.tile[NE];
    for (int u = blockIdx.x; u < (ntile + T / 128) * 8; u += gridDim.x) {
        const int rt = u >> 3, nt = u & 7;
        f32x4 acc[4][4];
        if (rt < ntile) {
            const int e = find_expert(em.tile, rt);
            const int r0 = (rt - em.tile[e]) * 128, ne = em.cnt[e];
            const int* lst = p.list + (size_t)e * T;
            const bf16_t* A = p.gbuf + (size_t)em.off[e] * ED;
            const float* W = p.w_ed + (size_t)e * ED * D + nt * 128;
            gemm_tile(smem, ED,
                      [&](int r) { const int rr = r0 + r; return A + (size_t)(rr < ne ? rr : 0) * ED; },
                      [&](int n) { return W + n; }, D, acc);
#pragma unroll
            for (int m = 0; m < 4; ++m)
#pragma unroll
                for (int j = 0; j < 4; ++j) {
                    const int rr = r0 + wr * 64 + m * 16 + fq * 4 + j;
                    if (rr < ne) {
                        const int a = lst[rr];
                        const float w = p.topw[a];
                        bf16_t* yr = p.ybuf + ((size_t)(a >> 3) * 9 + (a & 7)) * D + nt * 128 + wc * 64 + fr;
#pragma unroll
                        for (int n = 0; n < 4; ++n) yr[n * 16] = f2bf(acc[m][n][j] * w);
                    }
                }
        } else {
            const int tb = (rt - ntile) * 128;
            const bf16_t* A = p.gsh + (size_t)tb * ED;
            const float* W = p.w_sd + nt * 128;
            gemm_tile(smem, ED, [&](int r) { return A + (size_t)r * ED; }, [&](int n) { return W + n; }, D, acc);
#pragma unroll
            for (int m = 0; m < 4; ++m)
#pragma unroll
                for (int j = 0; j < 4; ++j) {
                    const int row = tb + wr * 64 + m * 16 + fq * 4 + j;
                    bf16_t* yr = p.ybuf + ((size_t)row * 9 + 8) * D + nt * 128 + wc * 64 + fr;
#pragma unroll
                    for (int n = 0; n < 4; ++n) yr[n * 16] = f2bf(acc[m][n][j]);
                }
        }
    }
}

__device__ void ph_final(const Params& p) {
    const int tid = otid(), lane = tid & 63, wid = tid >> 6;
    for (int row = blockIdx.x * 4 + wid; row < T; row += gridDim.x * 4) {
        const int b = row >> 12;
        const float* g2 = p.mod + b * 6144 + 5120;
        float4 v[4];
        float s = 0.f;
#pragma unroll
        for (int i = 0; i < 4; ++i) {
            const int col = (lane + 64 * i) * 4;
            float f0 = 0.f, f1 = 0.f, f2 = 0.f, f3 = 0.f;
#pragma unroll
            for (int k = 0; k < 9; ++k) {
                const uint2 w = *(const uint2*)(p.ybuf + ((size_t)row * 9 + k) * D + col);
                f0 += __uint_as_float(w.x << 16); f1 += __uint_as_float(w.x & 0xffff0000u);
                f2 += __uint_as_float(w.y << 16); f3 += __uint_as_float(w.y & 0xffff0000u);
            }
            const float4 xv = *(const float4*)(p.x1 + (size_t)row * D + col);
            const float4 g4 = *(const float4*)(g2 + col);
            v[i].x = ALPHA * xv.x + g4.x * f0; v[i].y = ALPHA * xv.y + g4.y * f1;
            v[i].z = ALPHA * xv.z + g4.z * f2; v[i].w = ALPHA * xv.w + g4.w * f3;
            s += v[i].x + v[i].y + v[i].z + v[i].w;
        }
        const float mean = wave_sum(s) * (1.f / D);
        float q = 0.f;
#pragma unroll
        for (int i = 0; i < 4; ++i) {
            v[i].x -= mean; v[i].y -= mean; v[i].z -= mean; v[i].w -= mean;
            q += v[i].x * v[i].x + v[i].y * v[i].y + v[i].z * v[i].z + v[i].w * v[i].w;
        }
        const float rstd = rsqrtf(wave_sum(q) * (1.f / D) + LN_EPS);
#pragma unroll
        for (int i = 0; i < 4; ++i) {
            const int col = (lane + 64 * i) * 4;
            const float4 g4 = *(const float4*)(p.ln2_g + col), b4 = *(const float4*)(p.ln2_b + col);
            float4 y;
            y.x = v[i].x * rstd * g4.x + b4.x; y.y = v[i].y * rstd * g4.y + b4.y;
            y.z = v[i].z * rstd * g4.z + b4.z; y.w = v[i].w * rstd * g4.w + b4.w;
            *(float4*)(p.out + (size_t)row * D + col) = y;
        }
    }
}

constexpr int LDS_BYTES = 67584;
constexpr int NPHASE = 12;

template <int PH>
__device__ __forceinline__ void run_phase(const Params& p, char* smem) {
    if (PH == 0) ph_mod(p, smem);
    if (PH == 1) ph_ln0(p);
    if (PH == 2) ph_inproj(p, smem);
    if (PH == 3) { ph_h1(p, smem); ph_attn(p, smem); }
    if (PH == 4) { ph_h2(p); ph_attn_merge(p); }
    if (PH == 5) ph_h3(p, smem);
    if (PH == 6) ph_outproj(p, smem);
    if (PH == 7) ph_ln1(p);
    if (PH == 8) ph_router(p, smem);
    if (PH == 9) ph_gateup(p, smem);
    if (PH == 10) ph_down(p, smem);
    if (PH == 11) ph_final(p);
}

template <int PH>
__global__ void __launch_bounds__(NTHREADS, 2) k_phase(Params p) {
    extern __shared__ __attribute__((aligned(16))) char smem[];
    run_phase<PH>(p, smem);
}

__global__ void __launch_bounds__(NTHREADS, 2) k_all(Params p) {
    extern __shared__ __attribute__((aligned(16))) char smem[];
    volatile LAS unsigned* st = (volatile LAS unsigned*)(smem + LDS_BYTES - 16);
    if (threadIdx.x == 0) { st[0] = 0u; st[1] = 0u; st[2] = 0u; st[3] = 0u; }
    __syncthreads();
    XcdBarrier bar = xcd_barrier_post(p.bar, st);
    run_phase<0>(p, smem); xcd_barrier(bar);
    run_phase<1>(p, smem); xcd_barrier(bar);
    run_phase<2>(p, smem); xcd_barrier(bar);
    run_phase<3>(p, smem); xcd_barrier(bar);
    run_phase<4>(p, smem); xcd_barrier(bar);
    run_phase<5>(p, smem); xcd_barrier(bar);
    run_phase<6>(p, smem); xcd_barrier(bar);
    run_phase<7>(p, smem); xcd_barrier(bar);
    run_phase<8>(p, smem); xcd_barrier(bar);
    run_phase<9>(p, smem); xcd_barrier(bar);
    run_phase<10>(p, smem); xcd_barrier(bar);
    run_phase<11>(p, smem);
}

template <int PH>
static void launch_phase(const Params& p, int grid, hipStream_t stream) {
    hipLaunchKernelGGL(k_phase<PH>, dim3(grid), dim3(NTHREADS), LDS_BYTES, stream, p);
}

extern "C" void kernel_launch(void* const* d_in, const int* in_sizes, int n_in, void* d_out, int out_size, void* d_ws, size_t ws_size,
                              hipStream_t stream) {
    (void)in_sizes; (void)n_in; (void)out_size;
    Params p{};
    const float** pin = (const float**)&p.x;
    for (int i = 0; i < 21; ++i) pin[i] = (const float*)d_in[i];
    p.out = (float*)d_out;
    char* ws = (char*)d_ws;
    size_t off = 0;
    auto carve = [&](size_t bytes) { char* r = ws + off; off += (bytes + 255) & ~(size_t)255; return r; };
    char* ctl = carve(65536);
    p.bar = (unsigned*)ctl;
    p.cnt = (int*)(ctl + 16384);
    p.mod = (float*)carve(4 * 6144 * 4);
    p.lbv = (float*)carve(512 * 4);
    p.biasT = (float*)carve(3 * 129 * 4 * 4);
    p.h1 = (bf16_t*)carve((size_t)T * D * 2);
    p.proj = (bf16_t*)carve((size_t)T * INW * 2);
    p.lgf = (float*)carve((size_t)T * 512 * 4);
    p.ao = (float*)carve((size_t)3 * T * 256 * 4);
    p.alse = (float*)carve((size_t)3 * T * 4 * 4);
    p.mixin = (bf16_t*)carve((size_t)T * 768 * 2);
    p.pre1 = (float*)carve((size_t)T * D * 4);
    p.x1 = (float*)carve((size_t)T * D * 4);
    p.h2 = (bf16_t*)carve((size_t)T * D * 2);
    p.h2f = (float*)carve((size_t)T * D * 4);
    p.topi = (int*)carve((size_t)T * 8 * 4);
    p.topw = (float*)carve((size_t)T * 8 * 4);
    p.list = (int*)carve((size_t)NE * T * 4);
    p.gbuf = (bf16_t*)carve((size_t)T * TOPK * ED * 2);
    p.gsh = (bf16_t*)carve((size_t)T * ED * 2);
    p.ybuf = (bf16_t*)carve((size_t)T * 9 * D * 2);
    p.kv = (float*)p.ybuf;
    p.sst = (bf16_t*)((char*)p.ybuf + (size_t)1024 * 16384 * 4);
    p.dec = (float*)carve((size_t)1024 * 128 * 4);
    if (off > ws_size) { fprintf(stderr, "kernel_launch: workspace too small: need %zu have %zu\n", off, ws_size); return; }

    static int grid = 0;
    if (grid == 0) {
        int dev = 0, cus = 0, per_cu = 0;
        hipGetDevice(&dev);
        hipDeviceGetAttribute(&cus, hipDeviceAttributeMultiprocessorCount, dev);
        hipFuncSetAttribute((const void*)k_all, hipFuncAttributeMaxDynamicSharedMemorySize, LDS_BYTES);
        hipOccupancyMaxActiveBlocksPerMultiprocessor(&per_cu, (const void*)k_all, NTHREADS, LDS_BYTES);
        if (per_cu < 1) per_cu = 1;
        grid = cus * (per_cu < 2 ? per_cu : 2);
        fprintf(stderr, "kernel_launch: cus %d per_cu %d grid %d ws need %zu have %zu\n", cus, per_cu, grid, off, ws_size);
    }
    hipMemsetAsync(ctl, 0, 65536, stream);
#if ONE_LAUNCH
    hipLaunchKernelGGL(k_all, dim3(grid), dim3(NTHREADS), LDS_BYTES, stream, p);
#else
    launch_phase<0>(p, grid, stream); launch_phase<1>(p, grid, stream); launch_phase<2>(p, grid, stream); launch_phase<3>(p, grid, stream);
    launch_phase<4>(p, grid, stream); launch_phase<5>(p, grid, stream); launch_phase<6>(p, grid, stream); launch_phase<7>(p, grid, stream);
    launch_phase<8>(p, grid, stream); launch_phase<9>(p, grid, stream); launch_phase<10>(p, grid, stream); launch_phase<11>(p, grid, stream);
#endif
}
```

```cpp
#include <hip/hip_runtime.h>
#include <stdint.h>
#include <stdio.h>

#ifndef ONE_LAUNCH
#define ONE_LAUNCH 1
#endif

constexpr int D = 1024, NBATCH = 4, S = 4096, T = NBATCH * S;
constexpr int INW = 4352;
constexpr int NE = 256, TOPK = 8, ED = 256;
constexpr int OFF_HQ = 0, OFF_HF = 512, OFF_HI = 1024, OFF_HG = 1536, OFF_AQ = 2048, OFF_AK = 2816, OFF_AV = 3584;
constexpr float ALPHA = 1.189207115002721f;
constexpr float LN_EPS = 1e-5f, RMS_EPS = 1e-6f;
constexpr int NTHREADS = 256;

typedef unsigned short bf16_t;
using bf16x8 = __attribute__((ext_vector_type(8))) short;
using f32x4 = __attribute__((ext_vector_type(4))) float;
using u32x4 = __attribute__((ext_vector_type(4))) unsigned int;

typedef float v2f_t __attribute__((ext_vector_type(2)));
typedef __bf16 v2bf_t __attribute__((ext_vector_type(2)));
typedef short v4s __attribute__((ext_vector_type(4)));
__device__ __forceinline__ unsigned short f2bf(float f) { return __builtin_bit_cast(unsigned short, (__bf16)f); }
__device__ __forceinline__ float bf2f(unsigned short h) { return __uint_as_float(((uint32_t)h) << 16); }
__device__ __forceinline__ uint32_t pack2(float a, float b) {
    const v2f_t f = {a, b};
    return __builtin_bit_cast(uint32_t, __builtin_convertvector(f, v2bf_t));
}
__device__ __forceinline__ float sigmoidf_(float v) { return 1.f / (1.f + __expf(-v)); }

__device__ __forceinline__ int otid() { int t = threadIdx.x; asm volatile("" : "+v"(t)); return t; }

struct Params {
    const float *x, *c, *w_ada, *b_ada, *w_in, *hg_lb, *hg_nw, *rel_bias, *w_out, *ln1_g, *ln1_b, *w_router, *router_bias,
        *w_eg, *w_eu, *w_ed, *w_sg, *w_su, *w_sd, *ln2_g, *ln2_b;
    float* out;
    unsigned* bar;
    int* cnt;
    float* mod;
    float* lbv;
    float* biasT;
    bf16_t* h1;
    bf16_t* proj;
    float* lgf;
    float* ao;
    float* alse;
    bf16_t* mixin;
    float* pre1;
    float* x1;
    bf16_t* h2;
    float* wr2;
    float* lgp;
    int* topi;
    float* topw;
    int* list;
    bf16_t* gbuf;
    bf16_t* gsh;
    bf16_t* ybuf;
    float* kv;
    float* dec;
    bf16_t* sst;
};

#define XB_TMO      128
#define XB_XCNT(j)  (256  + 64 * (j))
#define XB_XSUB(j)  (1280 + 64 * (j))
#define XB_XGEN(j)  (2304 + 64 * (j))
#define XB_TOP      3328
#define XB_TOPGEN   3392
#define XCD_BAR_WORDS 3456
#define XB_SPIN_CAP (1u << 18)
#define LAS __attribute__((address_space(3)))

__device__ __forceinline__ unsigned xb_ld(unsigned* p)              { return __hip_atomic_load(p, __ATOMIC_RELAXED, __HIP_MEMORY_SCOPE_AGENT); }
__device__ __forceinline__ unsigned xb_add(unsigned* p, unsigned v) { return __hip_atomic_fetch_add(p, v, __ATOMIC_RELAXED, __HIP_MEMORY_SCOPE_AGENT); }
__device__ __forceinline__ unsigned xb_xcc_id() { return (unsigned)__builtin_amdgcn_s_getreg((3 << 11) | 20) & 0xFu; }
#define XB_SPIN(cond, bar) do { unsigned _sp = 0; while (cond) { __builtin_amdgcn_s_sleep(1); \
    if ((++_sp & 255u) == 0u) { if (xb_ld(&(bar)[XB_TMO])) break; if (_sp > XB_SPIN_CAP) { atomicAdd(&(bar)[XB_TMO], 1u); break; } } } } while (0)

struct XcdBarrier {
    unsigned* bar; unsigned x;
    volatile LAS unsigned* st;
};
__device__ __forceinline__ XcdBarrier xcd_barrier_post(unsigned* bar, volatile LAS unsigned* st) {
    XcdBarrier b; b.bar = bar; b.x = xb_xcc_id(); b.st = st;
    if (threadIdx.x == 0) (void)xb_add(&bar[XB_XCNT(b.x)], 1u);
    return b;
}
__device__ __forceinline__ void xcd_barrier_complete(unsigned* bar, unsigned x, unsigned& nloc, unsigned& nx) {
    const unsigned G = gridDim.x * gridDim.y * gridDim.z;
    unsigned sum, cnt, mine, sp = 0u;
    for (;;) {
        sum = 0u; cnt = 0u; mine = 0u;
#pragma unroll
        for (unsigned j = 0; j < 16; ++j) { const unsigned c = xb_ld(&bar[XB_XCNT(j)]); sum += c; cnt += (c > 0u) ? 1u : 0u; mine = (j == x) ? c : mine; }
        if (sum == G) break;
        __builtin_amdgcn_s_sleep(1);
        if ((++sp & 255u) == 0u) { if (xb_ld(&bar[XB_TMO])) break; if (sp > XB_SPIN_CAP) { atomicAdd(&bar[XB_TMO], 1u); break; } }
    }
    nloc = mine > 0u ? mine : 1u; nx = cnt > 0u ? cnt : 1u;
}
__device__ __forceinline__ void xcd_barrier(const XcdBarrier& b) {
    asm volatile("s_waitcnt vmcnt(0)" ::: "memory");
    __syncthreads();
    if (threadIdx.x == 0) {
        unsigned* bar = b.bar;
        __builtin_amdgcn_s_waitcnt(0);
        unsigned nloc = b.st[0], nx = b.st[1];
        if (nloc == 0u) { xcd_barrier_complete(bar, b.x, nloc, nx); b.st[0] = nloc; b.st[1] = nx; }
        const unsigned old = xb_add(&bar[XB_XSUB(b.x)], 1u);
        const unsigned gen = old / nloc;
        if (old + 1u == (gen + 1u) * nloc) {
            __builtin_amdgcn_fence(__ATOMIC_RELEASE, "agent");
            asm volatile("s_waitcnt vmcnt(0)" ::: "memory");
            const unsigned og = xb_add(&bar[XB_TOP], 1u);
            const unsigned tg = og / nx;
            if (og + 1u == (tg + 1u) * nx) xb_add(&bar[XB_TOPGEN], 1u);
            else XB_SPIN(xb_ld(&bar[XB_TOPGEN]) == tg, bar);
            __builtin_amdgcn_fence(__ATOMIC_ACQUIRE, "agent");
            xb_add(&bar[XB_XGEN(b.x)], 1u);
            asm volatile("s_waitcnt vmcnt(0)" ::: "memory");
        } else {
            XB_SPIN(xb_ld(&bar[XB_XGEN(b.x)]) == gen, bar);
            __builtin_amdgcn_fence(__ATOMIC_ACQUIRE, "agent");
            asm volatile("s_waitcnt vmcnt(0)" ::: "memory");
        }
    }
    __syncthreads();
}

constexpr int BK = 64;
__device__ __forceinline__ int swz(int row, int chunk) { return row * 128 + ((chunk ^ ((row >> 1) & 7)) << 4); }

template <class AF, class BF>
__device__ __forceinline__ void gemm_tile(char* smem, const int K, AF arow, BF bcol, const int ldb, f32x4 (&acc)[4][4]) {
    const int tid = otid(), lane = tid & 63, wid = tid >> 6, wr = wid >> 1, wc = wid & 1, fr = lane & 15, fq = lane >> 4;
    char* sA = smem;
    char* sB = smem + 16384;
    const bf16_t* ap[4];
#pragma unroll
    for (int i = 0; i < 4; ++i) ap[i] = arow((tid >> 3) + 32 * i) + (tid & 7) * 8;
    const int nq = tid & 31, kg = tid >> 5;
    const float* bp = bcol(nq * 4) + (size_t)(kg * 8) * ldb;
#pragma unroll
    for (int m = 0; m < 4; ++m)
#pragma unroll
        for (int n = 0; n < 4; ++n) acc[m][n] = f32x4{0.f, 0.f, 0.f, 0.f};
    u32x4 ra[4];
    f32x4 rb[8];
#pragma unroll
    for (int i = 0; i < 4; ++i) ra[i] = *(const u32x4*)(ap[i]);
#pragma unroll
    for (int j = 0; j < 8; ++j) rb[j] = *(const f32x4*)(bp + (size_t)j * ldb);
    for (int k0 = 0; k0 < K; k0 += BK) {
        __syncthreads();
#pragma unroll
        for (int i = 0; i < 4; ++i) *(u32x4*)(sA + swz((tid >> 3) + 32 * i, tid & 7)) = ra[i];
        {
            u32x4 v;
            v.x = pack2(rb[0].x, rb[1].x); v.y = pack2(rb[2].x, rb[3].x); v.z = pack2(rb[4].x, rb[5].x); v.w = pack2(rb[6].x, rb[7].x);
            *(u32x4*)(sB + swz(nq * 4 + 0, kg)) = v;
            v.x = pack2(rb[0].y, rb[1].y); v.y = pack2(rb[2].y, rb[3].y); v.z = pack2(rb[4].y, rb[5].y); v.w = pack2(rb[6].y, rb[7].y);
            *(u32x4*)(sB + swz(nq * 4 + 1, kg)) = v;
            v.x = pack2(rb[0].z, rb[1].z); v.y = pack2(rb[2].z, rb[3].z); v.z = pack2(rb[4].z, rb[5].z); v.w = pack2(rb[6].z, rb[7].z);
            *(u32x4*)(sB + swz(nq * 4 + 2, kg)) = v;
            v.x = pack2(rb[0].w, rb[1].w); v.y = pack2(rb[2].w, rb[3].w); v.z = pack2(rb[4].w, rb[5].w); v.w = pack2(rb[6].w, rb[7].w);
            *(u32x4*)(sB + swz(nq * 4 + 3, kg)) = v;
        }
        __syncthreads();
        if (k0 + BK < K) {
#pragma unroll
            for (int i = 0; i < 4; ++i) ra[i] = *(const u32x4*)(ap[i] + k0 + BK);
#pragma unroll
            for (int j = 0; j < 8; ++j) rb[j] = *(const f32x4*)(bp + (size_t)(k0 + BK + j) * ldb);
        }
#pragma unroll
        for (int ks = 0; ks < 2; ++ks) {
            bf16x8 af[4], bfr[4];
#pragma unroll
            for (int m = 0; m < 4; ++m) af[m] = *(const bf16x8*)(sA + swz(wr * 64 + m * 16 + fr, ks * 4 + fq));
#pragma unroll
            for (int n = 0; n < 4; ++n) bfr[n] = *(const bf16x8*)(sB + swz(wc * 64 + n * 16 + fr, ks * 4 + fq));
#pragma unroll
            for (int m = 0; m < 4; ++m)
#pragma unroll
                for (int n = 0; n < 4; ++n) acc[m][n] = __builtin_amdgcn_mfma_f32_16x16x32_bf16(af[m], bfr[n], acc[m][n], 0, 0, 0);
        }
    }
}

__device__ __forceinline__ float wave_sum(float v) {
#pragma unroll
    for (int o = 32; o > 0; o >>= 1) v += __shfl_xor(v, o, 64);
    return v;
}

__device__ __forceinline__ int t5_bucket(int n) {
    if (n < 16) return n;
    const float v = logf((float)n / 16.f) / logf(128.f) * 16.f;
    int large = 16 + (int)v;
    return large < 31 ? large : 31;
}

__device__ void ph_mod(const Params& p, char* smem) {
    const int tid = otid();
    float* cond = (float*)smem;
    float* red = cond + 4096;
    for (int i = tid; i < 4096; i += NTHREADS) { const float v = p.c[i]; cond[i] = v / (1.f + __expf(-v)); }
    __syncthreads();
    const int NU = 192;
    for (int u = blockIdx.x; u < NU + 2 + 64; u += gridDim.x) {
        if (u >= NU + 2) {
            const int base = (u - NU - 2) * 4096;
            for (int i = tid; i < 4096; i += NTHREADS) {
                const float w = p.w_router[base + i];
                const float hi = bf2f(f2bf(w));
                p.wr2[base + i] = hi;
                p.wr2[262144 + base + i] = w - hi;
            }
        } else if (u < NU) {
            const int cl = tid & 31, kq = tid >> 5, n = u * 32 + cl;
            float a0 = 0.f, a1 = 0.f, a2 = 0.f, a3 = 0.f;
            for (int k = kq; k < 1024; k += 8) {
                const float w = p.w_ada[(size_t)k * 6144 + n];
                a0 += cond[k] * w; a1 += cond[1024 + k] * w; a2 += cond[2048 + k] * w; a3 += cond[3072 + k] * w;
            }
            __syncthreads();
            red[(kq * 4 + 0) * 32 + cl] = a0; red[(kq * 4 + 1) * 32 + cl] = a1; red[(kq * 4 + 2) * 32 + cl] = a2; red[(kq * 4 + 3) * 32 + cl] = a3;
            __syncthreads();
            if (tid < 128) {
                const int b = tid >> 5, c2 = tid & 31;
                float s = 0.f;
                for (int q = 0; q < 8; ++q) s += red[(q * 4 + b) * 32 + c2];
                p.mod[b * 6144 + u * 32 + c2] = s + p.b_ada[u * 32 + c2];
            }
        } else if (u == NU) {
            for (int j = tid; j < 512; j += NTHREADS) {
                const float a = p.hg_lb[j], b = p.hg_lb[512 + j];
                const float m = fmaxf(a, b);
                const float ea = expf(a - m), eb = expf(b - m);
                p.lbv[j] = ea / (ea + eb);
            }
        } else {
            for (int i = tid; i < 3 * 129 * 4; i += NTHREADS) {
                const int g = i / (129 * 4), m = (i >> 2) % 129, hh = i & 3;
                const int dil = (g == 0) ? 1 : (g == 1 ? 4 : 16);
                p.biasT[i] = p.rel_bias[t5_bucket(m * dil) * 12 + g * 4 + hh];
            }
        }
    }
}

__device__ void ph_ln0(const Params& p) {
    const int tid = otid(), lane = tid & 63, wid = tid >> 6;
    for (int row = blockIdx.x * 4 + wid; row < T; row += gridDim.x * 4) {
        const float4* xr = (const float4*)(p.x + (size_t)row * D);
        float4 v[4];
        float s = 0.f;
#pragma unroll
        for (int i = 0; i < 4; ++i) { v[i] = xr[lane + 64 * i]; s += v[i].x + v[i].y + v[i].z + v[i].w; }
        const float mean = wave_sum(s) * (1.f / D);
        float q = 0.f;
#pragma unroll
        for (int i = 0; i < 4; ++i) {
            v[i].x -= mean; v[i].y -= mean; v[i].z -= mean; v[i].w -= mean;
            q += v[i].x * v[i].x + v[i].y * v[i].y + v[i].z * v[i].z + v[i].w * v[i].w;
        }
        const float rstd = rsqrtf(wave_sum(q) * (1.f / D) + LN_EPS);
        const int b = row >> 12;
        const float* sh = p.mod + b * 6144;
        const float* sc = sh + 1024;
#pragma unroll
        for (int i = 0; i < 4; ++i) {
            const int col = (lane + 64 * i) * 4;
            const float4 s4 = *(const float4*)(sc + col), h4 = *(const float4*)(sh + col);
            uint2 o;
            o.x = pack2(v[i].x * rstd * (1.f + s4.x) + h4.x, v[i].y * rstd * (1.f + s4.y) + h4.y);
            o.y = pack2(v[i].z * rstd * (1.f + s4.z) + h4.z, v[i].w * rstd * (1.f + s4.w) + h4.w);
            *(uint2*)(p.h1 + (size_t)row * D + col) = o;
        }
    }
}

__device__ void ph_inproj(const Params& p, char* smem) {
    const int tid = otid(), lane = tid & 63, wid = tid >> 6, wr = wid >> 1, wc = wid & 1, fr = lane & 15, fq = lane >> 4;
    const int NT = INW / 128;
    for (int u = blockIdx.x; u < (T / 128) * NT; u += gridDim.x) {
        const int mt = u / NT, nt = u % NT;
        const bf16_t* A = p.h1 + (size_t)mt * 128 * D;
        const float* W = p.w_in + nt * 128;
        f32x4 acc[4][4];
        gemm_tile(smem, D, [&](int r) { return A + (size_t)r * D; }, [&](int n) { return W + n; }, INW, acc);
        if (nt >= 4 && nt < 8) {
#pragma unroll
            for (int m = 0; m < 4; ++m)
#pragma unroll
                for (int n = 0; n < 4; ++n) {
                    const int c = nt * 128 - OFF_HF + wc * 64 + n * 16 + fr;
                    const float lb = p.lbv[c];
#pragma unroll
                    for (int j = 0; j < 4; ++j) {
                        const int row = mt * 128 + wr * 64 + m * 16 + fq * 4 + j;
                        const float f = lb + (1.f - lb) * (1.f / (1.f + expf(-acc[m][n][j])));
                        p.lgf[(size_t)row * 512 + c] = logf(f);
                    }
                }
        } else {
#pragma unroll
            for (int m = 0; m < 4; ++m)
#pragma unroll
                for (int n = 0; n < 4; ++n)
#pragma unroll
                    for (int j = 0; j < 4; ++j) {
                        const int row = mt * 128 + wr * 64 + m * 16 + fq * 4 + j;
                        p.proj[(size_t)row * INW + nt * 128 + wc * 64 + n * 16 + fr] = f2bf(acc[m][n][j]);
                    }
        }
    }
}


__device__ __forceinline__ int swz16(int row, int chunk) { return row * 256 + ((chunk ^ (row & 15)) << 4); }
__device__ __forceinline__ bf16x8 tr_frag16(const char* tile, int ks, int c) {
    const int lane = otid() & 63, g = lane >> 4, q = (lane & 15) >> 2, pp = lane & 3;
    const int r0 = 32 * ks + 8 * g + q, ch = 2 * c + (pp >> 1), bo = 8 * (pp & 1);
    const v4s lo = __builtin_amdgcn_ds_read_tr16_b64_v4i16((LAS v4s*)(tile + swz16(r0, ch) + bo));
    const v4s hi = __builtin_amdgcn_ds_read_tr16_b64_v4i16((LAS v4s*)(tile + swz16(r0 + 4, ch) + bo));
    return bf16x8{lo[0], lo[1], lo[2], lo[3], hi[0], hi[1], hi[2], hi[3]};
}

__device__ void ph_h1(const Params& p, char* smem) {
    const int tid = otid(), lane = tid & 63, wid = tid >> 6, wr = wid >> 1, wc = wid & 1, fr = lane & 15, fq = lane >> 4;
    char* sI = smem;
    char* sK = smem + 16384;
    float* sL = (float*)(smem + 32768);
    float* totS = (float*)(smem + 65536);
    const int d = tid & 127, half = tid >> 7;
    for (int u = blockIdx.x; u < 1024; u += gridDim.x) {
        const int bh = u >> 6, c = u & 63, b = bh >> 2, h = bh & 3;
        const size_t row0 = (size_t)b * S + c * 64;
        __syncthreads();
#pragma unroll
        for (int i = 0; i < 4; ++i) {
            const int idx = tid + 256 * i, r = idx >> 4, ch = idx & 15;
            *(u32x4*)(sI + swz16(r, ch)) = *(const u32x4*)(p.proj + (row0 + r) * INW + OFF_HI + h * 128 + ch * 8);
        }
#pragma unroll
        for (int i = 0; i < 8; ++i) {
            const int idx = tid + 256 * i, r = idx >> 5, c4 = idx & 31;
            *(f32x4*)(sL + r * 128 + c4 * 4) = *(const f32x4*)(p.lgf + (row0 + r) * 512 + h * 128 + c4 * 4);
        }
        __syncthreads();
        const float* lcol = sL + half * 32 * 128 + d;
        float tot = 0.f;
#pragma unroll
        for (int s = 0; s < 32; ++s) tot += lcol[s * 128];
        totS[half * 128 + d] = tot;
        __syncthreads();
        const float t0 = totS[d], bl = t0 + totS[128 + d];
        float run = half ? t0 : 0.f;
#pragma unroll 8
        for (int s = 0; s < 32; ++s) {
            const float lv = lcol[s * 128];
            run += lv;
            const float kt = (1.f - __expf(lv)) * __expf(bl - run);
            *(bf16_t*)(sK + swz16(half * 32 + s, d >> 3) + (d & 7) * 2) = f2bf(kt);
        }
        if (half == 0) p.dec[u * 128 + d] = __expf(bl);
        __syncthreads();
        f32x4 acc[4][4];
#pragma unroll
        for (int m = 0; m < 4; ++m)
#pragma unroll
            for (int n = 0; n < 4; ++n) acc[m][n] = f32x4{0.f, 0.f, 0.f, 0.f};
#pragma unroll
        for (int ks = 0; ks < 2; ++ks) {
            bf16x8 af[4], bfr[4];
#pragma unroll
            for (int m = 0; m < 4; ++m) af[m] = tr_frag16(sI, ks, wr * 4 + m);
#pragma unroll
            for (int n = 0; n < 4; ++n) bfr[n] = tr_frag16(sK, ks, wc * 4 + n);
#pragma unroll
            for (int m = 0; m < 4; ++m)
#pragma unroll
                for (int n = 0; n < 4; ++n) acc[m][n] = __builtin_amdgcn_mfma_f32_16x16x32_bf16(af[m], bfr[n], acc[m][n], 0, 0, 0);
        }
        float* kvu = p.kv + (size_t)u * 16384;
#pragma unroll
        for (int m = 0; m < 4; ++m)
#pragma unroll
            for (int n = 0; n < 4; ++n)
#pragma unroll
                for (int j = 0; j < 4; ++j) kvu[(wr * 64 + m * 16 + fq * 4 + j) * 128 + wc * 64 + n * 16 + fr] = acc[m][n][j];
    }
}

__device__ void ph_h2(const Params& p) {
    for (int it = blockIdx.x * NTHREADS + otid(); it < 16 * 8192; it += gridDim.x * NTHREADS) {
        const int bh = it >> 13, e2 = it & 8191, dv = e2 >> 6, dk = (e2 & 63) * 2;
        const size_t eoff = (size_t)dv * 128 + dk;
        float sx = 0.f, sy = 0.f;
#pragma unroll 8
        for (int c = 0; c < 64; ++c) {
            const size_t u = (size_t)bh * 64 + c;
            *(uint32_t*)(p.sst + u * 16384 + eoff) = pack2(sx, sy);
            const float2 kvv = *(const float2*)(p.kv + u * 16384 + eoff);
            const float2 dc = *(const float2*)(p.dec + u * 128 + dk);
            sx = dc.x * sx + kvv.x; sy = dc.y * sy + kvv.y;
        }
    }
}

__device__ void ph_h3(const Params& p, char* smem) {
    const int tid = otid(), lane = tid & 63, wid = tid >> 6, wr = wid >> 1, wc = wid & 1, fr = lane & 15, fq = lane >> 4;
    char* sQ = smem;
    char* sK = smem + 16384;
    char* sP = smem + 32768;
    float* sL = (float*)(smem + 32768);
    float* totS = (float*)(smem + 65536);
    const int d = tid & 127, half = tid >> 7;
    for (int u = blockIdx.x; u < 1024; u += gridDim.x) {
        const int bh = u >> 6, c = u & 63, b = bh >> 2, h = bh & 3;
        const size_t row0 = (size_t)b * S + c * 64;
        __syncthreads();
#pragma unroll
        for (int i = 0; i < 4; ++i) {
            const int idx = tid + 256 * i, r = idx >> 4, ch = idx & 15;
            *(u32x4*)(sQ + swz16(r, ch)) = *(const u32x4*)(p.proj + (row0 + r) * INW + OFF_HQ + h * 128 + ch * 8);
        }
#pragma unroll
        for (int i = 0; i < 8; ++i) {
            const int idx = tid + 256 * i, r = idx >> 5, c4 = idx & 31;
            *(f32x4*)(sL + r * 128 + c4 * 4) = *(const f32x4*)(p.lgf + (row0 + r) * 512 + h * 128 + c4 * 4);
        }
        __syncthreads();
        const float* lcol = sL + half * 32 * 128 + d;
        float tot = 0.f;
#pragma unroll
        for (int s = 0; s < 32; ++s) tot += lcol[s * 128];
        totS[half * 128 + d] = tot;
        __syncthreads();
        const float t0 = totS[d];
        float run = half ? t0 : 0.f;
#pragma unroll 8
        for (int s = 0; s < 32; ++s) {
            const float lv = lcol[s * 128];
            run += lv;
            const int o = swz16(half * 32 + s, d >> 3) + (d & 7) * 2;
            const float qm = bf2f(*(const bf16_t*)(sQ + o)) * __expf(run - t0);
            const float kh = (1.f - __expf(lv)) * __expf(t0 - run);
            *(bf16_t*)(sQ + o) = f2bf(qm);
            *(bf16_t*)(sK + o) = f2bf(kh);
        }
        __syncthreads();
        {
            f32x4 pa[2][2];
#pragma unroll
            for (int m = 0; m < 2; ++m)
#pragma unroll
                for (int n = 0; n < 2; ++n) pa[m][n] = f32x4{0.f, 0.f, 0.f, 0.f};
#pragma unroll
            for (int ks = 0; ks < 4; ++ks) {
                bf16x8 af[2], bfr[2];
#pragma unroll
                for (int m = 0; m < 2; ++m) af[m] = *(const bf16x8*)(sQ + swz16(wr * 32 + m * 16 + fr, ks * 4 + fq));
#pragma unroll
                for (int n = 0; n < 2; ++n) bfr[n] = *(const bf16x8*)(sK + swz16(wc * 32 + n * 16 + fr, ks * 4 + fq));
#pragma unroll
                for (int m = 0; m < 2; ++m)
#pragma unroll
                    for (int n = 0; n < 2; ++n) pa[m][n] = __builtin_amdgcn_mfma_f32_16x16x32_bf16(af[m], bfr[n], pa[m][n], 0, 0, 0);
            }
#pragma unroll
            for (int m = 0; m < 2; ++m)
#pragma unroll
                for (int n = 0; n < 2; ++n)
#pragma unroll
                    for (int j = 0; j < 4; ++j) {
                        const int t = wr * 32 + m * 16 + fq * 4 + j, s_ = wc * 32 + n * 16 + fr;
                        const float v = (s_ <= t) ? pa[m][n][j] : 0.f;
                        *(bf16_t*)(sP + swz(t, s_ >> 3) + (s_ & 7) * 2) = f2bf(v);
                    }
        }
        __syncthreads();
        f32x4 oa[8];
#pragma unroll
        for (int n = 0; n < 8; ++n) oa[n] = f32x4{0.f, 0.f, 0.f, 0.f};
        const int ch = tid & 7;
#pragma unroll
        for (int sub = 0; sub < 2; ++sub) {
            float sc[8];
#pragma unroll
            for (int j = 0; j < 8; ++j) sc[j] = __expf(totS[sub * 64 + ch * 8 + j]);
#pragma unroll
            for (int i = 0; i < 4; ++i) {
                const int r = (tid + 256 * i) >> 3;
                const u32x4 v = *(const u32x4*)(p.sst + (size_t)u * 16384 + r * 128 + sub * 64 + ch * 8);
                u32x4 w;
                w.x = pack2(__uint_as_float(v.x << 16) * sc[0], __uint_as_float(v.x & 0xffff0000u) * sc[1]);
                w.y = pack2(__uint_as_float(v.y << 16) * sc[2], __uint_as_float(v.y & 0xffff0000u) * sc[3]);
                w.z = pack2(__uint_as_float(v.z << 16) * sc[4], __uint_as_float(v.z & 0xffff0000u) * sc[5]);
                w.w = pack2(__uint_as_float(v.w << 16) * sc[6], __uint_as_float(v.w & 0xffff0000u) * sc[7]);
                *(u32x4*)(sK + swz(r, ch)) = w;
            }
            __syncthreads();
#pragma unroll
            for (int ks = 0; ks < 2; ++ks) {
                const bf16x8 af = *(const bf16x8*)(sQ + swz16(wid * 16 + fr, sub * 8 + ks * 4 + fq));
#pragma unroll
                for (int n = 0; n < 8; ++n) {
                    const bf16x8 bfr = *(const bf16x8*)(sK + swz(n * 16 + fr, ks * 4 + fq));
                    oa[n] = __builtin_amdgcn_mfma_f32_16x16x32_bf16(af, bfr, oa[n], 0, 0, 0);
                }
            }
            __syncthreads();
        }
#pragma unroll
        for (int i = 0; i < 4; ++i) {
            const int idx = tid + 256 * i, r = idx >> 4, c16 = idx & 15;
            *(u32x4*)(sK + swz16(r, c16)) = *(const u32x4*)(p.proj + (row0 + r) * INW + OFF_HI + h * 128 + c16 * 8);
        }
        __syncthreads();
#pragma unroll
        for (int ks = 0; ks < 2; ++ks) {
            const bf16x8 af = *(const bf16x8*)(sP + swz(wid * 16 + fr, ks * 4 + fq));
#pragma unroll
            for (int n = 0; n < 8; ++n) {
                const bf16x8 bfr = tr_frag16(sK, ks, n);
                oa[n] = __builtin_amdgcn_mfma_f32_16x16x32_bf16(af, bfr, oa[n], 0, 0, 0);
            }
        }
        float ss[4] = {0.f, 0.f, 0.f, 0.f};
#pragma unroll
        for (int n = 0; n < 8; ++n)
#pragma unroll
            for (int j = 0; j < 4; ++j) ss[j] += oa[n][j] * oa[n][j];
#pragma unroll
        for (int j = 0; j < 4; ++j) {
            ss[j] += __shfl_xor(ss[j], 1, 64); ss[j] += __shfl_xor(ss[j], 2, 64); ss[j] += __shfl_xor(ss[j], 4, 64); ss[j] += __shfl_xor(ss[j], 8, 64);
        }
#pragma unroll
        for (int j = 0; j < 4; ++j) {
            const size_t row = row0 + wid * 16 + fq * 4 + j;
            const float rstd = rsqrtf(ss[j] * (1.f / 128.f) + RMS_EPS);
#pragma unroll
            for (int n = 0; n < 8; ++n) {
                const int dv = n * 16 + fr;
                const float g = bf2f(p.proj[row * INW + OFF_HG + h * 128 + dv]);
                const float y = oa[n][j] * rstd * p.hg_nw[h * 128 + dv] * (g / (1.f + __expf(-g)));
                p.mixin[row * 768 + h * 128 + dv] = f2bf(y);
            }
        }
    }
}

__device__ __forceinline__ bf16x8 tr_frag8(const char* tile, int ks, int c) {
    const int lane = otid() & 63, g = lane >> 4, q = (lane & 15) >> 2, pp = lane & 3;
    const int r0 = 32 * ks + 8 * g + q, ch = 2 * c + (pp >> 1), bo = 8 * (pp & 1);
    const v4s lo = __builtin_amdgcn_ds_read_tr16_b64_v4i16((LAS v4s*)(tile + swz(r0, ch) + bo));
    const v4s hi = __builtin_amdgcn_ds_read_tr16_b64_v4i16((LAS v4s*)(tile + swz(r0 + 4, ch) + bo));
    return bf16x8{lo[0], lo[1], lo[2], lo[3], hi[0], hi[1], hi[2], hi[3]};
}

__device__ void ph_attn(const Params& p, char* smem) {
    const int tid = otid(), lane = tid & 63, wid = tid >> 6, fr = lane & 15, fq = lane >> 4;
    char* sQ = smem;
    char* sK = smem + 8192;
    char* sP = sK;
    char* sV = smem + 33792;
    float* sBias = (float*)(smem + 58368);
    for (int u = blockIdx.x; u < 3072; u += gridDim.x) {
        const int ti = u & 63, gq = u >> 6, g = gq % 3, bhh = gq / 3, hh = bhh & 3, b = bhh >> 2;
        const int lsh = (g == 0) ? 0 : (g == 1 ? 2 : 4), dl = 1 << lsh;
        const int tpr = (S >> lsh) >> 6;
        const int r = ti / tpr, j0 = (ti % tpr) * 64;
        const bf16_t* base = p.proj + (size_t)b * S * INW + (g * 4 + hh) * 64;
        __syncthreads();
#pragma unroll
        for (int i = 0; i < 2; ++i) {
            const int idx = tid + 256 * i, row = idx >> 3, ch = idx & 7;
            const int tok = (j0 + row) * dl + r;
            *(u32x4*)(sQ + swz(row, ch)) = *(const u32x4*)(base + (size_t)tok * INW + OFF_AQ + ch * 8);
        }
#pragma unroll
        for (int i = 0; i < 6; ++i) {
            const int idx = tid + 256 * i, row = idx >> 3, ch = idx & 7;
            const int j = j0 - 128 + row;
            u32x4 kx = {0u, 0u, 0u, 0u}, vx = {0u, 0u, 0u, 0u};
            if (j >= 0) {
                const size_t o = (size_t)(j * dl + r) * INW + ch * 8;
                kx = *(const u32x4*)(base + o + OFF_AK);
                vx = *(const u32x4*)(base + o + OFF_AV);
            }
            *(u32x4*)(sK + swz(row, ch)) = kx;
            *(u32x4*)(sV + swz(row, ch)) = vx;
        }
        if (tid < 129) sBias[tid] = p.biasT[(g * 129 + tid) * 4 + hh];
        __syncthreads();
        f32x4 sa[12];
#pragma unroll
        for (int n = 0; n < 12; ++n) sa[n] = f32x4{0.f, 0.f, 0.f, 0.f};
#pragma unroll
        for (int ks = 0; ks < 2; ++ks) {
            const bf16x8 af = *(const bf16x8*)(sQ + swz(wid * 16 + fr, ks * 4 + fq));
#pragma unroll
            for (int n = 0; n < 12; ++n) {
                const bf16x8 bfr = *(const bf16x8*)(sK + swz(n * 16 + fr, ks * 4 + fq));
                sa[n] = __builtin_amdgcn_mfma_f32_16x16x32_bf16(af, bfr, sa[n], 0, 0, 0);
            }
        }
        float mx[4] = {-INFINITY, -INFINITY, -INFINITY, -INFINITY};
#pragma unroll
        for (int n = 0; n < 12; ++n)
#pragma unroll
            for (int j = 0; j < 4; ++j) {
                const int jj = wid * 16 + fq * 4 + j, kk = n * 16 + fr, m = jj + 128 - kk;
                const bool valid = (m >= 0) && (m <= 128) && (j0 - 128 + kk >= 0);
                const int mc = m < 0 ? 0 : (m > 128 ? 128 : m);
                const float v = valid ? sa[n][j] * 0.125f + sBias[mc] : -INFINITY;
                sa[n][j] = v;
                mx[j] = fmaxf(mx[j], v);
            }
#pragma unroll
        for (int j = 0; j < 4; ++j) {
            mx[j] = fmaxf(mx[j], __shfl_xor(mx[j], 1, 64)); mx[j] = fmaxf(mx[j], __shfl_xor(mx[j], 2, 64));
            mx[j] = fmaxf(mx[j], __shfl_xor(mx[j], 4, 64)); mx[j] = fmaxf(mx[j], __shfl_xor(mx[j], 8, 64));
        }
        float ls[4] = {0.f, 0.f, 0.f, 0.f};
#pragma unroll
        for (int n = 0; n < 12; ++n)
#pragma unroll
            for (int j = 0; j < 4; ++j) { const float pe = __expf(sa[n][j] - mx[j]); sa[n][j] = pe; ls[j] += pe; }
#pragma unroll
        for (int j = 0; j < 4; ++j) {
            ls[j] += __shfl_xor(ls[j], 1, 64); ls[j] += __shfl_xor(ls[j], 2, 64); ls[j] += __shfl_xor(ls[j], 4, 64); ls[j] += __shfl_xor(ls[j], 8, 64);
        }
        __syncthreads();
#pragma unroll
        for (int n = 0; n < 12; ++n)
#pragma unroll
            for (int j = 0; j < 4; ++j) *(bf16_t*)(sP + (wid * 16 + fq * 4 + j) * 400 + (n * 16 + fr) * 2) = f2bf(sa[n][j]);
        f32x4 oa[4];
#pragma unroll
        for (int n = 0; n < 4; ++n) oa[n] = f32x4{0.f, 0.f, 0.f, 0.f};
#pragma unroll
        for (int ks = 0; ks < 6; ++ks) {
            const bf16x8 af = *(const bf16x8*)(sP + (wid * 16 + fr) * 400 + (ks * 4 + fq) * 16);
#pragma unroll
            for (int n = 0; n < 4; ++n) {
                const bf16x8 bfr = tr_frag8(sV, ks, n);
                oa[n] = __builtin_amdgcn_mfma_f32_16x16x32_bf16(af, bfr, oa[n], 0, 0, 0);
            }
        }
#pragma unroll
        for (int j = 0; j < 4; ++j) {
            const int jj = wid * 16 + fq * 4 + j;
            const size_t row = (size_t)g * T + (size_t)b * S + (j0 + jj) * dl + r;
            const float inv = 1.f / ls[j];
#pragma unroll
            for (int n = 0; n < 4; ++n) p.ao[row * 256 + hh * 64 + n * 16 + fr] = oa[n][j] * inv;
            if (fr == 0) p.alse[row * 4 + hh] = mx[j] + __logf(ls[j]);
        }
    }
}

__device__ void ph_attn_merge(const Params& p) {
    const int tid = otid(), lane = tid & 63, wid = tid >> 6;
    for (int row = blockIdx.x * 4 + wid; row < T; row += gridDim.x * 4) {
        const int hh = lane >> 4;
        const float l0 = p.alse[((size_t)0 * T + row) * 4 + hh], l1 = p.alse[((size_t)1 * T + row) * 4 + hh], l2 = p.alse[((size_t)2 * T + row) * 4 + hh];
        const float mxl = fmaxf(l0, fmaxf(l1, l2));
        float e0 = __expf(l0 - mxl), e1 = __expf(l1 - mxl), e2 = __expf(l2 - mxl);
        const float inv = 1.f / (e0 + e1 + e2);
        e0 *= inv; e1 *= inv; e2 *= inv;
        const f32x4 a0 = *(const f32x4*)(p.ao + ((size_t)0 * T + row) * 256 + lane * 4);
        const f32x4 a1 = *(const f32x4*)(p.ao + ((size_t)1 * T + row) * 256 + lane * 4);
        const f32x4 a2 = *(const f32x4*)(p.ao + ((size_t)2 * T + row) * 256 + lane * 4);
        uint2 o;
        o.x = pack2(a0[0] * e0 + a1[0] * e1 + a2[0] * e2, a0[1] * e0 + a1[1] * e1 + a2[1] * e2);
        o.y = pack2(a0[2] * e0 + a1[2] * e1 + a2[2] * e2, a0[3] * e0 + a1[3] * e1 + a2[3] * e2);
        *(uint2*)(p.mixin + (size_t)row * 768 + 512 + lane * 4) = o;
    }
}

__device__ void ph_outproj(const Params& p, char* smem) {
    const int tid = otid(), lane = tid & 63, wid = tid >> 6, wr = wid >> 1, wc = wid & 1, fr = lane & 15, fq = lane >> 4;
    for (int u = blockIdx.x; u < (T / 128) * 8; u += gridDim.x) {
        const int mt = u >> 3, nt = u & 7;
        const bf16_t* A = p.mixin + (size_t)mt * 128 * 768;
        const float* W = p.w_out + nt * 128;
        f32x4 acc[4][4];
        gemm_tile(smem, 768, [&](int r) { return A + (size_t)r * 768; }, [&](int n) { return W + n; }, D, acc);
        const int b = (mt * 128) >> 12;
        const float* g1 = p.mod + b * 6144 + 2048;
#pragma unroll
        for (int m = 0; m < 4; ++m)
#pragma unroll
            for (int n = 0; n < 4; ++n) {
                const int col = nt * 128 + wc * 64 + n * 16 + fr;
                const float gg = g1[col];
#pragma unroll
                for (int j = 0; j < 4; ++j) {
                    const size_t row = (size_t)mt * 128 + wr * 64 + m * 16 + fq * 4 + j;
                    p.pre1[row * D + col] = ALPHA * p.x[row * D + col] + gg * acc[m][n][j];
                }
            }
    }
}

__device__ void ph_ln1(const Params& p) {
    const int tid = otid(), lane = tid & 63, wid = tid >> 6;
    for (int row = blockIdx.x * 4 + wid; row < T; row += gridDim.x * 4) {
        const float4* xr = (const float4*)(p.pre1 + (size_t)row * D);
        float4 v[4];
        float s = 0.f;
#pragma unroll
        for (int i = 0; i < 4; ++i) { v[i] = xr[lane + 64 * i]; s += v[i].x + v[i].y + v[i].z + v[i].w; }
        float mean = wave_sum(s) * (1.f / D);
        float q = 0.f;
#pragma unroll
        for (int i = 0; i < 4; ++i) {
            v[i].x -= mean; v[i].y -= mean; v[i].z -= mean; v[i].w -= mean;
            q += v[i].x * v[i].x + v[i].y * v[i].y + v[i].z * v[i].z + v[i].w * v[i].w;
        }
        float rstd = rsqrtf(wave_sum(q) * (1.f / D) + LN_EPS);
        s = 0.f;
#pragma unroll
        for (int i = 0; i < 4; ++i) {
            const int col = (lane + 64 * i) * 4;
            const float4 g4 = *(const float4*)(p.ln1_g + col), b4 = *(const float4*)(p.ln1_b + col);
            v[i].x = v[i].x * rstd * g4.x + b4.x; v[i].y = v[i].y * rstd * g4.y + b4.y;
            v[i].z = v[i].z * rstd * g4.z + b4.z; v[i].w = v[i].w * rstd * g4.w + b4.w;
            *(float4*)(p.x1 + (size_t)row * D + col) = v[i];
            s += v[i].x + v[i].y + v[i].z + v[i].w;
        }
        mean = wave_sum(s) * (1.f / D);
        q = 0.f;
#pragma unroll
        for (int i = 0; i < 4; ++i) {
            v[i].x -= mean; v[i].y -= mean; v[i].z -= mean; v[i].w -= mean;
            q += v[i].x * v[i].x + v[i].y * v[i].y + v[i].z * v[i].z + v[i].w * v[i].w;
        }
        rstd = rsqrtf(wave_sum(q) * (1.f / D) + LN_EPS);
        const int b = row >> 12;
        const float* sh = p.mod + b * 6144 + 3072;
        const float* sc = sh + 1024;
#pragma unroll
        for (int i = 0; i < 4; ++i) {
            const int col = (lane + 64 * i) * 4;
            const float4 s4 = *(const float4*)(sc + col), h4 = *(const float4*)(sh + col);
            float4 y;
            y.x = v[i].x * rstd * (1.f + s4.x) + h4.x; y.y = v[i].y * rstd * (1.f + s4.y) + h4.y;
            y.z = v[i].z * rstd * (1.f + s4.z) + h4.z; y.w = v[i].w * rstd * (1.f + s4.w) + h4.w;
            uint2 o;
            o.x = pack2(y.x, y.y); o.y = pack2(y.z, y.w);
            *(uint2*)(p.h2 + (size_t)row * 2048 + col) = o;
            uint2 o2;
            o2.x = pack2(y.x - __uint_as_float(o.x << 16), y.y - __uint_as_float(o.x & 0xffff0000u));
            o2.y = pack2(y.z - __uint_as_float(o.y << 16), y.w - __uint_as_float(o.y & 0xffff0000u));
            *(uint2*)(p.h2 + (size_t)row * 2048 + 1024 + col) = o2;
        }
    }
}

__device__ void ph_router_gemm(const Params& p, char* smem) {
    const int tid = otid(), lane = tid & 63, wid = tid >> 6, wr = wid >> 1, wc = wid & 1, fr = lane & 15, fq = lane >> 4;
    for (int u = blockIdx.x; u < 768; u += gridDim.x) {
        const int pass = u >> 8, mt = (u & 255) >> 1, nt = u & 1;
        const bf16_t* A = p.h2 + (size_t)mt * 128 * 2048 + (pass == 1 ? 1024 : 0);
        const float* W = p.wr2 + (pass == 2 ? 262144 : 0) + nt * 128;
        f32x4 acc[4][4];
        gemm_tile(smem, D, [&](int r) { return A + (size_t)r * 2048; }, [&](int n) { return W + n; }, NE, acc);
        float* out = p.lgp + (size_t)pass * T * NE;
#pragma unroll
        for (int m = 0; m < 4; ++m)
#pragma unroll
            for (int n = 0; n < 4; ++n)
#pragma unroll
                for (int j = 0; j < 4; ++j)
                    out[(size_t)(mt * 128 + wr * 64 + m * 16 + fq * 4 + j) * NE + nt * 128 + wc * 64 + n * 16 + fr] = acc[m][n][j];
    }
}

__device__ void ph_topk(const Params& p) {
    const int tid = otid(), lane = tid & 63, wid = tid >> 6;
    for (int tok = blockIdx.x * 4 + wid; tok < T; tok += gridDim.x * 4) {
        float sc[4], bv[4];
#pragma unroll
        for (int j = 0; j < 4; ++j) {
            const int e = j * 64 + lane;
            const size_t o = (size_t)tok * NE + e;
            const float x = (p.lgp[o] + p.lgp[(size_t)T * NE + o]) + p.lgp[(size_t)2 * T * NE + o];
            sc[j] = 1.f / (1.f + expf(-x));
            bv[j] = sc[j] + p.router_bias[e];
        }
        float gsum[4];
#pragma unroll
        for (int j = 0; j < 4; ++j) {
            float m1 = bv[j];
#pragma unroll
            for (int o = 16; o > 0; o >>= 1) m1 = fmaxf(m1, __shfl_xor(m1, o, 64));
            const unsigned long long bal = __ballot(bv[j] == m1);
            const unsigned hm = (unsigned)(bal >> (lane & 32));
            const int first = __ffs(hm) - 1;
            float m2 = ((lane & 31) == first) ? -INFINITY : bv[j];
#pragma unroll
            for (int o = 16; o > 0; o >>= 1) m2 = fmaxf(m2, __shfl_xor(m2, o, 64));
            gsum[j] = m1 + m2;
        }
        float gs[8];
#pragma unroll
        for (int j = 0; j < 4; ++j) { gs[2 * j] = __shfl(gsum[j], 0, 64); gs[2 * j + 1] = __shfl(gsum[j], 32, 64); }
        unsigned gmask = 0u;
#pragma unroll
        for (int r = 0; r < 4; ++r) {
            float best = -INFINITY; int bi = 0;
#pragma unroll
            for (int g = 0; g < 8; ++g) {
                const bool ok = (((gmask >> g) & 1u) == 0u) && (gs[g] > best);
                if (ok) { best = gs[g]; bi = g; }
            }
            gmask |= 1u << bi;
        }
        float cand[4];
#pragma unroll
        for (int j = 0; j < 4; ++j) cand[j] = ((gmask >> (2 * j + (lane >> 5))) & 1u) ? bv[j] : -INFINITY;
        float wsum = 0.f, myw = 0.f;
        int mye = 0;
#pragma unroll
        for (int r = 0; r < 8; ++r) {
            float bvv = cand[0]; int be = lane;
#pragma unroll
            for (int j = 1; j < 4; ++j) if (cand[j] > bvv) { bvv = cand[j]; be = j * 64 + lane; }
#pragma unroll
            for (int o = 32; o > 0; o >>= 1) {
                const float ov = __shfl_xor(bvv, o, 64);
                const int oe = __shfl_xor(be, o, 64);
                if (ov > bvv || (ov == bvv && oe < be)) { bvv = ov; be = oe; }
            }
            const int bj = be >> 6;
            const float mysc = bj == 0 ? sc[0] : (bj == 1 ? sc[1] : (bj == 2 ? sc[2] : sc[3]));
            const float sval = __shfl(mysc, be & 63, 64);
#pragma unroll
            for (int j = 0; j < 4; ++j) if (be == j * 64 + lane) cand[j] = -INFINITY;
            wsum += sval;
            if (lane == r) { myw = sval; mye = be; }
        }
        if (lane < 8) {
            const int a = tok * 8 + lane;
            p.topi[a] = mye;
            p.topw[a] = myw * (2.5f / wsum);
            const int pos = atomicAdd(&p.cnt[mye], 1);
            p.list[(size_t)mye * T + pos] = a;
        }
    }
}

struct ExpMap { int* cnt; int* off; int* tile; };
__device__ __forceinline__ ExpMap exp_map(const Params& p, char* smem) {
    ExpMap m;
    m.cnt = (int*)(smem + 32768); m.off = m.cnt + 256; m.tile = m.off + 256;
    const int tid = otid();
    __syncthreads();
    m.cnt[tid] = p.cnt[tid];
    __syncthreads();
    if (tid == 0) {
        int off = 0, tl = 0;
        for (int e = 0; e < NE; ++e) { m.off[e] = off; m.tile[e] = tl; const int c = m.cnt[e]; off += c; tl += (c + 127) >> 7; }
        m.tile[NE] = tl;
    }
    __syncthreads();
    return m;
}
__device__ __forceinline__ int find_expert(const int* tile, int rt) {
    int lo = 0, hi = NE;
    while (hi - lo > 1) { const int mid = (lo + hi) >> 1; if (tile[mid] <= rt) lo = mid; else hi = mid; }
    return lo;
}

__device__ void ph_gateup(const Params& p, char* smem) {
    const int tid = otid(), lane = tid & 63, wid = tid >> 6, wr = wid >> 1, wc = wid & 1, fr = lane & 15, fq = lane >> 4;
    const ExpMap em = exp_map(p, smem);
    const int ntile = em.tile[NE];
    for (int u = blockIdx.x; u < (ntile + T / 128) * 4; u += gridDim.x) {
        const int rt = u >> 2, nt = u & 3, c0 = nt * 64;
        f32x4 acc[4][4];
        if (rt < ntile) {
            const int e = find_expert(em.tile, rt);
            const int r0 = (rt - em.tile[e]) * 128, ne = em.cnt[e];
            const int* lst = p.list + (size_t)e * T;
            const float* Wg = p.w_eg + (size_t)e * D * ED;
            const float* Wu = p.w_eu + (size_t)e * D * ED;
            gemm_tile(smem, D,
                      [&](int r) { const int rr = r0 + r; const int a = lst[rr < ne ? rr : 0]; return p.h2 + (size_t)(a >> 3) * 2048; },
                      [&](int n) { const int t16 = n >> 4; return ((t16 & 1) ? Wu : Wg) + c0 + 16 * (t16 >> 1) + (n & 15); },
                      ED, acc);
            const size_t gbase = (size_t)em.off[e];
#pragma unroll
            for (int m = 0; m < 4; ++m)
#pragma unroll
                for (int n = 0; n < 4; n += 2) {
                    const int col = c0 + 16 * (2 * wc + (n >> 1)) + fr;
#pragma unroll
                    for (int j = 0; j < 4; ++j) {
                        const int rr = r0 + wr * 64 + m * 16 + fq * 4 + j;
                        if (rr < ne) {
                            const float g = acc[m][n][j], uu = acc[m][n + 1][j];
                            p.gbuf[(gbase + rr) * ED + col] = f2bf(g / (1.f + __expf(-g)) * uu);
                        }
                    }
                }
        } else {
            const int tb = (rt - ntile) * 128;
            const bf16_t* A = p.h2 + (size_t)tb * 2048;
            gemm_tile(smem, D,
                      [&](int r) { return A + (size_t)r * 2048; },
                      [&](int n) { const int t16 = n >> 4; return ((t16 & 1) ? p.w_su : p.w_sg) + c0 + 16 * (t16 >> 1) + (n & 15); },
                      ED, acc);
#pragma unroll
            for (int m = 0; m < 4; ++m)
#pragma unroll
                for (int n = 0; n < 4; n += 2) {
                    const int col = c0 + 16 * (2 * wc + (n >> 1)) + fr;
#pragma unroll
                    for (int j = 0; j < 4; ++j) {
                        const int row = tb + wr * 64 + m * 16 + fq * 4 + j;
                        const float g = acc[m][n][j], uu = acc[m][n + 1][j];
                        p.gsh[(size_t)row * ED + col] = f2bf(g / (1.f + __expf(-g)) * uu);
                    }
                }
        }
    }
}

__device__ void ph_down(const Params& p, char* smem) {
    const int tid = otid(), lane = tid & 63, wid = tid >> 6, wr = wid >> 1, wc = wid & 1, fr = lane & 15, fq = lane >> 4;
    const ExpMap em = exp_map(p, smem);
    const int ntile = em.tile[NE];
    for (int u = blockIdx.x; u < (ntile + T / 128) * 8; u += gridDim.x) {
        const int rt = u >> 3, nt = u & 7;
        f32x4 acc[4][4];
        if (rt < ntile) {
            const int e = find_expert(em.tile, rt);
            const int r0 = (rt - em.tile[e]) * 128, ne = em.cnt[e];
            const int* lst = p.list + (size_t)e * T;
            const bf16_t* A = p.gbuf + (size_t)em.off[e] * ED;
            const float* W = p.w_ed + (size_t)e * ED * D + nt * 128;
            gemm_tile(smem, ED,
                      [&](int r) { const int rr = r0 + r; return A + (size_t)(rr < ne ? rr : 0) * ED; },
                      [&](int n) { return W + n; }, D, acc);
#pragma unroll
            for (int m = 0; m < 4; ++m)
#pragma unroll
                for (int j = 0; j < 4; ++j) {
                    const int rr = r0 + wr * 64 + m * 16 + fq * 4 + j;
                    if (rr < ne) {
                        const int a = lst[rr];
                        const float w = p.topw[a];
                        bf16_t* yr = p.ybuf + ((size_t)(a >> 3) * 9 + (a & 7)) * D + nt * 128 + wc * 64 + fr;
#pragma unroll
                        for (int n = 0; n < 4; ++n) yr[n * 16] = f2bf(acc[m][n][j] * w);
                    }
                }
        } else {
            const int tb = (rt - ntile) * 128;
            const bf16_t* A = p.gsh + (size_t)tb * ED;
            const float* W = p.w_sd + nt * 128;
            gemm_tile(smem, ED, [&](int r) { return A + (size_t)r * ED; }, [&](int n) { return W + n; }, D, acc);
#pragma unroll
            for (int m = 0; m < 4; ++m)
#pragma unroll
                for (int j = 0; j < 4; ++j) {
                    const int row = tb + wr * 64 + m * 16 + fq * 4 + j;
                    bf16_t* yr = p.ybuf + ((size_t)row * 9 + 8) * D + nt * 128 + wc * 64 + fr;
#pragma unroll
                    for (int n = 0; n < 4; ++n) yr[n * 16] = f2bf(acc[m][n][j]);
                }
        }
    }
}

__device__ void ph_final(const Params& p) {
    const int tid = otid(), lane = tid & 63, wid = tid >> 6;
    for (int row = blockIdx.x * 4 + wid; row < T; row += gridDim.x * 4) {
        const int b = row >> 12;
        const float* g2 = p.mod + b * 6144 + 5120;
        float4 v[4];
        float s = 0.f;
#pragma unroll
        for (int i = 0; i < 4; ++i) {
            const int col = (lane + 64 * i) * 4;
            float f0 = 0.f, f1 = 0.f, f2 = 0.f, f3 = 0.f;
#pragma unroll
            for (int k = 0; k < 9; ++k) {
                const uint2 w = *(const uint2*)(p.ybuf + ((size_t)row * 9 + k) * D + col);
                f0 += __uint_as_float(w.x << 16); f1 += __uint_as_float(w.x & 0xffff0000u);
                f2 += __uint_as_float(w.y << 16); f3 += __uint_as_float(w.y & 0xffff0000u);
            }
            const float4 xv = *(const float4*)(p.x1 + (size_t)row * D + col);
            const float4 g4 = *(const float4*)(g2 + col);
            v[i].x = ALPHA * xv.x + g4.x * f0; v[i].y = ALPHA * xv.y + g4.y * f1;
            v[i].z = ALPHA * xv.z + g4.z * f2; v[i].w = ALPHA * xv.w + g4.w * f3;
            s += v[i].x + v[i].y + v[i].z + v[i].w;
        }
        const float mean = wave_sum(s) * (1.f / D);
        float q = 0.f;
#pragma unroll
        for (int i = 0; i < 4; ++i) {
            v[i].x -= mean; v[i].y -= mean; v[i].z -= mean; v[i].w -= mean;
            q += v[i].x * v[i].x + v[i].y * v[i].y + v[i].z * v[i].z + v[i].w * v[i].w;
        }
        const float rstd = rsqrtf(wave_sum(q) * (1.f / D) + LN_EPS);
#pragma unroll
        for (int i = 0; i < 4; ++i) {
            const int col = (lane + 64 * i) * 4;
            const float4 g4 = *(const float4*)(p.ln2_g + col), b4 = *(const float4*)(p.ln2_b + col);
            float4 y;
            y.x = v[i].x * rstd * g4.x + b4.x; y.y = v[i].y * rstd * g4.y + b4.y;
            y.z = v[i].z * rstd * g4.z + b4.z; y.w = v[i].w * rstd * g4.w + b4.w;
            *(float4*)(p.out + (size_t)row * D + col) = y;
        }
    }
}

constexpr int LDS_BYTES = 67584;
constexpr int NPHASE = 13;

template <int PH>
__device__ __forceinline__ void run_phase(const Params& p, char* smem) {
    if (PH == 0) ph_mod(p, smem);
    if (PH == 1) ph_ln0(p);
    if (PH == 2) ph_inproj(p, smem);
    if (PH == 3) { ph_h1(p, smem); ph_attn(p, smem); }
    if (PH == 4) { ph_h2(p); ph_attn_merge(p); }
    if (PH == 5) ph_h3(p, smem);
    if (PH == 6) ph_outproj(p, smem);
    if (PH == 7) ph_ln1(p);
    if (PH == 8) ph_router_gemm(p, smem);
    if (PH == 9) ph_topk(p);
    if (PH == 10) ph_gateup(p, smem);
    if (PH == 11) ph_down(p, smem);
    if (PH == 12) ph_final(p);
}

template <int PH>
__global__ void __launch_bounds__(NTHREADS, 2) k_phase(Params p) {
    extern __shared__ __attribute__((aligned(16))) char smem[];
    run_phase<PH>(p, smem);
}

__global__ void __launch_bounds__(NTHREADS, 2) k_all(Params p) {
    extern __shared__ __attribute__((aligned(16))) char smem[];
    volatile LAS unsigned* st = (volatile LAS unsigned*)(smem + LDS_BYTES - 16);
    if (threadIdx.x == 0) { st[0] = 0u; st[1] = 0u; st[2] = 0u; st[3] = 0u; }
    __syncthreads();
    XcdBarrier bar = xcd_barrier_post(p.bar, st);
    run_phase<0>(p, smem); xcd_barrier(bar);
    run_phase<1>(p, smem); xcd_barrier(bar);
    run_phase<2>(p, smem); xcd_barrier(bar);
    run_phase<3>(p, smem); xcd_barrier(bar);
    run_phase<4>(p, smem); xcd_barrier(bar);
    run_phase<5>(p, smem); xcd_barrier(bar);
    run_phase<6>(p, smem); xcd_barrier(bar);
    run_phase<7>(p, smem); xcd_barrier(bar);
    run_phase<8>(p, smem); xcd_barrier(bar);
    run_phase<9>(p, smem); xcd_barrier(bar);
    run_phase<10>(p, smem); xcd_barrier(bar);
    run_phase<11>(p, smem); xcd_barrier(bar);
    run_phase<12>(p, smem);
}

template <int PH>
static void launch_phase(const Params& p, int grid, hipStream_t stream) {
    hipLaunchKernelGGL(k_phase<PH>, dim3(grid), dim3(NTHREADS), LDS_BYTES, stream, p);
}

extern "C" void kernel_launch(void* const* d_in, const int* in_sizes, int n_in, void* d_out, int out_size, void* d_ws, size_t ws_size,
                              hipStream_t stream) {
    (void)in_sizes; (void)n_in; (void)out_size;
    Params p{};
    const float** pin = (const float**)&p.x;
    for (int i = 0; i < 21; ++i) pin[i] = (const float*)d_in[i];
    p.out = (float*)d_out;
    char* ws = (char*)d_ws;
    size_t off = 0;
    auto carve = [&](size_t bytes) { char* r = ws + off; off += (bytes + 255) & ~(size_t)255; return r; };
    char* ctl = carve(65536);
    p.bar = (unsigned*)ctl;
    p.cnt = (int*)(ctl + 16384);
    p.mod = (float*)carve(4 * 6144 * 4);
    p.lbv = (float*)carve(512 * 4);
    p.biasT = (float*)carve(3 * 129 * 4 * 4);
    p.h1 = (bf16_t*)carve((size_t)T * D * 2);
    p.proj = (bf16_t*)carve((size_t)T * INW * 2);
    p.lgf = (float*)carve((size_t)T * 512 * 4);
    p.ao = (float*)carve((size_t)3 * T * 256 * 4);
    p.alse = (float*)carve((size_t)3 * T * 4 * 4);
    p.mixin = (bf16_t*)carve((size_t)T * 768 * 2);
    p.pre1 = (float*)carve((size_t)T * D * 4);
    p.x1 = (float*)carve((size_t)T * D * 4);
    p.h2 = (bf16_t*)carve((size_t)T * 2048 * 2);
    p.wr2 = (float*)carve((size_t)2 * D * NE * 4);
    p.lgp = (float*)carve((size_t)3 * T * NE * 4);
    p.topi = (int*)carve((size_t)T * 8 * 4);
    p.topw = (float*)carve((size_t)T * 8 * 4);
    p.list = (int*)carve((size_t)NE * T * 4);
    p.gbuf = (bf16_t*)carve((size_t)T * TOPK * ED * 2);
    p.gsh = (bf16_t*)carve((size_t)T * ED * 2);
    p.ybuf = (bf16_t*)carve((size_t)T * 9 * D * 2);
    p.kv = (float*)p.ybuf;
    p.sst = (bf16_t*)((char*)p.ybuf + (size_t)1024 * 16384 * 4);
    p.dec = (float*)carve((size_t)1024 * 128 * 4);
    if (off > ws_size) { fprintf(stderr, "kernel_launch: workspace too small: need %zu have %zu\n", off, ws_size); return; }

    static int grid = 0;
    if (grid == 0) {
        int dev = 0, cus = 0, per_cu = 0;
        hipGetDevice(&dev);
        hipDeviceGetAttribute(&cus, hipDeviceAttributeMultiprocessorCount, dev);
        hipFuncSetAttribute((const void*)k_all, hipFuncAttributeMaxDynamicSharedMemorySize, LDS_BYTES);
        hipOccupancyMaxActiveBlocksPerMultiprocessor(&per_cu, (const void*)k_all, NTHREADS, LDS_BYTES);
        if (per_cu < 1) per_cu = 1;
        grid = cus * (per_cu < 2 ? per_cu : 2);
        fprintf(stderr, "kernel_launch: cus %d per_cu %d grid %d ws need %zu have %zu\n", cus, per_cu, grid, off, ws_size);
    }
    hipMemsetAsync(ctl, 0, 65536, stream);
#if ONE_LAUNCH
    hipLaunchKernelGGL(k_all, dim3(grid), dim3(NTHREADS), LDS_BYTES, stream, p);
#else
    launch_phase<0>(p, grid, stream); launch_phase<1>(p, grid, stream); launch_phase<2>(p, grid, stream); launch_phase<3>(p, grid, stream);
    launch_phase<4>(p, grid, stream); launch_phase<5>(p, grid, stream); launch_phase<6>(p, grid, stream); launch_phase<7>(p, grid, stream);
    launch_phase<8>(p, grid, stream); launch_phase<9>(p, grid, stream); launch_phase<10>(p, grid, stream); launch_phase<11>(p, grid, stream); launch_phase<12>(p, grid, stream);
#endif
}
```

```cpp
#include <hip/hip_runtime.h>
#include <stdint.h>
#include <stdio.h>

#ifndef ONE_LAUNCH
#define ONE_LAUNCH 1
#endif

constexpr int D = 1024, NBATCH = 4, S = 4096, T = NBATCH * S;
constexpr int INW = 4352;
constexpr int NE = 256, TOPK = 8, ED = 256;
constexpr int OFF_HQ = 0, OFF_HF = 512, OFF_HI = 1024, OFF_HG = 1536, OFF_AQ = 2048, OFF_AK = 2816, OFF_AV = 3584;
constexpr float ALPHA = 1.189207115002721f;
constexpr float LN_EPS = 1e-5f, RMS_EPS = 1e-6f;
constexpr int NTHREADS = 256;

typedef unsigned short bf16_t;
using bf16x8 = __attribute__((ext_vector_type(8))) short;
using f32x4 = __attribute__((ext_vector_type(4))) float;
using u32x4 = __attribute__((ext_vector_type(4))) unsigned int;

typedef float v2f_t __attribute__((ext_vector_type(2)));
typedef __bf16 v2bf_t __attribute__((ext_vector_type(2)));
typedef short v4s __attribute__((ext_vector_type(4)));
__device__ __forceinline__ unsigned short f2bf(float f) { return __builtin_bit_cast(unsigned short, (__bf16)f); }
__device__ __forceinline__ float bf2f(unsigned short h) { return __uint_as_float(((uint32_t)h) << 16); }
__device__ __forceinline__ uint32_t pack2(float a, float b) {
    const v2f_t f = {a, b};
    return __builtin_bit_cast(uint32_t, __builtin_convertvector(f, v2bf_t));
}
__device__ __forceinline__ float sigmoidf_(float v) { return 1.f / (1.f + __expf(-v)); }

__device__ __forceinline__ int otid() { int t = threadIdx.x; asm volatile("" : "+v"(t)); return t; }

struct Params {
    const float *x, *c, *w_ada, *b_ada, *w_in, *hg_lb, *hg_nw, *rel_bias, *w_out, *ln1_g, *ln1_b, *w_router, *router_bias,
        *w_eg, *w_eu, *w_ed, *w_sg, *w_su, *w_sd, *ln2_g, *ln2_b;
    float* out;
    unsigned* bar;
    int* cnt;
    float* mod;
    float* lbv;
    float* biasT;
    bf16_t* h1;
    bf16_t* proj;
    float* lgf;
    float* ao;
    float* alse;
    bf16_t* mixin;
    float* pre1;
    float* x1;
    bf16_t* h2;
    float* wr2;
    float* lgp;
    int* topi;
    float* topw;
    int* list;
    bf16_t* gbuf;
    bf16_t* gsh;
    bf16_t* ybuf;
    float* kv;
    float* dec;
    bf16_t* sst;
};

#define XB_TMO      128
#define XB_XCNT(j)  (256  + 64 * (j))
#define XB_XSUB(j)  (1280 + 64 * (j))
#define XB_XGEN(j)  (2304 + 64 * (j))
#define XB_TOP      3328
#define XB_TOPGEN   3392
#define XCD_BAR_WORDS 3456
#define XB_SPIN_CAP (1u << 18)
#define LAS __attribute__((address_space(3)))

__device__ __forceinline__ unsigned xb_ld(unsigned* p)              { return __hip_atomic_load(p, __ATOMIC_RELAXED, __HIP_MEMORY_SCOPE_AGENT); }
__device__ __forceinline__ unsigned xb_add(unsigned* p, unsigned v) { return __hip_atomic_fetch_add(p, v, __ATOMIC_RELAXED, __HIP_MEMORY_SCOPE_AGENT); }
__device__ __forceinline__ unsigned xb_xcc_id() { return (unsigned)__builtin_amdgcn_s_getreg((3 << 11) | 20) & 0xFu; }
#define XB_SPIN(cond, bar) do { unsigned _sp = 0; while (cond) { __builtin_amdgcn_s_sleep(1); \
    if ((++_sp & 255u) == 0u) { if (xb_ld(&(bar)[XB_TMO])) break; if (_sp > XB_SPIN_CAP) { atomicAdd(&(bar)[XB_TMO], 1u); break; } } } } while (0)

struct XcdBarrier {
    unsigned* bar; unsigned x;
    volatile LAS unsigned* st;
};
__device__ __forceinline__ XcdBarrier xcd_barrier_post(unsigned* bar, volatile LAS unsigned* st) {
    XcdBarrier b; b.bar = bar; b.x = xb_xcc_id(); b.st = st;
    if (threadIdx.x == 0) (void)xb_add(&bar[XB_XCNT(b.x)], 1u);
    return b;
}
__device__ __forceinline__ void xcd_barrier_complete(unsigned* bar, unsigned x, unsigned& nloc, unsigned& nx) {
    const unsigned G = gridDim.x * gridDim.y * gridDim.z;
    unsigned sum, cnt, mine, sp = 0u;
    for (;;) {
        sum = 0u; cnt = 0u; mine = 0u;
#pragma unroll
        for (unsigned j = 0; j < 16; ++j) { const unsigned c = xb_ld(&bar[XB_XCNT(j)]); sum += c; cnt += (c > 0u) ? 1u : 0u; mine = (j == x) ? c : mine; }
        if (sum == G) break;
        __builtin_amdgcn_s_sleep(1);
        if ((++sp & 255u) == 0u) { if (xb_ld(&bar[XB_TMO])) break; if (sp > XB_SPIN_CAP) { atomicAdd(&bar[XB_TMO], 1u); break; } }
    }
    nloc = mine > 0u ? mine : 1u; nx = cnt > 0u ? cnt : 1u;
}
__device__ __forceinline__ void xcd_barrier(const XcdBarrier& b) {
    asm volatile("s_waitcnt vmcnt(0)" ::: "memory");
    __syncthreads();
    if (threadIdx.x == 0) {
        unsigned* bar = b.bar;
        __builtin_amdgcn_s_waitcnt(0);
        unsigned nloc = b.st[0], nx = b.st[1];
        if (nloc == 0u) { xcd_barrier_complete(bar, b.x, nloc, nx); b.st[0] = nloc; b.st[1] = nx; }
        const unsigned old = xb_add(&bar[XB_XSUB(b.x)], 1u);
        const unsigned gen = old / nloc;
        if (old + 1u == (gen + 1u) * nloc) {
            __builtin_amdgcn_fence(__ATOMIC_RELEASE, "agent");
            asm volatile("s_waitcnt vmcnt(0)" ::: "memory");
            const unsigned og = xb_add(&bar[XB_TOP], 1u);
            const unsigned tg = og / nx;
            if (og + 1u == (tg + 1u) * nx) xb_add(&bar[XB_TOPGEN], 1u);
            else XB_SPIN(xb_ld(&bar[XB_TOPGEN]) == tg, bar);
            __builtin_amdgcn_fence(__ATOMIC_ACQUIRE, "agent");
            xb_add(&bar[XB_XGEN(b.x)], 1u);
            asm volatile("s_waitcnt vmcnt(0)" ::: "memory");
        } else {
            XB_SPIN(xb_ld(&bar[XB_XGEN(b.x)]) == gen, bar);
            __builtin_amdgcn_fence(__ATOMIC_ACQUIRE, "agent");
            asm volatile("s_waitcnt vmcnt(0)" ::: "memory");
        }
    }
    __syncthreads();
}

constexpr int BK = 64;
__device__ __forceinline__ int swz(int row, int chunk) { return row * 128 + ((chunk ^ ((row >> 1) & 7)) << 4); }

template <class AF, class BF>
__device__ __forceinline__ void gemm_tile(char* smem, const int K, AF arow, BF bcol, const int ldb, f32x4 (&acc)[4][4]) {
    const int tid = otid(), lane = tid & 63, wid = tid >> 6, wr = wid >> 1, wc = wid & 1, fr = lane & 15, fq = lane >> 4;
    char* sA = smem;
    char* sB = smem + 16384;
    const bf16_t* ap[4];
#pragma unroll
    for (int i = 0; i < 4; ++i) ap[i] = arow((tid >> 3) + 32 * i) + (tid & 7) * 8;
    const int nq = tid & 31, kg = tid >> 5;
    const float* bp = bcol(nq * 4) + (size_t)(kg * 8) * ldb;
#pragma unroll
    for (int m = 0; m < 4; ++m)
#pragma unroll
        for (int n = 0; n < 4; ++n) acc[m][n] = f32x4{0.f, 0.f, 0.f, 0.f};
    u32x4 ra[4];
    f32x4 rb[8];
#pragma unroll
    for (int i = 0; i < 4; ++i) ra[i] = *(const u32x4*)(ap[i]);
#pragma unroll
    for (int j = 0; j < 8; ++j) rb[j] = *(const f32x4*)(bp + (size_t)j * ldb);
    for (int k0 = 0; k0 < K; k0 += BK) {
        __syncthreads();
#pragma unroll
        for (int i = 0; i < 4; ++i) *(u32x4*)(sA + swz((tid >> 3) + 32 * i, tid & 7)) = ra[i];
        {
            u32x4 v;
            v.x = pack2(rb[0].x, rb[1].x); v.y = pack2(rb[2].x, rb[3].x); v.z = pack2(rb[4].x, rb[5].x); v.w = pack2(rb[6].x, rb[7].x);
            *(u32x4*)(sB + swz(nq * 4 + 0, kg)) = v;
            v.x = pack2(rb[0].y, rb[1].y); v.y = pack2(rb[2].y, rb[3].y); v.z = pack2(rb[4].y, rb[5].y); v.w = pack2(rb[6].y, rb[7].y);
            *(u32x4*)(sB + swz(nq * 4 + 1, kg)) = v;
            v.x = pack2(rb[0].z, rb[1].z); v.y = pack2(rb[2].z, rb[3].z); v.z = pack2(rb[4].z, rb[5].z); v.w = pack2(rb[6].z, rb[7].z);
            *(u32x4*)(sB + swz(nq * 4 + 2, kg)) = v;
            v.x = pack2(rb[0].w, rb[1].w); v.y = pack2(rb[2].w, rb[3].w); v.z = pack2(rb[4].w, rb[5].w); v.w = pack2(rb[6].w, rb[7].w);
            *(u32x4*)(sB + swz(nq * 4 + 3, kg)) = v;
        }
        __syncthreads();
        if (k0 + BK < K) {
#pragma unroll
            for (int i = 0; i < 4; ++i) ra[i] = *(const u32x4*)(ap[i] + k0 + BK);
#pragma unroll
            for (int j = 0; j < 8; ++j) rb[j] = *(const f32x4*)(bp + (size_t)(k0 + BK + j) * ldb);
        }
#pragma unroll
        for (int ks = 0; ks < 2; ++ks) {
            bf16x8 af[4], bfr[4];
#pragma unroll
            for (int m = 0; m < 4; ++m) af[m] = *(const bf16x8*)(sA + swz(wr * 64 + m * 16 + fr, ks * 4 + fq));
#pragma unroll
            for (int n = 0; n < 4; ++n) bfr[n] = *(const bf16x8*)(sB + swz(wc * 64 + n * 16 + fr, ks * 4 + fq));
#pragma unroll
            for (int m = 0; m < 4; ++m)
#pragma unroll
                for (int n = 0; n < 4; ++n) acc[m][n] = __builtin_amdgcn_mfma_f32_16x16x32_bf16(af[m], bfr[n], acc[m][n], 0, 0, 0);
        }
    }
}

__device__ __forceinline__ float wave_sum(float v) {
#pragma unroll
    for (int o = 32; o > 0; o >>= 1) v += __shfl_xor(v, o, 64);
    return v;
}

__device__ __forceinline__ int t5_bucket(int n) {
    if (n < 16) return n;
    const float v = logf((float)n / 16.f) / logf(128.f) * 16.f;
    int large = 16 + (int)v;
    return large < 31 ? large : 31;
}

__device__ void ph_mod(const Params& p, char* smem) {
    const int tid = otid();
    float* cond = (float*)smem;
    float* red = cond + 4096;
    for (int i = tid; i < 4096; i += NTHREADS) { const float v = p.c[i]; cond[i] = v / (1.f + __expf(-v)); }
    __syncthreads();
    const int NU = 192;
    for (int u = blockIdx.x; u < NU + 2 + 64; u += gridDim.x) {
        if (u >= NU + 2) {
            const int base = (u - NU - 2) * 4096;
            for (int i = tid; i < 4096; i += NTHREADS) {
                const float w = p.w_router[base + i];
                const float hi = bf2f(f2bf(w));
                p.wr2[base + i] = hi;
                p.wr2[262144 + base + i] = w - hi;
            }
        } else if (u < NU) {
            const int cl = tid & 31, kq = tid >> 5, n = u * 32 + cl;
            float a0 = 0.f, a1 = 0.f, a2 = 0.f, a3 = 0.f;
            for (int k = kq; k < 1024; k += 8) {
                const float w = p.w_ada[(size_t)k * 6144 + n];
                a0 += cond[k] * w; a1 += cond[1024 + k] * w; a2 += cond[2048 + k] * w; a3 += cond[3072 + k] * w;
            }
            __syncthreads();
            red[(kq * 4 + 0) * 32 + cl] = a0; red[(kq * 4 + 1) * 32 + cl] = a1; red[(kq * 4 + 2) * 32 + cl] = a2; red[(kq * 4 + 3) * 32 + cl] = a3;
            __syncthreads();
            if (tid < 128) {
                const int b = tid >> 5, c2 = tid & 31;
                float s = 0.f;
                for (int q = 0; q < 8; ++q) s += red[(q * 4 + b) * 32 + c2];
                p.mod[b * 6144 + u * 32 + c2] = s + p.b_ada[u * 32 + c2];
            }
        } else if (u == NU) {
            for (int j = tid; j < 512; j += NTHREADS) {
                const float a = p.hg_lb[j], b = p.hg_lb[512 + j];
                const float m = fmaxf(a, b);
                const float ea = expf(a - m), eb = expf(b - m);
                p.lbv[j] = ea / (ea + eb);
            }
        } else {
            for (int i = tid; i < 3 * 129 * 4; i += NTHREADS) {
                const int g = i / (129 * 4), m = (i >> 2) % 129, hh = i & 3;
                const int dil = (g == 0) ? 1 : (g == 1 ? 4 : 16);
                p.biasT[i] = p.rel_bias[t5_bucket(m * dil) * 12 + g * 4 + hh];
            }
        }
    }
}

__device__ void ph_ln0(const Params& p) {
    const int tid = otid(), lane = tid & 63, wid = tid >> 6;
    for (int row = blockIdx.x * 4 + wid; row < T; row += gridDim.x * 4) {
        const float4* xr = (const float4*)(p.x + (size_t)row * D);
        float4 v[4];
        float s = 0.f;
#pragma unroll
        for (int i = 0; i < 4; ++i) { v[i] = xr[lane + 64 * i]; s += v[i].x + v[i].y + v[i].z + v[i].w; }
        const float mean = wave_sum(s) * (1.f / D);
        float q = 0.f;
#pragma unroll
        for (int i = 0; i < 4; ++i) {
            v[i].x -= mean; v[i].y -= mean; v[i].z -= mean; v[i].w -= mean;
            q += v[i].x * v[i].x + v[i].y * v[i].y + v[i].z * v[i].z + v[i].w * v[i].w;
        }
        const float rstd = rsqrtf(wave_sum(q) * (1.f / D) + LN_EPS);
        const int b = row >> 12;
        const float* sh = p.mod + b * 6144;
        const float* sc = sh + 1024;
#pragma unroll
        for (int i = 0; i < 4; ++i) {
            const int col = (lane + 64 * i) * 4;
            const float4 s4 = *(const float4*)(sc + col), h4 = *(const float4*)(sh + col);
            uint2 o;
            o.x = pack2(v[i].x * rstd * (1.f + s4.x) + h4.x, v[i].y * rstd * (1.f + s4.y) + h4.y);
            o.y = pack2(v[i].z * rstd * (1.f + s4.z) + h4.z, v[i].w * rstd * (1.f + s4.w) + h4.w);
            *(uint2*)(p.h1 + (size_t)row * D + col) = o;
        }
    }
}

__device__ __forceinline__ int swz16(int row, int chunk) { return row * 256 + ((chunk ^ (row & 15)) << 4); }
__device__ __forceinline__ bf16x8 tr_frag16(const char* tile, int ks, int c) {
    const int lane = otid() & 63, g = lane >> 4, q = (lane & 15) >> 2, pp = lane & 3;
    const int r0 = 32 * ks + 8 * g + q, ch = 2 * c + (pp >> 1), bo = 8 * (pp & 1);
    const v4s lo = __builtin_amdgcn_ds_read_tr16_b64_v4i16((LAS v4s*)(tile + swz16(r0, ch) + bo));
    const v4s hi = __builtin_amdgcn_ds_read_tr16_b64_v4i16((LAS v4s*)(tile + swz16(r0 + 4, ch) + bo));
    return bf16x8{lo[0], lo[1], lo[2], lo[3], hi[0], hi[1], hi[2], hi[3]};
}


__device__ __forceinline__ int aoff(int row, int chunk) { return row * 64 + ((chunk ^ ((row >> 2) & 3)) << 4); }
constexpr int G2_STAGE = 24576;

template <int BMODE, class AF, class BF>
__device__ __forceinline__ void gemm2(char* smem, const int K, AF arow, BF bsrc, const int ldb, f32x4 (&acc)[4][8], const int nvalid = 256) {
    const int tid = otid(), lane = tid & 63, wid = tid >> 6, fr = lane & 15, fq = lane >> 4;
    const bf16_t* ap[4];
#pragma unroll
    for (int i = 0; i < 4; ++i) ap[i] = arow((tid >> 2) + 64 * i) + (tid & 3) * 8;
    const float* bpf = nullptr;
    const bf16_t* bpb[2] = {nullptr, nullptr};
    if (BMODE == 0) bpf = (const float*)bsrc((tid & 31) * 4) + (size_t)(tid >> 5) * ldb;
    else {
#pragma unroll
        for (int i = 0; i < 2; ++i) bpb[i] = (const bf16_t*)bsrc((tid >> 2) + 64 * i) + (tid & 3) * 8;
    }
#pragma unroll
    for (int m = 0; m < 4; ++m)
#pragma unroll
        for (int n = 0; n < 8; ++n) acc[m][n] = f32x4{0.f, 0.f, 0.f, 0.f};
    u32x4 ra[4];
    f32x4 rbf[4];
    u32x4 rbb[2];
    auto gload = [&](int k0) {
#pragma unroll
        for (int i = 0; i < 4; ++i) ra[i] = *(const u32x4*)(ap[i] + k0);
        if (BMODE == 0) {
#pragma unroll
            for (int j = 0; j < 4; ++j) rbf[j] = *(const f32x4*)(bpf + (size_t)(k0 + 8 * j) * ldb);
        } else {
#pragma unroll
            for (int i = 0; i < 2; ++i) rbb[i] = *(const u32x4*)(bpb[i] + k0);
        }
    };
    auto lwrite = [&](char* st) {
        char* sA = st;
        char* sB = st + 16384;
#pragma unroll
        for (int i = 0; i < 4; ++i) *(u32x4*)(sA + aoff((tid >> 2) + 64 * i, tid & 3)) = ra[i];
        if (BMODE == 0) {
#pragma unroll
            for (int j = 0; j < 4; ++j) {
                uint2 w;
                w.x = pack2(rbf[j][0], rbf[j][1]); w.y = pack2(rbf[j][2], rbf[j][3]);
                *(uint2*)(sB + swz16((tid >> 5) + 8 * j, (tid & 31) >> 1) + (tid & 1) * 8) = w;
            }
        } else {
#pragma unroll
            for (int i = 0; i < 2; ++i) *(u32x4*)(sB + aoff((tid >> 2) + 64 * i, tid & 3)) = rbb[i];
        }
    };
    const int nk = K >> 5;
    const bool active = wid * 64 < nvalid;
    gload(0);
    lwrite(smem);
    if (nk > 1) gload(32);
    __syncthreads();
    for (int kt = 0; kt < nk; ++kt) {
        char* cur = smem + (kt & 1) * G2_STAGE;
        if (kt + 1 < nk) lwrite(smem + ((kt + 1) & 1) * G2_STAGE);
        if (kt + 2 < nk) gload((kt + 2) * 32);
        const char* sA = cur;
        const char* sB = cur + 16384;
        if (active) {
            bf16x8 af[4];
#pragma unroll
            for (int m = 0; m < 4; ++m) af[m] = *(const bf16x8*)(sA + aoff(wid * 64 + m * 16 + fr, fq));
#pragma unroll
            for (int n = 0; n < 8; ++n) {
                bf16x8 bfr;
                if (BMODE == 0) bfr = tr_frag16(sB, 0, n);
                else bfr = *(const bf16x8*)(sB + aoff(n * 16 + fr, fq));
#pragma unroll
                for (int m = 0; m < 4; ++m) acc[m][n] = __builtin_amdgcn_mfma_f32_16x16x32_bf16(af[m], bfr, acc[m][n], 0, 0, 0);
            }
        }
        __syncthreads();
    }
}


constexpr int EPI_WAVE = 8704;
template <class VF, class SF>
__device__ __forceinline__ void epi_bf16(char* wl, const int lane, VF val, SF store) {
    const int fr = lane & 15, fq = lane >> 4, odd = lane & 1;
#pragma unroll
    for (int n = 0; n < 8; ++n)
#pragma unroll
        for (int jp = 0; jp < 2; ++jp) {
            const float a = val(n, 2 * jp), b = val(n, 2 * jp + 1);
            const float x = odd ? a : b;
            const float y = __shfl_xor(x, 1, 64);
            const uint32_t w = odd ? pack2(y, b) : pack2(a, y);
            *(uint32_t*)(wl + (fq * 4 + 2 * jp + odd) * 272 + (n * 16 + (fr & ~1)) * 2) = w;
        }
    int ln = lane;
    asm volatile("" : "+v"(ln));
#pragma unroll
    for (int i = 0; i < 4; ++i) {
        const int idx = ln + 64 * i, row = idx >> 4, ch = idx & 15;
        store(row, ch, *(const u32x4*)(wl + row * 272 + ch * 16));
    }
}
template <class VF, class SF>
__device__ __forceinline__ void epi_f32(char* wl, const int lane, VF val, SF store) {
    const int fr = lane & 15, fq = lane >> 4;
#pragma unroll
    for (int n = 0; n < 8; ++n)
#pragma unroll
        for (int j = 0; j < 4; ++j) *(float*)(wl + (fq * 4 + j) * 528 + (n * 16 + fr) * 4) = val(n, j);
    int ln = lane;
    asm volatile("" : "+v"(ln));
#pragma unroll
    for (int i = 0; i < 8; ++i) {
        const int idx = ln + 64 * i, row = idx >> 5, ch = idx & 31;
        store(row, ch, *(const f32x4*)(wl + row * 528 + ch * 16));
    }
}

__device__ void ph_inproj(const Params& p, char* smem) {
    const int tid = otid(), lane = tid & 63, wid = tid >> 6, fr = lane & 15, fq = lane >> 4;
    const int NT = INW / 128;
    const int xcd = blockIdx.x & 7, nbx = gridDim.x >> 3;
    for (int i = blockIdx.x >> 3; i < 8 * NT; i += nbx) {
        const int nt = i >> 3, mt = xcd * 8 + (i & 7);
        const bf16_t* A = p.h1 + (size_t)mt * 256 * D;
        const float* W = p.w_in + nt * 128;
        f32x4 acc[4][8];
        __syncthreads();
        gemm2<0>(smem, D, [&](int r) { return A + (size_t)r * D; }, [&](int n) { return W + n; }, INW, acc);
        char* wl = smem + wid * EPI_WAVE;
        if (nt >= 4 && nt < 8) {
            float lbc[8];
#pragma unroll
            for (int n = 0; n < 8; ++n) lbc[n] = p.lbv[nt * 128 - OFF_HF + n * 16 + fr];
#pragma unroll
            for (int m = 0; m < 4; ++m) {
                float* dst = p.lgf + (size_t)(mt * 256 + wid * 64 + m * 16) * 512 + (nt * 128 - OFF_HF);
                epi_f32(wl, lane,
                        [&](int n, int j) { return logf(lbc[n] + (1.f - lbc[n]) * (1.f / (1.f + expf(-acc[m][n][j])))); },
                        [&](int row, int ch, f32x4 v) { *(f32x4*)(dst + (size_t)row * 512 + ch * 4) = v; });
            }
        } else {
#pragma unroll
            for (int m = 0; m < 4; ++m) {
                bf16_t* dst = p.proj + (size_t)(mt * 256 + wid * 64 + m * 16) * INW + nt * 128;
                epi_bf16(wl, lane, [&](int n, int j) { return acc[m][n][j]; },
                         [&](int row, int ch, u32x4 v) { *(u32x4*)(dst + (size_t)row * INW + ch * 8) = v; });
            }
        }
    }
}

__device__ void ph_h1(const Params& p, char* smem) {
    const int tid = otid(), lane = tid & 63, wid = tid >> 6, wr = wid >> 1, wc = wid & 1, fr = lane & 15, fq = lane >> 4;
    char* sI = smem;
    char* sK = smem + 16384;
    float* sL = (float*)(smem + 32768);
    float* totS = (float*)(smem + 65536);
    const int d = tid & 127, half = tid >> 7;
    for (int u = blockIdx.x; u < 1024; u += gridDim.x) {
        const int bh = u >> 6, c = u & 63, b = bh >> 2, h = bh & 3;
        const size_t row0 = (size_t)b * S + c * 64;
        __syncthreads();
#pragma unroll
        for (int i = 0; i < 4; ++i) {
            const int idx = tid + 256 * i, r = idx >> 4, ch = idx & 15;
            *(u32x4*)(sI + swz16(r, ch)) = *(const u32x4*)(p.proj + (row0 + r) * INW + OFF_HI + h * 128 + ch * 8);
        }
#pragma unroll
        for (int i = 0; i < 8; ++i) {
            const int idx = tid + 256 * i, r = idx >> 5, c4 = idx & 31;
            *(f32x4*)(sL + r * 128 + c4 * 4) = *(const f32x4*)(p.lgf + (row0 + r) * 512 + h * 128 + c4 * 4);
        }
        __syncthreads();
        const float* lcol = sL + half * 32 * 128 + d;
        float tot = 0.f;
#pragma unroll
        for (int s = 0; s < 32; ++s) tot += lcol[s * 128];
        totS[half * 128 + d] = tot;
        __syncthreads();
        const float t0 = totS[d], bl = t0 + totS[128 + d];
        float run = half ? t0 : 0.f;
#pragma unroll 8
        for (int s = 0; s < 32; ++s) {
            const float lv = lcol[s * 128];
            run += lv;
            const float kt = (1.f - __expf(lv)) * __expf(bl - run);
            *(bf16_t*)(sK + swz16(half * 32 + s, d >> 3) + (d & 7) * 2) = f2bf(kt);
        }
        if (half == 0) p.dec[u * 128 + d] = __expf(bl);
        __syncthreads();
        f32x4 acc[4][4];
#pragma unroll
        for (int m = 0; m < 4; ++m)
#pragma unroll
            for (int n = 0; n < 4; ++n) acc[m][n] = f32x4{0.f, 0.f, 0.f, 0.f};
#pragma unroll
        for (int ks = 0; ks < 2; ++ks) {
            bf16x8 af[4], bfr[4];
#pragma unroll
            for (int m = 0; m < 4; ++m) af[m] = tr_frag16(sI, ks, wr * 4 + m);
#pragma unroll
            for (int n = 0; n < 4; ++n) bfr[n] = tr_frag16(sK, ks, wc * 4 + n);
#pragma unroll
            for (int m = 0; m < 4; ++m)
#pragma unroll
                for (int n = 0; n < 4; ++n) acc[m][n] = __builtin_amdgcn_mfma_f32_16x16x32_bf16(af[m], bfr[n], acc[m][n], 0, 0, 0);
        }
        float* kvu = p.kv + (size_t)u * 16384;
#pragma unroll
        for (int m = 0; m < 4; ++m)
#pragma unroll
            for (int n = 0; n < 4; ++n)
#pragma unroll
                for (int j = 0; j < 4; ++j) kvu[(wr * 64 + m * 16 + fq * 4 + j) * 128 + wc * 64 + n * 16 + fr] = acc[m][n][j];
    }
}

__device__ void ph_h2(const Params& p) {
    for (int it = blockIdx.x * NTHREADS + otid(); it < 16 * 8192; it += gridDim.x * NTHREADS) {
        const int bh = it >> 13, e2 = it & 8191, dv = e2 >> 6, dk = (e2 & 63) * 2;
        const size_t eoff = (size_t)dv * 128 + dk;
        float sx = 0.f, sy = 0.f;
#pragma unroll 8
        for (int c = 0; c < 64; ++c) {
            const size_t u = (size_t)bh * 64 + c;
            *(uint32_t*)(p.sst + u * 16384 + eoff) = pack2(sx, sy);
            const float2 kvv = *(const float2*)(p.kv + u * 16384 + eoff);
            const float2 dc = *(const float2*)(p.dec + u * 128 + dk);
            sx = dc.x * sx + kvv.x; sy = dc.y * sy + kvv.y;
        }
    }
}

__device__ void ph_h3(const Params& p, char* smem) {
    const int tid = otid(), lane = tid & 63, wid = tid >> 6, wr = wid >> 1, wc = wid & 1, fr = lane & 15, fq = lane >> 4;
    char* sQ = smem;
    char* sK = smem + 16384;
    char* sP = smem + 32768;
    float* sL = (float*)(smem + 32768);
    float* totS = (float*)(smem + 65536);
    const int d = tid & 127, half = tid >> 7;
    for (int u = blockIdx.x; u < 1024; u += gridDim.x) {
        const int bh = u >> 6, c = u & 63, b = bh >> 2, h = bh & 3;
        const size_t row0 = (size_t)b * S + c * 64;
        __syncthreads();
#pragma unroll
        for (int i = 0; i < 4; ++i) {
            const int idx = tid + 256 * i, r = idx >> 4, ch = idx & 15;
            *(u32x4*)(sQ + swz16(r, ch)) = *(const u32x4*)(p.proj + (row0 + r) * INW + OFF_HQ + h * 128 + ch * 8);
        }
#pragma unroll
        for (int i = 0; i < 8; ++i) {
            const int idx = tid + 256 * i, r = idx >> 5, c4 = idx & 31;
            *(f32x4*)(sL + r * 128 + c4 * 4) = *(const f32x4*)(p.lgf + (row0 + r) * 512 + h * 128 + c4 * 4);
        }
        __syncthreads();
        const float* lcol = sL + half * 32 * 128 + d;
        float tot = 0.f;
#pragma unroll
        for (int s = 0; s < 32; ++s) tot += lcol[s * 128];
        totS[half * 128 + d] = tot;
        __syncthreads();
        const float t0 = totS[d];
        float run = half ? t0 : 0.f;
#pragma unroll 8
        for (int s = 0; s < 32; ++s) {
            const float lv = lcol[s * 128];
            run += lv;
            const int o = swz16(half * 32 + s, d >> 3) + (d & 7) * 2;
            const float qm = bf2f(*(const bf16_t*)(sQ + o)) * __expf(run - t0);
            const float kh = (1.f - __expf(lv)) * __expf(t0 - run);
            *(bf16_t*)(sQ + o) = f2bf(qm);
            *(bf16_t*)(sK + o) = f2bf(kh);
        }
        __syncthreads();
        {
            f32x4 pa[2][2];
#pragma unroll
            for (int m = 0; m < 2; ++m)
#pragma unroll
                for (int n = 0; n < 2; ++n) pa[m][n] = f32x4{0.f, 0.f, 0.f, 0.f};
#pragma unroll
            for (int ks = 0; ks < 4; ++ks) {
                bf16x8 af[2], bfr[2];
#pragma unroll
                for (int m = 0; m < 2; ++m) af[m] = *(const bf16x8*)(sQ + swz16(wr * 32 + m * 16 + fr, ks * 4 + fq));
#pragma unroll
                for (int n = 0; n < 2; ++n) bfr[n] = *(const bf16x8*)(sK + swz16(wc * 32 + n * 16 + fr, ks * 4 + fq));
#pragma unroll
                for (int m = 0; m < 2; ++m)
#pragma unroll
                    for (int n = 0; n < 2; ++n) pa[m][n] = __builtin_amdgcn_mfma_f32_16x16x32_bf16(af[m], bfr[n], pa[m][n], 0, 0, 0);
            }
#pragma unroll
            for (int m = 0; m < 2; ++m)
#pragma unroll
                for (int n = 0; n < 2; ++n)
#pragma unroll
                    for (int j = 0; j < 4; ++j) {
                        const int t = wr * 32 + m * 16 + fq * 4 + j, s_ = wc * 32 + n * 16 + fr;
                        const float v = (s_ <= t) ? pa[m][n][j] : 0.f;
                        *(bf16_t*)(sP + swz(t, s_ >> 3) + (s_ & 7) * 2) = f2bf(v);
                    }
        }
        __syncthreads();
        f32x4 oa[8];
#pragma unroll
        for (int n = 0; n < 8; ++n) oa[n] = f32x4{0.f, 0.f, 0.f, 0.f};
        const int ch = tid & 7;
#pragma unroll
        for (int sub = 0; sub < 2; ++sub) {
            float sc[8];
#pragma unroll
            for (int j = 0; j < 8; ++j) sc[j] = __expf(totS[sub * 64 + ch * 8 + j]);
#pragma unroll
            for (int i = 0; i < 4; ++i) {
                const int r = (tid + 256 * i) >> 3;
                const u32x4 v = *(const u32x4*)(p.sst + (size_t)u * 16384 + r * 128 + sub * 64 + ch * 8);
                u32x4 w;
                w.x = pack2(__uint_as_float(v.x << 16) * sc[0], __uint_as_float(v.x & 0xffff0000u) * sc[1]);
                w.y = pack2(__uint_as_float(v.y << 16) * sc[2], __uint_as_float(v.y & 0xffff0000u) * sc[3]);
                w.z = pack2(__uint_as_float(v.z << 16) * sc[4], __uint_as_float(v.z & 0xffff0000u) * sc[5]);
                w.w = pack2(__uint_as_float(v.w << 16) * sc[6], __uint_as_float(v.w & 0xffff0000u) * sc[7]);
                *(u32x4*)(sK + swz(r, ch)) = w;
            }
            __syncthreads();
#pragma unroll
            for (int ks = 0; ks < 2; ++ks) {
                const bf16x8 af = *(const bf16x8*)(sQ + swz16(wid * 16 + fr, sub * 8 + ks * 4 + fq));
#pragma unroll
                for (int n = 0; n < 8; ++n) {
                    const bf16x8 bfr = *(const bf16x8*)(sK + swz(n * 16 + fr, ks * 4 + fq));
                    oa[n] = __builtin_amdgcn_mfma_f32_16x16x32_bf16(af, bfr, oa[n], 0, 0, 0);
                }
            }
            __syncthreads();
        }
#pragma unroll
        for (int i = 0; i < 4; ++i) {
            const int idx = tid + 256 * i, r = idx >> 4, c16 = idx & 15;
            *(u32x4*)(sK + swz16(r, c16)) = *(const u32x4*)(p.proj + (row0 + r) * INW + OFF_HI + h * 128 + c16 * 8);
        }
        __syncthreads();
#pragma unroll
        for (int ks = 0; ks < 2; ++ks) {
            const bf16x8 af = *(const bf16x8*)(sP + swz(wid * 16 + fr, ks * 4 + fq));
#pragma unroll
            for (int n = 0; n < 8; ++n) {
                const bf16x8 bfr = tr_frag16(sK, ks, n);
                oa[n] = __builtin_amdgcn_mfma_f32_16x16x32_bf16(af, bfr, oa[n], 0, 0, 0);
            }
        }
        float ss[4] = {0.f, 0.f, 0.f, 0.f};
#pragma unroll
        for (int n = 0; n < 8; ++n)
#pragma unroll
            for (int j = 0; j < 4; ++j) ss[j] += oa[n][j] * oa[n][j];
#pragma unroll
        for (int j = 0; j < 4; ++j) {
            ss[j] += __shfl_xor(ss[j], 1, 64); ss[j] += __shfl_xor(ss[j], 2, 64); ss[j] += __shfl_xor(ss[j], 4, 64); ss[j] += __shfl_xor(ss[j], 8, 64);
        }
#pragma unroll
        for (int j = 0; j < 4; ++j) {
            const size_t row = row0 + wid * 16 + fq * 4 + j;
            const float rstd = rsqrtf(ss[j] * (1.f / 128.f) + RMS_EPS);
#pragma unroll
            for (int n = 0; n < 8; ++n) {
                const int dv = n * 16 + fr;
                const float g = bf2f(p.proj[row * INW + OFF_HG + h * 128 + dv]);
                const float y = oa[n][j] * rstd * p.hg_nw[h * 128 + dv] * (g / (1.f + __expf(-g)));
                p.mixin[row * 768 + h * 128 + dv] = f2bf(y);
            }
        }
    }
}

__device__ __forceinline__ bf16x8 tr_frag8(const char* tile, int ks, int c) {
    const int lane = otid() & 63, g = lane >> 4, q = (lane & 15) >> 2, pp = lane & 3;
    const int r0 = 32 * ks + 8 * g + q, ch = 2 * c + (pp >> 1), bo = 8 * (pp & 1);
    const v4s lo = __builtin_amdgcn_ds_read_tr16_b64_v4i16((LAS v4s*)(tile + swz(r0, ch) + bo));
    const v4s hi = __builtin_amdgcn_ds_read_tr16_b64_v4i16((LAS v4s*)(tile + swz(r0 + 4, ch) + bo));
    return bf16x8{lo[0], lo[1], lo[2], lo[3], hi[0], hi[1], hi[2], hi[3]};
}

__device__ void ph_attn(const Params& p, char* smem) {
    const int tid = otid(), lane = tid & 63, wid = tid >> 6, fr = lane & 15, fq = lane >> 4;
    char* sQ = smem;
    char* sK = smem + 8192;
    char* sP = sK;
    char* sV = smem + 33792;
    float* sBias = (float*)(smem + 58368);
    for (int u = blockIdx.x; u < 3072; u += gridDim.x) {
        const int ti = u & 63, gq = u >> 6, g = gq % 3, bhh = gq / 3, hh = bhh & 3, b = bhh >> 2;
        const int lsh = (g == 0) ? 0 : (g == 1 ? 2 : 4), dl = 1 << lsh;
        const int tpr = (S >> lsh) >> 6;
        const int r = ti / tpr, j0 = (ti % tpr) * 64;
        const bf16_t* base = p.proj + (size_t)b * S * INW + (g * 4 + hh) * 64;
        __syncthreads();
#pragma unroll
        for (int i = 0; i < 2; ++i) {
            const int idx = tid + 256 * i, row = idx >> 3, ch = idx & 7;
            const int tok = (j0 + row) * dl + r;
            *(u32x4*)(sQ + swz(row, ch)) = *(const u32x4*)(base + (size_t)tok * INW + OFF_AQ + ch * 8);
        }
#pragma unroll
        for (int i = 0; i < 6; ++i) {
            const int idx = tid + 256 * i, row = idx >> 3, ch = idx & 7;
            const int j = j0 - 128 + row;
            u32x4 kx = {0u, 0u, 0u, 0u}, vx = {0u, 0u, 0u, 0u};
            if (j >= 0) {
                const size_t o = (size_t)(j * dl + r) * INW + ch * 8;
                kx = *(const u32x4*)(base + o + OFF_AK);
                vx = *(const u32x4*)(base + o + OFF_AV);
            }
            *(u32x4*)(sK + swz(row, ch)) = kx;
            *(u32x4*)(sV + swz(row, ch)) = vx;
        }
        if (tid < 129) sBias[tid] = p.biasT[(g * 129 + tid) * 4 + hh];
        __syncthreads();
        f32x4 sa[12];
#pragma unroll
        for (int n = 0; n < 12; ++n) sa[n] = f32x4{0.f, 0.f, 0.f, 0.f};
#pragma unroll
        for (int ks = 0; ks < 2; ++ks) {
            const bf16x8 af = *(const bf16x8*)(sQ + swz(wid * 16 + fr, ks * 4 + fq));
#pragma unroll
            for (int n = 0; n < 12; ++n) {
                const bf16x8 bfr = *(const bf16x8*)(sK + swz(n * 16 + fr, ks * 4 + fq));
                sa[n] = __builtin_amdgcn_mfma_f32_16x16x32_bf16(af, bfr, sa[n], 0, 0, 0);
            }
        }
        float mx[4] = {-INFINITY, -INFINITY, -INFINITY, -INFINITY};
#pragma unroll
        for (int n = 0; n < 12; ++n)
#pragma unroll
            for (int j = 0; j < 4; ++j) {
                const int jj = wid * 16 + fq * 4 + j, kk = n * 16 + fr, m = jj + 128 - kk;
                const bool valid = (m >= 0) && (m <= 128) && (j0 - 128 + kk >= 0);
                const int mc = m < 0 ? 0 : (m > 128 ? 128 : m);
                const float v = valid ? sa[n][j] * 0.125f + sBias[mc] : -INFINITY;
                sa[n][j] = v;
                mx[j] = fmaxf(mx[j], v);
            }
#pragma unroll
        for (int j = 0; j < 4; ++j) {
            mx[j] = fmaxf(mx[j], __shfl_xor(mx[j], 1, 64)); mx[j] = fmaxf(mx[j], __shfl_xor(mx[j], 2, 64));
            mx[j] = fmaxf(mx[j], __shfl_xor(mx[j], 4, 64)); mx[j] = fmaxf(mx[j], __shfl_xor(mx[j], 8, 64));
        }
        float ls[4] = {0.f, 0.f, 0.f, 0.f};
#pragma unroll
        for (int n = 0; n < 12; ++n)
#pragma unroll
            for (int j = 0; j < 4; ++j) { const float pe = __expf(sa[n][j] - mx[j]); sa[n][j] = pe; ls[j] += pe; }
#pragma unroll
        for (int j = 0; j < 4; ++j) {
            ls[j] += __shfl_xor(ls[j], 1, 64); ls[j] += __shfl_xor(ls[j], 2, 64); ls[j] += __shfl_xor(ls[j], 4, 64); ls[j] += __shfl_xor(ls[j], 8, 64);
        }
        __syncthreads();
#pragma unroll
        for (int n = 0; n < 12; ++n)
#pragma unroll
            for (int j = 0; j < 4; ++j) *(bf16_t*)(sP + (wid * 16 + fq * 4 + j) * 400 + (n * 16 + fr) * 2) = f2bf(sa[n][j]);
        f32x4 oa[4];
#pragma unroll
        for (int n = 0; n < 4; ++n) oa[n] = f32x4{0.f, 0.f, 0.f, 0.f};
#pragma unroll
        for (int ks = 0; ks < 6; ++ks) {
            const bf16x8 af = *(const bf16x8*)(sP + (wid * 16 + fr) * 400 + (ks * 4 + fq) * 16);
#pragma unroll
            for (int n = 0; n < 4; ++n) {
                const bf16x8 bfr = tr_frag8(sV, ks, n);
                oa[n] = __builtin_amdgcn_mfma_f32_16x16x32_bf16(af, bfr, oa[n], 0, 0, 0);
            }
        }
#pragma unroll
        for (int j = 0; j < 4; ++j) {
            const int jj = wid * 16 + fq * 4 + j;
            const size_t row = (size_t)g * T + (size_t)b * S + (j0 + jj) * dl + r;
            const float inv = 1.f / ls[j];
#pragma unroll
            for (int n = 0; n < 4; ++n) p.ao[row * 256 + hh * 64 + n * 16 + fr] = oa[n][j] * inv;
            if (fr == 0) p.alse[row * 4 + hh] = mx[j] + __logf(ls[j]);
        }
    }
}

__device__ void ph_attn_merge(const Params& p) {
    const int tid = otid(), lane = tid & 63, wid = tid >> 6;
    for (int row = blockIdx.x * 4 + wid; row < T; row += gridDim.x * 4) {
        const int hh = lane >> 4;
        const float l0 = p.alse[((size_t)0 * T + row) * 4 + hh], l1 = p.alse[((size_t)1 * T + row) * 4 + hh], l2 = p.alse[((size_t)2 * T + row) * 4 + hh];
        const float mxl = fmaxf(l0, fmaxf(l1, l2));
        float e0 = __expf(l0 - mxl), e1 = __expf(l1 - mxl), e2 = __expf(l2 - mxl);
        const float inv = 1.f / (e0 + e1 + e2);
        e0 *= inv; e1 *= inv; e2 *= inv;
        const f32x4 a0 = *(const f32x4*)(p.ao + ((size_t)0 * T + row) * 256 + lane * 4);
        const f32x4 a1 = *(const f32x4*)(p.ao + ((size_t)1 * T + row) * 256 + lane * 4);
        const f32x4 a2 = *(const f32x4*)(p.ao + ((size_t)2 * T + row) * 256 + lane * 4);
        uint2 o;
        o.x = pack2(a0[0] * e0 + a1[0] * e1 + a2[0] * e2, a0[1] * e0 + a1[1] * e1 + a2[1] * e2);
        o.y = pack2(a0[2] * e0 + a1[2] * e1 + a2[2] * e2, a0[3] * e0 + a1[3] * e1 + a2[3] * e2);
        *(uint2*)(p.mixin + (size_t)row * 768 + 512 + lane * 4) = o;
    }
}

__device__ void ph_outproj(const Params& p, char* smem) {
    const int tid = otid(), lane = tid & 63, wid = tid >> 6;
    const int xcd = blockIdx.x & 7, nbx = gridDim.x >> 3;
    for (int i = blockIdx.x >> 3; i < 64; i += nbx) {
        const int nt = i >> 3, mt = xcd * 8 + (i & 7);
        const bf16_t* A = p.mixin + (size_t)mt * 256 * 768;
        const float* W = p.w_out + nt * 128;
        f32x4 acc[4][8];
        __syncthreads();
        gemm2<0>(smem, 768, [&](int r) { return A + (size_t)r * 768; }, [&](int n) { return W + n; }, D, acc);
        const int b = (mt * 256) >> 12;
        const float* g1 = p.mod + b * 6144 + 2048 + nt * 128;
        char* wl = smem + wid * EPI_WAVE;
#pragma unroll
        for (int m = 0; m < 4; ++m) {
            const size_t rbase = (size_t)(mt * 256 + wid * 64 + m * 16) * D + nt * 128;
            epi_f32(wl, lane, [&](int n, int j) { return acc[m][n][j]; },
                    [&](int row, int ch, f32x4 v) {
                        const f32x4 xv = *(const f32x4*)(p.x + rbase + (size_t)row * D + ch * 4);
                        const f32x4 gv = *(const f32x4*)(g1 + ch * 4);
                        f32x4 o;
                        o[0] = ALPHA * xv[0] + gv[0] * v[0]; o[1] = ALPHA * xv[1] + gv[1] * v[1];
                        o[2] = ALPHA * xv[2] + gv[2] * v[2]; o[3] = ALPHA * xv[3] + gv[3] * v[3];
                        *(f32x4*)(p.pre1 + rbase + (size_t)row * D + ch * 4) = o;
                    });
        }
    }
}

__device__ void ph_ln1(const Params& p) {
    const int tid = otid(), lane = tid & 63, wid = tid >> 6;
    for (int row = blockIdx.x * 4 + wid; row < T; row += gridDim.x * 4) {
        const float4* xr = (const float4*)(p.pre1 + (size_t)row * D);
        float4 v[4];
        float s = 0.f;
#pragma unroll
        for (int i = 0; i < 4; ++i) { v[i] = xr[lane + 64 * i]; s += v[i].x + v[i].y + v[i].z + v[i].w; }
        float mean = wave_sum(s) * (1.f / D);
        float q = 0.f;
#pragma unroll
        for (int i = 0; i < 4; ++i) {
            v[i].x -= mean; v[i].y -= mean; v[i].z -= mean; v[i].w -= mean;
            q += v[i].x * v[i].x + v[i].y * v[i].y + v[i].z * v[i].z + v[i].w * v[i].w;
        }
        float rstd = rsqrtf(wave_sum(q) * (1.f / D) + LN_EPS);
        s = 0.f;
#pragma unroll
        for (int i = 0; i < 4; ++i) {
            const int col = (lane + 64 * i) * 4;
            const float4 g4 = *(const float4*)(p.ln1_g + col), b4 = *(const float4*)(p.ln1_b + col);
            v[i].x = v[i].x * rstd * g4.x + b4.x; v[i].y = v[i].y * rstd * g4.y + b4.y;
            v[i].z = v[i].z * rstd * g4.z + b4.z; v[i].w = v[i].w * rstd * g4.w + b4.w;
            *(float4*)(p.x1 + (size_t)row * D + col) = v[i];
            s += v[i].x + v[i].y + v[i].z + v[i].w;
        }
        mean = wave_sum(s) * (1.f / D);
        q = 0.f;
#pragma unroll
        for (int i = 0; i < 4; ++i) {
            v[i].x -= mean; v[i].y -= mean; v[i].z -= mean; v[i].w -= mean;
            q += v[i].x * v[i].x + v[i].y * v[i].y + v[i].z * v[i].z + v[i].w * v[i].w;
        }
        rstd = rsqrtf(wave_sum(q) * (1.f / D) + LN_EPS);
        const int b = row >> 12;
        const float* sh = p.mod + b * 6144 + 3072;
        const float* sc = sh + 1024;
#pragma unroll
        for (int i = 0; i < 4; ++i) {
            const int col = (lane + 64 * i) * 4;
            const float4 s4 = *(const float4*)(sc + col), h4 = *(const float4*)(sh + col);
            float4 y;
            y.x = v[i].x * rstd * (1.f + s4.x) + h4.x; y.y = v[i].y * rstd * (1.f + s4.y) + h4.y;
            y.z = v[i].z * rstd * (1.f + s4.z) + h4.z; y.w = v[i].w * rstd * (1.f + s4.w) + h4.w;
            uint2 o;
            o.x = pack2(y.x, y.y); o.y = pack2(y.z, y.w);
            *(uint2*)(p.h2 + (size_t)row * 2048 + col) = o;
            uint2 o2;
            o2.x = pack2(y.x - __uint_as_float(o.x << 16), y.y - __uint_as_float(o.x & 0xffff0000u));
            o2.y = pack2(y.z - __uint_as_float(o.y << 16), y.w - __uint_as_float(o.y & 0xffff0000u));
            *(uint2*)(p.h2 + (size_t)row * 2048 + 1024 + col) = o2;
        }
    }
}

__device__ void ph_router_gemm(const Params& p, char* smem) {
    const int tid = otid(), lane = tid & 63, wid = tid >> 6;
    for (int u = blockIdx.x; u < 384; u += gridDim.x) {
        const int pass = u >> 7, mt = (u & 127) >> 1, nt = u & 1;
        const bf16_t* A = p.h2 + (size_t)mt * 256 * 2048 + (pass == 1 ? 1024 : 0);
        const float* W = p.wr2 + (pass == 2 ? 262144 : 0) + nt * 128;
        f32x4 acc[4][8];
        __syncthreads();
        gemm2<0>(smem, D, [&](int r) { return A + (size_t)r * 2048; }, [&](int n) { return W + n; }, NE, acc);
        char* wl = smem + wid * EPI_WAVE;
#pragma unroll
        for (int m = 0; m < 4; ++m) {
            float* dst = p.lgp + (size_t)pass * T * NE + (size_t)(mt * 256 + wid * 64 + m * 16) * NE + nt * 128;
            epi_f32(wl, lane, [&](int n, int j) { return acc[m][n][j]; },
                    [&](int row, int ch, f32x4 v) { *(f32x4*)(dst + (size_t)row * NE + ch * 4) = v; });
        }
    }
}

__device__ void ph_topk(const Params& p) {
    const int tid = otid(), lane = tid & 63, wid = tid >> 6;
    for (int tok = blockIdx.x * 4 + wid; tok < T; tok += gridDim.x * 4) {
        float sc[4], bv[4];
#pragma unroll
        for (int j = 0; j < 4; ++j) {
            const int e = j * 64 + lane;
            const size_t o = (size_t)tok * NE + e;
            const float x = (p.lgp[o] + p.lgp[(size_t)T * NE + o]) + p.lgp[(size_t)2 * T * NE + o];
            sc[j] = 1.f / (1.f + expf(-x));
            bv[j] = sc[j] + p.router_bias[e];
        }
        float gsum[4];
#pragma unroll
        for (int j = 0; j < 4; ++j) {
            float m1 = bv[j];
#pragma unroll
            for (int o = 16; o > 0; o >>= 1) m1 = fmaxf(m1, __shfl_xor(m1, o, 64));
            const unsigned long long bal = __ballot(bv[j] == m1);
            const unsigned hm = (unsigned)(bal >> (lane & 32));
            const int first = __ffs(hm) - 1;
            float m2 = ((lane & 31) == first) ? -INFINITY : bv[j];
#pragma unroll
            for (int o = 16; o > 0; o >>= 1) m2 = fmaxf(m2, __shfl_xor(m2, o, 64));
            gsum[j] = m1 + m2;
        }
        float gs[8];
#pragma unroll
        for (int j = 0; j < 4; ++j) { gs[2 * j] = __shfl(gsum[j], 0, 64); gs[2 * j + 1] = __shfl(gsum[j], 32, 64); }
        unsigned gmask = 0u;
#pragma unroll
        for (int r = 0; r < 4; ++r) {
            float best = -INFINITY; int bi = 0;
#pragma unroll
            for (int g = 0; g < 8; ++g) {
                const bool ok = (((gmask >> g) & 1u) == 0u) && (gs[g] > best);
                if (ok) { best = gs[g]; bi = g; }
            }
            gmask |= 1u << bi;
        }
        float cand[4];
#pragma unroll
        for (int j = 0; j < 4; ++j) cand[j] = ((gmask >> (2 * j + (lane >> 5))) & 1u) ? bv[j] : -INFINITY;
        float wsum = 0.f, myw = 0.f;
        int mye = 0;
#pragma unroll
        for (int r = 0; r < 8; ++r) {
            float bvv = cand[0]; int be = lane;
#pragma unroll
            for (int j = 1; j < 4; ++j) if (cand[j] > bvv) { bvv = cand[j]; be = j * 64 + lane; }
#pragma unroll
            for (int o = 32; o > 0; o >>= 1) {
                const float ov = __shfl_xor(bvv, o, 64);
                const int oe = __shfl_xor(be, o, 64);
                if (ov > bvv || (ov == bvv && oe < be)) { bvv = ov; be = oe; }
            }
            const int bj = be >> 6;
            const float mysc = bj == 0 ? sc[0] : (bj == 1 ? sc[1] : (bj == 2 ? sc[2] : sc[3]));
            const float sval = __shfl(mysc, be & 63, 64);
#pragma unroll
            for (int j = 0; j < 4; ++j) if (be == j * 64 + lane) cand[j] = -INFINITY;
            wsum += sval;
            if (lane == r) { myw = sval; mye = be; }
        }
        if (lane < 8) {
            const int a = tok * 8 + lane;
            p.topi[a] = mye;
            p.topw[a] = myw * (2.5f / wsum);
        }
    }
}

__device__ void ph_lists(const Params& p, char* smem) {
    const int tid = otid(), lane = tid & 63, wid = tid >> 6;
    int* wtot = (int*)smem;
    for (int e = blockIdx.x; e < NE; e += gridDim.x) {
        __syncthreads();
        const int4* src = (const int4*)p.topi + wid * 8192;
        int cntw = 0;
        for (int i = 0; i < 128; ++i) {
            const int4 v = src[i * 64 + lane];
            cntw += __popcll(__ballot(v.x == e)) + __popcll(__ballot(v.y == e)) + __popcll(__ballot(v.z == e)) + __popcll(__ballot(v.w == e));
        }
        if (lane == 0) wtot[wid] = cntw;
        __syncthreads();
        int base = 0;
        for (int w = 0; w < wid; ++w) base += wtot[w];
        if (tid == 0) p.cnt[e] = wtot[0] + wtot[1] + wtot[2] + wtot[3];
        int* dst = p.list + (size_t)e * T;
        const unsigned long long lt = (1ull << lane) - 1ull;
        for (int i = 0; i < 128; ++i) {
            const int4 v = src[i * 64 + lane];
            const int a0 = (wid * 8192 + i * 64 + lane) * 4;
            unsigned long long m;
            m = __ballot(v.x == e); if (v.x == e) dst[base + __popcll(m & lt)] = a0;     base += __popcll(m);
            m = __ballot(v.y == e); if (v.y == e) dst[base + __popcll(m & lt)] = a0 + 1; base += __popcll(m);
            m = __ballot(v.z == e); if (v.z == e) dst[base + __popcll(m & lt)] = a0 + 2; base += __popcll(m);
            m = __ballot(v.w == e); if (v.w == e) dst[base + __popcll(m & lt)] = a0 + 3; base += __popcll(m);
        }
    }
}

struct ExpMap { int* cnt; int* off; int* tile; };
__device__ __forceinline__ ExpMap exp_map(const Params& p, char* smem) {
    ExpMap m;
    m.cnt = (int*)(smem + 49152); m.off = m.cnt + 256; m.tile = m.off + 256;
    const int tid = otid();
    __syncthreads();
    m.cnt[tid] = p.cnt[tid];
    __syncthreads();
    if (tid == 0) {
        int off = 0, tl = 0;
        for (int e = 0; e < NE; ++e) { m.off[e] = off; m.tile[e] = tl; const int c = m.cnt[e]; off += c; tl += (c + 255) >> 8; }
        m.tile[NE] = tl;
    }
    __syncthreads();
    return m;
}
__device__ __forceinline__ int find_expert(const int* tile, int rt) {
    int lo = 0, hi = NE;
    while (hi - lo > 1) { const int mid = (lo + hi) >> 1; if (tile[mid] <= rt) lo = mid; else hi = mid; }
    return lo;
}
#define ROWA(smem) ((int*)((smem) + 49152 + 3328))
#define ROWW(smem) ((float*)((smem) + 49152 + 3328 + 1024))

__device__ void ph_gateup(const Params& p, char* smem) {
    const int tid = otid(), lane = tid & 63, wid = tid >> 6;
    const ExpMap em = exp_map(p, smem);
    int* rowA = ROWA(smem);
    const int ntile = em.tile[NE];
    const int U = (ntile + T / 256) * 4;
    const int xcd = blockIdx.x & 7, nbx = gridDim.x >> 3;
    const int lo = (int)(((long long)U * xcd) >> 3), hi = (int)(((long long)U * (xcd + 1)) >> 3);
    for (int u = lo + (blockIdx.x >> 3); u < hi; u += nbx) {
        const int rt = u >> 2, c0 = (u & 3) * 64;
        const float *Wg, *Wu;
        bf16_t* gdst;
        int nrow, tokv;
        if (rt < ntile) {
            const int e = find_expert(em.tile, rt);
            const int r0 = (rt - em.tile[e]) * 256, ne = em.cnt[e];
            Wg = p.w_eg + (size_t)e * D * ED; Wu = p.w_eu + (size_t)e * D * ED;
            gdst = p.gbuf + ((size_t)em.off[e] + r0) * ED + c0;
            nrow = ne - r0;
            tokv = (r0 + tid < ne) ? (p.list[(size_t)e * T + r0 + tid] >> 3) : -1;
        } else {
            const int tb = (rt - ntile) * 256;
            Wg = p.w_sg; Wu = p.w_su;
            gdst = p.gsh + (size_t)tb * ED + c0;
            nrow = 256;
            tokv = tb + tid;
        }
        __syncthreads();
        rowA[tid] = tokv;
        __syncthreads();
        const int t0 = rowA[0];
        f32x4 acc[4][8];
        gemm2<0>(smem, D,
                 [&](int r) { const int t = rowA[r]; return p.h2 + (size_t)(t < 0 ? t0 : t) * 2048; },
                 [&](int n) { const int t16 = n >> 4; return ((t16 & 1) ? Wu : Wg) + c0 + 16 * (t16 >> 1) + (n & 15); },
                 ED, acc, nrow);
        if (wid * 64 < nrow) {
            char* wl = smem + wid * EPI_WAVE;
#pragma unroll
            for (int m = 0; m < 4; ++m) {
                const int rb = wid * 64 + m * 16;
                epi_bf16(wl, lane,
                         [&](int n, int j) { if (n >= 4) return 0.f; const float g = acc[m][2 * n][j], uu = acc[m][2 * n + 1][j]; return g / (1.f + __expf(-g)) * uu; },
                         [&](int row, int ch, u32x4 v) { if (ch < 8 && rb + row < nrow) *(u32x4*)(gdst + (size_t)(rb + row) * ED + ch * 8) = v; });
            }
        }
    }
}

__device__ void ph_down(const Params& p, char* smem) {
    const int tid = otid(), lane = tid & 63, wid = tid >> 6;
    const ExpMap em = exp_map(p, smem);
    int* rowA = ROWA(smem);
    float* rowW = ROWW(smem);
    const int ntile = em.tile[NE];
    const int U = (ntile + T / 256) * 8;
    const int xcd = blockIdx.x & 7, nbx = gridDim.x >> 3;
    const int lo = (int)(((long long)U * xcd) >> 3), hi = (int)(((long long)U * (xcd + 1)) >> 3);
    for (int u = lo + (blockIdx.x >> 3); u < hi; u += nbx) {
        const int rt = u >> 3, nt = u & 7;
        const bf16_t* A;
        const float* W;
        int nrow, slot;
        float wv;
        if (rt < ntile) {
            const int e = find_expert(em.tile, rt);
            const int r0 = (rt - em.tile[e]) * 256, ne = em.cnt[e];
            A = p.gbuf + ((size_t)em.off[e] + r0) * ED;
            W = p.w_ed + (size_t)e * ED * D + nt * 128;
            nrow = ne - r0;
            const int a = (r0 + tid < ne) ? p.list[(size_t)e * T + r0 + tid] : -1;
            slot = (a >= 0) ? (a >> 3) * 9 + (a & 7) : -1;
            wv = (a >= 0) ? p.topw[a] : 0.f;
        } else {
            const int tb = (rt - ntile) * 256;
            A = p.gsh + (size_t)tb * ED;
            W = p.w_sd + nt * 128;
            nrow = 256;
            slot = (tb + tid) * 9 + 8;
            wv = 1.f;
        }
        __syncthreads();
        rowA[tid] = slot;
        rowW[tid] = wv;
        __syncthreads();
        f32x4 acc[4][8];
        gemm2<0>(smem, ED, [&](int r) { return A + (size_t)(r < nrow ? r : 0) * ED; }, [&](int n) { return W + n; }, D, acc, nrow);
        if (wid * 64 < nrow) {
            char* wl = smem + wid * EPI_WAVE;
#pragma unroll
            for (int m = 0; m < 4; ++m) {
                const int rb = wid * 64 + m * 16;
                float wj[4];
#pragma unroll
                for (int j = 0; j < 4; ++j) wj[j] = rowW[rb + (lane >> 4) * 4 + j];
                epi_bf16(wl, lane, [&](int n, int j) { return acc[m][n][j] * wj[j]; },
                         [&](int row, int ch, u32x4 v) {
                             const int sl = rowA[rb + row];
                             if (sl >= 0) *(u32x4*)(p.ybuf + (size_t)sl * D + nt * 128 + ch * 8) = v;
                         });
            }
        }
    }
}

__device__ void ph_final(const Params& p) {
    const int tid = otid(), lane = tid & 63, wid = tid >> 6;
    for (int row = blockIdx.x * 4 + wid; row < T; row += gridDim.x * 4) {
        const int b = row >> 12;
        const float* g2 = p.mod + b * 6144 + 5120;
        float4 v[4];
        float s = 0.f;
#pragma unroll
        for (int i = 0; i < 4; ++i) {
            const int col = (lane + 64 * i) * 4;
            float f0 = 0.f, f1 = 0.f, f2 = 0.f, f3 = 0.f;
#pragma unroll
            for (int k = 0; k < 9; ++k) {
                const uint2 w = *(const uint2*)(p.ybuf + ((size_t)row * 9 + k) * D + col);
                f0 += __uint_as_float(w.x << 16); f1 += __uint_as_float(w.x & 0xffff0000u);
                f2 += __uint_as_float(w.y << 16); f3 += __uint_as_float(w.y & 0xffff0000u);
            }
            const float4 xv = *(const float4*)(p.x1 + (size_t)row * D + col);
            const float4 g4 = *(const float4*)(g2 + col);
            v[i].x = ALPHA * xv.x + g4.x * f0; v[i].y = ALPHA * xv.y + g4.y * f1;
            v[i].z = ALPHA * xv.z + g4.z * f2; v[i].w = ALPHA * xv.w + g4.w * f3;
            s += v[i].x + v[i].y + v[i].z + v[i].w;
        }
        const float mean = wave_sum(s) * (1.f / D);
        float q = 0.f;
#pragma unroll
        for (int i = 0; i < 4; ++i) {
            v[i].x -= mean; v[i].y -= mean; v[i].z -= mean; v[i].w -= mean;
            q += v[i].x * v[i].x + v[i].y * v[i].y + v[i].z * v[i].z + v[i].w * v[i].w;
        }
        const float rstd = rsqrtf(wave_sum(q) * (1.f / D) + LN_EPS);
#pragma unroll
        for (int i = 0; i < 4; ++i) {
            const int col = (lane + 64 * i) * 4;
            const float4 g4 = *(const float4*)(p.ln2_g + col), b4 = *(const float4*)(p.ln2_b + col);
            float4 y;
            y.x = v[i].x * rstd * g4.x + b4.x; y.y = v[i].y * rstd * g4.y + b4.y;
            y.z = v[i].z * rstd * g4.z + b4.z; y.w = v[i].w * rstd * g4.w + b4.w;
            *(float4*)(p.out + (size_t)row * D + col) = y;
        }
    }
}

constexpr int LDS_BYTES = 67584;
constexpr int NPHASE = 14;

template <int PH>
__device__ __forceinline__ void run_phase(const Params& p, char* smem) {
    if (PH == 0) ph_mod(p, smem);
    if (PH == 1) ph_ln0(p);
    if (PH == 2) ph_inproj(p, smem);
    if (PH == 3) { ph_h1(p, smem); ph_attn(p, smem); }
    if (PH == 4) { ph_h2(p); ph_attn_merge(p); }
    if (PH == 5) ph_h3(p, smem);
    if (PH == 6) ph_outproj(p, smem);
    if (PH == 7) ph_ln1(p);
    if (PH == 8) ph_router_gemm(p, smem);
    if (PH == 9) ph_topk(p);
    if (PH == 10) ph_lists(p, smem);
    if (PH == 11) ph_gateup(p, smem);
    if (PH == 12) ph_down(p, smem);
    if (PH == 13) ph_final(p);
}

template <int PH>
__global__ void __launch_bounds__(NTHREADS, 2) k_phase(Params p) {
    extern __shared__ __attribute__((aligned(16))) char smem[];
    run_phase<PH>(p, smem);
}

__global__ void __launch_bounds__(NTHREADS, 2) k_all(Params p) {
    extern __shared__ __attribute__((aligned(16))) char smem[];
    volatile LAS unsigned* st = (volatile LAS unsigned*)(smem + LDS_BYTES - 16);
    if (threadIdx.x == 0) { st[0] = 0u; st[1] = 0u; st[2] = 0u; st[3] = 0u; }
    __syncthreads();
    XcdBarrier bar = xcd_barrier_post(p.bar, st);
    run_phase<0>(p, smem); xcd_barrier(bar);
    run_phase<1>(p, smem); xcd_barrier(bar);
    run_phase<2>(p, smem); xcd_barrier(bar);
    run_phase<3>(p, smem); xcd_barrier(bar);
    run_phase<4>(p, smem); xcd_barrier(bar);
    run_phase<5>(p, smem); xcd_barrier(bar);
    run_phase<6>(p, smem); xcd_barrier(bar);
    run_phase<7>(p, smem); xcd_barrier(bar);
    run_phase<8>(p, smem); xcd_barrier(bar);
    run_phase<9>(p, smem); xcd_barrier(bar);
    run_phase<10>(p, smem); xcd_barrier(bar);
    run_phase<11>(p, smem); xcd_barrier(bar);
    run_phase<12>(p, smem); xcd_barrier(bar);
    run_phase<13>(p, smem);
}

template <int PH>
static void launch_phase(const Params& p, int grid, hipStream_t stream) {
    hipLaunchKernelGGL(k_phase<PH>, dim3(grid), dim3(NTHREADS), LDS_BYTES, stream, p);
}

extern "C" void kernel_launch(void* const* d_in, const int* in_sizes, int n_in, void* d_out, int out_size, void* d_ws, size_t ws_size,
                              hipStream_t stream) {
    (void)in_sizes; (void)n_in; (void)out_size;
    Params p{};
    const float** pin = (const float**)&p.x;
    for (int i = 0; i < 21; ++i) pin[i] = (const float*)d_in[i];
    p.out = (float*)d_out;
    char* ws = (char*)d_ws;
    size_t off = 0;
    auto carve = [&](size_t bytes) { char* r = ws + off; off += (bytes + 255) & ~(size_t)255; return r; };
    char* ctl = carve(65536);
    p.bar = (unsigned*)ctl;
    p.cnt = (int*)(ctl + 16384);
    p.mod = (float*)carve(4 * 6144 * 4);
    p.lbv = (float*)carve(512 * 4);
    p.biasT = (float*)carve(3 * 129 * 4 * 4);
    p.h1 = (bf16_t*)carve((size_t)T * D * 2);
    p.proj = (bf16_t*)carve((size_t)T * INW * 2);
    p.lgf = (float*)carve((size_t)T * 512 * 4);
    p.ao = (float*)carve((size_t)3 * T * 256 * 4);
    p.alse = (float*)carve((size_t)3 * T * 4 * 4);
    p.mixin = (bf16_t*)carve((size_t)T * 768 * 2);
    p.pre1 = (float*)carve((size_t)T * D * 4);
    p.x1 = (float*)carve((size_t)T * D * 4);
    p.h2 = (bf16_t*)carve((size_t)T * 2048 * 2);
    p.wr2 = (float*)carve((size_t)2 * D * NE * 4);
    p.lgp = (float*)carve((size_t)3 * T * NE * 4);
    p.topi = (int*)carve((size_t)T * 8 * 4);
    p.topw = (float*)carve((size_t)T * 8 * 4);
    p.list = (int*)carve((size_t)NE * T * 4);
    p.gbuf = (bf16_t*)carve((size_t)T * TOPK * ED * 2);
    p.gsh = (bf16_t*)carve((size_t)T * ED * 2);
    p.ybuf = (bf16_t*)carve((size_t)T * 9 * D * 2);
    p.kv = (float*)p.ybuf;
    p.sst = (bf16_t*)((char*)p.ybuf + (size_t)1024 * 16384 * 4);
    p.dec = (float*)carve((size_t)1024 * 128 * 4);
    if (off > ws_size) { fprintf(stderr, "kernel_launch: workspace too small: need %zu have %zu\n", off, ws_size); return; }

    static int grid = 0;
    if (grid == 0) {
        int dev = 0, cus = 0, per_cu = 0;
        hipGetDevice(&dev);
        hipDeviceGetAttribute(&cus, hipDeviceAttributeMultiprocessorCount, dev);
        hipFuncSetAttribute((const void*)k_all, hipFuncAttributeMaxDynamicSharedMemorySize, LDS_BYTES);
        hipOccupancyMaxActiveBlocksPerMultiprocessor(&per_cu, (const void*)k_all, NTHREADS, LDS_BYTES);
        if (per_cu < 1) per_cu = 1;
        grid = cus * (per_cu < 2 ? per_cu : 2);
        fprintf(stderr, "kernel_launch: cus %d per_cu %d grid %d ws need %zu have %zu\n", cus, per_cu, grid, off, ws_size);
    }
    hipMemsetAsync(ctl, 0, 65536, stream);
#if ONE_LAUNCH
    hipLaunchKernelGGL(k_all, dim3(grid), dim3(NTHREADS), LDS_BYTES, stream, p);
#else
    launch_phase<0>(p, grid, stream); launch_phase<1>(p, grid, stream); launch_phase<2>(p, grid, stream); launch_phase<3>(p, grid, stream);
    launch_phase<4>(p, grid, stream); launch_phase<5>(p, grid, stream); launch_phase<6>(p, grid, stream); launch_phase<7>(p, grid, stream);
    launch_phase<8>(p, grid, stream); launch_phase<9>(p, grid, stream); launch_phase<10>(p, grid, stream); launch_phase<11>(p, grid, stream); launch_phase<12>(p, grid, stream); launch_phase<13>(p, grid, stream);
#endif
}
```

```cpp
#include <hip/hip_runtime.h>
#include <stdint.h>
#include <stdio.h>

#ifndef ONE_LAUNCH
#define ONE_LAUNCH 1
#endif

constexpr int D = 1024, NBATCH = 4, S = 4096, T = NBATCH * S;
constexpr int INW = 4352;
constexpr int NE = 256, TOPK = 8, ED = 256;
constexpr int OFF_HQ = 0, OFF_HF = 512, OFF_HI = 1024, OFF_HG = 1536, OFF_AQ = 2048, OFF_AK = 2816, OFF_AV = 3584;
constexpr float ALPHA = 1.189207115002721f;
constexpr float LN_EPS = 1e-5f, RMS_EPS = 1e-6f;
constexpr int NTHREADS = 512;
constexpr int VB_LDS = 67584;

typedef unsigned short bf16_t;
using bf16x8 = __attribute__((ext_vector_type(8))) short;
using f32x4 = __attribute__((ext_vector_type(4))) float;
using u32x4 = __attribute__((ext_vector_type(4))) unsigned int;

typedef float v2f_t __attribute__((ext_vector_type(2)));
typedef __bf16 v2bf_t __attribute__((ext_vector_type(2)));
typedef short v4s __attribute__((ext_vector_type(4)));
__device__ __forceinline__ unsigned short f2bf(float f) { return __builtin_bit_cast(unsigned short, (__bf16)f); }
__device__ __forceinline__ float bf2f(unsigned short h) { return __uint_as_float(((uint32_t)h) << 16); }
__device__ __forceinline__ uint32_t pack2(float a, float b) {
    const v2f_t f = {a, b};
    return __builtin_bit_cast(uint32_t, __builtin_convertvector(f, v2bf_t));
}
__device__ __forceinline__ float sigmoidf_(float v) { return 1.f / (1.f + __expf(-v)); }

__device__ __forceinline__ int otid() { int t = threadIdx.x; asm volatile("" : "+v"(t)); return t; }

struct Params {
    const float *x, *c, *w_ada, *b_ada, *w_in, *hg_lb, *hg_nw, *rel_bias, *w_out, *ln1_g, *ln1_b, *w_router, *router_bias,
        *w_eg, *w_eu, *w_ed, *w_sg, *w_su, *w_sd, *ln2_g, *ln2_b;
    float* out;
    unsigned* bar;
    int* cnt;
    float* mod;
    float* lbv;
    float* biasT;
    bf16_t* h1;
    bf16_t* proj;
    float* lgf;
    float* ao;
    float* alse;
    bf16_t* mixin;
    float* pre1;
    float* x1;
    bf16_t* h2;
    bf16_t* winT;
    bf16_t* woutT;
    bf16_t* wrT;
    bf16_t* wsgT;
    bf16_t* wsuT;
    bf16_t* wsdT;
    float* lgp;
    int* topi;
    float* topw;
    int* list;
    bf16_t* gbuf;
    bf16_t* gsh;
    bf16_t* ybuf;
    float* kv;
    float* dec;
    bf16_t* sst;
};

#define XB_TMO      128
#define XB_XCNT(j)  (256  + 64 * (j))
#define XB_XSUB(j)  (1280 + 64 * (j))
#define XB_XGEN(j)  (2304 + 64 * (j))
#define XB_TOP      3328
#define XB_TOPGEN   3392
#define XCD_BAR_WORDS 3456
#define XB_SPIN_CAP (1u << 18)
#define LAS __attribute__((address_space(3)))

__device__ __forceinline__ unsigned xb_ld(unsigned* p)              { return __hip_atomic_load(p, __ATOMIC_RELAXED, __HIP_MEMORY_SCOPE_AGENT); }
__device__ __forceinline__ unsigned xb_add(unsigned* p, unsigned v) { return __hip_atomic_fetch_add(p, v, __ATOMIC_RELAXED, __HIP_MEMORY_SCOPE_AGENT); }
__device__ __forceinline__ unsigned xb_xcc_id() { return (unsigned)__builtin_amdgcn_s_getreg((3 << 11) | 20) & 0xFu; }
#define XB_SPIN(cond, bar) do { unsigned _sp = 0; while (cond) { __builtin_amdgcn_s_sleep(1); \
    if ((++_sp & 255u) == 0u) { if (xb_ld(&(bar)[XB_TMO])) break; if (_sp > XB_SPIN_CAP) { atomicAdd(&(bar)[XB_TMO], 1u); break; } } } } while (0)

struct XcdBarrier {
    unsigned* bar; unsigned x;
    volatile LAS unsigned* st;
};
__device__ __forceinline__ XcdBarrier xcd_barrier_post(unsigned* bar, volatile LAS unsigned* st) {
    XcdBarrier b; b.bar = bar; b.x = xb_xcc_id(); b.st = st;
    if (threadIdx.x == 0) (void)xb_add(&bar[XB_XCNT(b.x)], 1u);
    return b;
}
__device__ __forceinline__ void xcd_barrier_complete(unsigned* bar, unsigned x, unsigned& nloc, unsigned& nx) {
    const unsigned G = gridDim.x * gridDim.y * gridDim.z;
    unsigned sum, cnt, mine, sp = 0u;
    for (;;) {
        sum = 0u; cnt = 0u; mine = 0u;
#pragma unroll
        for (unsigned j = 0; j < 16; ++j) { const unsigned c = xb_ld(&bar[XB_XCNT(j)]); sum += c; cnt += (c > 0u) ? 1u : 0u; mine = (j == x) ? c : mine; }
        if (sum == G) break;
        __builtin_amdgcn_s_sleep(1);
        if ((++sp & 255u) == 0u) { if (xb_ld(&bar[XB_TMO])) break; if (sp > XB_SPIN_CAP) { atomicAdd(&bar[XB_TMO], 1u); break; } }
    }
    nloc = mine > 0u ? mine : 1u; nx = cnt > 0u ? cnt : 1u;
}
__device__ __forceinline__ void xcd_barrier(const XcdBarrier& b) {
    asm volatile("s_waitcnt vmcnt(0)" ::: "memory");
    __syncthreads();
    if (threadIdx.x == 0) {
        unsigned* bar = b.bar;
        __builtin_amdgcn_s_waitcnt(0);
        unsigned nloc = b.st[0], nx = b.st[1];
        if (nloc == 0u) { xcd_barrier_complete(bar, b.x, nloc, nx); b.st[0] = nloc; b.st[1] = nx; }
        const unsigned old = xb_add(&bar[XB_XSUB(b.x)], 1u);
        const unsigned gen = old / nloc;
        if (old + 1u == (gen + 1u) * nloc) {
            __builtin_amdgcn_fence(__ATOMIC_RELEASE, "agent");
            asm volatile("s_waitcnt vmcnt(0)" ::: "memory");
            const unsigned og = xb_add(&bar[XB_TOP], 1u);
            const unsigned tg = og / nx;
            if (og + 1u == (tg + 1u) * nx) xb_add(&bar[XB_TOPGEN], 1u);
            else XB_SPIN(xb_ld(&bar[XB_TOPGEN]) == tg, bar);
            __builtin_amdgcn_fence(__ATOMIC_ACQUIRE, "agent");
            xb_add(&bar[XB_XGEN(b.x)], 1u);
            asm volatile("s_waitcnt vmcnt(0)" ::: "memory");
        } else {
            XB_SPIN(xb_ld(&bar[XB_XGEN(b.x)]) == gen, bar);
            __builtin_amdgcn_fence(__ATOMIC_ACQUIRE, "agent");
            asm volatile("s_waitcnt vmcnt(0)" ::: "memory");
        }
    }
    __syncthreads();
}

struct VB { int vb, nvb, tid; char* smem; };
__device__ __forceinline__ VB make_vb(char* smem) {
    const int t = otid();
    VB v; v.vb = (int)blockIdx.x * 2 + (t >> 8); v.nvb = (int)gridDim.x * 2; v.tid = t & 255; v.smem = smem + (t >> 8) * VB_LDS;
    return v;
}
__device__ __forceinline__ int swz(int row, int chunk) { return row * 128 + ((chunk ^ ((row >> 1) & 7)) << 4); }

__device__ __forceinline__ float wave_sum(float v) {
#pragma unroll
    for (int o = 32; o > 0; o >>= 1) v += __shfl_xor(v, o, 64);
    return v;
}

__device__ __forceinline__ int t5_bucket(int n) {
    if (n < 16) return n;
    const float v = logf((float)n / 16.f) / logf(128.f) * 16.f;
    int large = 16 + (int)v;
    return large < 31 ? large : 31;
}

__device__ __forceinline__ void tr_tile(const VB& v, const float* src, int ld, bf16_t* dst, bf16_t* dst2, int ldd, int k0, int n0) {
    float* t = (float*)v.smem;
    __syncthreads();
#pragma unroll
    for (int i = 0; i < 4; ++i) {
        const int r = (v.tid >> 4) + 16 * i, c4 = v.tid & 15;
        const f32x4 x = *(const f32x4*)(src + (size_t)(k0 + r) * ld + n0 + c4 * 4);
        t[r * 65 + c4 * 4 + 0] = x[0]; t[r * 65 + c4 * 4 + 1] = x[1]; t[r * 65 + c4 * 4 + 2] = x[2]; t[r * 65 + c4 * 4 + 3] = x[3];
    }
    __syncthreads();
    const int n = v.tid >> 2, kq = v.tid & 3;
    float f[16];
#pragma unroll
    for (int i = 0; i < 16; ++i) f[i] = t[(kq * 16 + i) * 65 + n];
    u32x4 a, b;
    a[0] = pack2(f[0], f[1]); a[1] = pack2(f[2], f[3]); a[2] = pack2(f[4], f[5]); a[3] = pack2(f[6], f[7]);
    b[0] = pack2(f[8], f[9]); b[1] = pack2(f[10], f[11]); b[2] = pack2(f[12], f[13]); b[3] = pack2(f[14], f[15]);
    bf16_t* d = dst + (size_t)(n0 + n) * ldd + k0 + kq * 16;
    *(u32x4*)d = a; *(u32x4*)(d + 8) = b;
    if (dst2) {
        u32x4 c, e;
#pragma unroll
        for (int i = 0; i < 4; ++i) {
            c[i] = pack2(f[2 * i] - __uint_as_float(a[i] << 16), f[2 * i + 1] - __uint_as_float(a[i] & 0xffff0000u));
            e[i] = pack2(f[8 + 2 * i] - __uint_as_float(b[i] << 16), f[8 + 2 * i + 1] - __uint_as_float(b[i] & 0xffff0000u));
        }
        bf16_t* d2 = dst2 + (size_t)(n0 + n) * ldd + k0 + kq * 16;
        *(u32x4*)d2 = c; *(u32x4*)(d2 + 8) = e;
    }
}

__device__ void ph_mod(const Params& p, char* smem0) {
    const VB v = make_vb(smem0);
    const int tid = v.tid;
    float* cond = (float*)(v.smem + 20480);
    float* red = cond + 4096;
    for (int i = tid; i < 4096; i += 256) { const float x = p.c[i]; cond[i] = x / (1.f + __expf(-x)); }
    __syncthreads();
    const int NU = 194 + 1088 + 192 + 64 + 64 + 64 + 64;
    const int rounds = (NU + v.nvb - 1) / v.nvb;
    for (int it = 0; it < rounds; ++it) {
        int u = v.vb + it * v.nvb;
        if (u >= NU) u = NU - 1;
        if (u < 192) {
            const int cl = tid & 31, kq = tid >> 5, n = u * 32 + cl;
            float a0 = 0.f, a1 = 0.f, a2 = 0.f, a3 = 0.f;
            for (int k = kq; k < 1024; k += 8) {
                const float w = p.w_ada[(size_t)k * 6144 + n];
                a0 += cond[k] * w; a1 += cond[1024 + k] * w; a2 += cond[2048 + k] * w; a3 += cond[3072 + k] * w;
            }
            red[(kq * 4 + 0) * 32 + cl] = a0; red[(kq * 4 + 1) * 32 + cl] = a1; red[(kq * 4 + 2) * 32 + cl] = a2; red[(kq * 4 + 3) * 32 + cl] = a3;
        }
        __syncthreads();
        if (u < 192) {
            if (tid < 128) {
                const int b = tid >> 5, c2 = tid & 31;
                float s = 0.f;
                for (int q = 0; q < 8; ++q) s += red[(q * 4 + b) * 32 + c2];
                p.mod[b * 6144 + u * 32 + c2] = s + p.b_ada[u * 32 + c2];
            }
        } else if (u == 192) {
            for (int j = tid; j < 512; j += 256) {
                const float a = p.hg_lb[j], b = p.hg_lb[512 + j];
                const float m = fmaxf(a, b);
                const float ea = expf(a - m), eb = expf(b - m);
                p.lbv[j] = ea / (ea + eb);
            }
        } else if (u == 193) {
            for (int i = tid; i < 3 * 129 * 4; i += 256) {
                const int g = i / (129 * 4), m = (i >> 2) % 129, hh = i & 3;
                const int dil = (g == 0) ? 1 : (g == 1 ? 4 : 16);
                p.biasT[i] = p.rel_bias[t5_bucket(m * dil) * 12 + g * 4 + hh];
            }
        }
        {
            int w = u - 194;
            const float* src = p.w_out; int ld = D; bf16_t* dst = p.woutT; bf16_t* dst2 = nullptr; int ldd = 768, k0 = 0, n0 = 0;
            if (w >= 0) {
                if (w < 1088) { src = p.w_in; ld = INW; dst = p.winT; ldd = D; k0 = (w / 68) * 64; n0 = (w % 68) * 64; }
                else if ((w -= 1088) < 192) { k0 = (w >> 4) * 64; n0 = (w & 15) * 64; }
                else if ((w -= 192) < 64) { src = p.w_router; ld = NE; dst = p.wrT; dst2 = p.wrT + (size_t)NE * D; ldd = D; k0 = (w >> 2) * 64; n0 = (w & 3) * 64; }
                else if ((w -= 64) < 64) { src = p.w_sg; ld = ED; dst = p.wsgT; ldd = D; k0 = (w >> 2) * 64; n0 = (w & 3) * 64; }
                else if ((w -= 64) < 64) { src = p.w_su; ld = ED; dst = p.wsuT; ldd = D; k0 = (w >> 2) * 64; n0 = (w & 3) * 64; }
                else { w -= 64; src = p.w_sd; ld = D; dst = p.wsdT; ldd = ED; k0 = (w >> 4) * 64; n0 = (w & 15) * 64; }
            }
            tr_tile(v, src, ld, dst, dst2, ldd, k0, n0);
        }
    }
}

__device__ void ph_ln0(const Params& p) {
    const int tid = otid(), lane = tid & 63, wid = tid >> 6;
    for (int row = blockIdx.x * 8 + wid; row < T; row += gridDim.x * 8) {
        const float4* xr = (const float4*)(p.x + (size_t)row * D);
        float4 v[4];
        float s = 0.f;
#pragma unroll
        for (int i = 0; i < 4; ++i) { v[i] = xr[lane + 64 * i]; s += v[i].x + v[i].y + v[i].z + v[i].w; }
        const float mean = wave_sum(s) * (1.f / D);
        float q = 0.f;
#pragma unroll
        for (int i = 0; i < 4; ++i) {
            v[i].x -= mean; v[i].y -= mean; v[i].z -= mean; v[i].w -= mean;
            q += v[i].x * v[i].x + v[i].y * v[i].y + v[i].z * v[i].z + v[i].w * v[i].w;
        }
        const float rstd = rsqrtf(wave_sum(q) * (1.f / D) + LN_EPS);
        const int b = row >> 12;
        const float* sh = p.mod + b * 6144;
        const float* sc = sh + 1024;
#pragma unroll
        for (int i = 0; i < 4; ++i) {
            const int col = (lane + 64 * i) * 4;
            const float4 s4 = *(const float4*)(sc + col), h4 = *(const float4*)(sh + col);
            uint2 o;
            o.x = pack2(v[i].x * rstd * (1.f + s4.x) + h4.x, v[i].y * rstd * (1.f + s4.y) + h4.y);
            o.y = pack2(v[i].z * rstd * (1.f + s4.z) + h4.z, v[i].w * rstd * (1.f + s4.w) + h4.w);
            *(uint2*)(p.h1 + (size_t)row * D + col) = o;
        }
    }
}

__device__ __forceinline__ int swz16(int row, int chunk) { return row * 256 + ((chunk ^ (row & 15)) << 4); }
__device__ __forceinline__ bf16x8 tr_frag16(const char* tile, int ks, int c) {
    const int lane = otid() & 63, g = lane >> 4, q = (lane & 15) >> 2, pp = lane & 3;
    const int r0 = 32 * ks + 8 * g + q, ch = 2 * c + (pp >> 1), bo = 8 * (pp & 1);
    const v4s lo = __builtin_amdgcn_ds_read_tr16_b64_v4i16((LAS v4s*)(tile + swz16(r0, ch) + bo));
    const v4s hi = __builtin_amdgcn_ds_read_tr16_b64_v4i16((LAS v4s*)(tile + swz16(r0 + 4, ch) + bo));
    return bf16x8{lo[0], lo[1], lo[2], lo[3], hi[0], hi[1], hi[2], hi[3]};
}


__device__ __forceinline__ int aoff(int row, int chunk) { return row * 64 + ((chunk ^ ((row >> 2) & 3)) << 4); }
__device__ __forceinline__ int boff(int row, int chunk) { return row * 512 + ((chunk ^ (((row & 3) << 2) | ((row >> 2) & 3))) << 4); }
__device__ __forceinline__ bf16x8 tr_frag32(const char* tile, int c) {
    const int lane = otid() & 63, g = lane >> 4, q = (lane & 15) >> 2, pp = lane & 3;
    const int r0 = 8 * g + q, ch = 2 * c + (pp >> 1), bo = 8 * (pp & 1);
    const v4s lo = __builtin_amdgcn_ds_read_tr16_b64_v4i16((LAS v4s*)(tile + boff(r0, ch) + bo));
    const v4s hi = __builtin_amdgcn_ds_read_tr16_b64_v4i16((LAS v4s*)(tile + boff(r0 + 4, ch) + bo));
    return bf16x8{lo[0], lo[1], lo[2], lo[3], hi[0], hi[1], hi[2], hi[3]};
}
constexpr int G3_STAGE = 32768;

template <int BMODE, class AF, class BF>
__device__ __forceinline__ void gemm3(char* smem, const int K, AF arow, BF bsrc, const int ldb, f32x4 (&acc)[4][8], const int nvalid = 256) {
    const int tid = otid(), lane = tid & 63, wid = tid >> 6, wr = wid >> 1, wc = wid & 1, fr = lane & 15, fq = lane >> 4;
    const bf16_t* ap[2];
#pragma unroll
    for (int i = 0; i < 2; ++i) ap[i] = arow((tid >> 2) + 128 * i) + (tid & 3) * 8;
    const float* bpf = nullptr;
    const bf16_t* bpb[2] = {nullptr, nullptr};
    if (BMODE == 0) bpf = (const float*)bsrc((tid & 63) * 4) + (size_t)(tid >> 6) * ldb;
    else {
#pragma unroll
        for (int i = 0; i < 2; ++i) bpb[i] = (const bf16_t*)bsrc((tid >> 2) + 128 * i) + (tid & 3) * 8;
    }
#pragma unroll
    for (int m = 0; m < 4; ++m)
#pragma unroll
        for (int n = 0; n < 8; ++n) acc[m][n] = f32x4{0.f, 0.f, 0.f, 0.f};
    u32x4 ra0[2], ra1[2];
    f32x4 rf0[4], rf1[4];
    u32x4 rb0[2], rb1[2];
    const bool active = wr * 64 < nvalid;
#define G3_GLOAD(RA, RF, RB, k0) do { \
        _Pragma("unroll") for (int i = 0; i < 2; ++i) RA[i] = *(const u32x4*)(ap[i] + (k0)); \
        if (BMODE == 0) { _Pragma("unroll") for (int j = 0; j < 4; ++j) RF[j] = *(const f32x4*)(bpf + (size_t)((k0) + 8 * j) * ldb); } \
        else { _Pragma("unroll") for (int i = 0; i < 2; ++i) RB[i] = *(const u32x4*)(bpb[i] + (k0)); } } while (0)
#define G3_LWRITE(RA, RF, RB, st) do { \
        char* sA_ = (st); char* sB_ = (st) + 16384; \
        _Pragma("unroll") for (int i = 0; i < 2; ++i) *(u32x4*)(sA_ + aoff((tid >> 2) + 128 * i, tid & 3)) = RA[i]; \
        if (BMODE == 0) { _Pragma("unroll") for (int j = 0; j < 4; ++j) { uint2 w_; w_.x = pack2(RF[j][0], RF[j][1]); w_.y = pack2(RF[j][2], RF[j][3]); \
                *(uint2*)(sB_ + boff((tid >> 6) + 8 * j, (tid & 63) >> 1) + (tid & 1) * 8) = w_; } } \
        else { _Pragma("unroll") for (int i = 0; i < 2; ++i) *(u32x4*)(sB_ + aoff((tid >> 2) + 128 * i, tid & 3)) = RB[i]; } } while (0)
#define G3_COMPUTE(st) do { if (active) { \
        const char* sA_ = (st); const char* sB_ = (st) + 16384; \
        bf16x8 af[4]; \
        _Pragma("unroll") for (int m = 0; m < 4; ++m) af[m] = *(const bf16x8*)(sA_ + aoff(wr * 64 + m * 16 + fr, fq)); \
        _Pragma("unroll") for (int n = 0; n < 8; ++n) { \
            bf16x8 bfr; \
            if (BMODE == 0) bfr = tr_frag32(sB_, wc * 8 + n); else bfr = *(const bf16x8*)(sB_ + aoff(wc * 128 + n * 16 + fr, fq)); \
            _Pragma("unroll") for (int m = 0; m < 4; ++m) acc[m][n] = __builtin_amdgcn_mfma_f32_16x16x32_bf16(af[m], bfr, acc[m][n], 0, 0, 0); } } } while (0)
    const int nk = K >> 5;
    char* st0 = smem;
    char* st1 = smem + G3_STAGE;
    G3_GLOAD(ra0, rf0, rb0, 0);
    G3_GLOAD(ra1, rf1, rb1, 32);
    G3_LWRITE(ra0, rf0, rb0, st0);
    if (nk > 2) G3_GLOAD(ra0, rf0, rb0, 64);
    __syncthreads();
    for (int kt = 0; kt < nk; kt += 2) {
        G3_LWRITE(ra1, rf1, rb1, st1);
        if (kt + 3 < nk) G3_GLOAD(ra1, rf1, rb1, (kt + 3) * 32);
        G3_COMPUTE(st0);
        __syncthreads();
        if (kt + 2 < nk) G3_LWRITE(ra0, rf0, rb0, st0);
        if (kt + 4 < nk) G3_GLOAD(ra0, rf0, rb0, (kt + 4) * 32);
        G3_COMPUTE(st1);
        __syncthreads();
    }
#undef G3_GLOAD
#undef G3_LWRITE
#undef G3_COMPUTE
}
constexpr int EPI_WAVE = 8704;
template <class VF, class SF>
__device__ __forceinline__ void epi_bf16(char* wl, const int lane, VF val, SF store) {
    const int fr = lane & 15, fq = lane >> 4, odd = lane & 1;
#pragma unroll
    for (int n = 0; n < 8; ++n)
#pragma unroll
        for (int jp = 0; jp < 2; ++jp) {
            const float a = val(n, 2 * jp), b = val(n, 2 * jp + 1);
            const float x = odd ? a : b;
            const float y = __shfl_xor(x, 1, 64);
            const uint32_t w = odd ? pack2(y, b) : pack2(a, y);
            *(uint32_t*)(wl + (fq * 4 + 2 * jp + odd) * 272 + (n * 16 + (fr & ~1)) * 2) = w;
        }
    int ln = lane;
    asm volatile("" : "+v"(ln));
#pragma unroll
    for (int i = 0; i < 4; ++i) {
        const int idx = ln + 64 * i, row = idx >> 4, ch = idx & 15;
        store(row, ch, *(const u32x4*)(wl + row * 272 + ch * 16));
    }
}
template <class VF, class SF>
__device__ __forceinline__ void epi_f32(char* wl, const int lane, VF val, SF store) {
    const int fr = lane & 15, fq = lane >> 4;
#pragma unroll
    for (int n = 0; n < 8; ++n)
#pragma unroll
        for (int j = 0; j < 4; ++j) *(float*)(wl + (fq * 4 + j) * 528 + (n * 16 + fr) * 4) = val(n, j);
    int ln = lane;
    asm volatile("" : "+v"(ln));
#pragma unroll
    for (int i = 0; i < 8; ++i) {
        const int idx = ln + 64 * i, row = idx >> 5, ch = idx & 31;
        store(row, ch, *(const f32x4*)(wl + row * 528 + ch * 16));
    }
}

__device__ void ph_inproj(const Params& p, char* smem) {
    const int tid = otid(), lane = tid & 63, wid = tid >> 6, wr = wid >> 1, wc = wid & 1, fr = lane & 15;
    const int NTN = INW / 256;
    const int xcd = blockIdx.x & 7, nbx = gridDim.x >> 3;
    for (int i = blockIdx.x >> 3; i < 8 * NTN; i += nbx) {
        const int nt = i >> 3, mt = xcd * 8 + (i & 7);
        const bf16_t* A = p.h1 + (size_t)mt * 256 * D;
        const bf16_t* Bt = p.winT + (size_t)nt * 256 * D;
        f32x4 acc[4][8];
        __syncthreads();
        gemm3<1>(smem, D, [&](int r) { return A + (size_t)r * D; }, [&](int n) { return Bt + (size_t)n * D; }, 0, acc);
        char* wl = smem + wid * EPI_WAVE;
        const int colb = nt * 256 + wc * 128;
        const int rowb = mt * 256 + wr * 64;
        if (colb >= OFF_HF && colb < OFF_HI) {
            float lbc[8];
#pragma unroll
            for (int n = 0; n < 8; ++n) lbc[n] = p.lbv[colb - OFF_HF + n * 16 + fr];
#pragma unroll
            for (int m = 0; m < 4; ++m) {
                float* dst = p.lgf + (size_t)(rowb + m * 16) * 512 + (colb - OFF_HF);
                epi_f32(wl, lane,
                        [&](int n, int j) { return logf(lbc[n] + (1.f - lbc[n]) * (1.f / (1.f + expf(-acc[m][n][j])))); },
                        [&](int row, int ch, f32x4 v) { *(f32x4*)(dst + (size_t)row * 512 + ch * 4) = v; });
            }
        } else {
#pragma unroll
            for (int m = 0; m < 4; ++m) {
                bf16_t* dst = p.proj + (size_t)(rowb + m * 16) * INW + colb;
                epi_bf16(wl, lane, [&](int n, int j) { return acc[m][n][j]; },
                         [&](int row, int ch, u32x4 v) { *(u32x4*)(dst + (size_t)row * INW + ch * 8) = v; });
            }
        }
    }
}

__device__ void ph_h1(const Params& p, char* smem0) {
    const VB vbk = make_vb(smem0);
    char* smem = vbk.smem;
    const int tid = vbk.tid, lane = tid & 63, wid = tid >> 6, wr = wid >> 1, wc = wid & 1, fr = lane & 15, fq = lane >> 4;
    char* sI = smem;
    char* sK = smem + 16384;
    float* sL = (float*)(smem + 32768);
    float* totS = (float*)(smem + 65536);
    const int d = tid & 127, half = tid >> 7;
    for (int u = vbk.vb; u < 1024; u += vbk.nvb) {
        const int bh = u >> 6, c = u & 63, b = bh >> 2, h = bh & 3;
        const size_t row0 = (size_t)b * S + c * 64;
        __syncthreads();
#pragma unroll
        for (int i = 0; i < 4; ++i) {
            const int idx = tid + 256 * i, r = idx >> 4, ch = idx & 15;
            *(u32x4*)(sI + swz16(r, ch)) = *(const u32x4*)(p.proj + (row0 + r) * INW + OFF_HI + h * 128 + ch * 8);
        }
#pragma unroll
        for (int i = 0; i < 8; ++i) {
            const int idx = tid + 256 * i, r = idx >> 5, c4 = idx & 31;
            *(f32x4*)(sL + r * 128 + c4 * 4) = *(const f32x4*)(p.lgf + (row0 + r) * 512 + h * 128 + c4 * 4);
        }
        __syncthreads();
        const float* lcol = sL + half * 32 * 128 + d;
        float tot = 0.f;
#pragma unroll
        for (int s = 0; s < 32; ++s) tot += lcol[s * 128];
        totS[half * 128 + d] = tot;
        __syncthreads();
        const float t0 = totS[d], bl = t0 + totS[128 + d];
        float run = half ? t0 : 0.f;
#pragma unroll 8
        for (int s = 0; s < 32; ++s) {
            const float lv = lcol[s * 128];
            run += lv;
            const float kt = (1.f - __expf(lv)) * __expf(bl - run);
            *(bf16_t*)(sK + swz16(half * 32 + s, d >> 3) + (d & 7) * 2) = f2bf(kt);
        }
        if (half == 0) p.dec[u * 128 + d] = __expf(bl);
        __syncthreads();
        f32x4 acc[4][4];
#pragma unroll
        for (int m = 0; m < 4; ++m)
#pragma unroll
            for (int n = 0; n < 4; ++n) acc[m][n] = f32x4{0.f, 0.f, 0.f, 0.f};
#pragma unroll
        for (int ks = 0; ks < 2; ++ks) {
            bf16x8 af[4], bfr[4];
#pragma unroll
            for (int m = 0; m < 4; ++m) af[m] = tr_frag16(sI, ks, wr * 4 + m);
#pragma unroll
            for (int n = 0; n < 4; ++n) bfr[n] = tr_frag16(sK, ks, wc * 4 + n);
#pragma unroll
            for (int m = 0; m < 4; ++m)
#pragma unroll
                for (int n = 0; n < 4; ++n) acc[m][n] = __builtin_amdgcn_mfma_f32_16x16x32_bf16(af[m], bfr[n], acc[m][n], 0, 0, 0);
        }
        float* kvu = p.kv + (size_t)u * 16384;
#pragma unroll
        for (int m = 0; m < 4; ++m)
#pragma unroll
            for (int n = 0; n < 4; ++n)
#pragma unroll
                for (int j = 0; j < 4; ++j) kvu[(wr * 64 + m * 16 + fq * 4 + j) * 128 + wc * 64 + n * 16 + fr] = acc[m][n][j];
    }
}

__device__ void ph_h2(const Params& p) {
    for (int it = blockIdx.x * NTHREADS + otid(); it < 16 * 8192; it += gridDim.x * NTHREADS) {
        const int bh = it >> 13, e2 = it & 8191, dv = e2 >> 6, dk = (e2 & 63) * 2;
        const size_t eoff = (size_t)dv * 128 + dk;
        float sx = 0.f, sy = 0.f;
#pragma unroll 8
        for (int c = 0; c < 64; ++c) {
            const size_t u = (size_t)bh * 64 + c;
            *(uint32_t*)(p.sst + u * 16384 + eoff) = pack2(sx, sy);
            const float2 kvv = *(const float2*)(p.kv + u * 16384 + eoff);
            const float2 dc = *(const float2*)(p.dec + u * 128 + dk);
            sx = dc.x * sx + kvv.x; sy = dc.y * sy + kvv.y;
        }
    }
}

__device__ void ph_h3(const Params& p, char* smem0) {
    const VB vbk = make_vb(smem0);
    char* smem = vbk.smem;
    const int tid = vbk.tid, lane = tid & 63, wid = tid >> 6, wr = wid >> 1, wc = wid & 1, fr = lane & 15, fq = lane >> 4;
    char* sQ = smem;
    char* sK = smem + 16384;
    char* sP = smem + 32768;
    float* sL = (float*)(smem + 32768);
    float* totS = (float*)(smem + 65536);
    const int d = tid & 127, half = tid >> 7;
    for (int u = vbk.vb; u < 1024; u += vbk.nvb) {
        const int bh = u >> 6, c = u & 63, b = bh >> 2, h = bh & 3;
        const size_t row0 = (size_t)b * S + c * 64;
        __syncthreads();
#pragma unroll
        for (int i = 0; i < 4; ++i) {
            const int idx = tid + 256 * i, r = idx >> 4, ch = idx & 15;
            *(u32x4*)(sQ + swz16(r, ch)) = *(const u32x4*)(p.proj + (row0 + r) * INW + OFF_HQ + h * 128 + ch * 8);
        }
#pragma unroll
        for (int i = 0; i < 8; ++i) {
            const int idx = tid + 256 * i, r = idx >> 5, c4 = idx & 31;
            *(f32x4*)(sL + r * 128 + c4 * 4) = *(const f32x4*)(p.lgf + (row0 + r) * 512 + h * 128 + c4 * 4);
        }
        __syncthreads();
        const float* lcol = sL + half * 32 * 128 + d;
        float tot = 0.f;
#pragma unroll
        for (int s = 0; s < 32; ++s) tot += lcol[s * 128];
        totS[half * 128 + d] = tot;
        __syncthreads();
        const float t0 = totS[d];
        float run = half ? t0 : 0.f;
#pragma unroll 8
        for (int s = 0; s < 32; ++s) {
            const float lv = lcol[s * 128];
            run += lv;
            const int o = swz16(half * 32 + s, d >> 3) + (d & 7) * 2;
            const float qm = bf2f(*(const bf16_t*)(sQ + o)) * __expf(run - t0);
            const float kh = (1.f - __expf(lv)) * __expf(t0 - run);
            *(bf16_t*)(sQ + o) = f2bf(qm);
            *(bf16_t*)(sK + o) = f2bf(kh);
        }
        __syncthreads();
        {
            f32x4 pa[2][2];
#pragma unroll
            for (int m = 0; m < 2; ++m)
#pragma unroll
                for (int n = 0; n < 2; ++n) pa[m][n] = f32x4{0.f, 0.f, 0.f, 0.f};
#pragma unroll
            for (int ks = 0; ks < 4; ++ks) {
                bf16x8 af[2], bfr[2];
#pragma unroll
                for (int m = 0; m < 2; ++m) af[m] = *(const bf16x8*)(sQ + swz16(wr * 32 + m * 16 + fr, ks * 4 + fq));
#pragma unroll
                for (int n = 0; n < 2; ++n) bfr[n] = *(const bf16x8*)(sK + swz16(wc * 32 + n * 16 + fr, ks * 4 + fq));
#pragma unroll
                for (int m = 0; m < 2; ++m)
#pragma unroll
                    for (int n = 0; n < 2; ++n) pa[m][n] = __builtin_amdgcn_mfma_f32_16x16x32_bf16(af[m], bfr[n], pa[m][n], 0, 0, 0);
            }
#pragma unroll
            for (int m = 0; m < 2; ++m)
#pragma unroll
                for (int n = 0; n < 2; ++n)
#pragma unroll
                    for (int j = 0; j < 4; ++j) {
                        const int t = wr * 32 + m * 16 + fq * 4 + j, s_ = wc * 32 + n * 16 + fr;
                        const float v = (s_ <= t) ? pa[m][n][j] : 0.f;
                        *(bf16_t*)(sP + swz(t, s_ >> 3) + (s_ & 7) * 2) = f2bf(v);
                    }
        }
        __syncthreads();
        f32x4 oa[8];
#pragma unroll
        for (int n = 0; n < 8; ++n) oa[n] = f32x4{0.f, 0.f, 0.f, 0.f};
        const int ch = tid & 7;
#pragma unroll
        for (int sub = 0; sub < 2; ++sub) {
            float sc[8];
#pragma unroll
            for (int j = 0; j < 8; ++j) sc[j] = __expf(totS[sub * 64 + ch * 8 + j]);
#pragma unroll
            for (int i = 0; i < 4; ++i) {
                const int r = (tid + 256 * i) >> 3;
                const u32x4 v = *(const u32x4*)(p.sst + (size_t)u * 16384 + r * 128 + sub * 64 + ch * 8);
                u32x4 w;
                w.x = pack2(__uint_as_float(v.x << 16) * sc[0], __uint_as_float(v.x & 0xffff0000u) * sc[1]);
                w.y = pack2(__uint_as_float(v.y << 16) * sc[2], __uint_as_float(v.y & 0xffff0000u) * sc[3]);
                w.z = pack2(__uint_as_float(v.z << 16) * sc[4], __uint_as_float(v.z & 0xffff0000u) * sc[5]);
                w.w = pack2(__uint_as_float(v.w << 16) * sc[6], __uint_as_float(v.w & 0xffff0000u) * sc[7]);
                *(u32x4*)(sK + swz(r, ch)) = w;
            }
            __syncthreads();
#pragma unroll
            for (int ks = 0; ks < 2; ++ks) {
                const bf16x8 af = *(const bf16x8*)(sQ + swz16(wid * 16 + fr, sub * 8 + ks * 4 + fq));
#pragma unroll
                for (int n = 0; n < 8; ++n) {
                    const bf16x8 bfr = *(const bf16x8*)(sK + swz(n * 16 + fr, ks * 4 + fq));
                    oa[n] = __builtin_amdgcn_mfma_f32_16x16x32_bf16(af, bfr, oa[n], 0, 0, 0);
                }
            }
            __syncthreads();
        }
#pragma unroll
        for (int i = 0; i < 4; ++i) {
            const int idx = tid + 256 * i, r = idx >> 4, c16 = idx & 15;
            *(u32x4*)(sK + swz16(r, c16)) = *(const u32x4*)(p.proj + (row0 + r) * INW + OFF_HI + h * 128 + c16 * 8);
        }
        __syncthreads();
#pragma unroll
        for (int ks = 0; ks < 2; ++ks) {
            const bf16x8 af = *(const bf16x8*)(sP + swz(wid * 16 + fr, ks * 4 + fq));
#pragma unroll
            for (int n = 0; n < 8; ++n) {
                const bf16x8 bfr = tr_frag16(sK, ks, n);
                oa[n] = __builtin_amdgcn_mfma_f32_16x16x32_bf16(af, bfr, oa[n], 0, 0, 0);
            }
        }
        float ss[4] = {0.f, 0.f, 0.f, 0.f};
#pragma unroll
        for (int n = 0; n < 8; ++n)
#pragma unroll
            for (int j = 0; j < 4; ++j) ss[j] += oa[n][j] * oa[n][j];
#pragma unroll
        for (int j = 0; j < 4; ++j) {
            ss[j] += __shfl_xor(ss[j], 1, 64); ss[j] += __shfl_xor(ss[j], 2, 64); ss[j] += __shfl_xor(ss[j], 4, 64); ss[j] += __shfl_xor(ss[j], 8, 64);
        }
#pragma unroll
        for (int j = 0; j < 4; ++j) {
            const size_t row = row0 + wid * 16 + fq * 4 + j;
            const float rstd = rsqrtf(ss[j] * (1.f / 128.f) + RMS_EPS);
#pragma unroll
            for (int n = 0; n < 8; ++n) {
                const int dv = n * 16 + fr;
                const float g = bf2f(p.proj[row * INW + OFF_HG + h * 128 + dv]);
                const float y = oa[n][j] * rstd * p.hg_nw[h * 128 + dv] * (g / (1.f + __expf(-g)));
                p.mixin[row * 768 + h * 128 + dv] = f2bf(y);
            }
        }
    }
}

__device__ __forceinline__ bf16x8 tr_frag8(const char* tile, int ks, int c) {
    const int lane = otid() & 63, g = lane >> 4, q = (lane & 15) >> 2, pp = lane & 3;
    const int r0 = 32 * ks + 8 * g + q, ch = 2 * c + (pp >> 1), bo = 8 * (pp & 1);
    const v4s lo = __builtin_amdgcn_ds_read_tr16_b64_v4i16((LAS v4s*)(tile + swz(r0, ch) + bo));
    const v4s hi = __builtin_amdgcn_ds_read_tr16_b64_v4i16((LAS v4s*)(tile + swz(r0 + 4, ch) + bo));
    return bf16x8{lo[0], lo[1], lo[2], lo[3], hi[0], hi[1], hi[2], hi[3]};
}

__device__ void ph_attn(const Params& p, char* smem0) {
    const VB vbk = make_vb(smem0);
    char* smem = vbk.smem;
    const int tid = vbk.tid, lane = tid & 63, wid = tid >> 6, fr = lane & 15, fq = lane >> 4;
    char* sQ = smem;
    char* sK = smem + 8192;
    char* sP = sK;
    char* sV = smem + 33792;
    float* sBias = (float*)(smem + 58368);
    for (int u = vbk.vb; u < 3072; u += vbk.nvb) {
        const int ti = u & 63, gq = u >> 6, g = gq % 3, bhh = gq / 3, hh = bhh & 3, b = bhh >> 2;
        const int lsh = (g == 0) ? 0 : (g == 1 ? 2 : 4), dl = 1 << lsh;
        const int tpr = (S >> lsh) >> 6;
        const int r = ti / tpr, j0 = (ti % tpr) * 64;
        const bf16_t* base = p.proj + (size_t)b * S * INW + (g * 4 + hh) * 64;
        __syncthreads();
#pragma unroll
        for (int i = 0; i < 2; ++i) {
            const int idx = tid + 256 * i, row = idx >> 3, ch = idx & 7;
            const int tok = (j0 + row) * dl + r;
            *(u32x4*)(sQ + swz(row, ch)) = *(const u32x4*)(base + (size_t)tok * INW + OFF_AQ + ch * 8);
        }
#pragma unroll
        for (int i = 0; i < 6; ++i) {
            const int idx = tid + 256 * i, row = idx >> 3, ch = idx & 7;
            const int j = j0 - 128 + row;
            u32x4 kx = {0u, 0u, 0u, 0u}, vx = {0u, 0u, 0u, 0u};
            if (j >= 0) {
                const size_t o = (size_t)(j * dl + r) * INW + ch * 8;
                kx = *(const u32x4*)(base + o + OFF_AK);
                vx = *(const u32x4*)(base + o + OFF_AV);
            }
            *(u32x4*)(sK + swz(row, ch)) = kx;
            *(u32x4*)(sV + swz(row, ch)) = vx;
        }
        if (tid < 129) sBias[tid] = p.biasT[(g * 129 + tid) * 4 + hh];
        __syncthreads();
        f32x4 sa[12];
#pragma unroll
        for (int n = 0; n < 12; ++n) sa[n] = f32x4{0.f, 0.f, 0.f, 0.f};
#pragma unroll
        for (int ks = 0; ks < 2; ++ks) {
            const bf16x8 af = *(const bf16x8*)(sQ + swz(wid * 16 + fr, ks * 4 + fq));
#pragma unroll
            for (int n = 0; n < 12; ++n) {
                const bf16x8 bfr = *(const bf16x8*)(sK + swz(n * 16 + fr, ks * 4 + fq));
                sa[n] = __builtin_amdgcn_mfma_f32_16x16x32_bf16(af, bfr, sa[n], 0, 0, 0);
            }
        }
        float mx[4] = {-INFINITY, -INFINITY, -INFINITY, -INFINITY};
#pragma unroll
        for (int n = 0; n < 12; ++n)
#pragma unroll
            for (int j = 0; j < 4; ++j) {
                const int jj = wid * 16 + fq * 4 + j, kk = n * 16 + fr, m = jj + 128 - kk;
                const bool valid = (m >= 0) && (m <= 128) && (j0 - 128 + kk >= 0);
                const int mc = m < 0 ? 0 : (m > 128 ? 128 : m);
                const float v = valid ? sa[n][j] * 0.125f + sBias[mc] : -INFINITY;
                sa[n][j] = v;
                mx[j] = fmaxf(mx[j], v);
            }
#pragma unroll
        for (int j = 0; j < 4; ++j) {
            mx[j] = fmaxf(mx[j], __shfl_xor(mx[j], 1, 64)); mx[j] = fmaxf(mx[j], __shfl_xor(mx[j], 2, 64));
            mx[j] = fmaxf(mx[j], __shfl_xor(mx[j], 4, 64)); mx[j] = fmaxf(mx[j], __shfl_xor(mx[j], 8, 64));
        }
        float ls[4] = {0.f, 0.f, 0.f, 0.f};
#pragma unroll
        for (int n = 0; n < 12; ++n)
#pragma unroll
            for (int j = 0; j < 4; ++j) { const float pe = __expf(sa[n][j] - mx[j]); sa[n][j] = pe; ls[j] += pe; }
#pragma unroll
        for (int j = 0; j < 4; ++j) {
            ls[j] += __shfl_xor(ls[j], 1, 64); ls[j] += __shfl_xor(ls[j], 2, 64); ls[j] += __shfl_xor(ls[j], 4, 64); ls[j] += __shfl_xor(ls[j], 8, 64);
        }
        __syncthreads();
#pragma unroll
        for (int n = 0; n < 12; ++n)
#pragma unroll
            for (int j = 0; j < 4; ++j) *(bf16_t*)(sP + (wid * 16 + fq * 4 + j) * 400 + (n * 16 + fr) * 2) = f2bf(sa[n][j]);
        f32x4 oa[4];
#pragma unroll
        for (int n = 0; n < 4; ++n) oa[n] = f32x4{0.f, 0.f, 0.f, 0.f};
#pragma unroll
        for (int ks = 0; ks < 6; ++ks) {
            const bf16x8 af = *(const bf16x8*)(sP + (wid * 16 + fr) * 400 + (ks * 4 + fq) * 16);
#pragma unroll
            for (int n = 0; n < 4; ++n) {
                const bf16x8 bfr = tr_frag8(sV, ks, n);
                oa[n] = __builtin_amdgcn_mfma_f32_16x16x32_bf16(af, bfr, oa[n], 0, 0, 0);
            }
        }
#pragma unroll
        for (int j = 0; j < 4; ++j) {
            const int jj = wid * 16 + fq * 4 + j;
            const size_t row = (size_t)g * T + (size_t)b * S + (j0 + jj) * dl + r;
            const float inv = 1.f / ls[j];
#pragma unroll
            for (int n = 0; n < 4; ++n) p.ao[row * 256 + hh * 64 + n * 16 + fr] = oa[n][j] * inv;
            if (fr == 0) p.alse[row * 4 + hh] = mx[j] + __logf(ls[j]);
        }
    }
}

__device__ void ph_attn_merge(const Params& p) {
    const int tid = otid(), lane = tid & 63, wid = tid >> 6;
    for (int row = blockIdx.x * 8 + wid; row < T; row += gridDim.x * 8) {
        const int hh = lane >> 4;
        const float l0 = p.alse[((size_t)0 * T + row) * 4 + hh], l1 = p.alse[((size_t)1 * T + row) * 4 + hh], l2 = p.alse[((size_t)2 * T + row) * 4 + hh];
        const float mxl = fmaxf(l0, fmaxf(l1, l2));
        float e0 = __expf(l0 - mxl), e1 = __expf(l1 - mxl), e2 = __expf(l2 - mxl);
        const float inv = 1.f / (e0 + e1 + e2);
        e0 *= inv; e1 *= inv; e2 *= inv;
        const f32x4 a0 = *(const f32x4*)(p.ao + ((size_t)0 * T + row) * 256 + lane * 4);
        const f32x4 a1 = *(const f32x4*)(p.ao + ((size_t)1 * T + row) * 256 + lane * 4);
        const f32x4 a2 = *(const f32x4*)(p.ao + ((size_t)2 * T + row) * 256 + lane * 4);
        uint2 o;
        o.x = pack2(a0[0] * e0 + a1[0] * e1 + a2[0] * e2, a0[1] * e0 + a1[1] * e1 + a2[1] * e2);
        o.y = pack2(a0[2] * e0 + a1[2] * e1 + a2[2] * e2, a0[3] * e0 + a1[3] * e1 + a2[3] * e2);
        *(uint2*)(p.mixin + (size_t)row * 768 + 512 + lane * 4) = o;
    }
}

__device__ void ph_outproj(const Params& p, char* smem) {
    const int tid = otid(), lane = tid & 63, wid = tid >> 6, wr = wid >> 1, wc = wid & 1;
    const int xcd = blockIdx.x & 7, nbx = gridDim.x >> 3;
    for (int i = blockIdx.x >> 3; i < 32; i += nbx) {
        const int nt = i >> 3, mt = xcd * 8 + (i & 7);
        const bf16_t* A = p.mixin + (size_t)mt * 256 * 768;
        const bf16_t* Bt = p.woutT + (size_t)nt * 256 * 768;
        f32x4 acc[4][8];
        __syncthreads();
        gemm3<1>(smem, 768, [&](int r) { return A + (size_t)r * 768; }, [&](int n) { return Bt + (size_t)n * 768; }, 0, acc);
        const int b = (mt * 256) >> 12;
        const int colb = nt * 256 + wc * 128;
        const float* g1 = p.mod + b * 6144 + 2048 + colb;
        char* wl = smem + wid * EPI_WAVE;
#pragma unroll
        for (int m = 0; m < 4; ++m) {
            const size_t rbase = (size_t)(mt * 256 + wr * 64 + m * 16) * D + colb;
            epi_f32(wl, lane, [&](int n, int j) { return acc[m][n][j]; },
                    [&](int row, int ch, f32x4 v) {
                        const f32x4 xv = *(const f32x4*)(p.x + rbase + (size_t)row * D + ch * 4);
                        const f32x4 gv = *(const f32x4*)(g1 + ch * 4);
                        f32x4 o;
                        o[0] = ALPHA * xv[0] + gv[0] * v[0]; o[1] = ALPHA * xv[1] + gv[1] * v[1];
                        o[2] = ALPHA * xv[2] + gv[2] * v[2]; o[3] = ALPHA * xv[3] + gv[3] * v[3];
                        *(f32x4*)(p.pre1 + rbase + (size_t)row * D + ch * 4) = o;
                    });
        }
    }
}

__device__ void ph_ln1(const Params& p) {
    const int tid = otid(), lane = tid & 63, wid = tid >> 6;
    for (int row = blockIdx.x * 8 + wid; row < T; row += gridDim.x * 8) {
        const float4* xr = (const float4*)(p.pre1 + (size_t)row * D);
        float4 v[4];
        float s = 0.f;
#pragma unroll
        for (int i = 0; i < 4; ++i) { v[i] = xr[lane + 64 * i]; s += v[i].x + v[i].y + v[i].z + v[i].w; }
        float mean = wave_sum(s) * (1.f / D);
        float q = 0.f;
#pragma unroll
        for (int i = 0; i < 4; ++i) {
            v[i].x -= mean; v[i].y -= mean; v[i].z -= mean; v[i].w -= mean;
            q += v[i].x * v[i].x + v[i].y * v[i].y + v[i].z * v[i].z + v[i].w * v[i].w;
        }
        float rstd = rsqrtf(wave_sum(q) * (1.f / D) + LN_EPS);
        s = 0.f;
#pragma unroll
        for (int i = 0; i < 4; ++i) {
            const int col = (lane + 64 * i) * 4;
            const float4 g4 = *(const float4*)(p.ln1_g + col), b4 = *(const float4*)(p.ln1_b + col);
            v[i].x = v[i].x * rstd * g4.x + b4.x; v[i].y = v[i].y * rstd * g4.y + b4.y;
            v[i].z = v[i].z * rstd * g4.z + b4.z; v[i].w = v[i].w * rstd * g4.w + b4.w;
            *(float4*)(p.x1 + (size_t)row * D + col) = v[i];
            s += v[i].x + v[i].y + v[i].z + v[i].w;
        }
        mean = wave_sum(s) * (1.f / D);
        q = 0.f;
#pragma unroll
        for (int i = 0; i < 4; ++i) {
            v[i].x -= mean; v[i].y -= mean; v[i].z -= mean; v[i].w -= mean;
            q += v[i].x * v[i].x + v[i].y * v[i].y + v[i].z * v[i].z + v[i].w * v[i].w;
        }
        rstd = rsqrtf(wave_sum(q) * (1.f / D) + LN_EPS);
        const int b = row >> 12;
        const float* sh = p.mod + b * 6144 + 3072;
        const float* sc = sh + 1024;
#pragma unroll
        for (int i = 0; i < 4; ++i) {
            const int col = (lane + 64 * i) * 4;
            const float4 s4 = *(const float4*)(sc + col), h4 = *(const float4*)(sh + col);
            float4 y;
            y.x = v[i].x * rstd * (1.f + s4.x) + h4.x; y.y = v[i].y * rstd * (1.f + s4.y) + h4.y;
            y.z = v[i].z * rstd * (1.f + s4.z) + h4.z; y.w = v[i].w * rstd * (1.f + s4.w) + h4.w;
            uint2 o;
            o.x = pack2(y.x, y.y); o.y = pack2(y.z, y.w);
            *(uint2*)(p.h2 + (size_t)row * 2048 + col) = o;
            uint2 o2;
            o2.x = pack2(y.x - __uint_as_float(o.x << 16), y.y - __uint_as_float(o.x & 0xffff0000u));
            o2.y = pack2(y.z - __uint_as_float(o.y << 16), y.w - __uint_as_float(o.y & 0xffff0000u));
            *(uint2*)(p.h2 + (size_t)row * 2048 + 1024 + col) = o2;
        }
    }
}

__device__ void ph_router_gemm(const Params& p, char* smem) {
    const int tid = otid(), lane = tid & 63, wid = tid >> 6, wr = wid >> 1, wc = wid & 1;
    for (int u = blockIdx.x; u < 192; u += gridDim.x) {
        const int pass = u >> 6, mt = u & 63;
        const bf16_t* A = p.h2 + (size_t)mt * 256 * 2048 + (pass == 1 ? 1024 : 0);
        const bf16_t* Bt = p.wrT + (pass == 2 ? (size_t)NE * D : 0);
        f32x4 acc[4][8];
        __syncthreads();
        gemm3<1>(smem, D, [&](int r) { return A + (size_t)r * 2048; }, [&](int n) { return Bt + (size_t)n * D; }, 0, acc);
        char* wl = smem + wid * EPI_WAVE;
#pragma unroll
        for (int m = 0; m < 4; ++m) {
            float* dst = p.lgp + (size_t)pass * T * NE + (size_t)(mt * 256 + wr * 64 + m * 16) * NE + wc * 128;
            epi_f32(wl, lane, [&](int n, int j) { return acc[m][n][j]; },
                    [&](int row, int ch, f32x4 v) { *(f32x4*)(dst + (size_t)row * NE + ch * 4) = v; });
        }
    }
}

__device__ void ph_topk(const Params& p) {
    const int tid = otid(), lane = tid & 63, wid = tid >> 6;
    for (int tok = blockIdx.x * 8 + wid; tok < T; tok += gridDim.x * 8) {
        float sc[4], bv[4];
#pragma unroll
        for (int j = 0; j < 4; ++j) {
            const int e = j * 64 + lane;
            const size_t o = (size_t)tok * NE + e;
            const float x = (p.lgp[o] + p.lgp[(size_t)T * NE + o]) + p.lgp[(size_t)2 * T * NE + o];
            sc[j] = 1.f / (1.f + expf(-x));
            bv[j] = sc[j] + p.router_bias[e];
        }
        float gsum[4];
#pragma unroll
        for (int j = 0; j < 4; ++j) {
            float m1 = bv[j];
#pragma unroll
            for (int o = 16; o > 0; o >>= 1) m1 = fmaxf(m1, __shfl_xor(m1, o, 64));
            const unsigned long long bal = __ballot(bv[j] == m1);
            const unsigned hm = (unsigned)(bal >> (lane & 32));
            const int first = __ffs(hm) - 1;
            float m2 = ((lane & 31) == first) ? -INFINITY : bv[j];
#pragma unroll
            for (int o = 16; o > 0; o >>= 1) m2 = fmaxf(m2, __shfl_xor(m2, o, 64));
            gsum[j] = m1 + m2;
        }
        float gs[8];
#pragma unroll
        for (int j = 0; j < 4; ++j) { gs[2 * j] = __shfl(gsum[j], 0, 64); gs[2 * j + 1] = __shfl(gsum[j], 32, 64); }
        unsigned gmask = 0u;
#pragma unroll
        for (int r = 0; r < 4; ++r) {
            float best = -INFINITY; int bi = 0;
#pragma unroll
            for (int g = 0; g < 8; ++g) {
                const bool ok = (((gmask >> g) & 1u) == 0u) && (gs[g] > best);
                if (ok) { best = gs[g]; bi = g; }
            }
            gmask |= 1u << bi;
        }
        float cand[4];
#pragma unroll
        for (int j = 0; j < 4; ++j) cand[j] = ((gmask >> (2 * j + (lane >> 5))) & 1u) ? bv[j] : -INFINITY;
        float wsum = 0.f, myw = 0.f;
        int mye = 0;
#pragma unroll
        for (int r = 0; r < 8; ++r) {
            float bvv = cand[0]; int be = lane;
#pragma unroll
            for (int j = 1; j < 4; ++j) if (cand[j] > bvv) { bvv = cand[j]; be = j * 64 + lane; }
#pragma unroll
            for (int o = 32; o > 0; o >>= 1) {
                const float ov = __shfl_xor(bvv, o, 64);
                const int oe = __shfl_xor(be, o, 64);
                if (ov > bvv || (ov == bvv && oe < be)) { bvv = ov; be = oe; }
            }
            const int bj = be >> 6;
            const float mysc = bj == 0 ? sc[0] : (bj == 1 ? sc[1] : (bj == 2 ? sc[2] : sc[3]));
            const float sval = __shfl(mysc, be & 63, 64);
#pragma unroll
            for (int j = 0; j < 4; ++j) if (be == j * 64 + lane) cand[j] = -INFINITY;
            wsum += sval;
            if (lane == r) { myw = sval; mye = be; }
        }
        if (lane < 8) {
            const int a = tok * 8 + lane;
            p.topi[a] = mye;
            p.topw[a] = myw * (2.5f / wsum);
        }
    }
}

__device__ void ph_lists(const Params& p, char* smem) {
    const int tid = otid(), lane = tid & 63, wid = tid >> 6;
    int* wtot = (int*)smem;
    for (int e = blockIdx.x; e < NE; e += gridDim.x) {
        __syncthreads();
        const int4* src = (const int4*)p.topi + wid * 4096;
        int cntw = 0;
        for (int i = 0; i < 64; ++i) {
            const int4 v = src[i * 64 + lane];
            cntw += __popcll(__ballot(v.x == e)) + __popcll(__ballot(v.y == e)) + __popcll(__ballot(v.z == e)) + __popcll(__ballot(v.w == e));
        }
        if (lane == 0) wtot[wid] = cntw;
        __syncthreads();
        int base = 0, tot = 0;
        for (int w = 0; w < 8; ++w) { const int c = wtot[w]; if (w < wid) base += c; tot += c; }
        if (tid == 0) p.cnt[e] = tot;
        int* dst = p.list + (size_t)e * T;
        const unsigned long long lt = (1ull << lane) - 1ull;
        for (int i = 0; i < 64; ++i) {
            const int4 v = src[i * 64 + lane];
            const int a0 = (wid * 4096 + i * 64 + lane) * 4;
            unsigned long long m;
            m = __ballot(v.x == e); if (v.x == e) dst[base + __popcll(m & lt)] = a0;     base += __popcll(m);
            m = __ballot(v.y == e); if (v.y == e) dst[base + __popcll(m & lt)] = a0 + 1; base += __popcll(m);
            m = __ballot(v.z == e); if (v.z == e) dst[base + __popcll(m & lt)] = a0 + 2; base += __popcll(m);
            m = __ballot(v.w == e); if (v.w == e) dst[base + __popcll(m & lt)] = a0 + 3; base += __popcll(m);
        }
    }
}

struct ExpMap { int* cnt; int* off; int* tile; };
__device__ __forceinline__ ExpMap exp_map(const Params& p, char* smem) {
    ExpMap m;
    m.cnt = (int*)(smem + 73728); m.off = m.cnt + 256; m.tile = m.off + 256;
    const int tid = otid();
    __syncthreads();
    if (tid < NE) m.cnt[tid] = p.cnt[tid];
    __syncthreads();
    if (tid == 0) {
        int off = 0, tl = 0;
        for (int e = 0; e < NE; ++e) { m.off[e] = off; m.tile[e] = tl; const int c = m.cnt[e]; off += c; tl += (c + 255) >> 8; }
        m.tile[NE] = tl;
    }
    __syncthreads();
    return m;
}
__device__ __forceinline__ int find_expert(const int* tile, int rt) {
    int lo = 0, hi = NE;
    while (hi - lo > 1) { const int mid = (lo + hi) >> 1; if (tile[mid] <= rt) lo = mid; else hi = mid; }
    return lo;
}
#define ROWA(smem) ((int*)((smem) + 73728 + 3328))
#define ROWW(smem) ((float*)((smem) + 73728 + 3328 + 1024))

__device__ void ph_gateup(const Params& p, char* smem) {
    const int tid = otid(), lane = tid & 63, wid = tid >> 6, wr = wid >> 1, wc = wid & 1;
    const ExpMap em = exp_map(p, smem);
    int* rowA = ROWA(smem);
    const int ntile = em.tile[NE];
    const int U = (ntile + T / 256) * 2;
    const int xcd = blockIdx.x & 7, nbx = gridDim.x >> 3;
    const int lo = (int)(((long long)U * xcd) >> 3), hi = (int)(((long long)U * (xcd + 1)) >> 3);
    for (int u = lo + (blockIdx.x >> 3); u < hi; u += nbx) {
        const int rt = u >> 1, c0 = (u & 1) * 128;
        const float *Wg, *Wu;
        bf16_t* gdst;
        int nrow, tokv = -1;
        if (rt < ntile) {
            const int e = find_expert(em.tile, rt);
            const int r0 = (rt - em.tile[e]) * 256, ne = em.cnt[e];
            Wg = p.w_eg + (size_t)e * D * ED; Wu = p.w_eu + (size_t)e * D * ED;
            gdst = p.gbuf + ((size_t)em.off[e] + r0) * ED + c0;
            nrow = ne - r0;
            if (tid < 256 && r0 + tid < ne) tokv = p.list[(size_t)e * T + r0 + tid] >> 3;
        } else {
            const int tb = (rt - ntile) * 256;
            Wg = p.w_sg; Wu = p.w_su;
            gdst = p.gsh + (size_t)tb * ED + c0;
            nrow = 256;
            tokv = tb + (tid & 255);
        }
        __syncthreads();
        if (tid < 256) rowA[tid] = tokv;
        __syncthreads();
        const int t0 = rowA[0];
        f32x4 acc[4][8];
        gemm3<0>(smem, D,
                 [&](int r) { const int t = rowA[r]; return p.h2 + (size_t)(t < 0 ? t0 : t) * 2048; },
                 [&](int n) { const int t16 = n >> 4; return ((t16 & 1) ? Wu : Wg) + c0 + 16 * (t16 >> 1) + (n & 15); },
                 ED, acc, nrow);
        if (wr * 64 < nrow) {
            char* wl = smem + wid * EPI_WAVE;
#pragma unroll
            for (int m = 0; m < 4; ++m) {
                const int rb = wr * 64 + m * 16;
                epi_bf16(wl, lane,
                         [&](int n, int j) { if (n >= 4) return 0.f; const float g = acc[m][2 * n][j], uu = acc[m][2 * n + 1][j]; return g / (1.f + __expf(-g)) * uu; },
                         [&](int row, int ch, u32x4 v) { if (ch < 8 && rb + row < nrow) *(u32x4*)(gdst + (size_t)(rb + row) * ED + wc * 64 + ch * 8) = v; });
            }
        }
    }
}

__device__ void ph_down(const Params& p, char* smem) {
    const int tid = otid(), lane = tid & 63, wid = tid >> 6, wr = wid >> 1, wc = wid & 1;
    const ExpMap em = exp_map(p, smem);
    int* rowA = ROWA(smem);
    float* rowW = ROWW(smem);
    const int ntile = em.tile[NE];
    const int U = (ntile + T / 256) * 4;
    const int xcd = blockIdx.x & 7, nbx = gridDim.x >> 3;
    const int lo = (int)(((long long)U * xcd) >> 3), hi = (int)(((long long)U * (xcd + 1)) >> 3);
    for (int u = lo + (blockIdx.x >> 3); u < hi; u += nbx) {
        const int rt = u >> 2, nt = u & 3;
        const bf16_t* A;
        const float* W;
        int nrow, slot = -1;
        float wv = 0.f;
        if (rt < ntile) {
            const int e = find_expert(em.tile, rt);
            const int r0 = (rt - em.tile[e]) * 256, ne = em.cnt[e];
            A = p.gbuf + ((size_t)em.off[e] + r0) * ED;
            W = p.w_ed + (size_t)e * ED * D + nt * 256;
            nrow = ne - r0;
            if (tid < 256 && r0 + tid < ne) {
                const int a = p.list[(size_t)e * T + r0 + tid];
                slot = (a >> 3) * 9 + (a & 7);
                wv = p.topw[a];
            }
        } else {
            const int tb = (rt - ntile) * 256;
            A = p.gsh + (size_t)tb * ED;
            W = p.w_sd + nt * 256;
            nrow = 256;
            slot = (tb + (tid & 255)) * 9 + 8;
            wv = 1.f;
        }
        __syncthreads();
        if (tid < 256) { rowA[tid] = slot; rowW[tid] = wv; }
        __syncthreads();
        f32x4 acc[4][8];
        gemm3<0>(smem, ED, [&](int r) { return A + (size_t)(r < nrow ? r : 0) * ED; }, [&](int n) { return W + n; }, D, acc, nrow);
        if (wr * 64 < nrow) {
            char* wl = smem + wid * EPI_WAVE;
#pragma unroll
            for (int m = 0; m < 4; ++m) {
                const int rb = wr * 64 + m * 16;
                float wj[4];
#pragma unroll
                for (int j = 0; j < 4; ++j) wj[j] = rowW[rb + (lane >> 4) * 4 + j];
                epi_bf16(wl, lane, [&](int n, int j) { return acc[m][n][j] * wj[j]; },
                         [&](int row, int ch, u32x4 v) {
                             const int sl = rowA[rb + row];
                             if (sl >= 0) *(u32x4*)(p.ybuf + (size_t)sl * D + nt * 256 + wc * 128 + ch * 8) = v;
                         });
            }
        }
    }
}

__device__ void ph_final(const Params& p) {
    const int tid = otid(), lane = tid & 63, wid = tid >> 6;
    for (int row = blockIdx.x * 8 + wid; row < T; row += gridDim.x * 8) {
        const int b = row >> 12;
        const float* g2 = p.mod + b * 6144 + 5120;
        float4 v[4];
        float s = 0.f;
#pragma unroll
        for (int i = 0; i < 4; ++i) {
            const int col = (lane + 64 * i) * 4;
            float f0 = 0.f, f1 = 0.f, f2 = 0.f, f3 = 0.f;
#pragma unroll
            for (int k = 0; k < 9; ++k) {
                const uint2 w = *(const uint2*)(p.ybuf + ((size_t)row * 9 + k) * D + col);
                f0 += __uint_as_float(w.x << 16); f1 += __uint_as_float(w.x & 0xffff0000u);
                f2 += __uint_as_float(w.y << 16); f3 += __uint_as_float(w.y & 0xffff0000u);
            }
            const float4 xv = *(const float4*)(p.x1 + (size_t)row * D + col);
            const float4 g4 = *(const float4*)(g2 + col);
            v[i].x = ALPHA * xv.x + g4.x * f0; v[i].y = ALPHA * xv.y + g4.y * f1;
            v[i].z = ALPHA * xv.z + g4.z * f2; v[i].w = ALPHA * xv.w + g4.w * f3;
            s += v[i].x + v[i].y + v[i].z + v[i].w;
        }
        const float mean = wave_sum(s) * (1.f / D);
        float q = 0.f;
#pragma unroll
        for (int i = 0; i < 4; ++i) {
            v[i].x -= mean; v[i].y -= mean; v[i].z -= mean; v[i].w -= mean;
            q += v[i].x * v[i].x + v[i].y * v[i].y + v[i].z * v[i].z + v[i].w * v[i].w;
        }
        const float rstd = rsqrtf(wave_sum(q) * (1.f / D) + LN_EPS);
#pragma unroll
        for (int i = 0; i < 4; ++i) {
            const int col = (lane + 64 * i) * 4;
            const float4 g4 = *(const float4*)(p.ln2_g + col), b4 = *(const float4*)(p.ln2_b + col);
            float4 y;
            y.x = v[i].x * rstd * g4.x + b4.x; y.y = v[i].y * rstd * g4.y + b4.y;
            y.z = v[i].z * rstd * g4.z + b4.z; y.w = v[i].w * rstd * g4.w + b4.w;
            *(float4*)(p.out + (size_t)row * D + col) = y;
        }
    }
}

constexpr int LDS_BYTES = 2 * VB_LDS + 16;
constexpr int NPHASE = 14;

template <int PH>
__device__ __forceinline__ void run_phase(const Params& p, char* smem) {
    if (PH == 0) ph_mod(p, smem);
    if (PH == 1) ph_ln0(p);
    if (PH == 2) ph_inproj(p, smem);
    if (PH == 3) { ph_h1(p, smem); ph_attn(p, smem); }
    if (PH == 4) { ph_h2(p); ph_attn_merge(p); }
    if (PH == 5) ph_h3(p, smem);
    if (PH == 6) ph_outproj(p, smem);
    if (PH == 7) ph_ln1(p);
    if (PH == 8) ph_router_gemm(p, smem);
    if (PH == 9) ph_topk(p);
    if (PH == 10) ph_lists(p, smem);
    if (PH == 11) ph_gateup(p, smem);
    if (PH == 12) ph_down(p, smem);
    if (PH == 13) ph_final(p);
}

template <int PH>
__global__ void __launch_bounds__(NTHREADS, 2) k_phase(Params p) {
    extern __shared__ __attribute__((aligned(16))) char smem[];
    run_phase<PH>(p, smem);
}

__global__ void __launch_bounds__(NTHREADS, 2) k_all(Params p) {
    extern __shared__ __attribute__((aligned(16))) char smem[];
    volatile LAS unsigned* st = (volatile LAS unsigned*)(smem + LDS_BYTES - 16);
    if (threadIdx.x == 0) { st[0] = 0u; st[1] = 0u; st[2] = 0u; st[3] = 0u; }
    __syncthreads();
    XcdBarrier bar = xcd_barrier_post(p.bar, st);
    run_phase<0>(p, smem); xcd_barrier(bar);
    run_phase<1>(p, smem); xcd_barrier(bar);
    run_phase<2>(p, smem); xcd_barrier(bar);
    run_phase<3>(p, smem); xcd_barrier(bar);
    run_phase<4>(p, smem); xcd_barrier(bar);
    run_phase<5>(p, smem); xcd_barrier(bar);
    run_phase<6>(p, smem); xcd_barrier(bar);
    run_phase<7>(p, smem); xcd_barrier(bar);
    run_phase<8>(p, smem); xcd_barrier(bar);
    run_phase<9>(p, smem); xcd_barrier(bar);
    run_phase<10>(p, smem); xcd_barrier(bar);
    run_phase<11>(p, smem); xcd_barrier(bar);
    run_phase<12>(p, smem); xcd_barrier(bar);
    run_phase<13>(p, smem);
}

template <int PH>
static void launch_phase(const Params& p, int grid, hipStream_t stream) {
    static bool attr = false;
    if (!attr) { (void)hipFuncSetAttribute((const void*)k_phase<PH>, hipFuncAttributeMaxDynamicSharedMemorySize, LDS_BYTES); attr = true; }
    hipLaunchKernelGGL(k_phase<PH>, dim3(grid), dim3(NTHREADS), LDS_BYTES, stream, p);
}

extern "C" void kernel_launch(void* const* d_in, const int* in_sizes, int n_in, void* d_out, int out_size, void* d_ws, size_t ws_size,
                              hipStream_t stream) {
    (void)in_sizes; (void)n_in; (void)out_size;
    Params p{};
    const float** pin = (const float**)&p.x;
    for (int i = 0; i < 21; ++i) pin[i] = (const float*)d_in[i];
    p.out = (float*)d_out;
    char* ws = (char*)d_ws;
    size_t off = 0;
    auto carve = [&](size_t bytes) { char* r = ws + off; off += (bytes + 255) & ~(size_t)255; return r; };
    char* ctl = carve(65536);
    p.bar = (unsigned*)ctl;
    p.cnt = (int*)(ctl + 16384);
    p.mod = (float*)carve(4 * 6144 * 4);
    p.lbv = (float*)carve(512 * 4);
    p.biasT = (float*)carve(3 * 129 * 4 * 4);
    p.winT = (bf16_t*)carve((size_t)INW * D * 2);
    p.woutT = (bf16_t*)carve((size_t)D * 768 * 2);
    p.wrT = (bf16_t*)carve((size_t)2 * NE * D * 2);
    p.wsgT = (bf16_t*)carve((size_t)ED * D * 2);
    p.wsuT = (bf16_t*)carve((size_t)ED * D * 2);
    p.wsdT = (bf16_t*)carve((size_t)D * ED * 2);
    p.h1 = (bf16_t*)carve((size_t)T * D * 2);
    p.proj = (bf16_t*)carve((size_t)T * INW * 2);
    p.lgf = (float*)carve((size_t)T * 512 * 4);
    p.ao = (float*)carve((size_t)3 * T * 256 * 4);
    p.alse = (float*)carve((size_t)3 * T * 4 * 4);
    p.mixin = (bf16_t*)carve((size_t)T * 768 * 2);
    p.pre1 = (float*)carve((size_t)T * D * 4);
    p.x1 = (float*)carve((size_t)T * D * 4);
    p.h2 = (bf16_t*)carve((size_t)T * 2048 * 2);
    p.lgp = (float*)carve((size_t)3 * T * NE * 4);
    p.topi = (int*)carve((size_t)T * 8 * 4);
    p.topw = (float*)carve((size_t)T * 8 * 4);
    p.list = (int*)carve((size_t)NE * T * 4);
    p.gbuf = (bf16_t*)carve((size_t)T * TOPK * ED * 2);
    p.gsh = (bf16_t*)carve((size_t)T * ED * 2);
    p.ybuf = (bf16_t*)carve((size_t)T * 9 * D * 2);
    p.kv = (float*)p.ybuf;
    p.sst = (bf16_t*)((char*)p.ybuf + (size_t)1024 * 16384 * 4);
    p.dec = (float*)carve((size_t)1024 * 128 * 4);
    if (off > ws_size) { fprintf(stderr, "kernel_launch: workspace too small: need %zu have %zu\n", off, ws_size); return; }

    static int grid = 0;
    if (grid == 0) {
        int dev = 0, cus = 0, per_cu = 0;
        (void)hipGetDevice(&dev);
        (void)hipDeviceGetAttribute(&cus, hipDeviceAttributeMultiprocessorCount, dev);
        (void)hipFuncSetAttribute((const void*)k_all, hipFuncAttributeMaxDynamicSharedMemorySize, LDS_BYTES);
        (void)hipOccupancyMaxActiveBlocksPerMultiprocessor(&per_cu, (const void*)k_all, NTHREADS, LDS_BYTES);
        grid = cus;
        if (grid != 256) grid = 256;
        fprintf(stderr, "kernel_launch: cus %d per_cu %d grid %d ws need %zu have %zu\n", cus, per_cu, grid, off, ws_size);
    }
    (void)hipMemsetAsync(ctl, 0, 65536, stream);
#if ONE_LAUNCH
    hipLaunchKernelGGL(k_all, dim3(grid), dim3(NTHREADS), LDS_BYTES, stream, p);
#else
    launch_phase<0>(p, grid, stream); launch_phase<1>(p, grid, stream); launch_phase<2>(p, grid, stream); launch_phase<3>(p, grid, stream);
    launch_phase<4>(p, grid, stream); launch_phase<5>(p, grid, stream); launch_phase<6>(p, grid, stream); launch_phase<7>(p, grid, stream);
    launch_phase<8>(p, grid, stream); launch_phase<9>(p, grid, stream); launch_phase<10>(p, grid, stream); launch_phase<11>(p, grid, stream);
    launch_phase<12>(p, grid, stream); launch_phase<13>(p, grid, stream);
#endif
}
```

```cpp
#include <hip/hip_runtime.h>
#include <stdint.h>
#include <stdio.h>

#ifndef ONE_LAUNCH
#define ONE_LAUNCH 1
#endif

constexpr int D = 1024, NBATCH = 4, S = 4096, T = NBATCH * S;
constexpr int INW = 4352;
constexpr int NE = 256, TOPK = 8, ED = 256;
constexpr int OFF_HQ = 0, OFF_HF = 512, OFF_HI = 1024, OFF_HG = 1536, OFF_AQ = 2048, OFF_AK = 2816, OFF_AV = 3584;
constexpr float ALPHA = 1.189207115002721f;
constexpr float LN_EPS = 1e-5f, RMS_EPS = 1e-6f;
constexpr int NTHREADS = 512;
constexpr int VB_LDS = 67584;

typedef unsigned short bf16_t;
using bf16x8 = __attribute__((ext_vector_type(8))) short;
using f32x4 = __attribute__((ext_vector_type(4))) float;
using u32x4 = __attribute__((ext_vector_type(4))) unsigned int;

typedef float v2f_t __attribute__((ext_vector_type(2)));
typedef __bf16 v2bf_t __attribute__((ext_vector_type(2)));
typedef short v4s __attribute__((ext_vector_type(4)));
__device__ __forceinline__ unsigned short f2bf(float f) { return __builtin_bit_cast(unsigned short, (__bf16)f); }
__device__ __forceinline__ float bf2f(unsigned short h) { return __uint_as_float(((uint32_t)h) << 16); }
__device__ __forceinline__ uint32_t pack2(float a, float b) {
    const v2f_t f = {a, b};
    return __builtin_bit_cast(uint32_t, __builtin_convertvector(f, v2bf_t));
}
__device__ __forceinline__ float sigmoidf_(float v) { return 1.f / (1.f + __expf(-v)); }

__device__ __forceinline__ int otid() { int t = threadIdx.x; asm volatile("" : "+v"(t)); return t; }

struct Params {
    const float *x, *c, *w_ada, *b_ada, *w_in, *hg_lb, *hg_nw, *rel_bias, *w_out, *ln1_g, *ln1_b, *w_router, *router_bias,
        *w_eg, *w_eu, *w_ed, *w_sg, *w_su, *w_sd, *ln2_g, *ln2_b;
    float* out;
    unsigned* bar;
    int* cnt;
    float* mod;
    float* lbv;
    float* biasT;
    bf16_t* h1;
    bf16_t* proj;
    float* lgf;
    float* ao;
    float* alse;
    bf16_t* mixin;
    float* pre1;
    float* x1;
    bf16_t* h2;
    bf16_t* winT;
    bf16_t* woutT;
    bf16_t* wrT;
    bf16_t* wsgT;
    bf16_t* wsuT;
    bf16_t* wsdT;
    float* lgp;
    int* topi;
    float* topw;
    int* list;
    bf16_t* gbuf;
    bf16_t* gsh;
    bf16_t* ybuf;
    float* kv;
    float* dec;
    bf16_t* sst;
};

#define XB_TMO      128
#define XB_XCNT(j)  (256  + 64 * (j))
#define XB_XSUB(j)  (1280 + 64 * (j))
#define XB_XGEN(j)  (2304 + 64 * (j))
#define XB_TOP      3328
#define XB_TOPGEN   3392
#define XCD_BAR_WORDS 3456
#define XB_SPIN_CAP (1u << 18)
#define LAS __attribute__((address_space(3)))

__device__ __forceinline__ unsigned xb_ld(unsigned* p)              { return __hip_atomic_load(p, __ATOMIC_RELAXED, __HIP_MEMORY_SCOPE_AGENT); }
__device__ __forceinline__ unsigned xb_add(unsigned* p, unsigned v) { return __hip_atomic_fetch_add(p, v, __ATOMIC_RELAXED, __HIP_MEMORY_SCOPE_AGENT); }
__device__ __forceinline__ unsigned xb_xcc_id() { return (unsigned)__builtin_amdgcn_s_getreg((3 << 11) | 20) & 0xFu; }
#define XB_SPIN(cond, bar) do { unsigned _sp = 0; while (cond) { __builtin_amdgcn_s_sleep(1); \
    if ((++_sp & 255u) == 0u) { if (xb_ld(&(bar)[XB_TMO])) break; if (_sp > XB_SPIN_CAP) { atomicAdd(&(bar)[XB_TMO], 1u); break; } } } } while (0)

struct XcdBarrier {
    unsigned* bar; unsigned x;
    volatile LAS unsigned* st;
};
__device__ __forceinline__ XcdBarrier xcd_barrier_post(unsigned* bar, volatile LAS unsigned* st) {
    XcdBarrier b; b.bar = bar; b.x = xb_xcc_id(); b.st = st;
    if (threadIdx.x == 0) (void)xb_add(&bar[XB_XCNT(b.x)], 1u);
    return b;
}
__device__ __forceinline__ void xcd_barrier_complete(unsigned* bar, unsigned x, unsigned& nloc, unsigned& nx) {
    const unsigned G = gridDim.x * gridDim.y * gridDim.z;
    unsigned sum, cnt, mine, sp = 0u;
    for (;;) {
        sum = 0u; cnt = 0u; mine = 0u;
#pragma unroll
        for (unsigned j = 0; j < 16; ++j) { const unsigned c = xb_ld(&bar[XB_XCNT(j)]); sum += c; cnt += (c > 0u) ? 1u : 0u; mine = (j == x) ? c : mine; }
        if (sum == G) break;
        __builtin_amdgcn_s_sleep(1);
        if ((++sp & 255u) == 0u) { if (xb_ld(&bar[XB_TMO])) break; if (sp > XB_SPIN_CAP) { atomicAdd(&bar[XB_TMO], 1u); break; } }
    }
    nloc = mine > 0u ? mine : 1u; nx = cnt > 0u ? cnt : 1u;
}
__device__ __forceinline__ void xcd_barrier(const XcdBarrier& b) {
    asm volatile("s_waitcnt vmcnt(0)" ::: "memory");
    __syncthreads();
    if (threadIdx.x == 0) {
        unsigned* bar = b.bar;
        __builtin_amdgcn_s_waitcnt(0);
        unsigned nloc = b.st[0], nx = b.st[1];
        if (nloc == 0u) { xcd_barrier_complete(bar, b.x, nloc, nx); b.st[0] = nloc; b.st[1] = nx; }
        const unsigned old = xb_add(&bar[XB_XSUB(b.x)], 1u);
        const unsigned gen = old / nloc;
        if (old + 1u == (gen + 1u) * nloc) {
            __builtin_amdgcn_fence(__ATOMIC_RELEASE, "agent");
            asm volatile("s_waitcnt vmcnt(0)" ::: "memory");
            const unsigned og = xb_add(&bar[XB_TOP], 1u);
            const unsigned tg = og / nx;
            if (og + 1u == (tg + 1u) * nx) xb_add(&bar[XB_TOPGEN], 1u);
            else XB_SPIN(xb_ld(&bar[XB_TOPGEN]) == tg, bar);
            __builtin_amdgcn_fence(__ATOMIC_ACQUIRE, "agent");
            xb_add(&bar[XB_XGEN(b.x)], 1u);
            asm volatile("s_waitcnt vmcnt(0)" ::: "memory");
        } else {
            XB_SPIN(xb_ld(&bar[XB_XGEN(b.x)]) == gen, bar);
            __builtin_amdgcn_fence(__ATOMIC_ACQUIRE, "agent");
            asm volatile("s_waitcnt vmcnt(0)" ::: "memory");
        }
    }
    __syncthreads();
}

struct VB { int vb, nvb, tid; char* smem; };
__device__ __forceinline__ VB make_vb(char* smem) {
    const int t = otid();
    VB v; v.vb = (int)blockIdx.x * 2 + (t >> 8); v.nvb = (int)gridDim.x * 2; v.tid = t & 255; v.smem = smem + (t >> 8) * VB_LDS;
    return v;
}
__device__ __forceinline__ int swz(int row, int chunk) { return row * 128 + ((chunk ^ ((row >> 1) & 7)) << 4); }

__device__ __forceinline__ float wave_sum(float v) {
#pragma unroll
    for (int o = 32; o > 0; o >>= 1) v += __shfl_xor(v, o, 64);
    return v;
}

__device__ __forceinline__ int t5_bucket(int n) {
    if (n < 16) return n;
    const float v = logf((float)n / 16.f) / logf(128.f) * 16.f;
    int large = 16 + (int)v;
    return large < 31 ? large : 31;
}

__device__ __forceinline__ void tr_tile(const VB& v, const float* src, int ld, bf16_t* dst, bf16_t* dst2, int ldd, int k0, int n0) {
    float* t = (float*)v.smem;
    __syncthreads();
#pragma unroll
    for (int i = 0; i < 4; ++i) {
        const int r = (v.tid >> 4) + 16 * i, c4 = v.tid & 15;
        const f32x4 x = *(const f32x4*)(src + (size_t)(k0 + r) * ld + n0 + c4 * 4);
        t[r * 65 + c4 * 4 + 0] = x[0]; t[r * 65 + c4 * 4 + 1] = x[1]; t[r * 65 + c4 * 4 + 2] = x[2]; t[r * 65 + c4 * 4 + 3] = x[3];
    }
    __syncthreads();
    const int n = v.tid >> 2, kq = v.tid & 3;
    float f[16];
#pragma unroll
    for (int i = 0; i < 16; ++i) f[i] = t[(kq * 16 + i) * 65 + n];
    u32x4 a, b;
    a[0] = pack2(f[0], f[1]); a[1] = pack2(f[2], f[3]); a[2] = pack2(f[4], f[5]); a[3] = pack2(f[6], f[7]);
    b[0] = pack2(f[8], f[9]); b[1] = pack2(f[10], f[11]); b[2] = pack2(f[12], f[13]); b[3] = pack2(f[14], f[15]);
    bf16_t* d = dst + (size_t)(n0 + n) * ldd + k0 + kq * 16;
    *(u32x4*)d = a; *(u32x4*)(d + 8) = b;
    if (dst2) {
        u32x4 c, e;
#pragma unroll
        for (int i = 0; i < 4; ++i) {
            c[i] = pack2(f[2 * i] - __uint_as_float(a[i] << 16), f[2 * i + 1] - __uint_as_float(a[i] & 0xffff0000u));
            e[i] = pack2(f[8 + 2 * i] - __uint_as_float(b[i] << 16), f[8 + 2 * i + 1] - __uint_as_float(b[i] & 0xffff0000u));
        }
        bf16_t* d2 = dst2 + (size_t)(n0 + n) * ldd + k0 + kq * 16;
        *(u32x4*)d2 = c; *(u32x4*)(d2 + 8) = e;
    }
}

__device__ void ph_mod(const Params& p, char* smem0) {
    const VB v = make_vb(smem0);
    const int tid = v.tid;
    float* cond = (float*)(v.smem + 20480);
    float* red = cond + 4096;
    for (int i = tid; i < 4096; i += 256) { const float x = p.c[i]; cond[i] = x / (1.f + __expf(-x)); }
    __syncthreads();
    const int NU = 194 + 1088 + 192 + 64 + 64 + 64 + 64;
    const int rounds = (NU + v.nvb - 1) / v.nvb;
    for (int it = 0; it < rounds; ++it) {
        int u = v.vb + it * v.nvb;
        if (u >= NU) u = NU - 1;
        if (u < 192) {
            const int cl = tid & 31, kq = tid >> 5, n = u * 32 + cl;
            float a0 = 0.f, a1 = 0.f, a2 = 0.f, a3 = 0.f;
            for (int k = kq; k < 1024; k += 8) {
                const float w = p.w_ada[(size_t)k * 6144 + n];
                a0 += cond[k] * w; a1 += cond[1024 + k] * w; a2 += cond[2048 + k] * w; a3 += cond[3072 + k] * w;
            }
            red[(kq * 4 + 0) * 32 + cl] = a0; red[(kq * 4 + 1) * 32 + cl] = a1; red[(kq * 4 + 2) * 32 + cl] = a2; red[(kq * 4 + 3) * 32 + cl] = a3;
        }
        __syncthreads();
        if (u < 192) {
            if (tid < 128) {
                const int b = tid >> 5, c2 = tid & 31;
                float s = 0.f;
                for (int q = 0; q < 8; ++q) s += red[(q * 4 + b) * 32 + c2];
                p.mod[b * 6144 + u * 32 + c2] = s + p.b_ada[u * 32 + c2];
            }
        } else if (u == 192) {
            for (int j = tid; j < 512; j += 256) {
                const float a = p.hg_lb[j], b = p.hg_lb[512 + j];
                const float m = fmaxf(a, b);
                const float ea = expf(a - m), eb = expf(b - m);
                p.lbv[j] = ea / (ea + eb);
            }
        } else if (u == 193) {
            for (int i = tid; i < 3 * 129 * 4; i += 256) {
                const int g = i / (129 * 4), m = (i >> 2) % 129, hh = i & 3;
                const int dil = (g == 0) ? 1 : (g == 1 ? 4 : 16);
                p.biasT[i] = p.rel_bias[t5_bucket(m * dil) * 12 + g * 4 + hh];
            }
        }
        {
            int w = u - 194;
            const float* src = p.w_out; int ld = D; bf16_t* dst = p.woutT; bf16_t* dst2 = nullptr; int ldd = 768, k0 = 0, n0 = 0;
            if (w >= 0) {
                if (w < 1088) { src = p.w_in; ld = INW; dst = p.winT; ldd = D; k0 = (w / 68) * 64; n0 = (w % 68) * 64; }
                else if ((w -= 1088) < 192) { k0 = (w >> 4) * 64; n0 = (w & 15) * 64; }
                else if ((w -= 192) < 64) { src = p.w_router; ld = NE; dst = p.wrT; dst2 = p.wrT + (size_t)NE * D; ldd = D; k0 = (w >> 2) * 64; n0 = (w & 3) * 64; }
                else if ((w -= 64) < 64) { src = p.w_sg; ld = ED; dst = p.wsgT; ldd = D; k0 = (w >> 2) * 64; n0 = (w & 3) * 64; }
                else if ((w -= 64) < 64) { src = p.w_su; ld = ED; dst = p.wsuT; ldd = D; k0 = (w >> 2) * 64; n0 = (w & 3) * 64; }
                else { w -= 64; src = p.w_sd; ld = D; dst = p.wsdT; ldd = ED; k0 = (w >> 4) * 64; n0 = (w & 15) * 64; }
            }
            tr_tile(v, src, ld, dst, dst2, ldd, k0, n0);
        }
    }
}

__device__ void ph_ln0(const Params& p) {
    const int tid = otid(), lane = tid & 63, wid = tid >> 6;
    for (int row = blockIdx.x * 8 + wid; row < T; row += gridDim.x * 8) {
        const float4* xr = (const float4*)(p.x + (size_t)row * D);
        float4 v[4];
        float s = 0.f;
#pragma unroll
        for (int i = 0; i < 4; ++i) { v[i] = xr[lane + 64 * i]; s += v[i].x + v[i].y + v[i].z + v[i].w; }
        const float mean = wave_sum(s) * (1.f / D);
        float q = 0.f;
#pragma unroll
        for (int i = 0; i < 4; ++i) {
            v[i].x -= mean; v[i].y -= mean; v[i].z -= mean; v[i].w -= mean;
            q += v[i].x * v[i].x + v[i].y * v[i].y + v[i].z * v[i].z + v[i].w * v[i].w;
        }
        const float rstd = rsqrtf(wave_sum(q) * (1.f / D) + LN_EPS);
        const int b = row >> 12;
        const float* sh = p.mod + b * 6144;
        const float* sc = sh + 1024;
#pragma unroll
        for (int i = 0; i < 4; ++i) {
            const int col = (lane + 64 * i) * 4;
            const float4 s4 = *(const float4*)(sc + col), h4 = *(const float4*)(sh + col);
            uint2 o;
            o.x = pack2(v[i].x * rstd * (1.f + s4.x) + h4.x, v[i].y * rstd * (1.f + s4.y) + h4.y);
            o.y = pack2(v[i].z * rstd * (1.f + s4.z) + h4.z, v[i].w * rstd * (1.f + s4.w) + h4.w);
            *(uint2*)(p.h1 + (size_t)row * D + col) = o;
        }
    }
}

__device__ __forceinline__ int swz16(int row, int chunk) { return row * 256 + ((chunk ^ (row & 15)) << 4); }
struct TrBase { int lo, hi; };
__device__ __forceinline__ TrBase tr16_base(int lane) {
    const int g = lane >> 4, q = (lane & 15) >> 2, pp = lane & 3;
    const int xl = 8 * (g & 1) + q, h = pp >> 1;
    TrBase t;
    t.lo = (8 * g + q) * 256 + ((xl >> 1) << 5) + ((h ^ (xl & 1)) << 4) + 8 * (pp & 1);
    t.hi = (t.lo + 1024) ^ 64;
    return t;
}
__device__ __forceinline__ bf16x8 tr_frag16(const char* tile, const TrBase& tb, int ks, int c) {
    int cx = c << 5;
    asm volatile("" : "+v"(cx));
    const v4s lo = __builtin_amdgcn_ds_read_tr16_b64_v4i16((LAS v4s*)(tile + ks * 8192 + (tb.lo ^ cx)));
    const v4s hi = __builtin_amdgcn_ds_read_tr16_b64_v4i16((LAS v4s*)(tile + ks * 8192 + (tb.hi ^ cx)));
    return bf16x8{lo[0], lo[1], lo[2], lo[3], hi[0], hi[1], hi[2], hi[3]};
}


__device__ __forceinline__ int aoff(int row, int chunk) { return row * 64 + ((chunk ^ ((row >> 2) & 3)) << 4); }
__device__ __forceinline__ int boff(int row, int chunk) { return row * 512 + ((chunk ^ (((row & 3) << 1) | (((row >> 3) & 1) << 3))) << 4); }
__device__ __forceinline__ bf16x8 tr_pair(const char* p) {
    const v4s lo = __builtin_amdgcn_ds_read_tr16_b64_v4i16((LAS v4s*)(p));
    const v4s hi = __builtin_amdgcn_ds_read_tr16_b64_v4i16((LAS v4s*)(p + 2048));
    return bf16x8{lo[0], lo[1], lo[2], lo[3], hi[0], hi[1], hi[2], hi[3]};
}
constexpr int G3_STAGE = 32768;

template <int BMODE, class AF, class BF>
__device__ __forceinline__ void gemm3(char* smem, const int K, AF arow, BF bsrc, const int ldb, f32x4 (&acc)[4][8], const int nvalid = 256) {
    const int tid = otid(), lane = tid & 63, wid = tid >> 6, wr = wid >> 1, wc = wid & 1, fr = lane & 15, fq = lane >> 4;
    const bf16_t* ap[2];
#pragma unroll
    for (int i = 0; i < 2; ++i) ap[i] = arow((tid >> 2) + 128 * i) + (tid & 3) * 8;
    const float* bpf = nullptr;
    const bf16_t* bpb[2] = {nullptr, nullptr};
    if (BMODE == 0) bpf = (const float*)bsrc((tid & 63) * 4) + (size_t)(tid >> 6) * ldb;
    else {
#pragma unroll
        for (int i = 0; i < 2; ++i) bpb[i] = (const bf16_t*)bsrc((tid >> 2) + 128 * i) + (tid & 3) * 8;
    }
#pragma unroll
    for (int m = 0; m < 4; ++m)
#pragma unroll
        for (int n = 0; n < 8; ++n) acc[m][n] = f32x4{0.f, 0.f, 0.f, 0.f};
    const int trbase = (8 * fq + (fr >> 2)) * 512 + wc * 256 + (((fr >> 2) | ((fq & 1) << 2)) << 5) + ((fr & 3) >> 1) * 16 + (fr & 1) * 8;
    u32x4 ra0[2], ra1[2];
    f32x4 rf0[4], rf1[4];
    u32x4 rb0[2], rb1[2];
    const bool active = wr * 64 < nvalid;
#define G3_GLOAD(RA, RF, RB, k0) do { \
        _Pragma("unroll") for (int i = 0; i < 2; ++i) RA[i] = *(const u32x4*)(ap[i] + (k0)); \
        if (BMODE == 0) { _Pragma("unroll") for (int j = 0; j < 4; ++j) RF[j] = *(const f32x4*)(bpf + (size_t)((k0) + 8 * j) * ldb); } \
        else { _Pragma("unroll") for (int i = 0; i < 2; ++i) RB[i] = *(const u32x4*)(bpb[i] + (k0)); } } while (0)
#define G3_LWRITE(RA, RF, RB, st) do { \
        char* sA_ = (st); char* sB_ = (st) + 16384; \
        _Pragma("unroll") for (int i = 0; i < 2; ++i) *(u32x4*)(sA_ + aoff((tid >> 2) + 128 * i, tid & 3)) = RA[i]; \
        if (BMODE == 0) { _Pragma("unroll") for (int j = 0; j < 4; ++j) { uint2 w_; w_.x = pack2(RF[j][0], RF[j][1]); w_.y = pack2(RF[j][2], RF[j][3]); \
                *(uint2*)(sB_ + boff((tid >> 6) + 8 * j, (tid & 63) >> 1) + (tid & 1) * 8) = w_; } } \
        else { _Pragma("unroll") for (int i = 0; i < 2; ++i) *(u32x4*)(sB_ + aoff((tid >> 2) + 128 * i, tid & 3)) = RB[i]; } } while (0)
#define G3_COMPUTE(st) do { if (active) { \
        const char* sA_ = (st); const char* sB_ = (st) + 16384; \
        bf16x8 af[4]; \
        _Pragma("unroll") for (int m = 0; m < 4; ++m) af[m] = *(const bf16x8*)(sA_ + aoff(wr * 64 + m * 16 + fr, fq)); \
        _Pragma("unroll") for (int n = 0; n < 8; ++n) { \
            bf16x8 bfr; \
            if (BMODE == 0) bfr = tr_pair(sB_ + (trbase ^ (n << 5))); else bfr = *(const bf16x8*)(sB_ + aoff(wc * 128 + n * 16 + fr, fq)); \
            _Pragma("unroll") for (int m = 0; m < 4; ++m) acc[m][n] = __builtin_amdgcn_mfma_f32_16x16x32_bf16(af[m], bfr, acc[m][n], 0, 0, 0); } } } while (0)
    const int nk = K >> 5;
    char* st0 = smem;
    char* st1 = smem + G3_STAGE;
    G3_GLOAD(ra0, rf0, rb0, 0);
    G3_GLOAD(ra1, rf1, rb1, 32);
    G3_LWRITE(ra0, rf0, rb0, st0);
    if (nk > 2) G3_GLOAD(ra0, rf0, rb0, 64);
    __syncthreads();
    for (int kt = 0; kt < nk; kt += 2) {
        G3_LWRITE(ra1, rf1, rb1, st1);
        if (kt + 3 < nk) G3_GLOAD(ra1, rf1, rb1, (kt + 3) * 32);
        G3_COMPUTE(st0);
        __syncthreads();
        if (kt + 2 < nk) G3_LWRITE(ra0, rf0, rb0, st0);
        if (kt + 4 < nk) G3_GLOAD(ra0, rf0, rb0, (kt + 4) * 32);
        G3_COMPUTE(st1);
        __syncthreads();
    }
#undef G3_GLOAD
#undef G3_LWRITE
#undef G3_COMPUTE
}

template <class AF, class BF>
__device__ __forceinline__ void gemm4(char* smem, const int K, AF arow, BF brow, f32x4 (&acc)[4][8]) {
    const int tid = otid(), lane = tid & 63, wid = tid >> 6, wr = wid >> 1, wc = wid & 1, fr = lane & 15, fq = lane >> 4;
    const bf16_t* ga[2];
    const bf16_t* gb[2];
#pragma unroll
    for (int i = 0; i < 2; ++i) {
        const int r = 16 * (wid + 8 * i) + (lane >> 2), sc = ((lane & 3) ^ ((r >> 2) & 3)) * 8;
        ga[i] = arow(r) + sc;
        gb[i] = brow(r) + sc;
    }
#pragma unroll
    for (int m = 0; m < 4; ++m)
#pragma unroll
        for (int n = 0; n < 8; ++n) acc[m][n] = f32x4{0.f, 0.f, 0.f, 0.f};
    char* ldst = smem + wid * 1024 + lane * 16;
#define G4_ISSUE(slot, k0) do { \
        char* d_ = ldst + (slot) * 32768; \
        __builtin_amdgcn_global_load_lds((const unsigned*)(ga[0] + (k0)), (LAS unsigned*)(d_), 16, 0, 0); \
        __builtin_amdgcn_global_load_lds((const unsigned*)(ga[1] + (k0)), (LAS unsigned*)(d_ + 8192), 16, 0, 0); \
        __builtin_amdgcn_global_load_lds((const unsigned*)(gb[0] + (k0)), (LAS unsigned*)(d_ + 16384), 16, 0, 0); \
        __builtin_amdgcn_global_load_lds((const unsigned*)(gb[1] + (k0)), (LAS unsigned*)(d_ + 16384 + 8192), 16, 0, 0); } while (0)
    const int nk = K >> 5;
    G4_ISSUE(0, 0);
    G4_ISSUE(1, 32);
    int slot = 0, slot2 = 2;
    for (int kt = 0; kt < nk; ++kt) {
        if (kt + 1 < nk) asm volatile("s_waitcnt vmcnt(4)" ::: "memory");
        else asm volatile("s_waitcnt vmcnt(0)" ::: "memory");
        __builtin_amdgcn_s_barrier();
        if (kt + 2 < nk) G4_ISSUE(slot2, (kt + 2) * 32);
        const char* sA_ = smem + slot * 32768;
        const char* sB_ = sA_ + 16384;
        bf16x8 af[4];
#pragma unroll
        for (int m = 0; m < 4; ++m) af[m] = *(const bf16x8*)(sA_ + aoff(wr * 64 + m * 16 + fr, fq));
#pragma unroll
        for (int n = 0; n < 8; ++n) {
            const bf16x8 bfr = *(const bf16x8*)(sB_ + aoff(wc * 128 + n * 16 + fr, fq));
#pragma unroll
            for (int m = 0; m < 4; ++m) acc[m][n] = __builtin_amdgcn_mfma_f32_16x16x32_bf16(af[m], bfr, acc[m][n], 0, 0, 0);
        }
        slot = (slot == 2) ? 0 : slot + 1;
        slot2 = (slot2 == 2) ? 0 : slot2 + 1;
    }
#undef G4_ISSUE
    __syncthreads();
}

constexpr int EPI_WAVE = 8704;
template <class VF, class SF>
__device__ __forceinline__ void epi_bf16(char* wl, const int lane, VF val, SF store) {
    const int fr = lane & 15, fq = lane >> 4, odd = lane & 1;
#pragma unroll
    for (int n = 0; n < 8; ++n)
#pragma unroll
        for (int jp = 0; jp < 2; ++jp) {
            const float a = val(n, 2 * jp), b = val(n, 2 * jp + 1);
            const float x = odd ? a : b;
            const float y = __shfl_xor(x, 1, 64);
            const uint32_t w = odd ? pack2(y, b) : pack2(a, y);
            *(uint32_t*)(wl + (fq * 4 + 2 * jp + odd) * 272 + (n * 16 + (fr & ~1)) * 2) = w;
        }
    int ln = lane;
    asm volatile("" : "+v"(ln));
#pragma unroll
    for (int i = 0; i < 4; ++i) {
        const int idx = ln + 64 * i, row = idx >> 4, ch = idx & 15;
        store(row, ch, *(const u32x4*)(wl + row * 272 + ch * 16));
    }
}
template <class VF, class SF>
__device__ __forceinline__ void epi_f32(char* wl, const int lane, VF val, SF store) {
    const int fr = lane & 15, fq = lane >> 4;
#pragma unroll
    for (int n = 0; n < 8; ++n)
#pragma unroll
        for (int j = 0; j < 4; ++j) *(float*)(wl + (fq * 4 + j) * 528 + (n * 16 + fr) * 4) = val(n, j);
    int ln = lane;
    asm volatile("" : "+v"(ln));
#pragma unroll
    for (int i = 0; i < 8; ++i) {
        const int idx = ln + 64 * i, row = idx >> 5, ch = idx & 31;
        store(row, ch, *(const f32x4*)(wl + row * 528 + ch * 16));
    }
}

__device__ void ph_inproj(const Params& p, char* smem) {
    const int tid = otid(), lane = tid & 63, wid = tid >> 6, wr = wid >> 1, wc = wid & 1, fr = lane & 15;
    const int NTN = INW / 256;
    const int xcd = blockIdx.x & 7, nbx = gridDim.x >> 3;
    for (int i = blockIdx.x >> 3; i < 8 * NTN; i += nbx) {
        const int nt = i >> 3, mt = xcd * 8 + (i & 7);
        const bf16_t* A = p.h1 + (size_t)mt * 256 * D;
        const bf16_t* Bt = p.winT + (size_t)nt * 256 * D;
        f32x4 acc[4][8];
        __syncthreads();
        gemm4(smem, D, [&](int r) { return A + (size_t)r * D; }, [&](int n) { return Bt + (size_t)n * D; }, acc);
        char* wl = smem + wid * EPI_WAVE;
        const int colb = nt * 256 + wc * 128;
        const int rowb = mt * 256 + wr * 64;
        if (colb >= OFF_HF && colb < OFF_HI) {
            float lbc[8];
#pragma unroll
            for (int n = 0; n < 8; ++n) lbc[n] = p.lbv[colb - OFF_HF + n * 16 + fr];
#pragma unroll
            for (int m = 0; m < 4; ++m) {
                float* dst = p.lgf + (size_t)(rowb + m * 16) * 512 + (colb - OFF_HF);
                epi_f32(wl, lane,
                        [&](int n, int j) { return logf(lbc[n] + (1.f - lbc[n]) * (1.f / (1.f + expf(-acc[m][n][j])))); },
                        [&](int row, int ch, f32x4 v) { *(f32x4*)(dst + (size_t)row * 512 + ch * 4) = v; });
            }
        } else {
#pragma unroll
            for (int m = 0; m < 4; ++m) {
                bf16_t* dst = p.proj + (size_t)(rowb + m * 16) * INW + colb;
                epi_bf16(wl, lane, [&](int n, int j) { return acc[m][n][j]; },
                         [&](int row, int ch, u32x4 v) { *(u32x4*)(dst + (size_t)row * INW + ch * 8) = v; });
            }
        }
    }
}

__device__ void ph_h1(const Params& p, char* smem0) {
    const VB vbk = make_vb(smem0);
    char* smem = vbk.smem;
    const int tid = vbk.tid, lane = tid & 63, wid = tid >> 6, wr = wid >> 1, wc = wid & 1, fr = lane & 15, fq = lane >> 4;
    char* sI = smem;
    char* sK = smem + 16384;
    float* sL = (float*)(smem + 32768);
    float* totS = (float*)(smem + 65536);
    const int d = tid & 127, half = tid >> 7;
    const TrBase trb = tr16_base(lane);
    for (int u = vbk.vb; u < 1024; u += vbk.nvb) {
        const int bh = u >> 6, c = u & 63, b = bh >> 2, h = bh & 3;
        const size_t row0 = (size_t)b * S + c * 64;
        __syncthreads();
#pragma unroll
        for (int i = 0; i < 4; ++i) {
            const int idx = tid + 256 * i, r = idx >> 4, ch = idx & 15;
            *(u32x4*)(sI + swz16(r, ch)) = *(const u32x4*)(p.proj + (row0 + r) * INW + OFF_HI + h * 128 + ch * 8);
        }
#pragma unroll
        for (int i = 0; i < 8; ++i) {
            const int idx = tid + 256 * i, r = idx >> 5, c4 = idx & 31;
            *(f32x4*)(sL + r * 128 + c4 * 4) = *(const f32x4*)(p.lgf + (row0 + r) * 512 + h * 128 + c4 * 4);
        }
        __syncthreads();
        const float* lcol = sL + half * 32 * 128 + d;
        float tot = 0.f;
#pragma unroll
        for (int s = 0; s < 32; ++s) tot += lcol[s * 128];
        totS[half * 128 + d] = tot;
        __syncthreads();
        const float t0 = totS[d], bl = t0 + totS[128 + d];
        float run = half ? t0 : 0.f;
#pragma unroll 8
        for (int s = 0; s < 32; ++s) {
            const float lv = lcol[s * 128];
            run += lv;
            const float kt = (1.f - __expf(lv)) * __expf(bl - run);
            *(bf16_t*)(sK + swz16(half * 32 + s, d >> 3) + (d & 7) * 2) = f2bf(kt);
        }
        if (half == 0) p.dec[u * 128 + d] = __expf(bl);
        __syncthreads();
        f32x4 acc[4][4];
#pragma unroll
        for (int m = 0; m < 4; ++m)
#pragma unroll
            for (int n = 0; n < 4; ++n) acc[m][n] = f32x4{0.f, 0.f, 0.f, 0.f};
#pragma unroll
        for (int ks = 0; ks < 2; ++ks) {
            bf16x8 af[4], bfr[4];
#pragma unroll
            for (int m = 0; m < 4; ++m) af[m] = tr_frag16(sI, trb, ks, wr * 4 + m);
#pragma unroll
            for (int n = 0; n < 4; ++n) bfr[n] = tr_frag16(sK, trb, ks, wc * 4 + n);
#pragma unroll
            for (int m = 0; m < 4; ++m)
#pragma unroll
                for (int n = 0; n < 4; ++n) acc[m][n] = __builtin_amdgcn_mfma_f32_16x16x32_bf16(af[m], bfr[n], acc[m][n], 0, 0, 0);
        }
        float* kvu = p.kv + (size_t)u * 16384;
#pragma unroll
        for (int m = 0; m < 4; ++m)
#pragma unroll
            for (int n = 0; n < 4; ++n)
#pragma unroll
                for (int j = 0; j < 4; ++j) kvu[(wr * 64 + m * 16 + fq * 4 + j) * 128 + wc * 64 + n * 16 + fr] = acc[m][n][j];
    }
}

__device__ void ph_h2(const Params& p) {
    for (int it = blockIdx.x * NTHREADS + otid(); it < 16 * 8192; it += gridDim.x * NTHREADS) {
        const int bh = it >> 13, e2 = it & 8191, dv = e2 >> 6, dk = (e2 & 63) * 2;
        const size_t eoff = (size_t)dv * 128 + dk;
        float sx = 0.f, sy = 0.f;
#pragma unroll 8
        for (int c = 0; c < 64; ++c) {
            const size_t u = (size_t)bh * 64 + c;
            *(uint32_t*)(p.sst + u * 16384 + eoff) = pack2(sx, sy);
            const float2 kvv = *(const float2*)(p.kv + u * 16384 + eoff);
            const float2 dc = *(const float2*)(p.dec + u * 128 + dk);
            sx = dc.x * sx + kvv.x; sy = dc.y * sy + kvv.y;
        }
    }
}

__device__ void ph_h3(const Params& p, char* smem0) {
    const VB vbk = make_vb(smem0);
    char* smem = vbk.smem;
    const int tid = vbk.tid, lane = tid & 63, wid = tid >> 6, wr = wid >> 1, wc = wid & 1, fr = lane & 15, fq = lane >> 4;
    char* sQ = smem;
    char* sK = smem + 16384;
    char* sP = smem + 32768;
    float* sL = (float*)(smem + 32768);
    float* totS = (float*)(smem + 65536);
    const int d = tid & 127, half = tid >> 7;
    const TrBase trb = tr16_base(lane);
    for (int u = vbk.vb; u < 1024; u += vbk.nvb) {
        const int bh = u >> 6, c = u & 63, b = bh >> 2, h = bh & 3;
        const size_t row0 = (size_t)b * S + c * 64;
        __syncthreads();
#pragma unroll
        for (int i = 0; i < 4; ++i) {
            const int idx = tid + 256 * i, r = idx >> 4, ch = idx & 15;
            *(u32x4*)(sQ + swz16(r, ch)) = *(const u32x4*)(p.proj + (row0 + r) * INW + OFF_HQ + h * 128 + ch * 8);
        }
#pragma unroll
        for (int i = 0; i < 8; ++i) {
            const int idx = tid + 256 * i, r = idx >> 5, c4 = idx & 31;
            *(f32x4*)(sL + r * 128 + c4 * 4) = *(const f32x4*)(p.lgf + (row0 + r) * 512 + h * 128 + c4 * 4);
        }
        __syncthreads();
        const float* lcol = sL + half * 32 * 128 + d;
        float tot = 0.f;
#pragma unroll
        for (int s = 0; s < 32; ++s) tot += lcol[s * 128];
        totS[half * 128 + d] = tot;
        __syncthreads();
        const float t0 = totS[d];
        float run = half ? t0 : 0.f;
#pragma unroll 8
        for (int s = 0; s < 32; ++s) {
            const float lv = lcol[s * 128];
            run += lv;
            const int o = swz16(half * 32 + s, d >> 3) + (d & 7) * 2;
            const float qm = bf2f(*(const bf16_t*)(sQ + o)) * __expf(run - t0);
            const float kh = (1.f - __expf(lv)) * __expf(t0 - run);
            *(bf16_t*)(sQ + o) = f2bf(qm);
            *(bf16_t*)(sK + o) = f2bf(kh);
        }
        __syncthreads();
        {
            f32x4 pa[2][2];
#pragma unroll
            for (int m = 0; m < 2; ++m)
#pragma unroll
                for (int n = 0; n < 2; ++n) pa[m][n] = f32x4{0.f, 0.f, 0.f, 0.f};
#pragma unroll
            for (int ks = 0; ks < 4; ++ks) {
                bf16x8 af[2], bfr[2];
#pragma unroll
                for (int m = 0; m < 2; ++m) af[m] = *(const bf16x8*)(sQ + swz16(wr * 32 + m * 16 + fr, ks * 4 + fq));
#pragma unroll
                for (int n = 0; n < 2; ++n) bfr[n] = *(const bf16x8*)(sK + swz16(wc * 32 + n * 16 + fr, ks * 4 + fq));
#pragma unroll
                for (int m = 0; m < 2; ++m)
#pragma unroll
                    for (int n = 0; n < 2; ++n) pa[m][n] = __builtin_amdgcn_mfma_f32_16x16x32_bf16(af[m], bfr[n], pa[m][n], 0, 0, 0);
            }
#pragma unroll
            for (int m = 0; m < 2; ++m)
#pragma unroll
                for (int n = 0; n < 2; ++n)
#pragma unroll
                    for (int j = 0; j < 4; ++j) {
                        const int t = wr * 32 + m * 16 + fq * 4 + j, s_ = wc * 32 + n * 16 + fr;
                        const float v = (s_ <= t) ? pa[m][n][j] : 0.f;
                        *(bf16_t*)(sP + swz(t, s_ >> 3) + (s_ & 7) * 2) = f2bf(v);
                    }
        }
        __syncthreads();
        f32x4 oa[8];
#pragma unroll
        for (int n = 0; n < 8; ++n) oa[n] = f32x4{0.f, 0.f, 0.f, 0.f};
        const int ch = tid & 7;
#pragma unroll
        for (int sub = 0; sub < 2; ++sub) {
            float sc[8];
#pragma unroll
            for (int j = 0; j < 8; ++j) sc[j] = __expf(totS[sub * 64 + ch * 8 + j]);
#pragma unroll
            for (int i = 0; i < 4; ++i) {
                const int r = (tid + 256 * i) >> 3;
                const u32x4 v = *(const u32x4*)(p.sst + (size_t)u * 16384 + r * 128 + sub * 64 + ch * 8);
                u32x4 w;
                w.x = pack2(__uint_as_float(v.x << 16) * sc[0], __uint_as_float(v.x & 0xffff0000u) * sc[1]);
                w.y = pack2(__uint_as_float(v.y << 16) * sc[2], __uint_as_float(v.y & 0xffff0000u) * sc[3]);
                w.z = pack2(__uint_as_float(v.z << 16) * sc[4], __uint_as_float(v.z & 0xffff0000u) * sc[5]);
                w.w = pack2(__uint_as_float(v.w << 16) * sc[6], __uint_as_float(v.w & 0xffff0000u) * sc[7]);
                *(u32x4*)(sK + swz(r, ch)) = w;
            }
            __syncthreads();
#pragma unroll
            for (int ks = 0; ks < 2; ++ks) {
                const bf16x8 af = *(const bf16x8*)(sQ + swz16(wid * 16 + fr, sub * 8 + ks * 4 + fq));
#pragma unroll
                for (int n = 0; n < 8; ++n) {
                    const bf16x8 bfr = *(const bf16x8*)(sK + swz(n * 16 + fr, ks * 4 + fq));
                    oa[n] = __builtin_amdgcn_mfma_f32_16x16x32_bf16(af, bfr, oa[n], 0, 0, 0);
                }
            }
            __syncthreads();
        }
#pragma unroll
        for (int i = 0; i < 4; ++i) {
            const int idx = tid + 256 * i, r = idx >> 4, c16 = idx & 15;
            *(u32x4*)(sK + swz16(r, c16)) = *(const u32x4*)(p.proj + (row0 + r) * INW + OFF_HI + h * 128 + c16 * 8);
        }
        __syncthreads();
#pragma unroll
        for (int ks = 0; ks < 2; ++ks) {
            const bf16x8 af = *(const bf16x8*)(sP + swz(wid * 16 + fr, ks * 4 + fq));
#pragma unroll
            for (int n = 0; n < 8; ++n) {
                const bf16x8 bfr = tr_frag16(sK, trb, ks, n);
                oa[n] = __builtin_amdgcn_mfma_f32_16x16x32_bf16(af, bfr, oa[n], 0, 0, 0);
            }
        }
        float ss[4] = {0.f, 0.f, 0.f, 0.f};
#pragma unroll
        for (int n = 0; n < 8; ++n)
#pragma unroll
            for (int j = 0; j < 4; ++j) ss[j] += oa[n][j] * oa[n][j];
#pragma unroll
        for (int j = 0; j < 4; ++j) {
            ss[j] += __shfl_xor(ss[j], 1, 64); ss[j] += __shfl_xor(ss[j], 2, 64); ss[j] += __shfl_xor(ss[j], 4, 64); ss[j] += __shfl_xor(ss[j], 8, 64);
        }
#pragma unroll
        for (int j = 0; j < 4; ++j) {
            const size_t row = row0 + wid * 16 + fq * 4 + j;
            const float rstd = rsqrtf(ss[j] * (1.f / 128.f) + RMS_EPS);
#pragma unroll
            for (int n = 0; n < 8; ++n) {
                const int dv = n * 16 + fr;
                const float g = bf2f(p.proj[row * INW + OFF_HG + h * 128 + dv]);
                const float y = oa[n][j] * rstd * p.hg_nw[h * 128 + dv] * (g / (1.f + __expf(-g)));
                p.mixin[row * 768 + h * 128 + dv] = f2bf(y);
            }
        }
    }
}

__device__ __forceinline__ TrBase tr8_base(int lane) {
    const int g = lane >> 4, q = (lane & 15) >> 2, pp = lane & 3;
    const int xl = 4 * (g & 1) + (q >> 1), h = pp >> 1;
    TrBase t;
    t.lo = (8 * g + q) * 128 + ((xl >> 1) << 5) + ((h ^ (xl & 1)) << 4) + 8 * (pp & 1);
    t.hi = (t.lo + 512) ^ 32;
    return t;
}
__device__ __forceinline__ bf16x8 tr_frag8(const char* tile, const TrBase& tb, int ks, int c) {
    int cx = c << 5;
    asm volatile("" : "+v"(cx));
    const v4s lo = __builtin_amdgcn_ds_read_tr16_b64_v4i16((LAS v4s*)(tile + ks * 4096 + (tb.lo ^ cx)));
    const v4s hi = __builtin_amdgcn_ds_read_tr16_b64_v4i16((LAS v4s*)(tile + ks * 4096 + (tb.hi ^ cx)));
    return bf16x8{lo[0], lo[1], lo[2], lo[3], hi[0], hi[1], hi[2], hi[3]};
}

__device__ void ph_attn(const Params& p, char* smem0) {
    const VB vbk = make_vb(smem0);
    char* smem = vbk.smem;
    const int tid = vbk.tid, lane = tid & 63, wid = tid >> 6, fr = lane & 15, fq = lane >> 4;
    char* sQ = smem;
    char* sK = smem + 8192;
    char* sP = sK;
    char* sV = smem + 33792;
    float* sBias = (float*)(smem + 58368);
    const TrBase trb = tr8_base(lane);
    for (int u = vbk.vb; u < 3072; u += vbk.nvb) {
        const int ti = u & 63, gq = u >> 6, g = gq % 3, bhh = gq / 3, hh = bhh & 3, b = bhh >> 2;
        const int lsh = (g == 0) ? 0 : (g == 1 ? 2 : 4), dl = 1 << lsh;
        const int tpr = (S >> lsh) >> 6;
        const int r = ti / tpr, j0 = (ti % tpr) * 64;
        const bf16_t* base = p.proj + (size_t)b * S * INW + (g * 4 + hh) * 64;
        __syncthreads();
#pragma unroll
        for (int i = 0; i < 2; ++i) {
            const int idx = tid + 256 * i, row = idx >> 3, ch = idx & 7;
            const int tok = (j0 + row) * dl + r;
            *(u32x4*)(sQ + swz(row, ch)) = *(const u32x4*)(base + (size_t)tok * INW + OFF_AQ + ch * 8);
        }
#pragma unroll
        for (int i = 0; i < 6; ++i) {
            const int idx = tid + 256 * i, row = idx >> 3, ch = idx & 7;
            const int j = j0 - 128 + row;
            u32x4 kx = {0u, 0u, 0u, 0u}, vx = {0u, 0u, 0u, 0u};
            if (j >= 0) {
                const size_t o = (size_t)(j * dl + r) * INW + ch * 8;
                kx = *(const u32x4*)(base + o + OFF_AK);
                vx = *(const u32x4*)(base + o + OFF_AV);
            }
            *(u32x4*)(sK + swz(row, ch)) = kx;
            *(u32x4*)(sV + swz(row, ch)) = vx;
        }
        if (tid < 129) sBias[tid] = p.biasT[(g * 129 + tid) * 4 + hh];
        __syncthreads();
        f32x4 sa[12];
#pragma unroll
        for (int n = 0; n < 12; ++n) sa[n] = f32x4{0.f, 0.f, 0.f, 0.f};
#pragma unroll
        for (int ks = 0; ks < 2; ++ks) {
            const bf16x8 af = *(const bf16x8*)(sQ + swz(wid * 16 + fr, ks * 4 + fq));
#pragma unroll
            for (int n = 0; n < 12; ++n) {
                const bf16x8 bfr = *(const bf16x8*)(sK + swz(n * 16 + fr, ks * 4 + fq));
                sa[n] = __builtin_amdgcn_mfma_f32_16x16x32_bf16(af, bfr, sa[n], 0, 0, 0);
            }
        }
        float mx[4] = {-INFINITY, -INFINITY, -INFINITY, -INFINITY};
#pragma unroll
        for (int n = 0; n < 12; ++n)
#pragma unroll
            for (int j = 0; j < 4; ++j) {
                const int jj = wid * 16 + fq * 4 + j, kk = n * 16 + fr, m = jj + 128 - kk;
                const bool valid = (m >= 0) && (m <= 128) && (j0 - 128 + kk >= 0);
                const int mc = m < 0 ? 0 : (m > 128 ? 128 : m);
                const float v = valid ? sa[n][j] * 0.125f + sBias[mc] : -INFINITY;
                sa[n][j] = v;
                mx[j] = fmaxf(mx[j], v);
            }
#pragma unroll
        for (int j = 0; j < 4; ++j) {
            mx[j] = fmaxf(mx[j], __shfl_xor(mx[j], 1, 64)); mx[j] = fmaxf(mx[j], __shfl_xor(mx[j], 2, 64));
            mx[j] = fmaxf(mx[j], __shfl_xor(mx[j], 4, 64)); mx[j] = fmaxf(mx[j], __shfl_xor(mx[j], 8, 64));
        }
        float ls[4] = {0.f, 0.f, 0.f, 0.f};
#pragma unroll
        for (int n = 0; n < 12; ++n)
#pragma unroll
            for (int j = 0; j < 4; ++j) { const float pe = __expf(sa[n][j] - mx[j]); sa[n][j] = pe; ls[j] += pe; }
#pragma unroll
        for (int j = 0; j < 4; ++j) {
            ls[j] += __shfl_xor(ls[j], 1, 64); ls[j] += __shfl_xor(ls[j], 2, 64); ls[j] += __shfl_xor(ls[j], 4, 64); ls[j] += __shfl_xor(ls[j], 8, 64);
        }
        __syncthreads();
#pragma unroll
        for (int n = 0; n < 12; ++n)
#pragma unroll
            for (int j = 0; j < 4; ++j) *(bf16_t*)(sP + (wid * 16 + fq * 4 + j) * 400 + (n * 16 + fr) * 2) = f2bf(sa[n][j]);
        f32x4 oa[4];
#pragma unroll
        for (int n = 0; n < 4; ++n) oa[n] = f32x4{0.f, 0.f, 0.f, 0.f};
#pragma unroll
        for (int ks = 0; ks < 6; ++ks) {
            const bf16x8 af = *(const bf16x8*)(sP + (wid * 16 + fr) * 400 + (ks * 4 + fq) * 16);
#pragma unroll
            for (int n = 0; n < 4; ++n) {
                const bf16x8 bfr = tr_frag8(sV, trb, ks, n);
                oa[n] = __builtin_amdgcn_mfma_f32_16x16x32_bf16(af, bfr, oa[n], 0, 0, 0);
            }
        }
#pragma unroll
        for (int j = 0; j < 4; ++j) {
            const int jj = wid * 16 + fq * 4 + j;
            const size_t row = (size_t)g * T + (size_t)b * S + (j0 + jj) * dl + r;
            const float inv = 1.f / ls[j];
#pragma unroll
            for (int n = 0; n < 4; ++n) p.ao[row * 256 + hh * 64 + n * 16 + fr] = oa[n][j] * inv;
            if (fr == 0) p.alse[row * 4 + hh] = mx[j] + __logf(ls[j]);
        }
    }
}

__device__ void ph_attn_merge(const Params& p) {
    const int tid = otid(), lane = tid & 63, wid = tid >> 6;
    for (int row = blockIdx.x * 8 + wid; row < T; row += gridDim.x * 8) {
        const int hh = lane >> 4;
        const float l0 = p.alse[((size_t)0 * T + row) * 4 + hh], l1 = p.alse[((size_t)1 * T + row) * 4 + hh], l2 = p.alse[((size_t)2 * T + row) * 4 + hh];
        const float mxl = fmaxf(l0, fmaxf(l1, l2));
        float e0 = __expf(l0 - mxl), e1 = __expf(l1 - mxl), e2 = __expf(l2 - mxl);
        const float inv = 1.f / (e0 + e1 + e2);
        e0 *= inv; e1 *= inv; e2 *= inv;
        const f32x4 a0 = *(const f32x4*)(p.ao + ((size_t)0 * T + row) * 256 + lane * 4);
        const f32x4 a1 = *(const f32x4*)(p.ao + ((size_t)1 * T + row) * 256 + lane * 4);
        const f32x4 a2 = *(const f32x4*)(p.ao + ((size_t)2 * T + row) * 256 + lane * 4);
        uint2 o;
        o.x = pack2(a0[0] * e0 + a1[0] * e1 + a2[0] * e2, a0[1] * e0 + a1[1] * e1 + a2[1] * e2);
        o.y = pack2(a0[2] * e0 + a1[2] * e1 + a2[2] * e2, a0[3] * e0 + a1[3] * e1 + a2[3] * e2);
        *(uint2*)(p.mixin + (size_t)row * 768 + 512 + lane * 4) = o;
    }
}

__device__ void ph_outproj(const Params& p, char* smem) {
    const int tid = otid(), lane = tid & 63, wid = tid >> 6, wr = wid >> 1, wc = wid & 1;
    const int xcd = blockIdx.x & 7, nbx = gridDim.x >> 3;
    for (int i = blockIdx.x >> 3; i < 32; i += nbx) {
        const int nt = i >> 3, mt = xcd * 8 + (i & 7);
        const bf16_t* A = p.mixin + (size_t)mt * 256 * 768;
        const bf16_t* Bt = p.woutT + (size_t)nt * 256 * 768;
        f32x4 acc[4][8];
        __syncthreads();
        gemm4(smem, 768, [&](int r) { return A + (size_t)r * 768; }, [&](int n) { return Bt + (size_t)n * 768; }, acc);
        const int b = (mt * 256) >> 12;
        const int colb = nt * 256 + wc * 128;
        const float* g1 = p.mod + b * 6144 + 2048 + colb;
        char* wl = smem + wid * EPI_WAVE;
#pragma unroll
        for (int m = 0; m < 4; ++m) {
            const size_t rbase = (size_t)(mt * 256 + wr * 64 + m * 16) * D + colb;
            epi_f32(wl, lane, [&](int n, int j) { return acc[m][n][j]; },
                    [&](int row, int ch, f32x4 v) {
                        const f32x4 xv = *(const f32x4*)(p.x + rbase + (size_t)row * D + ch * 4);
                        const f32x4 gv = *(const f32x4*)(g1 + ch * 4);
                        f32x4 o;
                        o[0] = ALPHA * xv[0] + gv[0] * v[0]; o[1] = ALPHA * xv[1] + gv[1] * v[1];
                        o[2] = ALPHA * xv[2] + gv[2] * v[2]; o[3] = ALPHA * xv[3] + gv[3] * v[3];
                        *(f32x4*)(p.pre1 + rbase + (size_t)row * D + ch * 4) = o;
                    });
        }
    }
}

__device__ void ph_ln1(const Params& p) {
    const int tid = otid(), lane = tid & 63, wid = tid >> 6;
    for (int row = blockIdx.x * 8 + wid; row < T; row += gridDim.x * 8) {
        const float4* xr = (const float4*)(p.pre1 + (size_t)row * D);
        float4 v[4];
        float s = 0.f;
#pragma unroll
        for (int i = 0; i < 4; ++i) { v[i] = xr[lane + 64 * i]; s += v[i].x + v[i].y + v[i].z + v[i].w; }
        float mean = wave_sum(s) * (1.f / D);
        float q = 0.f;
#pragma unroll
        for (int i = 0; i < 4; ++i) {
            v[i].x -= mean; v[i].y -= mean; v[i].z -= mean; v[i].w -= mean;
            q += v[i].x * v[i].x + v[i].y * v[i].y + v[i].z * v[i].z + v[i].w * v[i].w;
        }
        float rstd = rsqrtf(wave_sum(q) * (1.f / D) + LN_EPS);
        s = 0.f;
#pragma unroll
        for (int i = 0; i < 4; ++i) {
            const int col = (lane + 64 * i) * 4;
            const float4 g4 = *(const float4*)(p.ln1_g + col), b4 = *(const float4*)(p.ln1_b + col);
            v[i].x = v[i].x * rstd * g4.x + b4.x; v[i].y = v[i].y * rstd * g4.y + b4.y;
            v[i].z = v[i].z * rstd * g4.z + b4.z; v[i].w = v[i].w * rstd * g4.w + b4.w;
            *(float4*)(p.x1 + (size_t)row * D + col) = v[i];
            s += v[i].x + v[i].y + v[i].z + v[i].w;
        }
        mean = wave_sum(s) * (1.f / D);
        q = 0.f;
#pragma unroll
        for (int i = 0; i < 4; ++i) {
            v[i].x -= mean; v[i].y -= mean; v[i].z -= mean; v[i].w -= mean;
            q += v[i].x * v[i].x + v[i].y * v[i].y + v[i].z * v[i].z + v[i].w * v[i].w;
        }
        rstd = rsqrtf(wave_sum(q) * (1.f / D) + LN_EPS);
        const int b = row >> 12;
        const float* sh = p.mod + b * 6144 + 3072;
        const float* sc = sh + 1024;
#pragma unroll
        for (int i = 0; i < 4; ++i) {
            const int col = (lane + 64 * i) * 4;
            const float4 s4 = *(const float4*)(sc + col), h4 = *(const float4*)(sh + col);
            float4 y;
            y.x = v[i].x * rstd * (1.f + s4.x) + h4.x; y.y = v[i].y * rstd * (1.f + s4.y) + h4.y;
            y.z = v[i].z * rstd * (1.f + s4.z) + h4.z; y.w = v[i].w * rstd * (1.f + s4.w) + h4.w;
            uint2 o;
            o.x = pack2(y.x, y.y); o.y = pack2(y.z, y.w);
            *(uint2*)(p.h2 + (size_t)row * 2048 + col) = o;
            uint2 o2;
            o2.x = pack2(y.x - __uint_as_float(o.x << 16), y.y - __uint_as_float(o.x & 0xffff0000u));
            o2.y = pack2(y.z - __uint_as_float(o.y << 16), y.w - __uint_as_float(o.y & 0xffff0000u));
            *(uint2*)(p.h2 + (size_t)row * 2048 + 1024 + col) = o2;
        }
    }
}

__device__ void ph_router_gemm(const Params& p, char* smem) {
    const int tid = otid(), lane = tid & 63, wid = tid >> 6, wr = wid >> 1, wc = wid & 1;
    for (int u = blockIdx.x; u < 192; u += gridDim.x) {
        const int pass = u >> 6, mt = u & 63;
        const bf16_t* A = p.h2 + (size_t)mt * 256 * 2048 + (pass == 1 ? 1024 : 0);
        const bf16_t* Bt = p.wrT + (pass == 2 ? (size_t)NE * D : 0);
        f32x4 acc[4][8];
        __syncthreads();
        gemm4(smem, D, [&](int r) { return A + (size_t)r * 2048; }, [&](int n) { return Bt + (size_t)n * D; }, acc);
        char* wl = smem + wid * EPI_WAVE;
#pragma unroll
        for (int m = 0; m < 4; ++m) {
            float* dst = p.lgp + (size_t)pass * T * NE + (size_t)(mt * 256 + wr * 64 + m * 16) * NE + wc * 128;
            epi_f32(wl, lane, [&](int n, int j) { return acc[m][n][j]; },
                    [&](int row, int ch, f32x4 v) { *(f32x4*)(dst + (size_t)row * NE + ch * 4) = v; });
        }
    }
}

__device__ void ph_topk(const Params& p) {
    const int tid = otid(), lane = tid & 63, wid = tid >> 6;
    constexpr int TK = 4;
    for (int tok0 = (blockIdx.x * 8 + wid) * TK; tok0 < T; tok0 += gridDim.x * 8 * TK) {
        float sc[TK][4], bv[TK][4];
#pragma unroll
        for (int t = 0; t < TK; ++t)
#pragma unroll
            for (int j = 0; j < 4; ++j) {
                const int e = j * 64 + lane;
                const size_t o = (size_t)(tok0 + t) * NE + e;
                const float x = (p.lgp[o] + p.lgp[(size_t)T * NE + o]) + p.lgp[(size_t)2 * T * NE + o];
                sc[t][j] = 1.f / (1.f + expf(-x));
                bv[t][j] = sc[t][j] + p.router_bias[e];
            }
        float gsum[TK][4];
#pragma unroll
        for (int j = 0; j < 4; ++j) {
            float m1[TK], m2[TK];
#pragma unroll
            for (int t = 0; t < TK; ++t) m1[t] = bv[t][j];
#pragma unroll
            for (int o = 16; o > 0; o >>= 1)
#pragma unroll
                for (int t = 0; t < TK; ++t) m1[t] = fmaxf(m1[t], __shfl_xor(m1[t], o, 64));
#pragma unroll
            for (int t = 0; t < TK; ++t) {
                const unsigned long long bal = __ballot(bv[t][j] == m1[t]);
                const unsigned hm = (unsigned)(bal >> (lane & 32));
                const int first = __ffs(hm) - 1;
                m2[t] = ((lane & 31) == first) ? -INFINITY : bv[t][j];
            }
#pragma unroll
            for (int o = 16; o > 0; o >>= 1)
#pragma unroll
                for (int t = 0; t < TK; ++t) m2[t] = fmaxf(m2[t], __shfl_xor(m2[t], o, 64));
#pragma unroll
            for (int t = 0; t < TK; ++t) gsum[t][j] = m1[t] + m2[t];
        }
        float cand[TK][4];
#pragma unroll
        for (int t = 0; t < TK; ++t) {
            float gs[8];
#pragma unroll
            for (int j = 0; j < 4; ++j) { gs[2 * j] = __shfl(gsum[t][j], 0, 64); gs[2 * j + 1] = __shfl(gsum[t][j], 32, 64); }
            unsigned gmask = 0u;
#pragma unroll
            for (int r = 0; r < 4; ++r) {
                float best = -INFINITY; int bi = 0;
#pragma unroll
                for (int g = 0; g < 8; ++g) {
                    const bool ok = (((gmask >> g) & 1u) == 0u) && (gs[g] > best);
                    if (ok) { best = gs[g]; bi = g; }
                }
                gmask |= 1u << bi;
            }
#pragma unroll
            for (int j = 0; j < 4; ++j) cand[t][j] = ((gmask >> (2 * j + (lane >> 5))) & 1u) ? bv[t][j] : -INFINITY;
        }
        float wsum[TK], myw[TK];
        int mye[TK];
#pragma unroll
        for (int t = 0; t < TK; ++t) { wsum[t] = 0.f; myw[t] = 0.f; mye[t] = 0; }
#pragma unroll
        for (int r = 0; r < 8; ++r) {
            float bvv[TK]; int be[TK];
#pragma unroll
            for (int t = 0; t < TK; ++t) {
                bvv[t] = cand[t][0]; be[t] = lane;
#pragma unroll
                for (int j = 1; j < 4; ++j) if (cand[t][j] > bvv[t]) { bvv[t] = cand[t][j]; be[t] = j * 64 + lane; }
            }
#pragma unroll
            for (int o = 32; o > 0; o >>= 1)
#pragma unroll
                for (int t = 0; t < TK; ++t) {
                    const float ov = __shfl_xor(bvv[t], o, 64);
                    const int oe = __shfl_xor(be[t], o, 64);
                    if (ov > bvv[t] || (ov == bvv[t] && oe < be[t])) { bvv[t] = ov; be[t] = oe; }
                }
#pragma unroll
            for (int t = 0; t < TK; ++t) {
                const int bj = be[t] >> 6;
                const float mysc = bj == 0 ? sc[t][0] : (bj == 1 ? sc[t][1] : (bj == 2 ? sc[t][2] : sc[t][3]));
                const float sval = __shfl(mysc, be[t] & 63, 64);
#pragma unroll
                for (int j = 0; j < 4; ++j) if (be[t] == j * 64 + lane) cand[t][j] = -INFINITY;
                wsum[t] += sval;
                if (lane == r) { myw[t] = sval; mye[t] = be[t]; }
            }
        }
        if (lane < 8) {
#pragma unroll
            for (int t = 0; t < TK; ++t) {
                const int a = (tok0 + t) * 8 + lane;
                p.topi[a] = mye[t];
                p.topw[a] = myw[t] * (2.5f / wsum[t]);
            }
        }
    }
}

__device__ void ph_lists(const Params& p, char* smem) {
    const int tid = otid(), lane = tid & 63, wid = tid >> 6;
    int* wtot = (int*)smem;
    for (int e = blockIdx.x; e < NE; e += gridDim.x) {
        __syncthreads();
        const int4* src = (const int4*)p.topi + wid * 4096;
        int cntw = 0;
        for (int i = 0; i < 64; ++i) {
            const int4 v = src[i * 64 + lane];
            cntw += __popcll(__ballot(v.x == e)) + __popcll(__ballot(v.y == e)) + __popcll(__ballot(v.z == e)) + __popcll(__ballot(v.w == e));
        }
        if (lane == 0) wtot[wid] = cntw;
        __syncthreads();
        int base = 0, tot = 0;
        for (int w = 0; w < 8; ++w) { const int c = wtot[w]; if (w < wid) base += c; tot += c; }
        if (tid == 0) p.cnt[e] = tot;
        int* dst = p.list + (size_t)e * T;
        const unsigned long long lt = (1ull << lane) - 1ull;
        for (int i = 0; i < 64; ++i) {
            const int4 v = src[i * 64 + lane];
            const int a0 = (wid * 4096 + i * 64 + lane) * 4;
            unsigned long long m;
            m = __ballot(v.x == e); if (v.x == e) dst[base + __popcll(m & lt)] = a0;     base += __popcll(m);
            m = __ballot(v.y == e); if (v.y == e) dst[base + __popcll(m & lt)] = a0 + 1; base += __popcll(m);
            m = __ballot(v.z == e); if (v.z == e) dst[base + __popcll(m & lt)] = a0 + 2; base += __popcll(m);
            m = __ballot(v.w == e); if (v.w == e) dst[base + __popcll(m & lt)] = a0 + 3; base += __popcll(m);
        }
    }
}

struct ExpMap { int* cnt; int* off; int* tile; };
__device__ __forceinline__ ExpMap exp_map(const Params& p, char* smem) {
    ExpMap m;
    m.cnt = (int*)(smem + 73728); m.off = m.cnt + 256; m.tile = m.off + 256;
    const int tid = otid();
    __syncthreads();
    if (tid < NE) m.cnt[tid] = p.cnt[tid];
    __syncthreads();
    if (tid == 0) {
        int off = 0, tl = 0;
        for (int e = 0; e < NE; ++e) { m.off[e] = off; m.tile[e] = tl; const int c = m.cnt[e]; off += c; tl += (c + 255) >> 8; }
        m.tile[NE] = tl;
    }
    __syncthreads();
    return m;
}
__device__ __forceinline__ int find_expert(const int* tile, int rt) {
    int lo = 0, hi = NE;
    while (hi - lo > 1) { const int mid = (lo + hi) >> 1; if (tile[mid] <= rt) lo = mid; else hi = mid; }
    return lo;
}
#define ROWA(smem) ((int*)((smem) + 73728 + 3328))
#define ROWW(smem) ((float*)((smem) + 73728 + 3328 + 1024))

__device__ void ph_gateup(const Params& p, char* smem) {
    const int tid = otid(), lane = tid & 63, wid = tid >> 6, wr = wid >> 1, wc = wid & 1;
    const ExpMap em = exp_map(p, smem);
    int* rowA = ROWA(smem);
    const int ntile = em.tile[NE];
    const int U = (ntile + T / 256) * 2;
    const int xcd = blockIdx.x & 7, nbx = gridDim.x >> 3;
    const int lo = (int)(((long long)U * xcd) >> 3), hi = (int)(((long long)U * (xcd + 1)) >> 3);
    for (int u = lo + (blockIdx.x >> 3); u < hi; u += nbx) {
        const int rt = u >> 1, c0 = (u & 1) * 128;
        const float *Wg, *Wu;
        bf16_t* gdst;
        int nrow, tokv = -1;
        if (rt < ntile) {
            const int e = find_expert(em.tile, rt);
            const int r0 = (rt - em.tile[e]) * 256, ne = em.cnt[e];
            Wg = p.w_eg + (size_t)e * D * ED; Wu = p.w_eu + (size_t)e * D * ED;
            gdst = p.gbuf + ((size_t)em.off[e] + r0) * ED + c0;
            nrow = ne - r0;
            if (tid < 256 && r0 + tid < ne) tokv = p.list[(size_t)e * T + r0 + tid] >> 3;
        } else {
            const int tb = (rt - ntile) * 256;
            Wg = p.w_sg; Wu = p.w_su;
            gdst = p.gsh + (size_t)tb * ED + c0;
            nrow = 256;
            tokv = tb + (tid & 255);
        }
        __syncthreads();
        if (tid < 256) rowA[tid] = tokv;
        __syncthreads();
        const int t0 = rowA[0];
        f32x4 acc[4][8];
        gemm3<0>(smem, D,
                 [&](int r) { const int t = rowA[r]; return p.h2 + (size_t)(t < 0 ? t0 : t) * 2048; },
                 [&](int n) { const int t16 = n >> 4; return ((t16 & 1) ? Wu : Wg) + c0 + 16 * (t16 >> 1) + (n & 15); },
                 ED, acc, nrow);
        if (wr * 64 < nrow) {
            char* wl = smem + wid * EPI_WAVE;
#pragma unroll
            for (int m = 0; m < 4; ++m) {
                const int rb = wr * 64 + m * 16;
                epi_bf16(wl, lane,
                         [&](int n, int j) { if (n >= 4) return 0.f; const float g = acc[m][2 * n][j], uu = acc[m][2 * n + 1][j]; return g / (1.f + __expf(-g)) * uu; },
                         [&](int row, int ch, u32x4 v) { if (ch < 8 && rb + row < nrow) *(u32x4*)(gdst + (size_t)(rb + row) * ED + wc * 64 + ch * 8) = v; });
            }
        }
    }
}

__device__ void ph_down(const Params& p, char* smem) {
    const int tid = otid(), lane = tid & 63, wid = tid >> 6, wr = wid >> 1, wc = wid & 1;
    const ExpMap em = exp_map(p, smem);
    int* rowA = ROWA(smem);
    float* rowW = ROWW(smem);
    const int ntile = em.tile[NE];
    const int U = (ntile + T / 256) * 4;
    const int xcd = blockIdx.x & 7, nbx = gridDim.x >> 3;
    const int lo = (int)(((long long)U * xcd) >> 3), hi = (int)(((long long)U * (xcd + 1)) >> 3);
    for (int u = lo + (blockIdx.x >> 3); u < hi; u += nbx) {
        const int rt = u >> 2, nt = u & 3;
        const bf16_t* A;
        const float* W;
        int nrow, slot = -1;
        float wv = 0.f;
        if (rt < ntile) {
            const int e = find_expert(em.tile, rt);
            const int r0 = (rt - em.tile[e]) * 256, ne = em.cnt[e];
            A = p.gbuf + ((size_t)em.off[e] + r0) * ED;
            W = p.w_ed + (size_t)e * ED * D + nt * 256;
            nrow = ne - r0;
            if (tid < 256 && r0 + tid < ne) {
                const int a = p.list[(size_t)e * T + r0 + tid];
                slot = (a >> 3) * 9 + (a & 7);
                wv = p.topw[a];
            }
        } else {
            const int tb = (rt - ntile) * 256;
            A = p.gsh + (size_t)tb * ED;
            W = p.w_sd + nt * 256;
            nrow = 256;
            slot = (tb + (tid & 255)) * 9 + 8;
            wv = 1.f;
        }
        __syncthreads();
        if (tid < 256) { rowA[tid] = slot; rowW[tid] = wv; }
        __syncthreads();
        f32x4 acc[4][8];
        gemm3<0>(smem, ED, [&](int r) { return A + (size_t)(r < nrow ? r : 0) * ED; }, [&](int n) { return W + n; }, D, acc, nrow);
        if (wr * 64 < nrow) {
            char* wl = smem + wid * EPI_WAVE;
#pragma unroll
            for (int m = 0; m < 4; ++m) {
                const int rb = wr * 64 + m * 16;
                float wj[4];
#pragma unroll
                for (int j = 0; j < 4; ++j) wj[j] = rowW[rb + (lane >> 4) * 4 + j];
                epi_bf16(wl, lane, [&](int n, int j) { return acc[m][n][j] * wj[j]; },
                         [&](int row, int ch, u32x4 v) {
                             const int sl = rowA[rb + row];
                             if (sl >= 0) *(u32x4*)(p.ybuf + (size_t)sl * D + nt * 256 + wc * 128 + ch * 8) = v;
                         });
            }
        }
    }
}

__device__ void ph_final(const Params& p) {
    const int tid = otid(), lane = tid & 63, wid = tid >> 6;
    for (int row = blockIdx.x * 8 + wid; row < T; row += gridDim.x * 8) {
        const int b = row >> 12;
        const float* g2 = p.mod + b * 6144 + 5120;
        float4 v[4];
        float s = 0.f;
#pragma unroll
        for (int i = 0; i < 4; ++i) {
            const int col = (lane + 64 * i) * 4;
            float f0 = 0.f, f1 = 0.f, f2 = 0.f, f3 = 0.f;
#pragma unroll
            for (int k = 0; k < 9; ++k) {
                const uint2 w = *(const uint2*)(p.ybuf + ((size_t)row * 9 + k) * D + col);
                f0 += __uint_as_float(w.x << 16); f1 += __uint_as_float(w.x & 0xffff0000u);
                f2 += __uint_as_float(w.y << 16); f3 += __uint_as_float(w.y & 0xffff0000u);
            }
            const float4 xv = *(const float4*)(p.x1 + (size_t)row * D + col);
            const float4 g4 = *(const float4*)(g2 + col);
            v[i].x = ALPHA * xv.x + g4.x * f0; v[i].y = ALPHA * xv.y + g4.y * f1;
            v[i].z = ALPHA * xv.z + g4.z * f2; v[i].w = ALPHA * xv.w + g4.w * f3;
            s += v[i].x + v[i].y + v[i].z + v[i].w;
        }
        const float mean = wave_sum(s) * (1.f / D);
        float q = 0.f;
#pragma unroll
        for (int i = 0; i < 4; ++i) {
            v[i].x -= mean; v[i].y -= mean; v[i].z -= mean; v[i].w -= mean;
            q += v[i].x * v[i].x + v[i].y * v[i].y + v[i].z * v[i].z + v[i].w * v[i].w;
        }
        const float rstd = rsqrtf(wave_sum(q) * (1.f / D) + LN_EPS);
#pragma unroll
        for (int i = 0; i < 4; ++i) {
            const int col = (lane + 64 * i) * 4;
            const float4 g4 = *(const float4*)(p.ln2_g + col), b4 = *(const float4*)(p.ln2_b + col);
            float4 y;
            y.x = v[i].x * rstd * g4.x + b4.x; y.y = v[i].y * rstd * g4.y + b4.y;
            y.z = v[i].z * rstd * g4.z + b4.z; y.w = v[i].w * rstd * g4.w + b4.w;
            *(float4*)(p.out + (size_t)row * D + col) = y;
        }
    }
}

constexpr int LDS_BYTES = 2 * VB_LDS + 16;
constexpr int NPHASE = 14;

template <int PH>
__device__ __forceinline__ void run_phase(const Params& p, char* smem) {
    if (PH == 0) ph_mod(p, smem);
    if (PH == 1) ph_ln0(p);
    if (PH == 2) ph_inproj(p, smem);
    if (PH == 3) { ph_h1(p, smem); ph_attn(p, smem); }
    if (PH == 4) { ph_h2(p); ph_attn_merge(p); }
    if (PH == 5) ph_h3(p, smem);
    if (PH == 6) ph_outproj(p, smem);
    if (PH == 7) ph_ln1(p);
    if (PH == 8) ph_router_gemm(p, smem);
    if (PH == 9) ph_topk(p);
    if (PH == 10) ph_lists(p, smem);
    if (PH == 11) ph_gateup(p, smem);
    if (PH == 12) ph_down(p, smem);
    if (PH == 13) ph_final(p);
}

template <int PH>
__global__ void __launch_bounds__(NTHREADS, 2) k_phase(Params p) {
    extern __shared__ __attribute__((aligned(16))) char smem[];
    run_phase<PH>(p, smem);
}

__global__ void __launch_bounds__(NTHREADS, 2) k_all(Params p) {
    extern __shared__ __attribute__((aligned(16))) char smem[];
    volatile LAS unsigned* st = (volatile LAS unsigned*)(smem + LDS_BYTES - 16);
    if (threadIdx.x == 0) { st[0] = 0u; st[1] = 0u; st[2] = 0u; st[3] = 0u; }
    __syncthreads();
    XcdBarrier bar = xcd_barrier_post(p.bar, st);
    run_phase<0>(p, smem); xcd_barrier(bar);
    run_phase<1>(p, smem); xcd_barrier(bar);
    run_phase<2>(p, smem); xcd_barrier(bar);
    run_phase<3>(p, smem); xcd_barrier(bar);
    run_phase<4>(p, smem); xcd_barrier(bar);
    run_phase<5>(p, smem); xcd_barrier(bar);
    run_phase<6>(p, smem); xcd_barrier(bar);
    run_phase<7>(p, smem); xcd_barrier(bar);
    run_phase<8>(p, smem); xcd_barrier(bar);
    run_phase<9>(p, smem); xcd_barrier(bar);
    run_phase<10>(p, smem); xcd_barrier(bar);
    run_phase<11>(p, smem); xcd_barrier(bar);
    run_phase<12>(p, smem); xcd_barrier(bar);
    run_phase<13>(p, smem);
}

template <int PH>
static void launch_phase(const Params& p, int grid, hipStream_t stream) {
    static bool attr = false;
    if (!attr) { (void)hipFuncSetAttribute((const void*)k_phase<PH>, hipFuncAttributeMaxDynamicSharedMemorySize, LDS_BYTES); attr = true; }
    hipLaunchKernelGGL(k_phase<PH>, dim3(grid), dim3(NTHREADS), LDS_BYTES, stream, p);
}

extern "C" void kernel_launch(void* const* d_in, const int* in_sizes, int n_in, void* d_out, int out_size, void* d_ws, size_t ws_size,
                              hipStream_t stream) {
    (void)in_sizes; (void)n_in; (void)out_size;
    Params p{};
    const float** pin = (const float**)&p.x;
    for (int i = 0; i < 21; ++i) pin[i] = (const float*)d_in[i];
    p.out = (float*)d_out;
    char* ws = (char*)d_ws;
    size_t off = 0;
    auto carve = [&](size_t bytes) { char* r = ws + off; off += (bytes + 255) & ~(size_t)255; return r; };
    char* ctl = carve(65536);
    p.bar = (unsigned*)ctl;
    p.cnt = (int*)(ctl + 16384);
    p.mod = (float*)carve(4 * 6144 * 4);
    p.lbv = (float*)carve(512 * 4);
    p.biasT = (float*)carve(3 * 129 * 4 * 4);
    p.winT = (bf16_t*)carve((size_t)INW * D * 2);
    p.woutT = (bf16_t*)carve((size_t)D * 768 * 2);
    p.wrT = (bf16_t*)carve((size_t)2 * NE * D * 2);
    p.wsgT = (bf16_t*)carve((size_t)ED * D * 2);
    p.wsuT = (bf16_t*)carve((size_t)ED * D * 2);
    p.wsdT = (bf16_t*)carve((size_t)D * ED * 2);
    p.h1 = (bf16_t*)carve((size_t)T * D * 2);
    p.proj = (bf16_t*)carve((size_t)T * INW * 2);
    p.lgf = (float*)carve((size_t)T * 512 * 4);
    p.ao = (float*)carve((size_t)3 * T * 256 * 4);
    p.alse = (float*)carve((size_t)3 * T * 4 * 4);
    p.mixin = (bf16_t*)carve((size_t)T * 768 * 2);
    p.pre1 = (float*)carve((size_t)T * D * 4);
    p.x1 = (float*)carve((size_t)T * D * 4);
    p.h2 = (bf16_t*)carve((size_t)T * 2048 * 2);
    p.lgp = (float*)carve((size_t)3 * T * NE * 4);
    p.topi = (int*)carve((size_t)T * 8 * 4);
    p.topw = (float*)carve((size_t)T * 8 * 4);
    p.list = (int*)carve((size_t)NE * T * 4);
    p.gbuf = (bf16_t*)carve((size_t)T * TOPK * ED * 2);
    p.gsh = (bf16_t*)carve((size_t)T * ED * 2);
    p.ybuf = (bf16_t*)carve((size_t)T * 9 * D * 2);
    p.kv = (float*)p.ybuf;
    p.sst = (bf16_t*)((char*)p.ybuf + (size_t)1024 * 16384 * 4);
    p.dec = (float*)carve((size_t)1024 * 128 * 4);
    if (off > ws_size) { fprintf(stderr, "kernel_launch: workspace too small: need %zu have %zu\n", off, ws_size); return; }

    static int grid = 0;
    if (grid == 0) {
        int dev = 0, cus = 0, per_cu = 0;
        (void)hipGetDevice(&dev);
        (void)hipDeviceGetAttribute(&cus, hipDeviceAttributeMultiprocessorCount, dev);
        (void)hipFuncSetAttribute((const void*)k_all, hipFuncAttributeMaxDynamicSharedMemorySize, LDS_BYTES);
        (void)hipOccupancyMaxActiveBlocksPerMultiprocessor(&per_cu, (const void*)k_all, NTHREADS, LDS_BYTES);
        grid = cus;
        if (grid != 256) grid = 256;
        fprintf(stderr, "kernel_launch: cus %d per_cu %d grid %d ws need %zu have %zu\n", cus, per_cu, grid, off, ws_size);
    }
    (void)hipMemsetAsync(ctl, 0, 65536, stream);
#if ONE_LAUNCH
    hipLaunchKernelGGL(k_all, dim3(grid), dim3(NTHREADS), LDS_BYTES, stream, p);
#else
    launch_phase<0>(p, grid, stream); launch_phase<1>(p, grid, stream); launch_phase<2>(p, grid, stream); launch_phase<3>(p, grid, stream);
    launch_phase<4>(p, grid, stream); launch_phase<5>(p, grid, stream); launch_phase<6>(p, grid, stream); launch_phase<7>(p, grid, stream);
    launch_phase<8>(p, grid, stream); launch_phase<9>(p, grid, stream); launch_phase<10>(p, grid, stream); launch_phase<11>(p, grid, stream);
    launch_phase<12>(p, grid, stream); launch_phase<13>(p, grid, stream);
#endif
}
```

```cpp
#include <hip/hip_runtime.h>
#include <stdint.h>
#include <stdio.h>

#ifndef ONE_LAUNCH
#define ONE_LAUNCH 1
#endif

constexpr int D = 1024, NBATCH = 4, S = 4096, T = NBATCH * S;
constexpr int INW = 4352;
constexpr int NE = 256, TOPK = 8, ED = 256;
constexpr int OFF_HQ = 0, OFF_HF = 512, OFF_HI = 1024, OFF_HG = 1536, OFF_AQ = 2048, OFF_AK = 2816, OFF_AV = 3584;
constexpr float ALPHA = 1.189207115002721f;
constexpr float LN_EPS = 1e-5f, RMS_EPS = 1e-6f;
constexpr int NTHREADS = 512;
constexpr int VB_LDS = 67584;

typedef unsigned short bf16_t;
using bf16x8 = __attribute__((ext_vector_type(8))) short;
using f32x4 = __attribute__((ext_vector_type(4))) float;
using u32x4 = __attribute__((ext_vector_type(4))) unsigned int;

typedef float v2f_t __attribute__((ext_vector_type(2)));
typedef __bf16 v2bf_t __attribute__((ext_vector_type(2)));
typedef short v4s __attribute__((ext_vector_type(4)));
__device__ __forceinline__ unsigned short f2bf(float f) { return __builtin_bit_cast(unsigned short, (__bf16)f); }
__device__ __forceinline__ float bf2f(unsigned short h) { return __uint_as_float(((uint32_t)h) << 16); }
__device__ __forceinline__ uint32_t pack2(float a, float b) {
    const v2f_t f = {a, b};
    return __builtin_bit_cast(uint32_t, __builtin_convertvector(f, v2bf_t));
}
__device__ __forceinline__ float sigmoidf_(float v) { return 1.f / (1.f + __expf(-v)); }

__device__ __forceinline__ int otid() { int t = threadIdx.x; asm volatile("" : "+v"(t)); return t; }

constexpr size_t al256(size_t x) { return (x + 255) & ~(size_t)255; }
constexpr size_t WO_ctl = 0;
constexpr size_t WO_mod = WO_ctl + al256(65536);
constexpr size_t WO_lbv = WO_mod + al256(4 * 6144 * 4);
constexpr size_t WO_biasT = WO_lbv + al256(512 * 4);
constexpr size_t WO_winT = WO_biasT + al256(3 * 129 * 4 * 4);
constexpr size_t WO_woutT = WO_winT + al256((size_t)INW * D * 2);
constexpr size_t WO_wrT = WO_woutT + al256((size_t)D * 768 * 2);
constexpr size_t WO_wsgT = WO_wrT + al256((size_t)2 * NE * D * 2);
constexpr size_t WO_wsuT = WO_wsgT + al256((size_t)ED * D * 2);
constexpr size_t WO_wsdT = WO_wsuT + al256((size_t)ED * D * 2);
constexpr size_t WO_h1 = WO_wsdT + al256((size_t)D * ED * 2);
constexpr size_t WO_proj = WO_h1 + al256((size_t)T * D * 2);
constexpr size_t WO_lgf = WO_proj + al256((size_t)T * INW * 2);
constexpr size_t WO_ao = WO_lgf + al256((size_t)T * 512 * 4);
constexpr size_t WO_alse = WO_ao + al256((size_t)3 * T * 256 * 4);
constexpr size_t WO_mixin = WO_alse + al256((size_t)3 * T * 4 * 4);
constexpr size_t WO_pre1 = WO_mixin + al256((size_t)T * 768 * 2);
constexpr size_t WO_x1 = WO_pre1 + al256((size_t)T * D * 4);
constexpr size_t WO_h2 = WO_x1 + al256((size_t)T * D * 2);
constexpr size_t WO_lgp = WO_h2 + al256((size_t)T * 2048 * 2);
constexpr size_t WO_topi = WO_lgp + al256((size_t)3 * T * NE * 4);
constexpr size_t WO_topw = WO_topi + al256((size_t)T * 8 * 4);
constexpr size_t WO_list = WO_topw + al256((size_t)T * 8 * 4);
constexpr size_t WO_gbuf = WO_list + al256((size_t)NE * T * 4);
constexpr size_t WO_gsh = WO_gbuf + al256((size_t)T * TOPK * ED * 2);
constexpr size_t WO_ybuf = WO_gsh + al256((size_t)T * ED * 2);
constexpr size_t WO_dec = WO_ybuf + al256((size_t)T * 9 * D * 2);
constexpr size_t WS_END = WO_dec + al256((size_t)1024 * 128 * 4);
struct Params {
    const float *x, *c, *w_ada, *b_ada, *w_in, *hg_lb, *hg_nw, *rel_bias, *w_out, *ln1_g, *ln1_b, *w_router, *router_bias,
        *w_eg, *w_eu, *w_ed, *w_sg, *w_su, *w_sd, *ln2_g, *ln2_b;
    float* out;
    char* ws;
    __device__ __forceinline__ unsigned* bar() const { return (unsigned*)(ws + WO_ctl); }
    __device__ __forceinline__ int* cnt() const { return (int*)(ws + WO_ctl + 16384); }
    __device__ __forceinline__ float* kv() const { return (float*)(ws + WO_ybuf); }
    __device__ __forceinline__ bf16_t* sst() const { return (bf16_t*)(ws + WO_ybuf + (size_t)1024 * 16384 * 4); }
    __device__ __forceinline__ float* mod() const { return (float*)(ws + WO_mod); }
    __device__ __forceinline__ float* lbv() const { return (float*)(ws + WO_lbv); }
    __device__ __forceinline__ float* biasT() const { return (float*)(ws + WO_biasT); }
    __device__ __forceinline__ bf16_t* winT() const { return (bf16_t*)(ws + WO_winT); }
    __device__ __forceinline__ bf16_t* woutT() const { return (bf16_t*)(ws + WO_woutT); }
    __device__ __forceinline__ bf16_t* wrT() const { return (bf16_t*)(ws + WO_wrT); }
    __device__ __forceinline__ bf16_t* wsgT() const { return (bf16_t*)(ws + WO_wsgT); }
    __device__ __forceinline__ bf16_t* wsuT() const { return (bf16_t*)(ws + WO_wsuT); }
    __device__ __forceinline__ bf16_t* wsdT() const { return (bf16_t*)(ws + WO_wsdT); }
    __device__ __forceinline__ bf16_t* h1() const { return (bf16_t*)(ws + WO_h1); }
    __device__ __forceinline__ bf16_t* proj() const { return (bf16_t*)(ws + WO_proj); }
    __device__ __forceinline__ float* lgf() const { return (float*)(ws + WO_lgf); }
    __device__ __forceinline__ float* ao() const { return (float*)(ws + WO_ao); }
    __device__ __forceinline__ float* alse() const { return (float*)(ws + WO_alse); }
    __device__ __forceinline__ bf16_t* mixin() const { return (bf16_t*)(ws + WO_mixin); }
    __device__ __forceinline__ float* pre1() const { return (float*)(ws + WO_pre1); }
    __device__ __forceinline__ bf16_t* x1() const { return (bf16_t*)(ws + WO_x1); }
    __device__ __forceinline__ bf16_t* h2() const { return (bf16_t*)(ws + WO_h2); }
    __device__ __forceinline__ float* lgp() const { return (float*)(ws + WO_lgp); }
    __device__ __forceinline__ int* topi() const { return (int*)(ws + WO_topi); }
    __device__ __forceinline__ float* topw() const { return (float*)(ws + WO_topw); }
    __device__ __forceinline__ int* list() const { return (int*)(ws + WO_list); }
    __device__ __forceinline__ bf16_t* gbuf() const { return (bf16_t*)(ws + WO_gbuf); }
    __device__ __forceinline__ bf16_t* gsh() const { return (bf16_t*)(ws + WO_gsh); }
    __device__ __forceinline__ bf16_t* ybuf() const { return (bf16_t*)(ws + WO_ybuf); }
    __device__ __forceinline__ float* dec() const { return (float*)(ws + WO_dec); }
};

#define XB_TMO      128
#define XB_XCNT(j)  (256  + 64 * (j))
#define XB_XSUB(j)  (1280 + 64 * (j))
#define XB_XGEN(j)  (2304 + 64 * (j))
#define XB_TOP      3328
#define XB_TOPGEN   3392
#define XCD_BAR_WORDS 3456
#define XB_SPIN_CAP (1u << 18)
#define LAS __attribute__((address_space(3)))

__device__ __forceinline__ unsigned xb_ld(unsigned* p)              { return __hip_atomic_load(p, __ATOMIC_RELAXED, __HIP_MEMORY_SCOPE_AGENT); }
__device__ __forceinline__ unsigned xb_add(unsigned* p, unsigned v) { return __hip_atomic_fetch_add(p, v, __ATOMIC_RELAXED, __HIP_MEMORY_SCOPE_AGENT); }
__device__ __forceinline__ unsigned xb_xcc_id() { return (unsigned)__builtin_amdgcn_s_getreg((3 << 11) | 20) & 0xFu; }
#define XB_SPIN(cond, bar) do { unsigned _sp = 0; while (cond) { __builtin_amdgcn_s_sleep(1); \
    if ((++_sp & 255u) == 0u) { if (xb_ld(&(bar)[XB_TMO])) break; if (_sp > XB_SPIN_CAP) { atomicAdd(&(bar)[XB_TMO], 1u); break; } } } } while (0)

struct XcdBarrier {
    unsigned* bar; unsigned x;
    volatile LAS unsigned* st;
};
__device__ __forceinline__ XcdBarrier xcd_barrier_post(unsigned* bar, volatile LAS unsigned* st) {
    XcdBarrier b; b.bar = bar; b.x = xb_xcc_id(); b.st = st;
    if (threadIdx.x == 0) (void)xb_add(&bar[XB_XCNT(b.x)], 1u);
    return b;
}
__device__ __forceinline__ void xcd_barrier_complete(unsigned* bar, unsigned x, unsigned& nloc, unsigned& nx) {
    const unsigned G = gridDim.x * gridDim.y * gridDim.z;
    unsigned sum, cnt, mine, sp = 0u;
    for (;;) {
        sum = 0u; cnt = 0u; mine = 0u;
#pragma unroll
        for (unsigned j = 0; j < 16; ++j) { const unsigned c = xb_ld(&bar[XB_XCNT(j)]); sum += c; cnt += (c > 0u) ? 1u : 0u; mine = (j == x) ? c : mine; }
        if (sum == G) break;
        __builtin_amdgcn_s_sleep(1);
        if ((++sp & 255u) == 0u) { if (xb_ld(&bar[XB_TMO])) break; if (sp > XB_SPIN_CAP) { atomicAdd(&bar[XB_TMO], 1u); break; } }
    }
    nloc = mine > 0u ? mine : 1u; nx = cnt > 0u ? cnt : 1u;
}
__device__ __forceinline__ void xcd_barrier(const XcdBarrier& b) {
    asm volatile("s_waitcnt vmcnt(0)" ::: "memory");
    __syncthreads();
    if (threadIdx.x == 0) {
        unsigned* bar = b.bar;
        __builtin_amdgcn_s_waitcnt(0);
        unsigned nloc = b.st[0], nx = b.st[1];
        if (nloc == 0u) { xcd_barrier_complete(bar, b.x, nloc, nx); b.st[0] = nloc; b.st[1] = nx; }
        const unsigned old = xb_add(&bar[XB_XSUB(b.x)], 1u);
        const unsigned gen = old / nloc;
        if (old + 1u == (gen + 1u) * nloc) {
            __builtin_amdgcn_fence(__ATOMIC_RELEASE, "agent");
            asm volatile("s_waitcnt vmcnt(0)" ::: "memory");
            const unsigned og = xb_add(&bar[XB_TOP], 1u);
            const unsigned tg = og / nx;
            if (og + 1u == (tg + 1u) * nx) xb_add(&bar[XB_TOPGEN], 1u);
            else XB_SPIN(xb_ld(&bar[XB_TOPGEN]) == tg, bar);
            __builtin_amdgcn_fence(__ATOMIC_ACQUIRE, "agent");
            xb_add(&bar[XB_XGEN(b.x)], 1u);
            asm volatile("s_waitcnt vmcnt(0)" ::: "memory");
        } else {
            XB_SPIN(xb_ld(&bar[XB_XGEN(b.x)]) == gen, bar);
            __builtin_amdgcn_fence(__ATOMIC_ACQUIRE, "agent");
            asm volatile("s_waitcnt vmcnt(0)" ::: "memory");
        }
    }
    __syncthreads();
}

struct VB { int vb, nvb, tid; char* smem; };
__device__ __forceinline__ VB make_vb(char* smem) {
    const int t = otid();
    VB v; v.vb = (int)blockIdx.x * 2 + (t >> 8); v.nvb = (int)gridDim.x * 2; v.tid = t & 255; v.smem = smem + (t >> 8) * VB_LDS;
    return v;
}
__device__ __forceinline__ int swz(int row, int chunk) { return row * 128 + ((chunk ^ ((row >> 1) & 7)) << 4); }

__device__ __forceinline__ float wave_sum(float v) {
#pragma unroll
    for (int o = 32; o > 0; o >>= 1) v += __shfl_xor(v, o, 64);
    return v;
}

__device__ __forceinline__ int t5_bucket(int n) {
    if (n < 16) return n;
    const float v = logf((float)n / 16.f) / logf(128.f) * 16.f;
    int large = 16 + (int)v;
    return large < 31 ? large : 31;
}

__device__ __forceinline__ void tr_tile(const VB& v, const float* src, int ld, bf16_t* dst, bf16_t* dst2, int ldd, int k0, int n0) {
    float* t = (float*)v.smem;
    __syncthreads();
#pragma unroll
    for (int i = 0; i < 4; ++i) {
        const int r = (v.tid >> 4) + 16 * i, c4 = v.tid & 15;
        const f32x4 x = *(const f32x4*)(src + (size_t)(k0 + r) * ld + n0 + c4 * 4);
        t[r * 65 + c4 * 4 + 0] = x[0]; t[r * 65 + c4 * 4 + 1] = x[1]; t[r * 65 + c4 * 4 + 2] = x[2]; t[r * 65 + c4 * 4 + 3] = x[3];
    }
    __syncthreads();
    const int n = v.tid >> 2, kq = v.tid & 3;
    float f[16];
#pragma unroll
    for (int i = 0; i < 16; ++i) f[i] = t[(kq * 16 + i) * 65 + n];
    u32x4 a, b;
    a[0] = pack2(f[0], f[1]); a[1] = pack2(f[2], f[3]); a[2] = pack2(f[4], f[5]); a[3] = pack2(f[6], f[7]);
    b[0] = pack2(f[8], f[9]); b[1] = pack2(f[10], f[11]); b[2] = pack2(f[12], f[13]); b[3] = pack2(f[14], f[15]);
    bf16_t* d = dst + (size_t)(n0 + n) * ldd + k0 + kq * 16;
    *(u32x4*)d = a; *(u32x4*)(d + 8) = b;
    if (dst2) {
        u32x4 c, e;
#pragma unroll
        for (int i = 0; i < 4; ++i) {
            c[i] = pack2(f[2 * i] - __uint_as_float(a[i] << 16), f[2 * i + 1] - __uint_as_float(a[i] & 0xffff0000u));
            e[i] = pack2(f[8 + 2 * i] - __uint_as_float(b[i] << 16), f[8 + 2 * i + 1] - __uint_as_float(b[i] & 0xffff0000u));
        }
        bf16_t* d2 = dst2 + (size_t)(n0 + n) * ldd + k0 + kq * 16;
        *(u32x4*)d2 = c; *(u32x4*)(d2 + 8) = e;
    }
}

__device__ void ph_mod(const Params& p, char* smem0) {
    const VB v = make_vb(smem0);
    const int tid = v.tid;
    float* cond = (float*)(v.smem + 20480);
    float* red = cond + 4096;
    for (int i = tid; i < 4096; i += 256) { const float x = p.c[i]; cond[i] = x / (1.f + __expf(-x)); }
    __syncthreads();
    const int NU = 194 + 1088 + 192 + 64 + 64 + 64 + 64;
    const int rounds = (NU + v.nvb - 1) / v.nvb;
    for (int it = 0; it < rounds; ++it) {
        int u = v.vb + it * v.nvb;
        if (u >= NU) u = NU - 1;
        if (u < 192) {
            const int c4 = tid & 7, kq = tid >> 3;
            f32x4 a0 = {0.f, 0.f, 0.f, 0.f}, a1 = a0, a2 = a0, a3 = a0;
            const float* wp = p.w_ada + u * 32 + c4 * 4;
#pragma unroll 8
            for (int k = kq; k < 1024; k += 32) {
                const f32x4 w = *(const f32x4*)(wp + (size_t)k * 6144);
                a0 += cond[k] * w; a1 += cond[1024 + k] * w; a2 += cond[2048 + k] * w; a3 += cond[3072 + k] * w;
            }
            *(f32x4*)(red + (kq * 4 + 0) * 32 + c4 * 4) = a0; *(f32x4*)(red + (kq * 4 + 1) * 32 + c4 * 4) = a1;
            *(f32x4*)(red + (kq * 4 + 2) * 32 + c4 * 4) = a2; *(f32x4*)(red + (kq * 4 + 3) * 32 + c4 * 4) = a3;
        }
        __syncthreads();
        if (u < 192) {
            if (tid < 128) {
                const int b = tid >> 5, c2 = tid & 31;
                float s = 0.f;
                for (int q = 0; q < 32; ++q) s += red[(q * 4 + b) * 32 + c2];
                p.mod()[b * 6144 + u * 32 + c2] = s + p.b_ada[u * 32 + c2];
            }
        } else if (u == 192) {
            for (int j = tid; j < 512; j += 256) {
                const float a = p.hg_lb[j], b = p.hg_lb[512 + j];
                const float m = fmaxf(a, b);
                const float ea = expf(a - m), eb = expf(b - m);
                p.lbv()[j] = ea / (ea + eb);
            }
        } else if (u == 193) {
            for (int i = tid; i < 3 * 129 * 4; i += 256) {
                const int g = i / (129 * 4), m = (i >> 2) % 129, hh = i & 3;
                const int dil = (g == 0) ? 1 : (g == 1 ? 4 : 16);
                p.biasT()[i] = p.rel_bias[t5_bucket(m * dil) * 12 + g * 4 + hh];
            }
        }
        {
            int w = u - 194;
            const float* src = p.w_out; int ld = D; bf16_t* dst = p.woutT(); bf16_t* dst2 = nullptr; int ldd = 768, k0 = 0, n0 = 0;
            if (w >= 0) {
                if (w < 1088) { src = p.w_in; ld = INW; dst = p.winT(); ldd = D; k0 = (w / 68) * 64; n0 = (w % 68) * 64; }
                else if ((w -= 1088) < 192) { k0 = (w >> 4) * 64; n0 = (w & 15) * 64; }
                else if ((w -= 192) < 64) { src = p.w_router; ld = NE; dst = p.wrT(); dst2 = p.wrT() + (size_t)NE * D; ldd = D; k0 = (w >> 2) * 64; n0 = (w & 3) * 64; }
                else if ((w -= 64) < 64) { src = p.w_sg; ld = ED; dst = p.wsgT(); ldd = D; k0 = (w >> 2) * 64; n0 = (w & 3) * 64; }
                else if ((w -= 64) < 64) { src = p.w_su; ld = ED; dst = p.wsuT(); ldd = D; k0 = (w >> 2) * 64; n0 = (w & 3) * 64; }
                else { w -= 64; src = p.w_sd; ld = D; dst = p.wsdT(); ldd = ED; k0 = (w >> 4) * 64; n0 = (w & 15) * 64; }
            }
            tr_tile(v, src, ld, dst, dst2, ldd, k0, n0);
        }
    }
}

__device__ void ph_ln0(const Params& p) {
    const int tid = otid(), lane = tid & 63, wid = tid >> 6;
    for (int row = blockIdx.x * 8 + wid; row < T; row += gridDim.x * 8) {
        const float4* xr = (const float4*)(p.x + (size_t)row * D);
        float4 v[4];
        float s = 0.f;
#pragma unroll
        for (int i = 0; i < 4; ++i) { v[i] = xr[lane + 64 * i]; s += v[i].x + v[i].y + v[i].z + v[i].w; }
        const float mean = wave_sum(s) * (1.f / D);
        float q = 0.f;
#pragma unroll
        for (int i = 0; i < 4; ++i) {
            v[i].x -= mean; v[i].y -= mean; v[i].z -= mean; v[i].w -= mean;
            q += v[i].x * v[i].x + v[i].y * v[i].y + v[i].z * v[i].z + v[i].w * v[i].w;
        }
        const float rstd = rsqrtf(wave_sum(q) * (1.f / D) + LN_EPS);
        const int b = row >> 12;
        const float* sh = p.mod() + b * 6144;
        const float* sc = sh + 1024;
#pragma unroll
        for (int i = 0; i < 4; ++i) {
            const int col = (lane + 64 * i) * 4;
            const float4 s4 = *(const float4*)(sc + col), h4 = *(const float4*)(sh + col);
            uint2 o;
            o.x = pack2(v[i].x * rstd * (1.f + s4.x) + h4.x, v[i].y * rstd * (1.f + s4.y) + h4.y);
            o.y = pack2(v[i].z * rstd * (1.f + s4.z) + h4.z, v[i].w * rstd * (1.f + s4.w) + h4.w);
            *(uint2*)(p.h1() + (size_t)row * D + col) = o;
        }
    }
}

__device__ __forceinline__ int swz16(int row, int chunk) { return row * 256 + ((chunk ^ (row & 15)) << 4); }
struct TrBase { int lo, hi; };
__device__ __forceinline__ TrBase tr16_base(int lane) {
    const int g = lane >> 4, q = (lane & 15) >> 2, pp = lane & 3;
    const int xl = 8 * (g & 1) + q, h = pp >> 1;
    TrBase t;
    t.lo = (8 * g + q) * 256 + ((xl >> 1) << 5) + ((h ^ (xl & 1)) << 4) + 8 * (pp & 1);
    t.hi = (t.lo + 1024) ^ 64;
    return t;
}
__device__ __forceinline__ bf16x8 tr_frag16(const char* tile, const TrBase& tb, int ks, int c) {
    int cx = c << 5;
    asm volatile("" : "+v"(cx));
    const v4s lo = __builtin_amdgcn_ds_read_tr16_b64_v4i16((LAS v4s*)(tile + ks * 8192 + (tb.lo ^ cx)));
    const v4s hi = __builtin_amdgcn_ds_read_tr16_b64_v4i16((LAS v4s*)(tile + ks * 8192 + (tb.hi ^ cx)));
    return bf16x8{lo[0], lo[1], lo[2], lo[3], hi[0], hi[1], hi[2], hi[3]};
}


__device__ __forceinline__ int aoff(int row, int chunk) { return row * 64 + ((chunk ^ ((row >> 2) & 3)) << 4); }
__device__ __forceinline__ int boff(int row, int chunk) { return row * 512 + ((chunk ^ (((row & 3) << 1) | (((row >> 3) & 1) << 3))) << 4); }
__device__ __forceinline__ bf16x8 tr_pair(const char* p) {
    const v4s lo = __builtin_amdgcn_ds_read_tr16_b64_v4i16((LAS v4s*)(p));
    const v4s hi = __builtin_amdgcn_ds_read_tr16_b64_v4i16((LAS v4s*)(p + 2048));
    return bf16x8{lo[0], lo[1], lo[2], lo[3], hi[0], hi[1], hi[2], hi[3]};
}
constexpr int G3_STAGE = 32768;

template <int BMODE, class AF, class BF>
__device__ __forceinline__ void gemm3(char* smem, const int K, AF arow, BF bsrc, const int ldb, f32x4 (&acc)[4][8], const int nvalid = 256) {
    const int tid = otid(), lane = tid & 63, wid = tid >> 6, wr = wid >> 1, wc = wid & 1, fr = lane & 15, fq = lane >> 4;
    const bf16_t* ap[2];
#pragma unroll
    for (int i = 0; i < 2; ++i) ap[i] = arow((tid >> 2) + 128 * i) + (tid & 3) * 8;
    const float* bpf = nullptr;
    const bf16_t* bpb[2] = {nullptr, nullptr};
    if (BMODE == 0) bpf = (const float*)bsrc((tid & 63) * 4) + (size_t)(tid >> 6) * ldb;
    else {
#pragma unroll
        for (int i = 0; i < 2; ++i) bpb[i] = (const bf16_t*)bsrc((tid >> 2) + 128 * i) + (tid & 3) * 8;
    }
#pragma unroll
    for (int m = 0; m < 4; ++m)
#pragma unroll
        for (int n = 0; n < 8; ++n) acc[m][n] = f32x4{0.f, 0.f, 0.f, 0.f};
    const int trbase = (8 * fq + (fr >> 2)) * 512 + wc * 256 + (((fr >> 2) | ((fq & 1) << 2)) << 5) + ((fr & 3) >> 1) * 16 + (fr & 1) * 8;
    u32x4 ra0[2], ra1[2];
    f32x4 rf0[4], rf1[4];
    u32x4 rb0[2], rb1[2];
    const bool active = wr * 64 < nvalid;
#define G3_GLOAD(RA, RF, RB, k0) do { \
        _Pragma("unroll") for (int i = 0; i < 2; ++i) RA[i] = *(const u32x4*)(ap[i] + (k0)); \
        if (BMODE == 0) { _Pragma("unroll") for (int j = 0; j < 4; ++j) RF[j] = *(const f32x4*)(bpf + (size_t)((k0) + 8 * j) * ldb); } \
        else { _Pragma("unroll") for (int i = 0; i < 2; ++i) RB[i] = *(const u32x4*)(bpb[i] + (k0)); } } while (0)
#define G3_LWRITE(RA, RF, RB, st) do { \
        char* sA_ = (st); char* sB_ = (st) + 16384; \
        _Pragma("unroll") for (int i = 0; i < 2; ++i) *(u32x4*)(sA_ + aoff((tid >> 2) + 128 * i, tid & 3)) = RA[i]; \
        if (BMODE == 0) { _Pragma("unroll") for (int j = 0; j < 4; ++j) { uint2 w_; w_.x = pack2(RF[j][0], RF[j][1]); w_.y = pack2(RF[j][2], RF[j][3]); \
                *(uint2*)(sB_ + boff((tid >> 6) + 8 * j, (tid & 63) >> 1) + (tid & 1) * 8) = w_; } } \
        else { _Pragma("unroll") for (int i = 0; i < 2; ++i) *(u32x4*)(sB_ + aoff((tid >> 2) + 128 * i, tid & 3)) = RB[i]; } } while (0)
#define G3_COMPUTE(st) do { if (active) { \
        const char* sA_ = (st); const char* sB_ = (st) + 16384; \
        bf16x8 af[4]; \
        _Pragma("unroll") for (int m = 0; m < 4; ++m) af[m] = *(const bf16x8*)(sA_ + aoff(wr * 64 + m * 16 + fr, fq)); \
        _Pragma("unroll") for (int n = 0; n < 8; ++n) { \
            bf16x8 bfr; \
            if (BMODE == 0) bfr = tr_pair(sB_ + (trbase ^ (n << 5))); else bfr = *(const bf16x8*)(sB_ + aoff(wc * 128 + n * 16 + fr, fq)); \
            _Pragma("unroll") for (int m = 0; m < 4; ++m) acc[m][n] = __builtin_amdgcn_mfma_f32_16x16x32_bf16(af[m], bfr, acc[m][n], 0, 0, 0); } } } while (0)
    const int nk = K >> 5;
    char* st0 = smem;
    char* st1 = smem + G3_STAGE;
    G3_GLOAD(ra0, rf0, rb0, 0);
    G3_GLOAD(ra1, rf1, rb1, 32);
    G3_LWRITE(ra0, rf0, rb0, st0);
    if (nk > 2) G3_GLOAD(ra0, rf0, rb0, 64);
    __syncthreads();
    for (int kt = 0; kt < nk; kt += 2) {
        G3_LWRITE(ra1, rf1, rb1, st1);
        if (kt + 3 < nk) G3_GLOAD(ra1, rf1, rb1, (kt + 3) * 32);
        G3_COMPUTE(st0);
        __syncthreads();
        if (kt + 2 < nk) G3_LWRITE(ra0, rf0, rb0, st0);
        if (kt + 4 < nk) G3_GLOAD(ra0, rf0, rb0, (kt + 4) * 32);
        G3_COMPUTE(st1);
        __syncthreads();
    }
#undef G3_GLOAD
#undef G3_LWRITE
#undef G3_COMPUTE
}

template <class AF, class BF>
__device__ __forceinline__ void gemm4(char* smem, const int K, AF arow, BF brow, f32x4 (&acc)[4][8]) {
    const int tid = otid(), lane = tid & 63, wid = tid >> 6, wr = wid >> 1, wc = wid & 1, fr = lane & 15, fq = lane >> 4;
    const bf16_t* ga[2];
    const bf16_t* gb[2];
#pragma unroll
    for (int i = 0; i < 2; ++i) {
        const int r = 16 * (wid + 8 * i) + (lane >> 2), sc = ((lane & 3) ^ ((r >> 2) & 3)) * 8;
        ga[i] = arow(r) + sc;
        gb[i] = brow(r) + sc;
    }
#pragma unroll
    for (int m = 0; m < 4; ++m)
#pragma unroll
        for (int n = 0; n < 8; ++n) acc[m][n] = f32x4{0.f, 0.f, 0.f, 0.f};
    char* ldst = smem + wid * 1024 + lane * 16;
#define G4_ISSUE(slot, k0) do { \
        char* d_ = ldst + (slot) * 32768; \
        __builtin_amdgcn_global_load_lds((const unsigned*)(ga[0] + (k0)), (LAS unsigned*)(d_), 16, 0, 0); \
        __builtin_amdgcn_global_load_lds((const unsigned*)(ga[1] + (k0)), (LAS unsigned*)(d_ + 8192), 16, 0, 0); \
        __builtin_amdgcn_global_load_lds((const unsigned*)(gb[0] + (k0)), (LAS unsigned*)(d_ + 16384), 16, 0, 0); \
        __builtin_amdgcn_global_load_lds((const unsigned*)(gb[1] + (k0)), (LAS unsigned*)(d_ + 16384 + 8192), 16, 0, 0); } while (0)
    const int nk = K >> 5;
    G4_ISSUE(0, 0);
    G4_ISSUE(1, 32);
    int slot = 0, slot2 = 2;
    for (int kt = 0; kt < nk; ++kt) {
        if (kt + 1 < nk) asm volatile("s_waitcnt vmcnt(4)" ::: "memory");
        else asm volatile("s_waitcnt vmcnt(0)" ::: "memory");
        __builtin_amdgcn_s_barrier();
        if (kt + 2 < nk) G4_ISSUE(slot2, (kt + 2) * 32);
        const char* sA_ = smem + slot * 32768;
        const char* sB_ = sA_ + 16384;
        bf16x8 af[4];
#pragma unroll
        for (int m = 0; m < 4; ++m) af[m] = *(const bf16x8*)(sA_ + aoff(wr * 64 + m * 16 + fr, fq));
#pragma unroll
        for (int n = 0; n < 8; ++n) {
            const bf16x8 bfr = *(const bf16x8*)(sB_ + aoff(wc * 128 + n * 16 + fr, fq));
#pragma unroll
            for (int m = 0; m < 4; ++m) acc[m][n] = __builtin_amdgcn_mfma_f32_16x16x32_bf16(af[m], bfr, acc[m][n], 0, 0, 0);
        }
        slot = (slot == 2) ? 0 : slot + 1;
        slot2 = (slot2 == 2) ? 0 : slot2 + 1;
    }
#undef G4_ISSUE
    __syncthreads();
}


constexpr int EPI_WAVE = 8704;
template <class VF, class SF>
__device__ __forceinline__ void epi_bf16(char* wl, const int lane, VF val, SF store) {
    const int fr = lane & 15, fq = lane >> 4, odd = lane & 1;
#pragma unroll
    for (int n = 0; n < 8; ++n)
#pragma unroll
        for (int jp = 0; jp < 2; ++jp) {
            const float a = val(n, 2 * jp), b = val(n, 2 * jp + 1);
            const float x = odd ? a : b;
            const float y = __shfl_xor(x, 1, 64);
            const uint32_t w = odd ? pack2(y, b) : pack2(a, y);
            *(uint32_t*)(wl + (fq * 4 + 2 * jp + odd) * 272 + (n * 16 + (fr & ~1)) * 2) = w;
        }
    int ln = lane;
    asm volatile("" : "+v"(ln));
#pragma unroll
    for (int i = 0; i < 4; ++i) {
        const int idx = ln + 64 * i, row = idx >> 4, ch = idx & 15;
        store(row, ch, *(const u32x4*)(wl + row * 272 + ch * 16));
    }
}
template <class VF, class SF>
__device__ __forceinline__ void epi_f32(char* wl, const int lane, VF val, SF store) {
    const int fr = lane & 15, fq = lane >> 4;
#pragma unroll
    for (int n = 0; n < 8; ++n)
#pragma unroll
        for (int j = 0; j < 4; ++j) *(float*)(wl + (fq * 4 + j) * 528 + (n * 16 + fr) * 4) = val(n, j);
    int ln = lane;
    asm volatile("" : "+v"(ln));
#pragma unroll
    for (int i = 0; i < 8; ++i) {
        const int idx = ln + 64 * i, row = idx >> 5, ch = idx & 31;
        store(row, ch, *(const f32x4*)(wl + row * 528 + ch * 16));
    }
}

__device__ void ph_inproj(const Params& p, char* smem) {
    const int tid = otid(), lane = tid & 63, wid = tid >> 6, wr = wid >> 1, wc = wid & 1, fr = lane & 15;
    const int NTN = INW / 256;
    const int xcd = blockIdx.x & 7, nbx = gridDim.x >> 3;
    for (int i = blockIdx.x >> 3; i < 8 * NTN; i += nbx) {
        const int nt = i >> 3, mt = xcd * 8 + (i & 7);
        const bf16_t* A = p.h1() + (size_t)mt * 256 * D;
        const bf16_t* Bt = p.winT() + (size_t)nt * 256 * D;
        f32x4 acc[4][8];
        __syncthreads();
        gemm4(smem, D, [&](int r) { return A + (size_t)r * D; }, [&](int n) { return Bt + (size_t)n * D; }, acc);
        char* wl = smem + wid * EPI_WAVE;
        const int colb = nt * 256 + wc * 128;
        const int rowb = mt * 256 + wr * 64;
        if (colb >= OFF_HF && colb < OFF_HI) {
            float lbc[8];
#pragma unroll
            for (int n = 0; n < 8; ++n) lbc[n] = p.lbv()[colb - OFF_HF + n * 16 + fr];
#pragma unroll
            for (int m = 0; m < 4; ++m) {
                float* dst = p.lgf() + (size_t)(rowb + m * 16) * 512 + (colb - OFF_HF);
                epi_f32(wl, lane,
                        [&](int n, int j) { return logf(lbc[n] + (1.f - lbc[n]) * (1.f / (1.f + expf(-acc[m][n][j])))); },
                        [&](int row, int ch, f32x4 v) { *(f32x4*)(dst + (size_t)row * 512 + ch * 4) = v; });
            }
        } else {
#pragma unroll
            for (int m = 0; m < 4; ++m) {
                bf16_t* dst = p.proj() + (size_t)(rowb + m * 16) * INW + colb;
                epi_bf16(wl, lane, [&](int n, int j) { return acc[m][n][j]; },
                         [&](int row, int ch, u32x4 v) { *(u32x4*)(dst + (size_t)row * INW + ch * 8) = v; });
            }
        }
    }
}

__device__ void ph_h1(const Params& p, char* smem0) {
    const VB vbk = make_vb(smem0);
    char* smem = vbk.smem;
    const int tid = vbk.tid, lane = tid & 63, wid = tid >> 6, wr = wid >> 1, wc = wid & 1, fr = lane & 15, fq = lane >> 4;
    char* sI = smem;
    char* sK = smem + 16384;
    float* sL = (float*)(smem + 32768);
    float* totS = (float*)(smem + 65536);
    const int d = tid & 127, half = tid >> 7;
    const TrBase trb = tr16_base(lane);
    for (int u = vbk.vb; u < 1024; u += vbk.nvb) {
        const int bh = u >> 6, c = u & 63, b = bh >> 2, h = bh & 3;
        const size_t row0 = (size_t)b * S + c * 64;
        __syncthreads();
#pragma unroll
        for (int i = 0; i < 4; ++i) {
            const int idx = tid + 256 * i, r = idx >> 4, ch = idx & 15;
            *(u32x4*)(sI + swz16(r, ch)) = *(const u32x4*)(p.proj() + (row0 + r) * INW + OFF_HI + h * 128 + ch * 8);
        }
#pragma unroll
        for (int i = 0; i < 8; ++i) {
            const int idx = tid + 256 * i, r = idx >> 5, c4 = idx & 31;
            *(f32x4*)(sL + r * 128 + c4 * 4) = *(const f32x4*)(p.lgf() + (row0 + r) * 512 + h * 128 + c4 * 4);
        }
        __syncthreads();
        const float* lcol = sL + half * 32 * 128 + d;
        float tot = 0.f;
#pragma unroll
        for (int s = 0; s < 32; ++s) tot += lcol[s * 128];
        totS[half * 128 + d] = tot;
        __syncthreads();
        const float t0 = totS[d], bl = t0 + totS[128 + d];
        float run = half ? t0 : 0.f;
#pragma unroll 8
        for (int s = 0; s < 32; ++s) {
            const float lv = lcol[s * 128];
            run += lv;
            const float kt = (1.f - __expf(lv)) * __expf(bl - run);
            *(bf16_t*)(sK + swz16(half * 32 + s, d >> 3) + (d & 7) * 2) = f2bf(kt);
        }
        if (half == 0) p.dec()[u * 128 + d] = __expf(bl);
        __syncthreads();
        f32x4 acc[4][4];
#pragma unroll
        for (int m = 0; m < 4; ++m)
#pragma unroll
            for (int n = 0; n < 4; ++n) acc[m][n] = f32x4{0.f, 0.f, 0.f, 0.f};
#pragma unroll
        for (int ks = 0; ks < 2; ++ks) {
            bf16x8 af[4], bfr[4];
#pragma unroll
            for (int m = 0; m < 4; ++m) af[m] = tr_frag16(sI, trb, ks, wr * 4 + m);
#pragma unroll
            for (int n = 0; n < 4; ++n) bfr[n] = tr_frag16(sK, trb, ks, wc * 4 + n);
#pragma unroll
            for (int m = 0; m < 4; ++m)
#pragma unroll
                for (int n = 0; n < 4; ++n) acc[m][n] = __builtin_amdgcn_mfma_f32_16x16x32_bf16(af[m], bfr[n], acc[m][n], 0, 0, 0);
        }
        float* kvu = p.kv() + (size_t)u * 16384;
#pragma unroll
        for (int m = 0; m < 4; ++m)
#pragma unroll
            for (int n = 0; n < 4; ++n)
#pragma unroll
                for (int j = 0; j < 4; ++j) kvu[(wr * 64 + m * 16 + fq * 4 + j) * 128 + wc * 64 + n * 16 + fr] = acc[m][n][j];
    }
}

__device__ void ph_h2(const Params& p) {
    for (int it = blockIdx.x * NTHREADS + otid(); it < 16 * 8192; it += gridDim.x * NTHREADS) {
        const int bh = it >> 13, e2 = it & 8191, dv = e2 >> 6, dk = (e2 & 63) * 2;
        const size_t eoff = (size_t)dv * 128 + dk;
        float sx = 0.f, sy = 0.f;
#pragma unroll 8
        for (int c = 0; c < 64; ++c) {
            const size_t u = (size_t)bh * 64 + c;
            *(uint32_t*)(p.sst() + u * 16384 + eoff) = pack2(sx, sy);
            const float2 kvv = *(const float2*)(p.kv() + u * 16384 + eoff);
            const float2 dc = *(const float2*)(p.dec() + u * 128 + dk);
            sx = dc.x * sx + kvv.x; sy = dc.y * sy + kvv.y;
        }
    }
}

__device__ void ph_h3(const Params& p, char* smem0) {
    const VB vbk = make_vb(smem0);
    char* smem = vbk.smem;
    const int tid = vbk.tid, lane = tid & 63, wid = tid >> 6, wr = wid >> 1, wc = wid & 1, fr = lane & 15, fq = lane >> 4;
    char* sQ = smem;
    char* sK = smem + 16384;
    char* sP = smem + 32768;
    float* sL = (float*)(smem + 32768);
    float* totS = (float*)(smem + 65536);
    const int d = tid & 127, half = tid >> 7;
    const TrBase trb = tr16_base(lane);
    for (int u = vbk.vb; u < 1024; u += vbk.nvb) {
        const int bh = u >> 6, c = u & 63, b = bh >> 2, h = bh & 3;
        const size_t row0 = (size_t)b * S + c * 64;
        __syncthreads();
#pragma unroll
        for (int i = 0; i < 4; ++i) {
            const int idx = tid + 256 * i, r = idx >> 4, ch = idx & 15;
            *(u32x4*)(sQ + swz16(r, ch)) = *(const u32x4*)(p.proj() + (row0 + r) * INW + OFF_HQ + h * 128 + ch * 8);
        }
#pragma unroll
        for (int i = 0; i < 8; ++i) {
            const int idx = tid + 256 * i, r = idx >> 5, c4 = idx & 31;
            *(f32x4*)(sL + r * 128 + c4 * 4) = *(const f32x4*)(p.lgf() + (row0 + r) * 512 + h * 128 + c4 * 4);
        }
        __syncthreads();
        const float* lcol = sL + half * 32 * 128 + d;
        float tot = 0.f;
#pragma unroll
        for (int s = 0; s < 32; ++s) tot += lcol[s * 128];
        totS[half * 128 + d] = tot;
        __syncthreads();
        const float t0 = totS[d];
        float run = half ? t0 : 0.f;
#pragma unroll 8
        for (int s = 0; s < 32; ++s) {
            const float lv = lcol[s * 128];
            run += lv;
            const int o = swz16(half * 32 + s, d >> 3) + (d & 7) * 2;
            const float qm = bf2f(*(const bf16_t*)(sQ + o)) * __expf(run - t0);
            const float kh = (1.f - __expf(lv)) * __expf(t0 - run);
            *(bf16_t*)(sQ + o) = f2bf(qm);
            *(bf16_t*)(sK + o) = f2bf(kh);
        }
        __syncthreads();
        {
            f32x4 pa[2][2];
#pragma unroll
            for (int m = 0; m < 2; ++m)
#pragma unroll
                for (int n = 0; n < 2; ++n) pa[m][n] = f32x4{0.f, 0.f, 0.f, 0.f};
#pragma unroll
            for (int ks = 0; ks < 4; ++ks) {
                bf16x8 af[2], bfr[2];
#pragma unroll
                for (int m = 0; m < 2; ++m) af[m] = *(const bf16x8*)(sQ + swz16(wr * 32 + m * 16 + fr, ks * 4 + fq));
#pragma unroll
                for (int n = 0; n < 2; ++n) bfr[n] = *(const bf16x8*)(sK + swz16(wc * 32 + n * 16 + fr, ks * 4 + fq));
#pragma unroll
                for (int m = 0; m < 2; ++m)
#pragma unroll
                    for (int n = 0; n < 2; ++n) pa[m][n] = __builtin_amdgcn_mfma_f32_16x16x32_bf16(af[m], bfr[n], pa[m][n], 0, 0, 0);
            }
#pragma unroll
            for (int m = 0; m < 2; ++m)
#pragma unroll
                for (int n = 0; n < 2; ++n)
#pragma unroll
                    for (int j = 0; j < 4; ++j) {
                        const int t = wr * 32 + m * 16 + fq * 4 + j, s_ = wc * 32 + n * 16 + fr;
                        const float v = (s_ <= t) ? pa[m][n][j] : 0.f;
                        *(bf16_t*)(sP + swz(t, s_ >> 3) + (s_ & 7) * 2) = f2bf(v);
                    }
        }
        __syncthreads();
        f32x4 oa[8];
#pragma unroll
        for (int n = 0; n < 8; ++n) oa[n] = f32x4{0.f, 0.f, 0.f, 0.f};
        const int ch = tid & 7;
#pragma unroll
        for (int sub = 0; sub < 2; ++sub) {
            float sc[8];
#pragma unroll
            for (int j = 0; j < 8; ++j) sc[j] = __expf(totS[sub * 64 + ch * 8 + j]);
#pragma unroll
            for (int i = 0; i < 4; ++i) {
                const int r = (tid + 256 * i) >> 3;
                const u32x4 v = *(const u32x4*)(p.sst() + (size_t)u * 16384 + r * 128 + sub * 64 + ch * 8);
                u32x4 w;
                w.x = pack2(__uint_as_float(v.x << 16) * sc[0], __uint_as_float(v.x & 0xffff0000u) * sc[1]);
                w.y = pack2(__uint_as_float(v.y << 16) * sc[2], __uint_as_float(v.y & 0xffff0000u) * sc[3]);
                w.z = pack2(__uint_as_float(v.z << 16) * sc[4], __uint_as_float(v.z & 0xffff0000u) * sc[5]);
                w.w = pack2(__uint_as_float(v.w << 16) * sc[6], __uint_as_float(v.w & 0xffff0000u) * sc[7]);
                *(u32x4*)(sK + swz(r, ch)) = w;
            }
            __syncthreads();
#pragma unroll
            for (int ks = 0; ks < 2; ++ks) {
                const bf16x8 af = *(const bf16x8*)(sQ + swz16(wid * 16 + fr, sub * 8 + ks * 4 + fq));
#pragma unroll
                for (int n = 0; n < 8; ++n) {
                    const bf16x8 bfr = *(const bf16x8*)(sK + swz(n * 16 + fr, ks * 4 + fq));
                    oa[n] = __builtin_amdgcn_mfma_f32_16x16x32_bf16(af, bfr, oa[n], 0, 0, 0);
                }
            }
            __syncthreads();
        }
#pragma unroll
        for (int i = 0; i < 4; ++i) {
            const int idx = tid + 256 * i, r = idx >> 4, c16 = idx & 15;
            *(u32x4*)(sK + swz16(r, c16)) = *(const u32x4*)(p.proj() + (row0 + r) * INW + OFF_HI + h * 128 + c16 * 8);
        }
        __syncthreads();
#pragma unroll
        for (int ks = 0; ks < 2; ++ks) {
            const bf16x8 af = *(const bf16x8*)(sP + swz(wid * 16 + fr, ks * 4 + fq));
#pragma unroll
            for (int n = 0; n < 8; ++n) {
                const bf16x8 bfr = tr_frag16(sK, trb, ks, n);
                oa[n] = __builtin_amdgcn_mfma_f32_16x16x32_bf16(af, bfr, oa[n], 0, 0, 0);
            }
        }
        float ss[4] = {0.f, 0.f, 0.f, 0.f};
#pragma unroll
        for (int n = 0; n < 8; ++n)
#pragma unroll
            for (int j = 0; j < 4; ++j) ss[j] += oa[n][j] * oa[n][j];
#pragma unroll
        for (int j = 0; j < 4; ++j) {
            ss[j] += __shfl_xor(ss[j], 1, 64); ss[j] += __shfl_xor(ss[j], 2, 64); ss[j] += __shfl_xor(ss[j], 4, 64); ss[j] += __shfl_xor(ss[j], 8, 64);
        }
#pragma unroll
        for (int j = 0; j < 4; ++j) {
            const size_t row = row0 + wid * 16 + fq * 4 + j;
            const float rstd = rsqrtf(ss[j] * (1.f / 128.f) + RMS_EPS);
#pragma unroll
            for (int n = 0; n < 8; ++n) {
                const int dv = n * 16 + fr;
                const float g = bf2f(p.proj()[row * INW + OFF_HG + h * 128 + dv]);
                const float y = oa[n][j] * rstd * p.hg_nw[h * 128 + dv] * (g / (1.f + __expf(-g)));
                p.mixin()[row * 768 + h * 128 + dv] = f2bf(y);
            }
        }
    }
}

__device__ __forceinline__ TrBase tr8_base(int lane) {
    const int g = lane >> 4, q = (lane & 15) >> 2, pp = lane & 3;
    const int xl = 4 * (g & 1) + (q >> 1), h = pp >> 1;
    TrBase t;
    t.lo = (8 * g + q) * 128 + ((xl >> 1) << 5) + ((h ^ (xl & 1)) << 4) + 8 * (pp & 1);
    t.hi = (t.lo + 512) ^ 32;
    return t;
}
__device__ __forceinline__ bf16x8 tr_frag8(const char* tile, const TrBase& tb, int ks, int c) {
    int cx = c << 5;
    asm volatile("" : "+v"(cx));
    const v4s lo = __builtin_amdgcn_ds_read_tr16_b64_v4i16((LAS v4s*)(tile + ks * 4096 + (tb.lo ^ cx)));
    const v4s hi = __builtin_amdgcn_ds_read_tr16_b64_v4i16((LAS v4s*)(tile + ks * 4096 + (tb.hi ^ cx)));
    return bf16x8{lo[0], lo[1], lo[2], lo[3], hi[0], hi[1], hi[2], hi[3]};
}

__device__ void ph_attn(const Params& p, char* smem0) {
    const VB vbk = make_vb(smem0);
    char* smem = vbk.smem;
    const int tid = vbk.tid, lane = tid & 63, wid = tid >> 6, fr = lane & 15, fq = lane >> 4;
    char* sQ = smem;
    char* sK = smem + 8192;
    char* sP = sK;
    char* sV = smem + 33792;
    float* sBias = (float*)(smem + 58368);
    const TrBase trb = tr8_base(lane);
    for (int u = vbk.vb; u < 3072; u += vbk.nvb) {
        const int ti = u & 63, gq = u >> 6, g = gq % 3, bhh = gq / 3, hh = bhh & 3, b = bhh >> 2;
        const int lsh = (g == 0) ? 0 : (g == 1 ? 2 : 4), dl = 1 << lsh;
        const int tpr = (S >> lsh) >> 6;
        const int r = ti / tpr, j0 = (ti % tpr) * 64;
        const bf16_t* base = p.proj() + (size_t)b * S * INW + (g * 4 + hh) * 64;
        __syncthreads();
#pragma unroll
        for (int i = 0; i < 2; ++i) {
            const int idx = tid + 256 * i, row = idx >> 3, ch = idx & 7;
            const int tok = (j0 + row) * dl + r;
            *(u32x4*)(sQ + swz(row, ch)) = *(const u32x4*)(base + (size_t)tok * INW + OFF_AQ + ch * 8);
        }
#pragma unroll
        for (int i = 0; i < 6; ++i) {
            const int idx = tid + 256 * i, row = idx >> 3, ch = idx & 7;
            const int j = j0 - 128 + row;
            u32x4 kx = {0u, 0u, 0u, 0u}, vx = {0u, 0u, 0u, 0u};
            if (j >= 0) {
                const size_t o = (size_t)(j * dl + r) * INW + ch * 8;
                kx = *(const u32x4*)(base + o + OFF_AK);
                vx = *(const u32x4*)(base + o + OFF_AV);
            }
            *(u32x4*)(sK + swz(row, ch)) = kx;
            *(u32x4*)(sV + swz(row, ch)) = vx;
        }
        if (tid < 129) sBias[tid] = p.biasT()[(g * 129 + tid) * 4 + hh];
        __syncthreads();
        f32x4 sa[12];
#pragma unroll
        for (int n = 0; n < 12; ++n) sa[n] = f32x4{0.f, 0.f, 0.f, 0.f};
#pragma unroll
        for (int ks = 0; ks < 2; ++ks) {
            const bf16x8 af = *(const bf16x8*)(sQ + swz(wid * 16 + fr, ks * 4 + fq));
#pragma unroll
            for (int n = 0; n < 12; ++n) {
                const bf16x8 bfr = *(const bf16x8*)(sK + swz(n * 16 + fr, ks * 4 + fq));
                sa[n] = __builtin_amdgcn_mfma_f32_16x16x32_bf16(af, bfr, sa[n], 0, 0, 0);
            }
        }
        float mx[4] = {-INFINITY, -INFINITY, -INFINITY, -INFINITY};
#pragma unroll
        for (int n = 0; n < 12; ++n)
#pragma unroll
            for (int j = 0; j < 4; ++j) {
                const int jj = wid * 16 + fq * 4 + j, kk = n * 16 + fr, m = jj + 128 - kk;
                const bool valid = (m >= 0) && (m <= 128) && (j0 - 128 + kk >= 0);
                const int mc = m < 0 ? 0 : (m > 128 ? 128 : m);
                const float v = valid ? sa[n][j] * 0.125f + sBias[mc] : -INFINITY;
                sa[n][j] = v;
                mx[j] = fmaxf(mx[j], v);
            }
#pragma unroll
        for (int j = 0; j < 4; ++j) {
            mx[j] = fmaxf(mx[j], __shfl_xor(mx[j], 1, 64)); mx[j] = fmaxf(mx[j], __shfl_xor(mx[j], 2, 64));
            mx[j] = fmaxf(mx[j], __shfl_xor(mx[j], 4, 64)); mx[j] = fmaxf(mx[j], __shfl_xor(mx[j], 8, 64));
        }
        float ls[4] = {0.f, 0.f, 0.f, 0.f};
#pragma unroll
        for (int n = 0; n < 12; ++n)
#pragma unroll
            for (int j = 0; j < 4; ++j) { const float pe = __expf(sa[n][j] - mx[j]); sa[n][j] = pe; ls[j] += pe; }
#pragma unroll
        for (int j = 0; j < 4; ++j) {
            ls[j] += __shfl_xor(ls[j], 1, 64); ls[j] += __shfl_xor(ls[j], 2, 64); ls[j] += __shfl_xor(ls[j], 4, 64); ls[j] += __shfl_xor(ls[j], 8, 64);
        }
        __syncthreads();
#pragma unroll
        for (int n = 0; n < 12; ++n)
#pragma unroll
            for (int j = 0; j < 4; ++j) *(bf16_t*)(sP + (wid * 16 + fq * 4 + j) * 400 + (n * 16 + fr) * 2) = f2bf(sa[n][j]);
        f32x4 oa[4];
#pragma unroll
        for (int n = 0; n < 4; ++n) oa[n] = f32x4{0.f, 0.f, 0.f, 0.f};
#pragma unroll
        for (int ks = 0; ks < 6; ++ks) {
            const bf16x8 af = *(const bf16x8*)(sP + (wid * 16 + fr) * 400 + (ks * 4 + fq) * 16);
#pragma unroll
            for (int n = 0; n < 4; ++n) {
                const bf16x8 bfr = tr_frag8(sV, trb, ks, n);
                oa[n] = __builtin_amdgcn_mfma_f32_16x16x32_bf16(af, bfr, oa[n], 0, 0, 0);
            }
        }
#pragma unroll
        for (int j = 0; j < 4; ++j) {
            const int jj = wid * 16 + fq * 4 + j;
            const size_t row = (size_t)g * T + (size_t)b * S + (j0 + jj) * dl + r;
            const float inv = 1.f / ls[j];
#pragma unroll
            for (int n = 0; n < 4; ++n) p.ao()[row * 256 + hh * 64 + n * 16 + fr] = oa[n][j] * inv;
            if (fr == 0) p.alse()[row * 4 + hh] = mx[j] + __logf(ls[j]);
        }
    }
}

__device__ void ph_attn_merge(const Params& p) {
    const int tid = otid(), lane = tid & 63, wid = tid >> 6;
    for (int row = blockIdx.x * 8 + wid; row < T; row += gridDim.x * 8) {
        const int hh = lane >> 4;
        const float l0 = p.alse()[((size_t)0 * T + row) * 4 + hh], l1 = p.alse()[((size_t)1 * T + row) * 4 + hh], l2 = p.alse()[((size_t)2 * T + row) * 4 + hh];
        const float mxl = fmaxf(l0, fmaxf(l1, l2));
        float e0 = __expf(l0 - mxl), e1 = __expf(l1 - mxl), e2 = __expf(l2 - mxl);
        const float inv = 1.f / (e0 + e1 + e2);
        e0 *= inv; e1 *= inv; e2 *= inv;
        const f32x4 a0 = *(const f32x4*)(p.ao() + ((size_t)0 * T + row) * 256 + lane * 4);
        const f32x4 a1 = *(const f32x4*)(p.ao() + ((size_t)1 * T + row) * 256 + lane * 4);
        const f32x4 a2 = *(const f32x4*)(p.ao() + ((size_t)2 * T + row) * 256 + lane * 4);
        uint2 o;
        o.x = pack2(a0[0] * e0 + a1[0] * e1 + a2[0] * e2, a0[1] * e0 + a1[1] * e1 + a2[1] * e2);
        o.y = pack2(a0[2] * e0 + a1[2] * e1 + a2[2] * e2, a0[3] * e0 + a1[3] * e1 + a2[3] * e2);
        *(uint2*)(p.mixin() + (size_t)row * 768 + 512 + lane * 4) = o;
    }
}

__device__ void ph_outproj(const Params& p, char* smem) {
    const int tid = otid(), lane = tid & 63, wid = tid >> 6, wr = wid >> 1, wc = wid & 1;
    const int xcd = blockIdx.x & 7, nbx = gridDim.x >> 3;
    for (int i = blockIdx.x >> 3; i < 32; i += nbx) {
        const int nt = i >> 3, mt = xcd * 8 + (i & 7);
        const bf16_t* A = p.mixin() + (size_t)mt * 256 * 768;
        const bf16_t* Bt = p.woutT() + (size_t)nt * 256 * 768;
        f32x4 acc[4][8];
        __syncthreads();
        gemm4(smem, 768, [&](int r) { return A + (size_t)r * 768; }, [&](int n) { return Bt + (size_t)n * 768; }, acc);
        const int b = (mt * 256) >> 12;
        const int colb = nt * 256 + wc * 128;
        const float* g1 = p.mod() + b * 6144 + 2048 + colb;
        char* wl = smem + wid * EPI_WAVE;
#pragma unroll
        for (int m = 0; m < 4; ++m) {
            const size_t rbase = (size_t)(mt * 256 + wr * 64 + m * 16) * D + colb;
            epi_f32(wl, lane, [&](int n, int j) { return acc[m][n][j]; },
                    [&](int row, int ch, f32x4 v) {
                        const f32x4 xv = *(const f32x4*)(p.x + rbase + (size_t)row * D + ch * 4);
                        const f32x4 gv = *(const f32x4*)(g1 + ch * 4);
                        f32x4 o;
                        o[0] = ALPHA * xv[0] + gv[0] * v[0]; o[1] = ALPHA * xv[1] + gv[1] * v[1];
                        o[2] = ALPHA * xv[2] + gv[2] * v[2]; o[3] = ALPHA * xv[3] + gv[3] * v[3];
                        *(f32x4*)(p.pre1() + rbase + (size_t)row * D + ch * 4) = o;
                    });
        }
    }
}

__device__ void ph_ln1(const Params& p) {
    const int tid = otid(), lane = tid & 63, wid = tid >> 6;
    for (int row = blockIdx.x * 8 + wid; row < T; row += gridDim.x * 8) {
        const float4* xr = (const float4*)(p.pre1() + (size_t)row * D);
        float4 v[4];
        float s = 0.f;
#pragma unroll
        for (int i = 0; i < 4; ++i) { v[i] = xr[lane + 64 * i]; s += v[i].x + v[i].y + v[i].z + v[i].w; }
        float mean = wave_sum(s) * (1.f / D);
        float q = 0.f;
#pragma unroll
        for (int i = 0; i < 4; ++i) {
            v[i].x -= mean; v[i].y -= mean; v[i].z -= mean; v[i].w -= mean;
            q += v[i].x * v[i].x + v[i].y * v[i].y + v[i].z * v[i].z + v[i].w * v[i].w;
        }
        float rstd = rsqrtf(wave_sum(q) * (1.f / D) + LN_EPS);
        s = 0.f;
#pragma unroll
        for (int i = 0; i < 4; ++i) {
            const int col = (lane + 64 * i) * 4;
            const float4 g4 = *(const float4*)(p.ln1_g + col), b4 = *(const float4*)(p.ln1_b + col);
            v[i].x = v[i].x * rstd * g4.x + b4.x; v[i].y = v[i].y * rstd * g4.y + b4.y;
            v[i].z = v[i].z * rstd * g4.z + b4.z; v[i].w = v[i].w * rstd * g4.w + b4.w;
            { uint2 xo; xo.x = pack2(v[i].x, v[i].y); xo.y = pack2(v[i].z, v[i].w); *(uint2*)(p.x1() + (size_t)row * D + col) = xo; }
            s += v[i].x + v[i].y + v[i].z + v[i].w;
        }
        mean = wave_sum(s) * (1.f / D);
        q = 0.f;
#pragma unroll
        for (int i = 0; i < 4; ++i) {
            v[i].x -= mean; v[i].y -= mean; v[i].z -= mean; v[i].w -= mean;
            q += v[i].x * v[i].x + v[i].y * v[i].y + v[i].z * v[i].z + v[i].w * v[i].w;
        }
        rstd = rsqrtf(wave_sum(q) * (1.f / D) + LN_EPS);
        const int b = row >> 12;
        const float* sh = p.mod() + b * 6144 + 3072;
        const float* sc = sh + 1024;
#pragma unroll
        for (int i = 0; i < 4; ++i) {
            const int col = (lane + 64 * i) * 4;
            const float4 s4 = *(const float4*)(sc + col), h4 = *(const float4*)(sh + col);
            float4 y;
            y.x = v[i].x * rstd * (1.f + s4.x) + h4.x; y.y = v[i].y * rstd * (1.f + s4.y) + h4.y;
            y.z = v[i].z * rstd * (1.f + s4.z) + h4.z; y.w = v[i].w * rstd * (1.f + s4.w) + h4.w;
            uint2 o;
            o.x = pack2(y.x, y.y); o.y = pack2(y.z, y.w);
            *(uint2*)(p.h2() + (size_t)row * 2048 + col) = o;
            uint2 o2;
            o2.x = pack2(y.x - __uint_as_float(o.x << 16), y.y - __uint_as_float(o.x & 0xffff0000u));
            o2.y = pack2(y.z - __uint_as_float(o.y << 16), y.w - __uint_as_float(o.y & 0xffff0000u));
            *(uint2*)(p.h2() + (size_t)row * 2048 + 1024 + col) = o2;
        }
    }
}

__device__ void ph_router_gemm(const Params& p, char* smem) {
    const int tid = otid(), lane = tid & 63, wid = tid >> 6, wr = wid >> 1, wc = wid & 1;
    for (int u = blockIdx.x; u < 192; u += gridDim.x) {
        const int pass = u >> 6, mt = u & 63;
        const bf16_t* A = p.h2() + (size_t)mt * 256 * 2048 + (pass == 1 ? 1024 : 0);
        const bf16_t* Bt = p.wrT() + (pass == 2 ? (size_t)NE * D : 0);
        f32x4 acc[4][8];
        __syncthreads();
        gemm4(smem, D, [&](int r) { return A + (size_t)r * 2048; }, [&](int n) { return Bt + (size_t)n * D; }, acc);
        char* wl = smem + wid * EPI_WAVE;
#pragma unroll
        for (int m = 0; m < 4; ++m) {
            float* dst = p.lgp() + (size_t)pass * T * NE + (size_t)(mt * 256 + wr * 64 + m * 16) * NE + wc * 128;
            epi_f32(wl, lane, [&](int n, int j) { return acc[m][n][j]; },
                    [&](int row, int ch, f32x4 v) { *(f32x4*)(dst + (size_t)row * NE + ch * 4) = v; });
        }
    }
}

__device__ void ph_topk(const Params& p) {
    const int tid = otid(), lane = tid & 63, wid = tid >> 6;
    constexpr int TK = 4;
    for (int tok0 = (blockIdx.x * 8 + wid) * TK; tok0 < T; tok0 += gridDim.x * 8 * TK) {
        float sc[TK][4], bv[TK][4];
#pragma unroll
        for (int t = 0; t < TK; ++t)
#pragma unroll
            for (int j = 0; j < 4; ++j) {
                const int e = j * 64 + lane;
                const size_t o = (size_t)(tok0 + t) * NE + e;
                const float x = (p.lgp()[o] + p.lgp()[(size_t)T * NE + o]) + p.lgp()[(size_t)2 * T * NE + o];
                sc[t][j] = 1.f / (1.f + expf(-x));
                bv[t][j] = sc[t][j] + p.router_bias[e];
            }
        float gsum[TK][4];
#pragma unroll
        for (int j = 0; j < 4; ++j) {
            float m1[TK], m2[TK];
#pragma unroll
            for (int t = 0; t < TK; ++t) m1[t] = bv[t][j];
#pragma unroll
            for (int o = 16; o > 0; o >>= 1)
#pragma unroll
                for (int t = 0; t < TK; ++t) m1[t] = fmaxf(m1[t], __shfl_xor(m1[t], o, 64));
#pragma unroll
            for (int t = 0; t < TK; ++t) {
                const unsigned long long bal = __ballot(bv[t][j] == m1[t]);
                const unsigned hm = (unsigned)(bal >> (lane & 32));
                const int first = __ffs(hm) - 1;
                m2[t] = ((lane & 31) == first) ? -INFINITY : bv[t][j];
            }
#pragma unroll
            for (int o = 16; o > 0; o >>= 1)
#pragma unroll
                for (int t = 0; t < TK; ++t) m2[t] = fmaxf(m2[t], __shfl_xor(m2[t], o, 64));
#pragma unroll
            for (int t = 0; t < TK; ++t) gsum[t][j] = m1[t] + m2[t];
        }
        float cand[TK][4];
#pragma unroll
        for (int t = 0; t < TK; ++t) {
            float gs[8];
#pragma unroll
            for (int j = 0; j < 4; ++j) { gs[2 * j] = __shfl(gsum[t][j], 0, 64); gs[2 * j + 1] = __shfl(gsum[t][j], 32, 64); }
            unsigned gmask = 0u;
#pragma unroll
            for (int r = 0; r < 4; ++r) {
                float best = -INFINITY; int bi = 0;
#pragma unroll
                for (int g = 0; g < 8; ++g) {
                    const bool ok = (((gmask >> g) & 1u) == 0u) && (gs[g] > best);
                    if (ok) { best = gs[g]; bi = g; }
                }
                gmask |= 1u << bi;
            }
#pragma unroll
            for (int j = 0; j < 4; ++j) cand[t][j] = ((gmask >> (2 * j + (lane >> 5))) & 1u) ? bv[t][j] : -INFINITY;
        }
        float wsum[TK], myw[TK];
        int mye[TK];
#pragma unroll
        for (int t = 0; t < TK; ++t) { wsum[t] = 0.f; myw[t] = 0.f; mye[t] = 0; }
#pragma unroll
        for (int r = 0; r < 8; ++r) {
            float bvv[TK]; int be[TK];
#pragma unroll
            for (int t = 0; t < TK; ++t) {
                bvv[t] = cand[t][0]; be[t] = lane;
#pragma unroll
                for (int j = 1; j < 4; ++j) if (cand[t][j] > bvv[t]) { bvv[t] = cand[t][j]; be[t] = j * 64 + lane; }
            }
#pragma unroll
            for (int o = 32; o > 0; o >>= 1)
#pragma unroll
                for (int t = 0; t < TK; ++t) {
                    const float ov = __shfl_xor(bvv[t], o, 64);
                    const int oe = __shfl_xor(be[t], o, 64);
                    if (ov > bvv[t] || (ov == bvv[t] && oe < be[t])) { bvv[t] = ov; be[t] = oe; }
                }
#pragma unroll
            for (int t = 0; t < TK; ++t) {
                const int bj = be[t] >> 6;
                const float mysc = bj == 0 ? sc[t][0] : (bj == 1 ? sc[t][1] : (bj == 2 ? sc[t][2] : sc[t][3]));
                const float sval = __shfl(mysc, be[t] & 63, 64);
#pragma unroll
                for (int j = 0; j < 4; ++j) if (be[t] == j * 64 + lane) cand[t][j] = -INFINITY;
                wsum[t] += sval;
                if (lane == r) { myw[t] = sval; mye[t] = be[t]; }
            }
        }
        if (lane < 8) {
#pragma unroll
            for (int t = 0; t < TK; ++t) {
                const int a = (tok0 + t) * 8 + lane;
                p.topi()[a] = mye[t];
                p.topw()[a] = myw[t] * (2.5f / wsum[t]);
            }
        }
    }
}

__device__ void ph_lists(const Params& p, char* smem) {
    const int tid = otid(), lane = tid & 63, wid = tid >> 6;
    int* wtot = (int*)smem;
    for (int e = blockIdx.x; e < NE; e += gridDim.x) {
        __syncthreads();
        const int4* src = (const int4*)p.topi() + wid * 4096;
        int cntw = 0;
        for (int i = 0; i < 64; ++i) {
            const int4 v = src[i * 64 + lane];
            cntw += __popcll(__ballot(v.x == e)) + __popcll(__ballot(v.y == e)) + __popcll(__ballot(v.z == e)) + __popcll(__ballot(v.w == e));
        }
        if (lane == 0) wtot[wid] = cntw;
        __syncthreads();
        int base = 0, tot = 0;
        for (int w = 0; w < 8; ++w) { const int c = wtot[w]; if (w < wid) base += c; tot += c; }
        if (tid == 0) p.cnt()[e] = tot;
        int* dst = p.list() + (size_t)e * T;
        const unsigned long long lt = (1ull << lane) - 1ull;
        for (int i = 0; i < 64; ++i) {
            const int4 v = src[i * 64 + lane];
            const int a0 = (wid * 4096 + i * 64 + lane) * 4;
            unsigned long long m;
            m = __ballot(v.x == e); if (v.x == e) dst[base + __popcll(m & lt)] = a0;     base += __popcll(m);
            m = __ballot(v.y == e); if (v.y == e) dst[base + __popcll(m & lt)] = a0 + 1; base += __popcll(m);
            m = __ballot(v.z == e); if (v.z == e) dst[base + __popcll(m & lt)] = a0 + 2; base += __popcll(m);
            m = __ballot(v.w == e); if (v.w == e) dst[base + __popcll(m & lt)] = a0 + 3; base += __popcll(m);
        }
    }
}

struct ExpMap { int* cnt; int* off; int* tile; };
__device__ __forceinline__ ExpMap exp_map(const Params& p, char* smem) {
    ExpMap m;
    m.cnt = (int*)(smem + 98304); m.off = m.cnt + 256; m.tile = m.off + 256;
    const int tid = otid();
    __syncthreads();
    if (tid < NE) m.cnt[tid] = p.cnt()[tid];
    __syncthreads();
    if (tid == 0) {
        int off = 0, tl = 0;
        for (int e = 0; e < NE; ++e) { m.off[e] = off; m.tile[e] = tl; const int c = m.cnt[e]; off += c; tl += (c + 255) >> 8; }
        m.tile[NE] = tl;
    }
    __syncthreads();
    return m;
}
__device__ __forceinline__ int find_expert(const int* tile, int rt) {
    int lo = 0, hi = NE;
    while (hi - lo > 1) { const int mid = (lo + hi) >> 1; if (tile[mid] <= rt) lo = mid; else hi = mid; }
    return lo;
}
#define ROWA(smem) ((int*)((smem) + 98304 + 3328))
#define ROWW(smem) ((float*)((smem) + 98304 + 3328 + 1024))

__device__ void ph_gateup(const Params& p, char* smem) {
    const int tid = otid(), lane = tid & 63, wid = tid >> 6, wr = wid >> 1, wc = wid & 1;
    const ExpMap em = exp_map(p, smem);
    int* rowA = ROWA(smem);
    const int ntile = em.tile[NE];
    const int U = (ntile + T / 256) * 2;
    const int xcd = blockIdx.x & 7, nbx = gridDim.x >> 3;
    const int lo = (int)(((long long)U * xcd) >> 3), hi = (int)(((long long)U * (xcd + 1)) >> 3);
    for (int u = lo + (blockIdx.x >> 3); u < hi; u += nbx) {
        const int rt = u >> 1, c0 = (u & 1) * 128;
        const float *Wg, *Wu;
        bf16_t* gdst;
        int nrow, tokv = -1;
        if (rt < ntile) {
            const int e = find_expert(em.tile, rt);
            const int r0 = (rt - em.tile[e]) * 256, ne = em.cnt[e];
            Wg = p.w_eg + (size_t)e * D * ED; Wu = p.w_eu + (size_t)e * D * ED;
            gdst = p.gbuf() + ((size_t)em.off[e] + r0) * ED + c0;
            nrow = ne - r0;
            if (tid < 256 && r0 + tid < ne) tokv = p.list()[(size_t)e * T + r0 + tid] >> 3;
        } else {
            const int tb = (rt - ntile) * 256;
            Wg = p.w_sg; Wu = p.w_su;
            gdst = p.gsh() + (size_t)tb * ED + c0;
            nrow = 256;
            tokv = tb + (tid & 255);
        }
        __syncthreads();
        if (tid < 256) rowA[tid] = tokv;
        __syncthreads();
        const int t0 = rowA[0];
        f32x4 acc[4][8];
        gemm3<0>(smem, D,
                 [&](int r) { const int t = rowA[r]; return p.h2() + (size_t)(t < 0 ? t0 : t) * 2048; },
                 [&](int n) { const int t16 = n >> 4; return ((t16 & 1) ? Wu : Wg) + c0 + 16 * (t16 >> 1) + (n & 15); },
                 ED, acc, nrow);
        if (wr * 64 < nrow) {
            char* wl = smem + wid * EPI_WAVE;
#pragma unroll
            for (int m = 0; m < 4; ++m) {
                const int rb = wr * 64 + m * 16;
                epi_bf16(wl, lane,
                         [&](int n, int j) { if (n >= 4) return 0.f; const float g = acc[m][2 * n][j], uu = acc[m][2 * n + 1][j]; return g / (1.f + __expf(-g)) * uu; },
                         [&](int row, int ch, u32x4 v) { if (ch < 8 && rb + row < nrow) *(u32x4*)(gdst + (size_t)(rb + row) * ED + wc * 64 + ch * 8) = v; });
            }
        }
    }
}

__device__ void ph_down(const Params& p, char* smem) {
    const int tid = otid(), lane = tid & 63, wid = tid >> 6, wr = wid >> 1, wc = wid & 1;
    const ExpMap em = exp_map(p, smem);
    int* rowA = ROWA(smem);
    float* rowW = ROWW(smem);
    const int ntile = em.tile[NE];
    const int U = (ntile + T / 256) * 4;
    const int xcd = blockIdx.x & 7, nbx = gridDim.x >> 3;
    const int lo = (int)(((long long)U * xcd) >> 3), hi = (int)(((long long)U * (xcd + 1)) >> 3);
    for (int u = lo + (blockIdx.x >> 3); u < hi; u += nbx) {
        const int rt = u >> 2, nt = u & 3;
        const bf16_t* A;
        const float* W;
        int nrow, slot = -1;
        float wv = 0.f;
        if (rt < ntile) {
            const int e = find_expert(em.tile, rt);
            const int r0 = (rt - em.tile[e]) * 256, ne = em.cnt[e];
            A = p.gbuf() + ((size_t)em.off[e] + r0) * ED;
            W = p.w_ed + (size_t)e * ED * D + nt * 256;
            nrow = ne - r0;
            if (tid < 256 && r0 + tid < ne) {
                const int a = p.list()[(size_t)e * T + r0 + tid];
                slot = (a >> 3) * 9 + (a & 7);
                wv = p.topw()[a];
            }
        } else {
            const int tb = (rt - ntile) * 256;
            A = p.gsh() + (size_t)tb * ED;
            W = p.w_sd + nt * 256;
            nrow = 256;
            slot = (tb + (tid & 255)) * 9 + 8;
            wv = 1.f;
        }
        __syncthreads();
        if (tid < 256) { rowA[tid] = slot; rowW[tid] = wv; }
        __syncthreads();
        f32x4 acc[4][8];
        gemm3<0>(smem, ED, [&](int r) { return A + (size_t)(r < nrow ? r : 0) * ED; }, [&](int n) { return W + n; }, D, acc, nrow);
        if (wr * 64 < nrow) {
            char* wl = smem + wid * EPI_WAVE;
#pragma unroll
            for (int m = 0; m < 4; ++m) {
                const int rb = wr * 64 + m * 16;
                float wj[4];
#pragma unroll
                for (int j = 0; j < 4; ++j) wj[j] = rowW[rb + (lane >> 4) * 4 + j];
                epi_bf16(wl, lane, [&](int n, int j) { return acc[m][n][j] * wj[j]; },
                         [&](int row, int ch, u32x4 v) {
                             const int sl = rowA[rb + row];
                             if (sl >= 0) *(u32x4*)(p.ybuf() + (size_t)sl * D + nt * 256 + wc * 128 + ch * 8) = v;
                         });
            }
        }
    }
}

__device__ void ph_final(const Params& p) {
    const int tid = otid(), lane = tid & 63, wid = tid >> 6;
    for (int row = blockIdx.x * 8 + wid; row < T; row += gridDim.x * 8) {
        const int b = row >> 12;
        const float* g2 = p.mod() + b * 6144 + 5120;
        float4 v[4];
        float s = 0.f;
#pragma unroll
        for (int i = 0; i < 4; ++i) {
            const int col = (lane + 64 * i) * 4;
            float f0 = 0.f, f1 = 0.f, f2 = 0.f, f3 = 0.f;
#pragma unroll
            for (int k = 0; k < 9; ++k) {
                const uint2 w = *(const uint2*)(p.ybuf() + ((size_t)row * 9 + k) * D + col);
                f0 += __uint_as_float(w.x << 16); f1 += __uint_as_float(w.x & 0xffff0000u);
                f2 += __uint_as_float(w.y << 16); f3 += __uint_as_float(w.y & 0xffff0000u);
            }
            float4 xv;
            { const uint2 xw = *(const uint2*)(p.x1() + (size_t)row * D + col);
              xv.x = __uint_as_float(xw.x << 16); xv.y = __uint_as_float(xw.x & 0xffff0000u); xv.z = __uint_as_float(xw.y << 16); xv.w = __uint_as_float(xw.y & 0xffff0000u); }
            const float4 g4 = *(const float4*)(g2 + col);
            v[i].x = ALPHA * xv.x + g4.x * f0; v[i].y = ALPHA * xv.y + g4.y * f1;
            v[i].z = ALPHA * xv.z + g4.z * f2; v[i].w = ALPHA * xv.w + g4.w * f3;
            s += v[i].x + v[i].y + v[i].z + v[i].w;
        }
        const float mean = wave_sum(s) * (1.f / D);
        float q = 0.f;
#pragma unroll
        for (int i = 0; i < 4; ++i) {
            v[i].x -= mean; v[i].y -= mean; v[i].z -= mean; v[i].w -= mean;
            q += v[i].x * v[i].x + v[i].y * v[i].y + v[i].z * v[i].z + v[i].w * v[i].w;
        }
        const float rstd = rsqrtf(wave_sum(q) * (1.f / D) + LN_EPS);
#pragma unroll
        for (int i = 0; i < 4; ++i) {
            const int col = (lane + 64 * i) * 4;
            const float4 g4 = *(const float4*)(p.ln2_g + col), b4 = *(const float4*)(p.ln2_b + col);
            float4 y;
            y.x = v[i].x * rstd * g4.x + b4.x; y.y = v[i].y * rstd * g4.y + b4.y;
            y.z = v[i].z * rstd * g4.z + b4.z; y.w = v[i].w * rstd * g4.w + b4.w;
            *(float4*)(p.out + (size_t)row * D + col) = y;
        }
    }
}

constexpr int LDS_BYTES = 2 * VB_LDS + 16;
constexpr int NPHASE = 14;

template <int PH>
__device__ __forceinline__ void run_phase(const Params& p, char* smem) {
    if (PH == 0) ph_mod(p, smem);
    if (PH == 1) ph_ln0(p);
    if (PH == 2) ph_inproj(p, smem);
    if (PH == 3) { ph_h1(p, smem); ph_attn(p, smem); }
    if (PH == 4) { ph_h2(p); ph_attn_merge(p); }
    if (PH == 5) ph_h3(p, smem);
    if (PH == 6) ph_outproj(p, smem);
    if (PH == 7) ph_ln1(p);
    if (PH == 8) ph_router_gemm(p, smem);
    if (PH == 9) ph_topk(p);
    if (PH == 10) ph_lists(p, smem);
    if (PH == 11) ph_gateup(p, smem);
    if (PH == 12) ph_down(p, smem);
    if (PH == 13) ph_final(p);
}

template <int PH>
__global__ void __launch_bounds__(NTHREADS, 2) k_phase(Params p) {
    extern __shared__ __attribute__((aligned(16))) char smem[];
    run_phase<PH>(p, smem);
}

__global__ void __launch_bounds__(NTHREADS, 2) k_all(Params p) {
    extern __shared__ __attribute__((aligned(16))) char smem[];
    volatile LAS unsigned* st = (volatile LAS unsigned*)(smem + LDS_BYTES - 16);
    if (threadIdx.x == 0) { st[0] = 0u; st[1] = 0u; st[2] = 0u; st[3] = 0u; }
    __syncthreads();
    XcdBarrier bar = xcd_barrier_post(p.bar(), st);
    run_phase<0>(p, smem); xcd_barrier(bar);
    run_phase<1>(p, smem); xcd_barrier(bar);
    run_phase<2>(p, smem); xcd_barrier(bar);
    run_phase<3>(p, smem); xcd_barrier(bar);
    run_phase<4>(p, smem); xcd_barrier(bar);
    run_phase<5>(p, smem); xcd_barrier(bar);
    run_phase<6>(p, smem); xcd_barrier(bar);
    run_phase<7>(p, smem); xcd_barrier(bar);
    run_phase<8>(p, smem); xcd_barrier(bar);
    run_phase<9>(p, smem); xcd_barrier(bar);
    run_phase<10>(p, smem); xcd_barrier(bar);
    run_phase<11>(p, smem); xcd_barrier(bar);
    run_phase<12>(p, smem); xcd_barrier(bar);
    run_phase<13>(p, smem);
}

template <int PH>
static void launch_phase(const Params& p, int grid, hipStream_t stream) {
    static bool attr = false;
    if (!attr) { (void)hipFuncSetAttribute((const void*)k_phase<PH>, hipFuncAttributeMaxDynamicSharedMemorySize, LDS_BYTES); attr = true; }
    hipLaunchKernelGGL(k_phase<PH>, dim3(grid), dim3(NTHREADS), LDS_BYTES, stream, p);
}

extern "C" void kernel_launch(void* const* d_in, const int* in_sizes, int n_in, void* d_out, int out_size, void* d_ws, size_t ws_size,
                              hipStream_t stream) {
    (void)in_sizes; (void)n_in; (void)out_size;
    Params p{};
    const float** pin = (const float**)&p.x;
    for (int i = 0; i < 21; ++i) pin[i] = (const float*)d_in[i];
    p.out = (float*)d_out;
    p.ws = (char*)d_ws;
    char* ctl = p.ws + WO_ctl;
    if (WS_END > ws_size) { fprintf(stderr, "kernel_launch: workspace too small: need %zu have %zu\n", (size_t)WS_END, ws_size); return; }

    static int grid = 0;
    if (grid == 0) {
        int dev = 0, cus = 0, per_cu = 0;
        (void)hipGetDevice(&dev);
        (void)hipDeviceGetAttribute(&cus, hipDeviceAttributeMultiprocessorCount, dev);
        (void)hipFuncSetAttribute((const void*)k_all, hipFuncAttributeMaxDynamicSharedMemorySize, LDS_BYTES);
        (void)hipOccupancyMaxActiveBlocksPerMultiprocessor(&per_cu, (const void*)k_all, NTHREADS, LDS_BYTES);
        grid = cus;
        if (grid != 256) grid = 256;
        fprintf(stderr, "kernel_launch: cus %d per_cu %d grid %d ws need %zu have %zu\n", cus, per_cu, grid, (size_t)WS_END, ws_size);
    }
    (void)hipMemsetAsync(ctl, 0, 65536, stream);
#if ONE_LAUNCH
    hipLaunchKernelGGL(k_all, dim3(grid), dim3(NTHREADS), LDS_BYTES, stream, p);
#else
    launch_phase<0>(p, grid, stream); launch_phase<1>(p, grid, stream); launch_phase<2>(p, grid, stream); launch_phase<3>(p, grid, stream);
    launch_phase<4>(p, grid, stream); launch_phase<5>(p, grid, stream); launch_phase<6>(p, grid, stream); launch_phase<7>(p, grid, stream);
    launch_phase<8>(p, grid, stream); launch_phase<9>(p, grid, stream); launch_phase<10>(p, grid, stream); launch_phase<11>(p, grid, stream);
    launch_phase<12>(p, grid, stream); launch_phase<13>(p, grid, stream);
#endif
}
```

```cpp
#include <hip/hip_runtime.h>
#include <stdint.h>
#include <stdio.h>

#ifndef ONE_LAUNCH
#define ONE_LAUNCH 1
#endif

constexpr int D = 1024, NBATCH = 4, S = 4096, T = NBATCH * S;
constexpr int INW = 4352;
constexpr int NE = 256, TOPK = 8, ED = 256;
constexpr int OFF_HQ = 0, OFF_HF = 512, OFF_HI = 1024, OFF_HG = 1536, OFF_AQ = 2048, OFF_AK = 2816, OFF_AV = 3584;
constexpr float ALPHA = 1.189207115002721f;
constexpr float LN_EPS = 1e-5f, RMS_EPS = 1e-6f;
constexpr int NTHREADS = 512;
constexpr int VB_LDS = 67584;

typedef unsigned short bf16_t;
using bf16x8 = __attribute__((ext_vector_type(8))) short;
using f32x4 = __attribute__((ext_vector_type(4))) float;
using u32x4 = __attribute__((ext_vector_type(4))) unsigned int;

typedef float v2f_t __attribute__((ext_vector_type(2)));
typedef __bf16 v2bf_t __attribute__((ext_vector_type(2)));
typedef short v4s __attribute__((ext_vector_type(4)));
__device__ __forceinline__ unsigned short f2bf(float f) { return __builtin_bit_cast(unsigned short, (__bf16)f); }
__device__ __forceinline__ float bf2f(unsigned short h) { return __uint_as_float(((uint32_t)h) << 16); }
__device__ __forceinline__ uint32_t pack2(float a, float b) {
    const v2f_t f = {a, b};
    return __builtin_bit_cast(uint32_t, __builtin_convertvector(f, v2bf_t));
}
__device__ __forceinline__ float sigmoidf_(float v) { return 1.f / (1.f + __expf(-v)); }

__device__ __forceinline__ int otid() { int t = threadIdx.x; asm volatile("" : "+v"(t)); return t; }

constexpr size_t al256(size_t x) { return (x + 255) & ~(size_t)255; }
constexpr size_t WO_ctl = 0;
constexpr size_t WO_mod = WO_ctl + al256(65536);
constexpr size_t WO_lbv = WO_mod + al256(4 * 6144 * 4);
constexpr size_t WO_biasT = WO_lbv + al256(512 * 4);
constexpr size_t WO_winT = WO_biasT + al256(3 * 129 * 4 * 4);
constexpr size_t WO_woutT = WO_winT + al256((size_t)INW * D * 2);
constexpr size_t WO_wrT = WO_woutT + al256((size_t)D * 768 * 2);
constexpr size_t WO_wsgT = WO_wrT + al256((size_t)2 * NE * D * 2);
constexpr size_t WO_wsuT = WO_wsgT + al256((size_t)ED * D * 2);
constexpr size_t WO_wsdT = WO_wsuT + al256((size_t)ED * D * 2);
constexpr size_t WO_h1 = WO_wsdT + al256((size_t)D * ED * 2);
constexpr size_t WO_proj = WO_h1 + al256((size_t)T * D * 2);
constexpr size_t WO_lgf = WO_proj + al256((size_t)T * INW * 2);
constexpr size_t WO_ao = WO_lgf + al256((size_t)T * 512 * 4);
constexpr size_t WO_alse = WO_ao + al256((size_t)3 * T * 256 * 4);
constexpr size_t WO_mixin = WO_alse + al256((size_t)3 * T * 4 * 4);
constexpr size_t WO_pre1 = WO_mixin + al256((size_t)T * 768 * 2);
constexpr size_t WO_x1 = WO_pre1 + al256((size_t)T * D * 4);
constexpr size_t WO_h2 = WO_x1 + al256((size_t)T * D * 2);
constexpr size_t WO_lgp = WO_h2 + al256((size_t)T * 2048 * 2);
constexpr size_t WO_topi = WO_lgp + al256((size_t)3 * T * NE * 4);
constexpr size_t WO_topw = WO_topi + al256((size_t)T * 8 * 4);
constexpr size_t WO_list = WO_topw + al256((size_t)T * 8 * 4);
constexpr size_t WO_gbuf = WO_list + al256((size_t)NE * T * 4);
constexpr size_t WO_gsh = WO_gbuf + al256((size_t)T * TOPK * ED * 2);
constexpr size_t WO_ybuf = WO_gsh + al256((size_t)T * ED * 2);
constexpr size_t WO_dec = WO_ybuf + al256((size_t)T * 9 * D * 2);
constexpr size_t WS_END = WO_dec + al256((size_t)1024 * 128 * 4);
struct Params {
    const float *x, *c, *w_ada, *b_ada, *w_in, *hg_lb, *hg_nw, *rel_bias, *w_out, *ln1_g, *ln1_b, *w_router, *router_bias,
        *w_eg, *w_eu, *w_ed, *w_sg, *w_su, *w_sd, *ln2_g, *ln2_b;
    float* out;
    char* ws;
    __device__ __forceinline__ unsigned* bar() const { return (unsigned*)(ws + WO_ctl); }
    __device__ __forceinline__ int* cnt() const { return (int*)(ws + WO_ctl + 16384); }
    __device__ __forceinline__ float* kv() const { return (float*)(ws + WO_ybuf); }
    __device__ __forceinline__ bf16_t* sst() const { return (bf16_t*)(ws + WO_ybuf + (size_t)1024 * 16384 * 4); }
    __device__ __forceinline__ float* mod() const { return (float*)(ws + WO_mod); }
    __device__ __forceinline__ float* lbv() const { return (float*)(ws + WO_lbv); }
    __device__ __forceinline__ float* biasT() const { return (float*)(ws + WO_biasT); }
    __device__ __forceinline__ bf16_t* winT() const { return (bf16_t*)(ws + WO_winT); }
    __device__ __forceinline__ bf16_t* woutT() const { return (bf16_t*)(ws + WO_woutT); }
    __device__ __forceinline__ bf16_t* wrT() const { return (bf16_t*)(ws + WO_wrT); }
    __device__ __forceinline__ bf16_t* wsgT() const { return (bf16_t*)(ws + WO_wsgT); }
    __device__ __forceinline__ bf16_t* wsuT() const { return (bf16_t*)(ws + WO_wsuT); }
    __device__ __forceinline__ bf16_t* wsdT() const { return (bf16_t*)(ws + WO_wsdT); }
    __device__ __forceinline__ bf16_t* h1() const { return (bf16_t*)(ws + WO_h1); }
    __device__ __forceinline__ bf16_t* proj() const { return (bf16_t*)(ws + WO_proj); }
    __device__ __forceinline__ float* lgf() const { return (float*)(ws + WO_lgf); }
    __device__ __forceinline__ float* ao() const { return (float*)(ws + WO_ao); }
    __device__ __forceinline__ float* alse() const { return (float*)(ws + WO_alse); }
    __device__ __forceinline__ bf16_t* mixin() const { return (bf16_t*)(ws + WO_mixin); }
    __device__ __forceinline__ float* pre1() const { return (float*)(ws + WO_pre1); }
    __device__ __forceinline__ bf16_t* x1() const { return (bf16_t*)(ws + WO_x1); }
    __device__ __forceinline__ bf16_t* h2() const { return (bf16_t*)(ws + WO_h2); }
    __device__ __forceinline__ float* lgp() const { return (float*)(ws + WO_lgp); }
    __device__ __forceinline__ int* topi() const { return (int*)(ws + WO_topi); }
    __device__ __forceinline__ float* topw() const { return (float*)(ws + WO_topw); }
    __device__ __forceinline__ int* list() const { return (int*)(ws + WO_list); }
    __device__ __forceinline__ bf16_t* gbuf() const { return (bf16_t*)(ws + WO_gbuf); }
    __device__ __forceinline__ bf16_t* gsh() const { return (bf16_t*)(ws + WO_gsh); }
    __device__ __forceinline__ bf16_t* ybuf() const { return (bf16_t*)(ws + WO_ybuf); }
    __device__ __forceinline__ float* dec() const { return (float*)(ws + WO_dec); }
};

#define XB_TMO      128
#define XB_XCNT(j)  (256  + 64 * (j))
#define XB_XSUB(j)  (1280 + 64 * (j))
#define XB_XGEN(j)  (2304 + 64 * (j))
#define XB_TOP      3328
#define XB_TOPGEN   3392
#define XCD_BAR_WORDS 3456
#define XB_SPIN_CAP (1u << 18)
#define LAS __attribute__((address_space(3)))

__device__ __forceinline__ unsigned xb_ld(unsigned* p)              { return __hip_atomic_load(p, __ATOMIC_RELAXED, __HIP_MEMORY_SCOPE_AGENT); }
__device__ __forceinline__ unsigned xb_add(unsigned* p, unsigned v) { return __hip_atomic_fetch_add(p, v, __ATOMIC_RELAXED, __HIP_MEMORY_SCOPE_AGENT); }
__device__ __forceinline__ unsigned xb_xcc_id() { return (unsigned)__builtin_amdgcn_s_getreg((3 << 11) | 20) & 0xFu; }
#define XB_SPIN(cond, bar) do { unsigned _sp = 0; while (cond) { __builtin_amdgcn_s_sleep(1); \
    if ((++_sp & 255u) == 0u) { if (xb_ld(&(bar)[XB_TMO])) break; if (_sp > XB_SPIN_CAP) { atomicAdd(&(bar)[XB_TMO], 1u); break; } } } } while (0)

struct XcdBarrier {
    unsigned* bar; unsigned x;
    volatile LAS unsigned* st;
};
__device__ __forceinline__ XcdBarrier xcd_barrier_post(unsigned* bar, volatile LAS unsigned* st) {
    XcdBarrier b; b.bar = bar; b.x = xb_xcc_id(); b.st = st;
    if (threadIdx.x == 0) (void)xb_add(&bar[XB_XCNT(b.x)], 1u);
    return b;
}
__device__ __forceinline__ void xcd_barrier_complete(unsigned* bar, unsigned x, unsigned& nloc, unsigned& nx) {
    const unsigned G = gridDim.x * gridDim.y * gridDim.z;
    unsigned sum, cnt, mine, sp = 0u;
    for (;;) {
        sum = 0u; cnt = 0u; mine = 0u;
#pragma unroll
        for (unsigned j = 0; j < 16; ++j) { const unsigned c = xb_ld(&bar[XB_XCNT(j)]); sum += c; cnt += (c > 0u) ? 1u : 0u; mine = (j == x) ? c : mine; }
        if (sum == G) break;
        __builtin_amdgcn_s_sleep(1);
        if ((++sp & 255u) == 0u) { if (xb_ld(&bar[XB_TMO])) break; if (sp > XB_SPIN_CAP) { atomicAdd(&bar[XB_TMO], 1u); break; } }
    }
    nloc = mine > 0u ? mine : 1u; nx = cnt > 0u ? cnt : 1u;
}
__device__ __forceinline__ void xcd_barrier(const XcdBarrier& b) {
    asm volatile("s_waitcnt vmcnt(0)" ::: "memory");
    __syncthreads();
    if (threadIdx.x == 0) {
        unsigned* bar = b.bar;
        __builtin_amdgcn_s_waitcnt(0);
        unsigned nloc = b.st[0], nx = b.st[1];
        if (nloc == 0u) { xcd_barrier_complete(bar, b.x, nloc, nx); b.st[0] = nloc; b.st[1] = nx; }
        const unsigned old = xb_add(&bar[XB_XSUB(b.x)], 1u);
        const unsigned gen = old / nloc;
        if (old + 1u == (gen + 1u) * nloc) {
            __builtin_amdgcn_fence(__ATOMIC_RELEASE, "agent");
            asm volatile("s_waitcnt vmcnt(0)" ::: "memory");
            const unsigned og = xb_add(&bar[XB_TOP], 1u);
            const unsigned tg = og / nx;
            if (og + 1u == (tg + 1u) * nx) xb_add(&bar[XB_TOPGEN], 1u);
            else XB_SPIN(xb_ld(&bar[XB_TOPGEN]) == tg, bar);
            __builtin_amdgcn_fence(__ATOMIC_ACQUIRE, "agent");
            xb_add(&bar[XB_XGEN(b.x)], 1u);
            asm volatile("s_waitcnt vmcnt(0)" ::: "memory");
        } else {
            XB_SPIN(xb_ld(&bar[XB_XGEN(b.x)]) == gen, bar);
            __builtin_amdgcn_fence(__ATOMIC_ACQUIRE, "agent");
            asm volatile("s_waitcnt vmcnt(0)" ::: "memory");
        }
    }
    __syncthreads();
}

struct VB { int vb, nvb, tid; char* smem; };
__device__ __forceinline__ VB make_vb(char* smem) {
    const int t = otid();
    VB v; v.vb = (int)blockIdx.x * 2 + (t >> 8); v.nvb = (int)gridDim.x * 2; v.tid = t & 255; v.smem = smem + (t >> 8) * VB_LDS;
    return v;
}
__device__ __forceinline__ int swz(int row, int chunk) { return row * 128 + ((chunk ^ ((row >> 1) & 7)) << 4); }

__device__ __forceinline__ float wave_sum(float v) {
#pragma unroll
    for (int o = 32; o > 0; o >>= 1) v += __shfl_xor(v, o, 64);
    return v;
}

__device__ __forceinline__ int t5_bucket(int n) {
    if (n < 16) return n;
    const float v = logf((float)n / 16.f) / logf(128.f) * 16.f;
    int large = 16 + (int)v;
    return large < 31 ? large : 31;
}

__device__ __forceinline__ void tr_tile(const VB& v, const float* src, int ld, bf16_t* dst, bf16_t* dst2, int ldd, int k0, int n0) {
    float* t = (float*)v.smem;
    __syncthreads();
#pragma unroll
    for (int i = 0; i < 4; ++i) {
        const int r = (v.tid >> 4) + 16 * i, c4 = v.tid & 15;
        const f32x4 x = *(const f32x4*)(src + (size_t)(k0 + r) * ld + n0 + c4 * 4);
        t[r * 65 + c4 * 4 + 0] = x[0]; t[r * 65 + c4 * 4 + 1] = x[1]; t[r * 65 + c4 * 4 + 2] = x[2]; t[r * 65 + c4 * 4 + 3] = x[3];
    }
    __syncthreads();
    const int n = v.tid >> 2, kq = v.tid & 3;
    float f[16];
#pragma unroll
    for (int i = 0; i < 16; ++i) f[i] = t[(kq * 16 + i) * 65 + n];
    u32x4 a, b;
    a[0] = pack2(f[0], f[1]); a[1] = pack2(f[2], f[3]); a[2] = pack2(f[4], f[5]); a[3] = pack2(f[6], f[7]);
    b[0] = pack2(f[8], f[9]); b[1] = pack2(f[10], f[11]); b[2] = pack2(f[12], f[13]); b[3] = pack2(f[14], f[15]);
    bf16_t* d = dst + (size_t)(n0 + n) * ldd + k0 + kq * 16;
    *(u32x4*)d = a; *(u32x4*)(d + 8) = b;
    if (dst2) {
        u32x4 c, e;
#pragma unroll
        for (int i = 0; i < 4; ++i) {
            c[i] = pack2(f[2 * i] - __uint_as_float(a[i] << 16), f[2 * i + 1] - __uint_as_float(a[i] & 0xffff0000u));
            e[i] = pack2(f[8 + 2 * i] - __uint_as_float(b[i] << 16), f[8 + 2 * i + 1] - __uint_as_float(b[i] & 0xffff0000u));
        }
        bf16_t* d2 = dst2 + (size_t)(n0 + n) * ldd + k0 + kq * 16;
        *(u32x4*)d2 = c; *(u32x4*)(d2 + 8) = e;
    }
}

__device__ void ph_mod(const Params& p, char* smem0) {
    const VB v = make_vb(smem0);
    const int tid = v.tid;
    float* cond = (float*)(v.smem + 20480);
    float* red = cond + 4096;
    for (int i = tid; i < 4096; i += 256) { const float x = p.c[i]; cond[i] = x / (1.f + __expf(-x)); }
    __syncthreads();
    const int NU = 194 + 1088 + 192 + 64 + 64 + 64 + 64;
    const int rounds = (NU + v.nvb - 1) / v.nvb;
    for (int it = 0; it < rounds; ++it) {
        int u = v.vb + it * v.nvb;
        if (u >= NU) u = NU - 1;
        if (u < 192) {
            const int c4 = tid & 7, kq = tid >> 3;
            f32x4 a0 = {0.f, 0.f, 0.f, 0.f}, a1 = a0, a2 = a0, a3 = a0;
            const float* wp = p.w_ada + u * 32 + c4 * 4;
#pragma unroll 8
            for (int k = kq; k < 1024; k += 32) {
                const f32x4 w = *(const f32x4*)(wp + (size_t)k * 6144);
                a0 += cond[k] * w; a1 += cond[1024 + k] * w; a2 += cond[2048 + k] * w; a3 += cond[3072 + k] * w;
            }
            *(f32x4*)(red + (kq * 4 + 0) * 32 + c4 * 4) = a0; *(f32x4*)(red + (kq * 4 + 1) * 32 + c4 * 4) = a1;
            *(f32x4*)(red + (kq * 4 + 2) * 32 + c4 * 4) = a2; *(f32x4*)(red + (kq * 4 + 3) * 32 + c4 * 4) = a3;
        }
        __syncthreads();
        if (u < 192) {
            if (tid < 128) {
                const int b = tid >> 5, c2 = tid & 31;
                float s = 0.f;
                for (int q = 0; q < 32; ++q) s += red[(q * 4 + b) * 32 + c2];
                p.mod()[b * 6144 + u * 32 + c2] = s + p.b_ada[u * 32 + c2];
            }
        } else if (u == 192) {
            for (int j = tid; j < 512; j += 256) {
                const float a = p.hg_lb[j], b = p.hg_lb[512 + j];
                const float m = fmaxf(a, b);
                const float ea = expf(a - m), eb = expf(b - m);
                p.lbv()[j] = ea / (ea + eb);
            }
        } else if (u == 193) {
            for (int i = tid; i < 3 * 129 * 4; i += 256) {
                const int g = i / (129 * 4), m = (i >> 2) % 129, hh = i & 3;
                const int dil = (g == 0) ? 1 : (g == 1 ? 4 : 16);
                p.biasT()[i] = p.rel_bias[t5_bucket(m * dil) * 12 + g * 4 + hh];
            }
        }
        {
            int w = u - 194;
            const float* src = p.w_out; int ld = D; bf16_t* dst = p.woutT(); bf16_t* dst2 = nullptr; int ldd = 768, k0 = 0, n0 = 0;
            if (w >= 0) {
                if (w < 1088) { src = p.w_in; ld = INW; dst = p.winT(); ldd = D; k0 = (w / 68) * 64; n0 = (w % 68) * 64; }
                else if ((w -= 1088) < 192) { k0 = (w >> 4) * 64; n0 = (w & 15) * 64; }
                else if ((w -= 192) < 64) { src = p.w_router; ld = NE; dst = p.wrT(); dst2 = p.wrT() + (size_t)NE * D; ldd = D; k0 = (w >> 2) * 64; n0 = (w & 3) * 64; }
                else if ((w -= 64) < 64) { src = p.w_sg; ld = ED; dst = p.wsgT(); ldd = D; k0 = (w >> 2) * 64; n0 = (w & 3) * 64; }
                else if ((w -= 64) < 64) { src = p.w_su; ld = ED; dst = p.wsuT(); ldd = D; k0 = (w >> 2) * 64; n0 = (w & 3) * 64; }
                else { w -= 64; src = p.w_sd; ld = D; dst = p.wsdT(); ldd = ED; k0 = (w >> 4) * 64; n0 = (w & 15) * 64; }
            }
            tr_tile(v, src, ld, dst, dst2, ldd, k0, n0);
        }
    }
}

__device__ void ph_ln0(const Params& p) {
    const int tid = otid(), lane = tid & 63, wid = tid >> 6;
    const int rstride = gridDim.x * 8;
    float4 nv[4];
    {
        const float4* xr = (const float4*)(p.x + (size_t)(blockIdx.x * 8 + wid) * D);
#pragma unroll
        for (int i = 0; i < 4; ++i) nv[i] = xr[lane + 64 * i];
    }
    for (int row = blockIdx.x * 8 + wid; row < T; row += rstride) {
        float4 v[4];
        float s = 0.f;
#pragma unroll
        for (int i = 0; i < 4; ++i) { v[i] = nv[i]; s += v[i].x + v[i].y + v[i].z + v[i].w; }
        if (row + rstride < T) {
            const float4* xn = (const float4*)(p.x + (size_t)(row + rstride) * D);
#pragma unroll
            for (int i = 0; i < 4; ++i) nv[i] = xn[lane + 64 * i];
        }
        const float mean = wave_sum(s) * (1.f / D);
        float q = 0.f;
#pragma unroll
        for (int i = 0; i < 4; ++i) {
            v[i].x -= mean; v[i].y -= mean; v[i].z -= mean; v[i].w -= mean;
            q += v[i].x * v[i].x + v[i].y * v[i].y + v[i].z * v[i].z + v[i].w * v[i].w;
        }
        const float rstd = rsqrtf(wave_sum(q) * (1.f / D) + LN_EPS);
        const int b = row >> 12;
        const float* sh = p.mod() + b * 6144;
        const float* sc = sh + 1024;
#pragma unroll
        for (int i = 0; i < 4; ++i) {
            const int col = (lane + 64 * i) * 4;
            const float4 s4 = *(const float4*)(sc + col), h4 = *(const float4*)(sh + col);
            uint2 o;
            o.x = pack2(v[i].x * rstd * (1.f + s4.x) + h4.x, v[i].y * rstd * (1.f + s4.y) + h4.y);
            o.y = pack2(v[i].z * rstd * (1.f + s4.z) + h4.z, v[i].w * rstd * (1.f + s4.w) + h4.w);
            *(uint2*)(p.h1() + (size_t)row * D + col) = o;
        }
    }
}

__device__ __forceinline__ int swz16(int row, int chunk) { return row * 256 + ((chunk ^ (row & 15)) << 4); }
struct TrBase { int lo, hi; };
__device__ __forceinline__ TrBase tr16_base(int lane) {
    const int g = lane >> 4, q = (lane & 15) >> 2, pp = lane & 3;
    const int xl = 8 * (g & 1) + q, h = pp >> 1;
    TrBase t;
    t.lo = (8 * g + q) * 256 + ((xl >> 1) << 5) + ((h ^ (xl & 1)) << 4) + 8 * (pp & 1);
    t.hi = (t.lo + 1024) ^ 64;
    return t;
}
__device__ __forceinline__ bf16x8 tr_frag16(const char* tile, const TrBase& tb, int ks, int c) {
    int cx = c << 5;
    asm volatile("" : "+v"(cx));
    const v4s lo = __builtin_amdgcn_ds_read_tr16_b64_v4i16((LAS v4s*)(tile + ks * 8192 + (tb.lo ^ cx)));
    const v4s hi = __builtin_amdgcn_ds_read_tr16_b64_v4i16((LAS v4s*)(tile + ks * 8192 + (tb.hi ^ cx)));
    return bf16x8{lo[0], lo[1], lo[2], lo[3], hi[0], hi[1], hi[2], hi[3]};
}


__device__ __forceinline__ int aoff(int row, int chunk) { return row * 64 + ((chunk ^ ((row >> 2) & 3)) << 4); }
__device__ __forceinline__ int boff(int row, int chunk) { return row * 512 + ((chunk ^ (((row & 3) << 1) | (((row >> 3) & 1) << 3))) << 4); }
__device__ __forceinline__ bf16x8 tr_pair(const char* p) {
    const v4s lo = __builtin_amdgcn_ds_read_tr16_b64_v4i16((LAS v4s*)(p));
    const v4s hi = __builtin_amdgcn_ds_read_tr16_b64_v4i16((LAS v4s*)(p + 2048));
    return bf16x8{lo[0], lo[1], lo[2], lo[3], hi[0], hi[1], hi[2], hi[3]};
}
constexpr int G3_STAGE = 32768;

template <int BMODE, class AF, class BF>
__device__ __forceinline__ void gemm3(char* smem, const int K, AF arow, BF bsrc, const int ldb, f32x4 (&acc)[4][8], const int nvalid = 256) {
    const int tid = otid(), lane = tid & 63, wid = tid >> 6, wr = wid >> 1, wc = wid & 1, fr = lane & 15, fq = lane >> 4;
    const bf16_t* ap[2];
#pragma unroll
    for (int i = 0; i < 2; ++i) ap[i] = arow((tid >> 2) + 128 * i) + (tid & 3) * 8;
    const float* bpf = nullptr;
    const bf16_t* bpb[2] = {nullptr, nullptr};
    if (BMODE == 0) bpf = (const float*)bsrc((tid & 63) * 4) + (size_t)(tid >> 6) * ldb;
    else {
#pragma unroll
        for (int i = 0; i < 2; ++i) bpb[i] = (const bf16_t*)bsrc((tid >> 2) + 128 * i) + (tid & 3) * 8;
    }
#pragma unroll
    for (int m = 0; m < 4; ++m)
#pragma unroll
        for (int n = 0; n < 8; ++n) acc[m][n] = f32x4{0.f, 0.f, 0.f, 0.f};
    const int trbase = (8 * fq + (fr >> 2)) * 512 + wc * 256 + (((fr >> 2) | ((fq & 1) << 2)) << 5) + ((fr & 3) >> 1) * 16 + (fr & 1) * 8;
    u32x4 ra0[2], ra1[2];
    f32x4 rf0[4], rf1[4];
    u32x4 rb0[2], rb1[2];
    const bool active = wr * 64 < nvalid;
#define G3_GLOAD(RA, RF, RB, k0) do { \
        _Pragma("unroll") for (int i = 0; i < 2; ++i) RA[i] = *(const u32x4*)(ap[i] + (k0)); \
        if (BMODE == 0) { _Pragma("unroll") for (int j = 0; j < 4; ++j) RF[j] = *(const f32x4*)(bpf + (size_t)((k0) + 8 * j) * ldb); } \
        else { _Pragma("unroll") for (int i = 0; i < 2; ++i) RB[i] = *(const u32x4*)(bpb[i] + (k0)); } } while (0)
#define G3_LWRITE(RA, RF, RB, st) do { \
        char* sA_ = (st); char* sB_ = (st) + 16384; \
        _Pragma("unroll") for (int i = 0; i < 2; ++i) *(u32x4*)(sA_ + aoff((tid >> 2) + 128 * i, tid & 3)) = RA[i]; \
        if (BMODE == 0) { _Pragma("unroll") for (int j = 0; j < 4; ++j) { uint2 w_; w_.x = pack2(RF[j][0], RF[j][1]); w_.y = pack2(RF[j][2], RF[j][3]); \
                *(uint2*)(sB_ + boff((tid >> 6) + 8 * j, (tid & 63) >> 1) + (tid & 1) * 8) = w_; } } \
        else { _Pragma("unroll") for (int i = 0; i < 2; ++i) *(u32x4*)(sB_ + aoff((tid >> 2) + 128 * i, tid & 3)) = RB[i]; } } while (0)
#define G3_COMPUTE(st) do { if (active) { \
        const char* sA_ = (st); const char* sB_ = (st) + 16384; \
        bf16x8 af[4]; \
        _Pragma("unroll") for (int m = 0; m < 4; ++m) af[m] = *(const bf16x8*)(sA_ + aoff(wr * 64 + m * 16 + fr, fq)); \
        _Pragma("unroll") for (int n = 0; n < 8; ++n) { \
            bf16x8 bfr; \
            if (BMODE == 0) bfr = tr_pair(sB_ + (trbase ^ (n << 5))); else bfr = *(const bf16x8*)(sB_ + aoff(wc * 128 + n * 16 + fr, fq)); \
            _Pragma("unroll") for (int m = 0; m < 4; ++m) acc[m][n] = __builtin_amdgcn_mfma_f32_16x16x32_bf16(af[m], bfr, acc[m][n], 0, 0, 0); } } } while (0)
    const int nk = K >> 5;
    char* st0 = smem;
    char* st1 = smem + G3_STAGE;
    G3_GLOAD(ra0, rf0, rb0, 0);
    G3_GLOAD(ra1, rf1, rb1, 32);
    G3_LWRITE(ra0, rf0, rb0, st0);
    if (nk > 2) G3_GLOAD(ra0, rf0, rb0, 64);
    __syncthreads();
    for (int kt = 0; kt < nk; kt += 2) {
        G3_LWRITE(ra1, rf1, rb1, st1);
        if (kt + 3 < nk) G3_GLOAD(ra1, rf1, rb1, (kt + 3) * 32);
        G3_COMPUTE(st0);
        __syncthreads();
        if (kt + 2 < nk) G3_LWRITE(ra0, rf0, rb0, st0);
        if (kt + 4 < nk) G3_GLOAD(ra0, rf0, rb0, (kt + 4) * 32);
        G3_COMPUTE(st1);
        __syncthreads();
    }
#undef G3_GLOAD
#undef G3_LWRITE
#undef G3_COMPUTE
}

template <class AF, class BF>
__device__ __forceinline__ void gemm4(char* smem, const int K, AF arow, BF brow, f32x4 (&acc)[4][8]) {
    const int tid = otid(), lane = tid & 63, wid = tid >> 6, wr = wid >> 1, wc = wid & 1, fr = lane & 15, fq = lane >> 4;
    const bf16_t* ga[2];
    const bf16_t* gb[2];
#pragma unroll
    for (int i = 0; i < 2; ++i) {
        const int r = 16 * (wid + 8 * i) + (lane >> 2), sc = ((lane & 3) ^ ((r >> 2) & 3)) * 8;
        ga[i] = arow(r) + sc;
        gb[i] = brow(r) + sc;
    }
#pragma unroll
    for (int m = 0; m < 4; ++m)
#pragma unroll
        for (int n = 0; n < 8; ++n) acc[m][n] = f32x4{0.f, 0.f, 0.f, 0.f};
    char* ldst = smem + wid * 1024 + lane * 16;
#define G4_ISSUE(slot, k0) do { \
        char* d_ = ldst + (slot) * 32768; \
        __builtin_amdgcn_global_load_lds((const unsigned*)(ga[0] + (k0)), (LAS unsigned*)(d_), 16, 0, 0); \
        __builtin_amdgcn_global_load_lds((const unsigned*)(ga[1] + (k0)), (LAS unsigned*)(d_ + 8192), 16, 0, 0); \
        __builtin_amdgcn_global_load_lds((const unsigned*)(gb[0] + (k0)), (LAS unsigned*)(d_ + 16384), 16, 0, 0); \
        __builtin_amdgcn_global_load_lds((const unsigned*)(gb[1] + (k0)), (LAS unsigned*)(d_ + 16384 + 8192), 16, 0, 0); } while (0)
    const int nk = K >> 5;
    G4_ISSUE(0, 0);
    G4_ISSUE(1, 32);
    int slot = 0, slot2 = 2;
    for (int kt = 0; kt < nk; ++kt) {
        if (kt + 1 < nk) asm volatile("s_waitcnt vmcnt(4)" ::: "memory");
        else asm volatile("s_waitcnt vmcnt(0)" ::: "memory");
        __builtin_amdgcn_s_barrier();
        if (kt + 2 < nk) G4_ISSUE(slot2, (kt + 2) * 32);
        const char* sA_ = smem + slot * 32768;
        const char* sB_ = sA_ + 16384;
        bf16x8 af[4];
#pragma unroll
        for (int m = 0; m < 4; ++m) af[m] = *(const bf16x8*)(sA_ + aoff(wr * 64 + m * 16 + fr, fq));
#pragma unroll
        for (int n = 0; n < 8; ++n) {
            const bf16x8 bfr = *(const bf16x8*)(sB_ + aoff(wc * 128 + n * 16 + fr, fq));
#pragma unroll
            for (int m = 0; m < 4; ++m) acc[m][n] = __builtin_amdgcn_mfma_f32_16x16x32_bf16(af[m], bfr, acc[m][n], 0, 0, 0);
        }
        slot = (slot == 2) ? 0 : slot + 1;
        slot2 = (slot2 == 2) ? 0 : slot2 + 1;
    }
#undef G4_ISSUE
    __syncthreads();
}


constexpr int EPI_WAVE = 8704;
template <class VF, class SF>
__device__ __forceinline__ void epi_bf16(char* wl, const int lane, VF val, SF store) {
    const int fr = lane & 15, fq = lane >> 4, odd = lane & 1;
#pragma unroll
    for (int n = 0; n < 8; ++n)
#pragma unroll
        for (int jp = 0; jp < 2; ++jp) {
            const float a = val(n, 2 * jp), b = val(n, 2 * jp + 1);
            const float x = odd ? a : b;
            const float y = __shfl_xor(x, 1, 64);
            const uint32_t w = odd ? pack2(y, b) : pack2(a, y);
            *(uint32_t*)(wl + (fq * 4 + 2 * jp + odd) * 272 + (n * 16 + (fr & ~1)) * 2) = w;
        }
    int ln = lane;
    asm volatile("" : "+v"(ln));
#pragma unroll
    for (int i = 0; i < 4; ++i) {
        const int idx = ln + 64 * i, row = idx >> 4, ch = idx & 15;
        store(row, ch, *(const u32x4*)(wl + row * 272 + ch * 16));
    }
}
template <class VF, class SF>
__device__ __forceinline__ void epi_f32(char* wl, const int lane, VF val, SF store) {
    const int fr = lane & 15, fq = lane >> 4;
#pragma unroll
    for (int n = 0; n < 8; ++n)
#pragma unroll
        for (int j = 0; j < 4; ++j) *(float*)(wl + (fq * 4 + j) * 528 + (n * 16 + fr) * 4) = val(n, j);
    int ln = lane;
    asm volatile("" : "+v"(ln));
#pragma unroll
    for (int i = 0; i < 8; ++i) {
        const int idx = ln + 64 * i, row = idx >> 5, ch = idx & 31;
        store(row, ch, *(const f32x4*)(wl + row * 528 + ch * 16));
    }
}

__device__ void ph_inproj(const Params& p, char* smem) {
    const int tid = otid(), lane = tid & 63, wid = tid >> 6, wr = wid >> 1, wc = wid & 1, fr = lane & 15;
    const int NTN = INW / 256;
    const int xcd = blockIdx.x & 7, nbx = gridDim.x >> 3;
    for (int i = blockIdx.x >> 3; i < 8 * NTN; i += nbx) {
        const int nt = i >> 3, mt = xcd * 8 + (i & 7);
        const bf16_t* A = p.h1() + (size_t)mt * 256 * D;
        const bf16_t* Bt = p.winT() + (size_t)nt * 256 * D;
        f32x4 acc[4][8];
        __syncthreads();
        gemm4(smem, D, [&](int r) { return A + (size_t)r * D; }, [&](int n) { return Bt + (size_t)n * D; }, acc);
        char* wl = smem + wid * EPI_WAVE;
        const int colb = nt * 256 + wc * 128;
        const int rowb = mt * 256 + wr * 64;
        if (colb >= OFF_HF && colb < OFF_HI) {
            float lbc[8];
#pragma unroll
            for (int n = 0; n < 8; ++n) lbc[n] = p.lbv()[colb - OFF_HF + n * 16 + fr];
#pragma unroll
            for (int m = 0; m < 4; ++m) {
                float* dst = p.lgf() + (size_t)(rowb + m * 16) * 512 + (colb - OFF_HF);
                epi_f32(wl, lane,
                        [&](int n, int j) { return logf(lbc[n] + (1.f - lbc[n]) * (1.f / (1.f + expf(-acc[m][n][j])))); },
                        [&](int row, int ch, f32x4 v) { *(f32x4*)(dst + (size_t)row * 512 + ch * 4) = v; });
            }
        } else {
#pragma unroll
            for (int m = 0; m < 4; ++m) {
                bf16_t* dst = p.proj() + (size_t)(rowb + m * 16) * INW + colb;
                epi_bf16(wl, lane, [&](int n, int j) { return acc[m][n][j]; },
                         [&](int row, int ch, u32x4 v) { *(u32x4*)(dst + (size_t)row * INW + ch * 8) = v; });
            }
        }
    }
}

__device__ void ph_h1(const Params& p, char* smem0) {
    const VB vbk = make_vb(smem0);
    char* smem = vbk.smem;
    const int tid = vbk.tid, lane = tid & 63, wid = tid >> 6, wr = wid >> 1, wc = wid & 1, fr = lane & 15, fq = lane >> 4;
    char* sI = smem;
    char* sK = smem + 16384;
    float* sL = (float*)(smem + 32768);
    float* totS = (float*)(smem + 65536);
    const int d = tid & 127, half = tid >> 7;
    const TrBase trb = tr16_base(lane);
    for (int u = vbk.vb; u < 1024; u += vbk.nvb) {
        const int bh = u >> 6, c = u & 63, b = bh >> 2, h = bh & 3;
        const size_t row0 = (size_t)b * S + c * 64;
        __syncthreads();
#pragma unroll
        for (int i = 0; i < 4; ++i) {
            const int idx = tid + 256 * i, r = idx >> 4, ch = idx & 15;
            *(u32x4*)(sI + swz16(r, ch)) = *(const u32x4*)(p.proj() + (row0 + r) * INW + OFF_HI + h * 128 + ch * 8);
        }
#pragma unroll
        for (int i = 0; i < 8; ++i) {
            const int idx = tid + 256 * i, r = idx >> 5, c4 = idx & 31;
            *(f32x4*)(sL + r * 128 + c4 * 4) = *(const f32x4*)(p.lgf() + (row0 + r) * 512 + h * 128 + c4 * 4);
        }
        __syncthreads();
        const float* lcol = sL + half * 32 * 128 + d;
        float tot = 0.f;
#pragma unroll
        for (int s = 0; s < 32; ++s) tot += lcol[s * 128];
        totS[half * 128 + d] = tot;
        __syncthreads();
        const float t0 = totS[d], bl = t0 + totS[128 + d];
        float run = half ? t0 : 0.f;
#pragma unroll 8
        for (int s = 0; s < 32; ++s) {
            const float lv = lcol[s * 128];
            run += lv;
            const float kt = (1.f - __expf(lv)) * __expf(bl - run);
            *(bf16_t*)(sK + swz16(half * 32 + s, d >> 3) + (d & 7) * 2) = f2bf(kt);
        }
        if (half == 0) p.dec()[u * 128 + d] = __expf(bl);
        __syncthreads();
        f32x4 acc[4][4];
#pragma unroll
        for (int m = 0; m < 4; ++m)
#pragma unroll
            for (int n = 0; n < 4; ++n) acc[m][n] = f32x4{0.f, 0.f, 0.f, 0.f};
#pragma unroll
        for (int ks = 0; ks < 2; ++ks) {
            bf16x8 af[4], bfr[4];
#pragma unroll
            for (int m = 0; m < 4; ++m) af[m] = tr_frag16(sI, trb, ks, wr * 4 + m);
#pragma unroll
            for (int n = 0; n < 4; ++n) bfr[n] = tr_frag16(sK, trb, ks, wc * 4 + n);
#pragma unroll
            for (int m = 0; m < 4; ++m)
#pragma unroll
                for (int n = 0; n < 4; ++n) acc[m][n] = __builtin_amdgcn_mfma_f32_16x16x32_bf16(af[m], bfr[n], acc[m][n], 0, 0, 0);
        }
        float* kvu = p.kv() + (size_t)u * 16384;
#pragma unroll
        for (int m = 0; m < 4; ++m)
#pragma unroll
            for (int n = 0; n < 4; ++n)
#pragma unroll
                for (int j = 0; j < 4; ++j) kvu[(wr * 64 + m * 16 + fq * 4 + j) * 128 + wc * 64 + n * 16 + fr] = acc[m][n][j];
    }
}

__device__ void ph_h2(const Params& p) {
    for (int it = blockIdx.x * NTHREADS + otid(); it < 16 * 8192; it += gridDim.x * NTHREADS) {
        const int bh = it >> 13, e2 = it & 8191, dv = e2 >> 6, dk = (e2 & 63) * 2;
        const size_t eoff = (size_t)dv * 128 + dk;
        float sx = 0.f, sy = 0.f;
#pragma unroll 8
        for (int c = 0; c < 64; ++c) {
            const size_t u = (size_t)bh * 64 + c;
            *(uint32_t*)(p.sst() + u * 16384 + eoff) = pack2(sx, sy);
            const float2 kvv = *(const float2*)(p.kv() + u * 16384 + eoff);
            const float2 dc = *(const float2*)(p.dec() + u * 128 + dk);
            sx = dc.x * sx + kvv.x; sy = dc.y * sy + kvv.y;
        }
    }
}

__device__ void ph_h3(const Params& p, char* smem0) {
    const VB vbk = make_vb(smem0);
    char* smem = vbk.smem;
    const int tid = vbk.tid, lane = tid & 63, wid = tid >> 6, wr = wid >> 1, wc = wid & 1, fr = lane & 15, fq = lane >> 4;
    char* sQ = smem;
    char* sK = smem + 16384;
    char* sP = smem + 32768;
    float* sL = (float*)(smem + 32768);
    float* totS = (float*)(smem + 65536);
    char* sG = smem + 40960;
    const int d = tid & 127, half = tid >> 7;
    const TrBase trb = tr16_base(lane);
    for (int u = vbk.vb; u < 1024; u += vbk.nvb) {
        const int bh = u >> 6, c = u & 63, b = bh >> 2, h = bh & 3;
        const size_t row0 = (size_t)b * S + c * 64;
        __syncthreads();
#pragma unroll
        for (int i = 0; i < 4; ++i) {
            const int idx = tid + 256 * i, r = idx >> 4, ch = idx & 15;
            *(u32x4*)(sQ + swz16(r, ch)) = *(const u32x4*)(p.proj() + (row0 + r) * INW + OFF_HQ + h * 128 + ch * 8);
        }
#pragma unroll
        for (int i = 0; i < 8; ++i) {
            const int idx = tid + 256 * i, r = idx >> 5, c4 = idx & 31;
            *(f32x4*)(sL + r * 128 + c4 * 4) = *(const f32x4*)(p.lgf() + (row0 + r) * 512 + h * 128 + c4 * 4);
        }
        u32x4 sv0[4], sv1[4], iv[4], gv[4];
#pragma unroll
        for (int i = 0; i < 4; ++i) {
            const int r8 = (tid + 256 * i) >> 3;
            sv0[i] = *(const u32x4*)(p.sst() + (size_t)u * 16384 + r8 * 128 + (tid & 7) * 8);
            sv1[i] = *(const u32x4*)(p.sst() + (size_t)u * 16384 + r8 * 128 + 64 + (tid & 7) * 8);
            const int idx = tid + 256 * i, r = idx >> 4, c16 = idx & 15;
            iv[i] = *(const u32x4*)(p.proj() + (row0 + r) * INW + OFF_HI + h * 128 + c16 * 8);
            gv[i] = *(const u32x4*)(p.proj() + (row0 + r) * INW + OFF_HG + h * 128 + c16 * 8);
        }
        __syncthreads();
        const float* lcol = sL + half * 32 * 128 + d;
        float tot = 0.f;
#pragma unroll
        for (int s = 0; s < 32; ++s) tot += lcol[s * 128];
        totS[half * 128 + d] = tot;
        __syncthreads();
        const float t0 = totS[d];
        float run = half ? t0 : 0.f;
#pragma unroll 8
        for (int s = 0; s < 32; ++s) {
            const float lv = lcol[s * 128];
            run += lv;
            const int o = swz16(half * 32 + s, d >> 3) + (d & 7) * 2;
            const float qm = bf2f(*(const bf16_t*)(sQ + o)) * __expf(run - t0);
            const float kh = (1.f - __expf(lv)) * __expf(t0 - run);
            *(bf16_t*)(sQ + o) = f2bf(qm);
            *(bf16_t*)(sK + o) = f2bf(kh);
        }
        __syncthreads();
        {
            f32x4 pa[2][2];
#pragma unroll
            for (int m = 0; m < 2; ++m)
#pragma unroll
                for (int n = 0; n < 2; ++n) pa[m][n] = f32x4{0.f, 0.f, 0.f, 0.f};
#pragma unroll
            for (int ks = 0; ks < 4; ++ks) {
                bf16x8 af[2], bfr[2];
#pragma unroll
                for (int m = 0; m < 2; ++m) af[m] = *(const bf16x8*)(sQ + swz16(wr * 32 + m * 16 + fr, ks * 4 + fq));
#pragma unroll
                for (int n = 0; n < 2; ++n) bfr[n] = *(const bf16x8*)(sK + swz16(wc * 32 + n * 16 + fr, ks * 4 + fq));
#pragma unroll
                for (int m = 0; m < 2; ++m)
#pragma unroll
                    for (int n = 0; n < 2; ++n) pa[m][n] = __builtin_amdgcn_mfma_f32_16x16x32_bf16(af[m], bfr[n], pa[m][n], 0, 0, 0);
            }
#pragma unroll
            for (int m = 0; m < 2; ++m)
#pragma unroll
                for (int n = 0; n < 2; ++n)
#pragma unroll
                    for (int j = 0; j < 4; ++j) {
                        const int t = wr * 32 + m * 16 + fq * 4 + j, s_ = wc * 32 + n * 16 + fr;
                        const float v = (s_ <= t) ? pa[m][n][j] : 0.f;
                        *(bf16_t*)(sP + swz(t, s_ >> 3) + (s_ & 7) * 2) = f2bf(v);
                    }
        }
        __syncthreads();
        f32x4 oa[8];
#pragma unroll
        for (int i = 0; i < 4; ++i) { const int idx = tid + 256 * i; *(u32x4*)(sG + (idx >> 4) * 256 + (idx & 15) * 16) = gv[i]; }
#pragma unroll
        for (int n = 0; n < 8; ++n) oa[n] = f32x4{0.f, 0.f, 0.f, 0.f};
        const int ch = tid & 7;
#pragma unroll
        for (int sub = 0; sub < 2; ++sub) {
            float sc[8];
#pragma unroll
            for (int j = 0; j < 8; ++j) sc[j] = __expf(totS[sub * 64 + ch * 8 + j]);
#pragma unroll
            for (int i = 0; i < 4; ++i) {
                const int r = (tid + 256 * i) >> 3;
                const u32x4 v = sub ? sv1[i] : sv0[i];
                u32x4 w;
                w.x = pack2(__uint_as_float(v.x << 16) * sc[0], __uint_as_float(v.x & 0xffff0000u) * sc[1]);
                w.y = pack2(__uint_as_float(v.y << 16) * sc[2], __uint_as_float(v.y & 0xffff0000u) * sc[3]);
                w.z = pack2(__uint_as_float(v.z << 16) * sc[4], __uint_as_float(v.z & 0xffff0000u) * sc[5]);
                w.w = pack2(__uint_as_float(v.w << 16) * sc[6], __uint_as_float(v.w & 0xffff0000u) * sc[7]);
                *(u32x4*)(sK + swz(r, ch)) = w;
            }
            __syncthreads();
#pragma unroll
            for (int ks = 0; ks < 2; ++ks) {
                const bf16x8 af = *(const bf16x8*)(sQ + swz16(wid * 16 + fr, sub * 8 + ks * 4 + fq));
#pragma unroll
                for (int n = 0; n < 8; ++n) {
                    const bf16x8 bfr = *(const bf16x8*)(sK + swz(n * 16 + fr, ks * 4 + fq));
                    oa[n] = __builtin_amdgcn_mfma_f32_16x16x32_bf16(af, bfr, oa[n], 0, 0, 0);
                }
            }
            __syncthreads();
        }
#pragma unroll
        for (int i = 0; i < 4; ++i) {
            const int idx = tid + 256 * i, r = idx >> 4, c16 = idx & 15;
            *(u32x4*)(sK + swz16(r, c16)) = iv[i];
        }
        __syncthreads();
#pragma unroll
        for (int ks = 0; ks < 2; ++ks) {
            const bf16x8 af = *(const bf16x8*)(sP + swz(wid * 16 + fr, ks * 4 + fq));
#pragma unroll
            for (int n = 0; n < 8; ++n) {
                const bf16x8 bfr = tr_frag16(sK, trb, ks, n);
                oa[n] = __builtin_amdgcn_mfma_f32_16x16x32_bf16(af, bfr, oa[n], 0, 0, 0);
            }
        }
        float ss[4] = {0.f, 0.f, 0.f, 0.f};
#pragma unroll
        for (int n = 0; n < 8; ++n)
#pragma unroll
            for (int j = 0; j < 4; ++j) ss[j] += oa[n][j] * oa[n][j];
#pragma unroll
        for (int j = 0; j < 4; ++j) {
            ss[j] += __shfl_xor(ss[j], 1, 64); ss[j] += __shfl_xor(ss[j], 2, 64); ss[j] += __shfl_xor(ss[j], 4, 64); ss[j] += __shfl_xor(ss[j], 8, 64);
        }
#pragma unroll
        for (int j = 0; j < 4; ++j) {
            const size_t row = row0 + wid * 16 + fq * 4 + j;
            const float rstd = rsqrtf(ss[j] * (1.f / 128.f) + RMS_EPS);
#pragma unroll
            for (int n = 0; n < 8; ++n) {
                const int dv = n * 16 + fr;
                const float g = bf2f(*(const bf16_t*)(sG + (wid * 16 + fq * 4 + j) * 256 + dv * 2));
                const float y = oa[n][j] * rstd * p.hg_nw[h * 128 + dv] * (g / (1.f + __expf(-g)));
                p.mixin()[row * 768 + h * 128 + dv] = f2bf(y);
            }
        }
    }
}

__device__ __forceinline__ TrBase tr8_base(int lane) {
    const int g = lane >> 4, q = (lane & 15) >> 2, pp = lane & 3;
    const int xl = 4 * (g & 1) + (q >> 1), h = pp >> 1;
    TrBase t;
    t.lo = (8 * g + q) * 128 + ((xl >> 1) << 5) + ((h ^ (xl & 1)) << 4) + 8 * (pp & 1);
    t.hi = (t.lo + 512) ^ 32;
    return t;
}
__device__ __forceinline__ bf16x8 tr_frag8(const char* tile, const TrBase& tb, int ks, int c) {
    int cx = c << 5;
    asm volatile("" : "+v"(cx));
    const v4s lo = __builtin_amdgcn_ds_read_tr16_b64_v4i16((LAS v4s*)(tile + ks * 4096 + (tb.lo ^ cx)));
    const v4s hi = __builtin_amdgcn_ds_read_tr16_b64_v4i16((LAS v4s*)(tile + ks * 4096 + (tb.hi ^ cx)));
    return bf16x8{lo[0], lo[1], lo[2], lo[3], hi[0], hi[1], hi[2], hi[3]};
}

__device__ void ph_attn(const Params& p, char* smem0) {
    const VB vbk = make_vb(smem0);
    char* smem = vbk.smem;
    const int tid = vbk.tid, lane = tid & 63, wid = tid >> 6, fr = lane & 15, fq = lane >> 4;
    char* sQ = smem;
    char* sK = smem + 8192;
    char* sP = sK;
    char* sV = smem + 33792;
    float* sBias = (float*)(smem + 58368);
    const TrBase trb = tr8_base(lane);
    for (int u = vbk.vb; u < 3072; u += vbk.nvb) {
        const int ti = u & 63, gq = u >> 6, g = gq % 3, bhh = gq / 3, hh = bhh & 3, b = bhh >> 2;
        const int lsh = (g == 0) ? 0 : (g == 1 ? 2 : 4), dl = 1 << lsh;
        const int tpr = (S >> lsh) >> 6;
        const int r = ti / tpr, j0 = (ti % tpr) * 64;
        const bf16_t* base = p.proj() + (size_t)b * S * INW + (g * 4 + hh) * 64;
        __syncthreads();
#pragma unroll
        for (int i = 0; i < 2; ++i) {
            const int idx = tid + 256 * i, row = idx >> 3, ch = idx & 7;
            const int tok = (j0 + row) * dl + r;
            *(u32x4*)(sQ + swz(row, ch)) = *(const u32x4*)(base + (size_t)tok * INW + OFF_AQ + ch * 8);
        }
#pragma unroll
        for (int i = 0; i < 6; ++i) {
            const int idx = tid + 256 * i, row = idx >> 3, ch = idx & 7;
            const int j = j0 - 128 + row;
            u32x4 kx = {0u, 0u, 0u, 0u}, vx = {0u, 0u, 0u, 0u};
            if (j >= 0) {
                const size_t o = (size_t)(j * dl + r) * INW + ch * 8;
                kx = *(const u32x4*)(base + o + OFF_AK);
                vx = *(const u32x4*)(base + o + OFF_AV);
            }
            *(u32x4*)(sK + swz(row, ch)) = kx;
            *(u32x4*)(sV + swz(row, ch)) = vx;
        }
        if (tid < 129) sBias[tid] = p.biasT()[(g * 129 + tid) * 4 + hh];
        __syncthreads();
        f32x4 sa[12];
#pragma unroll
        for (int n = 0; n < 12; ++n) sa[n] = f32x4{0.f, 0.f, 0.f, 0.f};
#pragma unroll
        for (int ks = 0; ks < 2; ++ks) {
            const bf16x8 af = *(const bf16x8*)(sQ + swz(wid * 16 + fr, ks * 4 + fq));
#pragma unroll
            for (int n = 0; n < 12; ++n) {
                const bf16x8 bfr = *(const bf16x8*)(sK + swz(n * 16 + fr, ks * 4 + fq));
                sa[n] = __builtin_amdgcn_mfma_f32_16x16x32_bf16(af, bfr, sa[n], 0, 0, 0);
            }
        }
        float mx[4] = {-INFINITY, -INFINITY, -INFINITY, -INFINITY};
#pragma unroll
        for (int n = 0; n < 12; ++n)
#pragma unroll
            for (int j = 0; j < 4; ++j) {
                const int jj = wid * 16 + fq * 4 + j, kk = n * 16 + fr, m = jj + 128 - kk;
                const bool valid = (m >= 0) && (m <= 128) && (j0 - 128 + kk >= 0);
                const int mc = m < 0 ? 0 : (m > 128 ? 128 : m);
                const float v = valid ? sa[n][j] * 0.125f + sBias[mc] : -INFINITY;
                sa[n][j] = v;
                mx[j] = fmaxf(mx[j], v);
            }
#pragma unroll
        for (int j = 0; j < 4; ++j) {
            mx[j] = fmaxf(mx[j], __shfl_xor(mx[j], 1, 64)); mx[j] = fmaxf(mx[j], __shfl_xor(mx[j], 2, 64));
            mx[j] = fmaxf(mx[j], __shfl_xor(mx[j], 4, 64)); mx[j] = fmaxf(mx[j], __shfl_xor(mx[j], 8, 64));
        }
        float ls[4] = {0.f, 0.f, 0.f, 0.f};
#pragma unroll
        for (int n = 0; n < 12; ++n)
#pragma unroll
            for (int j = 0; j < 4; ++j) { const float pe = __expf(sa[n][j] - mx[j]); sa[n][j] = pe; ls[j] += pe; }
#pragma unroll
        for (int j = 0; j < 4; ++j) {
            ls[j] += __shfl_xor(ls[j], 1, 64); ls[j] += __shfl_xor(ls[j], 2, 64); ls[j] += __shfl_xor(ls[j], 4, 64); ls[j] += __shfl_xor(ls[j], 8, 64);
        }
        __syncthreads();
#pragma unroll
        for (int n = 0; n < 12; ++n)
#pragma unroll
            for (int j = 0; j < 4; ++j) *(bf16_t*)(sP + (wid * 16 + fq * 4 + j) * 400 + (n * 16 + fr) * 2) = f2bf(sa[n][j]);
        f32x4 oa[4];
#pragma unroll
        for (int n = 0; n < 4; ++n) oa[n] = f32x4{0.f, 0.f, 0.f, 0.f};
#pragma unroll
        for (int ks = 0; ks < 6; ++ks) {
            const bf16x8 af = *(const bf16x8*)(sP + (wid * 16 + fr) * 400 + (ks * 4 + fq) * 16);
#pragma unroll
            for (int n = 0; n < 4; ++n) {
                const bf16x8 bfr = tr_frag8(sV, trb, ks, n);
                oa[n] = __builtin_amdgcn_mfma_f32_16x16x32_bf16(af, bfr, oa[n], 0, 0, 0);
            }
        }
#pragma unroll
        for (int j = 0; j < 4; ++j) {
            const int jj = wid * 16 + fq * 4 + j;
            const size_t row = (size_t)g * T + (size_t)b * S + (j0 + jj) * dl + r;
            const float inv = 1.f / ls[j];
#pragma unroll
            for (int n = 0; n < 4; ++n) p.ao()[row * 256 + hh * 64 + n * 16 + fr] = oa[n][j] * inv;
            if (fr == 0) p.alse()[row * 4 + hh] = mx[j] + __logf(ls[j]);
        }
    }
}

__device__ void ph_attn_merge(const Params& p) {
    const int tid = otid(), lane = tid & 63, wid = tid >> 6;
    for (int row = blockIdx.x * 8 + wid; row < T; row += gridDim.x * 8) {
        const int hh = lane >> 4;
        const float l0 = p.alse()[((size_t)0 * T + row) * 4 + hh], l1 = p.alse()[((size_t)1 * T + row) * 4 + hh], l2 = p.alse()[((size_t)2 * T + row) * 4 + hh];
        const float mxl = fmaxf(l0, fmaxf(l1, l2));
        float e0 = __expf(l0 - mxl), e1 = __expf(l1 - mxl), e2 = __expf(l2 - mxl);
        const float inv = 1.f / (e0 + e1 + e2);
        e0 *= inv; e1 *= inv; e2 *= inv;
        const f32x4 a0 = *(const f32x4*)(p.ao() + ((size_t)0 * T + row) * 256 + lane * 4);
        const f32x4 a1 = *(const f32x4*)(p.ao() + ((size_t)1 * T + row) * 256 + lane * 4);
        const f32x4 a2 = *(const f32x4*)(p.ao() + ((size_t)2 * T + row) * 256 + lane * 4);
        uint2 o;
        o.x = pack2(a0[0] * e0 + a1[0] * e1 + a2[0] * e2, a0[1] * e0 + a1[1] * e1 + a2[1] * e2);
        o.y = pack2(a0[2] * e0 + a1[2] * e1 + a2[2] * e2, a0[3] * e0 + a1[3] * e1 + a2[3] * e2);
        *(uint2*)(p.mixin() + (size_t)row * 768 + 512 + lane * 4) = o;
    }
}

__device__ void ph_outproj(const Params& p, char* smem) {
    const int tid = otid(), lane = tid & 63, wid = tid >> 6, wr = wid >> 1, wc = wid & 1;
    const int xcd = blockIdx.x & 7, nbx = gridDim.x >> 3;
    for (int i = blockIdx.x >> 3; i < 32; i += nbx) {
        const int nt = i >> 3, mt = xcd * 8 + (i & 7);
        const bf16_t* A = p.mixin() + (size_t)mt * 256 * 768;
        const bf16_t* Bt = p.woutT() + (size_t)nt * 256 * 768;
        f32x4 acc[4][8];
        __syncthreads();
        gemm4(smem, 768, [&](int r) { return A + (size_t)r * 768; }, [&](int n) { return Bt + (size_t)n * 768; }, acc);
        const int b = (mt * 256) >> 12;
        const int colb = nt * 256 + wc * 128;
        const float* g1 = p.mod() + b * 6144 + 2048 + colb;
        char* wl = smem + wid * EPI_WAVE;
#pragma unroll
        for (int m = 0; m < 4; ++m) {
            const size_t rbase = (size_t)(mt * 256 + wr * 64 + m * 16) * D + colb;
            epi_f32(wl, lane, [&](int n, int j) { return acc[m][n][j]; },
                    [&](int row, int ch, f32x4 v) {
                        const f32x4 xv = *(const f32x4*)(p.x + rbase + (size_t)row * D + ch * 4);
                        const f32x4 gv = *(const f32x4*)(g1 + ch * 4);
                        f32x4 o;
                        o[0] = ALPHA * xv[0] + gv[0] * v[0]; o[1] = ALPHA * xv[1] + gv[1] * v[1];
                        o[2] = ALPHA * xv[2] + gv[2] * v[2]; o[3] = ALPHA * xv[3] + gv[3] * v[3];
                        *(f32x4*)(p.pre1() + rbase + (size_t)row * D + ch * 4) = o;
                    });
        }
    }
}

__device__ void ph_ln1(const Params& p) {
    const int tid = otid(), lane = tid & 63, wid = tid >> 6;
    const int rstride = gridDim.x * 8;
    float4 nv[4];
    {
        const float4* xr = (const float4*)(p.pre1() + (size_t)(blockIdx.x * 8 + wid) * D);
#pragma unroll
        for (int i = 0; i < 4; ++i) nv[i] = xr[lane + 64 * i];
    }
    for (int row = blockIdx.x * 8 + wid; row < T; row += rstride) {
        float4 v[4];
        float s = 0.f;
#pragma unroll
        for (int i = 0; i < 4; ++i) { v[i] = nv[i]; s += v[i].x + v[i].y + v[i].z + v[i].w; }
        if (row + rstride < T) {
            const float4* xn = (const float4*)(p.pre1() + (size_t)(row + rstride) * D);
#pragma unroll
            for (int i = 0; i < 4; ++i) nv[i] = xn[lane + 64 * i];
        }
        float mean = wave_sum(s) * (1.f / D);
        float q = 0.f;
#pragma unroll
        for (int i = 0; i < 4; ++i) {
            v[i].x -= mean; v[i].y -= mean; v[i].z -= mean; v[i].w -= mean;
            q += v[i].x * v[i].x + v[i].y * v[i].y + v[i].z * v[i].z + v[i].w * v[i].w;
        }
        float rstd = rsqrtf(wave_sum(q) * (1.f / D) + LN_EPS);
        s = 0.f;
#pragma unroll
        for (int i = 0; i < 4; ++i) {
            const int col = (lane + 64 * i) * 4;
            const float4 g4 = *(const float4*)(p.ln1_g + col), b4 = *(const float4*)(p.ln1_b + col);
            v[i].x = v[i].x * rstd * g4.x + b4.x; v[i].y = v[i].y * rstd * g4.y + b4.y;
            v[i].z = v[i].z * rstd * g4.z + b4.z; v[i].w = v[i].w * rstd * g4.w + b4.w;
            { uint2 xo; xo.x = pack2(v[i].x, v[i].y); xo.y = pack2(v[i].z, v[i].w); *(uint2*)(p.x1() + (size_t)row * D + col) = xo; }
            s += v[i].x + v[i].y + v[i].z + v[i].w;
        }
        mean = wave_sum(s) * (1.f / D);
        q = 0.f;
#pragma unroll
        for (int i = 0; i < 4; ++i) {
            v[i].x -= mean; v[i].y -= mean; v[i].z -= mean; v[i].w -= mean;
            q += v[i].x * v[i].x + v[i].y * v[i].y + v[i].z * v[i].z + v[i].w * v[i].w;
        }
        rstd = rsqrtf(wave_sum(q) * (1.f / D) + LN_EPS);
        const int b = row >> 12;
        const float* sh = p.mod() + b * 6144 + 3072;
        const float* sc = sh + 1024;
#pragma unroll
        for (int i = 0; i < 4; ++i) {
            const int col = (lane + 64 * i) * 4;
            const float4 s4 = *(const float4*)(sc + col), h4 = *(const float4*)(sh + col);
            float4 y;
            y.x = v[i].x * rstd * (1.f + s4.x) + h4.x; y.y = v[i].y * rstd * (1.f + s4.y) + h4.y;
            y.z = v[i].z * rstd * (1.f + s4.z) + h4.z; y.w = v[i].w * rstd * (1.f + s4.w) + h4.w;
            uint2 o;
            o.x = pack2(y.x, y.y); o.y = pack2(y.z, y.w);
            *(uint2*)(p.h2() + (size_t)row * 2048 + col) = o;
            uint2 o2;
            o2.x = pack2(y.x - __uint_as_float(o.x << 16), y.y - __uint_as_float(o.x & 0xffff0000u));
            o2.y = pack2(y.z - __uint_as_float(o.y << 16), y.w - __uint_as_float(o.y & 0xffff0000u));
            *(uint2*)(p.h2() + (size_t)row * 2048 + 1024 + col) = o2;
        }
    }
}

__device__ void ph_router_gemm(const Params& p, char* smem) {
    const int tid = otid(), lane = tid & 63, wid = tid >> 6, wr = wid >> 1, wc = wid & 1;
    for (int u = blockIdx.x; u < 192; u += gridDim.x) {
        const int pass = u >> 6, mt = u & 63;
        const bf16_t* A = p.h2() + (size_t)mt * 256 * 2048 + (pass == 1 ? 1024 : 0);
        const bf16_t* Bt = p.wrT() + (pass == 2 ? (size_t)NE * D : 0);
        f32x4 acc[4][8];
        __syncthreads();
        gemm4(smem, D, [&](int r) { return A + (size_t)r * 2048; }, [&](int n) { return Bt + (size_t)n * D; }, acc);
        char* wl = smem + wid * EPI_WAVE;
#pragma unroll
        for (int m = 0; m < 4; ++m) {
            float* dst = p.lgp() + (size_t)pass * T * NE + (size_t)(mt * 256 + wr * 64 + m * 16) * NE + wc * 128;
            epi_f32(wl, lane, [&](int n, int j) { return acc[m][n][j]; },
                    [&](int row, int ch, f32x4 v) { *(f32x4*)(dst + (size_t)row * NE + ch * 4) = v; });
        }
    }
}

__device__ void ph_topk(const Params& p) {
    const int tid = otid(), lane = tid & 63, wid = tid >> 6;
    constexpr int TK = 4;
    for (int tok0 = (blockIdx.x * 8 + wid) * TK; tok0 < T; tok0 += gridDim.x * 8 * TK) {
        float sc[TK][4], bv[TK][4];
#pragma unroll
        for (int t = 0; t < TK; ++t)
#pragma unroll
            for (int j = 0; j < 4; ++j) {
                const int e = j * 64 + lane;
                const size_t o = (size_t)(tok0 + t) * NE + e;
                const float x = (p.lgp()[o] + p.lgp()[(size_t)T * NE + o]) + p.lgp()[(size_t)2 * T * NE + o];
                sc[t][j] = 1.f / (1.f + expf(-x));
                bv[t][j] = sc[t][j] + p.router_bias[e];
            }
        float gsum[TK][4];
#pragma unroll
        for (int j = 0; j < 4; ++j) {
            float m1[TK], m2[TK];
#pragma unroll
            for (int t = 0; t < TK; ++t) m1[t] = bv[t][j];
#pragma unroll
            for (int o = 16; o > 0; o >>= 1)
#pragma unroll
                for (int t = 0; t < TK; ++t) m1[t] = fmaxf(m1[t], __shfl_xor(m1[t], o, 64));
#pragma unroll
            for (int t = 0; t < TK; ++t) {
                const unsigned long long bal = __ballot(bv[t][j] == m1[t]);
                const unsigned hm = (unsigned)(bal >> (lane & 32));
                const int first = __ffs(hm) - 1;
                m2[t] = ((lane & 31) == first) ? -INFINITY : bv[t][j];
            }
#pragma unroll
            for (int o = 16; o > 0; o >>= 1)
#pragma unroll
                for (int t = 0; t < TK; ++t) m2[t] = fmaxf(m2[t], __shfl_xor(m2[t], o, 64));
#pragma unroll
            for (int t = 0; t < TK; ++t) gsum[t][j] = m1[t] + m2[t];
        }
        float cand[TK][4];
#pragma unroll
        for (int t = 0; t < TK; ++t) {
            float gs[8];
#pragma unroll
            for (int j = 0; j < 4; ++j) { gs[2 * j] = __shfl(gsum[t][j], 0, 64); gs[2 * j + 1] = __shfl(gsum[t][j], 32, 64); }
            unsigned gmask = 0u;
#pragma unroll
            for (int r = 0; r < 4; ++r) {
                float best = -INFINITY; int bi = 0;
#pragma unroll
                for (int g = 0; g < 8; ++g) {
                    const bool ok = (((gmask >> g) & 1u) == 0u) && (gs[g] > best);
                    if (ok) { best = gs[g]; bi = g; }
                }
                gmask |= 1u << bi;
            }
#pragma unroll
            for (int j = 0; j < 4; ++j) cand[t][j] = ((gmask >> (2 * j + (lane >> 5))) & 1u) ? bv[t][j] : -INFINITY;
        }
        float wsum[TK], myw[TK];
        int mye[TK];
#pragma unroll
        for (int t = 0; t < TK; ++t) { wsum[t] = 0.f; myw[t] = 0.f; mye[t] = 0; }
#pragma unroll
        for (int r = 0; r < 8; ++r) {
            float bvv[TK]; int be[TK];
#pragma unroll
            for (int t = 0; t < TK; ++t) {
                bvv[t] = cand[t][0]; be[t] = lane;
#pragma unroll
                for (int j = 1; j < 4; ++j) if (cand[t][j] > bvv[t]) { bvv[t] = cand[t][j]; be[t] = j * 64 + lane; }
            }
#pragma unroll
            for (int o = 32; o > 0; o >>= 1)
#pragma unroll
                for (int t = 0; t < TK; ++t) {
                    const float ov = __shfl_xor(bvv[t], o, 64);
                    const int oe = __shfl_xor(be[t], o, 64);
                    if (ov > bvv[t] || (ov == bvv[t] && oe < be[t])) { bvv[t] = ov; be[t] = oe; }
                }
#pragma unroll
            for (int t = 0; t < TK; ++t) {
                const int bj = be[t] >> 6;
                const float mysc = bj == 0 ? sc[t][0] : (bj == 1 ? sc[t][1] : (bj == 2 ? sc[t][2] : sc[t][3]));
                const float sval = __shfl(mysc, be[t] & 63, 64);
#pragma unroll
                for (int j = 0; j < 4; ++j) if (be[t] == j * 64 + lane) cand[t][j] = -INFINITY;
                wsum[t] += sval;
                if (lane == r) { myw[t] = sval; mye[t] = be[t]; }
            }
        }
        if (lane < 8) {
#pragma unroll
            for (int t = 0; t < TK; ++t) {
                const int a = (tok0 + t) * 8 + lane;
                p.topi()[a] = mye[t];
                p.topw()[a] = myw[t] * (2.5f / wsum[t]);
            }
        }
    }
}

__device__ void ph_lists(const Params& p, char* smem) {
    const int tid = otid(), lane = tid & 63, wid = tid >> 6;
    int* wtot = (int*)smem;
    for (int e = blockIdx.x; e < NE; e += gridDim.x) {
        __syncthreads();
        const int4* src = (const int4*)p.topi() + wid * 4096;
        int cntw = 0;
        for (int i = 0; i < 64; ++i) {
            const int4 v = src[i * 64 + lane];
            cntw += __popcll(__ballot(v.x == e)) + __popcll(__ballot(v.y == e)) + __popcll(__ballot(v.z == e)) + __popcll(__ballot(v.w == e));
        }
        if (lane == 0) wtot[wid] = cntw;
        __syncthreads();
        int base = 0, tot = 0;
        for (int w = 0; w < 8; ++w) { const int c = wtot[w]; if (w < wid) base += c; tot += c; }
        if (tid == 0) p.cnt()[e] = tot;
        int* dst = p.list() + (size_t)e * T;
        const unsigned long long lt = (1ull << lane) - 1ull;
        for (int i = 0; i < 64; ++i) {
            const int4 v = src[i * 64 + lane];
            const int a0 = (wid * 4096 + i * 64 + lane) * 4;
            unsigned long long m;
            m = __ballot(v.x == e); if (v.x == e) dst[base + __popcll(m & lt)] = a0;     base += __popcll(m);
            m = __ballot(v.y == e); if (v.y == e) dst[base + __popcll(m & lt)] = a0 + 1; base += __popcll(m);
            m = __ballot(v.z == e); if (v.z == e) dst[base + __popcll(m & lt)] = a0 + 2; base += __popcll(m);
            m = __ballot(v.w == e); if (v.w == e) dst[base + __popcll(m & lt)] = a0 + 3; base += __popcll(m);
        }
    }
}

struct ExpMap { int* cnt; int* off; int* tile; };
__device__ __forceinline__ ExpMap exp_map(const Params& p, char* smem) {
    ExpMap m;
    m.cnt = (int*)(smem + 98304); m.off = m.cnt + 256; m.tile = m.off + 256;
    const int tid = otid();
    __syncthreads();
    if (tid < NE) m.cnt[tid] = p.cnt()[tid];
    __syncthreads();
    if (tid == 0) {
        int off = 0, tl = 0;
        for (int e = 0; e < NE; ++e) { m.off[e] = off; m.tile[e] = tl; const int c = m.cnt[e]; off += c; tl += (c + 255) >> 8; }
        m.tile[NE] = tl;
    }
    __syncthreads();
    return m;
}
__device__ __forceinline__ int find_expert(const int* tile, int rt) {
    int lo = 0, hi = NE;
    while (hi - lo > 1) { const int mid = (lo + hi) >> 1; if (tile[mid] <= rt) lo = mid; else hi = mid; }
    return lo;
}
#define ROWA(smem) ((int*)((smem) + 98304 + 3328))
#define ROWW(smem) ((float*)((smem) + 98304 + 3328 + 1024))

__device__ void ph_gateup(const Params& p, char* smem) {
    const int tid = otid(), lane = tid & 63, wid = tid >> 6, wr = wid >> 1, wc = wid & 1;
    const ExpMap em = exp_map(p, smem);
    int* rowA = ROWA(smem);
    const int ntile = em.tile[NE];
    const int U = (ntile + T / 256) * 2;
    const int xcd = blockIdx.x & 7, nbx = gridDim.x >> 3;
    const int lo = (int)(((long long)U * xcd) >> 3), hi = (int)(((long long)U * (xcd + 1)) >> 3);
    for (int u = lo + (blockIdx.x >> 3); u < hi; u += nbx) {
        const int rt = u >> 1, c0 = (u & 1) * 128;
        const float *Wg, *Wu;
        bf16_t* gdst;
        int nrow, tokv = -1;
        if (rt < ntile) {
            const int e = find_expert(em.tile, rt);
            const int r0 = (rt - em.tile[e]) * 256, ne = em.cnt[e];
            Wg = p.w_eg + (size_t)e * D * ED; Wu = p.w_eu + (size_t)e * D * ED;
            gdst = p.gbuf() + ((size_t)em.off[e] + r0) * ED + c0;
            nrow = ne - r0;
            if (tid < 256 && r0 + tid < ne) tokv = p.list()[(size_t)e * T + r0 + tid] >> 3;
        } else {
            const int tb = (rt - ntile) * 256;
            Wg = p.w_sg; Wu = p.w_su;
            gdst = p.gsh() + (size_t)tb * ED + c0;
            nrow = 256;
            tokv = tb + (tid & 255);
        }
        __syncthreads();
        if (tid < 256) rowA[tid] = tokv;
        __syncthreads();
        const int t0 = rowA[0];
        f32x4 acc[4][8];
        gemm3<0>(smem, D,
                 [&](int r) { const int t = rowA[r]; return p.h2() + (size_t)(t < 0 ? t0 : t) * 2048; },
                 [&](int n) { const int t16 = n >> 4; return ((t16 & 1) ? Wu : Wg) + c0 + 16 * (t16 >> 1) + (n & 15); },
                 ED, acc, nrow);
        if (wr * 64 < nrow) {
            char* wl = smem + wid * EPI_WAVE;
#pragma unroll
            for (int m = 0; m < 4; ++m) {
                const int rb = wr * 64 + m * 16;
                epi_bf16(wl, lane,
                         [&](int n, int j) { if (n >= 4) return 0.f; const float g = acc[m][2 * n][j], uu = acc[m][2 * n + 1][j]; return g / (1.f + __expf(-g)) * uu; },
                         [&](int row, int ch, u32x4 v) { if (ch < 8 && rb + row < nrow) *(u32x4*)(gdst + (size_t)(rb + row) * ED + wc * 64 + ch * 8) = v; });
            }
        }
    }
}

__device__ void ph_down(const Params& p, char* smem) {
    const int tid = otid(), lane = tid & 63, wid = tid >> 6, wr = wid >> 1, wc = wid & 1;
    const ExpMap em = exp_map(p, smem);
    int* rowA = ROWA(smem);
    float* rowW = ROWW(smem);
    const int ntile = em.tile[NE];
    const int U = (ntile + T / 256) * 4;
    const int xcd = blockIdx.x & 7, nbx = gridDim.x >> 3;
    const int lo = (int)(((long long)U * xcd) >> 3), hi = (int)(((long long)U * (xcd + 1)) >> 3);
    for (int u = lo + (blockIdx.x >> 3); u < hi; u += nbx) {
        const int rt = u >> 2, nt = u & 3;
        const bf16_t* A;
        const float* W;
        int nrow, slot = -1;
        float wv = 0.f;
        if (rt < ntile) {
            const int e = find_expert(em.tile, rt);
            const int r0 = (rt - em.tile[e]) * 256, ne = em.cnt[e];
            A = p.gbuf() + ((size_t)em.off[e] + r0) * ED;
            W = p.w_ed + (size_t)e * ED * D + nt * 256;
            nrow = ne - r0;
            if (tid < 256 && r0 + tid < ne) {
                const int a = p.list()[(size_t)e * T + r0 + tid];
                slot = (a >> 3) * 9 + (a & 7);
                wv = p.topw()[a];
            }
        } else {
            const int tb = (rt - ntile) * 256;
            A = p.gsh() + (size_t)tb * ED;
            W = p.w_sd + nt * 256;
            nrow = 256;
            slot = (tb + (tid & 255)) * 9 + 8;
            wv = 1.f;
        }
        __syncthreads();
        if (tid < 256) { rowA[tid] = slot; rowW[tid] = wv; }
        __syncthreads();
        f32x4 acc[4][8];
        gemm3<0>(smem, ED, [&](int r) { return A + (size_t)(r < nrow ? r : 0) * ED; }, [&](int n) { return W + n; }, D, acc, nrow);
        if (wr * 64 < nrow) {
            char* wl = smem + wid * EPI_WAVE;
#pragma unroll
            for (int m = 0; m < 4; ++m) {
                const int rb = wr * 64 + m * 16;
                float wj[4];
#pragma unroll
                for (int j = 0; j < 4; ++j) wj[j] = rowW[rb + (lane >> 4) * 4 + j];
                epi_bf16(wl, lane, [&](int n, int j) { return acc[m][n][j] * wj[j]; },
                         [&](int row, int ch, u32x4 v) {
                             const int sl = rowA[rb + row];
                             if (sl >= 0) *(u32x4*)(p.ybuf() + (size_t)sl * D + nt * 256 + wc * 128 + ch * 8) = v;
                         });
            }
        }
    }
}

__device__ void ph_final(const Params& p) {
    const int tid = otid(), lane = tid & 63, wid = tid >> 6;
    for (int row = blockIdx.x * 8 + wid; row < T; row += gridDim.x * 8) {
        const int b = row >> 12;
        const float* g2 = p.mod() + b * 6144 + 5120;
        float4 v[4];
        float s = 0.f;
#pragma unroll
        for (int i = 0; i < 4; ++i) {
            const int col = (lane + 64 * i) * 4;
            float f0 = 0.f, f1 = 0.f, f2 = 0.f, f3 = 0.f;
#pragma unroll
            for (int k = 0; k < 9; ++k) {
                const uint2 w = *(const uint2*)(p.ybuf() + ((size_t)row * 9 + k) * D + col);
                f0 += __uint_as_float(w.x << 16); f1 += __uint_as_float(w.x & 0xffff0000u);
                f2 += __uint_as_float(w.y << 16); f3 += __uint_as_float(w.y & 0xffff0000u);
            }
            float4 xv;
            { const uint2 xw = *(const uint2*)(p.x1() + (size_t)row * D + col);
              xv.x = __uint_as_float(xw.x << 16); xv.y = __uint_as_float(xw.x & 0xffff0000u); xv.z = __uint_as_float(xw.y << 16); xv.w = __uint_as_float(xw.y & 0xffff0000u); }
            const float4 g4 = *(const float4*)(g2 + col);
            v[i].x = ALPHA * xv.x + g4.x * f0; v[i].y = ALPHA * xv.y + g4.y * f1;
            v[i].z = ALPHA * xv.z + g4.z * f2; v[i].w = ALPHA * xv.w + g4.w * f3;
            s += v[i].x + v[i].y + v[i].z + v[i].w;
        }
        const float mean = wave_sum(s) * (1.f / D);
        float q = 0.f;
#pragma unroll
        for (int i = 0; i < 4; ++i) {
            v[i].x -= mean; v[i].y -= mean; v[i].z -= mean; v[i].w -= mean;
            q += v[i].x * v[i].x + v[i].y * v[i].y + v[i].z * v[i].z + v[i].w * v[i].w;
        }
        const float rstd = rsqrtf(wave_sum(q) * (1.f / D) + LN_EPS);
#pragma unroll
        for (int i = 0; i < 4; ++i) {
            const int col = (lane + 64 * i) * 4;
            const float4 g4 = *(const float4*)(p.ln2_g + col), b4 = *(const float4*)(p.ln2_b + col);
            float4 y;
            y.x = v[i].x * rstd * g4.x + b4.x; y.y = v[i].y * rstd * g4.y + b4.y;
            y.z = v[i].z * rstd * g4.z + b4.z; y.w = v[i].w * rstd * g4.w + b4.w;
            *(float4*)(p.out + (size_t)row * D + col) = y;
        }
    }
}

constexpr int LDS_BYTES = 2 * VB_LDS + 16;
constexpr int NPHASE = 14;

template <int PH>
__device__ __forceinline__ void run_phase(const Params& p, char* smem) {
    if (PH == 0) ph_mod(p, smem);
    if (PH == 1) ph_ln0(p);
    if (PH == 2) ph_inproj(p, smem);
    if (PH == 3) { ph_h1(p, smem); ph_attn(p, smem); }
    if (PH == 4) { ph_h2(p); ph_attn_merge(p); }
    if (PH == 5) ph_h3(p, smem);
    if (PH == 6) ph_outproj(p, smem);
    if (PH == 7) ph_ln1(p);
    if (PH == 8) ph_router_gemm(p, smem);
    if (PH == 9) ph_topk(p);
    if (PH == 10) ph_lists(p, smem);
    if (PH == 11) ph_gateup(p, smem);
    if (PH == 12) ph_down(p, smem);
    if (PH == 13) ph_final(p);
}

template <int PH>
__global__ void __launch_bounds__(NTHREADS, 2) k_phase(Params p) {
    extern __shared__ __attribute__((aligned(16))) char smem[];
    run_phase<PH>(p, smem);
}

__global__ void __launch_bounds__(NTHREADS, 2) k_all(Params p) {
    extern __shared__ __attribute__((aligned(16))) char smem[];
    volatile LAS unsigned* st = (volatile LAS unsigned*)(smem + LDS_BYTES - 16);
    if (threadIdx.x == 0) { st[0] = 0u; st[1] = 0u; st[2] = 0u; st[3] = 0u; }
    __syncthreads();
    XcdBarrier bar = xcd_barrier_post(p.bar(), st);
    run_phase<0>(p, smem); xcd_barrier(bar);
    run_phase<1>(p, smem); xcd_barrier(bar);
    run_phase<2>(p, smem); xcd_barrier(bar);
    run_phase<3>(p, smem); xcd_barrier(bar);
    run_phase<4>(p, smem); xcd_barrier(bar);
    run_phase<5>(p, smem); xcd_barrier(bar);
    run_phase<6>(p, smem); xcd_barrier(bar);
    run_phase<7>(p, smem); xcd_barrier(bar);
    run_phase<8>(p, smem); xcd_barrier(bar);
    run_phase<9>(p, smem); xcd_barrier(bar);
    run_phase<10>(p, smem); xcd_barrier(bar);
    run_phase<11>(p, smem); xcd_barrier(bar);
    run_phase<12>(p, smem); xcd_barrier(bar);
    run_phase<13>(p, smem);
}

template <int PH>
static void launch_phase(const Params& p, int grid, hipStream_t stream) {
    static bool attr = false;
    if (!attr) { (void)hipFuncSetAttribute((const void*)k_phase<PH>, hipFuncAttributeMaxDynamicSharedMemorySize, LDS_BYTES); attr = true; }
    hipLaunchKernelGGL(k_phase<PH>, dim3(grid), dim3(NTHREADS), LDS_BYTES, stream, p);
}

extern "C" void kernel_launch(void* const* d_in, const int* in_sizes, int n_in, void* d_out, int out_size, void* d_ws, size_t ws_size,
                              hipStream_t stream) {
    (void)in_sizes; (void)n_in; (void)out_size;
    Params p{};
    const float** pin = (const float**)&p.x;
    for (int i = 0; i < 21; ++i) pin[i] = (const float*)d_in[i];
    p.out = (float*)d_out;
    p.ws = (char*)d_ws;
    char* ctl = p.ws + WO_ctl;
    if (WS_END > ws_size) { fprintf(stderr, "kernel_launch: workspace too small: need %zu have %zu\n", (size_t)WS_END, ws_size); return; }

    static int grid = 0;
    if (grid == 0) {
        int dev = 0, cus = 0, per_cu = 0;
        (void)hipGetDevice(&dev);
        (void)hipDeviceGetAttribute(&cus, hipDeviceAttributeMultiprocessorCount, dev);
        (void)hipFuncSetAttribute((const void*)k_all, hipFuncAttributeMaxDynamicSharedMemorySize, LDS_BYTES);
        (void)hipOccupancyMaxActiveBlocksPerMultiprocessor(&per_cu, (const void*)k_all, NTHREADS, LDS_BYTES);
        grid = cus;
        if (grid != 256) grid = 256;
        fprintf(stderr, "kernel_launch: cus %d per_cu %d grid %d ws need %zu have %zu\n", cus, per_cu, grid, (size_t)WS_END, ws_size);
    }
    (void)hipMemsetAsync(ctl, 0, 65536, stream);
#if ONE_LAUNCH
    hipLaunchKernelGGL(k_all, dim3(grid), dim3(NTHREADS), LDS_BYTES, stream, p);
#else
    launch_phase<0>(p, grid, stream); launch_phase<1>(p, grid, stream); launch_phase<2>(p, grid, stream); launch_phase<3>(p, grid, stream);
    launch_phase<4>(p, grid, stream); launch_phase<5>(p, grid, stream); launch_phase<6>(p, grid, stream); launch_phase<7>(p, grid, stream);
    launch_phase<8>(p, grid, stream); launch_phase<9>(p, grid, stream); launch_phase<10>(p, grid, stream); launch_phase<11>(p, grid, stream);
    launch_phase<12>(p, grid, stream); launch_phase<13>(p, grid, stream);
#endif
}
```

```cpp
#include <hip/hip_runtime.h>
#include <stdint.h>
#include <stdio.h>

#ifndef ONE_LAUNCH
#define ONE_LAUNCH 1
#endif

constexpr int D = 1024, NBATCH = 4, S = 4096, T = NBATCH * S;
constexpr int INW = 4352;
constexpr int NE = 256, TOPK = 8, ED = 256;
constexpr int OFF_HQ = 0, OFF_HF = 512, OFF_HI = 1024, OFF_HG = 1536, OFF_AQ = 2048, OFF_AK = 2816, OFF_AV = 3584;
constexpr float ALPHA = 1.189207115002721f;
constexpr float LN_EPS = 1e-5f, RMS_EPS = 1e-6f;
constexpr int NTHREADS = 512;
constexpr int VB_LDS = 67584;

typedef unsigned short bf16_t;
using bf16x8 = __attribute__((ext_vector_type(8))) short;
using f32x4 = __attribute__((ext_vector_type(4))) float;
using u32x4 = __attribute__((ext_vector_type(4))) unsigned int;

typedef float v2f_t __attribute__((ext_vector_type(2)));
typedef __bf16 v2bf_t __attribute__((ext_vector_type(2)));
typedef short v4s __attribute__((ext_vector_type(4)));
__device__ __forceinline__ unsigned short f2bf(float f) { return __builtin_bit_cast(unsigned short, (__bf16)f); }
__device__ __forceinline__ float bf2f(unsigned short h) { return __uint_as_float(((uint32_t)h) << 16); }
__device__ __forceinline__ uint32_t pack2(float a, float b) {
    const v2f_t f = {a, b};
    return __builtin_bit_cast(uint32_t, __builtin_convertvector(f, v2bf_t));
}
__device__ __forceinline__ float sigmoidf_(float v) { return 1.f / (1.f + __expf(-v)); }

__device__ __forceinline__ int otid() { int t = threadIdx.x; asm volatile("" : "+v"(t)); return t; }

constexpr size_t al256(size_t x) { return (x + 255) & ~(size_t)255; }
constexpr size_t WO_ctl = 0;
constexpr size_t WO_mod = WO_ctl + al256(65536);
constexpr size_t WO_lbv = WO_mod + al256(4 * 6144 * 4);
constexpr size_t WO_biasT = WO_lbv + al256(512 * 4);
constexpr size_t WO_winT = WO_biasT + al256(3 * 129 * 4 * 4);
constexpr size_t WO_woutT = WO_winT + al256((size_t)INW * D * 2);
constexpr size_t WO_wrT = WO_woutT + al256((size_t)D * 768 * 2);
constexpr size_t WO_wsgT = WO_wrT + al256((size_t)2 * NE * D * 2);
constexpr size_t WO_wsuT = WO_wsgT + al256((size_t)ED * D * 2);
constexpr size_t WO_wsdT = WO_wsuT + al256((size_t)ED * D * 2);
constexpr size_t WO_h1 = WO_wsdT + al256((size_t)D * ED * 2);
constexpr size_t WO_proj = WO_h1 + al256((size_t)T * D * 2);
constexpr size_t WO_lgf = WO_proj + al256((size_t)T * INW * 2);
constexpr size_t WO_ao = WO_lgf + al256((size_t)T * 512 * 4);
constexpr size_t WO_alse = WO_ao + al256((size_t)3 * T * 256 * 4);
constexpr size_t WO_mixin = WO_alse + al256((size_t)3 * T * 4 * 4);
constexpr size_t WO_pre1 = WO_mixin + al256((size_t)T * 768 * 2);
constexpr size_t WO_x1 = WO_pre1 + al256((size_t)T * D * 4);
constexpr size_t WO_h2 = WO_x1 + al256((size_t)T * D * 2);
constexpr size_t WO_lgp = WO_h2 + al256((size_t)T * 2048 * 2);
constexpr size_t WO_topi = WO_lgp + al256((size_t)3 * T * NE * 4);
constexpr size_t WO_topw = WO_topi + al256((size_t)T * 8 * 4);
constexpr size_t WO_list = WO_topw + al256((size_t)T * 8 * 4);
constexpr size_t WO_gbuf = WO_list + al256((size_t)NE * T * 4);
constexpr size_t WO_gsh = WO_gbuf + al256((size_t)T * TOPK * ED * 2);
constexpr size_t WO_ybuf = WO_gsh + al256((size_t)T * ED * 2);
constexpr size_t WO_dec = WO_ybuf + al256((size_t)T * 9 * D * 2);
constexpr size_t WS_END = WO_dec + al256((size_t)1024 * 128 * 4);
struct Params {
    const float *x, *c, *w_ada, *b_ada, *w_in, *hg_lb, *hg_nw, *rel_bias, *w_out, *ln1_g, *ln1_b, *w_router, *router_bias,
        *w_eg, *w_eu, *w_ed, *w_sg, *w_su, *w_sd, *ln2_g, *ln2_b;
    float* out;
    char* ws;
    __device__ __forceinline__ unsigned* bar() const { return (unsigned*)(ws + WO_ctl); }
    __device__ __forceinline__ int* cnt() const { return (int*)(ws + WO_ctl + 16384); }
    __device__ __forceinline__ float* kv() const { return (float*)(ws + WO_ybuf); }
    __device__ __forceinline__ bf16_t* sst() const { return (bf16_t*)(ws + WO_ybuf + (size_t)1024 * 16384 * 4); }
    __device__ __forceinline__ float* mod() const { return (float*)(ws + WO_mod); }
    __device__ __forceinline__ float* lbv() const { return (float*)(ws + WO_lbv); }
    __device__ __forceinline__ float* biasT() const { return (float*)(ws + WO_biasT); }
    __device__ __forceinline__ bf16_t* winT() const { return (bf16_t*)(ws + WO_winT); }
    __device__ __forceinline__ bf16_t* woutT() const { return (bf16_t*)(ws + WO_woutT); }
    __device__ __forceinline__ bf16_t* wrT() const { return (bf16_t*)(ws + WO_wrT); }
    __device__ __forceinline__ bf16_t* wsgT() const { return (bf16_t*)(ws + WO_wsgT); }
    __device__ __forceinline__ bf16_t* wsuT() const { return (bf16_t*)(ws + WO_wsuT); }
    __device__ __forceinline__ bf16_t* wsdT() const { return (bf16_t*)(ws + WO_wsdT); }
    __device__ __forceinline__ bf16_t* h1() const { return (bf16_t*)(ws + WO_h1); }
    __device__ __forceinline__ bf16_t* proj() const { return (bf16_t*)(ws + WO_proj); }
    __device__ __forceinline__ float* lgf() const { return (float*)(ws + WO_lgf); }
    __device__ __forceinline__ float* ao() const { return (float*)(ws + WO_ao); }
    __device__ __forceinline__ float* alse() const { return (float*)(ws + WO_alse); }
    __device__ __forceinline__ bf16_t* mixin() const { return (bf16_t*)(ws + WO_mixin); }
    __device__ __forceinline__ float* pre1() const { return (float*)(ws + WO_pre1); }
    __device__ __forceinline__ bf16_t* x1() const { return (bf16_t*)(ws + WO_x1); }
    __device__ __forceinline__ bf16_t* h2() const { return (bf16_t*)(ws + WO_h2); }
    __device__ __forceinline__ float* lgp() const { return (float*)(ws + WO_lgp); }
    __device__ __forceinline__ int* topi() const { return (int*)(ws + WO_topi); }
    __device__ __forceinline__ float* topw() const { return (float*)(ws + WO_topw); }
    __device__ __forceinline__ int* list() const { return (int*)(ws + WO_list); }
    __device__ __forceinline__ bf16_t* gbuf() const { return (bf16_t*)(ws + WO_gbuf); }
    __device__ __forceinline__ bf16_t* gsh() const { return (bf16_t*)(ws + WO_gsh); }
    __device__ __forceinline__ bf16_t* ybuf() const { return (bf16_t*)(ws + WO_ybuf); }
    __device__ __forceinline__ float* dec() const { return (float*)(ws + WO_dec); }
};

#define XB_TMO      128
#define XB_XCNT(j)  (256  + 64 * (j))
#define XB_XSUB(j)  (1280 + 64 * (j))
#define XB_XGEN(j)  (2304 + 64 * (j))
#define XB_TOP      3328
#define XB_TOPGEN   3392
#define XCD_BAR_WORDS 3456
#define XB_SPIN_CAP (1u << 18)
#define LAS __attribute__((address_space(3)))

__device__ __forceinline__ unsigned xb_ld(unsigned* p)              { return __hip_atomic_load(p, __ATOMIC_RELAXED, __HIP_MEMORY_SCOPE_AGENT); }
__device__ __forceinline__ unsigned xb_add(unsigned* p, unsigned v) { return __hip_atomic_fetch_add(p, v, __ATOMIC_RELAXED, __HIP_MEMORY_SCOPE_AGENT); }
__device__ __forceinline__ unsigned xb_xcc_id() { return (unsigned)__builtin_amdgcn_s_getreg((3 << 11) | 20) & 0xFu; }
#define XB_SPIN(cond, bar) do { unsigned _sp = 0; while (cond) { __builtin_amdgcn_s_sleep(1); \
    if ((++_sp & 255u) == 0u) { if (xb_ld(&(bar)[XB_TMO])) break; if (_sp > XB_SPIN_CAP) { atomicAdd(&(bar)[XB_TMO], 1u); break; } } } } while (0)

struct XcdBarrier {
    unsigned* bar; unsigned x;
    volatile LAS unsigned* st;
};
__device__ __forceinline__ XcdBarrier xcd_barrier_post(unsigned* bar, volatile LAS unsigned* st) {
    XcdBarrier b; b.bar = bar; b.x = xb_xcc_id(); b.st = st;
    if (threadIdx.x == 0) (void)xb_add(&bar[XB_XCNT(b.x)], 1u);
    return b;
}
__device__ __forceinline__ void xcd_barrier_complete(unsigned* bar, unsigned x, unsigned& nloc, unsigned& nx) {
    const unsigned G = gridDim.x * gridDim.y * gridDim.z;
    unsigned sum, cnt, mine, sp = 0u;
    for (;;) {
        sum = 0u; cnt = 0u; mine = 0u;
#pragma unroll
        for (unsigned j = 0; j < 16; ++j) { const unsigned c = xb_ld(&bar[XB_XCNT(j)]); sum += c; cnt += (c > 0u) ? 1u : 0u; mine = (j == x) ? c : mine; }
        if (sum == G) break;
        __builtin_amdgcn_s_sleep(1);
        if ((++sp & 255u) == 0u) { if (xb_ld(&bar[XB_TMO])) break; if (sp > XB_SPIN_CAP) { atomicAdd(&bar[XB_TMO], 1u); break; } }
    }
    nloc = mine > 0u ? mine : 1u; nx = cnt > 0u ? cnt : 1u;
}
__device__ __forceinline__ void xcd_barrier(const XcdBarrier& b) {
    asm volatile("s_waitcnt vmcnt(0)" ::: "memory");
    __syncthreads();
    if (threadIdx.x == 0) {
        unsigned* bar = b.bar;
        __builtin_amdgcn_s_waitcnt(0);
        unsigned nloc = b.st[0], nx = b.st[1];
        if (nloc == 0u) { xcd_barrier_complete(bar, b.x, nloc, nx); b.st[0] = nloc; b.st[1] = nx; }
        const unsigned old = xb_add(&bar[XB_XSUB(b.x)], 1u);
        const unsigned gen = old / nloc;
        if (old + 1u == (gen + 1u) * nloc) {
            __builtin_amdgcn_fence(__ATOMIC_RELEASE, "agent");
            asm volatile("s_waitcnt vmcnt(0)" ::: "memory");
            const unsigned og = xb_add(&bar[XB_TOP], 1u);
            const unsigned tg = og / nx;
            if (og + 1u == (tg + 1u) * nx) xb_add(&bar[XB_TOPGEN], 1u);
            else XB_SPIN(xb_ld(&bar[XB_TOPGEN]) == tg, bar);
            __builtin_amdgcn_fence(__ATOMIC_ACQUIRE, "agent");
            xb_add(&bar[XB_XGEN(b.x)], 1u);
            asm volatile("s_waitcnt vmcnt(0)" ::: "memory");
        } else {
            XB_SPIN(xb_ld(&bar[XB_XGEN(b.x)]) == gen, bar);
            __builtin_amdgcn_fence(__ATOMIC_ACQUIRE, "agent");
            asm volatile("s_waitcnt vmcnt(0)" ::: "memory");
        }
    }
    __syncthreads();
}

struct VB { int vb, nvb, tid; char* smem; };
__device__ __forceinline__ VB make_vb(char* smem) {
    const int t = otid();
    VB v; v.vb = (int)blockIdx.x * 2 + (t >> 8); v.nvb = (int)gridDim.x * 2; v.tid = t & 255; v.smem = smem + (t >> 8) * VB_LDS;
    return v;
}
__device__ __forceinline__ int swz(int row, int chunk) { return row * 128 + ((chunk ^ ((row >> 1) & 7)) << 4); }

__device__ __forceinline__ float wave_sum(float v) {
#pragma unroll
    for (int o = 32; o > 0; o >>= 1) v += __shfl_xor(v, o, 64);
    return v;
}

__device__ __forceinline__ int t5_bucket(int n) {
    if (n < 16) return n;
    const float v = logf((float)n / 16.f) / logf(128.f) * 16.f;
    int large = 16 + (int)v;
    return large < 31 ? large : 31;
}

__device__ __forceinline__ void tr_tile(const VB& v, const float* src, int ld, bf16_t* dst, bf16_t* dst2, int ldd, int k0, int n0) {
    float* t = (float*)v.smem;
    __syncthreads();
#pragma unroll
    for (int i = 0; i < 4; ++i) {
        const int r = (v.tid >> 4) + 16 * i, c4 = v.tid & 15;
        const f32x4 x = *(const f32x4*)(src + (size_t)(k0 + r) * ld + n0 + c4 * 4);
        t[r * 65 + c4 * 4 + 0] = x[0]; t[r * 65 + c4 * 4 + 1] = x[1]; t[r * 65 + c4 * 4 + 2] = x[2]; t[r * 65 + c4 * 4 + 3] = x[3];
    }
    __syncthreads();
    const int n = v.tid >> 2, kq = v.tid & 3;
    float f[16];
#pragma unroll
    for (int i = 0; i < 16; ++i) f[i] = t[(kq * 16 + i) * 65 + n];
    u32x4 a, b;
    a[0] = pack2(f[0], f[1]); a[1] = pack2(f[2], f[3]); a[2] = pack2(f[4], f[5]); a[3] = pack2(f[6], f[7]);
    b[0] = pack2(f[8], f[9]); b[1] = pack2(f[10], f[11]); b[2] = pack2(f[12], f[13]); b[3] = pack2(f[14], f[15]);
    bf16_t* d = dst + (size_t)(n0 + n) * ldd + k0 + kq * 16;
    *(u32x4*)d = a; *(u32x4*)(d + 8) = b;
    if (dst2) {
        u32x4 c, e;
#pragma unroll
        for (int i = 0; i < 4; ++i) {
            c[i] = pack2(f[2 * i] - __uint_as_float(a[i] << 16), f[2 * i + 1] - __uint_as_float(a[i] & 0xffff0000u));
            e[i] = pack2(f[8 + 2 * i] - __uint_as_float(b[i] << 16), f[8 + 2 * i + 1] - __uint_as_float(b[i] & 0xffff0000u));
        }
        bf16_t* d2 = dst2 + (size_t)(n0 + n) * ldd + k0 + kq * 16;
        *(u32x4*)d2 = c; *(u32x4*)(d2 + 8) = e;
    }
}

__device__ void ph_mod(const Params& p, char* smem0) {
    const VB v = make_vb(smem0);
    const int tid = v.tid;
    float* cond = (float*)(v.smem + 20480);
    float* red = cond + 4096;
    for (int i = tid; i < 4096; i += 256) { const float x = p.c[i]; cond[i] = x / (1.f + __expf(-x)); }
    __syncthreads();
    const int NU = 194 + 1088 + 192 + 64 + 64 + 64 + 64;
    const int rounds = (NU + v.nvb - 1) / v.nvb;
    for (int it = 0; it < rounds; ++it) {
        int u = v.vb + it * v.nvb;
        if (u >= NU) u = NU - 1;
        if (u < 192) {
            const int c4 = tid & 7, kq = tid >> 3;
            f32x4 a0 = {0.f, 0.f, 0.f, 0.f}, a1 = a0, a2 = a0, a3 = a0;
            const float* wp = p.w_ada + u * 32 + c4 * 4;
#pragma unroll 8
            for (int k = kq; k < 1024; k += 32) {
                const f32x4 w = *(const f32x4*)(wp + (size_t)k * 6144);
                a0 += cond[k] * w; a1 += cond[1024 + k] * w; a2 += cond[2048 + k] * w; a3 += cond[3072 + k] * w;
            }
            *(f32x4*)(red + (kq * 4 + 0) * 32 + c4 * 4) = a0; *(f32x4*)(red + (kq * 4 + 1) * 32 + c4 * 4) = a1;
            *(f32x4*)(red + (kq * 4 + 2) * 32 + c4 * 4) = a2; *(f32x4*)(red + (kq * 4 + 3) * 32 + c4 * 4) = a3;
        }
        __syncthreads();
        if (u < 192) {
            if (tid < 128) {
                const int b = tid >> 5, c2 = tid & 31;
                float s = 0.f;
                for (int q = 0; q < 32; ++q) s += red[(q * 4 + b) * 32 + c2];
                p.mod()[b * 6144 + u * 32 + c2] = s + p.b_ada[u * 32 + c2];
            }
        } else if (u == 192) {
            for (int j = tid; j < 512; j += 256) {
                const float a = p.hg_lb[j], b = p.hg_lb[512 + j];
                const float m = fmaxf(a, b);
                const float ea = expf(a - m), eb = expf(b - m);
                p.lbv()[j] = ea / (ea + eb);
            }
        } else if (u == 193) {
            for (int i = tid; i < 3 * 129 * 4; i += 256) {
                const int g = i / (129 * 4), m = (i >> 2) % 129, hh = i & 3;
                const int dil = (g == 0) ? 1 : (g == 1 ? 4 : 16);
                p.biasT()[i] = p.rel_bias[t5_bucket(m * dil) * 12 + g * 4 + hh];
            }
        }
        {
            int w = u - 194;
            const float* src = p.w_out; int ld = D; bf16_t* dst = p.woutT(); bf16_t* dst2 = nullptr; int ldd = 768, k0 = 0, n0 = 0;
            if (w >= 0) {
                if (w < 1088) { src = p.w_in; ld = INW; dst = p.winT(); ldd = D; k0 = (w / 68) * 64; n0 = (w % 68) * 64; }
                else if ((w -= 1088) < 192) { k0 = (w >> 4) * 64; n0 = (w & 15) * 64; }
                else if ((w -= 192) < 64) { src = p.w_router; ld = NE; dst = p.wrT(); dst2 = p.wrT() + (size_t)NE * D; ldd = D; k0 = (w >> 2) * 64; n0 = (w & 3) * 64; }
                else if ((w -= 64) < 64) { src = p.w_sg; ld = ED; dst = p.wsgT(); ldd = D; k0 = (w >> 2) * 64; n0 = (w & 3) * 64; }
                else if ((w -= 64) < 64) { src = p.w_su; ld = ED; dst = p.wsuT(); ldd = D; k0 = (w >> 2) * 64; n0 = (w & 3) * 64; }
                else { w -= 64; src = p.w_sd; ld = D; dst = p.wsdT(); ldd = ED; k0 = (w >> 4) * 64; n0 = (w & 15) * 64; }
            }
            tr_tile(v, src, ld, dst, dst2, ldd, k0, n0);
        }
    }
}

__device__ void ph_ln0(const Params& p) {
    const int tid = otid(), lane = tid & 63, wid = tid >> 6;
    const int rstride = gridDim.x * 8;
    float4 nv[4];
    {
        const float4* xr = (const float4*)(p.x + (size_t)(blockIdx.x * 8 + wid) * D);
#pragma unroll
        for (int i = 0; i < 4; ++i) nv[i] = xr[lane + 64 * i];
    }
    for (int row = blockIdx.x * 8 + wid; row < T; row += rstride) {
        float4 v[4];
        float s = 0.f;
#pragma unroll
        for (int i = 0; i < 4; ++i) { v[i] = nv[i]; s += v[i].x + v[i].y + v[i].z + v[i].w; }
        if (row + rstride < T) {
            const float4* xn = (const float4*)(p.x + (size_t)(row + rstride) * D);
#pragma unroll
            for (int i = 0; i < 4; ++i) nv[i] = xn[lane + 64 * i];
        }
        const float mean = wave_sum(s) * (1.f / D);
        float q = 0.f;
#pragma unroll
        for (int i = 0; i < 4; ++i) {
            v[i].x -= mean; v[i].y -= mean; v[i].z -= mean; v[i].w -= mean;
            q += v[i].x * v[i].x + v[i].y * v[i].y + v[i].z * v[i].z + v[i].w * v[i].w;
        }
        const float rstd = rsqrtf(wave_sum(q) * (1.f / D) + LN_EPS);
        const int b = row >> 12;
        const float* sh = p.mod() + b * 6144;
        const float* sc = sh + 1024;
#pragma unroll
        for (int i = 0; i < 4; ++i) {
            const int col = (lane + 64 * i) * 4;
            const float4 s4 = *(const float4*)(sc + col), h4 = *(const float4*)(sh + col);
            uint2 o;
            o.x = pack2(v[i].x * rstd * (1.f + s4.x) + h4.x, v[i].y * rstd * (1.f + s4.y) + h4.y);
            o.y = pack2(v[i].z * rstd * (1.f + s4.z) + h4.z, v[i].w * rstd * (1.f + s4.w) + h4.w);
            *(uint2*)(p.h1() + (size_t)row * D + col) = o;
        }
    }
}

__device__ __forceinline__ int swz16(int row, int chunk) { return row * 256 + ((chunk ^ (row & 15)) << 4); }
struct TrBase { int lo, hi; };
__device__ __forceinline__ TrBase tr16_base(int lane) {
    const int g = lane >> 4, q = (lane & 15) >> 2, pp = lane & 3;
    const int xl = 8 * (g & 1) + q, h = pp >> 1;
    TrBase t;
    t.lo = (8 * g + q) * 256 + ((xl >> 1) << 5) + ((h ^ (xl & 1)) << 4) + 8 * (pp & 1);
    t.hi = (t.lo + 1024) ^ 64;
    return t;
}
__device__ __forceinline__ bf16x8 tr_frag16(const char* tile, const TrBase& tb, int ks, int c) {
    int cx = c << 5;
    asm volatile("" : "+v"(cx));
    const v4s lo = __builtin_amdgcn_ds_read_tr16_b64_v4i16((LAS v4s*)(tile + ks * 8192 + (tb.lo ^ cx)));
    const v4s hi = __builtin_amdgcn_ds_read_tr16_b64_v4i16((LAS v4s*)(tile + ks * 8192 + (tb.hi ^ cx)));
    return bf16x8{lo[0], lo[1], lo[2], lo[3], hi[0], hi[1], hi[2], hi[3]};
}


__device__ __forceinline__ int aoff(int row, int chunk) { return row * 64 + ((chunk ^ ((row >> 2) & 3)) << 4); }
__device__ __forceinline__ int boff(int row, int chunk) { return row * 512 + ((chunk ^ (((row & 3) << 1) | (((row >> 3) & 1) << 3))) << 4); }
__device__ __forceinline__ bf16x8 tr_pair(const char* p) {
    const v4s lo = __builtin_amdgcn_ds_read_tr16_b64_v4i16((LAS v4s*)(p));
    const v4s hi = __builtin_amdgcn_ds_read_tr16_b64_v4i16((LAS v4s*)(p + 2048));
    return bf16x8{lo[0], lo[1], lo[2], lo[3], hi[0], hi[1], hi[2], hi[3]};
}
constexpr int G3_STAGE = 32768;

template <int BMODE, class AF, class BF>
__device__ __forceinline__ void gemm3(char* smem, const int K, AF arow, BF bsrc, const int ldb, f32x4 (&acc)[4][8], const int nvalid = 256) {
    const int tid = otid(), lane = tid & 63, wid = tid >> 6, wr = wid >> 1, wc = wid & 1, fr = lane & 15, fq = lane >> 4;
    const bf16_t* ap[2];
#pragma unroll
    for (int i = 0; i < 2; ++i) ap[i] = arow((tid >> 2) + 128 * i) + (tid & 3) * 8;
    const float* bpf = nullptr;
    const bf16_t* bpb[2] = {nullptr, nullptr};
    if (BMODE == 0) bpf = (const float*)bsrc((tid & 63) * 4) + (size_t)(tid >> 6) * ldb;
    else {
#pragma unroll
        for (int i = 0; i < 2; ++i) bpb[i] = (const bf16_t*)bsrc((tid >> 2) + 128 * i) + (tid & 3) * 8;
    }
#pragma unroll
    for (int m = 0; m < 4; ++m)
#pragma unroll
        for (int n = 0; n < 8; ++n) acc[m][n] = f32x4{0.f, 0.f, 0.f, 0.f};
    const int trbase = (8 * fq + (fr >> 2)) * 512 + wc * 256 + (((fr >> 2) | ((fq & 1) << 2)) << 5) + ((fr & 3) >> 1) * 16 + (fr & 1) * 8;
    u32x4 ra0[2], ra1[2];
    f32x4 rf0[4], rf1[4];
    u32x4 rb0[2], rb1[2];
    const bool active = wr * 64 < nvalid;
#define G3_GLOAD(RA, RF, RB, k0) do { \
        _Pragma("unroll") for (int i = 0; i < 2; ++i) RA[i] = *(const u32x4*)(ap[i] + (k0)); \
        if (BMODE == 0) { _Pragma("unroll") for (int j = 0; j < 4; ++j) RF[j] = *(const f32x4*)(bpf + (size_t)((k0) + 8 * j) * ldb); } \
        else { _Pragma("unroll") for (int i = 0; i < 2; ++i) RB[i] = *(const u32x4*)(bpb[i] + (k0)); } } while (0)
#define G3_LWRITE(RA, RF, RB, st) do { \
        char* sA_ = (st); char* sB_ = (st) + 16384; \
        _Pragma("unroll") for (int i = 0; i < 2; ++i) *(u32x4*)(sA_ + aoff((tid >> 2) + 128 * i, tid & 3)) = RA[i]; \
        if (BMODE == 0) { _Pragma("unroll") for (int j = 0; j < 4; ++j) { uint2 w_; w_.x = pack2(RF[j][0], RF[j][1]); w_.y = pack2(RF[j][2], RF[j][3]); \
                *(uint2*)(sB_ + boff((tid >> 6) + 8 * j, (tid & 63) >> 1) + (tid & 1) * 8) = w_; } } \
        else { _Pragma("unroll") for (int i = 0; i < 2; ++i) *(u32x4*)(sB_ + aoff((tid >> 2) + 128 * i, tid & 3)) = RB[i]; } } while (0)
#define G3_COMPUTE(st) do { if (active) { \
        const char* sA_ = (st); const char* sB_ = (st) + 16384; \
        bf16x8 af[4]; \
        _Pragma("unroll") for (int m = 0; m < 4; ++m) af[m] = *(const bf16x8*)(sA_ + aoff(wr * 64 + m * 16 + fr, fq)); \
        _Pragma("unroll") for (int n = 0; n < 8; ++n) { \
            bf16x8 bfr; \
            if (BMODE == 0) bfr = tr_pair(sB_ + (trbase ^ (n << 5))); else bfr = *(const bf16x8*)(sB_ + aoff(wc * 128 + n * 16 + fr, fq)); \
            _Pragma("unroll") for (int m = 0; m < 4; ++m) acc[m][n] = __builtin_amdgcn_mfma_f32_16x16x32_bf16(af[m], bfr, acc[m][n], 0, 0, 0); } } } while (0)
    const int nk = K >> 5;
    char* st0 = smem;
    char* st1 = smem + G3_STAGE;
    G3_GLOAD(ra0, rf0, rb0, 0);
    G3_GLOAD(ra1, rf1, rb1, 32);
    G3_LWRITE(ra0, rf0, rb0, st0);
    if (nk > 2) G3_GLOAD(ra0, rf0, rb0, 64);
    __syncthreads();
    for (int kt = 0; kt < nk; kt += 2) {
        G3_LWRITE(ra1, rf1, rb1, st1);
        if (kt + 3 < nk) G3_GLOAD(ra1, rf1, rb1, (kt + 3) * 32);
        G3_COMPUTE(st0);
        __syncthreads();
        if (kt + 2 < nk) G3_LWRITE(ra0, rf0, rb0, st0);
        if (kt + 4 < nk) G3_GLOAD(ra0, rf0, rb0, (kt + 4) * 32);
        G3_COMPUTE(st1);
        __syncthreads();
    }
#undef G3_GLOAD
#undef G3_LWRITE
#undef G3_COMPUTE
}

template <class AF, class BF>
__device__ __forceinline__ void gemm4(char* smem, const int K, AF arow, BF brow, f32x4 (&acc)[4][8]) {
    const int tid = otid(), lane = tid & 63, wid = tid >> 6, wr = wid >> 1, wc = wid & 1, fr = lane & 15, fq = lane >> 4;
    const bf16_t* ga[2];
    const bf16_t* gb[2];
#pragma unroll
    for (int i = 0; i < 2; ++i) {
        const int r = 16 * (wid + 8 * i) + (lane >> 2), sc = ((lane & 3) ^ ((r >> 2) & 3)) * 8;
        ga[i] = arow(r) + sc;
        gb[i] = brow(r) + sc;
    }
#pragma unroll
    for (int m = 0; m < 4; ++m)
#pragma unroll
        for (int n = 0; n < 8; ++n) acc[m][n] = f32x4{0.f, 0.f, 0.f, 0.f};
    char* ldst = smem + wid * 1024 + lane * 16;
#define G4_ISSUE(slot, k0) do { \
        char* d_ = ldst + (slot) * 32768; \
        __builtin_amdgcn_global_load_lds((const unsigned*)(ga[0] + (k0)), (LAS unsigned*)(d_), 16, 0, 0); \
        __builtin_amdgcn_global_load_lds((const unsigned*)(ga[1] + (k0)), (LAS unsigned*)(d_ + 8192), 16, 0, 0); \
        __builtin_amdgcn_global_load_lds((const unsigned*)(gb[0] + (k0)), (LAS unsigned*)(d_ + 16384), 16, 0, 0); \
        __builtin_amdgcn_global_load_lds((const unsigned*)(gb[1] + (k0)), (LAS unsigned*)(d_ + 16384 + 8192), 16, 0, 0); } while (0)
    const int nk = K >> 5;
    G4_ISSUE(0, 0);
    G4_ISSUE(1, 32);
    int slot = 0, slot2 = 2;
    for (int kt = 0; kt < nk; ++kt) {
        if (kt + 1 < nk) asm volatile("s_waitcnt vmcnt(4)" ::: "memory");
        else asm volatile("s_waitcnt vmcnt(0)" ::: "memory");
        __builtin_amdgcn_s_barrier();
        if (kt + 2 < nk) G4_ISSUE(slot2, (kt + 2) * 32);
        const char* sA_ = smem + slot * 32768;
        const char* sB_ = sA_ + 16384;
        bf16x8 af[4];
#pragma unroll
        for (int m = 0; m < 4; ++m) af[m] = *(const bf16x8*)(sA_ + aoff(wr * 64 + m * 16 + fr, fq));
#pragma unroll
        for (int n = 0; n < 8; ++n) {
            const bf16x8 bfr = *(const bf16x8*)(sB_ + aoff(wc * 128 + n * 16 + fr, fq));
#pragma unroll
            for (int m = 0; m < 4; ++m) acc[m][n] = __builtin_amdgcn_mfma_f32_16x16x32_bf16(af[m], bfr, acc[m][n], 0, 0, 0);
        }
        slot = (slot == 2) ? 0 : slot + 1;
        slot2 = (slot2 == 2) ? 0 : slot2 + 1;
    }
#undef G4_ISSUE
    __syncthreads();
}


constexpr int EPI_WAVE = 8704;
template <class VF, class SF>
__device__ __forceinline__ void epi_bf16(char* wl, const int lane, VF val, SF store) {
    const int fr = lane & 15, fq = lane >> 4, odd = lane & 1;
#pragma unroll
    for (int n = 0; n < 8; ++n)
#pragma unroll
        for (int jp = 0; jp < 2; ++jp) {
            const float a = val(n, 2 * jp), b = val(n, 2 * jp + 1);
            const float x = odd ? a : b;
            const float y = __shfl_xor(x, 1, 64);
            const uint32_t w = odd ? pack2(y, b) : pack2(a, y);
            *(uint32_t*)(wl + (fq * 4 + 2 * jp + odd) * 272 + (n * 16 + (fr & ~1)) * 2) = w;
        }
    int ln = lane;
    asm volatile("" : "+v"(ln));
#pragma unroll
    for (int i = 0; i < 4; ++i) {
        const int idx = ln + 64 * i, row = idx >> 4, ch = idx & 15;
        store(row, ch, *(const u32x4*)(wl + row * 272 + ch * 16));
    }
}
template <class VF, class SF>
__device__ __forceinline__ void epi_f32(char* wl, const int lane, VF val, SF store) {
    const int fr = lane & 15, fq = lane >> 4;
#pragma unroll
    for (int n = 0; n < 8; ++n)
#pragma unroll
        for (int j = 0; j < 4; ++j) *(float*)(wl + (fq * 4 + j) * 528 + (n * 16 + fr) * 4) = val(n, j);
    int ln = lane;
    asm volatile("" : "+v"(ln));
#pragma unroll
    for (int i = 0; i < 8; ++i) {
        const int idx = ln + 64 * i, row = idx >> 5, ch = idx & 31;
        store(row, ch, *(const f32x4*)(wl + row * 528 + ch * 16));
    }
}

__device__ void ph_inproj(const Params& p, char* smem) {
    const int tid = otid(), lane = tid & 63, wid = tid >> 6, wr = wid >> 1, wc = wid & 1, fr = lane & 15;
    const int NTN = INW / 256;
    const int xcd = blockIdx.x & 7, nbx = gridDim.x >> 3;
    for (int i = blockIdx.x >> 3; i < 8 * NTN; i += nbx) {
        const int nt = i >> 3, mt = xcd * 8 + (i & 7);
        const bf16_t* A = p.h1() + (size_t)mt * 256 * D;
        const bf16_t* Bt = p.winT() + (size_t)nt * 256 * D;
        f32x4 acc[4][8];
        __syncthreads();
        gemm4(smem, D, [&](int r) { return A + (size_t)r * D; }, [&](int n) { return Bt + (size_t)n * D; }, acc);
        char* wl = smem + wid * EPI_WAVE;
        const int colb = nt * 256 + wc * 128;
        const int rowb = mt * 256 + wr * 64;
        if (colb >= OFF_HF && colb < OFF_HI) {
            float lbc[8];
#pragma unroll
            for (int n = 0; n < 8; ++n) lbc[n] = p.lbv()[colb - OFF_HF + n * 16 + fr];
#pragma unroll
            for (int m = 0; m < 4; ++m) {
                float* dst = p.lgf() + (size_t)(rowb + m * 16) * 512 + (colb - OFF_HF);
                epi_f32(wl, lane,
                        [&](int n, int j) { return logf(lbc[n] + (1.f - lbc[n]) * (1.f / (1.f + expf(-acc[m][n][j])))); },
                        [&](int row, int ch, f32x4 v) { *(f32x4*)(dst + (size_t)row * 512 + ch * 4) = v; });
            }
        } else {
#pragma unroll
            for (int m = 0; m < 4; ++m) {
                bf16_t* dst = p.proj() + (size_t)(rowb + m * 16) * INW + colb;
                epi_bf16(wl, lane, [&](int n, int j) { return acc[m][n][j]; },
                         [&](int row, int ch, u32x4 v) { *(u32x4*)(dst + (size_t)row * INW + ch * 8) = v; });
            }
        }
    }
}

__device__ void ph_h1(const Params& p, char* smem0) {
    const VB vbk = make_vb(smem0);
    char* smem = vbk.smem;
    const int tid = vbk.tid, lane = tid & 63, wid = tid >> 6, wr = wid >> 1, wc = wid & 1, fr = lane & 15, fq = lane >> 4;
    char* sI = smem;
    char* sK = smem + 16384;
    float* sL = (float*)(smem + 32768);
    float* totS = (float*)(smem + 65536);
    const int d = tid & 127, half = tid >> 7;
    const TrBase trb = tr16_base(lane);
    for (int u = vbk.vb; u < 1024; u += vbk.nvb) {
        const int bh = u >> 6, c = u & 63, b = bh >> 2, h = bh & 3;
        const size_t row0 = (size_t)b * S + c * 64;
        __syncthreads();
#pragma unroll
        for (int i = 0; i < 4; ++i) {
            const int idx = tid + 256 * i, r = idx >> 4, ch = idx & 15;
            *(u32x4*)(sI + swz16(r, ch)) = *(const u32x4*)(p.proj() + (row0 + r) * INW + OFF_HI + h * 128 + ch * 8);
        }
#pragma unroll
        for (int i = 0; i < 8; ++i) {
            const int idx = tid + 256 * i, r = idx >> 5, c4 = idx & 31;
            *(f32x4*)(sL + r * 128 + c4 * 4) = *(const f32x4*)(p.lgf() + (row0 + r) * 512 + h * 128 + c4 * 4);
        }
        __syncthreads();
        const float* lcol = sL + half * 32 * 128 + d;
        float tot = 0.f;
#pragma unroll
        for (int s = 0; s < 32; ++s) tot += lcol[s * 128];
        totS[half * 128 + d] = tot;
        __syncthreads();
        const float t0 = totS[d], bl = t0 + totS[128 + d];
        float run = half ? t0 : 0.f;
#pragma unroll 8
        for (int s = 0; s < 32; ++s) {
            const float lv = lcol[s * 128];
            run += lv;
            const float kt = (1.f - __expf(lv)) * __expf(bl - run);
            *(bf16_t*)(sK + swz16(half * 32 + s, d >> 3) + (d & 7) * 2) = f2bf(kt);
        }
        if (half == 0) p.dec()[u * 128 + d] = __expf(bl);
        __syncthreads();
        f32x4 acc[4][4];
#pragma unroll
        for (int m = 0; m < 4; ++m)
#pragma unroll
            for (int n = 0; n < 4; ++n) acc[m][n] = f32x4{0.f, 0.f, 0.f, 0.f};
#pragma unroll
        for (int ks = 0; ks < 2; ++ks) {
            bf16x8 af[4], bfr[4];
#pragma unroll
            for (int m = 0; m < 4; ++m) af[m] = tr_frag16(sI, trb, ks, wr * 4 + m);
#pragma unroll
            for (int n = 0; n < 4; ++n) bfr[n] = tr_frag16(sK, trb, ks, wc * 4 + n);
#pragma unroll
            for (int m = 0; m < 4; ++m)
#pragma unroll
                for (int n = 0; n < 4; ++n) acc[m][n] = __builtin_amdgcn_mfma_f32_16x16x32_bf16(af[m], bfr[n], acc[m][n], 0, 0, 0);
        }
        float* kvu = p.kv() + (size_t)u * 16384;
#pragma unroll
        for (int m = 0; m < 4; ++m)
#pragma unroll
            for (int n = 0; n < 4; ++n)
#pragma unroll
                for (int j = 0; j < 4; ++j) kvu[(wr * 64 + m * 16 + fq * 4 + j) * 128 + wc * 64 + n * 16 + fr] = acc[m][n][j];
    }
}

__device__ void ph_h2(const Params& p) {
    for (int it = blockIdx.x * NTHREADS + otid(); it < 16 * 8192; it += gridDim.x * NTHREADS) {
        const int bh = it >> 13, e2 = it & 8191, dv = e2 >> 6, dk = (e2 & 63) * 2;
        const size_t eoff = (size_t)dv * 128 + dk;
        float sx = 0.f, sy = 0.f;
#pragma unroll 8
        for (int c = 0; c < 64; ++c) {
            const size_t u = (size_t)bh * 64 + c;
            *(uint32_t*)(p.sst() + u * 16384 + eoff) = pack2(sx, sy);
            const float2 kvv = *(const float2*)(p.kv() + u * 16384 + eoff);
            const float2 dc = *(const float2*)(p.dec() + u * 128 + dk);
            sx = dc.x * sx + kvv.x; sy = dc.y * sy + kvv.y;
        }
    }
}

__device__ void ph_h3(const Params& p, char* smem0) {
    const VB vbk = make_vb(smem0);
    char* smem = vbk.smem;
    const int tid = vbk.tid, lane = tid & 63, wid = tid >> 6, wr = wid >> 1, wc = wid & 1, fr = lane & 15, fq = lane >> 4;
    char* sQ = smem;
    char* sK = smem + 16384;
    char* sP = smem + 32768;
    float* sL = (float*)(smem + 32768);
    float* totS = (float*)(smem + 65536);
    char* sG = smem + 40960;
    const int d = tid & 127, half = tid >> 7;
    const TrBase trb = tr16_base(lane);
    for (int u = vbk.vb; u < 1024; u += vbk.nvb) {
        const int bh = u >> 6, c = u & 63, b = bh >> 2, h = bh & 3;
        const size_t row0 = (size_t)b * S + c * 64;
        __syncthreads();
#pragma unroll
        for (int i = 0; i < 4; ++i) {
            const int idx = tid + 256 * i, r = idx >> 4, ch = idx & 15;
            *(u32x4*)(sQ + swz16(r, ch)) = *(const u32x4*)(p.proj() + (row0 + r) * INW + OFF_HQ + h * 128 + ch * 8);
        }
#pragma unroll
        for (int i = 0; i < 8; ++i) {
            const int idx = tid + 256 * i, r = idx >> 5, c4 = idx & 31;
            *(f32x4*)(sL + r * 128 + c4 * 4) = *(const f32x4*)(p.lgf() + (row0 + r) * 512 + h * 128 + c4 * 4);
        }
        u32x4 sv0[4], sv1[4], iv[4], gv[4];
#pragma unroll
        for (int i = 0; i < 4; ++i) {
            const int r8 = (tid + 256 * i) >> 3;
            sv0[i] = *(const u32x4*)(p.sst() + (size_t)u * 16384 + r8 * 128 + (tid & 7) * 8);
            sv1[i] = *(const u32x4*)(p.sst() + (size_t)u * 16384 + r8 * 128 + 64 + (tid & 7) * 8);
            const int idx = tid + 256 * i, r = idx >> 4, c16 = idx & 15;
            iv[i] = *(const u32x4*)(p.proj() + (row0 + r) * INW + OFF_HI + h * 128 + c16 * 8);
            gv[i] = *(const u32x4*)(p.proj() + (row0 + r) * INW + OFF_HG + h * 128 + c16 * 8);
        }
        __syncthreads();
        const float* lcol = sL + half * 32 * 128 + d;
        float tot = 0.f;
#pragma unroll
        for (int s = 0; s < 32; ++s) tot += lcol[s * 128];
        totS[half * 128 + d] = tot;
        __syncthreads();
        const float t0 = totS[d];
        float run = half ? t0 : 0.f;
#pragma unroll 8
        for (int s = 0; s < 32; ++s) {
            const float lv = lcol[s * 128];
            run += lv;
            const int o = swz16(half * 32 + s, d >> 3) + (d & 7) * 2;
            const float qm = bf2f(*(const bf16_t*)(sQ + o)) * __expf(run - t0);
            const float kh = (1.f - __expf(lv)) * __expf(t0 - run);
            *(bf16_t*)(sQ + o) = f2bf(qm);
            *(bf16_t*)(sK + o) = f2bf(kh);
        }
        __syncthreads();
        {
            f32x4 pa[2][2];
#pragma unroll
            for (int m = 0; m < 2; ++m)
#pragma unroll
                for (int n = 0; n < 2; ++n) pa[m][n] = f32x4{0.f, 0.f, 0.f, 0.f};
#pragma unroll
            for (int ks = 0; ks < 4; ++ks) {
                bf16x8 af[2], bfr[2];
#pragma unroll
                for (int m = 0; m < 2; ++m) af[m] = *(const bf16x8*)(sQ + swz16(wr * 32 + m * 16 + fr, ks * 4 + fq));
#pragma unroll
                for (int n = 0; n < 2; ++n) bfr[n] = *(const bf16x8*)(sK + swz16(wc * 32 + n * 16 + fr, ks * 4 + fq));
#pragma unroll
                for (int m = 0; m < 2; ++m)
#pragma unroll
                    for (int n = 0; n < 2; ++n) pa[m][n] = __builtin_amdgcn_mfma_f32_16x16x32_bf16(af[m], bfr[n], pa[m][n], 0, 0, 0);
            }
#pragma unroll
            for (int m = 0; m < 2; ++m)
#pragma unroll
                for (int n = 0; n < 2; ++n)
#pragma unroll
                    for (int j = 0; j < 4; ++j) {
                        const int t = wr * 32 + m * 16 + fq * 4 + j, s_ = wc * 32 + n * 16 + fr;
                        const float v = (s_ <= t) ? pa[m][n][j] : 0.f;
                        *(bf16_t*)(sP + swz(t, s_ >> 3) + (s_ & 7) * 2) = f2bf(v);
                    }
        }
        __syncthreads();
        f32x4 oa[8];
#pragma unroll
        for (int i = 0; i < 4; ++i) { const int idx = tid + 256 * i; *(u32x4*)(sG + (idx >> 4) * 256 + (idx & 15) * 16) = gv[i]; }
#pragma unroll
        for (int n = 0; n < 8; ++n) oa[n] = f32x4{0.f, 0.f, 0.f, 0.f};
        const int ch = tid & 7;
#pragma unroll
        for (int sub = 0; sub < 2; ++sub) {
            float sc[8];
#pragma unroll
            for (int j = 0; j < 8; ++j) sc[j] = __expf(totS[sub * 64 + ch * 8 + j]);
#pragma unroll
            for (int i = 0; i < 4; ++i) {
                const int r = (tid + 256 * i) >> 3;
                const u32x4 v = sub ? sv1[i] : sv0[i];
                u32x4 w;
                w.x = pack2(__uint_as_float(v.x << 16) * sc[0], __uint_as_float(v.x & 0xffff0000u) * sc[1]);
                w.y = pack2(__uint_as_float(v.y << 16) * sc[2], __uint_as_float(v.y & 0xffff0000u) * sc[3]);
                w.z = pack2(__uint_as_float(v.z << 16) * sc[4], __uint_as_float(v.z & 0xffff0000u) * sc[5]);
                w.w = pack2(__uint_as_float(v.w << 16) * sc[6], __uint_as_float(v.w & 0xffff0000u) * sc[7]);
                *(u32x4*)(sK + swz(r, ch)) = w;
            }
            __syncthreads();
#pragma unroll
            for (int ks = 0; ks < 2; ++ks) {
                const bf16x8 af = *(const bf16x8*)(sQ + swz16(wid * 16 + fr, sub * 8 + ks * 4 + fq));
#pragma unroll
                for (int n = 0; n < 8; ++n) {
                    const bf16x8 bfr = *(const bf16x8*)(sK + swz(n * 16 + fr, ks * 4 + fq));
                    oa[n] = __builtin_amdgcn_mfma_f32_16x16x32_bf16(af, bfr, oa[n], 0, 0, 0);
                }
            }
            __syncthreads();
        }
#pragma unroll
        for (int i = 0; i < 4; ++i) {
            const int idx = tid + 256 * i, r = idx >> 4, c16 = idx & 15;
            *(u32x4*)(sK + swz16(r, c16)) = iv[i];
        }
        __syncthreads();
#pragma unroll
        for (int ks = 0; ks < 2; ++ks) {
            const bf16x8 af = *(const bf16x8*)(sP + swz(wid * 16 + fr, ks * 4 + fq));
#pragma unroll
            for (int n = 0; n < 8; ++n) {
                const bf16x8 bfr = tr_frag16(sK, trb, ks, n);
                oa[n] = __builtin_amdgcn_mfma_f32_16x16x32_bf16(af, bfr, oa[n], 0, 0, 0);
            }
        }
        float ss[4] = {0.f, 0.f, 0.f, 0.f};
#pragma unroll
        for (int n = 0; n < 8; ++n)
#pragma unroll
            for (int j = 0; j < 4; ++j) ss[j] += oa[n][j] * oa[n][j];
#pragma unroll
        for (int j = 0; j < 4; ++j) {
            ss[j] += __shfl_xor(ss[j], 1, 64); ss[j] += __shfl_xor(ss[j], 2, 64); ss[j] += __shfl_xor(ss[j], 4, 64); ss[j] += __shfl_xor(ss[j], 8, 64);
        }
#pragma unroll
        for (int j = 0; j < 4; ++j) {
            const size_t row = row0 + wid * 16 + fq * 4 + j;
            const float rstd = rsqrtf(ss[j] * (1.f / 128.f) + RMS_EPS);
#pragma unroll
            for (int n = 0; n < 8; ++n) {
                const int dv = n * 16 + fr;
                const float g = bf2f(*(const bf16_t*)(sG + (wid * 16 + fq * 4 + j) * 256 + dv * 2));
                const float y = oa[n][j] * rstd * p.hg_nw[h * 128 + dv] * (g / (1.f + __expf(-g)));
                p.mixin()[row * 768 + h * 128 + dv] = f2bf(y);
            }
        }
    }
}

__device__ __forceinline__ TrBase tr8_base(int lane) {
    const int g = lane >> 4, q = (lane & 15) >> 2, pp = lane & 3;
    const int xl = 4 * (g & 1) + (q >> 1), h = pp >> 1;
    TrBase t;
    t.lo = (8 * g + q) * 128 + ((xl >> 1) << 5) + ((h ^ (xl & 1)) << 4) + 8 * (pp & 1);
    t.hi = (t.lo + 512) ^ 32;
    return t;
}
__device__ __forceinline__ bf16x8 tr_frag8(const char* tile, const TrBase& tb, int ks, int c) {
    int cx = c << 5;
    asm volatile("" : "+v"(cx));
    const v4s lo = __builtin_amdgcn_ds_read_tr16_b64_v4i16((LAS v4s*)(tile + ks * 4096 + (tb.lo ^ cx)));
    const v4s hi = __builtin_amdgcn_ds_read_tr16_b64_v4i16((LAS v4s*)(tile + ks * 4096 + (tb.hi ^ cx)));
    return bf16x8{lo[0], lo[1], lo[2], lo[3], hi[0], hi[1], hi[2], hi[3]};
}

__device__ void ph_attn(const Params& p, char* smem0) {
    const VB vbk = make_vb(smem0);
    char* smem = vbk.smem;
    const int tid = vbk.tid, lane = tid & 63, wid = tid >> 6, fr = lane & 15, fq = lane >> 4;
    char* sQ = smem;
    char* sK = smem + 8192;
    char* sP = sK;
    char* sV = smem + 33792;
    float* sBias = (float*)(smem + 58368);
    const TrBase trb = tr8_base(lane);
    for (int u = vbk.vb; u < 3072; u += vbk.nvb) {
        const int ti = u & 63, gq = u >> 6, g = gq % 3, bhh = gq / 3, hh = bhh & 3, b = bhh >> 2;
        const int lsh = (g == 0) ? 0 : (g == 1 ? 2 : 4), dl = 1 << lsh;
        const int tpr = (S >> lsh) >> 6;
        const int r = ti / tpr, j0 = (ti % tpr) * 64;
        const bf16_t* base = p.proj() + (size_t)b * S * INW + (g * 4 + hh) * 64;
        __syncthreads();
#pragma unroll
        for (int i = 0; i < 2; ++i) {
            const int idx = tid + 256 * i, row = idx >> 3, ch = idx & 7;
            const int tok = (j0 + row) * dl + r;
            *(u32x4*)(sQ + swz(row, ch)) = *(const u32x4*)(base + (size_t)tok * INW + OFF_AQ + ch * 8);
        }
#pragma unroll
        for (int i = 0; i < 6; ++i) {
            const int idx = tid + 256 * i, row = idx >> 3, ch = idx & 7;
            const int j = j0 - 128 + row;
            u32x4 kx = {0u, 0u, 0u, 0u}, vx = {0u, 0u, 0u, 0u};
            if (j >= 0) {
                const size_t o = (size_t)(j * dl + r) * INW + ch * 8;
                kx = *(const u32x4*)(base + o + OFF_AK);
                vx = *(const u32x4*)(base + o + OFF_AV);
            }
            *(u32x4*)(sK + swz(row, ch)) = kx;
            *(u32x4*)(sV + swz(row, ch)) = vx;
        }
        if (tid < 129) sBias[tid] = p.biasT()[(g * 129 + tid) * 4 + hh];
        __syncthreads();
        f32x4 sa[12];
#pragma unroll
        for (int n = 0; n < 12; ++n) sa[n] = f32x4{0.f, 0.f, 0.f, 0.f};
#pragma unroll
        for (int ks = 0; ks < 2; ++ks) {
            const bf16x8 af = *(const bf16x8*)(sQ + swz(wid * 16 + fr, ks * 4 + fq));
#pragma unroll
            for (int n = 0; n < 12; ++n) {
                const bf16x8 bfr = *(const bf16x8*)(sK + swz(n * 16 + fr, ks * 4 + fq));
                sa[n] = __builtin_amdgcn_mfma_f32_16x16x32_bf16(af, bfr, sa[n], 0, 0, 0);
            }
        }
        float mx[4] = {-INFINITY, -INFINITY, -INFINITY, -INFINITY};
#pragma unroll
        for (int n = 0; n < 12; ++n)
#pragma unroll
            for (int j = 0; j < 4; ++j) {
                const int jj = wid * 16 + fq * 4 + j, kk = n * 16 + fr, m = jj + 128 - kk;
                const bool valid = (m >= 0) && (m <= 128) && (j0 - 128 + kk >= 0);
                const int mc = m < 0 ? 0 : (m > 128 ? 128 : m);
                const float v = valid ? sa[n][j] * 0.125f + sBias[mc] : -INFINITY;
                sa[n][j] = v;
                mx[j] = fmaxf(mx[j], v);
            }
#pragma unroll
        for (int j = 0; j < 4; ++j) {
            mx[j] = fmaxf(mx[j], __shfl_xor(mx[j], 1, 64)); mx[j] = fmaxf(mx[j], __shfl_xor(mx[j], 2, 64));
            mx[j] = fmaxf(mx[j], __shfl_xor(mx[j], 4, 64)); mx[j] = fmaxf(mx[j], __shfl_xor(mx[j], 8, 64));
        }
        float ls[4] = {0.f, 0.f, 0.f, 0.f};
#pragma unroll
        for (int n = 0; n < 12; ++n)
#pragma unroll
            for (int j = 0; j < 4; ++j) { const float pe = __expf(sa[n][j] - mx[j]); sa[n][j] = pe; ls[j] += pe; }
#pragma unroll
        for (int j = 0; j < 4; ++j) {
            ls[j] += __shfl_xor(ls[j], 1, 64); ls[j] += __shfl_xor(ls[j], 2, 64); ls[j] += __shfl_xor(ls[j], 4, 64); ls[j] += __shfl_xor(ls[j], 8, 64);
        }
        __syncthreads();
#pragma unroll
        for (int n = 0; n < 12; ++n)
#pragma unroll
            for (int j = 0; j < 4; ++j) *(bf16_t*)(sP + (wid * 16 + fq * 4 + j) * 400 + (n * 16 + fr) * 2) = f2bf(sa[n][j]);
        f32x4 oa[4];
#pragma unroll
        for (int n = 0; n < 4; ++n) oa[n] = f32x4{0.f, 0.f, 0.f, 0.f};
#pragma unroll
        for (int ks = 0; ks < 6; ++ks) {
            const bf16x8 af = *(const bf16x8*)(sP + (wid * 16 + fr) * 400 + (ks * 4 + fq) * 16);
#pragma unroll
            for (int n = 0; n < 4; ++n) {
                const bf16x8 bfr = tr_frag8(sV, trb, ks, n);
                oa[n] = __builtin_amdgcn_mfma_f32_16x16x32_bf16(af, bfr, oa[n], 0, 0, 0);
            }
        }
#pragma unroll
        for (int j = 0; j < 4; ++j) {
            const int jj = wid * 16 + fq * 4 + j;
            const size_t row = (size_t)g * T + (size_t)b * S + (j0 + jj) * dl + r;
            const float inv = 1.f / ls[j];
#pragma unroll
            for (int n = 0; n < 4; ++n) p.ao()[row * 256 + hh * 64 + n * 16 + fr] = oa[n][j] * inv;
            if (fr == 0) p.alse()[row * 4 + hh] = mx[j] + __logf(ls[j]);
        }
    }
}

__device__ void ph_attn_merge(const Params& p) {
    const int tid = otid(), lane = tid & 63, wid = tid >> 6;
    for (int row = blockIdx.x * 8 + wid; row < T; row += gridDim.x * 8) {
        const int hh = lane >> 4;
        const float l0 = p.alse()[((size_t)0 * T + row) * 4 + hh], l1 = p.alse()[((size_t)1 * T + row) * 4 + hh], l2 = p.alse()[((size_t)2 * T + row) * 4 + hh];
        const float mxl = fmaxf(l0, fmaxf(l1, l2));
        float e0 = __expf(l0 - mxl), e1 = __expf(l1 - mxl), e2 = __expf(l2 - mxl);
        const float inv = 1.f / (e0 + e1 + e2);
        e0 *= inv; e1 *= inv; e2 *= inv;
        const f32x4 a0 = *(const f32x4*)(p.ao() + ((size_t)0 * T + row) * 256 + lane * 4);
        const f32x4 a1 = *(const f32x4*)(p.ao() + ((size_t)1 * T + row) * 256 + lane * 4);
        const f32x4 a2 = *(const f32x4*)(p.ao() + ((size_t)2 * T + row) * 256 + lane * 4);
        uint2 o;
        o.x = pack2(a0[0] * e0 + a1[0] * e1 + a2[0] * e2, a0[1] * e0 + a1[1] * e1 + a2[1] * e2);
        o.y = pack2(a0[2] * e0 + a1[2] * e1 + a2[2] * e2, a0[3] * e0 + a1[3] * e1 + a2[3] * e2);
        *(uint2*)(p.mixin() + (size_t)row * 768 + 512 + lane * 4) = o;
    }
}

__device__ void ph_outproj(const Params& p, char* smem) {
    const int tid = otid(), lane = tid & 63, wid = tid >> 6, wr = wid >> 1, wc = wid & 1;
    const int xcd = blockIdx.x & 7, nbx = gridDim.x >> 3;
    for (int i = blockIdx.x >> 3; i < 32; i += nbx) {
        const int nt = i >> 3, mt = xcd * 8 + (i & 7);
        const bf16_t* A = p.mixin() + (size_t)mt * 256 * 768;
        const bf16_t* Bt = p.woutT() + (size_t)nt * 256 * 768;
        f32x4 acc[4][8];
        __syncthreads();
        gemm4(smem, 768, [&](int r) { return A + (size_t)r * 768; }, [&](int n) { return Bt + (size_t)n * 768; }, acc);
        const int b = (mt * 256) >> 12;
        const int colb = nt * 256 + wc * 128;
        const float* g1 = p.mod() + b * 6144 + 2048 + colb;
        char* wl = smem + wid * EPI_WAVE;
#pragma unroll
        for (int m = 0; m < 4; ++m) {
            const size_t rbase = (size_t)(mt * 256 + wr * 64 + m * 16) * D + colb;
            epi_f32(wl, lane, [&](int n, int j) { return acc[m][n][j]; },
                    [&](int row, int ch, f32x4 v) {
                        const f32x4 xv = *(const f32x4*)(p.x + rbase + (size_t)row * D + ch * 4);
                        const f32x4 gv = *(const f32x4*)(g1 + ch * 4);
                        f32x4 o;
                        o[0] = ALPHA * xv[0] + gv[0] * v[0]; o[1] = ALPHA * xv[1] + gv[1] * v[1];
                        o[2] = ALPHA * xv[2] + gv[2] * v[2]; o[3] = ALPHA * xv[3] + gv[3] * v[3];
                        *(f32x4*)(p.pre1() + rbase + (size_t)row * D + ch * 4) = o;
                    });
        }
    }
}

__device__ void ph_ln1(const Params& p) {
    const int tid = otid(), lane = tid & 63, wid = tid >> 6;
    const int rstride = gridDim.x * 8;
    float4 nv[4];
    {
        const float4* xr = (const float4*)(p.pre1() + (size_t)(blockIdx.x * 8 + wid) * D);
#pragma unroll
        for (int i = 0; i < 4; ++i) nv[i] = xr[lane + 64 * i];
    }
    for (int row = blockIdx.x * 8 + wid; row < T; row += rstride) {
        float4 v[4];
        float s = 0.f;
#pragma unroll
        for (int i = 0; i < 4; ++i) { v[i] = nv[i]; s += v[i].x + v[i].y + v[i].z + v[i].w; }
        if (row + rstride < T) {
            const float4* xn = (const float4*)(p.pre1() + (size_t)(row + rstride) * D);
#pragma unroll
            for (int i = 0; i < 4; ++i) nv[i] = xn[lane + 64 * i];
        }
        float mean = wave_sum(s) * (1.f / D);
        float q = 0.f;
#pragma unroll
        for (int i = 0; i < 4; ++i) {
            v[i].x -= mean; v[i].y -= mean; v[i].z -= mean; v[i].w -= mean;
            q += v[i].x * v[i].x + v[i].y * v[i].y + v[i].z * v[i].z + v[i].w * v[i].w;
        }
        float rstd = rsqrtf(wave_sum(q) * (1.f / D) + LN_EPS);
        s = 0.f;
#pragma unroll
        for (int i = 0; i < 4; ++i) {
            const int col = (lane + 64 * i) * 4;
            const float4 g4 = *(const float4*)(p.ln1_g + col), b4 = *(const float4*)(p.ln1_b + col);
            v[i].x = v[i].x * rstd * g4.x + b4.x; v[i].y = v[i].y * rstd * g4.y + b4.y;
            v[i].z = v[i].z * rstd * g4.z + b4.z; v[i].w = v[i].w * rstd * g4.w + b4.w;
            { uint2 xo; xo.x = pack2(v[i].x, v[i].y); xo.y = pack2(v[i].z, v[i].w); *(uint2*)(p.x1() + (size_t)row * D + col) = xo; }
            s += v[i].x + v[i].y + v[i].z + v[i].w;
        }
        mean = wave_sum(s) * (1.f / D);
        q = 0.f;
#pragma unroll
        for (int i = 0; i < 4; ++i) {
            v[i].x -= mean; v[i].y -= mean; v[i].z -= mean; v[i].w -= mean;
            q += v[i].x * v[i].x + v[i].y * v[i].y + v[i].z * v[i].z + v[i].w * v[i].w;
        }
        rstd = rsqrtf(wave_sum(q) * (1.f / D) + LN_EPS);
        const int b = row >> 12;
        const float* sh = p.mod() + b * 6144 + 3072;
        const float* sc = sh + 1024;
#pragma unroll
        for (int i = 0; i < 4; ++i) {
            const int col = (lane + 64 * i) * 4;
            const float4 s4 = *(const float4*)(sc + col), h4 = *(const float4*)(sh + col);
            float4 y;
            y.x = v[i].x * rstd * (1.f + s4.x) + h4.x; y.y = v[i].y * rstd * (1.f + s4.y) + h4.y;
            y.z = v[i].z * rstd * (1.f + s4.z) + h4.z; y.w = v[i].w * rstd * (1.f + s4.w) + h4.w;
            uint2 o;
            o.x = pack2(y.x, y.y); o.y = pack2(y.z, y.w);
            *(uint2*)(p.h2() + (size_t)row * 2048 + col) = o;
            uint2 o2;
            o2.x = pack2(y.x - __uint_as_float(o.x << 16), y.y - __uint_as_float(o.x & 0xffff0000u));
            o2.y = pack2(y.z - __uint_as_float(o.y << 16), y.w - __uint_as_float(o.y & 0xffff0000u));
            *(uint2*)(p.h2() + (size_t)row * 2048 + 1024 + col) = o2;
        }
    }
}

__device__ void ph_router_gemm(const Params& p, char* smem) {
    const int tid = otid(), lane = tid & 63, wid = tid >> 6, wr = wid >> 1, wc = wid & 1;
    for (int u = blockIdx.x; u < 192; u += gridDim.x) {
        const int pass = u >> 6, mt = u & 63;
        const bf16_t* A = p.h2() + (size_t)mt * 256 * 2048 + (pass == 1 ? 1024 : 0);
        const bf16_t* Bt = p.wrT() + (pass == 2 ? (size_t)NE * D : 0);
        f32x4 acc[4][8];
        __syncthreads();
        gemm4(smem, D, [&](int r) { return A + (size_t)r * 2048; }, [&](int n) { return Bt + (size_t)n * D; }, acc);
        char* wl = smem + wid * EPI_WAVE;
#pragma unroll
        for (int m = 0; m < 4; ++m) {
            float* dst = p.lgp() + (size_t)pass * T * NE + (size_t)(mt * 256 + wr * 64 + m * 16) * NE + wc * 128;
            epi_f32(wl, lane, [&](int n, int j) { return acc[m][n][j]; },
                    [&](int row, int ch, f32x4 v) { *(f32x4*)(dst + (size_t)row * NE + ch * 4) = v; });
        }
    }
}

__device__ void ph_topk(const Params& p) {
    const int tid = otid(), lane = tid & 63, wid = tid >> 6;
    constexpr int TK = 4;
    for (int tok0 = (blockIdx.x * 8 + wid) * TK; tok0 < T; tok0 += gridDim.x * 8 * TK) {
        float sc[TK][4], bv[TK][4];
#pragma unroll
        for (int t = 0; t < TK; ++t)
#pragma unroll
            for (int j = 0; j < 4; ++j) {
                const int e = j * 64 + lane;
                const size_t o = (size_t)(tok0 + t) * NE + e;
                const float x = (p.lgp()[o] + p.lgp()[(size_t)T * NE + o]) + p.lgp()[(size_t)2 * T * NE + o];
                sc[t][j] = 1.f / (1.f + expf(-x));
                bv[t][j] = sc[t][j] + p.router_bias[e];
            }
        float gsum[TK][4];
#pragma unroll
        for (int j = 0; j < 4; ++j) {
            float m1[TK], m2[TK];
#pragma unroll
            for (int t = 0; t < TK; ++t) m1[t] = bv[t][j];
#pragma unroll
            for (int o = 16; o > 0; o >>= 1)
#pragma unroll
                for (int t = 0; t < TK; ++t) m1[t] = fmaxf(m1[t], __shfl_xor(m1[t], o, 64));
#pragma unroll
            for (int t = 0; t < TK; ++t) {
                const unsigned long long bal = __ballot(bv[t][j] == m1[t]);
                const unsigned hm = (unsigned)(bal >> (lane & 32));
                const int first = __ffs(hm) - 1;
                m2[t] = ((lane & 31) == first) ? -INFINITY : bv[t][j];
            }
#pragma unroll
            for (int o = 16; o > 0; o >>= 1)
#pragma unroll
                for (int t = 0; t < TK; ++t) m2[t] = fmaxf(m2[t], __shfl_xor(m2[t], o, 64));
#pragma unroll
            for (int t = 0; t < TK; ++t) gsum[t][j] = m1[t] + m2[t];
        }
        float cand[TK][4];
#pragma unroll
        for (int t = 0; t < TK; ++t) {
            float gs[8];
#pragma unroll
            for (int j = 0; j < 4; ++j) { gs[2 * j] = __shfl(gsum[t][j], 0, 64); gs[2 * j + 1] = __shfl(gsum[t][j], 32, 64); }
            unsigned gmask = 0u;
#pragma unroll
            for (int r = 0; r < 4; ++r) {
                float best = -INFINITY; int bi = 0;
#pragma unroll
                for (int g = 0; g < 8; ++g) {
                    const bool ok = (((gmask >> g) & 1u) == 0u) && (gs[g] > best);
                    if (ok) { best = gs[g]; bi = g; }
                }
                gmask |= 1u << bi;
            }
#pragma unroll
            for (int j = 0; j < 4; ++j) cand[t][j] = ((gmask >> (2 * j + (lane >> 5))) & 1u) ? bv[t][j] : -INFINITY;
        }
        float wsum[TK], myw[TK];
        int mye[TK];
#pragma unroll
        for (int t = 0; t < TK; ++t) { wsum[t] = 0.f; myw[t] = 0.f; mye[t] = 0; }
#pragma unroll
        for (int r = 0; r < 8; ++r) {
            float bvv[TK]; int be[TK];
#pragma unroll
            for (int t = 0; t < TK; ++t) {
                bvv[t] = cand[t][0]; be[t] = lane;
#pragma unroll
                for (int j = 1; j < 4; ++j) if (cand[t][j] > bvv[t]) { bvv[t] = cand[t][j]; be[t] = j * 64 + lane; }
            }
#pragma unroll
            for (int o = 32; o > 0; o >>= 1)
#pragma unroll
                for (int t = 0; t < TK; ++t) {
                    const float ov = __shfl_xor(bvv[t], o, 64);
                    const int oe = __shfl_xor(be[t], o, 64);
                    if (ov > bvv[t] || (ov == bvv[t] && oe < be[t])) { bvv[t] = ov; be[t] = oe; }
                }
#pragma unroll
            for (int t = 0; t < TK; ++t) {
                const int bj = be[t] >> 6;
                const float mysc = bj == 0 ? sc[t][0] : (bj == 1 ? sc[t][1] : (bj == 2 ? sc[t][2] : sc[t][3]));
                const float sval = __shfl(mysc, be[t] & 63, 64);
#pragma unroll
                for (int j = 0; j < 4; ++j) if (be[t] == j * 64 + lane) cand[t][j] = -INFINITY;
                wsum[t] += sval;
                if (lane == r) { myw[t] = sval; mye[t] = be[t]; }
            }
        }
        if (lane < 8) {
#pragma unroll
            for (int t = 0; t < TK; ++t) {
                const int a = (tok0 + t) * 8 + lane;
                p.topi()[a] = mye[t];
                p.topw()[a] = myw[t] * (2.5f / wsum[t]);
            }
        }
    }
}

__device__ void ph_lists(const Params& p, char* smem) {
    const int tid = otid(), lane = tid & 63, wid = tid >> 6;
    int* wtot = (int*)smem;
    for (int e = blockIdx.x; e < NE; e += gridDim.x) {
        __syncthreads();
        const int4* src = (const int4*)p.topi() + wid * 4096;
        int cntw = 0;
        for (int i = 0; i < 64; ++i) {
            const int4 v = src[i * 64 + lane];
            cntw += __popcll(__ballot(v.x == e)) + __popcll(__ballot(v.y == e)) + __popcll(__ballot(v.z == e)) + __popcll(__ballot(v.w == e));
        }
        if (lane == 0) wtot[wid] = cntw;
        __syncthreads();
        int base = 0, tot = 0;
        for (int w = 0; w < 8; ++w) { const int c = wtot[w]; if (w < wid) base += c; tot += c; }
        if (tid == 0) p.cnt()[e] = tot;
        int* dst = p.list() + (size_t)e * T;
        const unsigned long long lt = (1ull << lane) - 1ull;
        for (int i = 0; i < 64; ++i) {
            const int4 v = src[i * 64 + lane];
            const int a0 = (wid * 4096 + i * 64 + lane) * 4;
            unsigned long long m;
            m = __ballot(v.x == e); if (v.x == e) dst[base + __popcll(m & lt)] = a0;     base += __popcll(m);
            m = __ballot(v.y == e); if (v.y == e) dst[base + __popcll(m & lt)] = a0 + 1; base += __popcll(m);
            m = __ballot(v.z == e); if (v.z == e) dst[base + __popcll(m & lt)] = a0 + 2; base += __popcll(m);
            m = __ballot(v.w == e); if (v.w == e) dst[base + __popcll(m & lt)] = a0 + 3; base += __popcll(m);
        }
    }
}

struct ExpMap { int* cnt; int* off; int* tile; };
__device__ __forceinline__ ExpMap exp_map(const Params& p, char* smem) {
    ExpMap m;
    m.cnt = (int*)(smem + 98304); m.off = m.cnt + 256; m.tile = m.off + 256;
    const int tid = otid();
    __syncthreads();
    if (tid < NE) m.cnt[tid] = p.cnt()[tid];
    __syncthreads();
    if (tid == 0) {
        int off = 0, tl = 0;
        for (int e = 0; e < NE; ++e) { m.off[e] = off; m.tile[e] = tl; const int c = m.cnt[e]; off += c; tl += (c + 255) >> 8; }
        m.tile[NE] = tl;
    }
    __syncthreads();
    return m;
}
__device__ __forceinline__ int find_expert(const int* tile, int rt) {
    int lo = 0, hi = NE;
    while (hi - lo > 1) { const int mid = (lo + hi) >> 1; if (tile[mid] <= rt) lo = mid; else hi = mid; }
    return lo;
}
#define ROWA(smem) ((int*)((smem) + 98304 + 3328))
#define ROWW(smem) ((float*)((smem) + 98304 + 3328 + 1024))


struct UnitQ { int* ctr; int lo, hi; int* slot; };
__device__ __forceinline__ int uq_claim(const UnitQ& q) { return q.lo + (int)__hip_atomic_fetch_add(q.ctr, 1, __ATOMIC_RELAXED, __HIP_MEMORY_SCOPE_AGENT); }

__device__ void ph_gateup(const Params& p, char* smem) {
    const int tid = otid(), lane = tid & 63, wid = tid >> 6, wr = wid >> 1, wc = wid & 1;
    const ExpMap em = exp_map(p, smem);
    int* rowA = ROWA(smem);
    const int ntile = em.tile[NE];
    const int U = (ntile + T / 256) * 2;
    const int xcd = blockIdx.x & 7, nbx = gridDim.x >> 3;
    const int lo = (int)(((long long)U * xcd) >> 3), hi = (int)(((long long)U * (xcd + 1)) >> 3);
    int* qslot = (int*)(smem + 98304 + 8192);
    UnitQ uq; uq.ctr = p.cnt() + 512 + xcd * 16; uq.lo = lo; uq.hi = hi; uq.slot = qslot;
    (void)nbx;
    int unext = 0;
    if (tid == 0) unext = uq_claim(uq);
    for (;;) {
        __syncthreads();
        if (tid == 0) { *qslot = unext; unext = uq_claim(uq); }
        __syncthreads();
        const int u = *qslot;
        if (u >= hi) break;
        const int rt = u >> 1, c0 = (u & 1) * 128;
        const float *Wg, *Wu;
        bf16_t* gdst;
        int nrow, tokv = -1;
        if (rt < ntile) {
            const int e = find_expert(em.tile, rt);
            const int r0 = (rt - em.tile[e]) * 256, ne = em.cnt[e];
            Wg = p.w_eg + (size_t)e * D * ED; Wu = p.w_eu + (size_t)e * D * ED;
            gdst = p.gbuf() + ((size_t)em.off[e] + r0) * ED + c0;
            nrow = ne - r0;
            if (tid < 256 && r0 + tid < ne) tokv = p.list()[(size_t)e * T + r0 + tid] >> 3;
        } else {
            const int tb = (rt - ntile) * 256;
            Wg = p.w_sg; Wu = p.w_su;
            gdst = p.gsh() + (size_t)tb * ED + c0;
            nrow = 256;
            tokv = tb + (tid & 255);
        }
        __syncthreads();
        if (tid < 256) rowA[tid] = tokv;
        __syncthreads();
        const int t0 = rowA[0];
        f32x4 acc[4][8];
        gemm3<0>(smem, D,
                 [&](int r) { const int t = rowA[r]; return p.h2() + (size_t)(t < 0 ? t0 : t) * 2048; },
                 [&](int n) { const int t16 = n >> 4; return ((t16 & 1) ? Wu : Wg) + c0 + 16 * (t16 >> 1) + (n & 15); },
                 ED, acc, nrow);
        if (wr * 64 < nrow) {
            char* wl = smem + wid * EPI_WAVE;
#pragma unroll
            for (int m = 0; m < 4; ++m) {
                const int rb = wr * 64 + m * 16;
                epi_bf16(wl, lane,
                         [&](int n, int j) { if (n >= 4) return 0.f; const float g = acc[m][2 * n][j], uu = acc[m][2 * n + 1][j]; return g / (1.f + __expf(-g)) * uu; },
                         [&](int row, int ch, u32x4 v) { if (ch < 8 && rb + row < nrow) *(u32x4*)(gdst + (size_t)(rb + row) * ED + wc * 64 + ch * 8) = v; });
            }
        }
    }
}

__device__ void ph_down(const Params& p, char* smem) {
    const int tid = otid(), lane = tid & 63, wid = tid >> 6, wr = wid >> 1, wc = wid & 1;
    const ExpMap em = exp_map(p, smem);
    int* rowA = ROWA(smem);
    float* rowW = ROWW(smem);
    const int ntile = em.tile[NE];
    const int U = (ntile + T / 256) * 4;
    const int xcd = blockIdx.x & 7, nbx = gridDim.x >> 3;
    const int lo = (int)(((long long)U * xcd) >> 3), hi = (int)(((long long)U * (xcd + 1)) >> 3);
    int* qslot = (int*)(smem + 98304 + 8192);
    UnitQ uq; uq.ctr = p.cnt() + 768 + xcd * 16; uq.lo = lo; uq.hi = hi; uq.slot = qslot;
    (void)nbx;
    int unext = 0;
    if (tid == 0) unext = uq_claim(uq);
    for (;;) {
        __syncthreads();
        if (tid == 0) { *qslot = unext; unext = uq_claim(uq); }
        __syncthreads();
        const int u = *qslot;
        if (u >= hi) break;
        const int rt = u >> 2, nt = u & 3;
        const bf16_t* A;
        const float* W;
        int nrow, slot = -1;
        float wv = 0.f;
        if (rt < ntile) {
            const int e = find_expert(em.tile, rt);
            const int r0 = (rt - em.tile[e]) * 256, ne = em.cnt[e];
            A = p.gbuf() + ((size_t)em.off[e] + r0) * ED;
            W = p.w_ed + (size_t)e * ED * D + nt * 256;
            nrow = ne - r0;
            if (tid < 256 && r0 + tid < ne) {
                const int a = p.list()[(size_t)e * T + r0 + tid];
                slot = (a >> 3) * 9 + (a & 7);
                wv = p.topw()[a];
            }
        } else {
            const int tb = (rt - ntile) * 256;
            A = p.gsh() + (size_t)tb * ED;
            W = p.w_sd + nt * 256;
            nrow = 256;
            slot = (tb + (tid & 255)) * 9 + 8;
            wv = 1.f;
        }
        __syncthreads();
        if (tid < 256) { rowA[tid] = slot; rowW[tid] = wv; }
        __syncthreads();
        f32x4 acc[4][8];
        gemm3<0>(smem, ED, [&](int r) { return A + (size_t)(r < nrow ? r : 0) * ED; }, [&](int n) { return W + n; }, D, acc, nrow);
        if (wr * 64 < nrow) {
            char* wl = smem + wid * EPI_WAVE;
#pragma unroll
            for (int m = 0; m < 4; ++m) {
                const int rb = wr * 64 + m * 16;
                float wj[4];
#pragma unroll
                for (int j = 0; j < 4; ++j) wj[j] = rowW[rb + (lane >> 4) * 4 + j];
                epi_bf16(wl, lane, [&](int n, int j) { return acc[m][n][j] * wj[j]; },
                         [&](int row, int ch, u32x4 v) {
                             const int sl = rowA[rb + row];
                             if (sl >= 0) *(u32x4*)(p.ybuf() + (size_t)sl * D + nt * 256 + wc * 128 + ch * 8) = v;
                         });
            }
        }
    }
}

__device__ void ph_final(const Params& p) {
    const int tid = otid(), lane = tid & 63, wid = tid >> 6;
    for (int row = blockIdx.x * 8 + wid; row < T; row += gridDim.x * 8) {
        const int b = row >> 12;
        const float* g2 = p.mod() + b * 6144 + 5120;
        float4 v[4];
        float s = 0.f;
#pragma unroll
        for (int i = 0; i < 4; ++i) {
            const int col = (lane + 64 * i) * 4;
            float f0 = 0.f, f1 = 0.f, f2 = 0.f, f3 = 0.f;
#pragma unroll
            for (int k = 0; k < 9; ++k) {
                const uint2 w = *(const uint2*)(p.ybuf() + ((size_t)row * 9 + k) * D + col);
                f0 += __uint_as_float(w.x << 16); f1 += __uint_as_float(w.x & 0xffff0000u);
                f2 += __uint_as_float(w.y << 16); f3 += __uint_as_float(w.y & 0xffff0000u);
            }
            float4 xv;
            { const uint2 xw = *(const uint2*)(p.x1() + (size_t)row * D + col);
              xv.x = __uint_as_float(xw.x << 16); xv.y = __uint_as_float(xw.x & 0xffff0000u); xv.z = __uint_as_float(xw.y << 16); xv.w = __uint_as_float(xw.y & 0xffff0000u); }
            const float4 g4 = *(const float4*)(g2 + col);
            v[i].x = ALPHA * xv.x + g4.x * f0; v[i].y = ALPHA * xv.y + g4.y * f1;
            v[i].z = ALPHA * xv.z + g4.z * f2; v[i].w = ALPHA * xv.w + g4.w * f3;
            s += v[i].x + v[i].y + v[i].z + v[i].w;
        }
        const float mean = wave_sum(s) * (1.f / D);
        float q = 0.f;
#pragma unroll
        for (int i = 0; i < 4; ++i) {
            v[i].x -= mean; v[i].y -= mean; v[i].z -= mean; v[i].w -= mean;
            q += v[i].x * v[i].x + v[i].y * v[i].y + v[i].z * v[i].z + v[i].w * v[i].w;
        }
        const float rstd = rsqrtf(wave_sum(q) * (1.f / D) + LN_EPS);
#pragma unroll
        for (int i = 0; i < 4; ++i) {
            const int col = (lane + 64 * i) * 4;
            const float4 g4 = *(const float4*)(p.ln2_g + col), b4 = *(const float4*)(p.ln2_b + col);
            float4 y;
            y.x = v[i].x * rstd * g4.x + b4.x; y.y = v[i].y * rstd * g4.y + b4.y;
            y.z = v[i].z * rstd * g4.z + b4.z; y.w = v[i].w * rstd * g4.w + b4.w;
            *(float4*)(p.out + (size_t)row * D + col) = y;
        }
    }
}

constexpr int LDS_BYTES = 2 * VB_LDS + 16;
constexpr int NPHASE = 14;

template <int PH>
__device__ __forceinline__ void run_phase(const Params& p, char* smem) {
    if (PH == 0) ph_mod(p, smem);
    if (PH == 1) ph_ln0(p);
    if (PH == 2) ph_inproj(p, smem);
    if (PH == 3) { ph_h1(p, smem); ph_attn(p, smem); }
    if (PH == 4) { ph_h2(p); ph_attn_merge(p); }
    if (PH == 5) ph_h3(p, smem);
    if (PH == 6) ph_outproj(p, smem);
    if (PH == 7) ph_ln1(p);
    if (PH == 8) ph_router_gemm(p, smem);
    if (PH == 9) ph_topk(p);
    if (PH == 10) ph_lists(p, smem);
    if (PH == 11) ph_gateup(p, smem);
    if (PH == 12) ph_down(p, smem);
    if (PH == 13) ph_final(p);
}

template <int PH>
__global__ void __launch_bounds__(NTHREADS, 2) k_phase(Params p) {
    extern __shared__ __attribute__((aligned(16))) char smem[];
    run_phase<PH>(p, smem);
}

__global__ void __launch_bounds__(NTHREADS, 2) k_all(Params p) {
    extern __shared__ __attribute__((aligned(16))) char smem[];
    volatile LAS unsigned* st = (volatile LAS unsigned*)(smem + LDS_BYTES - 16);
    if (threadIdx.x == 0) { st[0] = 0u; st[1] = 0u; st[2] = 0u; st[3] = 0u; }
    __syncthreads();
    XcdBarrier bar = xcd_barrier_post(p.bar(), st);
    run_phase<0>(p, smem); xcd_barrier(bar);
    run_phase<1>(p, smem); xcd_barrier(bar);
    run_phase<2>(p, smem); xcd_barrier(bar);
    run_phase<3>(p, smem); xcd_barrier(bar);
    run_phase<4>(p, smem); xcd_barrier(bar);
    run_phase<5>(p, smem); xcd_barrier(bar);
    run_phase<6>(p, smem); xcd_barrier(bar);
    run_phase<7>(p, smem); xcd_barrier(bar);
    run_phase<8>(p, smem); xcd_barrier(bar);
    run_phase<9>(p, smem); xcd_barrier(bar);
    run_phase<10>(p, smem); xcd_barrier(bar);
    run_phase<11>(p, smem); xcd_barrier(bar);
    run_phase<12>(p, smem); xcd_barrier(bar);
    run_phase<13>(p, smem);
}

template <int PH>
static void launch_phase(const Params& p, int grid, hipStream_t stream) {
    static bool attr = false;
    if (!attr) { (void)hipFuncSetAttribute((const void*)k_phase<PH>, hipFuncAttributeMaxDynamicSharedMemorySize, LDS_BYTES); attr = true; }
    hipLaunchKernelGGL(k_phase<PH>, dim3(grid), dim3(NTHREADS), LDS_BYTES, stream, p);
}

extern "C" void kernel_launch(void* const* d_in, const int* in_sizes, int n_in, void* d_out, int out_size, void* d_ws, size_t ws_size,
                              hipStream_t stream) {
    (void)in_sizes; (void)n_in; (void)out_size;
    Params p{};
    const float** pin = (const float**)&p.x;
    for (int i = 0; i < 21; ++i) pin[i] = (const float*)d_in[i];
    p.out = (float*)d_out;
    p.ws = (char*)d_ws;
    char* ctl = p.ws + WO_ctl;
    if (WS_END > ws_size) { fprintf(stderr, "kernel_launch: workspace too small: need %zu have %zu\n", (size_t)WS_END, ws_size); return; }

    static int grid = 0;
    if (grid == 0) {
        int dev = 0, cus = 0, per_cu = 0;
        (void)hipGetDevice(&dev);
        (void)hipDeviceGetAttribute(&cus, hipDeviceAttributeMultiprocessorCount, dev);
        (void)hipFuncSetAttribute((const void*)k_all, hipFuncAttributeMaxDynamicSharedMemorySize, LDS_BYTES);
        (void)hipOccupancyMaxActiveBlocksPerMultiprocessor(&per_cu, (const void*)k_all, NTHREADS, LDS_BYTES);
        grid = cus;
        if (grid != 256) grid = 256;
        fprintf(stderr, "kernel_launch: cus %d per_cu %d grid %d ws need %zu have %zu\n", cus, per_cu, grid, (size_t)WS_END, ws_size);
    }
    (void)hipMemsetAsync(ctl, 0, 65536, stream);
#if ONE_LAUNCH
    hipLaunchKernelGGL(k_all, dim3(grid), dim3(NTHREADS), LDS_BYTES, stream, p);
#else
    launch_phase<0>(p, grid, stream); launch_phase<1>(p, grid, stream); launch_phase<2>(p, grid, stream); launch_phase<3>(p, grid, stream);
    launch_phase<4>(p, grid, stream); launch_phase<5>(p, grid, stream); launch_phase<6>(p, grid, stream); launch_phase<7>(p, grid, stream);
    launch_phase<8>(p, grid, stream); launch_phase<9>(p, grid, stream); launch_phase<10>(p, grid, stream); launch_phase<11>(p, grid, stream);
    launch_phase<12>(p, grid, stream); launch_phase<13>(p, grid, stream);
#endif
}
```

```cpp
#include <hip/hip_runtime.h>
#include <stdint.h>
#include <stdio.h>

#ifndef ONE_LAUNCH
#define ONE_LAUNCH 1
#endif

constexpr int D = 1024, NBATCH = 4, S = 4096, T = NBATCH * S;
constexpr int INW = 4352;
constexpr int NE = 256, TOPK = 8, ED = 256;
constexpr int OFF_HQ = 0, OFF_HF = 512, OFF_HI = 1024, OFF_HG = 1536, OFF_AQ = 2048, OFF_AK = 2816, OFF_AV = 3584;
constexpr float ALPHA = 1.189207115002721f;
constexpr float LN_EPS = 1e-5f, RMS_EPS = 1e-6f;
constexpr int NTHREADS = 512;
constexpr int VB_LDS = 67584;

typedef unsigned short bf16_t;
using bf16x8 = __attribute__((ext_vector_type(8))) short;
using f32x4 = __attribute__((ext_vector_type(4))) float;
using u32x4 = __attribute__((ext_vector_type(4))) unsigned int;

typedef float v2f_t __attribute__((ext_vector_type(2)));
typedef __bf16 v2bf_t __attribute__((ext_vector_type(2)));
typedef short v4s __attribute__((ext_vector_type(4)));
__device__ __forceinline__ unsigned short f2bf(float f) { return __builtin_bit_cast(unsigned short, (__bf16)f); }
__device__ __forceinline__ float bf2f(unsigned short h) { return __uint_as_float(((uint32_t)h) << 16); }
__device__ __forceinline__ uint32_t pack2(float a, float b) {
    const v2f_t f = {a, b};
    return __builtin_bit_cast(uint32_t, __builtin_convertvector(f, v2bf_t));
}
__device__ __forceinline__ float sigmoidf_(float v) { return 1.f / (1.f + __expf(-v)); }

__device__ __forceinline__ int otid() { int t = threadIdx.x; asm volatile("" : "+v"(t)); return t; }

constexpr size_t al256(size_t x) { return (x + 255) & ~(size_t)255; }
constexpr size_t WO_ctl = 0;
constexpr size_t WO_mod = WO_ctl + al256(65536);
constexpr size_t WO_lbv = WO_mod + al256(4 * 6144 * 4);
constexpr size_t WO_biasT = WO_lbv + al256(512 * 4);
constexpr size_t WO_winT = WO_biasT + al256(3 * 129 * 4 * 4);
constexpr size_t WO_woutT = WO_winT + al256((size_t)INW * D * 2);
constexpr size_t WO_wrT = WO_woutT + al256((size_t)D * 768 * 2);
constexpr size_t WO_wsgT = WO_wrT + al256((size_t)2 * NE * D * 2);
constexpr size_t WO_wsuT = WO_wsgT + al256((size_t)ED * D * 2);
constexpr size_t WO_wsdT = WO_wsuT + al256((size_t)ED * D * 2);
constexpr size_t WO_h1 = WO_wsdT + al256((size_t)D * ED * 2);
constexpr size_t WO_proj = WO_h1 + al256((size_t)T * D * 2);
constexpr size_t WO_lgf = WO_proj + al256((size_t)T * INW * 2);
constexpr size_t WO_ao = WO_lgf + al256((size_t)T * 512 * 4);
constexpr size_t WO_alse = WO_ao + al256((size_t)3 * T * 256 * 4);
constexpr size_t WO_mixin = WO_alse + al256((size_t)3 * T * 4 * 4);
constexpr size_t WO_pre1 = WO_mixin + al256((size_t)T * 768 * 2);
constexpr size_t WO_x1 = WO_pre1 + al256((size_t)T * D * 4);
constexpr size_t WO_h2 = WO_x1 + al256((size_t)T * D * 2);
constexpr size_t WO_lgp = WO_h2 + al256((size_t)T * 2048 * 2);
constexpr size_t WO_topi = WO_lgp + al256((size_t)3 * T * NE * 4);
constexpr size_t WO_topw = WO_topi + al256((size_t)T * 8 * 4);
constexpr size_t WO_list = WO_topw + al256((size_t)T * 8 * 4);
constexpr size_t WO_gbuf = WO_list + al256((size_t)NE * T * 4);
constexpr size_t WO_gsh = WO_gbuf + al256((size_t)T * TOPK * ED * 2);
constexpr size_t WO_ybuf = WO_gsh + al256((size_t)T * ED * 2);
constexpr size_t WO_dec = WO_ybuf + al256((size_t)T * 9 * D * 2);
constexpr size_t WS_END = WO_dec + al256((size_t)1024 * 128 * 4);
struct Params {
    const float *x, *c, *w_ada, *b_ada, *w_in, *hg_lb, *hg_nw, *rel_bias, *w_out, *ln1_g, *ln1_b, *w_router, *router_bias,
        *w_eg, *w_eu, *w_ed, *w_sg, *w_su, *w_sd, *ln2_g, *ln2_b;
    float* out;
    char* ws;
    __device__ __forceinline__ unsigned* bar() const { return (unsigned*)(ws + WO_ctl); }
    __device__ __forceinline__ int* cnt() const { return (int*)(ws + WO_ctl + 16384); }
    __device__ __forceinline__ float* kv() const { return (float*)(ws + WO_ybuf); }
    __device__ __forceinline__ bf16_t* sst() const { return (bf16_t*)(ws + WO_ybuf + (size_t)1024 * 16384 * 4); }
    __device__ __forceinline__ float* mod() const { return (float*)(ws + WO_mod); }
    __device__ __forceinline__ float* lbv() const { return (float*)(ws + WO_lbv); }
    __device__ __forceinline__ float* biasT() const { return (float*)(ws + WO_biasT); }
    __device__ __forceinline__ bf16_t* winT() const { return (bf16_t*)(ws + WO_winT); }
    __device__ __forceinline__ bf16_t* woutT() const { return (bf16_t*)(ws + WO_woutT); }
    __device__ __forceinline__ bf16_t* wrT() const { return (bf16_t*)(ws + WO_wrT); }
    __device__ __forceinline__ bf16_t* wsgT() const { return (bf16_t*)(ws + WO_wsgT); }
    __device__ __forceinline__ bf16_t* wsuT() const { return (bf16_t*)(ws + WO_wsuT); }
    __device__ __forceinline__ bf16_t* wsdT() const { return (bf16_t*)(ws + WO_wsdT); }
    __device__ __forceinline__ bf16_t* h1() const { return (bf16_t*)(ws + WO_h1); }
    __device__ __forceinline__ bf16_t* proj() const { return (bf16_t*)(ws + WO_proj); }
    __device__ __forceinline__ float* lgf() const { return (float*)(ws + WO_lgf); }
    __device__ __forceinline__ float* ao() const { return (float*)(ws + WO_ao); }
    __device__ __forceinline__ float* alse() const { return (float*)(ws + WO_alse); }
    __device__ __forceinline__ bf16_t* mixin() const { return (bf16_t*)(ws + WO_mixin); }
    __device__ __forceinline__ float* pre1() const { return (float*)(ws + WO_pre1); }
    __device__ __forceinline__ bf16_t* x1() const { return (bf16_t*)(ws + WO_x1); }
    __device__ __forceinline__ bf16_t* h2() const { return (bf16_t*)(ws + WO_h2); }
    __device__ __forceinline__ float* lgp() const { return (float*)(ws + WO_lgp); }
    __device__ __forceinline__ int* topi() const { return (int*)(ws + WO_topi); }
    __device__ __forceinline__ float* topw() const { return (float*)(ws + WO_topw); }
    __device__ __forceinline__ int* list() const { return (int*)(ws + WO_list); }
    __device__ __forceinline__ bf16_t* gbuf() const { return (bf16_t*)(ws + WO_gbuf); }
    __device__ __forceinline__ bf16_t* gsh() const { return (bf16_t*)(ws + WO_gsh); }
    __device__ __forceinline__ bf16_t* ybuf() const { return (bf16_t*)(ws + WO_ybuf); }
    __device__ __forceinline__ float* dec() const { return (float*)(ws + WO_dec); }
};

#define XB_TMO      128
#define XB_XCNT(j)  (256  + 64 * (j))
#define XB_XSUB(j)  (1280 + 64 * (j))
#define XB_XGEN(j)  (2304 + 64 * (j))
#define XB_TOP      3328
#define XB_TOPGEN   3392
#define XCD_BAR_WORDS 3456
#define XB_SPIN_CAP (1u << 18)
#define LAS __attribute__((address_space(3)))

__device__ __forceinline__ unsigned xb_ld(unsigned* p)              { return __hip_atomic_load(p, __ATOMIC_RELAXED, __HIP_MEMORY_SCOPE_AGENT); }
__device__ __forceinline__ unsigned xb_add(unsigned* p, unsigned v) { return __hip_atomic_fetch_add(p, v, __ATOMIC_RELAXED, __HIP_MEMORY_SCOPE_AGENT); }
__device__ __forceinline__ unsigned xb_xcc_id() { return (unsigned)__builtin_amdgcn_s_getreg((3 << 11) | 20) & 0xFu; }
#define XB_SPIN(cond, bar) do { unsigned _sp = 0; while (cond) { __builtin_amdgcn_s_sleep(1); \
    if ((++_sp & 255u) == 0u) { if (xb_ld(&(bar)[XB_TMO])) break; if (_sp > XB_SPIN_CAP) { atomicAdd(&(bar)[XB_TMO], 1u); break; } } } } while (0)

struct XcdBarrier {
    unsigned* bar; unsigned x;
    volatile LAS unsigned* st;
};
__device__ __forceinline__ XcdBarrier xcd_barrier_post(unsigned* bar, volatile LAS unsigned* st) {
    XcdBarrier b; b.bar = bar; b.x = xb_xcc_id(); b.st = st;
    if (threadIdx.x == 0) (void)xb_add(&bar[XB_XCNT(b.x)], 1u);
    return b;
}
__device__ __forceinline__ void xcd_barrier_complete(unsigned* bar, unsigned x, unsigned& nloc, unsigned& nx) {
    const unsigned G = gridDim.x * gridDim.y * gridDim.z;
    unsigned sum, cnt, mine, sp = 0u;
    for (;;) {
        sum = 0u; cnt = 0u; mine = 0u;
#pragma unroll
        for (unsigned j = 0; j < 16; ++j) { const unsigned c = xb_ld(&bar[XB_XCNT(j)]); sum += c; cnt += (c > 0u) ? 1u : 0u; mine = (j == x) ? c : mine; }
        if (sum == G) break;
        __builtin_amdgcn_s_sleep(1);
        if ((++sp & 255u) == 0u) { if (xb_ld(&bar[XB_TMO])) break; if (sp > XB_SPIN_CAP) { atomicAdd(&bar[XB_TMO], 1u); break; } }
    }
    nloc = mine > 0u ? mine : 1u; nx = cnt > 0u ? cnt : 1u;
}
__device__ __forceinline__ void xcd_barrier(const XcdBarrier& b) {
    asm volatile("s_waitcnt vmcnt(0)" ::: "memory");
    __syncthreads();
    if (threadIdx.x == 0) {
        unsigned* bar = b.bar;
        __builtin_amdgcn_s_waitcnt(0);
        unsigned nloc = b.st[0], nx = b.st[1];
        if (nloc == 0u) { xcd_barrier_complete(bar, b.x, nloc, nx); b.st[0] = nloc; b.st[1] = nx; }
        const unsigned old = xb_add(&bar[XB_XSUB(b.x)], 1u);
        const unsigned gen = old / nloc;
        if (old + 1u == (gen + 1u) * nloc) {
            __builtin_amdgcn_fence(__ATOMIC_RELEASE, "agent");
            asm volatile("s_waitcnt vmcnt(0)" ::: "memory");
            const unsigned og = xb_add(&bar[XB_TOP], 1u);
            const unsigned tg = og / nx;
            if (og + 1u == (tg + 1u) * nx) xb_add(&bar[XB_TOPGEN], 1u);
            else XB_SPIN(xb_ld(&bar[XB_TOPGEN]) == tg, bar);
            __builtin_amdgcn_fence(__ATOMIC_ACQUIRE, "agent");
            xb_add(&bar[XB_XGEN(b.x)], 1u);
            asm volatile("s_waitcnt vmcnt(0)" ::: "memory");
        } else {
            XB_SPIN(xb_ld(&bar[XB_XGEN(b.x)]) == gen, bar);
            __builtin_amdgcn_fence(__ATOMIC_ACQUIRE, "agent");
            asm volatile("s_waitcnt vmcnt(0)" ::: "memory");
        }
    }
    __syncthreads();
}

struct VB { int vb, nvb, tid; char* smem; };
__device__ __forceinline__ VB make_vb(char* smem) {
    const int t = otid();
    VB v; v.vb = (int)blockIdx.x * 2 + (t >> 8); v.nvb = (int)gridDim.x * 2; v.tid = t & 255; v.smem = smem + (t >> 8) * VB_LDS;
    return v;
}
__device__ __forceinline__ int swz(int row, int chunk) { return row * 128 + ((chunk ^ ((row >> 1) & 7)) << 4); }

__device__ __forceinline__ float wave_sum(float v) {
#pragma unroll
    for (int o = 32; o > 0; o >>= 1) v += __shfl_xor(v, o, 64);
    return v;
}

__device__ __forceinline__ int t5_bucket(int n) {
    if (n < 16) return n;
    const float v = logf((float)n / 16.f) / logf(128.f) * 16.f;
    int large = 16 + (int)v;
    return large < 31 ? large : 31;
}

__device__ __forceinline__ void tr_tile(const VB& v, const float* src, int ld, bf16_t* dst, bf16_t* dst2, int ldd, int k0, int n0) {
    float* t = (float*)v.smem;
    __syncthreads();
#pragma unroll
    for (int i = 0; i < 4; ++i) {
        const int r = (v.tid >> 4) + 16 * i, c4 = v.tid & 15;
        const f32x4 x = *(const f32x4*)(src + (size_t)(k0 + r) * ld + n0 + c4 * 4);
        t[r * 65 + c4 * 4 + 0] = x[0]; t[r * 65 + c4 * 4 + 1] = x[1]; t[r * 65 + c4 * 4 + 2] = x[2]; t[r * 65 + c4 * 4 + 3] = x[3];
    }
    __syncthreads();
    const int n = v.tid >> 2, kq = v.tid & 3;
    float f[16];
#pragma unroll
    for (int i = 0; i < 16; ++i) f[i] = t[(kq * 16 + i) * 65 + n];
    u32x4 a, b;
    a[0] = pack2(f[0], f[1]); a[1] = pack2(f[2], f[3]); a[2] = pack2(f[4], f[5]); a[3] = pack2(f[6], f[7]);
    b[0] = pack2(f[8], f[9]); b[1] = pack2(f[10], f[11]); b[2] = pack2(f[12], f[13]); b[3] = pack2(f[14], f[15]);
    bf16_t* d = dst + (size_t)(n0 + n) * ldd + k0 + kq * 16;
    *(u32x4*)d = a; *(u32x4*)(d + 8) = b;
    if (dst2) {
        u32x4 c, e;
#pragma unroll
        for (int i = 0; i < 4; ++i) {
            c[i] = pack2(f[2 * i] - __uint_as_float(a[i] << 16), f[2 * i + 1] - __uint_as_float(a[i] & 0xffff0000u));
            e[i] = pack2(f[8 + 2 * i] - __uint_as_float(b[i] << 16), f[8 + 2 * i + 1] - __uint_as_float(b[i] & 0xffff0000u));
        }
        bf16_t* d2 = dst2 + (size_t)(n0 + n) * ldd + k0 + kq * 16;
        *(u32x4*)d2 = c; *(u32x4*)(d2 + 8) = e;
    }
}

__device__ void ph_mod(const Params& p, char* smem0) {
    const VB v = make_vb(smem0);
    const int tid = v.tid;
    float* cond = (float*)(v.smem + 20480);
    float* red = cond + 4096;
    for (int i = tid; i < 4096; i += 256) { const float x = p.c[i]; cond[i] = x / (1.f + __expf(-x)); }
    __syncthreads();
    const int NU = 194 + 1088 + 192 + 64 + 64 + 64 + 64;
    const int rounds = (NU + v.nvb - 1) / v.nvb;
    for (int it = 0; it < rounds; ++it) {
        int u = v.vb + it * v.nvb;
        if (u >= NU) u = NU - 1;
        if (u < 192) {
            const int c4 = tid & 7, kq = tid >> 3;
            f32x4 a0 = {0.f, 0.f, 0.f, 0.f}, a1 = a0, a2 = a0, a3 = a0;
            const float* wp = p.w_ada + u * 32 + c4 * 4;
#pragma unroll 8
            for (int k = kq; k < 1024; k += 32) {
                const f32x4 w = *(const f32x4*)(wp + (size_t)k * 6144);
                a0 += cond[k] * w; a1 += cond[1024 + k] * w; a2 += cond[2048 + k] * w; a3 += cond[3072 + k] * w;
            }
            *(f32x4*)(red + (kq * 4 + 0) * 32 + c4 * 4) = a0; *(f32x4*)(red + (kq * 4 + 1) * 32 + c4 * 4) = a1;
            *(f32x4*)(red + (kq * 4 + 2) * 32 + c4 * 4) = a2; *(f32x4*)(red + (kq * 4 + 3) * 32 + c4 * 4) = a3;
        }
        __syncthreads();
        if (u < 192) {
            if (tid < 128) {
                const int b = tid >> 5, c2 = tid & 31;
                float s = 0.f;
                for (int q = 0; q < 32; ++q) s += red[(q * 4 + b) * 32 + c2];
                p.mod()[b * 6144 + u * 32 + c2] = s + p.b_ada[u * 32 + c2];
            }
        } else if (u == 192) {
            for (int j = tid; j < 512; j += 256) {
                const float a = p.hg_lb[j], b = p.hg_lb[512 + j];
                const float m = fmaxf(a, b);
                const float ea = expf(a - m), eb = expf(b - m);
                p.lbv()[j] = ea / (ea + eb);
            }
        } else if (u == 193) {
            for (int i = tid; i < 3 * 129 * 4; i += 256) {
                const int g = i / (129 * 4), m = (i >> 2) % 129, hh = i & 3;
                const int dil = (g == 0) ? 1 : (g == 1 ? 4 : 16);
                p.biasT()[i] = p.rel_bias[t5_bucket(m * dil) * 12 + g * 4 + hh];
            }
        }
        {
            int w = u - 194;
            const float* src = p.w_out; int ld = D; bf16_t* dst = p.woutT(); bf16_t* dst2 = nullptr; int ldd = 768, k0 = 0, n0 = 0;
            if (w >= 0) {
                if (w < 1088) { src = p.w_in; ld = INW; dst = p.winT(); ldd = D; k0 = (w / 68) * 64; n0 = (w % 68) * 64; }
                else if ((w -= 1088) < 192) { k0 = (w >> 4) * 64; n0 = (w & 15) * 64; }
                else if ((w -= 192) < 64) { src = p.w_router; ld = NE; dst = p.wrT(); dst2 = p.wrT() + (size_t)NE * D; ldd = D; k0 = (w >> 2) * 64; n0 = (w & 3) * 64; }
                else if ((w -= 64) < 64) { src = p.w_sg; ld = ED; dst = p.wsgT(); ldd = D; k0 = (w >> 2) * 64; n0 = (w & 3) * 64; }
                else if ((w -= 64) < 64) { src = p.w_su; ld = ED; dst = p.wsuT(); ldd = D; k0 = (w >> 2) * 64; n0 = (w & 3) * 64; }
                else { w -= 64; src = p.w_sd; ld = D; dst = p.wsdT(); ldd = ED; k0 = (w >> 4) * 64; n0 = (w & 15) * 64; }
            }
            tr_tile(v, src, ld, dst, dst2, ldd, k0, n0);
        }
    }
}

__device__ void ph_ln0(const Params& p) {
    const int tid = otid(), lane = tid & 63, wid = tid >> 6;
    const int rstride = gridDim.x * 8;
    float4 nv[4];
    {
        const float4* xr = (const float4*)(p.x + (size_t)(blockIdx.x * 8 + wid) * D);
#pragma unroll
        for (int i = 0; i < 4; ++i) nv[i] = xr[lane + 64 * i];
    }
    for (int row = blockIdx.x * 8 + wid; row < T; row += rstride) {
        float4 v[4];
        float s = 0.f;
#pragma unroll
        for (int i = 0; i < 4; ++i) { v[i] = nv[i]; s += v[i].x + v[i].y + v[i].z + v[i].w; }
        if (row + rstride < T) {
            const float4* xn = (const float4*)(p.x + (size_t)(row + rstride) * D);
#pragma unroll
            for (int i = 0; i < 4; ++i) nv[i] = xn[lane + 64 * i];
        }
        const float mean = wave_sum(s) * (1.f / D);
        float q = 0.f;
#pragma unroll
        for (int i = 0; i < 4; ++i) {
            v[i].x -= mean; v[i].y -= mean; v[i].z -= mean; v[i].w -= mean;
            q += v[i].x * v[i].x + v[i].y * v[i].y + v[i].z * v[i].z + v[i].w * v[i].w;
        }
        const float rstd = rsqrtf(wave_sum(q) * (1.f / D) + LN_EPS);
        const int b = row >> 12;
        const float* sh = p.mod() + b * 6144;
        const float* sc = sh + 1024;
#pragma unroll
        for (int i = 0; i < 4; ++i) {
            const int col = (lane + 64 * i) * 4;
            const float4 s4 = *(const float4*)(sc + col), h4 = *(const float4*)(sh + col);
            uint2 o;
            o.x = pack2(v[i].x * rstd * (1.f + s4.x) + h4.x, v[i].y * rstd * (1.f + s4.y) + h4.y);
            o.y = pack2(v[i].z * rstd * (1.f + s4.z) + h4.z, v[i].w * rstd * (1.f + s4.w) + h4.w);
            *(uint2*)(p.h1() + (size_t)row * D + col) = o;
        }
    }
}

__device__ __forceinline__ int swz16(int row, int chunk) { return row * 256 + ((chunk ^ (row & 15)) << 4); }
struct TrBase { int lo, hi; };
__device__ __forceinline__ TrBase tr16_base(int lane) {
    const int g = lane >> 4, q = (lane & 15) >> 2, pp = lane & 3;
    const int xl = 8 * (g & 1) + q, h = pp >> 1;
    TrBase t;
    t.lo = (8 * g + q) * 256 + ((xl >> 1) << 5) + ((h ^ (xl & 1)) << 4) + 8 * (pp & 1);
    t.hi = (t.lo + 1024) ^ 64;
    return t;
}
__device__ __forceinline__ bf16x8 tr_frag16(const char* tile, const TrBase& tb, int ks, int c) {
    int cx = c << 5;
    asm volatile("" : "+v"(cx));
    const v4s lo = __builtin_amdgcn_ds_read_tr16_b64_v4i16((LAS v4s*)(tile + ks * 8192 + (tb.lo ^ cx)));
    const v4s hi = __builtin_amdgcn_ds_read_tr16_b64_v4i16((LAS v4s*)(tile + ks * 8192 + (tb.hi ^ cx)));
    return bf16x8{lo[0], lo[1], lo[2], lo[3], hi[0], hi[1], hi[2], hi[3]};
}


__device__ __forceinline__ int aoff(int row, int chunk) { return row * 64 + ((chunk ^ ((row >> 2) & 3)) << 4); }
__device__ __forceinline__ int boff(int row, int chunk) { return row * 512 + ((chunk ^ (((row & 3) << 1) | (((row >> 3) & 1) << 3))) << 4); }
__device__ __forceinline__ bf16x8 tr_pair(const char* p) {
    const v4s lo = __builtin_amdgcn_ds_read_tr16_b64_v4i16((LAS v4s*)(p));
    const v4s hi = __builtin_amdgcn_ds_read_tr16_b64_v4i16((LAS v4s*)(p + 2048));
    return bf16x8{lo[0], lo[1], lo[2], lo[3], hi[0], hi[1], hi[2], hi[3]};
}
constexpr int G3_STAGE = 32768;

template <int BMODE, class AF, class BF>
__device__ __forceinline__ void gemm3(char* smem, const int K, AF arow, BF bsrc, const int ldb, f32x4 (&acc)[4][8], const int nvalid = 256) {
    const int tid = otid(), lane = tid & 63, wid = tid >> 6, wr = wid >> 1, wc = wid & 1, fr = lane & 15, fq = lane >> 4;
    const bf16_t* ap[2];
#pragma unroll
    for (int i = 0; i < 2; ++i) ap[i] = arow((tid >> 2) + 128 * i) + (tid & 3) * 8;
    const float* bpf = nullptr;
    const bf16_t* bpb[2] = {nullptr, nullptr};
    if (BMODE == 0) bpf = (const float*)bsrc((tid & 63) * 4) + (size_t)(tid >> 6) * ldb;
    else {
#pragma unroll
        for (int i = 0; i < 2; ++i) bpb[i] = (const bf16_t*)bsrc((tid >> 2) + 128 * i) + (tid & 3) * 8;
    }
#pragma unroll
    for (int m = 0; m < 4; ++m)
#pragma unroll
        for (int n = 0; n < 8; ++n) acc[m][n] = f32x4{0.f, 0.f, 0.f, 0.f};
    const int trbase = (8 * fq + (fr >> 2)) * 512 + wc * 256 + (((fr >> 2) | ((fq & 1) << 2)) << 5) + ((fr & 3) >> 1) * 16 + (fr & 1) * 8;
    u32x4 ra0[2], ra1[2];
    f32x4 rf0[4], rf1[4];
    u32x4 rb0[2], rb1[2];
    const bool active = wr * 64 < nvalid;
#define G3_GLOAD(RA, RF, RB, k0) do { \
        _Pragma("unroll") for (int i = 0; i < 2; ++i) RA[i] = *(const u32x4*)(ap[i] + (k0)); \
        if (BMODE == 0) { _Pragma("unroll") for (int j = 0; j < 4; ++j) RF[j] = *(const f32x4*)(bpf + (size_t)((k0) + 8 * j) * ldb); } \
        else { _Pragma("unroll") for (int i = 0; i < 2; ++i) RB[i] = *(const u32x4*)(bpb[i] + (k0)); } } while (0)
#define G3_LWRITE(RA, RF, RB, st) do { \
        char* sA_ = (st); char* sB_ = (st) + 16384; \
        _Pragma("unroll") for (int i = 0; i < 2; ++i) *(u32x4*)(sA_ + aoff((tid >> 2) + 128 * i, tid & 3)) = RA[i]; \
        if (BMODE == 0) { _Pragma("unroll") for (int j = 0; j < 4; ++j) { uint2 w_; w_.x = pack2(RF[j][0], RF[j][1]); w_.y = pack2(RF[j][2], RF[j][3]); \
                *(uint2*)(sB_ + boff((tid >> 6) + 8 * j, (tid & 63) >> 1) + (tid & 1) * 8) = w_; } } \
        else { _Pragma("unroll") for (int i = 0; i < 2; ++i) *(u32x4*)(sB_ + aoff((tid >> 2) + 128 * i, tid & 3)) = RB[i]; } } while (0)
#define G3_COMPUTE(st) do { if (active) { \
        const char* sA_ = (st); const char* sB_ = (st) + 16384; \
        bf16x8 af[4]; \
        _Pragma("unroll") for (int m = 0; m < 4; ++m) af[m] = *(const bf16x8*)(sA_ + aoff(wr * 64 + m * 16 + fr, fq)); \
        _Pragma("unroll") for (int n = 0; n < 8; ++n) { \
            bf16x8 bfr; \
            if (BMODE == 0) bfr = tr_pair(sB_ + (trbase ^ (n << 5))); else bfr = *(const bf16x8*)(sB_ + aoff(wc * 128 + n * 16 + fr, fq)); \
            _Pragma("unroll") for (int m = 0; m < 4; ++m) acc[m][n] = __builtin_amdgcn_mfma_f32_16x16x32_bf16(af[m], bfr, acc[m][n], 0, 0, 0); } } } while (0)
    const int nk = K >> 5;
    char* st0 = smem;
    char* st1 = smem + G3_STAGE;
    G3_GLOAD(ra0, rf0, rb0, 0);
    G3_GLOAD(ra1, rf1, rb1, 32);
    G3_LWRITE(ra0, rf0, rb0, st0);
    if (nk > 2) G3_GLOAD(ra0, rf0, rb0, 64);
    __syncthreads();
    for (int kt = 0; kt < nk; kt += 2) {
        G3_LWRITE(ra1, rf1, rb1, st1);
        if (kt + 3 < nk) G3_GLOAD(ra1, rf1, rb1, (kt + 3) * 32);
        G3_COMPUTE(st0);
        __syncthreads();
        if (kt + 2 < nk) G3_LWRITE(ra0, rf0, rb0, st0);
        if (kt + 4 < nk) G3_GLOAD(ra0, rf0, rb0, (kt + 4) * 32);
        G3_COMPUTE(st1);
        __syncthreads();
    }
#undef G3_GLOAD
#undef G3_LWRITE
#undef G3_COMPUTE
}

template <class AF, class BF>
__device__ __forceinline__ void gemm4(char* smem, const int K, AF arow, BF brow, f32x4 (&acc)[4][8]) {
    const int tid = otid(), lane = tid & 63, wid = tid >> 6, wr = wid >> 1, wc = wid & 1, fr = lane & 15, fq = lane >> 4;
    const bf16_t* ga[2];
    const bf16_t* gb[2];
#pragma unroll
    for (int i = 0; i < 2; ++i) {
        const int r = 16 * (wid + 8 * i) + (lane >> 2), sc = ((lane & 3) ^ ((r >> 2) & 3)) * 8;
        ga[i] = arow(r) + sc;
        gb[i] = brow(r) + sc;
    }
#pragma unroll
    for (int m = 0; m < 4; ++m)
#pragma unroll
        for (int n = 0; n < 8; ++n) acc[m][n] = f32x4{0.f, 0.f, 0.f, 0.f};
    char* ldst = smem + wid * 1024 + lane * 16;
#define G4_ISSUE(slot, k0) do { \
        char* d_ = ldst + (slot) * 32768; \
        __builtin_amdgcn_global_load_lds((const unsigned*)(ga[0] + (k0)), (LAS unsigned*)(d_), 16, 0, 0); \
        __builtin_amdgcn_global_load_lds((const unsigned*)(ga[1] + (k0)), (LAS unsigned*)(d_ + 8192), 16, 0, 0); \
        __builtin_amdgcn_global_load_lds((const unsigned*)(gb[0] + (k0)), (LAS unsigned*)(d_ + 16384), 16, 0, 0); \
        __builtin_amdgcn_global_load_lds((const unsigned*)(gb[1] + (k0)), (LAS unsigned*)(d_ + 16384 + 8192), 16, 0, 0); } while (0)
    const int nk = K >> 5;
    G4_ISSUE(0, 0);
    G4_ISSUE(1, 32);
    int slot = 0, slot2 = 2;
    for (int kt = 0; kt < nk; ++kt) {
        if (kt + 1 < nk) asm volatile("s_waitcnt vmcnt(4)" ::: "memory");
        else asm volatile("s_waitcnt vmcnt(0)" ::: "memory");
        __builtin_amdgcn_s_barrier();
        if (kt + 2 < nk) G4_ISSUE(slot2, (kt + 2) * 32);
        const char* sA_ = smem + slot * 32768;
        const char* sB_ = sA_ + 16384;
        bf16x8 af[4];
#pragma unroll
        for (int m = 0; m < 4; ++m) af[m] = *(const bf16x8*)(sA_ + aoff(wr * 64 + m * 16 + fr, fq));
#pragma unroll
        for (int n = 0; n < 8; ++n) {
            const bf16x8 bfr = *(const bf16x8*)(sB_ + aoff(wc * 128 + n * 16 + fr, fq));
#pragma unroll
            for (int m = 0; m < 4; ++m) acc[m][n] = __builtin_amdgcn_mfma_f32_16x16x32_bf16(af[m], bfr, acc[m][n], 0, 0, 0);
        }
        slot = (slot == 2) ? 0 : slot + 1;
        slot2 = (slot2 == 2) ? 0 : slot2 + 1;
    }
#undef G4_ISSUE
    __syncthreads();
}


constexpr int G5_B0 = 49152;
template <class AF, class BF>
__device__ __forceinline__ void gemm5(char* smem, const int K, AF arow, BF bsrc, const int ldb, f32x4 (&acc)[4][8]) {
    const int tid = otid(), lane = tid & 63, wid = tid >> 6, wr = wid >> 1, wc = wid & 1, fr = lane & 15, fq = lane >> 4;
    const bf16_t* ga[2];
#pragma unroll
    for (int i = 0; i < 2; ++i) {
        const int r = 16 * (wid + 8 * i) + (lane >> 2);
        ga[i] = arow(r) + (((lane & 3) ^ ((r >> 2) & 3)) * 8);
    }
    const float* bpf = (const float*)bsrc((tid & 63) * 4) + (size_t)(tid >> 6) * ldb;
#pragma unroll
    for (int m = 0; m < 4; ++m)
#pragma unroll
        for (int n = 0; n < 8; ++n) acc[m][n] = f32x4{0.f, 0.f, 0.f, 0.f};
    const int trbase = (8 * fq + (fr >> 2)) * 512 + wc * 256 + (((fr >> 2) | ((fq & 1) << 2)) << 5) + ((fr & 3) >> 1) * 16 + (fr & 1) * 8;
    char* ldst = smem + wid * 1024 + lane * 16;
    const unsigned lds0 = (unsigned)(size_t)smem;
    unsigned bwoff[4];
#pragma unroll
    for (int j = 0; j < 4; ++j) bwoff[j] = boff((tid >> 6) + 8 * j, (tid & 63) >> 1) + (tid & 1) * 8;
    f32x4 rf0[4], rf1[4];
    const int klast = K - 32;
#define G5_ADMA(slot, k0) do { \
        char* d_ = ldst + (slot) * 16384; \
        __builtin_amdgcn_global_load_lds((const unsigned*)(ga[0] + (k0)), (LAS unsigned*)(d_), 16, 0, 0); \
        __builtin_amdgcn_global_load_lds((const unsigned*)(ga[1] + (k0)), (LAS unsigned*)(d_ + 8192), 16, 0, 0); } while (0)
#define G5_BLOAD(RF, k0) do { const float* q0_ = bpf + (size_t)(k0) * ldb; const float* q1_ = q0_ + (size_t)8 * ldb; const float* q2_ = q0_ + (size_t)16 * ldb; const float* q3_ = q0_ + (size_t)24 * ldb; \
        asm volatile("global_load_dwordx4 %0, %4, off\n\tglobal_load_dwordx4 %1, %5, off\n\tglobal_load_dwordx4 %2, %6, off\n\tglobal_load_dwordx4 %3, %7, off" \
                     : "=&v"(RF[0]), "=&v"(RF[1]), "=&v"(RF[2]), "=&v"(RF[3]) : "v"(q0_), "v"(q1_), "v"(q2_), "v"(q3_) : "memory"); } while (0)
#define G5_BWAIT(RF, N) asm volatile("s_waitcnt vmcnt(" #N ")" : "+v"(RF[0]), "+v"(RF[1]), "+v"(RF[2]), "+v"(RF[3]) :: "memory")
#define G5_BWRITE(RF, st) do { const unsigned sB_ = lds0 + G5_B0 + (st) * 16384; \
        _Pragma("unroll") for (int j = 0; j < 4; ++j) { \
            const unsigned long long w_ = (unsigned long long)pack2(RF[j][0], RF[j][1]) | ((unsigned long long)pack2(RF[j][2], RF[j][3]) << 32); \
            asm volatile("ds_write_b64 %0, %1" :: "v"(sB_ + bwoff[j]), "v"(w_) : "memory"); } } while (0)
#define G5_TRB(n0) do { \
        _Pragma("unroll") for (int n = 0; n < 4; ++n) { const unsigned a_ = sBa_ + (unsigned)(trbase ^ (((n0) + n) << 5)); \
            asm volatile("ds_read_b64_tr_b16 %0, %2\n\tds_read_b64_tr_b16 %1, %2 offset:2048" : "=&v"(tl[n]), "=&v"(th[n]) : "v"(a_) : "memory"); } } while (0)
#define G5_TRW() asm volatile("s_waitcnt lgkmcnt(0)" : "+v"(tl[0]), "+v"(tl[1]), "+v"(tl[2]), "+v"(tl[3]), "+v"(th[0]), "+v"(th[1]), "+v"(th[2]), "+v"(th[3]) :: "memory")
#define G5_MM(n0) do { _Pragma("unroll") for (int n = 0; n < 4; ++n) { \
            const bf16x8 bfr = bf16x8{tl[n][0], tl[n][1], tl[n][2], tl[n][3], th[n][0], th[n][1], th[n][2], th[n][3]}; \
            _Pragma("unroll") for (int m = 0; m < 4; ++m) acc[m][(n0) + n] = __builtin_amdgcn_mfma_f32_16x16x32_bf16(af[m], bfr, acc[m][(n0) + n], 0, 0, 0); } } while (0)
#define G5_COMPUTE(aslot, bst) do { \
        const char* sA_ = smem + (aslot) * 16384; const unsigned sBa_ = lds0 + G5_B0 + (bst) * 16384; \
        v4s tl[4], th[4]; \
        G5_TRB(0); \
        bf16x8 af[4]; \
        _Pragma("unroll") for (int m = 0; m < 4; ++m) af[m] = *(const bf16x8*)(sA_ + aoff(wr * 64 + m * 16 + fr, fq)); \
        G5_TRW(); G5_MM(0); \
        G5_TRB(4); G5_TRW(); G5_MM(4); } while (0)
#define G5_KC(k) ((k) < klast ? (k) : klast)
    const int nk = K >> 5;
    G5_BLOAD(rf0, 0);
    G5_ADMA(0, 0);
    G5_BLOAD(rf1, 32);
    G5_BWAIT(rf0, 6);
    G5_BWRITE(rf0, 0);
    G5_ADMA(1, 32);
    G5_BLOAD(rf0, G5_KC(64));
    int as0 = 0, as2 = 2;
    for (int kt = 0; kt < nk; kt += 2) {
        asm volatile("s_waitcnt vmcnt(10) lgkmcnt(0)" ::: "memory");
        __builtin_amdgcn_s_barrier();
        G5_ADMA(as2, G5_KC((kt + 2) * 32));
        G5_BWAIT(rf1, 8);
        G5_BWRITE(rf1, 1);
        G5_BLOAD(rf1, G5_KC((kt + 3) * 32));
        G5_COMPUTE(as0, 0);
        as0 = (as0 == 2) ? 0 : as0 + 1; as2 = (as2 == 2) ? 0 : as2 + 1;
        asm volatile("s_waitcnt vmcnt(10) lgkmcnt(0)" ::: "memory");
        __builtin_amdgcn_s_barrier();
        G5_ADMA(as2, G5_KC((kt + 3) * 32));
        G5_BWAIT(rf0, 8);
        G5_BWRITE(rf0, 0);
        G5_BLOAD(rf0, G5_KC((kt + 4) * 32));
        G5_COMPUTE(as0, 1);
        as0 = (as0 == 2) ? 0 : as0 + 1; as2 = (as2 == 2) ? 0 : as2 + 1;
    }
    G5_BWAIT(rf0, 0);
    G5_BWAIT(rf1, 0);
    asm volatile("s_waitcnt lgkmcnt(0)" ::: "memory");
    __syncthreads();
#undef G5_ADMA
#undef G5_BLOAD
#undef G5_BWAIT
#undef G5_BWRITE
#undef G5_COMPUTE
#undef G5_TRB
#undef G5_TRW
#undef G5_MM
#undef G5_KC
}

constexpr int EPI_WAVE = 8704;
template <class VF, class SF>
__device__ __forceinline__ void epi_bf16(char* wl, const int lane, VF val, SF store) {
    const int fr = lane & 15, fq = lane >> 4, odd = lane & 1;
#pragma unroll
    for (int n = 0; n < 8; ++n)
#pragma unroll
        for (int jp = 0; jp < 2; ++jp) {
            const float a = val(n, 2 * jp), b = val(n, 2 * jp + 1);
            const float x = odd ? a : b;
            const float y = __shfl_xor(x, 1, 64);
            const uint32_t w = odd ? pack2(y, b) : pack2(a, y);
            *(uint32_t*)(wl + (fq * 4 + 2 * jp + odd) * 272 + (n * 16 + (fr & ~1)) * 2) = w;
        }
    int ln = lane;
    asm volatile("" : "+v"(ln));
#pragma unroll
    for (int i = 0; i < 4; ++i) {
        const int idx = ln + 64 * i, row = idx >> 4, ch = idx & 15;
        store(row, ch, *(const u32x4*)(wl + row * 272 + ch * 16));
    }
}
template <class VF, class SF>
__device__ __forceinline__ void epi_f32(char* wl, const int lane, VF val, SF store) {
    const int fr = lane & 15, fq = lane >> 4;
#pragma unroll
    for (int n = 0; n < 8; ++n)
#pragma unroll
        for (int j = 0; j < 4; ++j) *(float*)(wl + (fq * 4 + j) * 528 + (n * 16 + fr) * 4) = val(n, j);
    int ln = lane;
    asm volatile("" : "+v"(ln));
#pragma unroll
    for (int i = 0; i < 8; ++i) {
        const int idx = ln + 64 * i, row = idx >> 5, ch = idx & 31;
        store(row, ch, *(const f32x4*)(wl + row * 528 + ch * 16));
    }
}

__device__ void ph_inproj(const Params& p, char* smem) {
    const int tid = otid(), lane = tid & 63, wid = tid >> 6, wr = wid >> 1, wc = wid & 1, fr = lane & 15;
    const int NTN = INW / 256;
    const int xcd = blockIdx.x & 7, nbx = gridDim.x >> 3;
    for (int i = blockIdx.x >> 3; i < 8 * NTN; i += nbx) {
        const int nt = i >> 3, mt = xcd * 8 + (i & 7);
        const bf16_t* A = p.h1() + (size_t)mt * 256 * D;
        const bf16_t* Bt = p.winT() + (size_t)nt * 256 * D;
        f32x4 acc[4][8];
        __syncthreads();
        gemm4(smem, D, [&](int r) { return A + (size_t)r * D; }, [&](int n) { return Bt + (size_t)n * D; }, acc);
        char* wl = smem + wid * EPI_WAVE;
        const int colb = nt * 256 + wc * 128;
        const int rowb = mt * 256 + wr * 64;
        if (colb >= OFF_HF && colb < OFF_HI) {
            float lbc[8];
#pragma unroll
            for (int n = 0; n < 8; ++n) lbc[n] = p.lbv()[colb - OFF_HF + n * 16 + fr];
#pragma unroll
            for (int m = 0; m < 4; ++m) {
                float* dst = p.lgf() + (size_t)(rowb + m * 16) * 512 + (colb - OFF_HF);
                epi_f32(wl, lane,
                        [&](int n, int j) { return logf(lbc[n] + (1.f - lbc[n]) * (1.f / (1.f + expf(-acc[m][n][j])))); },
                        [&](int row, int ch, f32x4 v) { *(f32x4*)(dst + (size_t)row * 512 + ch * 4) = v; });
            }
        } else {
#pragma unroll
            for (int m = 0; m < 4; ++m) {
                bf16_t* dst = p.proj() + (size_t)(rowb + m * 16) * INW + colb;
                epi_bf16(wl, lane, [&](int n, int j) { return acc[m][n][j]; },
                         [&](int row, int ch, u32x4 v) { *(u32x4*)(dst + (size_t)row * INW + ch * 8) = v; });
            }
        }
    }
}

__device__ void ph_h1(const Params& p, char* smem0) {
    const VB vbk = make_vb(smem0);
    char* smem = vbk.smem;
    const int tid = vbk.tid, lane = tid & 63, wid = tid >> 6, wr = wid >> 1, wc = wid & 1, fr = lane & 15, fq = lane >> 4;
    char* sI = smem;
    char* sK = smem + 16384;
    float* sL = (float*)(smem + 32768);
    float* totS = (float*)(smem + 65536);
    const int d = tid & 127, half = tid >> 7;
    const TrBase trb = tr16_base(lane);
    for (int u = vbk.vb; u < 1024; u += vbk.nvb) {
        const int bh = u >> 6, c = u & 63, b = bh >> 2, h = bh & 3;
        const size_t row0 = (size_t)b * S + c * 64;
        __syncthreads();
#pragma unroll
        for (int i = 0; i < 4; ++i) {
            const int idx = tid + 256 * i, r = idx >> 4, ch = idx & 15;
            *(u32x4*)(sI + swz16(r, ch)) = *(const u32x4*)(p.proj() + (row0 + r) * INW + OFF_HI + h * 128 + ch * 8);
        }
#pragma unroll
        for (int i = 0; i < 8; ++i) {
            const int idx = tid + 256 * i, r = idx >> 5, c4 = idx & 31;
            *(f32x4*)(sL + r * 128 + c4 * 4) = *(const f32x4*)(p.lgf() + (row0 + r) * 512 + h * 128 + c4 * 4);
        }
        __syncthreads();
        const float* lcol = sL + half * 32 * 128 + d;
        float tot = 0.f;
#pragma unroll
        for (int s = 0; s < 32; ++s) tot += lcol[s * 128];
        totS[half * 128 + d] = tot;
        __syncthreads();
        const float t0 = totS[d], bl = t0 + totS[128 + d];
        float run = half ? t0 : 0.f;
#pragma unroll 8
        for (int s = 0; s < 32; ++s) {
            const float lv = lcol[s * 128];
            run += lv;
            const float kt = (1.f - __expf(lv)) * __expf(bl - run);
            *(bf16_t*)(sK + swz16(half * 32 + s, d >> 3) + (d & 7) * 2) = f2bf(kt);
        }
        if (half == 0) p.dec()[u * 128 + d] = __expf(bl);
        __syncthreads();
        f32x4 acc[4][4];
#pragma unroll
        for (int m = 0; m < 4; ++m)
#pragma unroll
            for (int n = 0; n < 4; ++n) acc[m][n] = f32x4{0.f, 0.f, 0.f, 0.f};
#pragma unroll
        for (int ks = 0; ks < 2; ++ks) {
            bf16x8 af[4], bfr[4];
#pragma unroll
            for (int m = 0; m < 4; ++m) af[m] = tr_frag16(sI, trb, ks, wr * 4 + m);
#pragma unroll
            for (int n = 0; n < 4; ++n) bfr[n] = tr_frag16(sK, trb, ks, wc * 4 + n);
#pragma unroll
            for (int m = 0; m < 4; ++m)
#pragma unroll
                for (int n = 0; n < 4; ++n) acc[m][n] = __builtin_amdgcn_mfma_f32_16x16x32_bf16(af[m], bfr[n], acc[m][n], 0, 0, 0);
        }
        float* kvu = p.kv() + (size_t)u * 16384;
#pragma unroll
        for (int m = 0; m < 4; ++m)
#pragma unroll
            for (int n = 0; n < 4; ++n)
#pragma unroll
                for (int j = 0; j < 4; ++j) kvu[(wr * 64 + m * 16 + fq * 4 + j) * 128 + wc * 64 + n * 16 + fr] = acc[m][n][j];
    }
}

__device__ void ph_h2(const Params& p) {
    for (int it = blockIdx.x * NTHREADS + otid(); it < 16 * 8192; it += gridDim.x * NTHREADS) {
        const int bh = it >> 13, e2 = it & 8191, dv = e2 >> 6, dk = (e2 & 63) * 2;
        const size_t eoff = (size_t)dv * 128 + dk;
        float sx = 0.f, sy = 0.f;
#pragma unroll 8
        for (int c = 0; c < 64; ++c) {
            const size_t u = (size_t)bh * 64 + c;
            *(uint32_t*)(p.sst() + u * 16384 + eoff) = pack2(sx, sy);
            const float2 kvv = *(const float2*)(p.kv() + u * 16384 + eoff);
            const float2 dc = *(const float2*)(p.dec() + u * 128 + dk);
            sx = dc.x * sx + kvv.x; sy = dc.y * sy + kvv.y;
        }
    }
}

__device__ void ph_h3(const Params& p, char* smem0) {
    const VB vbk = make_vb(smem0);
    char* smem = vbk.smem;
    const int tid = vbk.tid, lane = tid & 63, wid = tid >> 6, wr = wid >> 1, wc = wid & 1, fr = lane & 15, fq = lane >> 4;
    char* sQ = smem;
    char* sK = smem + 16384;
    char* sP = smem + 32768;
    float* sL = (float*)(smem + 32768);
    float* totS = (float*)(smem + 65536);
    char* sG = smem + 40960;
    const int d = tid & 127, half = tid >> 7;
    const TrBase trb = tr16_base(lane);
    for (int u = vbk.vb; u < 1024; u += vbk.nvb) {
        const int bh = u >> 6, c = u & 63, b = bh >> 2, h = bh & 3;
        const size_t row0 = (size_t)b * S + c * 64;
        __syncthreads();
#pragma unroll
        for (int i = 0; i < 4; ++i) {
            const int idx = tid + 256 * i, r = idx >> 4, ch = idx & 15;
            *(u32x4*)(sQ + swz16(r, ch)) = *(const u32x4*)(p.proj() + (row0 + r) * INW + OFF_HQ + h * 128 + ch * 8);
        }
#pragma unroll
        for (int i = 0; i < 8; ++i) {
            const int idx = tid + 256 * i, r = idx >> 5, c4 = idx & 31;
            *(f32x4*)(sL + r * 128 + c4 * 4) = *(const f32x4*)(p.lgf() + (row0 + r) * 512 + h * 128 + c4 * 4);
        }
        u32x4 sv0[4], sv1[4], iv[4], gv[4];
#pragma unroll
        for (int i = 0; i < 4; ++i) {
            const int r8 = (tid + 256 * i) >> 3;
            sv0[i] = *(const u32x4*)(p.sst() + (size_t)u * 16384 + r8 * 128 + (tid & 7) * 8);
            sv1[i] = *(const u32x4*)(p.sst() + (size_t)u * 16384 + r8 * 128 + 64 + (tid & 7) * 8);
            const int idx = tid + 256 * i, r = idx >> 4, c16 = idx & 15;
            iv[i] = *(const u32x4*)(p.proj() + (row0 + r) * INW + OFF_HI + h * 128 + c16 * 8);
            gv[i] = *(const u32x4*)(p.proj() + (row0 + r) * INW + OFF_HG + h * 128 + c16 * 8);
        }
        __syncthreads();
        const float* lcol = sL + half * 32 * 128 + d;
        float tot = 0.f;
#pragma unroll
        for (int s = 0; s < 32; ++s) tot += lcol[s * 128];
        totS[half * 128 + d] = tot;
        __syncthreads();
        const float t0 = totS[d];
        float run = half ? t0 : 0.f;
#pragma unroll 8
        for (int s = 0; s < 32; ++s) {
            const float lv = lcol[s * 128];
            run += lv;
            const int o = swz16(half * 32 + s, d >> 3) + (d & 7) * 2;
            const float qm = bf2f(*(const bf16_t*)(sQ + o)) * __expf(run - t0);
            const float kh = (1.f - __expf(lv)) * __expf(t0 - run);
            *(bf16_t*)(sQ + o) = f2bf(qm);
            *(bf16_t*)(sK + o) = f2bf(kh);
        }
        __syncthreads();
        {
            f32x4 pa[2][2];
#pragma unroll
            for (int m = 0; m < 2; ++m)
#pragma unroll
                for (int n = 0; n < 2; ++n) pa[m][n] = f32x4{0.f, 0.f, 0.f, 0.f};
#pragma unroll
            for (int ks = 0; ks < 4; ++ks) {
                bf16x8 af[2], bfr[2];
#pragma unroll
                for (int m = 0; m < 2; ++m) af[m] = *(const bf16x8*)(sQ + swz16(wr * 32 + m * 16 + fr, ks * 4 + fq));
#pragma unroll
                for (int n = 0; n < 2; ++n) bfr[n] = *(const bf16x8*)(sK + swz16(wc * 32 + n * 16 + fr, ks * 4 + fq));
#pragma unroll
                for (int m = 0; m < 2; ++m)
#pragma unroll
                    for (int n = 0; n < 2; ++n) pa[m][n] = __builtin_amdgcn_mfma_f32_16x16x32_bf16(af[m], bfr[n], pa[m][n], 0, 0, 0);
            }
#pragma unroll
            for (int m = 0; m < 2; ++m)
#pragma unroll
                for (int n = 0; n < 2; ++n)
#pragma unroll
                    for (int j = 0; j < 4; ++j) {
                        const int t = wr * 32 + m * 16 + fq * 4 + j, s_ = wc * 32 + n * 16 + fr;
                        const float v = (s_ <= t) ? pa[m][n][j] : 0.f;
                        *(bf16_t*)(sP + swz(t, s_ >> 3) + (s_ & 7) * 2) = f2bf(v);
                    }
        }
        __syncthreads();
        f32x4 oa[8];
#pragma unroll
        for (int i = 0; i < 4; ++i) { const int idx = tid + 256 * i; *(u32x4*)(sG + (idx >> 4) * 256 + (idx & 15) * 16) = gv[i]; }
#pragma unroll
        for (int n = 0; n < 8; ++n) oa[n] = f32x4{0.f, 0.f, 0.f, 0.f};
        const int ch = tid & 7;
#pragma unroll
        for (int sub = 0; sub < 2; ++sub) {
            float sc[8];
#pragma unroll
            for (int j = 0; j < 8; ++j) sc[j] = __expf(totS[sub * 64 + ch * 8 + j]);
#pragma unroll
            for (int i = 0; i < 4; ++i) {
                const int r = (tid + 256 * i) >> 3;
                const u32x4 v = sub ? sv1[i] : sv0[i];
                u32x4 w;
                w.x = pack2(__uint_as_float(v.x << 16) * sc[0], __uint_as_float(v.x & 0xffff0000u) * sc[1]);
                w.y = pack2(__uint_as_float(v.y << 16) * sc[2], __uint_as_float(v.y & 0xffff0000u) * sc[3]);
                w.z = pack2(__uint_as_float(v.z << 16) * sc[4], __uint_as_float(v.z & 0xffff0000u) * sc[5]);
                w.w = pack2(__uint_as_float(v.w << 16) * sc[6], __uint_as_float(v.w & 0xffff0000u) * sc[7]);
                *(u32x4*)(sK + swz(r, ch)) = w;
            }
            __syncthreads();
#pragma unroll
            for (int ks = 0; ks < 2; ++ks) {
                const bf16x8 af = *(const bf16x8*)(sQ + swz16(wid * 16 + fr, sub * 8 + ks * 4 + fq));
#pragma unroll
                for (int n = 0; n < 8; ++n) {
                    const bf16x8 bfr = *(const bf16x8*)(sK + swz(n * 16 + fr, ks * 4 + fq));
                    oa[n] = __builtin_amdgcn_mfma_f32_16x16x32_bf16(af, bfr, oa[n], 0, 0, 0);
                }
            }
            __syncthreads();
        }
#pragma unroll
        for (int i = 0; i < 4; ++i) {
            const int idx = tid + 256 * i, r = idx >> 4, c16 = idx & 15;
            *(u32x4*)(sK + swz16(r, c16)) = iv[i];
        }
        __syncthreads();
#pragma unroll
        for (int ks = 0; ks < 2; ++ks) {
            const bf16x8 af = *(const bf16x8*)(sP + swz(wid * 16 + fr, ks * 4 + fq));
#pragma unroll
            for (int n = 0; n < 8; ++n) {
                const bf16x8 bfr = tr_frag16(sK, trb, ks, n);
                oa[n] = __builtin_amdgcn_mfma_f32_16x16x32_bf16(af, bfr, oa[n], 0, 0, 0);
            }
        }
        float ss[4] = {0.f, 0.f, 0.f, 0.f};
#pragma unroll
        for (int n = 0; n < 8; ++n)
#pragma unroll
            for (int j = 0; j < 4; ++j) ss[j] += oa[n][j] * oa[n][j];
#pragma unroll
        for (int j = 0; j < 4; ++j) {
            ss[j] += __shfl_xor(ss[j], 1, 64); ss[j] += __shfl_xor(ss[j], 2, 64); ss[j] += __shfl_xor(ss[j], 4, 64); ss[j] += __shfl_xor(ss[j], 8, 64);
        }
#pragma unroll
        for (int j = 0; j < 4; ++j) {
            const size_t row = row0 + wid * 16 + fq * 4 + j;
            const float rstd = rsqrtf(ss[j] * (1.f / 128.f) + RMS_EPS);
#pragma unroll
            for (int n = 0; n < 8; ++n) {
                const int dv = n * 16 + fr;
                const float g = bf2f(*(const bf16_t*)(sG + (wid * 16 + fq * 4 + j) * 256 + dv * 2));
                const float y = oa[n][j] * rstd * p.hg_nw[h * 128 + dv] * (g / (1.f + __expf(-g)));
                p.mixin()[row * 768 + h * 128 + dv] = f2bf(y);
            }
        }
    }
}

__device__ __forceinline__ TrBase tr8_base(int lane) {
    const int g = lane >> 4, q = (lane & 15) >> 2, pp = lane & 3;
    const int xl = 4 * (g & 1) + (q >> 1), h = pp >> 1;
    TrBase t;
    t.lo = (8 * g + q) * 128 + ((xl >> 1) << 5) + ((h ^ (xl & 1)) << 4) + 8 * (pp & 1);
    t.hi = (t.lo + 512) ^ 32;
    return t;
}
__device__ __forceinline__ bf16x8 tr_frag8(const char* tile, const TrBase& tb, int ks, int c) {
    int cx = c << 5;
    asm volatile("" : "+v"(cx));
    const v4s lo = __builtin_amdgcn_ds_read_tr16_b64_v4i16((LAS v4s*)(tile + ks * 4096 + (tb.lo ^ cx)));
    const v4s hi = __builtin_amdgcn_ds_read_tr16_b64_v4i16((LAS v4s*)(tile + ks * 4096 + (tb.hi ^ cx)));
    return bf16x8{lo[0], lo[1], lo[2], lo[3], hi[0], hi[1], hi[2], hi[3]};
}

__device__ void ph_attn(const Params& p, char* smem0) {
    const VB vbk = make_vb(smem0);
    char* smem = vbk.smem;
    const int tid = vbk.tid, lane = tid & 63, wid = tid >> 6, fr = lane & 15, fq = lane >> 4;
    char* sQ = smem;
    char* sK = smem + 8192;
    char* sP = sK;
    char* sV = smem + 33792;
    float* sBias = (float*)(smem + 58368);
    const TrBase trb = tr8_base(lane);
    for (int u = vbk.vb; u < 3072; u += vbk.nvb) {
        const int ti = u & 63, gq = u >> 6, g = gq % 3, bhh = gq / 3, hh = bhh & 3, b = bhh >> 2;
        const int lsh = (g == 0) ? 0 : (g == 1 ? 2 : 4), dl = 1 << lsh;
        const int tpr = (S >> lsh) >> 6;
        const int r = ti / tpr, j0 = (ti % tpr) * 64;
        const bf16_t* base = p.proj() + (size_t)b * S * INW + (g * 4 + hh) * 64;
        __syncthreads();
#pragma unroll
        for (int i = 0; i < 2; ++i) {
            const int idx = tid + 256 * i, row = idx >> 3, ch = idx & 7;
            const int tok = (j0 + row) * dl + r;
            *(u32x4*)(sQ + swz(row, ch)) = *(const u32x4*)(base + (size_t)tok * INW + OFF_AQ + ch * 8);
        }
#pragma unroll
        for (int i = 0; i < 6; ++i) {
            const int idx = tid + 256 * i, row = idx >> 3, ch = idx & 7;
            const int j = j0 - 128 + row;
            u32x4 kx = {0u, 0u, 0u, 0u}, vx = {0u, 0u, 0u, 0u};
            if (j >= 0) {
                const size_t o = (size_t)(j * dl + r) * INW + ch * 8;
                kx = *(const u32x4*)(base + o + OFF_AK);
                vx = *(const u32x4*)(base + o + OFF_AV);
            }
            *(u32x4*)(sK + swz(row, ch)) = kx;
            *(u32x4*)(sV + swz(row, ch)) = vx;
        }
        if (tid < 129) sBias[tid] = p.biasT()[(g * 129 + tid) * 4 + hh];
        __syncthreads();
        f32x4 sa[12];
#pragma unroll
        for (int n = 0; n < 12; ++n) sa[n] = f32x4{0.f, 0.f, 0.f, 0.f};
#pragma unroll
        for (int ks = 0; ks < 2; ++ks) {
            const bf16x8 af = *(const bf16x8*)(sQ + swz(wid * 16 + fr, ks * 4 + fq));
#pragma unroll
            for (int n = 0; n < 12; ++n) {
                const bf16x8 bfr = *(const bf16x8*)(sK + swz(n * 16 + fr, ks * 4 + fq));
                sa[n] = __builtin_amdgcn_mfma_f32_16x16x32_bf16(af, bfr, sa[n], 0, 0, 0);
            }
        }
        float mx[4] = {-INFINITY, -INFINITY, -INFINITY, -INFINITY};
#pragma unroll
        for (int n = 0; n < 12; ++n)
#pragma unroll
            for (int j = 0; j < 4; ++j) {
                const int jj = wid * 16 + fq * 4 + j, kk = n * 16 + fr, m = jj + 128 - kk;
                const bool valid = (m >= 0) && (m <= 128) && (j0 - 128 + kk >= 0);
                const int mc = m < 0 ? 0 : (m > 128 ? 128 : m);
                const float v = valid ? sa[n][j] * 0.125f + sBias[mc] : -INFINITY;
                sa[n][j] = v;
                mx[j] = fmaxf(mx[j], v);
            }
#pragma unroll
        for (int j = 0; j < 4; ++j) {
            mx[j] = fmaxf(mx[j], __shfl_xor(mx[j], 1, 64)); mx[j] = fmaxf(mx[j], __shfl_xor(mx[j], 2, 64));
            mx[j] = fmaxf(mx[j], __shfl_xor(mx[j], 4, 64)); mx[j] = fmaxf(mx[j], __shfl_xor(mx[j], 8, 64));
        }
        float ls[4] = {0.f, 0.f, 0.f, 0.f};
#pragma unroll
        for (int n = 0; n < 12; ++n)
#pragma unroll
            for (int j = 0; j < 4; ++j) { const float pe = __expf(sa[n][j] - mx[j]); sa[n][j] = pe; ls[j] += pe; }
#pragma unroll
        for (int j = 0; j < 4; ++j) {
            ls[j] += __shfl_xor(ls[j], 1, 64); ls[j] += __shfl_xor(ls[j], 2, 64); ls[j] += __shfl_xor(ls[j], 4, 64); ls[j] += __shfl_xor(ls[j], 8, 64);
        }
        __syncthreads();
#pragma unroll
        for (int n = 0; n < 12; ++n)
#pragma unroll
            for (int j = 0; j < 4; ++j) *(bf16_t*)(sP + (wid * 16 + fq * 4 + j) * 400 + (n * 16 + fr) * 2) = f2bf(sa[n][j]);
        f32x4 oa[4];
#pragma unroll
        for (int n = 0; n < 4; ++n) oa[n] = f32x4{0.f, 0.f, 0.f, 0.f};
#pragma unroll
        for (int ks = 0; ks < 6; ++ks) {
            const bf16x8 af = *(const bf16x8*)(sP + (wid * 16 + fr) * 400 + (ks * 4 + fq) * 16);
#pragma unroll
            for (int n = 0; n < 4; ++n) {
                const bf16x8 bfr = tr_frag8(sV, trb, ks, n);
                oa[n] = __builtin_amdgcn_mfma_f32_16x16x32_bf16(af, bfr, oa[n], 0, 0, 0);
            }
        }
#pragma unroll
        for (int j = 0; j < 4; ++j) {
            const int jj = wid * 16 + fq * 4 + j;
            const size_t row = (size_t)g * T + (size_t)b * S + (j0 + jj) * dl + r;
            const float inv = 1.f / ls[j];
#pragma unroll
            for (int n = 0; n < 4; ++n) p.ao()[row * 256 + hh * 64 + n * 16 + fr] = oa[n][j] * inv;
            if (fr == 0) p.alse()[row * 4 + hh] = mx[j] + __logf(ls[j]);
        }
    }
}

__device__ void ph_attn_merge(const Params& p) {
    const int tid = otid(), lane = tid & 63, wid = tid >> 6;
    for (int row = blockIdx.x * 8 + wid; row < T; row += gridDim.x * 8) {
        const int hh = lane >> 4;
        const float l0 = p.alse()[((size_t)0 * T + row) * 4 + hh], l1 = p.alse()[((size_t)1 * T + row) * 4 + hh], l2 = p.alse()[((size_t)2 * T + row) * 4 + hh];
        const float mxl = fmaxf(l0, fmaxf(l1, l2));
        float e0 = __expf(l0 - mxl), e1 = __expf(l1 - mxl), e2 = __expf(l2 - mxl);
        const float inv = 1.f / (e0 + e1 + e2);
        e0 *= inv; e1 *= inv; e2 *= inv;
        const f32x4 a0 = *(const f32x4*)(p.ao() + ((size_t)0 * T + row) * 256 + lane * 4);
        const f32x4 a1 = *(const f32x4*)(p.ao() + ((size_t)1 * T + row) * 256 + lane * 4);
        const f32x4 a2 = *(const f32x4*)(p.ao() + ((size_t)2 * T + row) * 256 + lane * 4);
        uint2 o;
        o.x = pack2(a0[0] * e0 + a1[0] * e1 + a2[0] * e2, a0[1] * e0 + a1[1] * e1 + a2[1] * e2);
        o.y = pack2(a0[2] * e0 + a1[2] * e1 + a2[2] * e2, a0[3] * e0 + a1[3] * e1 + a2[3] * e2);
        *(uint2*)(p.mixin() + (size_t)row * 768 + 512 + lane * 4) = o;
    }
}

__device__ void ph_outproj(const Params& p, char* smem) {
    const int tid = otid(), lane = tid & 63, wid = tid >> 6, wr = wid >> 1, wc = wid & 1;
    const int xcd = blockIdx.x & 7, nbx = gridDim.x >> 3;
    for (int i = blockIdx.x >> 3; i < 32; i += nbx) {
        const int nt = i >> 3, mt = xcd * 8 + (i & 7);
        const bf16_t* A = p.mixin() + (size_t)mt * 256 * 768;
        const bf16_t* Bt = p.woutT() + (size_t)nt * 256 * 768;
        f32x4 acc[4][8];
        __syncthreads();
        gemm4(smem, 768, [&](int r) { return A + (size_t)r * 768; }, [&](int n) { return Bt + (size_t)n * 768; }, acc);
        const int b = (mt * 256) >> 12;
        const int colb = nt * 256 + wc * 128;
        const float* g1 = p.mod() + b * 6144 + 2048 + colb;
        char* wl = smem + wid * EPI_WAVE;
#pragma unroll
        for (int m = 0; m < 4; ++m) {
            const size_t rbase = (size_t)(mt * 256 + wr * 64 + m * 16) * D + colb;
            epi_f32(wl, lane, [&](int n, int j) { return acc[m][n][j]; },
                    [&](int row, int ch, f32x4 v) {
                        const f32x4 xv = *(const f32x4*)(p.x + rbase + (size_t)row * D + ch * 4);
                        const f32x4 gv = *(const f32x4*)(g1 + ch * 4);
                        f32x4 o;
                        o[0] = ALPHA * xv[0] + gv[0] * v[0]; o[1] = ALPHA * xv[1] + gv[1] * v[1];
                        o[2] = ALPHA * xv[2] + gv[2] * v[2]; o[3] = ALPHA * xv[3] + gv[3] * v[3];
                        *(f32x4*)(p.pre1() + rbase + (size_t)row * D + ch * 4) = o;
                    });
        }
    }
}

__device__ void ph_ln1(const Params& p) {
    const int tid = otid(), lane = tid & 63, wid = tid >> 6;
    const int rstride = gridDim.x * 8;
    float4 nv[4];
    {
        const float4* xr = (const float4*)(p.pre1() + (size_t)(blockIdx.x * 8 + wid) * D);
#pragma unroll
        for (int i = 0; i < 4; ++i) nv[i] = xr[lane + 64 * i];
    }
    for (int row = blockIdx.x * 8 + wid; row < T; row += rstride) {
        float4 v[4];
        float s = 0.f;
#pragma unroll
        for (int i = 0; i < 4; ++i) { v[i] = nv[i]; s += v[i].x + v[i].y + v[i].z + v[i].w; }
        if (row + rstride < T) {
            const float4* xn = (const float4*)(p.pre1() + (size_t)(row + rstride) * D);
#pragma unroll
            for (int i = 0; i < 4; ++i) nv[i] = xn[lane + 64 * i];
        }
        float mean = wave_sum(s) * (1.f / D);
        float q = 0.f;
#pragma unroll
        for (int i = 0; i < 4; ++i) {
            v[i].x -= mean; v[i].y -= mean; v[i].z -= mean; v[i].w -= mean;
            q += v[i].x * v[i].x + v[i].y * v[i].y + v[i].z * v[i].z + v[i].w * v[i].w;
        }
        float rstd = rsqrtf(wave_sum(q) * (1.f / D) + LN_EPS);
        s = 0.f;
#pragma unroll
        for (int i = 0; i < 4; ++i) {
            const int col = (lane + 64 * i) * 4;
            const float4 g4 = *(const float4*)(p.ln1_g + col), b4 = *(const float4*)(p.ln1_b + col);
            v[i].x = v[i].x * rstd * g4.x + b4.x; v[i].y = v[i].y * rstd * g4.y + b4.y;
            v[i].z = v[i].z * rstd * g4.z + b4.z; v[i].w = v[i].w * rstd * g4.w + b4.w;
            { uint2 xo; xo.x = pack2(v[i].x, v[i].y); xo.y = pack2(v[i].z, v[i].w); *(uint2*)(p.x1() + (size_t)row * D + col) = xo; }
            s += v[i].x + v[i].y + v[i].z + v[i].w;
        }
        mean = wave_sum(s) * (1.f / D);
        q = 0.f;
#pragma unroll
        for (int i = 0; i < 4; ++i) {
            v[i].x -= mean; v[i].y -= mean; v[i].z -= mean; v[i].w -= mean;
            q += v[i].x * v[i].x + v[i].y * v[i].y + v[i].z * v[i].z + v[i].w * v[i].w;
        }
        rstd = rsqrtf(wave_sum(q) * (1.f / D) + LN_EPS);
        const int b = row >> 12;
        const float* sh = p.mod() + b * 6144 + 3072;
        const float* sc = sh + 1024;
#pragma unroll
        for (int i = 0; i < 4; ++i) {
            const int col = (lane + 64 * i) * 4;
            const float4 s4 = *(const float4*)(sc + col), h4 = *(const float4*)(sh + col);
            float4 y;
            y.x = v[i].x * rstd * (1.f + s4.x) + h4.x; y.y = v[i].y * rstd * (1.f + s4.y) + h4.y;
            y.z = v[i].z * rstd * (1.f + s4.z) + h4.z; y.w = v[i].w * rstd * (1.f + s4.w) + h4.w;
            uint2 o;
            o.x = pack2(y.x, y.y); o.y = pack2(y.z, y.w);
            *(uint2*)(p.h2() + (size_t)row * 2048 + col) = o;
            uint2 o2;
            o2.x = pack2(y.x - __uint_as_float(o.x << 16), y.y - __uint_as_float(o.x & 0xffff0000u));
            o2.y = pack2(y.z - __uint_as_float(o.y << 16), y.w - __uint_as_float(o.y & 0xffff0000u));
            *(uint2*)(p.h2() + (size_t)row * 2048 + 1024 + col) = o2;
        }
    }
}

__device__ void ph_router_gemm(const Params& p, char* smem) {
    const int tid = otid(), lane = tid & 63, wid = tid >> 6, wr = wid >> 1, wc = wid & 1;
    for (int u = blockIdx.x; u < 192; u += gridDim.x) {
        const int pass = u >> 6, mt = u & 63;
        const bf16_t* A = p.h2() + (size_t)mt * 256 * 2048 + (pass == 1 ? 1024 : 0);
        const bf16_t* Bt = p.wrT() + (pass == 2 ? (size_t)NE * D : 0);
        f32x4 acc[4][8];
        __syncthreads();
        gemm4(smem, D, [&](int r) { return A + (size_t)r * 2048; }, [&](int n) { return Bt + (size_t)n * D; }, acc);
        char* wl = smem + wid * EPI_WAVE;
#pragma unroll
        for (int m = 0; m < 4; ++m) {
            float* dst = p.lgp() + (size_t)pass * T * NE + (size_t)(mt * 256 + wr * 64 + m * 16) * NE + wc * 128;
            epi_f32(wl, lane, [&](int n, int j) { return acc[m][n][j]; },
                    [&](int row, int ch, f32x4 v) { *(f32x4*)(dst + (size_t)row * NE + ch * 4) = v; });
        }
    }
}

__device__ void ph_topk(const Params& p) {
    const int tid = otid(), lane = tid & 63, wid = tid >> 6;
    constexpr int TK = 4;
    for (int tok0 = (blockIdx.x * 8 + wid) * TK; tok0 < T; tok0 += gridDim.x * 8 * TK) {
        float sc[TK][4], bv[TK][4];
#pragma unroll
        for (int t = 0; t < TK; ++t)
#pragma unroll
            for (int j = 0; j < 4; ++j) {
                const int e = j * 64 + lane;
                const size_t o = (size_t)(tok0 + t) * NE + e;
                const float x = (p.lgp()[o] + p.lgp()[(size_t)T * NE + o]) + p.lgp()[(size_t)2 * T * NE + o];
                sc[t][j] = 1.f / (1.f + expf(-x));
                bv[t][j] = sc[t][j] + p.router_bias[e];
            }
        float gsum[TK][4];
#pragma unroll
        for (int j = 0; j < 4; ++j) {
            float m1[TK], m2[TK];
#pragma unroll
            for (int t = 0; t < TK; ++t) m1[t] = bv[t][j];
#pragma unroll
            for (int o = 16; o > 0; o >>= 1)
#pragma unroll
                for (int t = 0; t < TK; ++t) m1[t] = fmaxf(m1[t], __shfl_xor(m1[t], o, 64));
#pragma unroll
            for (int t = 0; t < TK; ++t) {
                const unsigned long long bal = __ballot(bv[t][j] == m1[t]);
                const unsigned hm = (unsigned)(bal >> (lane & 32));
                const int first = __ffs(hm) - 1;
                m2[t] = ((lane & 31) == first) ? -INFINITY : bv[t][j];
            }
#pragma unroll
            for (int o = 16; o > 0; o >>= 1)
#pragma unroll
                for (int t = 0; t < TK; ++t) m2[t] = fmaxf(m2[t], __shfl_xor(m2[t], o, 64));
#pragma unroll
            for (int t = 0; t < TK; ++t) gsum[t][j] = m1[t] + m2[t];
        }
        float cand[TK][4];
#pragma unroll
        for (int t = 0; t < TK; ++t) {
            float gs[8];
#pragma unroll
            for (int j = 0; j < 4; ++j) { gs[2 * j] = __shfl(gsum[t][j], 0, 64); gs[2 * j + 1] = __shfl(gsum[t][j], 32, 64); }
            unsigned gmask = 0u;
#pragma unroll
            for (int r = 0; r < 4; ++r) {
                float best = -INFINITY; int bi = 0;
#pragma unroll
                for (int g = 0; g < 8; ++g) {
                    const bool ok = (((gmask >> g) & 1u) == 0u) && (gs[g] > best);
                    if (ok) { best = gs[g]; bi = g; }
                }
                gmask |= 1u << bi;
            }
#pragma unroll
            for (int j = 0; j < 4; ++j) cand[t][j] = ((gmask >> (2 * j + (lane >> 5))) & 1u) ? bv[t][j] : -INFINITY;
        }
        float wsum[TK], myw[TK];
        int mye[TK];
#pragma unroll
        for (int t = 0; t < TK; ++t) { wsum[t] = 0.f; myw[t] = 0.f; mye[t] = 0; }
#pragma unroll
        for (int r = 0; r < 8; ++r) {
            float bvv[TK]; int be[TK];
#pragma unroll
            for (int t = 0; t < TK; ++t) {
                bvv[t] = cand[t][0]; be[t] = lane;
#pragma unroll
                for (int j = 1; j < 4; ++j) if (cand[t][j] > bvv[t]) { bvv[t] = cand[t][j]; be[t] = j * 64 + lane; }
            }
#pragma unroll
            for (int o = 32; o > 0; o >>= 1)
#pragma unroll
                for (int t = 0; t < TK; ++t) {
                    const float ov = __shfl_xor(bvv[t], o, 64);
                    const int oe = __shfl_xor(be[t], o, 64);
                    if (ov > bvv[t] || (ov == bvv[t] && oe < be[t])) { bvv[t] = ov; be[t] = oe; }
                }
#pragma unroll
            for (int t = 0; t < TK; ++t) {
                const int bj = be[t] >> 6;
                const float mysc = bj == 0 ? sc[t][0] : (bj == 1 ? sc[t][1] : (bj == 2 ? sc[t][2] : sc[t][3]));
                const float sval = __shfl(mysc, be[t] & 63, 64);
#pragma unroll
                for (int j = 0; j < 4; ++j) if (be[t] == j * 64 + lane) cand[t][j] = -INFINITY;
                wsum[t] += sval;
                if (lane == r) { myw[t] = sval; mye[t] = be[t]; }
            }
        }
        if (lane < 8) {
#pragma unroll
            for (int t = 0; t < TK; ++t) {
                const int a = (tok0 + t) * 8 + lane;
                p.topi()[a] = mye[t];
                p.topw()[a] = myw[t] * (2.5f / wsum[t]);
            }
        }
    }
}

__device__ void ph_lists(const Params& p, char* smem) {
    const int tid = otid(), lane = tid & 63, wid = tid >> 6;
    int* wtot = (int*)smem;
    for (int e = blockIdx.x; e < NE; e += gridDim.x) {
        __syncthreads();
        const int4* src = (const int4*)p.topi() + wid * 4096;
        int cntw = 0;
        for (int i = 0; i < 64; ++i) {
            const int4 v = src[i * 64 + lane];
            cntw += __popcll(__ballot(v.x == e)) + __popcll(__ballot(v.y == e)) + __popcll(__ballot(v.z == e)) + __popcll(__ballot(v.w == e));
        }
        if (lane == 0) wtot[wid] = cntw;
        __syncthreads();
        int base = 0, tot = 0;
        for (int w = 0; w < 8; ++w) { const int c = wtot[w]; if (w < wid) base += c; tot += c; }
        if (tid == 0) p.cnt()[e] = tot;
        int* dst = p.list() + (size_t)e * T;
        const unsigned long long lt = (1ull << lane) - 1ull;
        for (int i = 0; i < 64; ++i) {
            const int4 v = src[i * 64 + lane];
            const int a0 = (wid * 4096 + i * 64 + lane) * 4;
            unsigned long long m;
            m = __ballot(v.x == e); if (v.x == e) dst[base + __popcll(m & lt)] = a0;     base += __popcll(m);
            m = __ballot(v.y == e); if (v.y == e) dst[base + __popcll(m & lt)] = a0 + 1; base += __popcll(m);
            m = __ballot(v.z == e); if (v.z == e) dst[base + __popcll(m & lt)] = a0 + 2; base += __popcll(m);
            m = __ballot(v.w == e); if (v.w == e) dst[base + __popcll(m & lt)] = a0 + 3; base += __popcll(m);
        }
    }
}

struct ExpMap { int* cnt; int* off; int* tile; };
__device__ __forceinline__ ExpMap exp_map(const Params& p, char* smem) {
    ExpMap m;
    m.cnt = (int*)(smem + 98304); m.off = m.cnt + 256; m.tile = m.off + 256;
    const int tid = otid();
    __syncthreads();
    if (tid < NE) m.cnt[tid] = p.cnt()[tid];
    __syncthreads();
    if (tid == 0) {
        int off = 0, tl = 0;
        for (int e = 0; e < NE; ++e) { m.off[e] = off; m.tile[e] = tl; const int c = m.cnt[e]; off += c; tl += (c + 255) >> 8; }
        m.tile[NE] = tl;
    }
    __syncthreads();
    return m;
}
__device__ __forceinline__ int find_expert(const int* tile, int rt) {
    int lo = 0, hi = NE;
    while (hi - lo > 1) { const int mid = (lo + hi) >> 1; if (tile[mid] <= rt) lo = mid; else hi = mid; }
    return lo;
}
#define ROWA(smem) ((int*)((smem) + 98304 + 3328))
#define ROWW(smem) ((float*)((smem) + 98304 + 3328 + 1024))

__device__ void ph_gateup(const Params& p, char* smem) {
    const int tid = otid(), lane = tid & 63, wid = tid >> 6, wr = wid >> 1, wc = wid & 1;
    const ExpMap em = exp_map(p, smem);
    int* rowA = ROWA(smem);
    const int ntile = em.tile[NE];
    const int U = (ntile + T / 256) * 2;
    const int xcd = blockIdx.x & 7, nbx = gridDim.x >> 3;
    const int lo = (int)(((long long)U * xcd) >> 3), hi = (int)(((long long)U * (xcd + 1)) >> 3);
    for (int u = lo + (blockIdx.x >> 3); u < hi; u += nbx) {
        const int rt = u >> 1, c0 = (u & 1) * 128;
        const float *Wg, *Wu;
        bf16_t* gdst;
        int nrow, tokv = -1;
        if (rt < ntile) {
            const int e = find_expert(em.tile, rt);
            const int r0 = (rt - em.tile[e]) * 256, ne = em.cnt[e];
            Wg = p.w_eg + (size_t)e * D * ED; Wu = p.w_eu + (size_t)e * D * ED;
            gdst = p.gbuf() + ((size_t)em.off[e] + r0) * ED + c0;
            nrow = ne - r0;
            if (tid < 256 && r0 + tid < ne) tokv = p.list()[(size_t)e * T + r0 + tid] >> 3;
        } else {
            const int tb = (rt - ntile) * 256;
            Wg = p.w_sg; Wu = p.w_su;
            gdst = p.gsh() + (size_t)tb * ED + c0;
            nrow = 256;
            tokv = tb + (tid & 255);
        }
        __syncthreads();
        if (tid < 256) rowA[tid] = tokv;
        __syncthreads();
        const int t0 = rowA[0];
        f32x4 acc[4][8];
        gemm5(smem, D,
              [&](int r) { const int t = rowA[r]; return p.h2() + (size_t)(t < 0 ? t0 : t) * 2048; },
              [&](int n) { const int t16 = n >> 4; return ((t16 & 1) ? Wu : Wg) + c0 + 16 * (t16 >> 1) + (n & 15); },
              ED, acc);
        if (wr * 64 < nrow) {
            char* wl = smem + wid * EPI_WAVE;
#pragma unroll
            for (int m = 0; m < 4; ++m) {
                const int rb = wr * 64 + m * 16;
                epi_bf16(wl, lane,
                         [&](int n, int j) { if (n >= 4) return 0.f; const float g = acc[m][2 * n][j], uu = acc[m][2 * n + 1][j]; return g / (1.f + __expf(-g)) * uu; },
                         [&](int row, int ch, u32x4 v) { if (ch < 8 && rb + row < nrow) *(u32x4*)(gdst + (size_t)(rb + row) * ED + wc * 64 + ch * 8) = v; });
            }
        }
    }
}

__device__ void ph_down(const Params& p, char* smem) {
    const int tid = otid(), lane = tid & 63, wid = tid >> 6, wr = wid >> 1, wc = wid & 1;
    const ExpMap em = exp_map(p, smem);
    int* rowA = ROWA(smem);
    float* rowW = ROWW(smem);
    const int ntile = em.tile[NE];
    const int U = (ntile + T / 256) * 4;
    const int xcd = blockIdx.x & 7, nbx = gridDim.x >> 3;
    const int lo = (int)(((long long)U * xcd) >> 3), hi = (int)(((long long)U * (xcd + 1)) >> 3);
    for (int u = lo + (blockIdx.x >> 3); u < hi; u += nbx) {
        const int rt = u >> 2, nt = u & 3;
        const bf16_t* A;
        const float* W;
        int nrow, slot = -1;
        float wv = 0.f;
        if (rt < ntile) {
            const int e = find_expert(em.tile, rt);
            const int r0 = (rt - em.tile[e]) * 256, ne = em.cnt[e];
            A = p.gbuf() + ((size_t)em.off[e] + r0) * ED;
            W = p.w_ed + (size_t)e * ED * D + nt * 256;
            nrow = ne - r0;
            if (tid < 256 && r0 + tid < ne) {
                const int a = p.list()[(size_t)e * T + r0 + tid];
                slot = (a >> 3) * 9 + (a & 7);
                wv = p.topw()[a];
            }
        } else {
            const int tb = (rt - ntile) * 256;
            A = p.gsh() + (size_t)tb * ED;
            W = p.w_sd + nt * 256;
            nrow = 256;
            slot = (tb + (tid & 255)) * 9 + 8;
            wv = 1.f;
        }
        __syncthreads();
        if (tid < 256) { rowA[tid] = slot; rowW[tid] = wv; }
        __syncthreads();
        f32x4 acc[4][8];
        gemm5(smem, ED, [&](int r) { return A + (size_t)(r < nrow ? r : 0) * ED; }, [&](int n) { return W + n; }, D, acc);
        if (wr * 64 < nrow) {
            char* wl = smem + wid * EPI_WAVE;
#pragma unroll
            for (int m = 0; m < 4; ++m) {
                const int rb = wr * 64 + m * 16;
                float wj[4];
#pragma unroll
                for (int j = 0; j < 4; ++j) wj[j] = rowW[rb + (lane >> 4) * 4 + j];
                epi_bf16(wl, lane, [&](int n, int j) { return acc[m][n][j] * wj[j]; },
                         [&](int row, int ch, u32x4 v) {
                             const int sl = rowA[rb + row];
                             if (sl >= 0) *(u32x4*)(p.ybuf() + (size_t)sl * D + nt * 256 + wc * 128 + ch * 8) = v;
                         });
            }
        }
    }
}

__device__ void ph_final(const Params& p) {
    const int tid = otid(), lane = tid & 63, wid = tid >> 6;
    for (int row = blockIdx.x * 8 + wid; row < T; row += gridDim.x * 8) {
        const int b = row >> 12;
        const float* g2 = p.mod() + b * 6144 + 5120;
        float4 v[4];
        float s = 0.f;
#pragma unroll
        for (int i = 0; i < 4; ++i) {
            const int col = (lane + 64 * i) * 4;
            float f0 = 0.f, f1 = 0.f, f2 = 0.f, f3 = 0.f;
#pragma unroll
            for (int k = 0; k < 9; ++k) {
                const uint2 w = *(const uint2*)(p.ybuf() + ((size_t)row * 9 + k) * D + col);
                f0 += __uint_as_float(w.x << 16); f1 += __uint_as_float(w.x & 0xffff0000u);
                f2 += __uint_as_float(w.y << 16); f3 += __uint_as_float(w.y & 0xffff0000u);
            }
            float4 xv;
            { const uint2 xw = *(const uint2*)(p.x1() + (size_t)row * D + col);
              xv.x = __uint_as_float(xw.x << 16); xv.y = __uint_as_float(xw.x & 0xffff0000u); xv.z = __uint_as_float(xw.y << 16); xv.w = __uint_as_float(xw.y & 0xffff0000u); }
            const float4 g4 = *(const float4*)(g2 + col);
            v[i].x = ALPHA * xv.x + g4.x * f0; v[i].y = ALPHA * xv.y + g4.y * f1;
            v[i].z = ALPHA * xv.z + g4.z * f2; v[i].w = ALPHA * xv.w + g4.w * f3;
            s += v[i].x + v[i].y + v[i].z + v[i].w;
        }
        const float mean = wave_sum(s) * (1.f / D);
        float q = 0.f;
#pragma unroll
        for (int i = 0; i < 4; ++i) {
            v[i].x -= mean; v[i].y -= mean; v[i].z -= mean; v[i].w -= mean;
            q += v[i].x * v[i].x + v[i].y * v[i].y + v[i].z * v[i].z + v[i].w * v[i].w;
        }
        const float rstd = rsqrtf(wave_sum(q) * (1.f / D) + LN_EPS);
#pragma unroll
        for (int i = 0; i < 4; ++i) {
            const int col = (lane + 64 * i) * 4;
            const float4 g4 = *(const float4*)(p.ln2_g + col), b4 = *(const float4*)(p.ln2_b + col);
            float4 y;
            y.x = v[i].x * rstd * g4.x + b4.x; y.y = v[i].y * rstd * g4.y + b4.y;
            y.z = v[i].z * rstd * g4.z + b4.z; y.w = v[i].w * rstd * g4.w + b4.w;
            *(float4*)(p.out + (size_t)row * D + col) = y;
        }
    }
}

constexpr int LDS_BYTES = 2 * VB_LDS + 16;
constexpr int NPHASE = 14;

template <int PH>
__device__ __forceinline__ void run_phase(const Params& p, char* smem) {
    if (PH == 0) ph_mod(p, smem);
    if (PH == 1) ph_ln0(p);
    if (PH == 2) ph_inproj(p, smem);
    if (PH == 3) { ph_h1(p, smem); ph_attn(p, smem); }
    if (PH == 4) { ph_h2(p); ph_attn_merge(p); }
    if (PH == 5) ph_h3(p, smem);
    if (PH == 6) ph_outproj(p, smem);
    if (PH == 7) ph_ln1(p);
    if (PH == 8) ph_router_gemm(p, smem);
    if (PH == 9) ph_topk(p);
    if (PH == 10) ph_lists(p, smem);
    if (PH == 11) ph_gateup(p, smem);
    if (PH == 12) ph_down(p, smem);
    if (PH == 13) ph_final(p);
}

template <int PH>
__global__ void __launch_bounds__(NTHREADS, 2) k_phase(Params p) {
    extern __shared__ __attribute__((aligned(16))) char smem[];
    run_phase<PH>(p, smem);
}

__global__ void __launch_bounds__(NTHREADS, 2) k_all(Params p) {
    extern __shared__ __attribute__((aligned(16))) char smem[];
    volatile LAS unsigned* st = (volatile LAS unsigned*)(smem + LDS_BYTES - 16);
    if (threadIdx.x == 0) { st[0] = 0u; st[1] = 0u; st[2] = 0u; st[3] = 0u; }
    __syncthreads();
    XcdBarrier bar = xcd_barrier_post(p.bar(), st);
    run_phase<0>(p, smem); xcd_barrier(bar);
    run_phase<1>(p, smem); xcd_barrier(bar);
    run_phase<2>(p, smem); xcd_barrier(bar);
    run_phase<3>(p, smem); xcd_barrier(bar);
    run_phase<4>(p, smem); xcd_barrier(bar);
    run_phase<5>(p, smem); xcd_barrier(bar);
    run_phase<6>(p, smem); xcd_barrier(bar);
    run_phase<7>(p, smem); xcd_barrier(bar);
    run_phase<8>(p, smem); xcd_barrier(bar);
    run_phase<9>(p, smem); xcd_barrier(bar);
    run_phase<10>(p, smem); xcd_barrier(bar);
    run_phase<11>(p, smem); xcd_barrier(bar);
    run_phase<12>(p, smem); xcd_barrier(bar);
    run_phase<13>(p, smem);
}

template <int PH>
static void launch_phase(const Params& p, int grid, hipStream_t stream) {
    static bool attr = false;
    if (!attr) { (void)hipFuncSetAttribute((const void*)k_phase<PH>, hipFuncAttributeMaxDynamicSharedMemorySize, LDS_BYTES); attr = true; }
    hipLaunchKernelGGL(k_phase<PH>, dim3(grid), dim3(NTHREADS), LDS_BYTES, stream, p);
}

extern "C" void kernel_launch(void* const* d_in, const int* in_sizes, int n_in, void* d_out, int out_size, void* d_ws, size_t ws_size,
                              hipStream_t stream) {
    (void)in_sizes; (void)n_in; (void)out_size;
    Params p{};
    const float** pin = (const float**)&p.x;
    for (int i = 0; i < 21; ++i) pin[i] = (const float*)d_in[i];
    p.out = (float*)d_out;
    p.ws = (char*)d_ws;
    char* ctl = p.ws + WO_ctl;
    if (WS_END > ws_size) { fprintf(stderr, "kernel_launch: workspace too small: need %zu have %zu\n", (size_t)WS_END, ws_size); return; }

    static int grid = 0;
    if (grid == 0) {
        int dev = 0, cus = 0, per_cu = 0;
        (void)hipGetDevice(&dev);
        (void)hipDeviceGetAttribute(&cus, hipDeviceAttributeMultiprocessorCount, dev);
        (void)hipFuncSetAttribute((const void*)k_all, hipFuncAttributeMaxDynamicSharedMemorySize, LDS_BYTES);
        (void)hipOccupancyMaxActiveBlocksPerMultiprocessor(&per_cu, (const void*)k_all, NTHREADS, LDS_BYTES);
        grid = cus;
        if (grid != 256) grid = 256;
        fprintf(stderr, "kernel_launch: cus %d per_cu %d grid %d ws need %zu have %zu\n", cus, per_cu, grid, (size_t)WS_END, ws_size);
    }
    (void)hipMemsetAsync(ctl, 0, 65536, stream);
#if ONE_LAUNCH
    hipLaunchKernelGGL(k_all, dim3(grid), dim3(NTHREADS), LDS_BYTES, stream, p);
#else
    launch_phase<0>(p, grid, stream); launch_phase<1>(p, grid, stream); launch_phase<2>(p, grid, stream); launch_phase<3>(p, grid, stream);
    launch_phase<4>(p, grid, stream); launch_phase<5>(p, grid, stream); launch_phase<6>(p, grid, stream); launch_phase<7>(p, grid, stream);
    launch_phase<8>(p, grid, stream); launch_phase<9>(p, grid, stream); launch_phase<10>(p, grid, stream); launch_phase<11>(p, grid, stream);
    launch_phase<12>(p, grid, stream); launch_phase<13>(p, grid, stream);
#endif
}
```

```cpp
#include <hip/hip_runtime.h>
#include <stdint.h>
#include <stdio.h>

#ifndef ONE_LAUNCH
#define ONE_LAUNCH 1
#endif

constexpr int D = 1024, NBATCH = 4, S = 4096, T = NBATCH * S;
constexpr int INW = 4352;
constexpr int NE = 256, TOPK = 8, ED = 256;
constexpr int OFF_HQ = 0, OFF_HF = 512, OFF_HI = 1024, OFF_HG = 1536, OFF_AQ = 2048, OFF_AK = 2816, OFF_AV = 3584;
constexpr float ALPHA = 1.189207115002721f;
constexpr float LN_EPS = 1e-5f, RMS_EPS = 1e-6f;
constexpr int NTHREADS = 512;
constexpr int VB_LDS = 67584;

typedef unsigned short bf16_t;
using bf16x8 = __attribute__((ext_vector_type(8))) short;
using f32x4 = __attribute__((ext_vector_type(4))) float;
using u32x4 = __attribute__((ext_vector_type(4))) unsigned int;

typedef float v2f_t __attribute__((ext_vector_type(2)));
typedef __bf16 v2bf_t __attribute__((ext_vector_type(2)));
typedef short v4s __attribute__((ext_vector_type(4)));
__device__ __forceinline__ unsigned short f2bf(float f) { return __builtin_bit_cast(unsigned short, (__bf16)f); }
__device__ __forceinline__ float bf2f(unsigned short h) { return __uint_as_float(((uint32_t)h) << 16); }
__device__ __forceinline__ uint32_t pack2(float a, float b) {
    const v2f_t f = {a, b};
    return __builtin_bit_cast(uint32_t, __builtin_convertvector(f, v2bf_t));
}
__device__ __forceinline__ float sigmoidf_(float v) { return 1.f / (1.f + __expf(-v)); }

__device__ __forceinline__ int otid() { int t = threadIdx.x; asm volatile("" : "+v"(t)); return t; }

constexpr size_t al256(size_t x) { return (x + 255) & ~(size_t)255; }
constexpr size_t WO_ctl = 0;
constexpr size_t WO_mod = WO_ctl + al256(65536);
constexpr size_t WO_lbv = WO_mod + al256(4 * 6144 * 4);
constexpr size_t WO_biasT = WO_lbv + al256(512 * 4);
constexpr size_t WO_winT = WO_biasT + al256(3 * 129 * 4 * 4);
constexpr size_t WO_woutT = WO_winT + al256((size_t)INW * D * 2);
constexpr size_t WO_wrT = WO_woutT + al256((size_t)D * 768 * 2);
constexpr size_t WO_wsgT = WO_wrT + al256((size_t)2 * NE * D * 2);
constexpr size_t WO_wsuT = WO_wsgT + al256((size_t)ED * D * 2);
constexpr size_t WO_wsdT = WO_wsuT + al256((size_t)ED * D * 2);
constexpr size_t WO_h1 = WO_wsdT + al256((size_t)D * ED * 2);
constexpr size_t WO_proj = WO_h1 + al256((size_t)T * D * 2);
constexpr size_t WO_lgf = WO_proj + al256((size_t)T * INW * 2);
constexpr size_t WO_ao = WO_lgf + al256((size_t)T * 512 * 4);
constexpr size_t WO_alse = WO_ao + al256((size_t)3 * T * 256 * 4);
constexpr size_t WO_mixin = WO_alse + al256((size_t)3 * T * 4 * 4);
constexpr size_t WO_pre1 = WO_mixin + al256((size_t)T * 768 * 2);
constexpr size_t WO_x1 = WO_pre1 + al256((size_t)T * D * 4);
constexpr size_t WO_h2 = WO_x1 + al256((size_t)T * D * 2);
constexpr size_t WO_lgp = WO_h2 + al256((size_t)T * 2048 * 2);
constexpr size_t WO_topi = WO_lgp + al256((size_t)3 * T * NE * 4);
constexpr size_t WO_topw = WO_topi + al256((size_t)T * 8 * 4);
constexpr size_t WO_list = WO_topw + al256((size_t)T * 8 * 4);
constexpr size_t WO_gbuf = WO_list + al256((size_t)NE * T * 4);
constexpr size_t WO_gsh = WO_gbuf + al256((size_t)T * TOPK * ED * 2);
constexpr size_t WO_ybuf = WO_gsh + al256((size_t)T * ED * 2);
constexpr size_t WO_ysh = WO_ybuf + al256((size_t)T * 8 * D);
constexpr size_t WO_dec = WO_ysh + al256((size_t)T * D * 2);
constexpr size_t WS_END = WO_dec + al256((size_t)1024 * 128 * 4);
struct Params {
    const float *x, *c, *w_ada, *b_ada, *w_in, *hg_lb, *hg_nw, *rel_bias, *w_out, *ln1_g, *ln1_b, *w_router, *router_bias,
        *w_eg, *w_eu, *w_ed, *w_sg, *w_su, *w_sd, *ln2_g, *ln2_b;
    float* out;
    char* ws;
    __device__ __forceinline__ unsigned* bar() const { return (unsigned*)(ws + WO_ctl); }
    __device__ __forceinline__ int* cnt() const { return (int*)(ws + WO_ctl + 16384); }
    __device__ __forceinline__ float* kv() const { return (float*)(ws + WO_ybuf); }
    __device__ __forceinline__ bf16_t* sst() const { return (bf16_t*)(ws + WO_ybuf + (size_t)1024 * 16384 * 4); }
    __device__ __forceinline__ float* mod() const { return (float*)(ws + WO_mod); }
    __device__ __forceinline__ float* lbv() const { return (float*)(ws + WO_lbv); }
    __device__ __forceinline__ float* biasT() const { return (float*)(ws + WO_biasT); }
    __device__ __forceinline__ bf16_t* winT() const { return (bf16_t*)(ws + WO_winT); }
    __device__ __forceinline__ bf16_t* woutT() const { return (bf16_t*)(ws + WO_woutT); }
    __device__ __forceinline__ bf16_t* wrT() const { return (bf16_t*)(ws + WO_wrT); }
    __device__ __forceinline__ bf16_t* wsgT() const { return (bf16_t*)(ws + WO_wsgT); }
    __device__ __forceinline__ bf16_t* wsuT() const { return (bf16_t*)(ws + WO_wsuT); }
    __device__ __forceinline__ bf16_t* wsdT() const { return (bf16_t*)(ws + WO_wsdT); }
    __device__ __forceinline__ bf16_t* h1() const { return (bf16_t*)(ws + WO_h1); }
    __device__ __forceinline__ bf16_t* proj() const { return (bf16_t*)(ws + WO_proj); }
    __device__ __forceinline__ float* lgf() const { return (float*)(ws + WO_lgf); }
    __device__ __forceinline__ float* ao() const { return (float*)(ws + WO_ao); }
    __device__ __forceinline__ float* alse() const { return (float*)(ws + WO_alse); }
    __device__ __forceinline__ bf16_t* mixin() const { return (bf16_t*)(ws + WO_mixin); }
    __device__ __forceinline__ float* pre1() const { return (float*)(ws + WO_pre1); }
    __device__ __forceinline__ bf16_t* x1() const { return (bf16_t*)(ws + WO_x1); }
    __device__ __forceinline__ bf16_t* h2() const { return (bf16_t*)(ws + WO_h2); }
    __device__ __forceinline__ float* lgp() const { return (float*)(ws + WO_lgp); }
    __device__ __forceinline__ int* topi() const { return (int*)(ws + WO_topi); }
    __device__ __forceinline__ float* topw() const { return (float*)(ws + WO_topw); }
    __device__ __forceinline__ int* list() const { return (int*)(ws + WO_list); }
    __device__ __forceinline__ bf16_t* gbuf() const { return (bf16_t*)(ws + WO_gbuf); }
    __device__ __forceinline__ bf16_t* gsh() const { return (bf16_t*)(ws + WO_gsh); }
    __device__ __forceinline__ unsigned char* ybuf() const { return (unsigned char*)(ws + WO_ybuf); }
    __device__ __forceinline__ bf16_t* ysh() const { return (bf16_t*)(ws + WO_ysh); }
    __device__ __forceinline__ float* dec() const { return (float*)(ws + WO_dec); }
};

#define XB_TMO      128
#define XB_XCNT(j)  (256  + 64 * (j))
#define XB_XSUB(j)  (1280 + 64 * (j))
#define XB_XGEN(j)  (2304 + 64 * (j))
#define XB_TOP      3328
#define XB_TOPGEN   3392
#define XCD_BAR_WORDS 3456
#define XB_SPIN_CAP (1u << 18)
#define LAS __attribute__((address_space(3)))

__device__ __forceinline__ unsigned xb_ld(unsigned* p)              { return __hip_atomic_load(p, __ATOMIC_RELAXED, __HIP_MEMORY_SCOPE_AGENT); }
__device__ __forceinline__ unsigned xb_add(unsigned* p, unsigned v) { return __hip_atomic_fetch_add(p, v, __ATOMIC_RELAXED, __HIP_MEMORY_SCOPE_AGENT); }
__device__ __forceinline__ unsigned xb_xcc_id() { return (unsigned)__builtin_amdgcn_s_getreg((3 << 11) | 20) & 0xFu; }
#define XB_SPIN(cond, bar) do { unsigned _sp = 0; while (cond) { __builtin_amdgcn_s_sleep(1); \
    if ((++_sp & 255u) == 0u) { if (xb_ld(&(bar)[XB_TMO])) break; if (_sp > XB_SPIN_CAP) { atomicAdd(&(bar)[XB_TMO], 1u); break; } } } } while (0)

struct XcdBarrier {
    unsigned* bar; unsigned x;
    volatile LAS unsigned* st;
};
__device__ __forceinline__ XcdBarrier xcd_barrier_post(unsigned* bar, volatile LAS unsigned* st) {
    XcdBarrier b; b.bar = bar; b.x = xb_xcc_id(); b.st = st;
    if (threadIdx.x == 0) (void)xb_add(&bar[XB_XCNT(b.x)], 1u);
    return b;
}
__device__ __forceinline__ void xcd_barrier_complete(unsigned* bar, unsigned x, unsigned& nloc, unsigned& nx) {
    const unsigned G = gridDim.x * gridDim.y * gridDim.z;
    unsigned sum, cnt, mine, sp = 0u;
    for (;;) {
        sum = 0u; cnt = 0u; mine = 0u;
#pragma unroll
        for (unsigned j = 0; j < 16; ++j) { const unsigned c = xb_ld(&bar[XB_XCNT(j)]); sum += c; cnt += (c > 0u) ? 1u : 0u; mine = (j == x) ? c : mine; }
        if (sum == G) break;
        __builtin_amdgcn_s_sleep(1);
        if ((++sp & 255u) == 0u) { if (xb_ld(&bar[XB_TMO])) break; if (sp > XB_SPIN_CAP) { atomicAdd(&bar[XB_TMO], 1u); break; } }
    }
    nloc = mine > 0u ? mine : 1u; nx = cnt > 0u ? cnt : 1u;
}
__device__ __forceinline__ void xcd_barrier(const XcdBarrier& b) {
    asm volatile("s_waitcnt vmcnt(0)" ::: "memory");
    __syncthreads();
    if (threadIdx.x == 0) {
        unsigned* bar = b.bar;
        __builtin_amdgcn_s_waitcnt(0);
        unsigned nloc = b.st[0], nx = b.st[1];
        if (nloc == 0u) { xcd_barrier_complete(bar, b.x, nloc, nx); b.st[0] = nloc; b.st[1] = nx; }
        const unsigned old = xb_add(&bar[XB_XSUB(b.x)], 1u);
        const unsigned gen = old / nloc;
        if (old + 1u == (gen + 1u) * nloc) {
            __builtin_amdgcn_fence(__ATOMIC_RELEASE, "agent");
            asm volatile("s_waitcnt vmcnt(0)" ::: "memory");
            const unsigned og = xb_add(&bar[XB_TOP], 1u);
            const unsigned tg = og / nx;
            if (og + 1u == (tg + 1u) * nx) xb_add(&bar[XB_TOPGEN], 1u);
            else XB_SPIN(xb_ld(&bar[XB_TOPGEN]) == tg, bar);
            __builtin_amdgcn_fence(__ATOMIC_ACQUIRE, "agent");
            xb_add(&bar[XB_XGEN(b.x)], 1u);
            asm volatile("s_waitcnt vmcnt(0)" ::: "memory");
        } else {
            XB_SPIN(xb_ld(&bar[XB_XGEN(b.x)]) == gen, bar);
            __builtin_amdgcn_fence(__ATOMIC_ACQUIRE, "agent");
            asm volatile("s_waitcnt vmcnt(0)" ::: "memory");
        }
    }
    __syncthreads();
}

struct VB { int vb, nvb, tid; char* smem; };
__device__ __forceinline__ VB make_vb(char* smem) {
    const int t = otid();
    VB v; v.vb = (int)blockIdx.x * 2 + (t >> 8); v.nvb = (int)gridDim.x * 2; v.tid = t & 255; v.smem = smem + (t >> 8) * VB_LDS;
    return v;
}
__device__ __forceinline__ int swz(int row, int chunk) { return row * 128 + ((chunk ^ ((row >> 1) & 7)) << 4); }

__device__ __forceinline__ float wave_sum(float v) {
#pragma unroll
    for (int o = 32; o > 0; o >>= 1) v += __shfl_xor(v, o, 64);
    return v;
}

__device__ __forceinline__ int t5_bucket(int n) {
    if (n < 16) return n;
    const float v = logf((float)n / 16.f) / logf(128.f) * 16.f;
    int large = 16 + (int)v;
    return large < 31 ? large : 31;
}

__device__ __forceinline__ void tr_tile(const VB& v, const float* src, int ld, bf16_t* dst, bf16_t* dst2, int ldd, int k0, int n0) {
    float* t = (float*)v.smem;
    __syncthreads();
#pragma unroll
    for (int i = 0; i < 4; ++i) {
        const int r = (v.tid >> 4) + 16 * i, c4 = v.tid & 15;
        const f32x4 x = *(const f32x4*)(src + (size_t)(k0 + r) * ld + n0 + c4 * 4);
        t[r * 65 + c4 * 4 + 0] = x[0]; t[r * 65 + c4 * 4 + 1] = x[1]; t[r * 65 + c4 * 4 + 2] = x[2]; t[r * 65 + c4 * 4 + 3] = x[3];
    }
    __syncthreads();
    const int n = v.tid >> 2, kq = v.tid & 3;
    float f[16];
#pragma unroll
    for (int i = 0; i < 16; ++i) f[i] = t[(kq * 16 + i) * 65 + n];
    u32x4 a, b;
    a[0] = pack2(f[0], f[1]); a[1] = pack2(f[2], f[3]); a[2] = pack2(f[4], f[5]); a[3] = pack2(f[6], f[7]);
    b[0] = pack2(f[8], f[9]); b[1] = pack2(f[10], f[11]); b[2] = pack2(f[12], f[13]); b[3] = pack2(f[14], f[15]);
    bf16_t* d = dst + (size_t)(n0 + n) * ldd + k0 + kq * 16;
    *(u32x4*)d = a; *(u32x4*)(d + 8) = b;
    if (dst2) {
        u32x4 c, e;
#pragma unroll
        for (int i = 0; i < 4; ++i) {
            c[i] = pack2(f[2 * i] - __uint_as_float(a[i] << 16), f[2 * i + 1] - __uint_as_float(a[i] & 0xffff0000u));
            e[i] = pack2(f[8 + 2 * i] - __uint_as_float(b[i] << 16), f[8 + 2 * i + 1] - __uint_as_float(b[i] & 0xffff0000u));
        }
        bf16_t* d2 = dst2 + (size_t)(n0 + n) * ldd + k0 + kq * 16;
        *(u32x4*)d2 = c; *(u32x4*)(d2 + 8) = e;
    }
}

__device__ void ph_mod(const Params& p, char* smem0) {
    const VB v = make_vb(smem0);
    const int tid = v.tid;
    float* cond = (float*)(v.smem + 20480);
    float* red = cond + 4096;
    for (int i = tid; i < 4096; i += 256) { const float x = p.c[i]; cond[i] = x / (1.f + __expf(-x)); }
    __syncthreads();
    const int NU = 194 + 1088 + 192 + 64 + 64 + 64 + 64;
    const int rounds = (NU + v.nvb - 1) / v.nvb;
    for (int it = 0; it < rounds; ++it) {
        int u = v.vb + it * v.nvb;
        if (u >= NU) u = NU - 1;
        if (u < 192) {
            const int c4 = tid & 7, kq = tid >> 3;
            f32x4 a0 = {0.f, 0.f, 0.f, 0.f}, a1 = a0, a2 = a0, a3 = a0;
            const float* wp = p.w_ada + u * 32 + c4 * 4;
#pragma unroll 8
            for (int k = kq; k < 1024; k += 32) {
                const f32x4 w = *(const f32x4*)(wp + (size_t)k * 6144);
                a0 += cond[k] * w; a1 += cond[1024 + k] * w; a2 += cond[2048 + k] * w; a3 += cond[3072 + k] * w;
            }
            *(f32x4*)(red + (kq * 4 + 0) * 32 + c4 * 4) = a0; *(f32x4*)(red + (kq * 4 + 1) * 32 + c4 * 4) = a1;
            *(f32x4*)(red + (kq * 4 + 2) * 32 + c4 * 4) = a2; *(f32x4*)(red + (kq * 4 + 3) * 32 + c4 * 4) = a3;
        }
        __syncthreads();
        if (u < 192) {
            if (tid < 128) {
                const int b = tid >> 5, c2 = tid & 31;
                float s = 0.f;
                for (int q = 0; q < 32; ++q) s += red[(q * 4 + b) * 32 + c2];
                p.mod()[b * 6144 + u * 32 + c2] = s + p.b_ada[u * 32 + c2];
            }
        } else if (u == 192) {
            for (int j = tid; j < 512; j += 256) {
                const float a = p.hg_lb[j], b = p.hg_lb[512 + j];
                const float m = fmaxf(a, b);
                const float ea = expf(a - m), eb = expf(b - m);
                p.lbv()[j] = ea / (ea + eb);
            }
        } else if (u == 193) {
            for (int i = tid; i < 3 * 129 * 4; i += 256) {
                const int g = i / (129 * 4), m = (i >> 2) % 129, hh = i & 3;
                const int dil = (g == 0) ? 1 : (g == 1 ? 4 : 16);
                p.biasT()[i] = p.rel_bias[t5_bucket(m * dil) * 12 + g * 4 + hh];
            }
        }
        {
            int w = u - 194;
            const float* src = p.w_out; int ld = D; bf16_t* dst = p.woutT(); bf16_t* dst2 = nullptr; int ldd = 768, k0 = 0, n0 = 0;
            if (w >= 0) {
                if (w < 1088) { src = p.w_in; ld = INW; dst = p.winT(); ldd = D; k0 = (w / 68) * 64; n0 = (w % 68) * 64; }
                else if ((w -= 1088) < 192) { k0 = (w >> 4) * 64; n0 = (w & 15) * 64; }
                else if ((w -= 192) < 64) { src = p.w_router; ld = NE; dst = p.wrT(); dst2 = p.wrT() + (size_t)NE * D; ldd = D; k0 = (w >> 2) * 64; n0 = (w & 3) * 64; }
                else if ((w -= 64) < 64) { src = p.w_sg; ld = ED; dst = p.wsgT(); ldd = D; k0 = (w >> 2) * 64; n0 = (w & 3) * 64; }
                else if ((w -= 64) < 64) { src = p.w_su; ld = ED; dst = p.wsuT(); ldd = D; k0 = (w >> 2) * 64; n0 = (w & 3) * 64; }
                else { w -= 64; src = p.w_sd; ld = D; dst = p.wsdT(); ldd = ED; k0 = (w >> 4) * 64; n0 = (w & 15) * 64; }
            }
            tr_tile(v, src, ld, dst, dst2, ldd, k0, n0);
        }
    }
}

__device__ void ph_ln0(const Params& p) {
    const int tid = otid(), lane = tid & 63, wid = tid >> 6;
    const int rstride = gridDim.x * 8;
    float4 nv[4];
    {
        const float4* xr = (const float4*)(p.x + (size_t)(blockIdx.x * 8 + wid) * D);
#pragma unroll
        for (int i = 0; i < 4; ++i) nv[i] = xr[lane + 64 * i];
    }
    for (int row = blockIdx.x * 8 + wid; row < T; row += rstride) {
        float4 v[4];
        float s = 0.f;
#pragma unroll
        for (int i = 0; i < 4; ++i) { v[i] = nv[i]; s += v[i].x + v[i].y + v[i].z + v[i].w; }
        if (row + rstride < T) {
            const float4* xn = (const float4*)(p.x + (size_t)(row + rstride) * D);
#pragma unroll
            for (int i = 0; i < 4; ++i) nv[i] = xn[lane + 64 * i];
        }
        const float mean = wave_sum(s) * (1.f / D);
        float q = 0.f;
#pragma unroll
        for (int i = 0; i < 4; ++i) {
            v[i].x -= mean; v[i].y -= mean; v[i].z -= mean; v[i].w -= mean;
            q += v[i].x * v[i].x + v[i].y * v[i].y + v[i].z * v[i].z + v[i].w * v[i].w;
        }
        const float rstd = rsqrtf(wave_sum(q) * (1.f / D) + LN_EPS);
        const int b = row >> 12;
        const float* sh = p.mod() + b * 6144;
        const float* sc = sh + 1024;
#pragma unroll
        for (int i = 0; i < 4; ++i) {
            const int col = (lane + 64 * i) * 4;
            const float4 s4 = *(const float4*)(sc + col), h4 = *(const float4*)(sh + col);
            uint2 o;
            o.x = pack2(v[i].x * rstd * (1.f + s4.x) + h4.x, v[i].y * rstd * (1.f + s4.y) + h4.y);
            o.y = pack2(v[i].z * rstd * (1.f + s4.z) + h4.z, v[i].w * rstd * (1.f + s4.w) + h4.w);
            *(uint2*)(p.h1() + (size_t)row * D + col) = o;
        }
    }
}

__device__ __forceinline__ int swz16(int row, int chunk) { return row * 256 + ((chunk ^ (row & 15)) << 4); }
struct TrBase { int lo, hi; };
__device__ __forceinline__ TrBase tr16_base(int lane) {
    const int g = lane >> 4, q = (lane & 15) >> 2, pp = lane & 3;
    const int xl = 8 * (g & 1) + q, h = pp >> 1;
    TrBase t;
    t.lo = (8 * g + q) * 256 + ((xl >> 1) << 5) + ((h ^ (xl & 1)) << 4) + 8 * (pp & 1);
    t.hi = (t.lo + 1024) ^ 64;
    return t;
}
__device__ __forceinline__ bf16x8 tr_frag16(const char* tile, const TrBase& tb, int ks, int c) {
    int cx = c << 5;
    asm volatile("" : "+v"(cx));
    const v4s lo = __builtin_amdgcn_ds_read_tr16_b64_v4i16((LAS v4s*)(tile + ks * 8192 + (tb.lo ^ cx)));
    const v4s hi = __builtin_amdgcn_ds_read_tr16_b64_v4i16((LAS v4s*)(tile + ks * 8192 + (tb.hi ^ cx)));
    return bf16x8{lo[0], lo[1], lo[2], lo[3], hi[0], hi[1], hi[2], hi[3]};
}


__device__ __forceinline__ int aoff(int row, int chunk) { return row * 64 + ((chunk ^ ((row >> 2) & 3)) << 4); }
__device__ __forceinline__ int boff(int row, int chunk) { return row * 512 + ((chunk ^ (((row & 3) << 1) | (((row >> 3) & 1) << 3))) << 4); }
__device__ __forceinline__ bf16x8 tr_pair(const char* p) {
    const v4s lo = __builtin_amdgcn_ds_read_tr16_b64_v4i16((LAS v4s*)(p));
    const v4s hi = __builtin_amdgcn_ds_read_tr16_b64_v4i16((LAS v4s*)(p + 2048));
    return bf16x8{lo[0], lo[1], lo[2], lo[3], hi[0], hi[1], hi[2], hi[3]};
}
constexpr int G3_STAGE = 32768;

template <int BMODE, class AF, class BF>
__device__ __forceinline__ void gemm3(char* smem, const int K, AF arow, BF bsrc, const int ldb, f32x4 (&acc)[4][8], const int nvalid = 256) {
    const int tid = otid(), lane = tid & 63, wid = tid >> 6, wr = wid >> 1, wc = wid & 1, fr = lane & 15, fq = lane >> 4;
    const bf16_t* ap[2];
#pragma unroll
    for (int i = 0; i < 2; ++i) ap[i] = arow((tid >> 2) + 128 * i) + (tid & 3) * 8;
    const float* bpf = nullptr;
    const bf16_t* bpb[2] = {nullptr, nullptr};
    if (BMODE == 0) bpf = (const float*)bsrc((tid & 63) * 4) + (size_t)(tid >> 6) * ldb;
    else {
#pragma unroll
        for (int i = 0; i < 2; ++i) bpb[i] = (const bf16_t*)bsrc((tid >> 2) + 128 * i) + (tid & 3) * 8;
    }
#pragma unroll
    for (int m = 0; m < 4; ++m)
#pragma unroll
        for (int n = 0; n < 8; ++n) acc[m][n] = f32x4{0.f, 0.f, 0.f, 0.f};
    const int trbase = (8 * fq + (fr >> 2)) * 512 + wc * 256 + (((fr >> 2) | ((fq & 1) << 2)) << 5) + ((fr & 3) >> 1) * 16 + (fr & 1) * 8;
    u32x4 ra0[2], ra1[2];
    f32x4 rf0[4], rf1[4];
    u32x4 rb0[2], rb1[2];
    const bool active = wr * 64 < nvalid;
#define G3_GLOAD(RA, RF, RB, k0) do { \
        _Pragma("unroll") for (int i = 0; i < 2; ++i) RA[i] = *(const u32x4*)(ap[i] + (k0)); \
        if (BMODE == 0) { _Pragma("unroll") for (int j = 0; j < 4; ++j) RF[j] = *(const f32x4*)(bpf + (size_t)((k0) + 8 * j) * ldb); } \
        else { _Pragma("unroll") for (int i = 0; i < 2; ++i) RB[i] = *(const u32x4*)(bpb[i] + (k0)); } } while (0)
#define G3_LWRITE(RA, RF, RB, st) do { \
        char* sA_ = (st); char* sB_ = (st) + 16384; \
        _Pragma("unroll") for (int i = 0; i < 2; ++i) *(u32x4*)(sA_ + aoff((tid >> 2) + 128 * i, tid & 3)) = RA[i]; \
        if (BMODE == 0) { _Pragma("unroll") for (int j = 0; j < 4; ++j) { uint2 w_; w_.x = pack2(RF[j][0], RF[j][1]); w_.y = pack2(RF[j][2], RF[j][3]); \
                *(uint2*)(sB_ + boff((tid >> 6) + 8 * j, (tid & 63) >> 1) + (tid & 1) * 8) = w_; } } \
        else { _Pragma("unroll") for (int i = 0; i < 2; ++i) *(u32x4*)(sB_ + aoff((tid >> 2) + 128 * i, tid & 3)) = RB[i]; } } while (0)
#define G3_COMPUTE(st) do { if (active) { \
        const char* sA_ = (st); const char* sB_ = (st) + 16384; \
        bf16x8 af[4]; \
        _Pragma("unroll") for (int m = 0; m < 4; ++m) af[m] = *(const bf16x8*)(sA_ + aoff(wr * 64 + m * 16 + fr, fq)); \
        _Pragma("unroll") for (int n = 0; n < 8; ++n) { \
            bf16x8 bfr; \
            if (BMODE == 0) bfr = tr_pair(sB_ + (trbase ^ (n << 5))); else bfr = *(const bf16x8*)(sB_ + aoff(wc * 128 + n * 16 + fr, fq)); \
            _Pragma("unroll") for (int m = 0; m < 4; ++m) acc[m][n] = __builtin_amdgcn_mfma_f32_16x16x32_bf16(af[m], bfr, acc[m][n], 0, 0, 0); } } } while (0)
    const int nk = K >> 5;
    char* st0 = smem;
    char* st1 = smem + G3_STAGE;
    G3_GLOAD(ra0, rf0, rb0, 0);
    G3_GLOAD(ra1, rf1, rb1, 32);
    G3_LWRITE(ra0, rf0, rb0, st0);
    if (nk > 2) G3_GLOAD(ra0, rf0, rb0, 64);
    __syncthreads();
    for (int kt = 0; kt < nk; kt += 2) {
        G3_LWRITE(ra1, rf1, rb1, st1);
        if (kt + 3 < nk) G3_GLOAD(ra1, rf1, rb1, (kt + 3) * 32);
        G3_COMPUTE(st0);
        __syncthreads();
        if (kt + 2 < nk) G3_LWRITE(ra0, rf0, rb0, st0);
        if (kt + 4 < nk) G3_GLOAD(ra0, rf0, rb0, (kt + 4) * 32);
        G3_COMPUTE(st1);
        __syncthreads();
    }
#undef G3_GLOAD
#undef G3_LWRITE
#undef G3_COMPUTE
}

template <class AF, class BF>
__device__ __forceinline__ void gemm4(char* smem, const int K, AF arow, BF brow, f32x4 (&acc)[4][8]) {
    const int tid = otid(), lane = tid & 63, wid = tid >> 6, wr = wid >> 1, wc = wid & 1, fr = lane & 15, fq = lane >> 4;
    const bf16_t* ga[2];
    const bf16_t* gb[2];
#pragma unroll
    for (int i = 0; i < 2; ++i) {
        const int r = 16 * (wid + 8 * i) + (lane >> 2), sc = ((lane & 3) ^ ((r >> 2) & 3)) * 8;
        ga[i] = arow(r) + sc;
        gb[i] = brow(r) + sc;
    }
#pragma unroll
    for (int m = 0; m < 4; ++m)
#pragma unroll
        for (int n = 0; n < 8; ++n) acc[m][n] = f32x4{0.f, 0.f, 0.f, 0.f};
    char* ldst = smem + wid * 1024 + lane * 16;
#define G4_ISSUE(slot, k0) do { \
        char* d_ = ldst + (slot) * 32768; \
        __builtin_amdgcn_global_load_lds((const unsigned*)(ga[0] + (k0)), (LAS unsigned*)(d_), 16, 0, 0); \
        __builtin_amdgcn_global_load_lds((const unsigned*)(ga[1] + (k0)), (LAS unsigned*)(d_ + 8192), 16, 0, 0); \
        __builtin_amdgcn_global_load_lds((const unsigned*)(gb[0] + (k0)), (LAS unsigned*)(d_ + 16384), 16, 0, 0); \
        __builtin_amdgcn_global_load_lds((const unsigned*)(gb[1] + (k0)), (LAS unsigned*)(d_ + 16384 + 8192), 16, 0, 0); } while (0)
    const int nk = K >> 5;
    G4_ISSUE(0, 0);
    G4_ISSUE(1, 32);
    int slot = 0, slot2 = 2;
    for (int kt = 0; kt < nk; ++kt) {
        if (kt + 1 < nk) asm volatile("s_waitcnt vmcnt(4)" ::: "memory");
        else asm volatile("s_waitcnt vmcnt(0)" ::: "memory");
        __builtin_amdgcn_s_barrier();
        if (kt + 2 < nk) G4_ISSUE(slot2, (kt + 2) * 32);
        const char* sA_ = smem + slot * 32768;
        const char* sB_ = sA_ + 16384;
        bf16x8 af[4];
#pragma unroll
        for (int m = 0; m < 4; ++m) af[m] = *(const bf16x8*)(sA_ + aoff(wr * 64 + m * 16 + fr, fq));
#pragma unroll
        for (int n = 0; n < 8; ++n) {
            const bf16x8 bfr = *(const bf16x8*)(sB_ + aoff(wc * 128 + n * 16 + fr, fq));
#pragma unroll
            for (int m = 0; m < 4; ++m) acc[m][n] = __builtin_amdgcn_mfma_f32_16x16x32_bf16(af[m], bfr, acc[m][n], 0, 0, 0);
        }
        slot = (slot == 2) ? 0 : slot + 1;
        slot2 = (slot2 == 2) ? 0 : slot2 + 1;
    }
#undef G4_ISSUE
    __syncthreads();
}


constexpr int G5_B0 = 49152;
template <class AF, class BF>
__device__ __forceinline__ void gemm5(char* smem, const int K, AF arow, BF bsrc, const int ldb, f32x4 (&acc)[4][8]) {
    const int tid = otid(), lane = tid & 63, wid = tid >> 6, wr = wid >> 1, wc = wid & 1, fr = lane & 15, fq = lane >> 4;
    const bf16_t* ga[2];
#pragma unroll
    for (int i = 0; i < 2; ++i) {
        const int r = 16 * (wid + 8 * i) + (lane >> 2);
        ga[i] = arow(r) + (((lane & 3) ^ ((r >> 2) & 3)) * 8);
    }
    const float* bpf = (const float*)bsrc((tid & 63) * 4) + (size_t)(tid >> 6) * ldb;
#pragma unroll
    for (int m = 0; m < 4; ++m)
#pragma unroll
        for (int n = 0; n < 8; ++n) acc[m][n] = f32x4{0.f, 0.f, 0.f, 0.f};
    const int trbase = (8 * fq + (fr >> 2)) * 512 + wc * 256 + (((fr >> 2) | ((fq & 1) << 2)) << 5) + ((fr & 3) >> 1) * 16 + (fr & 1) * 8;
    char* ldst = smem + wid * 1024 + lane * 16;
    const unsigned lds0 = (unsigned)(size_t)smem;
    unsigned bwoff[4];
#pragma unroll
    for (int j = 0; j < 4; ++j) bwoff[j] = boff((tid >> 6) + 8 * j, (tid & 63) >> 1) + (tid & 1) * 8;
    f32x4 rf0[4], rf1[4];
    const int klast = K - 32;
#define G5_ADMA(slot, k0) do { \
        char* d_ = ldst + (slot) * 16384; \
        __builtin_amdgcn_global_load_lds((const unsigned*)(ga[0] + (k0)), (LAS unsigned*)(d_), 16, 0, 0); \
        __builtin_amdgcn_global_load_lds((const unsigned*)(ga[1] + (k0)), (LAS unsigned*)(d_ + 8192), 16, 0, 0); } while (0)
#define G5_BLOAD(RF, k0) do { const float* q0_ = bpf + (size_t)(k0) * ldb; const float* q1_ = q0_ + (size_t)8 * ldb; const float* q2_ = q0_ + (size_t)16 * ldb; const float* q3_ = q0_ + (size_t)24 * ldb; \
        asm volatile("global_load_dwordx4 %0, %4, off\n\tglobal_load_dwordx4 %1, %5, off\n\tglobal_load_dwordx4 %2, %6, off\n\tglobal_load_dwordx4 %3, %7, off" \
                     : "=&v"(RF[0]), "=&v"(RF[1]), "=&v"(RF[2]), "=&v"(RF[3]) : "v"(q0_), "v"(q1_), "v"(q2_), "v"(q3_) : "memory"); } while (0)
#define G5_BWAIT(RF, N) asm volatile("s_waitcnt vmcnt(" #N ")" : "+v"(RF[0]), "+v"(RF[1]), "+v"(RF[2]), "+v"(RF[3]) :: "memory")
#define G5_BWRITE(RF, st) do { const unsigned sB_ = lds0 + G5_B0 + (st) * 16384; \
        _Pragma("unroll") for (int j = 0; j < 4; ++j) { \
            const unsigned long long w_ = (unsigned long long)pack2(RF[j][0], RF[j][1]) | ((unsigned long long)pack2(RF[j][2], RF[j][3]) << 32); \
            asm volatile("ds_write_b64 %0, %1" :: "v"(sB_ + bwoff[j]), "v"(w_) : "memory"); } } while (0)
#define G5_TRB(n0) do { \
        _Pragma("unroll") for (int n = 0; n < 4; ++n) { const unsigned a_ = sBa_ + (unsigned)(trbase ^ (((n0) + n) << 5)); \
            asm volatile("ds_read_b64_tr_b16 %0, %2\n\tds_read_b64_tr_b16 %1, %2 offset:2048" : "=&v"(tl[n]), "=&v"(th[n]) : "v"(a_) : "memory"); } } while (0)
#define G5_TRW() asm volatile("s_waitcnt lgkmcnt(0)" : "+v"(tl[0]), "+v"(tl[1]), "+v"(tl[2]), "+v"(tl[3]), "+v"(th[0]), "+v"(th[1]), "+v"(th[2]), "+v"(th[3]) :: "memory")
#define G5_MM(n0) do { _Pragma("unroll") for (int n = 0; n < 4; ++n) { \
            const bf16x8 bfr = bf16x8{tl[n][0], tl[n][1], tl[n][2], tl[n][3], th[n][0], th[n][1], th[n][2], th[n][3]}; \
            _Pragma("unroll") for (int m = 0; m < 4; ++m) acc[m][(n0) + n] = __builtin_amdgcn_mfma_f32_16x16x32_bf16(af[m], bfr, acc[m][(n0) + n], 0, 0, 0); } } while (0)
#define G5_COMPUTE(aslot, bst) do { \
        const char* sA_ = smem + (aslot) * 16384; const unsigned sBa_ = lds0 + G5_B0 + (bst) * 16384; \
        v4s tl[4], th[4]; \
        G5_TRB(0); \
        bf16x8 af[4]; \
        _Pragma("unroll") for (int m = 0; m < 4; ++m) af[m] = *(const bf16x8*)(sA_ + aoff(wr * 64 + m * 16 + fr, fq)); \
        G5_TRW(); G5_MM(0); \
        G5_TRB(4); G5_TRW(); G5_MM(4); } while (0)
#define G5_KC(k) ((k) < klast ? (k) : klast)
    const int nk = K >> 5;
    G5_BLOAD(rf0, 0);
    G5_ADMA(0, 0);
    G5_BLOAD(rf1, 32);
    G5_BWAIT(rf0, 6);
    G5_BWRITE(rf0, 0);
    G5_ADMA(1, 32);
    G5_BLOAD(rf0, G5_KC(64));
    int as0 = 0, as2 = 2;
    for (int kt = 0; kt < nk; kt += 2) {
        asm volatile("s_waitcnt vmcnt(10) lgkmcnt(0)" ::: "memory");
        __builtin_amdgcn_s_barrier();
        G5_ADMA(as2, G5_KC((kt + 2) * 32));
        G5_BWAIT(rf1, 8);
        G5_BWRITE(rf1, 1);
        G5_BLOAD(rf1, G5_KC((kt + 3) * 32));
        G5_COMPUTE(as0, 0);
        as0 = (as0 == 2) ? 0 : as0 + 1; as2 = (as2 == 2) ? 0 : as2 + 1;
        asm volatile("s_waitcnt vmcnt(10) lgkmcnt(0)" ::: "memory");
        __builtin_amdgcn_s_barrier();
        G5_ADMA(as2, G5_KC((kt + 3) * 32));
        G5_BWAIT(rf0, 8);
        G5_BWRITE(rf0, 0);
        G5_BLOAD(rf0, G5_KC((kt + 4) * 32));
        G5_COMPUTE(as0, 1);
        as0 = (as0 == 2) ? 0 : as0 + 1; as2 = (as2 == 2) ? 0 : as2 + 1;
    }
    G5_BWAIT(rf0, 0);
    G5_BWAIT(rf1, 0);
    asm volatile("s_waitcnt lgkmcnt(0)" ::: "memory");
    __syncthreads();
#undef G5_ADMA
#undef G5_BLOAD
#undef G5_BWAIT
#undef G5_BWRITE
#undef G5_COMPUTE
#undef G5_TRB
#undef G5_TRW
#undef G5_MM
#undef G5_KC
}

constexpr int EPI_WAVE = 8704;
template <class VF, class SF>
__device__ __forceinline__ void epi_bf16(char* wl, const int lane, VF val, SF store) {
    const int fr = lane & 15, fq = lane >> 4, odd = lane & 1;
#pragma unroll
    for (int n = 0; n < 8; ++n)
#pragma unroll
        for (int jp = 0; jp < 2; ++jp) {
            const float a = val(n, 2 * jp), b = val(n, 2 * jp + 1);
            const float x = odd ? a : b;
            const float y = __shfl_xor(x, 1, 64);
            const uint32_t w = odd ? pack2(y, b) : pack2(a, y);
            *(uint32_t*)(wl + (fq * 4 + 2 * jp + odd) * 272 + (n * 16 + (fr & ~1)) * 2) = w;
        }
    int ln = lane;
    asm volatile("" : "+v"(ln));
#pragma unroll
    for (int i = 0; i < 4; ++i) {
        const int idx = ln + 64 * i, row = idx >> 4, ch = idx & 15;
        store(row, ch, *(const u32x4*)(wl + row * 272 + ch * 16));
    }
}
template <class VF, class SF>
__device__ __forceinline__ void epi_f32(char* wl, const int lane, VF val, SF store) {
    const int fr = lane & 15, fq = lane >> 4;
#pragma unroll
    for (int n = 0; n < 8; ++n)
#pragma unroll
        for (int j = 0; j < 4; ++j) *(float*)(wl + (fq * 4 + j) * 528 + (n * 16 + fr) * 4) = val(n, j);
    int ln = lane;
    asm volatile("" : "+v"(ln));
#pragma unroll
    for (int i = 0; i < 8; ++i) {
        const int idx = ln + 64 * i, row = idx >> 5, ch = idx & 31;
        store(row, ch, *(const f32x4*)(wl + row * 528 + ch * 16));
    }
}


constexpr float Y8_SCALE = 32.f;
template <class VF, class SF>
__device__ __forceinline__ void epi_fp8(char* wl, const int lane, VF val, SF store) {
    const int fr = lane & 15, fq = lane >> 4, odd = lane & 1;
#pragma unroll
    for (int n = 0; n < 8; ++n)
#pragma unroll
        for (int jp = 0; jp < 2; ++jp) {
            const float a = val(n, 2 * jp), b = val(n, 2 * jp + 1);
            const float x = odd ? a : b;
            const float y = __shfl_xor(x, 1, 64);
            const int w = odd ? __builtin_amdgcn_cvt_pk_fp8_f32(y, b, 0, false) : __builtin_amdgcn_cvt_pk_fp8_f32(a, y, 0, false);
            *(unsigned short*)(wl + (fq * 4 + 2 * jp + odd) * 144 + n * 16 + (fr & ~1)) = (unsigned short)w;
        }
    int ln = lane;
    asm volatile("" : "+v"(ln));
#pragma unroll
    for (int i = 0; i < 2; ++i) {
        const int idx = ln + 64 * i, row = idx >> 3, ch = idx & 7;
        store(row, ch, *(const u32x4*)(wl + row * 144 + ch * 16));
    }
}

__device__ void ph_inproj(const Params& p, char* smem) {
    const int tid = otid(), lane = tid & 63, wid = tid >> 6, wr = wid >> 1, wc = wid & 1, fr = lane & 15;
    const int NTN = INW / 256;
    const int xcd = blockIdx.x & 7, nbx = gridDim.x >> 3;
    for (int i = blockIdx.x >> 3; i < 8 * NTN; i += nbx) {
        const int nt = i >> 3, mt = xcd * 8 + (i & 7);
        const bf16_t* A = p.h1() + (size_t)mt * 256 * D;
        const bf16_t* Bt = p.winT() + (size_t)nt * 256 * D;
        f32x4 acc[4][8];
        __syncthreads();
        gemm4(smem, D, [&](int r) { return A + (size_t)r * D; }, [&](int n) { return Bt + (size_t)n * D; }, acc);
        char* wl = smem + wid * EPI_WAVE;
        const int colb = nt * 256 + wc * 128;
        const int rowb = mt * 256 + wr * 64;
        if (colb >= OFF_HF && colb < OFF_HI) {
            float lbc[8];
#pragma unroll
            for (int n = 0; n < 8; ++n) lbc[n] = p.lbv()[colb - OFF_HF + n * 16 + fr];
#pragma unroll
            for (int m = 0; m < 4; ++m) {
                float* dst = p.lgf() + (size_t)(rowb + m * 16) * 512 + (colb - OFF_HF);
                epi_f32(wl, lane,
                        [&](int n, int j) { return logf(lbc[n] + (1.f - lbc[n]) * (1.f / (1.f + expf(-acc[m][n][j])))); },
                        [&](int row, int ch, f32x4 v) { *(f32x4*)(dst + (size_t)row * 512 + ch * 4) = v; });
            }
        } else {
#pragma unroll
            for (int m = 0; m < 4; ++m) {
                bf16_t* dst = p.proj() + (size_t)(rowb + m * 16) * INW + colb;
                epi_bf16(wl, lane, [&](int n, int j) { return acc[m][n][j]; },
                         [&](int row, int ch, u32x4 v) { *(u32x4*)(dst + (size_t)row * INW + ch * 8) = v; });
            }
        }
    }
}

__device__ void ph_h1(const Params& p, char* smem0) {
    const VB vbk = make_vb(smem0);
    char* smem = vbk.smem;
    const int tid = vbk.tid, lane = tid & 63, wid = tid >> 6, wr = wid >> 1, wc = wid & 1, fr = lane & 15, fq = lane >> 4;
    char* sI = smem;
    char* sK = smem + 16384;
    float* sL = (float*)(smem + 32768);
    float* totS = (float*)(smem + 65536);
    const int d = tid & 127, half = tid >> 7;
    const TrBase trb = tr16_base(lane);
    for (int u = vbk.vb; u < 1024; u += vbk.nvb) {
        const int bh = u >> 6, c = u & 63, b = bh >> 2, h = bh & 3;
        const size_t row0 = (size_t)b * S + c * 64;
        __syncthreads();
#pragma unroll
        for (int i = 0; i < 4; ++i) {
            const int idx = tid + 256 * i, r = idx >> 4, ch = idx & 15;
            *(u32x4*)(sI + swz16(r, ch)) = *(const u32x4*)(p.proj() + (row0 + r) * INW + OFF_HI + h * 128 + ch * 8);
        }
#pragma unroll
        for (int i = 0; i < 8; ++i) {
            const int idx = tid + 256 * i, r = idx >> 5, c4 = idx & 31;
            *(f32x4*)(sL + r * 128 + c4 * 4) = *(const f32x4*)(p.lgf() + (row0 + r) * 512 + h * 128 + c4 * 4);
        }
        __syncthreads();
        const float* lcol = sL + half * 32 * 128 + d;
        float tot = 0.f;
#pragma unroll
        for (int s = 0; s < 32; ++s) tot += lcol[s * 128];
        totS[half * 128 + d] = tot;
        __syncthreads();
        const float t0 = totS[d], bl = t0 + totS[128 + d];
        float run = half ? t0 : 0.f;
#pragma unroll 8
        for (int s = 0; s < 32; ++s) {
            const float lv = lcol[s * 128];
            run += lv;
            const float kt = (1.f - __expf(lv)) * __expf(bl - run);
            *(bf16_t*)(sK + swz16(half * 32 + s, d >> 3) + (d & 7) * 2) = f2bf(kt);
        }
        if (half == 0) p.dec()[u * 128 + d] = __expf(bl);
        __syncthreads();
        f32x4 acc[4][4];
#pragma unroll
        for (int m = 0; m < 4; ++m)
#pragma unroll
            for (int n = 0; n < 4; ++n) acc[m][n] = f32x4{0.f, 0.f, 0.f, 0.f};
#pragma unroll
        for (int ks = 0; ks < 2; ++ks) {
            bf16x8 af[4], bfr[4];
#pragma unroll
            for (int m = 0; m < 4; ++m) af[m] = tr_frag16(sI, trb, ks, wr * 4 + m);
#pragma unroll
            for (int n = 0; n < 4; ++n) bfr[n] = tr_frag16(sK, trb, ks, wc * 4 + n);
#pragma unroll
            for (int m = 0; m < 4; ++m)
#pragma unroll
                for (int n = 0; n < 4; ++n) acc[m][n] = __builtin_amdgcn_mfma_f32_16x16x32_bf16(af[m], bfr[n], acc[m][n], 0, 0, 0);
        }
        float* kvu = p.kv() + (size_t)u * 16384;
#pragma unroll
        for (int m = 0; m < 4; ++m)
#pragma unroll
            for (int n = 0; n < 4; ++n)
#pragma unroll
                for (int j = 0; j < 4; ++j) kvu[(wr * 64 + m * 16 + fq * 4 + j) * 128 + wc * 64 + n * 16 + fr] = acc[m][n][j];
    }
}

__device__ void ph_h2(const Params& p) {
    for (int it = blockIdx.x * NTHREADS + otid(); it < 16 * 8192; it += gridDim.x * NTHREADS) {
        const int bh = it >> 13, e2 = it & 8191, dv = e2 >> 6, dk = (e2 & 63) * 2;
        const size_t eoff = (size_t)dv * 128 + dk;
        float sx = 0.f, sy = 0.f;
#pragma unroll 8
        for (int c = 0; c < 64; ++c) {
            const size_t u = (size_t)bh * 64 + c;
            *(uint32_t*)(p.sst() + u * 16384 + eoff) = pack2(sx, sy);
            const float2 kvv = *(const float2*)(p.kv() + u * 16384 + eoff);
            const float2 dc = *(const float2*)(p.dec() + u * 128 + dk);
            sx = dc.x * sx + kvv.x; sy = dc.y * sy + kvv.y;
        }
    }
}

__device__ void ph_h3(const Params& p, char* smem0) {
    const VB vbk = make_vb(smem0);
    char* smem = vbk.smem;
    const int tid = vbk.tid, lane = tid & 63, wid = tid >> 6, wr = wid >> 1, wc = wid & 1, fr = lane & 15, fq = lane >> 4;
    char* sQ = smem;
    char* sK = smem + 16384;
    char* sP = smem + 32768;
    float* sL = (float*)(smem + 32768);
    float* totS = (float*)(smem + 65536);
    char* sG = smem + 40960;
    const int d = tid & 127, half = tid >> 7;
    const TrBase trb = tr16_base(lane);
    for (int u = vbk.vb; u < 1024; u += vbk.nvb) {
        const int bh = u >> 6, c = u & 63, b = bh >> 2, h = bh & 3;
        const size_t row0 = (size_t)b * S + c * 64;
        __syncthreads();
#pragma unroll
        for (int i = 0; i < 4; ++i) {
            const int idx = tid + 256 * i, r = idx >> 4, ch = idx & 15;
            *(u32x4*)(sQ + swz16(r, ch)) = *(const u32x4*)(p.proj() + (row0 + r) * INW + OFF_HQ + h * 128 + ch * 8);
        }
#pragma unroll
        for (int i = 0; i < 8; ++i) {
            const int idx = tid + 256 * i, r = idx >> 5, c4 = idx & 31;
            *(f32x4*)(sL + r * 128 + c4 * 4) = *(const f32x4*)(p.lgf() + (row0 + r) * 512 + h * 128 + c4 * 4);
        }
        u32x4 sv0[4], sv1[4], iv[4], gv[4];
#pragma unroll
        for (int i = 0; i < 4; ++i) {
            const int r8 = (tid + 256 * i) >> 3;
            sv0[i] = *(const u32x4*)(p.sst() + (size_t)u * 16384 + r8 * 128 + (tid & 7) * 8);
            sv1[i] = *(const u32x4*)(p.sst() + (size_t)u * 16384 + r8 * 128 + 64 + (tid & 7) * 8);
            const int idx = tid + 256 * i, r = idx >> 4, c16 = idx & 15;
            iv[i] = *(const u32x4*)(p.proj() + (row0 + r) * INW + OFF_HI + h * 128 + c16 * 8);
            gv[i] = *(const u32x4*)(p.proj() + (row0 + r) * INW + OFF_HG + h * 128 + c16 * 8);
        }
        __syncthreads();
        const float* lcol = sL + half * 32 * 128 + d;
        float tot = 0.f;
#pragma unroll
        for (int s = 0; s < 32; ++s) tot += lcol[s * 128];
        totS[half * 128 + d] = tot;
        __syncthreads();
        const float t0 = totS[d];
        float run = half ? t0 : 0.f;
#pragma unroll 8
        for (int s = 0; s < 32; ++s) {
            const float lv = lcol[s * 128];
            run += lv;
            const int o = swz16(half * 32 + s, d >> 3) + (d & 7) * 2;
            const float qm = bf2f(*(const bf16_t*)(sQ + o)) * __expf(run - t0);
            const float kh = (1.f - __expf(lv)) * __expf(t0 - run);
            *(bf16_t*)(sQ + o) = f2bf(qm);
            *(bf16_t*)(sK + o) = f2bf(kh);
        }
        __syncthreads();
        {
            f32x4 pa[2][2];
#pragma unroll
            for (int m = 0; m < 2; ++m)
#pragma unroll
                for (int n = 0; n < 2; ++n) pa[m][n] = f32x4{0.f, 0.f, 0.f, 0.f};
#pragma unroll
            for (int ks = 0; ks < 4; ++ks) {
                bf16x8 af[2], bfr[2];
#pragma unroll
                for (int m = 0; m < 2; ++m) af[m] = *(const bf16x8*)(sQ + swz16(wr * 32 + m * 16 + fr, ks * 4 + fq));
#pragma unroll
                for (int n = 0; n < 2; ++n) bfr[n] = *(const bf16x8*)(sK + swz16(wc * 32 + n * 16 + fr, ks * 4 + fq));
#pragma unroll
                for (int m = 0; m < 2; ++m)
#pragma unroll
                    for (int n = 0; n < 2; ++n) pa[m][n] = __builtin_amdgcn_mfma_f32_16x16x32_bf16(af[m], bfr[n], pa[m][n], 0, 0, 0);
            }
#pragma unroll
            for (int m = 0; m < 2; ++m)
#pragma unroll
                for (int n = 0; n < 2; ++n)
#pragma unroll
                    for (int j = 0; j < 4; ++j) {
                        const int t = wr * 32 + m * 16 + fq * 4 + j, s_ = wc * 32 + n * 16 + fr;
                        const float v = (s_ <= t) ? pa[m][n][j] : 0.f;
                        *(bf16_t*)(sP + swz(t, s_ >> 3) + (s_ & 7) * 2) = f2bf(v);
                    }
        }
        __syncthreads();
        f32x4 oa[8];
#pragma unroll
        for (int i = 0; i < 4; ++i) { const int idx = tid + 256 * i; *(u32x4*)(sG + (idx >> 4) * 256 + (idx & 15) * 16) = gv[i]; }
#pragma unroll
        for (int n = 0; n < 8; ++n) oa[n] = f32x4{0.f, 0.f, 0.f, 0.f};
        const int ch = tid & 7;
#pragma unroll
        for (int sub = 0; sub < 2; ++sub) {
            float sc[8];
#pragma unroll
            for (int j = 0; j < 8; ++j) sc[j] = __expf(totS[sub * 64 + ch * 8 + j]);
#pragma unroll
            for (int i = 0; i < 4; ++i) {
                const int r = (tid + 256 * i) >> 3;
                const u32x4 v = sub ? sv1[i] : sv0[i];
                u32x4 w;
                w.x = pack2(__uint_as_float(v.x << 16) * sc[0], __uint_as_float(v.x & 0xffff0000u) * sc[1]);
                w.y = pack2(__uint_as_float(v.y << 16) * sc[2], __uint_as_float(v.y & 0xffff0000u) * sc[3]);
                w.z = pack2(__uint_as_float(v.z << 16) * sc[4], __uint_as_float(v.z & 0xffff0000u) * sc[5]);
                w.w = pack2(__uint_as_float(v.w << 16) * sc[6], __uint_as_float(v.w & 0xffff0000u) * sc[7]);
                *(u32x4*)(sK + swz(r, ch)) = w;
            }
            __syncthreads();
#pragma unroll
            for (int ks = 0; ks < 2; ++ks) {
                const bf16x8 af = *(const bf16x8*)(sQ + swz16(wid * 16 + fr, sub * 8 + ks * 4 + fq));
#pragma unroll
                for (int n = 0; n < 8; ++n) {
                    const bf16x8 bfr = *(const bf16x8*)(sK + swz(n * 16 + fr, ks * 4 + fq));
                    oa[n] = __builtin_amdgcn_mfma_f32_16x16x32_bf16(af, bfr, oa[n], 0, 0, 0);
                }
            }
            __syncthreads();
        }
#pragma unroll
        for (int i = 0; i < 4; ++i) {
            const int idx = tid + 256 * i, r = idx >> 4, c16 = idx & 15;
            *(u32x4*)(sK + swz16(r, c16)) = iv[i];
        }
        __syncthreads();
#pragma unroll
        for (int ks = 0; ks < 2; ++ks) {
            const bf16x8 af = *(const bf16x8*)(sP + swz(wid * 16 + fr, ks * 4 + fq));
#pragma unroll
            for (int n = 0; n < 8; ++n) {
                const bf16x8 bfr = tr_frag16(sK, trb, ks, n);
                oa[n] = __builtin_amdgcn_mfma_f32_16x16x32_bf16(af, bfr, oa[n], 0, 0, 0);
            }
        }
        float ss[4] = {0.f, 0.f, 0.f, 0.f};
#pragma unroll
        for (int n = 0; n < 8; ++n)
#pragma unroll
            for (int j = 0; j < 4; ++j) ss[j] += oa[n][j] * oa[n][j];
#pragma unroll
        for (int j = 0; j < 4; ++j) {
            ss[j] += __shfl_xor(ss[j], 1, 64); ss[j] += __shfl_xor(ss[j], 2, 64); ss[j] += __shfl_xor(ss[j], 4, 64); ss[j] += __shfl_xor(ss[j], 8, 64);
        }
#pragma unroll
        for (int j = 0; j < 4; ++j) {
            const size_t row = row0 + wid * 16 + fq * 4 + j;
            const float rstd = rsqrtf(ss[j] * (1.f / 128.f) + RMS_EPS);
#pragma unroll
            for (int n = 0; n < 8; ++n) {
                const int dv = n * 16 + fr;
                const float g = bf2f(*(const bf16_t*)(sG + (wid * 16 + fq * 4 + j) * 256 + dv * 2));
                const float y = oa[n][j] * rstd * p.hg_nw[h * 128 + dv] * (g / (1.f + __expf(-g)));
                p.mixin()[row * 768 + h * 128 + dv] = f2bf(y);
            }
        }
    }
}

__device__ __forceinline__ TrBase tr8_base(int lane) {
    const int g = lane >> 4, q = (lane & 15) >> 2, pp = lane & 3;
    const int xl = 4 * (g & 1) + (q >> 1), h = pp >> 1;
    TrBase t;
    t.lo = (8 * g + q) * 128 + ((xl >> 1) << 5) + ((h ^ (xl & 1)) << 4) + 8 * (pp & 1);
    t.hi = (t.lo + 512) ^ 32;
    return t;
}
__device__ __forceinline__ bf16x8 tr_frag8(const char* tile, const TrBase& tb, int ks, int c) {
    int cx = c << 5;
    asm volatile("" : "+v"(cx));
    const v4s lo = __builtin_amdgcn_ds_read_tr16_b64_v4i16((LAS v4s*)(tile + ks * 4096 + (tb.lo ^ cx)));
    const v4s hi = __builtin_amdgcn_ds_read_tr16_b64_v4i16((LAS v4s*)(tile + ks * 4096 + (tb.hi ^ cx)));
    return bf16x8{lo[0], lo[1], lo[2], lo[3], hi[0], hi[1], hi[2], hi[3]};
}

__device__ void ph_attn(const Params& p, char* smem0) {
    const VB vbk = make_vb(smem0);
    char* smem = vbk.smem;
    const int tid = vbk.tid, lane = tid & 63, wid = tid >> 6, fr = lane & 15, fq = lane >> 4;
    char* sQ = smem;
    char* sK = smem + 8192;
    char* sP = sK;
    char* sV = smem + 33792;
    float* sBias = (float*)(smem + 58368);
    const TrBase trb = tr8_base(lane);
    for (int u = vbk.vb; u < 3072; u += vbk.nvb) {
        const int ti = u & 63, gq = u >> 6, g = gq % 3, bhh = gq / 3, hh = bhh & 3, b = bhh >> 2;
        const int lsh = (g == 0) ? 0 : (g == 1 ? 2 : 4), dl = 1 << lsh;
        const int tpr = (S >> lsh) >> 6;
        const int r = ti / tpr, j0 = (ti % tpr) * 64;
        const bf16_t* base = p.proj() + (size_t)b * S * INW + (g * 4 + hh) * 64;
        __syncthreads();
#pragma unroll
        for (int i = 0; i < 2; ++i) {
            const int idx = tid + 256 * i, row = idx >> 3, ch = idx & 7;
            const int tok = (j0 + row) * dl + r;
            *(u32x4*)(sQ + swz(row, ch)) = *(const u32x4*)(base + (size_t)tok * INW + OFF_AQ + ch * 8);
        }
#pragma unroll
        for (int i = 0; i < 6; ++i) {
            const int idx = tid + 256 * i, row = idx >> 3, ch = idx & 7;
            const int j = j0 - 128 + row;
            u32x4 kx = {0u, 0u, 0u, 0u}, vx = {0u, 0u, 0u, 0u};
            if (j >= 0) {
                const size_t o = (size_t)(j * dl + r) * INW + ch * 8;
                kx = *(const u32x4*)(base + o + OFF_AK);
                vx = *(const u32x4*)(base + o + OFF_AV);
            }
            *(u32x4*)(sK + swz(row, ch)) = kx;
            *(u32x4*)(sV + swz(row, ch)) = vx;
        }
        if (tid < 129) sBias[tid] = p.biasT()[(g * 129 + tid) * 4 + hh];
        __syncthreads();
        f32x4 sa[12];
#pragma unroll
        for (int n = 0; n < 12; ++n) sa[n] = f32x4{0.f, 0.f, 0.f, 0.f};
#pragma unroll
        for (int ks = 0; ks < 2; ++ks) {
            const bf16x8 af = *(const bf16x8*)(sQ + swz(wid * 16 + fr, ks * 4 + fq));
#pragma unroll
            for (int n = 0; n < 12; ++n) {
                const bf16x8 bfr = *(const bf16x8*)(sK + swz(n * 16 + fr, ks * 4 + fq));
                sa[n] = __builtin_amdgcn_mfma_f32_16x16x32_bf16(af, bfr, sa[n], 0, 0, 0);
            }
        }
        float mx[4] = {-INFINITY, -INFINITY, -INFINITY, -INFINITY};
#pragma unroll
        for (int n = 0; n < 12; ++n)
#pragma unroll
            for (int j = 0; j < 4; ++j) {
                const int jj = wid * 16 + fq * 4 + j, kk = n * 16 + fr, m = jj + 128 - kk;
                const bool valid = (m >= 0) && (m <= 128) && (j0 - 128 + kk >= 0);
                const int mc = m < 0 ? 0 : (m > 128 ? 128 : m);
                const float v = valid ? sa[n][j] * 0.125f + sBias[mc] : -INFINITY;
                sa[n][j] = v;
                mx[j] = fmaxf(mx[j], v);
            }
#pragma unroll
        for (int j = 0; j < 4; ++j) {
            mx[j] = fmaxf(mx[j], __shfl_xor(mx[j], 1, 64)); mx[j] = fmaxf(mx[j], __shfl_xor(mx[j], 2, 64));
            mx[j] = fmaxf(mx[j], __shfl_xor(mx[j], 4, 64)); mx[j] = fmaxf(mx[j], __shfl_xor(mx[j], 8, 64));
        }
        float ls[4] = {0.f, 0.f, 0.f, 0.f};
#pragma unroll
        for (int n = 0; n < 12; ++n)
#pragma unroll
            for (int j = 0; j < 4; ++j) { const float pe = __expf(sa[n][j] - mx[j]); sa[n][j] = pe; ls[j] += pe; }
#pragma unroll
        for (int j = 0; j < 4; ++j) {
            ls[j] += __shfl_xor(ls[j], 1, 64); ls[j] += __shfl_xor(ls[j], 2, 64); ls[j] += __shfl_xor(ls[j], 4, 64); ls[j] += __shfl_xor(ls[j], 8, 64);
        }
        __syncthreads();
#pragma unroll
        for (int n = 0; n < 12; ++n)
#pragma unroll
            for (int j = 0; j < 4; ++j) *(bf16_t*)(sP + (wid * 16 + fq * 4 + j) * 400 + (n * 16 + fr) * 2) = f2bf(sa[n][j]);
        f32x4 oa[4];
#pragma unroll
        for (int n = 0; n < 4; ++n) oa[n] = f32x4{0.f, 0.f, 0.f, 0.f};
#pragma unroll
        for (int ks = 0; ks < 6; ++ks) {
            const bf16x8 af = *(const bf16x8*)(sP + (wid * 16 + fr) * 400 + (ks * 4 + fq) * 16);
#pragma unroll
            for (int n = 0; n < 4; ++n) {
                const bf16x8 bfr = tr_frag8(sV, trb, ks, n);
                oa[n] = __builtin_amdgcn_mfma_f32_16x16x32_bf16(af, bfr, oa[n], 0, 0, 0);
            }
        }
#pragma unroll
        for (int j = 0; j < 4; ++j) {
            const int jj = wid * 16 + fq * 4 + j;
            const size_t row = (size_t)g * T + (size_t)b * S + (j0 + jj) * dl + r;
            const float inv = 1.f / ls[j];
#pragma unroll
            for (int n = 0; n < 4; ++n) p.ao()[row * 256 + hh * 64 + n * 16 + fr] = oa[n][j] * inv;
            if (fr == 0) p.alse()[row * 4 + hh] = mx[j] + __logf(ls[j]);
        }
    }
}

__device__ void ph_attn_merge(const Params& p) {
    const int tid = otid(), lane = tid & 63, wid = tid >> 6;
    for (int row = blockIdx.x * 8 + wid; row < T; row += gridDim.x * 8) {
        const int hh = lane >> 4;
        const float l0 = p.alse()[((size_t)0 * T + row) * 4 + hh], l1 = p.alse()[((size_t)1 * T + row) * 4 + hh], l2 = p.alse()[((size_t)2 * T + row) * 4 + hh];
        const float mxl = fmaxf(l0, fmaxf(l1, l2));
        float e0 = __expf(l0 - mxl), e1 = __expf(l1 - mxl), e2 = __expf(l2 - mxl);
        const float inv = 1.f / (e0 + e1 + e2);
        e0 *= inv; e1 *= inv; e2 *= inv;
        const f32x4 a0 = *(const f32x4*)(p.ao() + ((size_t)0 * T + row) * 256 + lane * 4);
        const f32x4 a1 = *(const f32x4*)(p.ao() + ((size_t)1 * T + row) * 256 + lane * 4);
        const f32x4 a2 = *(const f32x4*)(p.ao() + ((size_t)2 * T + row) * 256 + lane * 4);
        uint2 o;
        o.x = pack2(a0[0] * e0 + a1[0] * e1 + a2[0] * e2, a0[1] * e0 + a1[1] * e1 + a2[1] * e2);
        o.y = pack2(a0[2] * e0 + a1[2] * e1 + a2[2] * e2, a0[3] * e0 + a1[3] * e1 + a2[3] * e2);
        *(uint2*)(p.mixin() + (size_t)row * 768 + 512 + lane * 4) = o;
    }
}

__device__ void ph_outproj(const Params& p, char* smem) {
    const int tid = otid(), lane = tid & 63, wid = tid >> 6, wr = wid >> 1, wc = wid & 1;
    const int xcd = blockIdx.x & 7, nbx = gridDim.x >> 3;
    for (int i = blockIdx.x >> 3; i < 32; i += nbx) {
        const int nt = i >> 3, mt = xcd * 8 + (i & 7);
        const bf16_t* A = p.mixin() + (size_t)mt * 256 * 768;
        const bf16_t* Bt = p.woutT() + (size_t)nt * 256 * 768;
        f32x4 acc[4][8];
        __syncthreads();
        gemm4(smem, 768, [&](int r) { return A + (size_t)r * 768; }, [&](int n) { return Bt + (size_t)n * 768; }, acc);
        const int b = (mt * 256) >> 12;
        const int colb = nt * 256 + wc * 128;
        const float* g1 = p.mod() + b * 6144 + 2048 + colb;
        char* wl = smem + wid * EPI_WAVE;
#pragma unroll
        for (int m = 0; m < 4; ++m) {
            const size_t rbase = (size_t)(mt * 256 + wr * 64 + m * 16) * D + colb;
            epi_f32(wl, lane, [&](int n, int j) { return acc[m][n][j]; },
                    [&](int row, int ch, f32x4 v) {
                        const f32x4 xv = *(const f32x4*)(p.x + rbase + (size_t)row * D + ch * 4);
                        const f32x4 gv = *(const f32x4*)(g1 + ch * 4);
                        f32x4 o;
                        o[0] = ALPHA * xv[0] + gv[0] * v[0]; o[1] = ALPHA * xv[1] + gv[1] * v[1];
                        o[2] = ALPHA * xv[2] + gv[2] * v[2]; o[3] = ALPHA * xv[3] + gv[3] * v[3];
                        *(f32x4*)(p.pre1() + rbase + (size_t)row * D + ch * 4) = o;
                    });
        }
    }
}

__device__ void ph_ln1(const Params& p) {
    const int tid = otid(), lane = tid & 63, wid = tid >> 6;
    const int rstride = gridDim.x * 8;
    float4 nv[4];
    {
        const float4* xr = (const float4*)(p.pre1() + (size_t)(blockIdx.x * 8 + wid) * D);
#pragma unroll
        for (int i = 0; i < 4; ++i) nv[i] = xr[lane + 64 * i];
    }
    for (int row = blockIdx.x * 8 + wid; row < T; row += rstride) {
        float4 v[4];
        float s = 0.f;
#pragma unroll
        for (int i = 0; i < 4; ++i) { v[i] = nv[i]; s += v[i].x + v[i].y + v[i].z + v[i].w; }
        if (row + rstride < T) {
            const float4* xn = (const float4*)(p.pre1() + (size_t)(row + rstride) * D);
#pragma unroll
            for (int i = 0; i < 4; ++i) nv[i] = xn[lane + 64 * i];
        }
        float mean = wave_sum(s) * (1.f / D);
        float q = 0.f;
#pragma unroll
        for (int i = 0; i < 4; ++i) {
            v[i].x -= mean; v[i].y -= mean; v[i].z -= mean; v[i].w -= mean;
            q += v[i].x * v[i].x + v[i].y * v[i].y + v[i].z * v[i].z + v[i].w * v[i].w;
        }
        float rstd = rsqrtf(wave_sum(q) * (1.f / D) + LN_EPS);
        s = 0.f;
#pragma unroll
        for (int i = 0; i < 4; ++i) {
            const int col = (lane + 64 * i) * 4;
            const float4 g4 = *(const float4*)(p.ln1_g + col), b4 = *(const float4*)(p.ln1_b + col);
            v[i].x = v[i].x * rstd * g4.x + b4.x; v[i].y = v[i].y * rstd * g4.y + b4.y;
            v[i].z = v[i].z * rstd * g4.z + b4.z; v[i].w = v[i].w * rstd * g4.w + b4.w;
            { uint2 xo; xo.x = pack2(v[i].x, v[i].y); xo.y = pack2(v[i].z, v[i].w); *(uint2*)(p.x1() + (size_t)row * D + col) = xo; }
            s += v[i].x + v[i].y + v[i].z + v[i].w;
        }
        mean = wave_sum(s) * (1.f / D);
        q = 0.f;
#pragma unroll
        for (int i = 0; i < 4; ++i) {
            v[i].x -= mean; v[i].y -= mean; v[i].z -= mean; v[i].w -= mean;
            q += v[i].x * v[i].x + v[i].y * v[i].y + v[i].z * v[i].z + v[i].w * v[i].w;
        }
        rstd = rsqrtf(wave_sum(q) * (1.f / D) + LN_EPS);
        const int b = row >> 12;
        const float* sh = p.mod() + b * 6144 + 3072;
        const float* sc = sh + 1024;
#pragma unroll
        for (int i = 0; i < 4; ++i) {
            const int col = (lane + 64 * i) * 4;
            const float4 s4 = *(const float4*)(sc + col), h4 = *(const float4*)(sh + col);
            float4 y;
            y.x = v[i].x * rstd * (1.f + s4.x) + h4.x; y.y = v[i].y * rstd * (1.f + s4.y) + h4.y;
            y.z = v[i].z * rstd * (1.f + s4.z) + h4.z; y.w = v[i].w * rstd * (1.f + s4.w) + h4.w;
            uint2 o;
            o.x = pack2(y.x, y.y); o.y = pack2(y.z, y.w);
            *(uint2*)(p.h2() + (size_t)row * 2048 + col) = o;
            uint2 o2;
            o2.x = pack2(y.x - __uint_as_float(o.x << 16), y.y - __uint_as_float(o.x & 0xffff0000u));
            o2.y = pack2(y.z - __uint_as_float(o.y << 16), y.w - __uint_as_float(o.y & 0xffff0000u));
            *(uint2*)(p.h2() + (size_t)row * 2048 + 1024 + col) = o2;
        }
    }
}

__device__ void ph_router_gemm(const Params& p, char* smem) {
    const int tid = otid(), lane = tid & 63, wid = tid >> 6, wr = wid >> 1, wc = wid & 1;
    for (int u = blockIdx.x; u < 192; u += gridDim.x) {
        const int pass = u >> 6, mt = u & 63;
        const bf16_t* A = p.h2() + (size_t)mt * 256 * 2048 + (pass == 1 ? 1024 : 0);
        const bf16_t* Bt = p.wrT() + (pass == 2 ? (size_t)NE * D : 0);
        f32x4 acc[4][8];
        __syncthreads();
        gemm4(smem, D, [&](int r) { return A + (size_t)r * 2048; }, [&](int n) { return Bt + (size_t)n * D; }, acc);
        char* wl = smem + wid * EPI_WAVE;
#pragma unroll
        for (int m = 0; m < 4; ++m) {
            float* dst = p.lgp() + (size_t)pass * T * NE + (size_t)(mt * 256 + wr * 64 + m * 16) * NE + wc * 128;
            epi_f32(wl, lane, [&](int n, int j) { return acc[m][n][j]; },
                    [&](int row, int ch, f32x4 v) { *(f32x4*)(dst + (size_t)row * NE + ch * 4) = v; });
        }
    }
}

__device__ void ph_topk(const Params& p) {
    const int tid = otid(), lane = tid & 63, wid = tid >> 6;
    constexpr int TK = 4;
    for (int tok0 = (blockIdx.x * 8 + wid) * TK; tok0 < T; tok0 += gridDim.x * 8 * TK) {
        float sc[TK][4], bv[TK][4];
#pragma unroll
        for (int t = 0; t < TK; ++t)
#pragma unroll
            for (int j = 0; j < 4; ++j) {
                const int e = j * 64 + lane;
                const size_t o = (size_t)(tok0 + t) * NE + e;
                const float x = (p.lgp()[o] + p.lgp()[(size_t)T * NE + o]) + p.lgp()[(size_t)2 * T * NE + o];
                sc[t][j] = 1.f / (1.f + expf(-x));
                bv[t][j] = sc[t][j] + p.router_bias[e];
            }
        float gsum[TK][4];
#pragma unroll
        for (int j = 0; j < 4; ++j) {
            float m1[TK], m2[TK];
#pragma unroll
            for (int t = 0; t < TK; ++t) m1[t] = bv[t][j];
#pragma unroll
            for (int o = 16; o > 0; o >>= 1)
#pragma unroll
                for (int t = 0; t < TK; ++t) m1[t] = fmaxf(m1[t], __shfl_xor(m1[t], o, 64));
#pragma unroll
            for (int t = 0; t < TK; ++t) {
                const unsigned long long bal = __ballot(bv[t][j] == m1[t]);
                const unsigned hm = (unsigned)(bal >> (lane & 32));
                const int first = __ffs(hm) - 1;
                m2[t] = ((lane & 31) == first) ? -INFINITY : bv[t][j];
            }
#pragma unroll
            for (int o = 16; o > 0; o >>= 1)
#pragma unroll
                for (int t = 0; t < TK; ++t) m2[t] = fmaxf(m2[t], __shfl_xor(m2[t], o, 64));
#pragma unroll
            for (int t = 0; t < TK; ++t) gsum[t][j] = m1[t] + m2[t];
        }
        float cand[TK][4];
#pragma unroll
        for (int t = 0; t < TK; ++t) {
            float gs[8];
#pragma unroll
            for (int j = 0; j < 4; ++j) { gs[2 * j] = __shfl(gsum[t][j], 0, 64); gs[2 * j + 1] = __shfl(gsum[t][j], 32, 64); }
            unsigned gmask = 0u;
#pragma unroll
            for (int r = 0; r < 4; ++r) {
                float best = -INFINITY; int bi = 0;
#pragma unroll
                for (int g = 0; g < 8; ++g) {
                    const bool ok = (((gmask >> g) & 1u) == 0u) && (gs[g] > best);
                    if (ok) { best = gs[g]; bi = g; }
                }
                gmask |= 1u << bi;
            }
#pragma unroll
            for (int j = 0; j < 4; ++j) cand[t][j] = ((gmask >> (2 * j + (lane >> 5))) & 1u) ? bv[t][j] : -INFINITY;
        }
        float wsum[TK], myw[TK];
        int mye[TK];
#pragma unroll
        for (int t = 0; t < TK; ++t) { wsum[t] = 0.f; myw[t] = 0.f; mye[t] = 0; }
#pragma unroll
        for (int r = 0; r < 8; ++r) {
            float bvv[TK]; int be[TK];
#pragma unroll
            for (int t = 0; t < TK; ++t) {
                bvv[t] = cand[t][0]; be[t] = lane;
#pragma unroll
                for (int j = 1; j < 4; ++j) if (cand[t][j] > bvv[t]) { bvv[t] = cand[t][j]; be[t] = j * 64 + lane; }
            }
#pragma unroll
            for (int o = 32; o > 0; o >>= 1)
#pragma unroll
                for (int t = 0; t < TK; ++t) {
                    const float ov = __shfl_xor(bvv[t], o, 64);
                    const int oe = __shfl_xor(be[t], o, 64);
                    if (ov > bvv[t] || (ov == bvv[t] && oe < be[t])) { bvv[t] = ov; be[t] = oe; }
                }
#pragma unroll
            for (int t = 0; t < TK; ++t) {
                const int bj = be[t] >> 6;
                const float mysc = bj == 0 ? sc[t][0] : (bj == 1 ? sc[t][1] : (bj == 2 ? sc[t][2] : sc[t][3]));
                const float sval = __shfl(mysc, be[t] & 63, 64);
#pragma unroll
                for (int j = 0; j < 4; ++j) if (be[t] == j * 64 + lane) cand[t][j] = -INFINITY;
                wsum[t] += sval;
                if (lane == r) { myw[t] = sval; mye[t] = be[t]; }
            }
        }
        if (lane < 8) {
#pragma unroll
            for (int t = 0; t < TK; ++t) {
                const int a = (tok0 + t) * 8 + lane;
                p.topi()[a] = mye[t];
                p.topw()[a] = myw[t] * (2.5f / wsum[t]);
            }
        }
    }
}

__device__ void ph_lists(const Params& p, char* smem) {
    const int tid = otid(), lane = tid & 63, wid = tid >> 6;
    int* wtot = (int*)smem;
    for (int e = blockIdx.x; e < NE; e += gridDim.x) {
        __syncthreads();
        const int4* src = (const int4*)p.topi() + wid * 4096;
        int cntw = 0;
        for (int i = 0; i < 64; ++i) {
            const int4 v = src[i * 64 + lane];
            cntw += __popcll(__ballot(v.x == e)) + __popcll(__ballot(v.y == e)) + __popcll(__ballot(v.z == e)) + __popcll(__ballot(v.w == e));
        }
        if (lane == 0) wtot[wid] = cntw;
        __syncthreads();
        int base = 0, tot = 0;
        for (int w = 0; w < 8; ++w) { const int c = wtot[w]; if (w < wid) base += c; tot += c; }
        if (tid == 0) p.cnt()[e] = tot;
        int* dst = p.list() + (size_t)e * T;
        const unsigned long long lt = (1ull << lane) - 1ull;
        for (int i = 0; i < 64; ++i) {
            const int4 v = src[i * 64 + lane];
            const int a0 = (wid * 4096 + i * 64 + lane) * 4;
            unsigned long long m;
            m = __ballot(v.x == e); if (v.x == e) dst[base + __popcll(m & lt)] = a0;     base += __popcll(m);
            m = __ballot(v.y == e); if (v.y == e) dst[base + __popcll(m & lt)] = a0 + 1; base += __popcll(m);
            m = __ballot(v.z == e); if (v.z == e) dst[base + __popcll(m & lt)] = a0 + 2; base += __popcll(m);
            m = __ballot(v.w == e); if (v.w == e) dst[base + __popcll(m & lt)] = a0 + 3; base += __popcll(m);
        }
    }
}

struct ExpMap { int* cnt; int* off; int* tile; };
__device__ __forceinline__ ExpMap exp_map(const Params& p, char* smem) {
    ExpMap m;
    m.cnt = (int*)(smem + 98304); m.off = m.cnt + 256; m.tile = m.off + 256;
    const int tid = otid();
    __syncthreads();
    if (tid < NE) m.cnt[tid] = p.cnt()[tid];
    __syncthreads();
    if (tid == 0) {
        int off = 0, tl = 0;
        for (int e = 0; e < NE; ++e) { m.off[e] = off; m.tile[e] = tl; const int c = m.cnt[e]; off += c; tl += (c + 255) >> 8; }
        m.tile[NE] = tl;
    }
    __syncthreads();
    return m;
}
__device__ __forceinline__ int find_expert(const int* tile, int rt) {
    int lo = 0, hi = NE;
    while (hi - lo > 1) { const int mid = (lo + hi) >> 1; if (tile[mid] <= rt) lo = mid; else hi = mid; }
    return lo;
}
#define ROWA(smem) ((int*)((smem) + 98304 + 3328))
#define ROWW(smem) ((float*)((smem) + 98304 + 3328 + 1024))

__device__ void ph_gateup(const Params& p, char* smem) {
    const int tid = otid(), lane = tid & 63, wid = tid >> 6, wr = wid >> 1, wc = wid & 1;
    const ExpMap em = exp_map(p, smem);
    int* rowA = ROWA(smem);
    const int ntile = em.tile[NE];
    const int U = (ntile + T / 256) * 2;
    const int xcd = blockIdx.x & 7, nbx = gridDim.x >> 3;
    const int lo = (int)(((long long)U * xcd) >> 3), hi = (int)(((long long)U * (xcd + 1)) >> 3);
    for (int u = lo + (blockIdx.x >> 3); u < hi; u += nbx) {
        const int rt = u >> 1, c0 = (u & 1) * 128;
        const float *Wg, *Wu;
        bf16_t* gdst;
        int nrow, tokv = -1;
        if (rt < ntile) {
            const int e = find_expert(em.tile, rt);
            const int r0 = (rt - em.tile[e]) * 256, ne = em.cnt[e];
            Wg = p.w_eg + (size_t)e * D * ED; Wu = p.w_eu + (size_t)e * D * ED;
            gdst = p.gbuf() + ((size_t)em.off[e] + r0) * ED + c0;
            nrow = ne - r0;
            if (tid < 256 && r0 + tid < ne) tokv = p.list()[(size_t)e * T + r0 + tid] >> 3;
        } else {
            const int tb = (rt - ntile) * 256;
            Wg = p.w_sg; Wu = p.w_su;
            gdst = p.gsh() + (size_t)tb * ED + c0;
            nrow = 256;
            tokv = tb + (tid & 255);
        }
        __syncthreads();
        if (tid < 256) rowA[tid] = tokv;
        __syncthreads();
        const int t0 = rowA[0];
        f32x4 acc[4][8];
        gemm5(smem, D,
              [&](int r) { const int t = rowA[r]; return p.h2() + (size_t)(t < 0 ? t0 : t) * 2048; },
              [&](int n) { const int t16 = n >> 4; return ((t16 & 1) ? Wu : Wg) + c0 + 16 * (t16 >> 1) + (n & 15); },
              ED, acc);
        if (wr * 64 < nrow) {
            char* wl = smem + wid * EPI_WAVE;
#pragma unroll
            for (int m = 0; m < 4; ++m) {
                const int rb = wr * 64 + m * 16;
                epi_bf16(wl, lane,
                         [&](int n, int j) { if (n >= 4) return 0.f; const float g = acc[m][2 * n][j], uu = acc[m][2 * n + 1][j]; return g / (1.f + __expf(-g)) * uu; },
                         [&](int row, int ch, u32x4 v) { if (ch < 8 && rb + row < nrow) *(u32x4*)(gdst + (size_t)(rb + row) * ED + wc * 64 + ch * 8) = v; });
            }
        }
    }
}

__device__ void ph_down(const Params& p, char* smem) {
    const int tid = otid(), lane = tid & 63, wid = tid >> 6, wr = wid >> 1, wc = wid & 1;
    const ExpMap em = exp_map(p, smem);
    int* rowA = ROWA(smem);
    float* rowW = ROWW(smem);
    const int ntile = em.tile[NE];
    const int U = (ntile + T / 256) * 4;
    const int xcd = blockIdx.x & 7, nbx = gridDim.x >> 3;
    const int lo = (int)(((long long)U * xcd) >> 3), hi = (int)(((long long)U * (xcd + 1)) >> 3);
    for (int u = lo + (blockIdx.x >> 3); u < hi; u += nbx) {
        const int rt = u >> 2, nt = u & 3;
        const bf16_t* A;
        const float* W;
        int nrow, slot = -1;
        float wv = 0.f;
        if (rt < ntile) {
            const int e = find_expert(em.tile, rt);
            const int r0 = (rt - em.tile[e]) * 256, ne = em.cnt[e];
            A = p.gbuf() + ((size_t)em.off[e] + r0) * ED;
            W = p.w_ed + (size_t)e * ED * D + nt * 256;
            nrow = ne - r0;
            if (tid < 256 && r0 + tid < ne) {
                const int a = p.list()[(size_t)e * T + r0 + tid];
                slot = a;
                wv = p.topw()[a] * Y8_SCALE;
            }
        } else {
            const int tb = (rt - ntile) * 256;
            A = p.gsh() + (size_t)tb * ED;
            W = p.w_sd + nt * 256;
            nrow = 256;
            slot = tb + (tid & 255);
            wv = 1.f;
        }
        __syncthreads();
        if (tid < 256) { rowA[tid] = slot; rowW[tid] = wv; }
        __syncthreads();
        f32x4 acc[4][8];
        gemm5(smem, ED, [&](int r) { return A + (size_t)(r < nrow ? r : 0) * ED; }, [&](int n) { return W + n; }, D, acc);
        if (wr * 64 < nrow) {
            char* wl = smem + wid * EPI_WAVE;
#pragma unroll
            for (int m = 0; m < 4; ++m) {
                const int rb = wr * 64 + m * 16;
                float wj[4];
#pragma unroll
                for (int j = 0; j < 4; ++j) wj[j] = rowW[rb + (lane >> 4) * 4 + j];
                if (rt < ntile) {
                    epi_fp8(wl, lane, [&](int n, int j) { return acc[m][n][j] * wj[j]; },
                            [&](int row, int ch, u32x4 v) {
                                const int sl = rowA[rb + row];
                                if (sl >= 0) *(u32x4*)(p.ybuf() + (size_t)sl * D + nt * 256 + wc * 128 + ch * 16) = v;
                            });
                } else {
                    epi_bf16(wl, lane, [&](int n, int j) { return acc[m][n][j]; },
                             [&](int row, int ch, u32x4 v) {
                                 const int sl = rowA[rb + row];
                                 *(u32x4*)(p.ysh() + (size_t)sl * D + nt * 256 + wc * 128 + ch * 8) = v;
                             });
                }
            }
        }
    }
}

__device__ void ph_final(const Params& p) {
    const int tid = otid(), lane = tid & 63, wid = tid >> 6;
    for (int row = blockIdx.x * 8 + wid; row < T; row += gridDim.x * 8) {
        const int b = row >> 12;
        const float* g2 = p.mod() + b * 6144 + 5120;
        float4 v[4];
        float s = 0.f;
#pragma unroll
        for (int i = 0; i < 4; ++i) {
            const int col = (lane + 64 * i) * 4;
            float f0 = 0.f, f1 = 0.f, f2 = 0.f, f3 = 0.f;
#pragma unroll
            for (int k = 0; k < 8; ++k) {
                const int w8 = *(const int*)(p.ybuf() + ((size_t)row * 8 + k) * D + col);
                const v2f_t lo = __builtin_amdgcn_cvt_pk_f32_fp8(w8, false), hi = __builtin_amdgcn_cvt_pk_f32_fp8(w8, true);
                f0 += lo[0]; f1 += lo[1]; f2 += hi[0]; f3 += hi[1];
            }
            f0 *= (1.f / Y8_SCALE); f1 *= (1.f / Y8_SCALE); f2 *= (1.f / Y8_SCALE); f3 *= (1.f / Y8_SCALE);
            {
                const uint2 w = *(const uint2*)(p.ysh() + (size_t)row * D + col);
                f0 += __uint_as_float(w.x << 16); f1 += __uint_as_float(w.x & 0xffff0000u);
                f2 += __uint_as_float(w.y << 16); f3 += __uint_as_float(w.y & 0xffff0000u);
            }
            float4 xv;
            { const uint2 xw = *(const uint2*)(p.x1() + (size_t)row * D + col);
              xv.x = __uint_as_float(xw.x << 16); xv.y = __uint_as_float(xw.x & 0xffff0000u); xv.z = __uint_as_float(xw.y << 16); xv.w = __uint_as_float(xw.y & 0xffff0000u); }
            const float4 g4 = *(const float4*)(g2 + col);
            v[i].x = ALPHA * xv.x + g4.x * f0; v[i].y = ALPHA * xv.y + g4.y * f1;
            v[i].z = ALPHA * xv.z + g4.z * f2; v[i].w = ALPHA * xv.w + g4.w * f3;
            s += v[i].x + v[i].y + v[i].z + v[i].w;
        }
        const float mean = wave_sum(s) * (1.f / D);
        float q = 0.f;
#pragma unroll
        for (int i = 0; i < 4; ++i) {
            v[i].x -= mean; v[i].y -= mean; v[i].z -= mean; v[i].w -= mean;
            q += v[i].x * v[i].x + v[i].y * v[i].y + v[i].z * v[i].z + v[i].w * v[i].w;
        }
        const float rstd = rsqrtf(wave_sum(q) * (1.f / D) + LN_EPS);
#pragma unroll
        for (int i = 0; i < 4; ++i) {
            const int col = (lane + 64 * i) * 4;
            const float4 g4 = *(const float4*)(p.ln2_g + col), b4 = *(const float4*)(p.ln2_b + col);
            float4 y;
            y.x = v[i].x * rstd * g4.x + b4.x; y.y = v[i].y * rstd * g4.y + b4.y;
            y.z = v[i].z * rstd * g4.z + b4.z; y.w = v[i].w * rstd * g4.w + b4.w;
            *(float4*)(p.out + (size_t)row * D + col) = y;
        }
    }
}

constexpr int LDS_BYTES = 2 * VB_LDS + 16;
constexpr int NPHASE = 14;

template <int PH>
__device__ __forceinline__ void run_phase(const Params& p, char* smem) {
    if (PH == 0) ph_mod(p, smem);
    if (PH == 1) ph_ln0(p);
    if (PH == 2) ph_inproj(p, smem);
    if (PH == 3) { ph_h1(p, smem); ph_attn(p, smem); }
    if (PH == 4) { ph_h2(p); ph_attn_merge(p); }
    if (PH == 5) ph_h3(p, smem);
    if (PH == 6) ph_outproj(p, smem);
    if (PH == 7) ph_ln1(p);
    if (PH == 8) ph_router_gemm(p, smem);
    if (PH == 9) ph_topk(p);
    if (PH == 10) ph_lists(p, smem);
    if (PH == 11) ph_gateup(p, smem);
    if (PH == 12) ph_down(p, smem);
    if (PH == 13) ph_final(p);
}

template <int PH>
__global__ void __launch_bounds__(NTHREADS, 2) k_phase(Params p) {
    extern __shared__ __attribute__((aligned(16))) char smem[];
    run_phase<PH>(p, smem);
}

__global__ void __launch_bounds__(NTHREADS, 2) k_all(Params p) {
    extern __shared__ __attribute__((aligned(16))) char smem[];
    volatile LAS unsigned* st = (volatile LAS unsigned*)(smem + LDS_BYTES - 16);
    if (threadIdx.x == 0) { st[0] = 0u; st[1] = 0u; st[2] = 0u; st[3] = 0u; }
    __syncthreads();
    XcdBarrier bar = xcd_barrier_post(p.bar(), st);
    run_phase<0>(p, smem); xcd_barrier(bar);
    run_phase<1>(p, smem); xcd_barrier(bar);
    run_phase<2>(p, smem); xcd_barrier(bar);
    run_phase<3>(p, smem); xcd_barrier(bar);
    run_phase<4>(p, smem); xcd_barrier(bar);
    run_phase<5>(p, smem); xcd_barrier(bar);
    run_phase<6>(p, smem); xcd_barrier(bar);
    run_phase<7>(p, smem); xcd_barrier(bar);
    run_phase<8>(p, smem); xcd_barrier(bar);
    run_phase<9>(p, smem); xcd_barrier(bar);
    run_phase<10>(p, smem); xcd_barrier(bar);
    run_phase<11>(p, smem); xcd_barrier(bar);
    run_phase<12>(p, smem); xcd_barrier(bar);
    run_phase<13>(p, smem);
}

template <int PH>
static void launch_phase(const Params& p, int grid, hipStream_t stream) {
    static bool attr = false;
    if (!attr) { (void)hipFuncSetAttribute((const void*)k_phase<PH>, hipFuncAttributeMaxDynamicSharedMemorySize, LDS_BYTES); attr = true; }
    hipLaunchKernelGGL(k_phase<PH>, dim3(grid), dim3(NTHREADS), LDS_BYTES, stream, p);
}

extern "C" void kernel_launch(void* const* d_in, const int* in_sizes, int n_in, void* d_out, int out_size, void* d_ws, size_t ws_size,
                              hipStream_t stream) {
    (void)in_sizes; (void)n_in; (void)out_size;
    Params p{};
    const float** pin = (const float**)&p.x;
    for (int i = 0; i < 21; ++i) pin[i] = (const float*)d_in[i];
    p.out = (float*)d_out;
    p.ws = (char*)d_ws;
    char* ctl = p.ws + WO_ctl;
    if (WS_END > ws_size) { fprintf(stderr, "kernel_launch: workspace too small: need %zu have %zu\n", (size_t)WS_END, ws_size); return; }

    static int grid = 0;
    if (grid == 0) {
        int dev = 0, cus = 0, per_cu = 0;
        (void)hipGetDevice(&dev);
        (void)hipDeviceGetAttribute(&cus, hipDeviceAttributeMultiprocessorCount, dev);
        (void)hipFuncSetAttribute((const void*)k_all, hipFuncAttributeMaxDynamicSharedMemorySize, LDS_BYTES);
        (void)hipOccupancyMaxActiveBlocksPerMultiprocessor(&per_cu, (const void*)k_all, NTHREADS, LDS_BYTES);
        grid = cus;
        if (grid != 256) grid = 256;
        fprintf(stderr, "kernel_launch: cus %d per_cu %d grid %d ws need %zu have %zu\n", cus, per_cu, grid, (size_t)WS_END, ws_size);
    }
    (void)hipMemsetAsync(ctl, 0, 65536, stream);
#if ONE_LAUNCH
    hipLaunchKernelGGL(k_all, dim3(grid), dim3(NTHREADS), LDS_BYTES, stream, p);
#else
    launch_phase<0>(p, grid, stream); launch_phase<1>(p, grid, stream); launch_phase<2>(p, grid, stream); launch_phase<3>(p, grid, stream);
    launch_phase<4>(p, grid, stream); launch_phase<5>(p, grid, stream); launch_phase<6>(p, grid, stream); launch_phase<7>(p, grid, stream);
    launch_phase<8>(p, grid, stream); launch_phase<9>(p, grid, stream); launch_phase<10>(p, grid, stream); launch_phase<11>(p, grid, stream);
    launch_phase<12>(p, grid, stream); launch_phase<13>(p, grid, stream);
#endif
}
```

```cpp
#include <hip/hip_runtime.h>
#include <stdint.h>
#include <stdio.h>

#ifndef ONE_LAUNCH
#define ONE_LAUNCH 1
#endif

constexpr int D = 1024, NBATCH = 4, S = 4096, T = NBATCH * S;
constexpr int INW = 4352;
constexpr int NE = 256, TOPK = 8, ED = 256;
constexpr int OFF_HQ = 0, OFF_HF = 512, OFF_HI = 1024, OFF_HG = 1536, OFF_AQ = 2048, OFF_AK = 2816, OFF_AV = 3584;
constexpr float ALPHA = 1.189207115002721f;
constexpr float LN_EPS = 1e-5f, RMS_EPS = 1e-6f;
constexpr int NTHREADS = 512;
constexpr int VB_LDS = 67584;

typedef unsigned short bf16_t;
using bf16x8 = __attribute__((ext_vector_type(8))) short;
using f32x4 = __attribute__((ext_vector_type(4))) float;
using u32x4 = __attribute__((ext_vector_type(4))) unsigned int;

typedef float v2f_t __attribute__((ext_vector_type(2)));
typedef __bf16 v2bf_t __attribute__((ext_vector_type(2)));
typedef short v4s __attribute__((ext_vector_type(4)));
__device__ __forceinline__ unsigned short f2bf(float f) { return __builtin_bit_cast(unsigned short, (__bf16)f); }
__device__ __forceinline__ float bf2f(unsigned short h) { return __uint_as_float(((uint32_t)h) << 16); }
__device__ __forceinline__ uint32_t pack2(float a, float b) {
    const v2f_t f = {a, b};
    return __builtin_bit_cast(uint32_t, __builtin_convertvector(f, v2bf_t));
}
__device__ __forceinline__ float sigmoidf_(float v) { return 1.f / (1.f + __expf(-v)); }

__device__ __forceinline__ int otid() { int t = threadIdx.x; asm volatile("" : "+v"(t)); return t; }

constexpr size_t al256(size_t x) { return (x + 255) & ~(size_t)255; }
constexpr size_t WO_ctl = 0;
constexpr size_t WO_mod = WO_ctl + al256(65536);
constexpr size_t WO_lbv = WO_mod + al256(4 * 6144 * 4);
constexpr size_t WO_biasT = WO_lbv + al256(512 * 4);
constexpr size_t WO_winT = WO_biasT + al256(3 * 129 * 4 * 4);
constexpr size_t WO_woutT = WO_winT + al256((size_t)INW * D * 2);
constexpr size_t WO_wrT = WO_woutT + al256((size_t)D * 768 * 2);
constexpr size_t WO_wsgT = WO_wrT + al256((size_t)2 * NE * D * 2);
constexpr size_t WO_wsuT = WO_wsgT + al256((size_t)ED * D * 2);
constexpr size_t WO_wsdT = WO_wsuT + al256((size_t)ED * D * 2);
constexpr size_t WO_h1 = WO_wsdT + al256((size_t)D * ED * 2);
constexpr size_t WO_proj = WO_h1 + al256((size_t)T * D * 2);
constexpr size_t WO_lgf = WO_proj + al256((size_t)T * INW * 2);
constexpr size_t WO_ao = WO_lgf + al256((size_t)T * 512 * 4);
constexpr size_t WO_alse = WO_ao + al256((size_t)3 * T * 256 * 4);
constexpr size_t WO_mixin = WO_alse + al256((size_t)3 * T * 4 * 4);
constexpr size_t WO_pre1 = WO_mixin + al256((size_t)T * 768 * 2);
constexpr size_t WO_x1 = WO_pre1 + al256((size_t)T * D * 4);
constexpr size_t WO_h2 = WO_x1 + al256((size_t)T * D * 2);
constexpr size_t WO_lgp = WO_h2 + al256((size_t)T * 2048 * 2);
constexpr size_t WO_topi = WO_lgp + al256((size_t)3 * T * NE * 4);
constexpr size_t WO_topw = WO_topi + al256((size_t)T * 8 * 4);
constexpr size_t WO_list = WO_topw + al256((size_t)T * 8 * 4);
constexpr size_t WO_gbuf = WO_list + al256((size_t)NE * T * 4);
constexpr size_t WO_gsh = WO_gbuf + al256((size_t)T * TOPK * ED * 2);
constexpr size_t WO_ybuf = WO_gsh + al256((size_t)T * ED * 2);
constexpr size_t WO_ysh = WO_ybuf + al256((size_t)T * 8 * D);
constexpr size_t WO_dec = WO_ysh + al256((size_t)T * D * 2);
constexpr size_t WS_END = WO_dec + al256((size_t)1024 * 128 * 4);
struct Params {
    const float *x, *c, *w_ada, *b_ada, *w_in, *hg_lb, *hg_nw, *rel_bias, *w_out, *ln1_g, *ln1_b, *w_router, *router_bias,
        *w_eg, *w_eu, *w_ed, *w_sg, *w_su, *w_sd, *ln2_g, *ln2_b;
    float* out;
    char* ws;
    __device__ __forceinline__ unsigned* bar() const { return (unsigned*)(ws + WO_ctl); }
    __device__ __forceinline__ int* cnt() const { return (int*)(ws + WO_ctl + 16384); }
    __device__ __forceinline__ bf16_t* kv() const { return (bf16_t*)(ws + WO_ybuf); }
    __device__ __forceinline__ bf16_t* sst() const { return (bf16_t*)(ws + WO_ybuf + (size_t)1024 * 16384 * 4); }
    __device__ __forceinline__ float* mod() const { return (float*)(ws + WO_mod); }
    __device__ __forceinline__ float* lbv() const { return (float*)(ws + WO_lbv); }
    __device__ __forceinline__ float* biasT() const { return (float*)(ws + WO_biasT); }
    __device__ __forceinline__ bf16_t* winT() const { return (bf16_t*)(ws + WO_winT); }
    __device__ __forceinline__ bf16_t* woutT() const { return (bf16_t*)(ws + WO_woutT); }
    __device__ __forceinline__ bf16_t* wrT() const { return (bf16_t*)(ws + WO_wrT); }
    __device__ __forceinline__ bf16_t* wsgT() const { return (bf16_t*)(ws + WO_wsgT); }
    __device__ __forceinline__ bf16_t* wsuT() const { return (bf16_t*)(ws + WO_wsuT); }
    __device__ __forceinline__ bf16_t* wsdT() const { return (bf16_t*)(ws + WO_wsdT); }
    __device__ __forceinline__ bf16_t* h1() const { return (bf16_t*)(ws + WO_h1); }
    __device__ __forceinline__ bf16_t* proj() const { return (bf16_t*)(ws + WO_proj); }
    __device__ __forceinline__ float* lgf() const { return (float*)(ws + WO_lgf); }
    __device__ __forceinline__ float* ao() const { return (float*)(ws + WO_ao); }
    __device__ __forceinline__ float* alse() const { return (float*)(ws + WO_alse); }
    __device__ __forceinline__ bf16_t* mixin() const { return (bf16_t*)(ws + WO_mixin); }
    __device__ __forceinline__ float* pre1() const { return (float*)(ws + WO_pre1); }
    __device__ __forceinline__ bf16_t* x1() const { return (bf16_t*)(ws + WO_x1); }
    __device__ __forceinline__ bf16_t* h2() const { return (bf16_t*)(ws + WO_h2); }
    __device__ __forceinline__ float* lgp() const { return (float*)(ws + WO_lgp); }
    __device__ __forceinline__ int* topi() const { return (int*)(ws + WO_topi); }
    __device__ __forceinline__ float* topw() const { return (float*)(ws + WO_topw); }
    __device__ __forceinline__ int* list() const { return (int*)(ws + WO_list); }
    __device__ __forceinline__ bf16_t* gbuf() const { return (bf16_t*)(ws + WO_gbuf); }
    __device__ __forceinline__ bf16_t* gsh() const { return (bf16_t*)(ws + WO_gsh); }
    __device__ __forceinline__ unsigned char* ybuf() const { return (unsigned char*)(ws + WO_ybuf); }
    __device__ __forceinline__ bf16_t* ysh() const { return (bf16_t*)(ws + WO_ysh); }
    __device__ __forceinline__ float* dec() const { return (float*)(ws + WO_dec); }
};

#define XB_TMO      128
#define XB_XCNT(j)  (256  + 64 * (j))
#define XB_XSUB(j)  (1280 + 64 * (j))
#define XB_XGEN(j)  (2304 + 64 * (j))
#define XB_TOP      3328
#define XB_TOPGEN   3392
#define XCD_BAR_WORDS 3456
#define XB_SPIN_CAP (1u << 18)
#define LAS __attribute__((address_space(3)))

__device__ __forceinline__ unsigned xb_ld(unsigned* p)              { return __hip_atomic_load(p, __ATOMIC_RELAXED, __HIP_MEMORY_SCOPE_AGENT); }
__device__ __forceinline__ unsigned xb_add(unsigned* p, unsigned v) { return __hip_atomic_fetch_add(p, v, __ATOMIC_RELAXED, __HIP_MEMORY_SCOPE_AGENT); }
__device__ __forceinline__ unsigned xb_xcc_id() { return (unsigned)__builtin_amdgcn_s_getreg((3 << 11) | 20) & 0xFu; }
#define XB_SPIN(cond, bar) do { unsigned _sp = 0; while (cond) { __builtin_amdgcn_s_sleep(1); \
    if ((++_sp & 255u) == 0u) { if (xb_ld(&(bar)[XB_TMO])) break; if (_sp > XB_SPIN_CAP) { atomicAdd(&(bar)[XB_TMO], 1u); break; } } } } while (0)

struct XcdBarrier {
    unsigned* bar; unsigned x;
    volatile LAS unsigned* st;
};
__device__ __forceinline__ XcdBarrier xcd_barrier_post(unsigned* bar, volatile LAS unsigned* st) {
    XcdBarrier b; b.bar = bar; b.x = xb_xcc_id(); b.st = st;
    if (threadIdx.x == 0) (void)xb_add(&bar[XB_XCNT(b.x)], 1u);
    return b;
}
__device__ __forceinline__ void xcd_barrier_complete(unsigned* bar, unsigned x, unsigned& nloc, unsigned& nx) {
    const unsigned G = gridDim.x * gridDim.y * gridDim.z;
    unsigned sum, cnt, mine, sp = 0u;
    for (;;) {
        sum = 0u; cnt = 0u; mine = 0u;
#pragma unroll
        for (unsigned j = 0; j < 16; ++j) { const unsigned c = xb_ld(&bar[XB_XCNT(j)]); sum += c; cnt += (c > 0u) ? 1u : 0u; mine = (j == x) ? c : mine; }
        if (sum == G) break;
        __builtin_amdgcn_s_sleep(1);
        if ((++sp & 255u) == 0u) { if (xb_ld(&bar[XB_TMO])) break; if (sp > XB_SPIN_CAP) { atomicAdd(&bar[XB_TMO], 1u); break; } }
    }
    nloc = mine > 0u ? mine : 1u; nx = cnt > 0u ? cnt : 1u;
}
__device__ __forceinline__ void xcd_barrier(const XcdBarrier& b) {
    asm volatile("s_waitcnt vmcnt(0)" ::: "memory");
    __syncthreads();
    if (threadIdx.x == 0) {
        unsigned* bar = b.bar;
        __builtin_amdgcn_s_waitcnt(0);
        unsigned nloc = b.st[0], nx = b.st[1];
        if (nloc == 0u) { xcd_barrier_complete(bar, b.x, nloc, nx); b.st[0] = nloc; b.st[1] = nx; }
        const unsigned old = xb_add(&bar[XB_XSUB(b.x)], 1u);
        const unsigned gen = old / nloc;
        if (old + 1u == (gen + 1u) * nloc) {
            __builtin_amdgcn_fence(__ATOMIC_RELEASE, "agent");
            asm volatile("s_waitcnt vmcnt(0)" ::: "memory");
            const unsigned og = xb_add(&bar[XB_TOP], 1u);
            const unsigned tg = og / nx;
            if (og + 1u == (tg + 1u) * nx) xb_add(&bar[XB_TOPGEN], 1u);
            else XB_SPIN(xb_ld(&bar[XB_TOPGEN]) == tg, bar);
            __builtin_amdgcn_fence(__ATOMIC_ACQUIRE, "agent");
            xb_add(&bar[XB_XGEN(b.x)], 1u);
            asm volatile("s_waitcnt vmcnt(0)" ::: "memory");
        } else {
            XB_SPIN(xb_ld(&bar[XB_XGEN(b.x)]) == gen, bar);
            __builtin_amdgcn_fence(__ATOMIC_ACQUIRE, "agent");
            asm volatile("s_waitcnt vmcnt(0)" ::: "memory");
        }
    }
    __syncthreads();
}

struct VB { int vb, nvb, tid; char* smem; };
__device__ __forceinline__ VB make_vb(char* smem) {
    const int t = otid();
    VB v; v.vb = (int)blockIdx.x * 2 + (t >> 8); v.nvb = (int)gridDim.x * 2; v.tid = t & 255; v.smem = smem + (t >> 8) * VB_LDS;
    return v;
}
__device__ __forceinline__ int swz(int row, int chunk) { return row * 128 + ((chunk ^ ((row >> 1) & 7)) << 4); }

__device__ __forceinline__ float wave_sum(float v) {
#pragma unroll
    for (int o = 32; o > 0; o >>= 1) v += __shfl_xor(v, o, 64);
    return v;
}

__device__ __forceinline__ int t5_bucket(int n) {
    if (n < 16) return n;
    const float v = logf((float)n / 16.f) / logf(128.f) * 16.f;
    int large = 16 + (int)v;
    return large < 31 ? large : 31;
}

__device__ __forceinline__ void tr_tile(const VB& v, const float* src, int ld, bf16_t* dst, bf16_t* dst2, int ldd, int k0, int n0) {
    float* t = (float*)v.smem;
    __syncthreads();
#pragma unroll
    for (int i = 0; i < 4; ++i) {
        const int r = (v.tid >> 4) + 16 * i, c4 = v.tid & 15;
        const f32x4 x = *(const f32x4*)(src + (size_t)(k0 + r) * ld + n0 + c4 * 4);
        t[r * 65 + c4 * 4 + 0] = x[0]; t[r * 65 + c4 * 4 + 1] = x[1]; t[r * 65 + c4 * 4 + 2] = x[2]; t[r * 65 + c4 * 4 + 3] = x[3];
    }
    __syncthreads();
    const int n = v.tid >> 2, kq = v.tid & 3;
    float f[16];
#pragma unroll
    for (int i = 0; i < 16; ++i) f[i] = t[(kq * 16 + i) * 65 + n];
    u32x4 a, b;
    a[0] = pack2(f[0], f[1]); a[1] = pack2(f[2], f[3]); a[2] = pack2(f[4], f[5]); a[3] = pack2(f[6], f[7]);
    b[0] = pack2(f[8], f[9]); b[1] = pack2(f[10], f[11]); b[2] = pack2(f[12], f[13]); b[3] = pack2(f[14], f[15]);
    bf16_t* d = dst + (size_t)(n0 + n) * ldd + k0 + kq * 16;
    *(u32x4*)d = a; *(u32x4*)(d + 8) = b;
    if (dst2) {
        u32x4 c, e;
#pragma unroll
        for (int i = 0; i < 4; ++i) {
            c[i] = pack2(f[2 * i] - __uint_as_float(a[i] << 16), f[2 * i + 1] - __uint_as_float(a[i] & 0xffff0000u));
            e[i] = pack2(f[8 + 2 * i] - __uint_as_float(b[i] << 16), f[8 + 2 * i + 1] - __uint_as_float(b[i] & 0xffff0000u));
        }
        bf16_t* d2 = dst2 + (size_t)(n0 + n) * ldd + k0 + kq * 16;
        *(u32x4*)d2 = c; *(u32x4*)(d2 + 8) = e;
    }
}

__device__ __forceinline__ void ph_mod(const Params& p, char* smem0) {
    const VB v = make_vb(smem0);
    const int tid = v.tid;
    float* cond = (float*)(v.smem + 20480);
    float* red = cond + 4096;
    for (int i = tid; i < 4096; i += 256) { const float x = p.c[i]; cond[i] = x / (1.f + __expf(-x)); }
    __syncthreads();
    const int NU = 194 + 1088 + 192 + 64 + 64 + 64 + 64;
    const int rounds = (NU + v.nvb - 1) / v.nvb;
    for (int it = 0; it < rounds; ++it) {
        int u = v.vb + it * v.nvb;
        if (u >= NU) u = NU - 1;
        if (u < 192) {
            const int c4 = tid & 7, kq = tid >> 3;
            f32x4 a0 = {0.f, 0.f, 0.f, 0.f}, a1 = a0, a2 = a0, a3 = a0;
            const float* wp = p.w_ada + u * 32 + c4 * 4;
#pragma unroll 8
            for (int k = kq; k < 1024; k += 32) {
                const f32x4 w = *(const f32x4*)(wp + (size_t)k * 6144);
                a0 += cond[k] * w; a1 += cond[1024 + k] * w; a2 += cond[2048 + k] * w; a3 += cond[3072 + k] * w;
            }
            *(f32x4*)(red + (kq * 4 + 0) * 32 + c4 * 4) = a0; *(f32x4*)(red + (kq * 4 + 1) * 32 + c4 * 4) = a1;
            *(f32x4*)(red + (kq * 4 + 2) * 32 + c4 * 4) = a2; *(f32x4*)(red + (kq * 4 + 3) * 32 + c4 * 4) = a3;
        }
        __syncthreads();
        if (u < 192) {
            if (tid < 128) {
                const int b = tid >> 5, c2 = tid & 31;
                float s = 0.f;
                for (int q = 0; q < 32; ++q) s += red[(q * 4 + b) * 32 + c2];
                p.mod()[b * 6144 + u * 32 + c2] = s + p.b_ada[u * 32 + c2];
            }
        } else if (u == 192) {
            for (int j = tid; j < 512; j += 256) {
                const float a = p.hg_lb[j], b = p.hg_lb[512 + j];
                const float m = fmaxf(a, b);
                const float ea = expf(a - m), eb = expf(b - m);
                p.lbv()[j] = ea / (ea + eb);
            }
        } else if (u == 193) {
            for (int i = tid; i < 3 * 129 * 4; i += 256) {
                const int g = i / (129 * 4), m = (i >> 2) % 129, hh = i & 3;
                const int dil = (g == 0) ? 1 : (g == 1 ? 4 : 16);
                p.biasT()[i] = p.rel_bias[t5_bucket(m * dil) * 12 + g * 4 + hh];
            }
        }
        {
            int w = u - 194;
            const float* src = p.w_out; int ld = D; bf16_t* dst = p.woutT(); bf16_t* dst2 = nullptr; int ldd = 768, k0 = 0, n0 = 0;
            if (w >= 0) {
                if (w < 1088) { src = p.w_in; ld = INW; dst = p.winT(); ldd = D; k0 = (w / 68) * 64; n0 = (w % 68) * 64; }
                else if ((w -= 1088) < 192) { k0 = (w >> 4) * 64; n0 = (w & 15) * 64; }
                else if ((w -= 192) < 64) { src = p.w_router; ld = NE; dst = p.wrT(); dst2 = p.wrT() + (size_t)NE * D; ldd = D; k0 = (w >> 2) * 64; n0 = (w & 3) * 64; }
                else if ((w -= 64) < 64) { src = p.w_sg; ld = ED; dst = p.wsgT(); ldd = D; k0 = (w >> 2) * 64; n0 = (w & 3) * 64; }
                else if ((w -= 64) < 64) { src = p.w_su; ld = ED; dst = p.wsuT(); ldd = D; k0 = (w >> 2) * 64; n0 = (w & 3) * 64; }
                else { w -= 64; src = p.w_sd; ld = D; dst = p.wsdT(); ldd = ED; k0 = (w >> 4) * 64; n0 = (w & 15) * 64; }
            }
            tr_tile(v, src, ld, dst, dst2, ldd, k0, n0);
        }
    }
}

__device__ __forceinline__ void ph_ln0(const Params& p) {
    const int tid = otid(), lane = tid & 63, wid = tid >> 6;
    const int rstride = gridDim.x * 8;
    float4 nv[4];
    {
        const float4* xr = (const float4*)(p.x + (size_t)(blockIdx.x * 8 + wid) * D);
#pragma unroll
        for (int i = 0; i < 4; ++i) nv[i] = xr[lane + 64 * i];
    }
    for (int row = blockIdx.x * 8 + wid; row < T; row += rstride) {
        float4 v[4];
        float s = 0.f;
#pragma unroll
        for (int i = 0; i < 4; ++i) { v[i] = nv[i]; s += v[i].x + v[i].y + v[i].z + v[i].w; }
        if (row + rstride < T) {
            const float4* xn = (const float4*)(p.x + (size_t)(row + rstride) * D);
#pragma unroll
            for (int i = 0; i < 4; ++i) nv[i] = xn[lane + 64 * i];
        }
        const float mean = wave_sum(s) * (1.f / D);
        float q = 0.f;
#pragma unroll
        for (int i = 0; i < 4; ++i) {
            v[i].x -= mean; v[i].y -= mean; v[i].z -= mean; v[i].w -= mean;
            q += v[i].x * v[i].x + v[i].y * v[i].y + v[i].z * v[i].z + v[i].w * v[i].w;
        }
        const float rstd = rsqrtf(wave_sum(q) * (1.f / D) + LN_EPS);
        const int b = row >> 12;
        const float* sh = p.mod() + b * 6144;
        const float* sc = sh + 1024;
#pragma unroll
        for (int i = 0; i < 4; ++i) {
            const int col = (lane + 64 * i) * 4;
            const float4 s4 = *(const float4*)(sc + col), h4 = *(const float4*)(sh + col);
            uint2 o;
            o.x = pack2(v[i].x * rstd * (1.f + s4.x) + h4.x, v[i].y * rstd * (1.f + s4.y) + h4.y);
            o.y = pack2(v[i].z * rstd * (1.f + s4.z) + h4.z, v[i].w * rstd * (1.f + s4.w) + h4.w);
            *(uint2*)(p.h1() + (size_t)row * D + col) = o;
        }
    }
}

__device__ __forceinline__ int swz16(int row, int chunk) { return row * 256 + ((chunk ^ (row & 15)) << 4); }
struct TrBase { int lo, hi; };
__device__ __forceinline__ TrBase tr16_base(int lane) {
    const int g = lane >> 4, q = (lane & 15) >> 2, pp = lane & 3;
    const int xl = 8 * (g & 1) + q, h = pp >> 1;
    TrBase t;
    t.lo = (8 * g + q) * 256 + ((xl >> 1) << 5) + ((h ^ (xl & 1)) << 4) + 8 * (pp & 1);
    t.hi = (t.lo + 1024) ^ 64;
    return t;
}
__device__ __forceinline__ bf16x8 tr_frag16(const char* tile, const TrBase& tb, int ks, int c) {
    int cx = c << 5;
    asm volatile("" : "+v"(cx));
    const v4s lo = __builtin_amdgcn_ds_read_tr16_b64_v4i16((LAS v4s*)(tile + ks * 8192 + (tb.lo ^ cx)));
    const v4s hi = __builtin_amdgcn_ds_read_tr16_b64_v4i16((LAS v4s*)(tile + ks * 8192 + (tb.hi ^ cx)));
    return bf16x8{lo[0], lo[1], lo[2], lo[3], hi[0], hi[1], hi[2], hi[3]};
}


__device__ __forceinline__ int aoff(int row, int chunk) { return row * 64 + ((chunk ^ ((row >> 2) & 3)) << 4); }
__device__ __forceinline__ int boff(int row, int chunk) { return row * 512 + ((chunk ^ (((row & 3) << 1) | (((row >> 3) & 1) << 3))) << 4); }
__device__ __forceinline__ bf16x8 tr_pair(const char* p) {
    const v4s lo = __builtin_amdgcn_ds_read_tr16_b64_v4i16((LAS v4s*)(p));
    const v4s hi = __builtin_amdgcn_ds_read_tr16_b64_v4i16((LAS v4s*)(p + 2048));
    return bf16x8{lo[0], lo[1], lo[2], lo[3], hi[0], hi[1], hi[2], hi[3]};
}
constexpr int G3_STAGE = 32768;

template <int BMODE, class AF, class BF>
__device__ __forceinline__ void gemm3(char* smem, const int K, AF arow, BF bsrc, const int ldb, f32x4 (&acc)[4][8], const int nvalid = 256) {
    const int tid = otid(), lane = tid & 63, wid = tid >> 6, wr = wid >> 1, wc = wid & 1, fr = lane & 15, fq = lane >> 4;
    const bf16_t* ap[2];
#pragma unroll
    for (int i = 0; i < 2; ++i) ap[i] = arow((tid >> 2) + 128 * i) + (tid & 3) * 8;
    const float* bpf = nullptr;
    const bf16_t* bpb[2] = {nullptr, nullptr};
    if (BMODE == 0) bpf = (const float*)bsrc((tid & 63) * 4) + (size_t)(tid >> 6) * ldb;
    else {
#pragma unroll
        for (int i = 0; i < 2; ++i) bpb[i] = (const bf16_t*)bsrc((tid >> 2) + 128 * i) + (tid & 3) * 8;
    }
#pragma unroll
    for (int m = 0; m < 4; ++m)
#pragma unroll
        for (int n = 0; n < 8; ++n) acc[m][n] = f32x4{0.f, 0.f, 0.f, 0.f};
    const int trbase = (8 * fq + (fr >> 2)) * 512 + wc * 256 + (((fr >> 2) | ((fq & 1) << 2)) << 5) + ((fr & 3) >> 1) * 16 + (fr & 1) * 8;
    u32x4 ra0[2], ra1[2];
    f32x4 rf0[4], rf1[4];
    u32x4 rb0[2], rb1[2];
    const bool active = wr * 64 < nvalid;
#define G3_GLOAD(RA, RF, RB, k0) do { \
        _Pragma("unroll") for (int i = 0; i < 2; ++i) RA[i] = *(const u32x4*)(ap[i] + (k0)); \
        if (BMODE == 0) { _Pragma("unroll") for (int j = 0; j < 4; ++j) RF[j] = *(const f32x4*)(bpf + (size_t)((k0) + 8 * j) * ldb); } \
        else { _Pragma("unroll") for (int i = 0; i < 2; ++i) RB[i] = *(const u32x4*)(bpb[i] + (k0)); } } while (0)
#define G3_LWRITE(RA, RF, RB, st) do { \
        char* sA_ = (st); char* sB_ = (st) + 16384; \
        _Pragma("unroll") for (int i = 0; i < 2; ++i) *(u32x4*)(sA_ + aoff((tid >> 2) + 128 * i, tid & 3)) = RA[i]; \
        if (BMODE == 0) { _Pragma("unroll") for (int j = 0; j < 4; ++j) { uint2 w_; w_.x = pack2(RF[j][0], RF[j][1]); w_.y = pack2(RF[j][2], RF[j][3]); \
                *(uint2*)(sB_ + boff((tid >> 6) + 8 * j, (tid & 63) >> 1) + (tid & 1) * 8) = w_; } } \
        else { _Pragma("unroll") for (int i = 0; i < 2; ++i) *(u32x4*)(sB_ + aoff((tid >> 2) + 128 * i, tid & 3)) = RB[i]; } } while (0)
#define G3_COMPUTE(st) do { if (active) { \
        const char* sA_ = (st); const char* sB_ = (st) + 16384; \
        bf16x8 af[4]; \
        _Pragma("unroll") for (int m = 0; m < 4; ++m) af[m] = *(const bf16x8*)(sA_ + aoff(wr * 64 + m * 16 + fr, fq)); \
        _Pragma("unroll") for (int n = 0; n < 8; ++n) { \
            bf16x8 bfr; \
            if (BMODE == 0) bfr = tr_pair(sB_ + (trbase ^ (n << 5))); else bfr = *(const bf16x8*)(sB_ + aoff(wc * 128 + n * 16 + fr, fq)); \
            _Pragma("unroll") for (int m = 0; m < 4; ++m) acc[m][n] = __builtin_amdgcn_mfma_f32_16x16x32_bf16(af[m], bfr, acc[m][n], 0, 0, 0); } } } while (0)
    const int nk = K >> 5;
    char* st0 = smem;
    char* st1 = smem + G3_STAGE;
    G3_GLOAD(ra0, rf0, rb0, 0);
    G3_GLOAD(ra1, rf1, rb1, 32);
    G3_LWRITE(ra0, rf0, rb0, st0);
    if (nk > 2) G3_GLOAD(ra0, rf0, rb0, 64);
    __syncthreads();
    for (int kt = 0; kt < nk; kt += 2) {
        G3_LWRITE(ra1, rf1, rb1, st1);
        if (kt + 3 < nk) G3_GLOAD(ra1, rf1, rb1, (kt + 3) * 32);
        G3_COMPUTE(st0);
        __syncthreads();
        if (kt + 2 < nk) G3_LWRITE(ra0, rf0, rb0, st0);
        if (kt + 4 < nk) G3_GLOAD(ra0, rf0, rb0, (kt + 4) * 32);
        G3_COMPUTE(st1);
        __syncthreads();
    }
#undef G3_GLOAD
#undef G3_LWRITE
#undef G3_COMPUTE
}

template <class AF, class BF>
__device__ __forceinline__ void gemm4(char* smem, const int K, AF arow, BF brow, f32x4 (&acc)[4][8]) {
    const int tid = otid(), lane = tid & 63, wid = tid >> 6, wr = wid >> 1, wc = wid & 1, fr = lane & 15, fq = lane >> 4;
    const bf16_t* ga[2];
    const bf16_t* gb[2];
#pragma unroll
    for (int i = 0; i < 2; ++i) {
        const int r = 16 * (wid + 8 * i) + (lane >> 2), sc = ((lane & 3) ^ ((r >> 2) & 3)) * 8;
        ga[i] = arow(r) + sc;
        gb[i] = brow(r) + sc;
    }
#pragma unroll
    for (int m = 0; m < 4; ++m)
#pragma unroll
        for (int n = 0; n < 8; ++n) acc[m][n] = f32x4{0.f, 0.f, 0.f, 0.f};
    char* ldst = smem + wid * 1024 + lane * 16;
#define G4_ISSUE(slot, k0) do { \
        char* d_ = ldst + (slot) * 32768; \
        __builtin_amdgcn_global_load_lds((const unsigned*)(ga[0] + (k0)), (LAS unsigned*)(d_), 16, 0, 0); \
        __builtin_amdgcn_global_load_lds((const unsigned*)(ga[1] + (k0)), (LAS unsigned*)(d_ + 8192), 16, 0, 0); \
        __builtin_amdgcn_global_load_lds((const unsigned*)(gb[0] + (k0)), (LAS unsigned*)(d_ + 16384), 16, 0, 0); \
        __builtin_amdgcn_global_load_lds((const unsigned*)(gb[1] + (k0)), (LAS unsigned*)(d_ + 16384 + 8192), 16, 0, 0); } while (0)
    const int nk = K >> 5;
    G4_ISSUE(0, 0);
    G4_ISSUE(1, 32);
    int slot = 0, slot2 = 2;
    for (int kt = 0; kt < nk; ++kt) {
        if (kt + 1 < nk) asm volatile("s_waitcnt vmcnt(4)" ::: "memory");
        else asm volatile("s_waitcnt vmcnt(0)" ::: "memory");
        __builtin_amdgcn_s_barrier();
        if (kt + 2 < nk) G4_ISSUE(slot2, (kt + 2) * 32);
        const char* sA_ = smem + slot * 32768;
        const char* sB_ = sA_ + 16384;
        bf16x8 af[4];
#pragma unroll
        for (int m = 0; m < 4; ++m) af[m] = *(const bf16x8*)(sA_ + aoff(wr * 64 + m * 16 + fr, fq));
#pragma unroll
        for (int n = 0; n < 8; ++n) {
            const bf16x8 bfr = *(const bf16x8*)(sB_ + aoff(wc * 128 + n * 16 + fr, fq));
#pragma unroll
            for (int m = 0; m < 4; ++m) acc[m][n] = __builtin_amdgcn_mfma_f32_16x16x32_bf16(af[m], bfr, acc[m][n], 0, 0, 0);
        }
        slot = (slot == 2) ? 0 : slot + 1;
        slot2 = (slot2 == 2) ? 0 : slot2 + 1;
    }
#undef G4_ISSUE
    __syncthreads();
}


constexpr int G5_B0 = 49152;
template <class AF, class BF>
__device__ __forceinline__ void gemm5(char* smem, const int K, AF arow, BF bsrc, const int ldb, f32x4 (&acc)[4][8]) {
    const int tid = otid(), lane = tid & 63, wid = tid >> 6, wr = wid >> 1, wc = wid & 1, fr = lane & 15, fq = lane >> 4;
    const bf16_t* ga[2];
#pragma unroll
    for (int i = 0; i < 2; ++i) {
        const int r = 16 * (wid + 8 * i) + (lane >> 2);
        ga[i] = arow(r) + (((lane & 3) ^ ((r >> 2) & 3)) * 8);
    }
    const float* bpf = (const float*)bsrc((tid & 63) * 4) + (size_t)(tid >> 6) * ldb;
#pragma unroll
    for (int m = 0; m < 4; ++m)
#pragma unroll
        for (int n = 0; n < 8; ++n) acc[m][n] = f32x4{0.f, 0.f, 0.f, 0.f};
    const int trbase = (8 * fq + (fr >> 2)) * 512 + wc * 256 + (((fr >> 2) | ((fq & 1) << 2)) << 5) + ((fr & 3) >> 1) * 16 + (fr & 1) * 8;
    char* ldst = smem + wid * 1024 + lane * 16;
    const unsigned lds0 = (unsigned)(size_t)smem;
    unsigned bwoff[4];
#pragma unroll
    for (int j = 0; j < 4; ++j) bwoff[j] = boff((tid >> 6) + 8 * j, (tid & 63) >> 1) + (tid & 1) * 8;
    f32x4 rf0[4], rf1[4];
    const int klast = K - 32;
#define G5_ADMA(slot, k0) do { \
        char* d_ = ldst + (slot) * 16384; \
        __builtin_amdgcn_global_load_lds((const unsigned*)(ga[0] + (k0)), (LAS unsigned*)(d_), 16, 0, 0); \
        __builtin_amdgcn_global_load_lds((const unsigned*)(ga[1] + (k0)), (LAS unsigned*)(d_ + 8192), 16, 0, 0); } while (0)
#define G5_BLOAD(RF, k0) do { const float* q0_ = bpf + (size_t)(k0) * ldb; const float* q1_ = q0_ + (size_t)8 * ldb; const float* q2_ = q0_ + (size_t)16 * ldb; const float* q3_ = q0_ + (size_t)24 * ldb; \
        asm volatile("global_load_dwordx4 %0, %4, off\n\tglobal_load_dwordx4 %1, %5, off\n\tglobal_load_dwordx4 %2, %6, off\n\tglobal_load_dwordx4 %3, %7, off" \
                     : "=&v"(RF[0]), "=&v"(RF[1]), "=&v"(RF[2]), "=&v"(RF[3]) : "v"(q0_), "v"(q1_), "v"(q2_), "v"(q3_) : "memory"); } while (0)
#define G5_BWAIT(RF, N) asm volatile("s_waitcnt vmcnt(" #N ")" : "+v"(RF[0]), "+v"(RF[1]), "+v"(RF[2]), "+v"(RF[3]) :: "memory")
#define G5_BWRITE(RF, st) do { const unsigned sB_ = lds0 + G5_B0 + (st) * 16384; \
        _Pragma("unroll") for (int j = 0; j < 4; ++j) { \
            const unsigned long long w_ = (unsigned long long)pack2(RF[j][0], RF[j][1]) | ((unsigned long long)pack2(RF[j][2], RF[j][3]) << 32); \
            asm volatile("ds_write_b64 %0, %1" :: "v"(sB_ + bwoff[j]), "v"(w_) : "memory"); } } while (0)
#define G5_TRB(n0) do { \
        _Pragma("unroll") for (int n = 0; n < 4; ++n) { const unsigned a_ = sBa_ + (unsigned)(trbase ^ (((n0) + n) << 5)); \
            asm volatile("ds_read_b64_tr_b16 %0, %2\n\tds_read_b64_tr_b16 %1, %2 offset:2048" : "=&v"(tl[n]), "=&v"(th[n]) : "v"(a_) : "memory"); } } while (0)
#define G5_TRW() asm volatile("s_waitcnt lgkmcnt(0)" : "+v"(tl[0]), "+v"(tl[1]), "+v"(tl[2]), "+v"(tl[3]), "+v"(th[0]), "+v"(th[1]), "+v"(th[2]), "+v"(th[3]) :: "memory")
#define G5_MM(n0) do { _Pragma("unroll") for (int n = 0; n < 4; ++n) { \
            const bf16x8 bfr = bf16x8{tl[n][0], tl[n][1], tl[n][2], tl[n][3], th[n][0], th[n][1], th[n][2], th[n][3]}; \
            _Pragma("unroll") for (int m = 0; m < 4; ++m) acc[m][(n0) + n] = __builtin_amdgcn_mfma_f32_16x16x32_bf16(af[m], bfr, acc[m][(n0) + n], 0, 0, 0); } } while (0)
#define G5_COMPUTE(aslot, bst) do { \
        const char* sA_ = smem + (aslot) * 16384; const unsigned sBa_ = lds0 + G5_B0 + (bst) * 16384; \
        v4s tl[4], th[4]; \
        G5_TRB(0); \
        bf16x8 af[4]; \
        _Pragma("unroll") for (int m = 0; m < 4; ++m) af[m] = *(const bf16x8*)(sA_ + aoff(wr * 64 + m * 16 + fr, fq)); \
        G5_TRW(); G5_MM(0); \
        G5_TRB(4); G5_TRW(); G5_MM(4); } while (0)
#define G5_KC(k) ((k) < klast ? (k) : klast)
    const int nk = K >> 5;
    G5_BLOAD(rf0, 0);
    G5_ADMA(0, 0);
    G5_BLOAD(rf1, 32);
    G5_BWAIT(rf0, 6);
    G5_BWRITE(rf0, 0);
    G5_ADMA(1, 32);
    G5_BLOAD(rf0, G5_KC(64));
    int as0 = 0, as2 = 2;
    for (int kt = 0; kt < nk; kt += 2) {
        asm volatile("s_waitcnt vmcnt(10) lgkmcnt(0)" ::: "memory");
        __builtin_amdgcn_s_barrier();
        G5_ADMA(as2, G5_KC((kt + 2) * 32));
        G5_BWAIT(rf1, 8);
        G5_BWRITE(rf1, 1);
        G5_BLOAD(rf1, G5_KC((kt + 3) * 32));
        G5_COMPUTE(as0, 0);
        as0 = (as0 == 2) ? 0 : as0 + 1; as2 = (as2 == 2) ? 0 : as2 + 1;
        asm volatile("s_waitcnt vmcnt(10) lgkmcnt(0)" ::: "memory");
        __builtin_amdgcn_s_barrier();
        G5_ADMA(as2, G5_KC((kt + 3) * 32));
        G5_BWAIT(rf0, 8);
        G5_BWRITE(rf0, 0);
        G5_BLOAD(rf0, G5_KC((kt + 4) * 32));
        G5_COMPUTE(as0, 1);
        as0 = (as0 == 2) ? 0 : as0 + 1; as2 = (as2 == 2) ? 0 : as2 + 1;
    }
    G5_BWAIT(rf0, 0);
    G5_BWAIT(rf1, 0);
    asm volatile("s_waitcnt lgkmcnt(0)" ::: "memory");
    __syncthreads();
#undef G5_ADMA
#undef G5_BLOAD
#undef G5_BWAIT
#undef G5_BWRITE
#undef G5_COMPUTE
#undef G5_TRB
#undef G5_TRW
#undef G5_MM
#undef G5_KC
}

constexpr int EPI_WAVE = 8704;
template <class VF, class SF>
__device__ __forceinline__ void epi_bf16(char* wl, const int lane, VF val, SF store) {
    const int fr = lane & 15, fq = lane >> 4, odd = lane & 1;
#pragma unroll
    for (int n = 0; n < 8; ++n)
#pragma unroll
        for (int jp = 0; jp < 2; ++jp) {
            const float a = val(n, 2 * jp), b = val(n, 2 * jp + 1);
            const float x = odd ? a : b;
            const float y = __shfl_xor(x, 1, 64);
            const uint32_t w = odd ? pack2(y, b) : pack2(a, y);
            *(uint32_t*)(wl + (fq * 4 + 2 * jp + odd) * 272 + (n * 16 + (fr & ~1)) * 2) = w;
        }
    int ln = lane;
    asm volatile("" : "+v"(ln));
#pragma unroll
    for (int i = 0; i < 4; ++i) {
        const int idx = ln + 64 * i, row = idx >> 4, ch = idx & 15;
        store(row, ch, *(const u32x4*)(wl + row * 272 + ch * 16));
    }
}
template <class VF, class SF>
__device__ __forceinline__ void epi_f32(char* wl, const int lane, VF val, SF store) {
    const int fr = lane & 15, fq = lane >> 4;
#pragma unroll
    for (int n = 0; n < 8; ++n)
#pragma unroll
        for (int j = 0; j < 4; ++j) *(float*)(wl + (fq * 4 + j) * 528 + (n * 16 + fr) * 4) = val(n, j);
    int ln = lane;
    asm volatile("" : "+v"(ln));
#pragma unroll
    for (int i = 0; i < 8; ++i) {
        const int idx = ln + 64 * i, row = idx >> 5, ch = idx & 31;
        store(row, ch, *(const f32x4*)(wl + row * 528 + ch * 16));
    }
}


constexpr float Y8_SCALE = 16.f;
template <class VF, class SF>
__device__ __forceinline__ void epi_fp8(char* wl, const int lane, VF val, SF store) {
    const int fr = lane & 15, fq = lane >> 4, odd = lane & 1;
#pragma unroll
    for (int n = 0; n < 8; ++n)
#pragma unroll
        for (int jp = 0; jp < 2; ++jp) {
            const float a = val(n, 2 * jp), b = val(n, 2 * jp + 1);
            const float x = odd ? a : b;
            const float y = __shfl_xor(x, 1, 64);
            const int w = odd ? __builtin_amdgcn_cvt_pk_fp8_f32(y, b, 0, false) : __builtin_amdgcn_cvt_pk_fp8_f32(a, y, 0, false);
            *(unsigned short*)(wl + (fq * 4 + 2 * jp + odd) * 144 + n * 16 + (fr & ~1)) = (unsigned short)w;
        }
    int ln = lane;
    asm volatile("" : "+v"(ln));
#pragma unroll
    for (int i = 0; i < 2; ++i) {
        const int idx = ln + 64 * i, row = idx >> 3, ch = idx & 7;
        store(row, ch, *(const u32x4*)(wl + row * 144 + ch * 16));
    }
}

__device__ __forceinline__ void ph_inproj(const Params& p, char* smem) {
    const int tid = otid(), lane = tid & 63, wid = tid >> 6, wr = wid >> 1, wc = wid & 1, fr = lane & 15;
    const int NTN = INW / 256;
    const int xcd = blockIdx.x & 7, nbx = gridDim.x >> 3;
    for (int i = blockIdx.x >> 3; i < 8 * NTN; i += nbx) {
        const int nt = i >> 3, mt = xcd * 8 + (i & 7);
        const bf16_t* A = p.h1() + (size_t)mt * 256 * D;
        const bf16_t* Bt = p.winT() + (size_t)nt * 256 * D;
        f32x4 acc[4][8];
        __syncthreads();
        gemm4(smem, D, [&](int r) { return A + (size_t)r * D; }, [&](int n) { return Bt + (size_t)n * D; }, acc);
        char* wl = smem + wid * EPI_WAVE;
        const int colb = nt * 256 + wc * 128;
        const int rowb = mt * 256 + wr * 64;
        if (colb >= OFF_HF && colb < OFF_HI) {
            float lbc[8];
#pragma unroll
            for (int n = 0; n < 8; ++n) lbc[n] = p.lbv()[colb - OFF_HF + n * 16 + fr];
#pragma unroll
            for (int m = 0; m < 4; ++m) {
                float* dst = p.lgf() + (size_t)(rowb + m * 16) * 512 + (colb - OFF_HF);
                epi_f32(wl, lane,
                        [&](int n, int j) { return __logf(lbc[n] + (1.f - lbc[n]) * (1.f / (1.f + __expf(-acc[m][n][j])))); },
                        [&](int row, int ch, f32x4 v) { *(f32x4*)(dst + (size_t)row * 512 + ch * 4) = v; });
            }
        } else {
#pragma unroll
            for (int m = 0; m < 4; ++m) {
                bf16_t* dst = p.proj() + (size_t)(rowb + m * 16) * INW + colb;
                epi_bf16(wl, lane, [&](int n, int j) { return acc[m][n][j]; },
                         [&](int row, int ch, u32x4 v) { *(u32x4*)(dst + (size_t)row * INW + ch * 8) = v; });
            }
        }
    }
}

__device__ __forceinline__ void ph_h1(const Params& p, char* smem0) {
    const VB vbk = make_vb(smem0);
    char* smem = vbk.smem;
    const int tid = vbk.tid, lane = tid & 63, wid = tid >> 6, wr = wid >> 1, wc = wid & 1, fr = lane & 15, fq = lane >> 4;
    char* sI = smem;
    char* sK = smem + 16384;
    float* sL = (float*)(smem + 32768);
    float* totS = (float*)(smem + 65536);
    const int d = tid & 127, half = tid >> 7;
    const TrBase trb = tr16_base(lane);
    for (int u = vbk.vb; u < 1024; u += vbk.nvb) {
        const int bh = u >> 6, c = u & 63, b = bh >> 2, h = bh & 3;
        const size_t row0 = (size_t)b * S + c * 64;
        __syncthreads();
#pragma unroll
        for (int i = 0; i < 4; ++i) {
            const int idx = tid + 256 * i, r = idx >> 4, ch = idx & 15;
            *(u32x4*)(sI + swz16(r, ch)) = *(const u32x4*)(p.proj() + (row0 + r) * INW + OFF_HI + h * 128 + ch * 8);
        }
#pragma unroll
        for (int i = 0; i < 8; ++i) {
            const int idx = tid + 256 * i, r = idx >> 5, c4 = idx & 31;
            *(f32x4*)(sL + r * 128 + c4 * 4) = *(const f32x4*)(p.lgf() + (row0 + r) * 512 + h * 128 + c4 * 4);
        }
        __syncthreads();
        const float* lcol = sL + half * 32 * 128 + d;
        float tot = 0.f;
#pragma unroll
        for (int s = 0; s < 32; ++s) tot += lcol[s * 128];
        totS[half * 128 + d] = tot;
        __syncthreads();
        const float t0 = totS[d], bl = t0 + totS[128 + d];
        float run = half ? t0 : 0.f;
#pragma unroll 8
        for (int s = 0; s < 32; ++s) {
            const float lv = lcol[s * 128];
            run += lv;
            const float kt = (1.f - __expf(lv)) * __expf(bl - run);
            *(bf16_t*)(sK + swz16(half * 32 + s, d >> 3) + (d & 7) * 2) = f2bf(kt);
        }
        if (half == 0) p.dec()[u * 128 + d] = __expf(bl);
        __syncthreads();
        f32x4 acc[4][4];
#pragma unroll
        for (int m = 0; m < 4; ++m)
#pragma unroll
            for (int n = 0; n < 4; ++n) acc[m][n] = f32x4{0.f, 0.f, 0.f, 0.f};
#pragma unroll
        for (int ks = 0; ks < 2; ++ks) {
            bf16x8 af[4], bfr[4];
#pragma unroll
            for (int m = 0; m < 4; ++m) af[m] = tr_frag16(sI, trb, ks, wr * 4 + m);
#pragma unroll
            for (int n = 0; n < 4; ++n) bfr[n] = tr_frag16(sK, trb, ks, wc * 4 + n);
#pragma unroll
            for (int m = 0; m < 4; ++m)
#pragma unroll
                for (int n = 0; n < 4; ++n) acc[m][n] = __builtin_amdgcn_mfma_f32_16x16x32_bf16(af[m], bfr[n], acc[m][n], 0, 0, 0);
        }
        __syncthreads();
        {
            int tz = tid;
            asm volatile("" : "+v"(tz));
            const int lz = tz & 63, odd = lz & 1;
            char* wbase = smem + ((tz >> 7) * 64 + (lz >> 4) * 4 + odd) * 272 + (((tz >> 6) & 1) * 64 + ((lz & 15) & ~1)) * 2;
#pragma unroll
            for (int m = 0; m < 4; ++m)
#pragma unroll
                for (int n = 0; n < 4; ++n)
#pragma unroll
                    for (int jp = 0; jp < 2; ++jp) {
                        const float a = acc[m][n][2 * jp], b2 = acc[m][n][2 * jp + 1];
                        const float x = odd ? a : b2;
                        const float y = __shfl_xor(x, 1, 64);
                        const uint32_t w = odd ? pack2(y, b2) : pack2(a, y);
                        *(uint32_t*)(wbase + (m * 16 + 2 * jp) * 272 + n * 32) = w;
                    }
            __syncthreads();
            bf16_t* kvu = p.kv() + (size_t)u * 16384;
            const int r0 = tz >> 4, ch = tz & 15;
#pragma unroll
            for (int i = 0; i < 8; ++i)
                *(u32x4*)(kvu + (r0 + 16 * i) * 128 + ch * 8) = *(const u32x4*)(smem + (r0 + 16 * i) * 272 + ch * 16);
        }
    }
}

__device__ __forceinline__ void ph_h2(const Params& p) {
    for (int it = blockIdx.x * NTHREADS + otid(); it < 16 * 8192; it += gridDim.x * NTHREADS) {
        const int bh = it >> 13, e2 = it & 8191, dv = e2 >> 6, dk = (e2 & 63) * 2;
        const size_t eoff = (size_t)dv * 128 + dk;
        float sx = 0.f, sy = 0.f;
#pragma unroll 8
        for (int c = 0; c < 64; ++c) {
            const size_t u = (size_t)bh * 64 + c;
            *(uint32_t*)(p.sst() + u * 16384 + eoff) = pack2(sx, sy);
            const uint32_t kvw = *(const uint32_t*)(p.kv() + u * 16384 + eoff);
            float2 kvv; kvv.x = __uint_as_float(kvw << 16); kvv.y = __uint_as_float(kvw & 0xffff0000u);
            const float2 dc = *(const float2*)(p.dec() + u * 128 + dk);
            sx = dc.x * sx + kvv.x; sy = dc.y * sy + kvv.y;
        }
    }
}

__device__ __forceinline__ void ph_h3(const Params& p, char* smem0) {
    const VB vbk = make_vb(smem0);
    char* smem = vbk.smem;
    const int tid = vbk.tid, lane = tid & 63, wid = tid >> 6, wr = wid >> 1, wc = wid & 1, fr = lane & 15, fq = lane >> 4;
    char* sQ = smem;
    char* sK = smem + 16384;
    char* sP = smem + 32768;
    float* sL = (float*)(smem + 32768);
    float* totS = (float*)(smem + 65536);
    char* sG = smem + 40960;
    const int d = tid & 127, half = tid >> 7;
    const TrBase trb = tr16_base(lane);
    for (int u = vbk.vb; u < 1024; u += vbk.nvb) {
        const int bh = u >> 6, c = u & 63, b = bh >> 2, h = bh & 3;
        const size_t row0 = (size_t)b * S + c * 64;
        __syncthreads();
#pragma unroll
        for (int i = 0; i < 4; ++i) {
            const int idx = tid + 256 * i, r = idx >> 4, ch = idx & 15;
            *(u32x4*)(sQ + swz16(r, ch)) = *(const u32x4*)(p.proj() + (row0 + r) * INW + OFF_HQ + h * 128 + ch * 8);
        }
#pragma unroll
        for (int i = 0; i < 8; ++i) {
            const int idx = tid + 256 * i, r = idx >> 5, c4 = idx & 31;
            *(f32x4*)(sL + r * 128 + c4 * 4) = *(const f32x4*)(p.lgf() + (row0 + r) * 512 + h * 128 + c4 * 4);
        }
        u32x4 sv0[4], sv1[4], iv[4], gv[4];
#pragma unroll
        for (int i = 0; i < 4; ++i) {
            const int r8 = (tid + 256 * i) >> 3;
            sv0[i] = *(const u32x4*)(p.sst() + (size_t)u * 16384 + r8 * 128 + (tid & 7) * 8);
            sv1[i] = *(const u32x4*)(p.sst() + (size_t)u * 16384 + r8 * 128 + 64 + (tid & 7) * 8);
            const int idx = tid + 256 * i, r = idx >> 4, c16 = idx & 15;
            iv[i] = *(const u32x4*)(p.proj() + (row0 + r) * INW + OFF_HI + h * 128 + c16 * 8);
            gv[i] = *(const u32x4*)(p.proj() + (row0 + r) * INW + OFF_HG + h * 128 + c16 * 8);
        }
        __syncthreads();
        const float* lcol = sL + half * 32 * 128 + d;
        float tot = 0.f;
#pragma unroll
        for (int s = 0; s < 32; ++s) tot += lcol[s * 128];
        totS[half * 128 + d] = tot;
        __syncthreads();
        const float t0 = totS[d];
        float run = half ? t0 : 0.f;
#pragma unroll 8
        for (int s = 0; s < 32; ++s) {
            const float lv = lcol[s * 128];
            run += lv;
            const int o = swz16(half * 32 + s, d >> 3) + (d & 7) * 2;
            const float qm = bf2f(*(const bf16_t*)(sQ + o)) * __expf(run - t0);
            const float kh = (1.f - __expf(lv)) * __expf(t0 - run);
            *(bf16_t*)(sQ + o) = f2bf(qm);
            *(bf16_t*)(sK + o) = f2bf(kh);
        }
        __syncthreads();
        {
            f32x4 pa[2][2];
#pragma unroll
            for (int m = 0; m < 2; ++m)
#pragma unroll
                for (int n = 0; n < 2; ++n) pa[m][n] = f32x4{0.f, 0.f, 0.f, 0.f};
#pragma unroll
            for (int ks = 0; ks < 4; ++ks) {
                bf16x8 af[2], bfr[2];
#pragma unroll
                for (int m = 0; m < 2; ++m) af[m] = *(const bf16x8*)(sQ + swz16(wr * 32 + m * 16 + fr, ks * 4 + fq));
#pragma unroll
                for (int n = 0; n < 2; ++n) bfr[n] = *(const bf16x8*)(sK + swz16(wc * 32 + n * 16 + fr, ks * 4 + fq));
#pragma unroll
                for (int m = 0; m < 2; ++m)
#pragma unroll
                    for (int n = 0; n < 2; ++n) pa[m][n] = __builtin_amdgcn_mfma_f32_16x16x32_bf16(af[m], bfr[n], pa[m][n], 0, 0, 0);
            }
#pragma unroll
            for (int m = 0; m < 2; ++m)
#pragma unroll
                for (int n = 0; n < 2; ++n)
#pragma unroll
                    for (int j = 0; j < 4; ++j) {
                        const int t = wr * 32 + m * 16 + fq * 4 + j, s_ = wc * 32 + n * 16 + fr;
                        const float v = (s_ <= t) ? pa[m][n][j] : 0.f;
                        *(bf16_t*)(sP + swz(t, s_ >> 3) + (s_ & 7) * 2) = f2bf(v);
                    }
        }
        __syncthreads();
        f32x4 oa[8];
#pragma unroll
        for (int i = 0; i < 4; ++i) { const int idx = tid + 256 * i; *(u32x4*)(sG + (idx >> 4) * 256 + (idx & 15) * 16) = gv[i]; }
#pragma unroll
        for (int n = 0; n < 8; ++n) oa[n] = f32x4{0.f, 0.f, 0.f, 0.f};
        const int ch = tid & 7;
#pragma unroll
        for (int sub = 0; sub < 2; ++sub) {
            float sc[8];
#pragma unroll
            for (int j = 0; j < 8; ++j) sc[j] = __expf(totS[sub * 64 + ch * 8 + j]);
#pragma unroll
            for (int i = 0; i < 4; ++i) {
                const int r = (tid + 256 * i) >> 3;
                const u32x4 v = sub ? sv1[i] : sv0[i];
                u32x4 w;
                w.x = pack2(__uint_as_float(v.x << 16) * sc[0], __uint_as_float(v.x & 0xffff0000u) * sc[1]);
                w.y = pack2(__uint_as_float(v.y << 16) * sc[2], __uint_as_float(v.y & 0xffff0000u) * sc[3]);
                w.z = pack2(__uint_as_float(v.z << 16) * sc[4], __uint_as_float(v.z & 0xffff0000u) * sc[5]);
                w.w = pack2(__uint_as_float(v.w << 16) * sc[6], __uint_as_float(v.w & 0xffff0000u) * sc[7]);
                *(u32x4*)(sK + swz(r, ch)) = w;
            }
            __syncthreads();
#pragma unroll
            for (int ks = 0; ks < 2; ++ks) {
                const bf16x8 af = *(const bf16x8*)(sQ + swz16(wid * 16 + fr, sub * 8 + ks * 4 + fq));
#pragma unroll
                for (int n = 0; n < 8; ++n) {
                    const bf16x8 bfr = *(const bf16x8*)(sK + swz(n * 16 + fr, ks * 4 + fq));
                    oa[n] = __builtin_amdgcn_mfma_f32_16x16x32_bf16(af, bfr, oa[n], 0, 0, 0);
                }
            }
            __syncthreads();
        }
#pragma unroll
        for (int i = 0; i < 4; ++i) {
            const int idx = tid + 256 * i, r = idx >> 4, c16 = idx & 15;
            *(u32x4*)(sK + swz16(r, c16)) = iv[i];
        }
        __syncthreads();
#pragma unroll
        for (int ks = 0; ks < 2; ++ks) {
            const bf16x8 af = *(const bf16x8*)(sP + swz(wid * 16 + fr, ks * 4 + fq));
#pragma unroll
            for (int n = 0; n < 8; ++n) {
                const bf16x8 bfr = tr_frag16(sK, trb, ks, n);
                oa[n] = __builtin_amdgcn_mfma_f32_16x16x32_bf16(af, bfr, oa[n], 0, 0, 0);
            }
        }
        float ss[4] = {0.f, 0.f, 0.f, 0.f};
#pragma unroll
        for (int n = 0; n < 8; ++n)
#pragma unroll
            for (int j = 0; j < 4; ++j) ss[j] += oa[n][j] * oa[n][j];
#pragma unroll
        for (int j = 0; j < 4; ++j) {
            ss[j] += __shfl_xor(ss[j], 1, 64); ss[j] += __shfl_xor(ss[j], 2, 64); ss[j] += __shfl_xor(ss[j], 4, 64); ss[j] += __shfl_xor(ss[j], 8, 64);
        }
#pragma unroll
        for (int j = 0; j < 4; ++j) {
            const size_t row = row0 + wid * 16 + fq * 4 + j;
            const float rstd = rsqrtf(ss[j] * (1.f / 128.f) + RMS_EPS);
#pragma unroll
            for (int n = 0; n < 8; ++n) {
                const int dv = n * 16 + fr;
                const float g = bf2f(*(const bf16_t*)(sG + (wid * 16 + fq * 4 + j) * 256 + dv * 2));
                const float y = oa[n][j] * rstd * p.hg_nw[h * 128 + dv] * (g / (1.f + __expf(-g)));
                p.mixin()[row * 768 + h * 128 + dv] = f2bf(y);
            }
        }
    }
}

__device__ __forceinline__ TrBase tr8_base(int lane) {
    const int g = lane >> 4, q = (lane & 15) >> 2, pp = lane & 3;
    const int xl = 4 * (g & 1) + (q >> 1), h = pp >> 1;
    TrBase t;
    t.lo = (8 * g + q) * 128 + ((xl >> 1) << 5) + ((h ^ (xl & 1)) << 4) + 8 * (pp & 1);
    t.hi = (t.lo + 512) ^ 32;
    return t;
}
__device__ __forceinline__ bf16x8 tr_frag8(const char* tile, const TrBase& tb, int ks, int c) {
    int cx = c << 5;
    asm volatile("" : "+v"(cx));
    const v4s lo = __builtin_amdgcn_ds_read_tr16_b64_v4i16((LAS v4s*)(tile + ks * 4096 + (tb.lo ^ cx)));
    const v4s hi = __builtin_amdgcn_ds_read_tr16_b64_v4i16((LAS v4s*)(tile + ks * 4096 + (tb.hi ^ cx)));
    return bf16x8{lo[0], lo[1], lo[2], lo[3], hi[0], hi[1], hi[2], hi[3]};
}

__device__ __forceinline__ void ph_attn(const Params& p, char* smem0) {
    const VB vbk = make_vb(smem0);
    char* smem = vbk.smem;
    const int tid = vbk.tid, lane = tid & 63, wid = tid >> 6, fr = lane & 15, fq = lane >> 4;
    char* sQ = smem;
    char* sK = smem + 8192;
    char* sP = sK;
    char* sV = smem + 33792;
    float* sBias = (float*)(smem + 58368);
    const TrBase trb = tr8_base(lane);
    for (int u = vbk.vb; u < 3072; u += vbk.nvb) {
        const int ti = u & 63, gq = u >> 6, g = gq % 3, bhh = gq / 3, hh = bhh & 3, b = bhh >> 2;
        const int lsh = (g == 0) ? 0 : (g == 1 ? 2 : 4), dl = 1 << lsh;
        const int tpr = (S >> lsh) >> 6;
        const int r = ti / tpr, j0 = (ti % tpr) * 64;
        const bf16_t* base = p.proj() + (size_t)b * S * INW + (g * 4 + hh) * 64;
        __syncthreads();
#pragma unroll
        for (int i = 0; i < 2; ++i) {
            const int idx = tid + 256 * i, row = idx >> 3, ch = idx & 7;
            const int tok = (j0 + row) * dl + r;
            *(u32x4*)(sQ + swz(row, ch)) = *(const u32x4*)(base + (size_t)tok * INW + OFF_AQ + ch * 8);
        }
#pragma unroll
        for (int i = 0; i < 6; ++i) {
            const int idx = tid + 256 * i, row = idx >> 3, ch = idx & 7;
            const int j = j0 - 128 + row;
            u32x4 kx = {0u, 0u, 0u, 0u}, vx = {0u, 0u, 0u, 0u};
            if (j >= 0) {
                const size_t o = (size_t)(j * dl + r) * INW + ch * 8;
                kx = *(const u32x4*)(base + o + OFF_AK);
                vx = *(const u32x4*)(base + o + OFF_AV);
            }
            *(u32x4*)(sK + swz(row, ch)) = kx;
            *(u32x4*)(sV + swz(row, ch)) = vx;
        }
        if (tid < 129) sBias[tid] = p.biasT()[(g * 129 + tid) * 4 + hh];
        __syncthreads();
        f32x4 sa[12];
#pragma unroll
        for (int n = 0; n < 12; ++n) sa[n] = f32x4{0.f, 0.f, 0.f, 0.f};
#pragma unroll
        for (int ks = 0; ks < 2; ++ks) {
            const bf16x8 af = *(const bf16x8*)(sQ + swz(wid * 16 + fr, ks * 4 + fq));
#pragma unroll
            for (int n = 0; n < 12; ++n) {
                const bf16x8 bfr = *(const bf16x8*)(sK + swz(n * 16 + fr, ks * 4 + fq));
                sa[n] = __builtin_amdgcn_mfma_f32_16x16x32_bf16(af, bfr, sa[n], 0, 0, 0);
            }
        }
        float mx[4] = {-INFINITY, -INFINITY, -INFINITY, -INFINITY};
#pragma unroll
        for (int n = 0; n < 12; ++n)
#pragma unroll
            for (int j = 0; j < 4; ++j) {
                const int jj = wid * 16 + fq * 4 + j, kk = n * 16 + fr, m = jj + 128 - kk;
                const bool valid = (m >= 0) && (m <= 128) && (j0 - 128 + kk >= 0);
                const int mc = m < 0 ? 0 : (m > 128 ? 128 : m);
                const float v = valid ? sa[n][j] * 0.125f + sBias[mc] : -INFINITY;
                sa[n][j] = v;
                mx[j] = fmaxf(mx[j], v);
            }
#pragma unroll
        for (int j = 0; j < 4; ++j) {
            mx[j] = fmaxf(mx[j], __shfl_xor(mx[j], 1, 64)); mx[j] = fmaxf(mx[j], __shfl_xor(mx[j], 2, 64));
            mx[j] = fmaxf(mx[j], __shfl_xor(mx[j], 4, 64)); mx[j] = fmaxf(mx[j], __shfl_xor(mx[j], 8, 64));
        }
        float ls[4] = {0.f, 0.f, 0.f, 0.f};
#pragma unroll
        for (int n = 0; n < 12; ++n)
#pragma unroll
            for (int j = 0; j < 4; ++j) { const float pe = __expf(sa[n][j] - mx[j]); sa[n][j] = pe; ls[j] += pe; }
#pragma unroll
        for (int j = 0; j < 4; ++j) {
            ls[j] += __shfl_xor(ls[j], 1, 64); ls[j] += __shfl_xor(ls[j], 2, 64); ls[j] += __shfl_xor(ls[j], 4, 64); ls[j] += __shfl_xor(ls[j], 8, 64);
        }
        __syncthreads();
#pragma unroll
        for (int n = 0; n < 12; ++n)
#pragma unroll
            for (int j = 0; j < 4; ++j) *(bf16_t*)(sP + (wid * 16 + fq * 4 + j) * 400 + (n * 16 + fr) * 2) = f2bf(sa[n][j]);
        f32x4 oa[4];
#pragma unroll
        for (int n = 0; n < 4; ++n) oa[n] = f32x4{0.f, 0.f, 0.f, 0.f};
#pragma unroll
        for (int ks = 0; ks < 6; ++ks) {
            const bf16x8 af = *(const bf16x8*)(sP + (wid * 16 + fr) * 400 + (ks * 4 + fq) * 16);
#pragma unroll
            for (int n = 0; n < 4; ++n) {
                const bf16x8 bfr = tr_frag8(sV, trb, ks, n);
                oa[n] = __builtin_amdgcn_mfma_f32_16x16x32_bf16(af, bfr, oa[n], 0, 0, 0);
            }
        }
#pragma unroll
        for (int j = 0; j < 4; ++j) {
            const int jj = wid * 16 + fq * 4 + j;
            const size_t row = (size_t)g * T + (size_t)b * S + (j0 + jj) * dl + r;
            const float inv = 1.f / ls[j];
#pragma unroll
            for (int n = 0; n < 4; ++n) p.ao()[row * 256 + hh * 64 + n * 16 + fr] = oa[n][j] * inv;
            if (fr == 0) p.alse()[row * 4 + hh] = mx[j] + __logf(ls[j]);
        }
    }
}

__device__ __forceinline__ void ph_attn_merge(const Params& p) {
    const int tid = otid(), lane = tid & 63, wid = tid >> 6;
    for (int row = blockIdx.x * 8 + wid; row < T; row += gridDim.x * 8) {
        const int hh = lane >> 4;
        const float l0 = p.alse()[((size_t)0 * T + row) * 4 + hh], l1 = p.alse()[((size_t)1 * T + row) * 4 + hh], l2 = p.alse()[((size_t)2 * T + row) * 4 + hh];
        const float mxl = fmaxf(l0, fmaxf(l1, l2));
        float e0 = __expf(l0 - mxl), e1 = __expf(l1 - mxl), e2 = __expf(l2 - mxl);
        const float inv = 1.f / (e0 + e1 + e2);
        e0 *= inv; e1 *= inv; e2 *= inv;
        const f32x4 a0 = *(const f32x4*)(p.ao() + ((size_t)0 * T + row) * 256 + lane * 4);
        const f32x4 a1 = *(const f32x4*)(p.ao() + ((size_t)1 * T + row) * 256 + lane * 4);
        const f32x4 a2 = *(const f32x4*)(p.ao() + ((size_t)2 * T + row) * 256 + lane * 4);
        uint2 o;
        o.x = pack2(a0[0] * e0 + a1[0] * e1 + a2[0] * e2, a0[1] * e0 + a1[1] * e1 + a2[1] * e2);
        o.y = pack2(a0[2] * e0 + a1[2] * e1 + a2[2] * e2, a0[3] * e0 + a1[3] * e1 + a2[3] * e2);
        *(uint2*)(p.mixin() + (size_t)row * 768 + 512 + lane * 4) = o;
    }
}

__device__ __forceinline__ void ph_outproj(const Params& p, char* smem) {
    const int tid = otid(), lane = tid & 63, wid = tid >> 6, wr = wid >> 1, wc = wid & 1;
    const int xcd = blockIdx.x & 7, nbx = gridDim.x >> 3;
    for (int i = blockIdx.x >> 3; i < 32; i += nbx) {
        const int nt = i >> 3, mt = xcd * 8 + (i & 7);
        const bf16_t* A = p.mixin() + (size_t)mt * 256 * 768;
        const bf16_t* Bt = p.woutT() + (size_t)nt * 256 * 768;
        f32x4 acc[4][8];
        __syncthreads();
        gemm4(smem, 768, [&](int r) { return A + (size_t)r * 768; }, [&](int n) { return Bt + (size_t)n * 768; }, acc);
        const int b = (mt * 256) >> 12;
        const int colb = nt * 256 + wc * 128;
        const float* g1 = p.mod() + b * 6144 + 2048 + colb;
        char* wl = smem + wid * EPI_WAVE;
#pragma unroll
        for (int m = 0; m < 4; ++m) {
            const size_t rbase = (size_t)(mt * 256 + wr * 64 + m * 16) * D + colb;
            epi_f32(wl, lane, [&](int n, int j) { return acc[m][n][j]; },
                    [&](int row, int ch, f32x4 v) {
                        const f32x4 xv = *(const f32x4*)(p.x + rbase + (size_t)row * D + ch * 4);
                        const f32x4 gv = *(const f32x4*)(g1 + ch * 4);
                        f32x4 o;
                        o[0] = ALPHA * xv[0] + gv[0] * v[0]; o[1] = ALPHA * xv[1] + gv[1] * v[1];
                        o[2] = ALPHA * xv[2] + gv[2] * v[2]; o[3] = ALPHA * xv[3] + gv[3] * v[3];
                        *(f32x4*)(p.pre1() + rbase + (size_t)row * D + ch * 4) = o;
                    });
        }
    }
}

__device__ __forceinline__ void ph_ln1(const Params& p) {
    const int tid = otid(), lane = tid & 63, wid = tid >> 6;
    const int rstride = gridDim.x * 8;
    float4 nv[4];
    {
        const float4* xr = (const float4*)(p.pre1() + (size_t)(blockIdx.x * 8 + wid) * D);
#pragma unroll
        for (int i = 0; i < 4; ++i) nv[i] = xr[lane + 64 * i];
    }
    for (int row = blockIdx.x * 8 + wid; row < T; row += rstride) {
        float4 v[4];
        float s = 0.f;
#pragma unroll
        for (int i = 0; i < 4; ++i) { v[i] = nv[i]; s += v[i].x + v[i].y + v[i].z + v[i].w; }
        if (row + rstride < T) {
            const float4* xn = (const float4*)(p.pre1() + (size_t)(row + rstride) * D);
#pragma unroll
            for (int i = 0; i < 4; ++i) nv[i] = xn[lane + 64 * i];
        }
        float mean = wave_sum(s) * (1.f / D);
        float q = 0.f;
#pragma unroll
        for (int i = 0; i < 4; ++i) {
            v[i].x -= mean; v[i].y -= mean; v[i].z -= mean; v[i].w -= mean;
            q += v[i].x * v[i].x + v[i].y * v[i].y + v[i].z * v[i].z + v[i].w * v[i].w;
        }
        float rstd = rsqrtf(wave_sum(q) * (1.f / D) + LN_EPS);
        s = 0.f;
#pragma unroll
        for (int i = 0; i < 4; ++i) {
            const int col = (lane + 64 * i) * 4;
            const float4 g4 = *(const float4*)(p.ln1_g + col), b4 = *(const float4*)(p.ln1_b + col);
            v[i].x = v[i].x * rstd * g4.x + b4.x; v[i].y = v[i].y * rstd * g4.y + b4.y;
            v[i].z = v[i].z * rstd * g4.z + b4.z; v[i].w = v[i].w * rstd * g4.w + b4.w;
            { uint2 xo; xo.x = pack2(v[i].x, v[i].y); xo.y = pack2(v[i].z, v[i].w); *(uint2*)(p.x1() + (size_t)row * D + col) = xo; }
            s += v[i].x + v[i].y + v[i].z + v[i].w;
        }
        mean = wave_sum(s) * (1.f / D);
        q = 0.f;
#pragma unroll
        for (int i = 0; i < 4; ++i) {
            v[i].x -= mean; v[i].y -= mean; v[i].z -= mean; v[i].w -= mean;
            q += v[i].x * v[i].x + v[i].y * v[i].y + v[i].z * v[i].z + v[i].w * v[i].w;
        }
        rstd = rsqrtf(wave_sum(q) * (1.f / D) + LN_EPS);
        const int b = row >> 12;
        const float* sh = p.mod() + b * 6144 + 3072;
        const float* sc = sh + 1024;
#pragma unroll
        for (int i = 0; i < 4; ++i) {
            const int col = (lane + 64 * i) * 4;
            const float4 s4 = *(const float4*)(sc + col), h4 = *(const float4*)(sh + col);
            float4 y;
            y.x = v[i].x * rstd * (1.f + s4.x) + h4.x; y.y = v[i].y * rstd * (1.f + s4.y) + h4.y;
            y.z = v[i].z * rstd * (1.f + s4.z) + h4.z; y.w = v[i].w * rstd * (1.f + s4.w) + h4.w;
            uint2 o;
            o.x = pack2(y.x, y.y); o.y = pack2(y.z, y.w);
            *(uint2*)(p.h2() + (size_t)row * 2048 + col) = o;
            uint2 o2;
            o2.x = pack2(y.x - __uint_as_float(o.x << 16), y.y - __uint_as_float(o.x & 0xffff0000u));
            o2.y = pack2(y.z - __uint_as_float(o.y << 16), y.w - __uint_as_float(o.y & 0xffff0000u));
            *(uint2*)(p.h2() + (size_t)row * 2048 + 1024 + col) = o2;
        }
    }
}


__device__ __forceinline__ void topk4_lds(const Params& p, const float* lg, const int tok0, const int lane) {
    constexpr int TK = 4;
        float sc[TK][4], bv[TK][4];
#pragma unroll
    for (int t = 0; t < TK; ++t)
#pragma unroll
        for (int j = 0; j < 4; ++j) {
            const int e = j * 64 + lane;
            const float x = lg[t * NE + e];
            sc[t][j] = 1.f / (1.f + expf(-x));
            bv[t][j] = sc[t][j] + p.router_bias[e];
        }
    float gsum[TK][4];
#pragma unroll
    for (int j = 0; j < 4; ++j) {
        float m1[TK], m2[TK];
#pragma unroll
        for (int t = 0; t < TK; ++t) m1[t] = bv[t][j];
#pragma unroll
        for (int o = 16; o > 0; o >>= 1)
#pragma unroll
            for (int t = 0; t < TK; ++t) m1[t] = fmaxf(m1[t], __shfl_xor(m1[t], o, 64));
#pragma unroll
        for (int t = 0; t < TK; ++t) {
            const unsigned long long bal = __ballot(bv[t][j] == m1[t]);
            const unsigned hm = (unsigned)(bal >> (lane & 32));
            const int first = __ffs(hm) - 1;
            m2[t] = ((lane & 31) == first) ? -INFINITY : bv[t][j];
        }
#pragma unroll
        for (int o = 16; o > 0; o >>= 1)
#pragma unroll
            for (int t = 0; t < TK; ++t) m2[t] = fmaxf(m2[t], __shfl_xor(m2[t], o, 64));
#pragma unroll
        for (int t = 0; t < TK; ++t) gsum[t][j] = m1[t] + m2[t];
    }
    float cand[TK][4];
#pragma unroll
    for (int t = 0; t < TK; ++t) {
        float gs[8];
#pragma unroll
        for (int j = 0; j < 4; ++j) { gs[2 * j] = __shfl(gsum[t][j], 0, 64); gs[2 * j + 1] = __shfl(gsum[t][j], 32, 64); }
        unsigned gmask = 0u;
#pragma unroll
        for (int r = 0; r < 4; ++r) {
            float best = -INFINITY; int bi = 0;
#pragma unroll
            for (int g = 0; g < 8; ++g) {
                const bool ok = (((gmask >> g) & 1u) == 0u) && (gs[g] > best);
                if (ok) { best = gs[g]; bi = g; }
            }
            gmask |= 1u << bi;
        }
#pragma unroll
        for (int j = 0; j < 4; ++j) cand[t][j] = ((gmask >> (2 * j + (lane >> 5))) & 1u) ? bv[t][j] : -INFINITY;
    }
    float wsum[TK], myw[TK];
    int mye[TK];
#pragma unroll
    for (int t = 0; t < TK; ++t) { wsum[t] = 0.f; myw[t] = 0.f; mye[t] = 0; }
#pragma unroll
    for (int r = 0; r < 8; ++r) {
        float bvv[TK]; int be[TK];
#pragma unroll
        for (int t = 0; t < TK; ++t) {
            bvv[t] = cand[t][0]; be[t] = lane;
#pragma unroll
            for (int j = 1; j < 4; ++j) if (cand[t][j] > bvv[t]) { bvv[t] = cand[t][j]; be[t] = j * 64 + lane; }
        }
#pragma unroll
        for (int o = 32; o > 0; o >>= 1)
#pragma unroll
            for (int t = 0; t < TK; ++t) {
                const float ov = __shfl_xor(bvv[t], o, 64);
                const int oe = __shfl_xor(be[t], o, 64);
                if (ov > bvv[t] || (ov == bvv[t] && oe < be[t])) { bvv[t] = ov; be[t] = oe; }
            }
#pragma unroll
        for (int t = 0; t < TK; ++t) {
            const int bj = be[t] >> 6;
            const float mysc = bj == 0 ? sc[t][0] : (bj == 1 ? sc[t][1] : (bj == 2 ? sc[t][2] : sc[t][3]));
            const float sval = __shfl(mysc, be[t] & 63, 64);
#pragma unroll
            for (int j = 0; j < 4; ++j) if (be[t] == j * 64 + lane) cand[t][j] = -INFINITY;
            wsum[t] += sval;
            if (lane == r) { myw[t] = sval; mye[t] = be[t]; }
        }
    }
    if (lane < 8) {
#pragma unroll
        for (int t = 0; t < TK; ++t) {
            const int a = (tok0 + t) * 8 + lane;
            p.topi()[a] = mye[t];
            p.topw()[a] = myw[t] * (2.5f / wsum[t]);
        }
    }
}

__device__ __forceinline__ void ph_router_topk(const Params& p, char* smem) {
    const int tid = otid(), lane = tid & 63, wid = tid >> 6, fr = lane & 15, fq = lane >> 4;
    float* lgs = (float*)(smem + 65536);
    for (int mt = blockIdx.x; mt < T / 64; mt += gridDim.x) {
        const bf16_t* A = p.h2() + (size_t)mt * 64 * 2048;
        const int ra = 16 * (wid & 3) + (lane >> 2);
        const bf16_t* ga = A + (size_t)ra * 2048 + (((lane & 3) ^ ((ra >> 2) & 3)) * 8);
        const bf16_t* gb[2];
#pragma unroll
        for (int i = 0; i < 2; ++i) {
            const int r = 16 * (wid + 8 * i) + (lane >> 2);
            gb[i] = p.wrT() + (size_t)r * D + (((lane & 3) ^ ((r >> 2) & 3)) * 8);
        }
        f32x4 acc[4][2];
#pragma unroll
        for (int m = 0; m < 4; ++m) { acc[m][0] = f32x4{0.f, 0.f, 0.f, 0.f}; acc[m][1] = f32x4{0.f, 0.f, 0.f, 0.f}; }
        char* ldA = smem + (wid & 3) * 1024 + lane * 16;
        char* ldB = smem + 4096 + wid * 1024 + lane * 16;
#define RT_ISSUE(slot, kt_) do { const int ps_ = (kt_) >> 5, k0_ = ((kt_) & 31) * 32; \
        const int ao_ = (ps_ & 1) * 1024 + k0_; const size_t bo_ = (size_t)(ps_ >> 1) * (NE * D) + k0_; \
        __builtin_amdgcn_global_load_lds((const unsigned*)(ga + ao_), (LAS unsigned*)(ldA + (slot) * 20480), 16, 0, 0); \
        __builtin_amdgcn_global_load_lds((const unsigned*)(gb[0] + bo_), (LAS unsigned*)(ldB + (slot) * 20480), 16, 0, 0); \
        __builtin_amdgcn_global_load_lds((const unsigned*)(gb[1] + bo_), (LAS unsigned*)(ldB + (slot) * 20480 + 8192), 16, 0, 0); } while (0)
        __syncthreads();
        RT_ISSUE(0, 0);
        RT_ISSUE(1, 1);
        int slot = 0, slot2 = 2;
        for (int kt = 0; kt < 96; ++kt) {
            if (kt + 1 < 96) asm volatile("s_waitcnt vmcnt(3)" ::: "memory");
            else asm volatile("s_waitcnt vmcnt(0)" ::: "memory");
            __builtin_amdgcn_s_barrier();
            if (kt + 2 < 96) RT_ISSUE(slot2, kt + 2);
            const char* sA_ = smem + slot * 20480;
            const char* sB_ = sA_ + 4096;
            bf16x8 af[4];
#pragma unroll
            for (int m = 0; m < 4; ++m) af[m] = *(const bf16x8*)(sA_ + aoff(m * 16 + fr, fq));
#pragma unroll
            for (int n = 0; n < 2; ++n) {
                const bf16x8 bfr = *(const bf16x8*)(sB_ + aoff((2 * wid + n) * 16 + fr, fq));
#pragma unroll
                for (int m = 0; m < 4; ++m) acc[m][n] = __builtin_amdgcn_mfma_f32_16x16x32_bf16(af[m], bfr, acc[m][n], 0, 0, 0);
            }
            slot = (slot == 2) ? 0 : slot + 1;
            slot2 = (slot2 == 2) ? 0 : slot2 + 1;
        }
#undef RT_ISSUE
#pragma unroll
        for (int m = 0; m < 4; ++m)
#pragma unroll
            for (int n = 0; n < 2; ++n)
#pragma unroll
                for (int j = 0; j < 4; ++j) lgs[(m * 16 + fq * 4 + j) * NE + (2 * wid + n) * 16 + fr] = acc[m][n][j];
        __syncthreads();
        topk4_lds(p, lgs + (wid * 8) * NE, mt * 64 + wid * 8, lane);
        topk4_lds(p, lgs + (wid * 8 + 4) * NE, mt * 64 + wid * 8 + 4, lane);
    }
}


__device__ __forceinline__ void ph_lists(const Params& p, char* smem) {
    const int tid = otid(), lane = tid & 63, wid = tid >> 6;
    int* wtot = (int*)smem;
    for (int e = blockIdx.x; e < NE; e += gridDim.x) {
        __syncthreads();
        const int4* src = (const int4*)p.topi() + wid * 4096;
        int cntw = 0;
        for (int i = 0; i < 64; ++i) {
            const int4 v = src[i * 64 + lane];
            cntw += __popcll(__ballot(v.x == e)) + __popcll(__ballot(v.y == e)) + __popcll(__ballot(v.z == e)) + __popcll(__ballot(v.w == e));
        }
        if (lane == 0) wtot[wid] = cntw;
        __syncthreads();
        int base = 0, tot = 0;
        for (int w = 0; w < 8; ++w) { const int c = wtot[w]; if (w < wid) base += c; tot += c; }
        if (tid == 0) p.cnt()[e] = tot;
        int* dst = p.list() + (size_t)e * T;
        const unsigned long long lt = (1ull << lane) - 1ull;
        for (int i = 0; i < 64; ++i) {
            const int4 v = src[i * 64 + lane];
            const int a0 = (wid * 4096 + i * 64 + lane) * 4;
            unsigned long long m;
            m = __ballot(v.x == e); if (v.x == e) dst[base + __popcll(m & lt)] = a0;     base += __popcll(m);
            m = __ballot(v.y == e); if (v.y == e) dst[base + __popcll(m & lt)] = a0 + 1; base += __popcll(m);
            m = __ballot(v.z == e); if (v.z == e) dst[base + __popcll(m & lt)] = a0 + 2; base += __popcll(m);
            m = __ballot(v.w == e); if (v.w == e) dst[base + __popcll(m & lt)] = a0 + 3; base += __popcll(m);
        }
    }
}

struct ExpMap { int* cnt; int* off; int* tile; };
__device__ __forceinline__ ExpMap exp_map(const Params& p, char* smem) {
    ExpMap m;
    m.cnt = (int*)(smem + 98304); m.off = m.cnt + 256; m.tile = m.off + 256;
    const int tid = otid();
    __syncthreads();
    if (tid < NE) m.cnt[tid] = p.cnt()[tid];
    __syncthreads();
    if (tid == 0) {
        int off = 0, tl = 0;
        for (int e = 0; e < NE; ++e) { m.off[e] = off; m.tile[e] = tl; const int c = m.cnt[e]; off += c; tl += (c + 255) >> 8; }
        m.tile[NE] = tl;
    }
    __syncthreads();
    return m;
}
__device__ __forceinline__ int find_expert(const int* tile, int rt) {
    int lo = 0, hi = NE;
    while (hi - lo > 1) { const int mid = (lo + hi) >> 1; if (tile[mid] <= rt) lo = mid; else hi = mid; }
    return lo;
}
#define ROWA(smem) ((int*)((smem) + 98304 + 3328))
#define ROWW(smem) ((float*)((smem) + 98304 + 3328 + 1024))

__device__ __forceinline__ void ph_gateup(const Params& p, char* smem) {
    const int tid = otid(), lane = tid & 63, wid = tid >> 6, wr = wid >> 1, wc = wid & 1;
    const ExpMap em = exp_map(p, smem);
    int* rowA = ROWA(smem);
    const int ntile = em.tile[NE];
    const int U = (ntile + T / 256) * 2;
    const int xcd = blockIdx.x & 7, nbx = gridDim.x >> 3;
    const int lo = (int)(((long long)U * xcd) >> 3), hi = (int)(((long long)U * (xcd + 1)) >> 3);
    for (int u = lo + (blockIdx.x >> 3); u < hi; u += nbx) {
        const int rt = u >> 1, c0 = (u & 1) * 128;
        const float *Wg, *Wu;
        bf16_t* gdst;
        int nrow, tokv = -1;
        if (rt < ntile) {
            const int e = find_expert(em.tile, rt);
            const int r0 = (rt - em.tile[e]) * 256, ne = em.cnt[e];
            Wg = p.w_eg + (size_t)e * D * ED; Wu = p.w_eu + (size_t)e * D * ED;
            gdst = p.gbuf() + ((size_t)em.off[e] + r0) * ED + c0;
            nrow = ne - r0;
            if (tid < 256 && r0 + tid < ne) tokv = p.list()[(size_t)e * T + r0 + tid] >> 3;
        } else {
            const int tb = (rt - ntile) * 256;
            Wg = p.w_sg; Wu = p.w_su;
            gdst = p.gsh() + (size_t)tb * ED + c0;
            nrow = 256;
            tokv = tb + (tid & 255);
        }
        __syncthreads();
        if (tid < 256) rowA[tid] = tokv;
        __syncthreads();
        const int t0 = rowA[0];
        f32x4 acc[4][8];
        gemm5(smem, D,
              [&](int r) { const int t = rowA[r]; return p.h2() + (size_t)(t < 0 ? t0 : t) * 2048; },
              [&](int n) { const int t16 = n >> 4; return ((t16 & 1) ? Wu : Wg) + c0 + 16 * (t16 >> 1) + (n & 15); },
              ED, acc);
        if (wr * 64 < nrow) {
            char* wl = smem + wid * EPI_WAVE;
#pragma unroll
            for (int m = 0; m < 4; ++m) {
                const int rb = wr * 64 + m * 16;
                epi_bf16(wl, lane,
                         [&](int n, int j) { if (n >= 4) return 0.f; const float g = acc[m][2 * n][j], uu = acc[m][2 * n + 1][j]; return g / (1.f + __expf(-g)) * uu; },
                         [&](int row, int ch, u32x4 v) { if (ch < 8 && rb + row < nrow) *(u32x4*)(gdst + (size_t)(rb + row) * ED + wc * 64 + ch * 8) = v; });
            }
        }
    }
}

__device__ __forceinline__ void ph_down(const Params& p, char* smem) {
    const int tid = otid(), lane = tid & 63, wid = tid >> 6, wr = wid >> 1, wc = wid & 1;
    const ExpMap em = exp_map(p, smem);
    int* rowA = ROWA(smem);
    float* rowW = ROWW(smem);
    const int ntile = em.tile[NE];
    const int U = (ntile + T / 256) * 4;
    const int xcd = blockIdx.x & 7, nbx = gridDim.x >> 3;
    const int lo = (int)(((long long)U * xcd) >> 3), hi = (int)(((long long)U * (xcd + 1)) >> 3);
    for (int u = lo + (blockIdx.x >> 3); u < hi; u += nbx) {
        const int rt = u >> 2, nt = u & 3;
        const bf16_t* A;
        const float* W;
        int nrow, slot = -1;
        float wv = 0.f;
        if (rt < ntile) {
            const int e = find_expert(em.tile, rt);
            const int r0 = (rt - em.tile[e]) * 256, ne = em.cnt[e];
            A = p.gbuf() + ((size_t)em.off[e] + r0) * ED;
            W = p.w_ed + (size_t)e * ED * D + nt * 256;
            nrow = ne - r0;
            if (tid < 256 && r0 + tid < ne) {
                const int a = p.list()[(size_t)e * T + r0 + tid];
                slot = a;
                wv = p.topw()[a] * Y8_SCALE;
            }
        } else {
            const int tb = (rt - ntile) * 256;
            A = p.gsh() + (size_t)tb * ED;
            W = p.w_sd + nt * 256;
            nrow = 256;
            slot = tb + (tid & 255);
            wv = 1.f;
        }
        __syncthreads();
        if (tid < 256) { rowA[tid] = slot; rowW[tid] = wv; }
        __syncthreads();
        f32x4 acc[4][8];
        gemm5(smem, ED, [&](int r) { return A + (size_t)(r < nrow ? r : 0) * ED; }, [&](int n) { return W + n; }, D, acc);
        if (wr * 64 < nrow) {
            char* wl = smem + wid * EPI_WAVE;
#pragma unroll
            for (int m = 0; m < 4; ++m) {
                const int rb = wr * 64 + m * 16;
                float wj[4];
#pragma unroll
                for (int j = 0; j < 4; ++j) wj[j] = rowW[rb + (lane >> 4) * 4 + j];
                if (rt < ntile) {
                    epi_fp8(wl, lane, [&](int n, int j) { return __builtin_amdgcn_fmed3f(acc[m][n][j] * wj[j], -440.f, 440.f); },
                            [&](int row, int ch, u32x4 v) {
                                const int sl = rowA[rb + row];
                                if (sl >= 0) *(u32x4*)(p.ybuf() + (size_t)sl * D + nt * 256 + wc * 128 + ch * 16) = v;
                            });
                } else {
                    epi_bf16(wl, lane, [&](int n, int j) { return acc[m][n][j]; },
                             [&](int row, int ch, u32x4 v) {
                                 const int sl = rowA[rb + row];
                                 *(u32x4*)(p.ysh() + (size_t)sl * D + nt * 256 + wc * 128 + ch * 8) = v;
                             });
                }
            }
        }
    }
}

__device__ __forceinline__ void ph_final(const Params& p) {
    const int tid = otid(), lane = tid & 63, wid = tid >> 6;
    for (int row = blockIdx.x * 8 + wid; row < T; row += gridDim.x * 8) {
        const int b = row >> 12;
        const float* g2 = p.mod() + b * 6144 + 5120;
        float4 v[4];
        float s = 0.f;
#pragma unroll
        for (int i = 0; i < 4; ++i) {
            const int col = (lane + 64 * i) * 4;
            float f0 = 0.f, f1 = 0.f, f2 = 0.f, f3 = 0.f;
#pragma unroll
            for (int k = 0; k < 8; ++k) {
                const int w8 = *(const int*)(p.ybuf() + ((size_t)row * 8 + k) * D + col);
                const v2f_t lo = __builtin_amdgcn_cvt_pk_f32_fp8(w8, false), hi = __builtin_amdgcn_cvt_pk_f32_fp8(w8, true);
                f0 += lo[0]; f1 += lo[1]; f2 += hi[0]; f3 += hi[1];
            }
            f0 *= (1.f / Y8_SCALE); f1 *= (1.f / Y8_SCALE); f2 *= (1.f / Y8_SCALE); f3 *= (1.f / Y8_SCALE);
            {
                const uint2 w = *(const uint2*)(p.ysh() + (size_t)row * D + col);
                f0 += __uint_as_float(w.x << 16); f1 += __uint_as_float(w.x & 0xffff0000u);
                f2 += __uint_as_float(w.y << 16); f3 += __uint_as_float(w.y & 0xffff0000u);
            }
            float4 xv;
            { const uint2 xw = *(const uint2*)(p.x1() + (size_t)row * D + col);
              xv.x = __uint_as_float(xw.x << 16); xv.y = __uint_as_float(xw.x & 0xffff0000u); xv.z = __uint_as_float(xw.y << 16); xv.w = __uint_as_float(xw.y & 0xffff0000u); }
            const float4 g4 = *(const float4*)(g2 + col);
            v[i].x = ALPHA * xv.x + g4.x * f0; v[i].y = ALPHA * xv.y + g4.y * f1;
            v[i].z = ALPHA * xv.z + g4.z * f2; v[i].w = ALPHA * xv.w + g4.w * f3;
            s += v[i].x + v[i].y + v[i].z + v[i].w;
        }
        const float mean = wave_sum(s) * (1.f / D);
        float q = 0.f;
#pragma unroll
        for (int i = 0; i < 4; ++i) {
            v[i].x -= mean; v[i].y -= mean; v[i].z -= mean; v[i].w -= mean;
            q += v[i].x * v[i].x + v[i].y * v[i].y + v[i].z * v[i].z + v[i].w * v[i].w;
        }
        const float rstd = rsqrtf(wave_sum(q) * (1.f / D) + LN_EPS);
#pragma unroll
        for (int i = 0; i < 4; ++i) {
            const int col = (lane + 64 * i) * 4;
            const float4 g4 = *(const float4*)(p.ln2_g + col), b4 = *(const float4*)(p.ln2_b + col);
            float4 y;
            y.x = v[i].x * rstd * g4.x + b4.x; y.y = v[i].y * rstd * g4.y + b4.y;
            y.z = v[i].z * rstd * g4.z + b4.z; y.w = v[i].w * rstd * g4.w + b4.w;
            *(float4*)(p.out + (size_t)row * D + col) = y;
        }
    }
}

constexpr int LDS_BYTES = 2 * VB_LDS + 16;
constexpr int NPHASE = 13;

template <int PH>
__device__ __forceinline__ void run_phase(const Params& p, char* smem) {
    if (PH == 0) ph_mod(p, smem);
    if (PH == 1) ph_ln0(p);
    if (PH == 2) ph_inproj(p, smem);
    if (PH == 3) { ph_h1(p, smem); ph_attn(p, smem); }
    if (PH == 4) { ph_h2(p); ph_attn_merge(p); }
    if (PH == 5) ph_h3(p, smem);
    if (PH == 6) ph_outproj(p, smem);
    if (PH == 7) ph_ln1(p);
    if (PH == 8) ph_router_topk(p, smem);
    if (PH == 9) ph_lists(p, smem);
    if (PH == 10) ph_gateup(p, smem);
    if (PH == 11) ph_down(p, smem);
    if (PH == 12) ph_final(p);
}

template <int PH>
__global__ void __launch_bounds__(NTHREADS, 2) k_phase(Params p) {
    extern __shared__ __attribute__((aligned(16))) char smem[];
    run_phase<PH>(p, smem);
}

__global__ void __launch_bounds__(NTHREADS, 2) k_all(Params p) {
    extern __shared__ __attribute__((aligned(16))) char smem[];
    volatile LAS unsigned* st = (volatile LAS unsigned*)(smem + LDS_BYTES - 16);
    if (threadIdx.x == 0) { st[0] = 0u; st[1] = 0u; st[2] = 0u; st[3] = 0u; }
    __syncthreads();
    XcdBarrier bar = xcd_barrier_post(p.bar(), st);
    run_phase<0>(p, smem); xcd_barrier(bar);
    run_phase<1>(p, smem); xcd_barrier(bar);
    run_phase<2>(p, smem); xcd_barrier(bar);
    run_phase<3>(p, smem); xcd_barrier(bar);
    run_phase<4>(p, smem); xcd_barrier(bar);
    run_phase<5>(p, smem); xcd_barrier(bar);
    run_phase<6>(p, smem); xcd_barrier(bar);
    run_phase<7>(p, smem); xcd_barrier(bar);
    run_phase<8>(p, smem); xcd_barrier(bar);
    run_phase<9>(p, smem); xcd_barrier(bar);
    run_phase<10>(p, smem); xcd_barrier(bar);
    run_phase<11>(p, smem); xcd_barrier(bar);
    run_phase<12>(p, smem);
}

template <int PH>
static void launch_phase(const Params& p, int grid, hipStream_t stream) {
    static bool attr = false;
    if (!attr) { (void)hipFuncSetAttribute((const void*)k_phase<PH>, hipFuncAttributeMaxDynamicSharedMemorySize, LDS_BYTES); attr = true; }
    hipLaunchKernelGGL(k_phase<PH>, dim3(grid), dim3(NTHREADS), LDS_BYTES, stream, p);
}

extern "C" void kernel_launch(void* const* d_in, const int* in_sizes, int n_in, void* d_out, int out_size, void* d_ws, size_t ws_size,
                              hipStream_t stream) {
    (void)in_sizes; (void)n_in; (void)out_size;
    Params p{};
    const float** pin = (const float**)&p.x;
    for (int i = 0; i < 21; ++i) pin[i] = (const float*)d_in[i];
    p.out = (float*)d_out;
    p.ws = (char*)d_ws;
    char* ctl = p.ws + WO_ctl;
    if (WS_END > ws_size) { fprintf(stderr, "kernel_launch: workspace too small: need %zu have %zu\n", (size_t)WS_END, ws_size); return; }

    static int grid = 0;
    if (grid == 0) {
        int dev = 0, cus = 0, per_cu = 0;
        (void)hipGetDevice(&dev);
        (void)hipDeviceGetAttribute(&cus, hipDeviceAttributeMultiprocessorCount, dev);
        (void)hipFuncSetAttribute((const void*)k_all, hipFuncAttributeMaxDynamicSharedMemorySize, LDS_BYTES);
        (void)hipOccupancyMaxActiveBlocksPerMultiprocessor(&per_cu, (const void*)k_all, NTHREADS, LDS_BYTES);
        grid = cus;
        if (grid != 256) grid = 256;
        fprintf(stderr, "kernel_launch: cus %d per_cu %d grid %d ws need %zu have %zu\n", cus, per_cu, grid, (size_t)WS_END, ws_size);
    }
    (void)hipMemsetAsync(ctl, 0, 65536, stream);
#if ONE_LAUNCH
    hipLaunchKernelGGL(k_all, dim3(grid), dim3(NTHREADS), LDS_BYTES, stream, p);
#else
    launch_phase<0>(p, grid, stream); launch_phase<1>(p, grid, stream); launch_phase<2>(p, grid, stream); launch_phase<3>(p, grid, stream);
    launch_phase<4>(p, grid, stream); launch_phase<5>(p, grid, stream); launch_phase<6>(p, grid, stream); launch_phase<7>(p, grid, stream);
    launch_phase<8>(p, grid, stream); launch_phase<9>(p, grid, stream); launch_phase<10>(p, grid, stream); launch_phase<11>(p, grid, stream);
    launch_phase<12>(p, grid, stream);
#endif
}
```

```cpp
#include <hip/hip_runtime.h>
#include <stdint.h>
#include <stdio.h>

#ifndef ONE_LAUNCH
#define ONE_LAUNCH 1
#endif

constexpr int D = 1024, NBATCH = 4, S = 4096, T = NBATCH * S;
constexpr int INW = 4352;
constexpr int NE = 256, TOPK = 8, ED = 256;
constexpr int OFF_HQ = 0, OFF_HF = 512, OFF_HI = 1024, OFF_HG = 1536, OFF_AQ = 2048, OFF_AK = 2816, OFF_AV = 3584;
constexpr float ALPHA = 1.189207115002721f;
constexpr float LN_EPS = 1e-5f, RMS_EPS = 1e-6f;
constexpr int NTHREADS = 512;
constexpr int VB_LDS = 67584;

typedef unsigned short bf16_t;
using bf16x8 = __attribute__((ext_vector_type(8))) short;
using f32x4 = __attribute__((ext_vector_type(4))) float;
using u32x4 = __attribute__((ext_vector_type(4))) unsigned int;

typedef float v2f_t __attribute__((ext_vector_type(2)));
typedef __bf16 v2bf_t __attribute__((ext_vector_type(2)));
typedef short v4s __attribute__((ext_vector_type(4)));
typedef _Float16 v2h_t __attribute__((ext_vector_type(2)));
using f16x8 = __attribute__((ext_vector_type(8))) _Float16;
__device__ __forceinline__ uint32_t pack2h(float a, float b) { const v2f_t f = {a, b}; return __builtin_bit_cast(uint32_t, __builtin_convertvector(f, v2h_t)); }
__device__ __forceinline__ unsigned short f2bf(float f) { return __builtin_bit_cast(unsigned short, (__bf16)f); }
__device__ __forceinline__ float bf2f(unsigned short h) { return __uint_as_float(((uint32_t)h) << 16); }
__device__ __forceinline__ uint32_t pack2(float a, float b) {
    const v2f_t f = {a, b};
    return __builtin_bit_cast(uint32_t, __builtin_convertvector(f, v2bf_t));
}
__device__ __forceinline__ float sigmoidf_(float v) { return 1.f / (1.f + __expf(-v)); }

__device__ __forceinline__ int otid() { int t = threadIdx.x; asm volatile("" : "+v"(t)); return t; }

constexpr size_t al256(size_t x) { return (x + 255) & ~(size_t)255; }
constexpr size_t WO_ctl = 0;
constexpr size_t WO_mod = WO_ctl + al256(65536);
constexpr size_t WO_lbv = WO_mod + al256(4 * 6144 * 4);
constexpr size_t WO_biasT = WO_lbv + al256(512 * 4);
constexpr size_t WO_winT = WO_biasT + al256(3 * 129 * 4 * 4);
constexpr size_t WO_woutT = WO_winT + al256((size_t)INW * D * 2);
constexpr size_t WO_wrT = WO_woutT + al256((size_t)D * 768 * 2);
constexpr size_t WO_wsgT = WO_wrT + al256((size_t)2 * NE * D * 2);
constexpr size_t WO_wsuT = WO_wsgT + al256((size_t)ED * D * 2);
constexpr size_t WO_wsdT = WO_wsuT + al256((size_t)ED * D * 2);
constexpr size_t WO_h1 = WO_wsdT + al256((size_t)D * ED * 2);
constexpr size_t WO_proj = WO_h1 + al256((size_t)T * D * 2);
constexpr size_t WO_lgf = WO_proj + al256((size_t)T * INW * 2);
constexpr size_t WO_ao = WO_lgf + al256((size_t)T * 512 * 4);
constexpr size_t WO_alse = WO_ao + al256((size_t)3 * T * 256 * 4);
constexpr size_t WO_mixin = WO_alse + al256((size_t)3 * T * 4 * 4);
constexpr size_t WO_pre1 = WO_mixin + al256((size_t)T * 768 * 2);
constexpr size_t WO_x1 = WO_pre1 + al256((size_t)T * D * 4);
constexpr size_t WO_h2 = WO_x1 + al256((size_t)T * D * 2);
constexpr size_t WO_lgp = WO_h2 + al256((size_t)T * 2048 * 2);
constexpr size_t WO_topi = WO_lgp + al256((size_t)3 * T * NE * 4);
constexpr size_t WO_topw = WO_topi + al256((size_t)T * 8 * 4);
constexpr size_t WO_list = WO_topw + al256((size_t)T * 8 * 4);
constexpr size_t WO_gbuf = WO_list + al256((size_t)NE * T * 4);
constexpr size_t WO_gsh = WO_gbuf + al256((size_t)T * TOPK * ED * 2);
constexpr size_t WO_ybuf = WO_gsh + al256((size_t)T * ED * 2);
constexpr size_t WO_ysh = WO_ybuf + al256((size_t)T * 8 * D);
constexpr size_t WO_dec = WO_ysh + al256((size_t)T * D * 2);
constexpr size_t WS_END = WO_dec + al256((size_t)1024 * 128 * 4);
struct Params {
    const float *x, *c, *w_ada, *b_ada, *w_in, *hg_lb, *hg_nw, *rel_bias, *w_out, *ln1_g, *ln1_b, *w_router, *router_bias,
        *w_eg, *w_eu, *w_ed, *w_sg, *w_su, *w_sd, *ln2_g, *ln2_b;
    float* out;
    char* ws;
    __device__ __forceinline__ unsigned* bar() const { return (unsigned*)(ws + WO_ctl); }
    __device__ __forceinline__ int* cnt() const { return (int*)(ws + WO_ctl + 16384); }
    __device__ __forceinline__ bf16_t* kv() const { return (bf16_t*)(ws + WO_ybuf); }
    __device__ __forceinline__ bf16_t* sst() const { return (bf16_t*)(ws + WO_ybuf + (size_t)1024 * 16384 * 4); }
    __device__ __forceinline__ float* mod() const { return (float*)(ws + WO_mod); }
    __device__ __forceinline__ float* lbv() const { return (float*)(ws + WO_lbv); }
    __device__ __forceinline__ float* biasT() const { return (float*)(ws + WO_biasT); }
    __device__ __forceinline__ bf16_t* winT() const { return (bf16_t*)(ws + WO_winT); }
    __device__ __forceinline__ bf16_t* woutT() const { return (bf16_t*)(ws + WO_woutT); }
    __device__ __forceinline__ bf16_t* wrT() const { return (bf16_t*)(ws + WO_wrT); }
    __device__ __forceinline__ bf16_t* wsgT() const { return (bf16_t*)(ws + WO_wsgT); }
    __device__ __forceinline__ bf16_t* wsuT() const { return (bf16_t*)(ws + WO_wsuT); }
    __device__ __forceinline__ bf16_t* wsdT() const { return (bf16_t*)(ws + WO_wsdT); }
    __device__ __forceinline__ bf16_t* h1() const { return (bf16_t*)(ws + WO_h1); }
    __device__ __forceinline__ bf16_t* proj() const { return (bf16_t*)(ws + WO_proj); }
    __device__ __forceinline__ float* lgf() const { return (float*)(ws + WO_lgf); }
    __device__ __forceinline__ bf16_t* ao() const { return (bf16_t*)(ws + WO_ao); }
    __device__ __forceinline__ float* alse() const { return (float*)(ws + WO_alse); }
    __device__ __forceinline__ bf16_t* mixin() const { return (bf16_t*)(ws + WO_mixin); }
    __device__ __forceinline__ float* pre1() const { return (float*)(ws + WO_pre1); }
    __device__ __forceinline__ bf16_t* x1() const { return (bf16_t*)(ws + WO_x1); }
    __device__ __forceinline__ bf16_t* h2() const { return (bf16_t*)(ws + WO_h2); }
    __device__ __forceinline__ float* lgp() const { return (float*)(ws + WO_lgp); }
    __device__ __forceinline__ int* topi() const { return (int*)(ws + WO_topi); }
    __device__ __forceinline__ float* topw() const { return (float*)(ws + WO_topw); }
    __device__ __forceinline__ int* list() const { return (int*)(ws + WO_list); }
    __device__ __forceinline__ bf16_t* gbuf() const { return (bf16_t*)(ws + WO_gbuf); }
    __device__ __forceinline__ bf16_t* gsh() const { return (bf16_t*)(ws + WO_gsh); }
    __device__ __forceinline__ unsigned char* ybuf() const { return (unsigned char*)(ws + WO_ybuf); }
    __device__ __forceinline__ bf16_t* ysh() const { return (bf16_t*)(ws + WO_ysh); }
    __device__ __forceinline__ float* dec() const { return (float*)(ws + WO_dec); }
};

#define XB_TMO      128
#define XB_XCNT(j)  (256  + 64 * (j))
#define XB_XSUB(j)  (1280 + 64 * (j))
#define XB_XGEN(j)  (2304 + 64 * (j))
#define XB_TOP      3328
#define XB_TOPGEN   3392
#define XCD_BAR_WORDS 3456
#define XB_SPIN_CAP (1u << 18)
#define LAS __attribute__((address_space(3)))

__device__ __forceinline__ unsigned xb_ld(unsigned* p)              { return __hip_atomic_load(p, __ATOMIC_RELAXED, __HIP_MEMORY_SCOPE_AGENT); }
__device__ __forceinline__ unsigned xb_add(unsigned* p, unsigned v) { return __hip_atomic_fetch_add(p, v, __ATOMIC_RELAXED, __HIP_MEMORY_SCOPE_AGENT); }
__device__ __forceinline__ unsigned xb_xcc_id() { return (unsigned)__builtin_amdgcn_s_getreg((3 << 11) | 20) & 0xFu; }
#define XB_SPIN(cond, bar) do { unsigned _sp = 0; while (cond) { __builtin_amdgcn_s_sleep(1); \
    if ((++_sp & 255u) == 0u) { if (xb_ld(&(bar)[XB_TMO])) break; if (_sp > XB_SPIN_CAP) { atomicAdd(&(bar)[XB_TMO], 1u); break; } } } } while (0)

struct XcdBarrier {
    unsigned* bar; unsigned x;
    volatile LAS unsigned* st;
};
__device__ __forceinline__ XcdBarrier xcd_barrier_post(unsigned* bar, volatile LAS unsigned* st) {
    XcdBarrier b; b.bar = bar; b.x = xb_xcc_id(); b.st = st;
    if (threadIdx.x == 0) (void)xb_add(&bar[XB_XCNT(b.x)], 1u);
    return b;
}
__device__ __forceinline__ void xcd_barrier_complete(unsigned* bar, unsigned x, unsigned& nloc, unsigned& nx) {
    const unsigned G = gridDim.x * gridDim.y * gridDim.z;
    unsigned sum, cnt, mine, sp = 0u;
    for (;;) {
        sum = 0u; cnt = 0u; mine = 0u;
#pragma unroll
        for (unsigned j = 0; j < 16; ++j) { const unsigned c = xb_ld(&bar[XB_XCNT(j)]); sum += c; cnt += (c > 0u) ? 1u : 0u; mine = (j == x) ? c : mine; }
        if (sum == G) break;
        __builtin_amdgcn_s_sleep(1);
        if ((++sp & 255u) == 0u) { if (xb_ld(&bar[XB_TMO])) break; if (sp > XB_SPIN_CAP) { atomicAdd(&bar[XB_TMO], 1u); break; } }
    }
    nloc = mine > 0u ? mine : 1u; nx = cnt > 0u ? cnt : 1u;
}
__device__ __forceinline__ void xcd_barrier(const XcdBarrier& b) {
    asm volatile("s_waitcnt vmcnt(0)" ::: "memory");
    __syncthreads();
    if (threadIdx.x == 0) {
        unsigned* bar = b.bar;
        __builtin_amdgcn_s_waitcnt(0);
        unsigned nloc = b.st[0], nx = b.st[1];
        if (nloc == 0u) { xcd_barrier_complete(bar, b.x, nloc, nx); b.st[0] = nloc; b.st[1] = nx; }
        const unsigned old = xb_add(&bar[XB_XSUB(b.x)], 1u);
        const unsigned gen = old / nloc;
        if (old + 1u == (gen + 1u) * nloc) {
            __builtin_amdgcn_fence(__ATOMIC_RELEASE, "agent");
            asm volatile("s_waitcnt vmcnt(0)" ::: "memory");
            const unsigned og = xb_add(&bar[XB_TOP], 1u);
            const unsigned tg = og / nx;
            if (og + 1u == (tg + 1u) * nx) xb_add(&bar[XB_TOPGEN], 1u);
            else XB_SPIN(xb_ld(&bar[XB_TOPGEN]) == tg, bar);
            __builtin_amdgcn_fence(__ATOMIC_ACQUIRE, "agent");
            xb_add(&bar[XB_XGEN(b.x)], 1u);
            asm volatile("s_waitcnt vmcnt(0)" ::: "memory");
        } else {
            XB_SPIN(xb_ld(&bar[XB_XGEN(b.x)]) == gen, bar);
            __builtin_amdgcn_fence(__ATOMIC_ACQUIRE, "agent");
            asm volatile("s_waitcnt vmcnt(0)" ::: "memory");
        }
    }
    __syncthreads();
}

struct VB { int vb, nvb, tid; char* smem; };
__device__ __forceinline__ VB make_vb(char* smem) {
    const int t = otid();
    VB v; v.vb = (int)blockIdx.x * 2 + (t >> 8); v.nvb = (int)gridDim.x * 2; v.tid = t & 255; v.smem = smem + (t >> 8) * VB_LDS;
    return v;
}
__device__ __forceinline__ int swz(int row, int chunk) { return row * 128 + ((chunk ^ ((row >> 1) & 7)) << 4); }

__device__ __forceinline__ float wave_sum(float v) {
#pragma unroll
    for (int o = 32; o > 0; o >>= 1) v += __shfl_xor(v, o, 64);
    return v;
}

__device__ __forceinline__ int t5_bucket(int n) {
    if (n < 16) return n;
    const float v = logf((float)n / 16.f) / logf(128.f) * 16.f;
    int large = 16 + (int)v;
    return large < 31 ? large : 31;
}

__device__ __forceinline__ void tr_tile(const VB& v, const float* src, int ld, bf16_t* dst, bf16_t* dst2, int ldd, int k0, int n0) {
    float* t = (float*)v.smem;
    __syncthreads();
#pragma unroll
    for (int i = 0; i < 4; ++i) {
        const int r = (v.tid >> 4) + 16 * i, c4 = v.tid & 15;
        const f32x4 x = *(const f32x4*)(src + (size_t)(k0 + r) * ld + n0 + c4 * 4);
        t[r * 65 + c4 * 4 + 0] = x[0]; t[r * 65 + c4 * 4 + 1] = x[1]; t[r * 65 + c4 * 4 + 2] = x[2]; t[r * 65 + c4 * 4 + 3] = x[3];
    }
    __syncthreads();
    const int n = v.tid >> 2, kq = v.tid & 3;
    float f[16];
#pragma unroll
    for (int i = 0; i < 16; ++i) f[i] = t[(kq * 16 + i) * 65 + n];
    u32x4 a, b;
    a[0] = pack2(f[0], f[1]); a[1] = pack2(f[2], f[3]); a[2] = pack2(f[4], f[5]); a[3] = pack2(f[6], f[7]);
    b[0] = pack2(f[8], f[9]); b[1] = pack2(f[10], f[11]); b[2] = pack2(f[12], f[13]); b[3] = pack2(f[14], f[15]);
    bf16_t* d = dst + (size_t)(n0 + n) * ldd + k0 + kq * 16;
    *(u32x4*)d = a; *(u32x4*)(d + 8) = b;
    if (dst2) {
        u32x4 c, e;
#pragma unroll
        for (int i = 0; i < 4; ++i) { c[i] = pack2h(f[2 * i], f[2 * i + 1]); e[i] = pack2h(f[8 + 2 * i], f[8 + 2 * i + 1]); }
        bf16_t* d2 = dst2 + (size_t)(n0 + n) * ldd + k0 + kq * 16;
        *(u32x4*)d2 = c; *(u32x4*)(d2 + 8) = e;
    }
}

__device__ __forceinline__ void ph_mod(const Params& p, char* smem0) {
    const VB v = make_vb(smem0);
    const int tid = v.tid;
    float* cond = (float*)(v.smem + 20480);
    float* red = cond + 4096;
    for (int i = tid; i < 4096; i += 256) { const float x = p.c[i]; cond[i] = x / (1.f + __expf(-x)); }
    __syncthreads();
    const int NU = 194 + 1088 + 192 + 64 + 64 + 64 + 64;
    const int rounds = (NU + v.nvb - 1) / v.nvb;
    for (int it = 0; it < rounds; ++it) {
        int u = v.vb + it * v.nvb;
        if (u >= NU) u = NU - 1;
        if (u < 192) {
            const int c4 = tid & 7, kq = tid >> 3;
            f32x4 a0 = {0.f, 0.f, 0.f, 0.f}, a1 = a0, a2 = a0, a3 = a0;
            const float* wp = p.w_ada + u * 32 + c4 * 4;
#pragma unroll 8
            for (int k = kq; k < 1024; k += 32) {
                const f32x4 w = *(const f32x4*)(wp + (size_t)k * 6144);
                a0 += cond[k] * w; a1 += cond[1024 + k] * w; a2 += cond[2048 + k] * w; a3 += cond[3072 + k] * w;
            }
            *(f32x4*)(red + (kq * 4 + 0) * 32 + c4 * 4) = a0; *(f32x4*)(red + (kq * 4 + 1) * 32 + c4 * 4) = a1;
            *(f32x4*)(red + (kq * 4 + 2) * 32 + c4 * 4) = a2; *(f32x4*)(red + (kq * 4 + 3) * 32 + c4 * 4) = a3;
        }
        __syncthreads();
        if (u < 192) {
            if (tid < 128) {
                const int b = tid >> 5, c2 = tid & 31;
                float s = 0.f;
                for (int q = 0; q < 32; ++q) s += red[(q * 4 + b) * 32 + c2];
                p.mod()[b * 6144 + u * 32 + c2] = s + p.b_ada[u * 32 + c2];
            }
        } else if (u == 192) {
            for (int j = tid; j < 512; j += 256) {
                const float a = p.hg_lb[j], b = p.hg_lb[512 + j];
                const float m = fmaxf(a, b);
                const float ea = expf(a - m), eb = expf(b - m);
                p.lbv()[j] = ea / (ea + eb);
            }
        } else if (u == 193) {
            for (int i = tid; i < 3 * 129 * 4; i += 256) {
                const int g = i / (129 * 4), m = (i >> 2) % 129, hh = i & 3;
                const int dil = (g == 0) ? 1 : (g == 1 ? 4 : 16);
                p.biasT()[i] = p.rel_bias[t5_bucket(m * dil) * 12 + g * 4 + hh];
            }
        }
        {
            int w = u - 194;
            const float* src = p.w_out; int ld = D; bf16_t* dst = p.woutT(); bf16_t* dst2 = nullptr; int ldd = 768, k0 = 0, n0 = 0;
            if (w >= 0) {
                if (w < 1088) { src = p.w_in; ld = INW; dst = p.winT(); ldd = D; k0 = (w / 68) * 64; n0 = (w % 68) * 64; }
                else if ((w -= 1088) < 192) { k0 = (w >> 4) * 64; n0 = (w & 15) * 64; }
                else if ((w -= 192) < 64) { src = p.w_router; ld = NE; dst = p.wrT() + (size_t)NE * D; dst2 = p.wrT(); ldd = D; k0 = (w >> 2) * 64; n0 = (w & 3) * 64; }
                else if ((w -= 64) < 64) { src = p.w_sg; ld = ED; dst = p.wsgT(); ldd = D; k0 = (w >> 2) * 64; n0 = (w & 3) * 64; }
                else if ((w -= 64) < 64) { src = p.w_su; ld = ED; dst = p.wsuT(); ldd = D; k0 = (w >> 2) * 64; n0 = (w & 3) * 64; }
                else { w -= 64; src = p.w_sd; ld = D; dst = p.wsdT(); ldd = ED; k0 = (w >> 4) * 64; n0 = (w & 15) * 64; }
            }
            tr_tile(v, src, ld, dst, dst2, ldd, k0, n0);
        }
    }
}

__device__ __forceinline__ void ph_ln0(const Params& p) {
    const int tid = otid(), lane = tid & 63, wid = tid >> 6;
    const int rstride = gridDim.x * 8;
    float4 nv[4];
    {
        const float4* xr = (const float4*)(p.x + (size_t)(blockIdx.x * 8 + wid) * D);
#pragma unroll
        for (int i = 0; i < 4; ++i) nv[i] = xr[lane + 64 * i];
    }
    for (int row = blockIdx.x * 8 + wid; row < T; row += rstride) {
        float4 v[4];
        float s = 0.f;
#pragma unroll
        for (int i = 0; i < 4; ++i) { v[i] = nv[i]; s += v[i].x + v[i].y + v[i].z + v[i].w; }
        if (row + rstride < T) {
            const float4* xn = (const float4*)(p.x + (size_t)(row + rstride) * D);
#pragma unroll
            for (int i = 0; i < 4; ++i) nv[i] = xn[lane + 64 * i];
        }
        const float mean = wave_sum(s) * (1.f / D);
        float q = 0.f;
#pragma unroll
        for (int i = 0; i < 4; ++i) {
            v[i].x -= mean; v[i].y -= mean; v[i].z -= mean; v[i].w -= mean;
            q += v[i].x * v[i].x + v[i].y * v[i].y + v[i].z * v[i].z + v[i].w * v[i].w;
        }
        const float rstd = rsqrtf(wave_sum(q) * (1.f / D) + LN_EPS);
        const int b = row >> 12;
        const float* sh = p.mod() + b * 6144;
        const float* sc = sh + 1024;
#pragma unroll
        for (int i = 0; i < 4; ++i) {
            const int col = (lane + 64 * i) * 4;
            const float4 s4 = *(const float4*)(sc + col), h4 = *(const float4*)(sh + col);
            uint2 o;
            o.x = pack2(v[i].x * rstd * (1.f + s4.x) + h4.x, v[i].y * rstd * (1.f + s4.y) + h4.y);
            o.y = pack2(v[i].z * rstd * (1.f + s4.z) + h4.z, v[i].w * rstd * (1.f + s4.w) + h4.w);
            *(uint2*)(p.h1() + (size_t)row * D + col) = o;
        }
    }
}

__device__ __forceinline__ int swz16(int row, int chunk) { return row * 256 + ((chunk ^ (row & 15)) << 4); }
struct TrBase { int lo, hi; };
__device__ __forceinline__ TrBase tr16_base(int lane) {
    const int g = lane >> 4, q = (lane & 15) >> 2, pp = lane & 3;
    const int xl = 8 * (g & 1) + q, h = pp >> 1;
    TrBase t;
    t.lo = (8 * g + q) * 256 + ((xl >> 1) << 5) + ((h ^ (xl & 1)) << 4) + 8 * (pp & 1);
    t.hi = (t.lo + 1024) ^ 64;
    return t;
}
__device__ __forceinline__ bf16x8 tr_frag16(const char* tile, const TrBase& tb, int ks, int c) {
    int cx = c << 5;
    asm volatile("" : "+v"(cx));
    const v4s lo = __builtin_amdgcn_ds_read_tr16_b64_v4i16((LAS v4s*)(tile + ks * 8192 + (tb.lo ^ cx)));
    const v4s hi = __builtin_amdgcn_ds_read_tr16_b64_v4i16((LAS v4s*)(tile + ks * 8192 + (tb.hi ^ cx)));
    return bf16x8{lo[0], lo[1], lo[2], lo[3], hi[0], hi[1], hi[2], hi[3]};
}


__device__ __forceinline__ int aoff(int row, int chunk) { return row * 64 + ((chunk ^ ((row >> 2) & 3)) << 4); }
__device__ __forceinline__ int boff(int row, int chunk) { return row * 512 + ((chunk ^ (((row & 3) << 1) | (((row >> 3) & 1) << 3))) << 4); }
__device__ __forceinline__ bf16x8 tr_pair(const char* p) {
    const v4s lo = __builtin_amdgcn_ds_read_tr16_b64_v4i16((LAS v4s*)(p));
    const v4s hi = __builtin_amdgcn_ds_read_tr16_b64_v4i16((LAS v4s*)(p + 2048));
    return bf16x8{lo[0], lo[1], lo[2], lo[3], hi[0], hi[1], hi[2], hi[3]};
}
constexpr int G3_STAGE = 32768;

template <int BMODE, class AF, class BF>
__device__ __forceinline__ void gemm3(char* smem, const int K, AF arow, BF bsrc, const int ldb, f32x4 (&acc)[4][8], const int nvalid = 256) {
    const int tid = otid(), lane = tid & 63, wid = tid >> 6, wr = wid >> 1, wc = wid & 1, fr = lane & 15, fq = lane >> 4;
    const bf16_t* ap[2];
#pragma unroll
    for (int i = 0; i < 2; ++i) ap[i] = arow((tid >> 2) + 128 * i) + (tid & 3) * 8;
    const float* bpf = nullptr;
    const bf16_t* bpb[2] = {nullptr, nullptr};
    if (BMODE == 0) bpf = (const float*)bsrc((tid & 63) * 4) + (size_t)(tid >> 6) * ldb;
    else {
#pragma unroll
        for (int i = 0; i < 2; ++i) bpb[i] = (const bf16_t*)bsrc((tid >> 2) + 128 * i) + (tid & 3) * 8;
    }
#pragma unroll
    for (int m = 0; m < 4; ++m)
#pragma unroll
        for (int n = 0; n < 8; ++n) acc[m][n] = f32x4{0.f, 0.f, 0.f, 0.f};
    const int trbase = (8 * fq + (fr >> 2)) * 512 + wc * 256 + (((fr >> 2) | ((fq & 1) << 2)) << 5) + ((fr & 3) >> 1) * 16 + (fr & 1) * 8;
    u32x4 ra0[2], ra1[2];
    f32x4 rf0[4], rf1[4];
    u32x4 rb0[2], rb1[2];
    const bool active = wr * 64 < nvalid;
#define G3_GLOAD(RA, RF, RB, k0) do { \
        _Pragma("unroll") for (int i = 0; i < 2; ++i) RA[i] = *(const u32x4*)(ap[i] + (k0)); \
        if (BMODE == 0) { _Pragma("unroll") for (int j = 0; j < 4; ++j) RF[j] = *(const f32x4*)(bpf + (size_t)((k0) + 8 * j) * ldb); } \
        else { _Pragma("unroll") for (int i = 0; i < 2; ++i) RB[i] = *(const u32x4*)(bpb[i] + (k0)); } } while (0)
#define G3_LWRITE(RA, RF, RB, st) do { \
        char* sA_ = (st); char* sB_ = (st) + 16384; \
        _Pragma("unroll") for (int i = 0; i < 2; ++i) *(u32x4*)(sA_ + aoff((tid >> 2) + 128 * i, tid & 3)) = RA[i]; \
        if (BMODE == 0) { _Pragma("unroll") for (int j = 0; j < 4; ++j) { uint2 w_; w_.x = pack2(RF[j][0], RF[j][1]); w_.y = pack2(RF[j][2], RF[j][3]); \
                *(uint2*)(sB_ + boff((tid >> 6) + 8 * j, (tid & 63) >> 1) + (tid & 1) * 8) = w_; } } \
        else { _Pragma("unroll") for (int i = 0; i < 2; ++i) *(u32x4*)(sB_ + aoff((tid >> 2) + 128 * i, tid & 3)) = RB[i]; } } while (0)
#define G3_COMPUTE(st) do { if (active) { \
        const char* sA_ = (st); const char* sB_ = (st) + 16384; \
        bf16x8 af[4]; \
        _Pragma("unroll") for (int m = 0; m < 4; ++m) af[m] = *(const bf16x8*)(sA_ + aoff(wr * 64 + m * 16 + fr, fq)); \
        _Pragma("unroll") for (int n = 0; n < 8; ++n) { \
            bf16x8 bfr; \
            if (BMODE == 0) bfr = tr_pair(sB_ + (trbase ^ (n << 5))); else bfr = *(const bf16x8*)(sB_ + aoff(wc * 128 + n * 16 + fr, fq)); \
            _Pragma("unroll") for (int m = 0; m < 4; ++m) acc[m][n] = __builtin_amdgcn_mfma_f32_16x16x32_bf16(af[m], bfr, acc[m][n], 0, 0, 0); } } } while (0)
    const int nk = K >> 5;
    char* st0 = smem;
    char* st1 = smem + G3_STAGE;
    G3_GLOAD(ra0, rf0, rb0, 0);
    G3_GLOAD(ra1, rf1, rb1, 32);
    G3_LWRITE(ra0, rf0, rb0, st0);
    if (nk > 2) G3_GLOAD(ra0, rf0, rb0, 64);
    __syncthreads();
    for (int kt = 0; kt < nk; kt += 2) {
        G3_LWRITE(ra1, rf1, rb1, st1);
        if (kt + 3 < nk) G3_GLOAD(ra1, rf1, rb1, (kt + 3) * 32);
        G3_COMPUTE(st0);
        __syncthreads();
        if (kt + 2 < nk) G3_LWRITE(ra0, rf0, rb0, st0);
        if (kt + 4 < nk) G3_GLOAD(ra0, rf0, rb0, (kt + 4) * 32);
        G3_COMPUTE(st1);
        __syncthreads();
    }
#undef G3_GLOAD
#undef G3_LWRITE
#undef G3_COMPUTE
}

template <class AF, class BF>
__device__ __forceinline__ void gemm4(char* smem, const int K, AF arow, BF brow, f32x4 (&acc)[4][8]) {
    const int tid = otid(), lane = tid & 63, wid = tid >> 6, wr = wid >> 1, wc = wid & 1, fr = lane & 15, fq = lane >> 4;
    const bf16_t* ga[2];
    const bf16_t* gb[2];
#pragma unroll
    for (int i = 0; i < 2; ++i) {
        const int r = 16 * (wid + 8 * i) + (lane >> 2), sc = ((lane & 3) ^ ((r >> 2) & 3)) * 8;
        ga[i] = arow(r) + sc;
        gb[i] = brow(r) + sc;
    }
#pragma unroll
    for (int m = 0; m < 4; ++m)
#pragma unroll
        for (int n = 0; n < 8; ++n) acc[m][n] = f32x4{0.f, 0.f, 0.f, 0.f};
    char* ldst = smem + wid * 1024 + lane * 16;
#define G4_ISSUE(slot, k0) do { \
        char* d_ = ldst + (slot) * 32768; \
        __builtin_amdgcn_global_load_lds((const unsigned*)(ga[0] + (k0)), (LAS unsigned*)(d_), 16, 0, 0); \
        __builtin_amdgcn_global_load_lds((const unsigned*)(ga[1] + (k0)), (LAS unsigned*)(d_ + 8192), 16, 0, 0); \
        __builtin_amdgcn_global_load_lds((const unsigned*)(gb[0] + (k0)), (LAS unsigned*)(d_ + 16384), 16, 0, 0); \
        __builtin_amdgcn_global_load_lds((const unsigned*)(gb[1] + (k0)), (LAS unsigned*)(d_ + 16384 + 8192), 16, 0, 0); } while (0)
    const int nk = K >> 5;
    G4_ISSUE(0, 0);
    G4_ISSUE(1, 32);
    int slot = 0, slot2 = 2;
    for (int kt = 0; kt < nk; ++kt) {
        if (kt + 1 < nk) asm volatile("s_waitcnt vmcnt(4)" ::: "memory");
        else asm volatile("s_waitcnt vmcnt(0)" ::: "memory");
        __builtin_amdgcn_s_barrier();
        if (kt + 2 < nk) G4_ISSUE(slot2, (kt + 2) * 32);
        const char* sA_ = smem + slot * 32768;
        const char* sB_ = sA_ + 16384;
        bf16x8 af[4];
#pragma unroll
        for (int m = 0; m < 4; ++m) af[m] = *(const bf16x8*)(sA_ + aoff(wr * 64 + m * 16 + fr, fq));
#pragma unroll
        for (int n = 0; n < 8; ++n) {
            const bf16x8 bfr = *(const bf16x8*)(sB_ + aoff(wc * 128 + n * 16 + fr, fq));
#pragma unroll
            for (int m = 0; m < 4; ++m) acc[m][n] = __builtin_amdgcn_mfma_f32_16x16x32_bf16(af[m], bfr, acc[m][n], 0, 0, 0);
        }
        slot = (slot == 2) ? 0 : slot + 1;
        slot2 = (slot2 == 2) ? 0 : slot2 + 1;
    }
#undef G4_ISSUE
    __syncthreads();
}


constexpr int G5_B0 = 49152;
template <class AF, class BF>
__device__ __forceinline__ void gemm5(char* smem, const int K, AF arow, BF bsrc, const int ldb, f32x4 (&acc)[4][8]) {
    const int tid = otid(), lane = tid & 63, wid = tid >> 6, wr = wid >> 1, wc = wid & 1, fr = lane & 15, fq = lane >> 4;
    const bf16_t* ga[2];
#pragma unroll
    for (int i = 0; i < 2; ++i) {
        const int r = 16 * (wid + 8 * i) + (lane >> 2);
        ga[i] = arow(r) + (((lane & 3) ^ ((r >> 2) & 3)) * 8);
    }
    const float* bpf = (const float*)bsrc((tid & 63) * 4) + (size_t)(tid >> 6) * ldb;
#pragma unroll
    for (int m = 0; m < 4; ++m)
#pragma unroll
        for (int n = 0; n < 8; ++n) acc[m][n] = f32x4{0.f, 0.f, 0.f, 0.f};
    const int trbase = (8 * fq + (fr >> 2)) * 512 + wc * 256 + (((fr >> 2) | ((fq & 1) << 2)) << 5) + ((fr & 3) >> 1) * 16 + (fr & 1) * 8;
    char* ldst = smem + wid * 1024 + lane * 16;
    const unsigned lds0 = (unsigned)(size_t)smem;
    unsigned bwoff[4];
#pragma unroll
    for (int j = 0; j < 4; ++j) bwoff[j] = boff((tid >> 6) + 8 * j, (tid & 63) >> 1) + (tid & 1) * 8;
    f32x4 rf0[4], rf1[4];
    const int klast = K - 32;
#define G5_ADMA(slot, k0) do { \
        char* d_ = ldst + (slot) * 16384; \
        __builtin_amdgcn_global_load_lds((const unsigned*)(ga[0] + (k0)), (LAS unsigned*)(d_), 16, 0, 0); \
        __builtin_amdgcn_global_load_lds((const unsigned*)(ga[1] + (k0)), (LAS unsigned*)(d_ + 8192), 16, 0, 0); } while (0)
#define G5_BLOAD(RF, k0) do { const float* q0_ = bpf + (size_t)(k0) * ldb; const float* q1_ = q0_ + (size_t)8 * ldb; const float* q2_ = q0_ + (size_t)16 * ldb; const float* q3_ = q0_ + (size_t)24 * ldb; \
        asm volatile("global_load_dwordx4 %0, %4, off\n\tglobal_load_dwordx4 %1, %5, off\n\tglobal_load_dwordx4 %2, %6, off\n\tglobal_load_dwordx4 %3, %7, off" \
                     : "=&v"(RF[0]), "=&v"(RF[1]), "=&v"(RF[2]), "=&v"(RF[3]) : "v"(q0_), "v"(q1_), "v"(q2_), "v"(q3_) : "memory"); } while (0)
#define G5_BWAIT(RF, N) asm volatile("s_waitcnt vmcnt(" #N ")" : "+v"(RF[0]), "+v"(RF[1]), "+v"(RF[2]), "+v"(RF[3]) :: "memory")
#define G5_BWRITE(RF, st) do { const unsigned sB_ = lds0 + G5_B0 + (st) * 16384; \
        _Pragma("unroll") for (int j = 0; j < 4; ++j) { \
            const unsigned long long w_ = (unsigned long long)pack2(RF[j][0], RF[j][1]) | ((unsigned long long)pack2(RF[j][2], RF[j][3]) << 32); \
            asm volatile("ds_write_b64 %0, %1" :: "v"(sB_ + bwoff[j]), "v"(w_) : "memory"); } } while (0)
#define G5_TRB(n0) do { \
        _Pragma("unroll") for (int n = 0; n < 4; ++n) { const unsigned a_ = sBa_ + (unsigned)(trbase ^ (((n0) + n) << 5)); \
            asm volatile("ds_read_b64_tr_b16 %0, %2\n\tds_read_b64_tr_b16 %1, %2 offset:2048" : "=&v"(tl[n]), "=&v"(th[n]) : "v"(a_) : "memory"); } } while (0)
#define G5_TRW() asm volatile("s_waitcnt lgkmcnt(0)" : "+v"(tl[0]), "+v"(tl[1]), "+v"(tl[2]), "+v"(tl[3]), "+v"(th[0]), "+v"(th[1]), "+v"(th[2]), "+v"(th[3]) :: "memory")
#define G5_MM(n0) do { _Pragma("unroll") for (int n = 0; n < 4; ++n) { \
            const bf16x8 bfr = bf16x8{tl[n][0], tl[n][1], tl[n][2], tl[n][3], th[n][0], th[n][1], th[n][2], th[n][3]}; \
            _Pragma("unroll") for (int m = 0; m < 4; ++m) acc[m][(n0) + n] = __builtin_amdgcn_mfma_f32_16x16x32_bf16(af[m], bfr, acc[m][(n0) + n], 0, 0, 0); } } while (0)
#define G5_COMPUTE(aslot, bst) do { \
        const char* sA_ = smem + (aslot) * 16384; const unsigned sBa_ = lds0 + G5_B0 + (bst) * 16384; \
        v4s tl[4], th[4]; \
        G5_TRB(0); \
        bf16x8 af[4]; \
        _Pragma("unroll") for (int m = 0; m < 4; ++m) af[m] = *(const bf16x8*)(sA_ + aoff(wr * 64 + m * 16 + fr, fq)); \
        G5_TRW(); G5_MM(0); \
        G5_TRB(4); G5_TRW(); G5_MM(4); } while (0)
#define G5_KC(k) ((k) < klast ? (k) : klast)
    const int nk = K >> 5;
    G5_BLOAD(rf0, 0);
    G5_ADMA(0, 0);
    G5_BLOAD(rf1, 32);
    G5_BWAIT(rf0, 6);
    G5_BWRITE(rf0, 0);
    G5_ADMA(1, 32);
    G5_BLOAD(rf0, G5_KC(64));
    int as0 = 0, as2 = 2;
    for (int kt = 0; kt < nk; kt += 2) {
        asm volatile("s_waitcnt vmcnt(10) lgkmcnt(0)" ::: "memory");
        __builtin_amdgcn_s_barrier();
        G5_ADMA(as2, G5_KC((kt + 2) * 32));
        G5_BWAIT(rf1, 8);
        G5_BWRITE(rf1, 1);
        G5_BLOAD(rf1, G5_KC((kt + 3) * 32));
        G5_COMPUTE(as0, 0);
        as0 = (as0 == 2) ? 0 : as0 + 1; as2 = (as2 == 2) ? 0 : as2 + 1;
        asm volatile("s_waitcnt vmcnt(10) lgkmcnt(0)" ::: "memory");
        __builtin_amdgcn_s_barrier();
        G5_ADMA(as2, G5_KC((kt + 3) * 32));
        G5_BWAIT(rf0, 8);
        G5_BWRITE(rf0, 0);
        G5_BLOAD(rf0, G5_KC((kt + 4) * 32));
        G5_COMPUTE(as0, 1);
        as0 = (as0 == 2) ? 0 : as0 + 1; as2 = (as2 == 2) ? 0 : as2 + 1;
    }
    G5_BWAIT(rf0, 0);
    G5_BWAIT(rf1, 0);
    asm volatile("s_waitcnt lgkmcnt(0)" ::: "memory");
    __syncthreads();
#undef G5_ADMA
#undef G5_BLOAD
#undef G5_BWAIT
#undef G5_BWRITE
#undef G5_COMPUTE
#undef G5_TRB
#undef G5_TRW
#undef G5_MM
#undef G5_KC
}


template <class AF, class BF>
__device__ __forceinline__ void gemm6(char* smem, const int K, AF arow, BF brow, f32x4 (&acc)[4][8]) {
    const int tid = otid(), lane = tid & 63, wid = tid >> 6, wr = wid >> 1, wc = wid & 1, fr = lane & 15, fq = lane >> 4;
    const bf16_t* ga[4];
    const bf16_t* gb[4];
#pragma unroll
    for (int i = 0; i < 4; ++i) {
        const int r = 8 * (wid + 8 * i) + (lane >> 3), sc = ((lane & 7) ^ ((r >> 1) & 7)) * 8;
        ga[i] = arow(r) + sc;
        gb[i] = brow(r) + sc;
    }
#pragma unroll
    for (int m = 0; m < 4; ++m)
#pragma unroll
        for (int n = 0; n < 8; ++n) acc[m][n] = f32x4{0.f, 0.f, 0.f, 0.f};
    char* ldst = smem + wid * 1024 + lane * 16;
#define G6_ISSUE(slot, k0) do { char* d_ = ldst + (slot) * 65536; \
        _Pragma("unroll") for (int i_ = 0; i_ < 4; ++i_) { \
            __builtin_amdgcn_global_load_lds((const unsigned*)(ga[i_] + (k0)), (LAS unsigned*)(d_ + i_ * 8192), 16, 0, 0); \
            __builtin_amdgcn_global_load_lds((const unsigned*)(gb[i_] + (k0)), (LAS unsigned*)(d_ + 32768 + i_ * 8192), 16, 0, 0); } } while (0)
    const int nk = K >> 6;
    G6_ISSUE(0, 0);
    for (int kt = 0; kt < nk; ++kt) {
        asm volatile("s_waitcnt vmcnt(0)" ::: "memory");
        __builtin_amdgcn_s_barrier();
        if (kt + 1 < nk) G6_ISSUE((kt + 1) & 1, (kt + 1) * 64);
        const char* sA_ = smem + (kt & 1) * 65536;
        const char* sB_ = sA_ + 32768;
#pragma unroll
        for (int ks = 0; ks < 2; ++ks) {
            bf16x8 af[4];
#pragma unroll
            for (int m = 0; m < 4; ++m) af[m] = *(const bf16x8*)(sA_ + swz(wr * 64 + m * 16 + fr, ks * 4 + fq));
#pragma unroll
            for (int n = 0; n < 8; ++n) {
                const bf16x8 bfr = *(const bf16x8*)(sB_ + swz(wc * 128 + n * 16 + fr, ks * 4 + fq));
#pragma unroll
                for (int m = 0; m < 4; ++m) acc[m][n] = __builtin_amdgcn_mfma_f32_16x16x32_bf16(af[m], bfr, acc[m][n], 0, 0, 0);
            }
        }
    }
#undef G6_ISSUE
    __syncthreads();
}

constexpr int EPI_WAVE = 8704;
template <class VF, class SF>
__device__ __forceinline__ void epi_bf16(char* wl, const int lane, VF val, SF store) {
    const int fr = lane & 15, fq = lane >> 4, odd = lane & 1;
#pragma unroll
    for (int n = 0; n < 8; ++n)
#pragma unroll
        for (int jp = 0; jp < 2; ++jp) {
            const float a = val(n, 2 * jp), b = val(n, 2 * jp + 1);
            const float x = odd ? a : b;
            const float y = __shfl_xor(x, 1, 64);
            const uint32_t w = odd ? pack2(y, b) : pack2(a, y);
            *(uint32_t*)(wl + (fq * 4 + 2 * jp + odd) * 272 + (n * 16 + (fr & ~1)) * 2) = w;
        }
    int ln = lane;
    asm volatile("" : "+v"(ln));
#pragma unroll
    for (int i = 0; i < 4; ++i) {
        const int idx = ln + 64 * i, row = idx >> 4, ch = idx & 15;
        store(row, ch, *(const u32x4*)(wl + row * 272 + ch * 16));
    }
}
template <class VF, class SF>
__device__ __forceinline__ void epi_f32(char* wl, const int lane, VF val, SF store) {
    const int fr = lane & 15, fq = lane >> 4;
#pragma unroll
    for (int n = 0; n < 8; ++n)
#pragma unroll
        for (int j = 0; j < 4; ++j) *(float*)(wl + (fq * 4 + j) * 528 + (n * 16 + fr) * 4) = val(n, j);
    int ln = lane;
    asm volatile("" : "+v"(ln));
#pragma unroll
    for (int i = 0; i < 8; ++i) {
        const int idx = ln + 64 * i, row = idx >> 5, ch = idx & 31;
        store(row, ch, *(const f32x4*)(wl + row * 528 + ch * 16));
    }
}


constexpr float Y8_SCALE = 16.f;
template <class VF, class SF>
__device__ __forceinline__ void epi_fp8(char* wl, const int lane, VF val, SF store) {
    const int fr = lane & 15, fq = lane >> 4, odd = lane & 1;
#pragma unroll
    for (int n = 0; n < 8; ++n)
#pragma unroll
        for (int jp = 0; jp < 2; ++jp) {
            const float a = val(n, 2 * jp), b = val(n, 2 * jp + 1);
            const float x = odd ? a : b;
            const float y = __shfl_xor(x, 1, 64);
            const int w = odd ? __builtin_amdgcn_cvt_pk_fp8_f32(y, b, 0, false) : __builtin_amdgcn_cvt_pk_fp8_f32(a, y, 0, false);
            *(unsigned short*)(wl + (fq * 4 + 2 * jp + odd) * 144 + n * 16 + (fr & ~1)) = (unsigned short)w;
        }
    int ln = lane;
    asm volatile("" : "+v"(ln));
#pragma unroll
    for (int i = 0; i < 2; ++i) {
        const int idx = ln + 64 * i, row = idx >> 3, ch = idx & 7;
        store(row, ch, *(const u32x4*)(wl + row * 144 + ch * 16));
    }
}

__device__ __forceinline__ void ph_inproj(const Params& p, char* smem) {
    const int tid = otid(), lane = tid & 63, wid = tid >> 6, wr = wid >> 1, wc = wid & 1, fr = lane & 15;
    const int NTN = INW / 256;
    const int xcd = blockIdx.x & 7, nbx = gridDim.x >> 3;
    for (int i = blockIdx.x >> 3; i < 8 * NTN; i += nbx) {
        const int nt = i >> 3, mt = xcd * 8 + (i & 7);
        const bf16_t* A = p.h1() + (size_t)mt * 256 * D;
        const bf16_t* Bt = p.winT() + (size_t)nt * 256 * D;
        f32x4 acc[4][8];
        __syncthreads();
        gemm6(smem, D, [&](int r) { return A + (size_t)r * D; }, [&](int n) { return Bt + (size_t)n * D; }, acc);
        char* wl = smem + wid * EPI_WAVE;
        const int colb = nt * 256 + wc * 128;
        const int rowb = mt * 256 + wr * 64;
        if (colb >= OFF_HF && colb < OFF_HI) {
            float lbc[8];
#pragma unroll
            for (int n = 0; n < 8; ++n) lbc[n] = p.lbv()[colb - OFF_HF + n * 16 + fr];
#pragma unroll
            for (int m = 0; m < 4; ++m) {
                float* dst = p.lgf() + (size_t)(rowb + m * 16) * 512 + (colb - OFF_HF);
                epi_f32(wl, lane,
                        [&](int n, int j) { return __logf(lbc[n] + (1.f - lbc[n]) * (1.f / (1.f + __expf(-acc[m][n][j])))); },
                        [&](int row, int ch, f32x4 v) { *(f32x4*)(dst + (size_t)row * 512 + ch * 4) = v; });
            }
        } else {
#pragma unroll
            for (int m = 0; m < 4; ++m) {
                bf16_t* dst = p.proj() + (size_t)(rowb + m * 16) * INW + colb;
                epi_bf16(wl, lane, [&](int n, int j) { return acc[m][n][j]; },
                         [&](int row, int ch, u32x4 v) { *(u32x4*)(dst + (size_t)row * INW + ch * 8) = v; });
            }
        }
    }
}

__device__ __forceinline__ void ph_h1(const Params& p, char* smem0) {
    const VB vbk = make_vb(smem0);
    char* smem = vbk.smem;
    const int tid = vbk.tid, lane = tid & 63, wid = tid >> 6, wr = wid >> 1, wc = wid & 1, fr = lane & 15, fq = lane >> 4;
    char* sI = smem;
    char* sK = smem + 16384;
    float* sL = (float*)(smem + 32768);
    float* totS = (float*)(smem + 65536);
    const int d = tid & 127, half = tid >> 7;
    const TrBase trb = tr16_base(lane);
    for (int u = vbk.vb; u < 1024; u += vbk.nvb) {
        const int bh = u >> 6, c = u & 63, b = bh >> 2, h = bh & 3;
        const size_t row0 = (size_t)b * S + c * 64;
        __syncthreads();
#pragma unroll
        for (int i = 0; i < 4; ++i) {
            const int idx = tid + 256 * i, r = idx >> 4, ch = idx & 15;
            *(u32x4*)(sI + swz16(r, ch)) = *(const u32x4*)(p.proj() + (row0 + r) * INW + OFF_HI + h * 128 + ch * 8);
        }
#pragma unroll
        for (int i = 0; i < 8; ++i) {
            const int idx = tid + 256 * i, r = idx >> 5, c4 = idx & 31;
            *(f32x4*)(sL + r * 128 + c4 * 4) = *(const f32x4*)(p.lgf() + (row0 + r) * 512 + h * 128 + c4 * 4);
        }
        __syncthreads();
        const float* lcol = sL + half * 32 * 128 + d;
        float tot = 0.f;
#pragma unroll
        for (int s = 0; s < 32; ++s) tot += lcol[s * 128];
        totS[half * 128 + d] = tot;
        __syncthreads();
        const float t0 = totS[d], bl = t0 + totS[128 + d];
        float run = half ? t0 : 0.f;
#pragma unroll 8
        for (int s = 0; s < 32; ++s) {
            const float lv = lcol[s * 128];
            run += lv;
            const float kt = (1.f - __expf(lv)) * __expf(bl - run);
            *(bf16_t*)(sK + swz16(half * 32 + s, d >> 3) + (d & 7) * 2) = f2bf(kt);
        }
        if (half == 0) p.dec()[u * 128 + d] = __expf(bl);
        __syncthreads();
        f32x4 acc[4][4];
#pragma unroll
        for (int m = 0; m < 4; ++m)
#pragma unroll
            for (int n = 0; n < 4; ++n) acc[m][n] = f32x4{0.f, 0.f, 0.f, 0.f};
#pragma unroll
        for (int ks = 0; ks < 2; ++ks) {
            bf16x8 af[4], bfr[4];
#pragma unroll
            for (int m = 0; m < 4; ++m) af[m] = tr_frag16(sI, trb, ks, wr * 4 + m);
#pragma unroll
            for (int n = 0; n < 4; ++n) bfr[n] = tr_frag16(sK, trb, ks, wc * 4 + n);
#pragma unroll
            for (int m = 0; m < 4; ++m)
#pragma unroll
                for (int n = 0; n < 4; ++n) acc[m][n] = __builtin_amdgcn_mfma_f32_16x16x32_bf16(af[m], bfr[n], acc[m][n], 0, 0, 0);
        }
        __syncthreads();
        {
            int tz = tid;
            asm volatile("" : "+v"(tz));
            const int lz = tz & 63, odd = lz & 1;
            char* wbase = smem + ((tz >> 7) * 64 + (lz >> 4) * 4 + odd) * 272 + (((tz >> 6) & 1) * 64 + ((lz & 15) & ~1)) * 2;
#pragma unroll
            for (int m = 0; m < 4; ++m)
#pragma unroll
                for (int n = 0; n < 4; ++n)
#pragma unroll
                    for (int jp = 0; jp < 2; ++jp) {
                        const float a = acc[m][n][2 * jp], b2 = acc[m][n][2 * jp + 1];
                        const float x = odd ? a : b2;
                        const float y = __shfl_xor(x, 1, 64);
                        const uint32_t w = odd ? pack2(y, b2) : pack2(a, y);
                        *(uint32_t*)(wbase + (m * 16 + 2 * jp) * 272 + n * 32) = w;
                    }
            __syncthreads();
            bf16_t* kvu = p.kv() + (size_t)u * 16384;
            const int r0 = tz >> 4, ch = tz & 15;
#pragma unroll
            for (int i = 0; i < 8; ++i)
                *(u32x4*)(kvu + (r0 + 16 * i) * 128 + ch * 8) = *(const u32x4*)(smem + (r0 + 16 * i) * 272 + ch * 16);
        }
    }
}

__device__ __forceinline__ void ph_h2(const Params& p) {
    for (int it = blockIdx.x * NTHREADS + otid(); it < 16 * 8192; it += gridDim.x * NTHREADS) {
        const int bh = it >> 13, e2 = it & 8191, dv = e2 >> 6, dk = (e2 & 63) * 2;
        const size_t eoff = (size_t)dv * 128 + dk;
        float sx = 0.f, sy = 0.f;
#pragma unroll 8
        for (int c = 0; c < 64; ++c) {
            const size_t u = (size_t)bh * 64 + c;
            *(uint32_t*)(p.sst() + u * 16384 + eoff) = pack2(sx, sy);
            const uint32_t kvw = *(const uint32_t*)(p.kv() + u * 16384 + eoff);
            float2 kvv; kvv.x = __uint_as_float(kvw << 16); kvv.y = __uint_as_float(kvw & 0xffff0000u);
            const float2 dc = *(const float2*)(p.dec() + u * 128 + dk);
            sx = dc.x * sx + kvv.x; sy = dc.y * sy + kvv.y;
        }
    }
}

__device__ __forceinline__ void ph_h3(const Params& p, char* smem0) {
    const VB vbk = make_vb(smem0);
    char* smem = vbk.smem;
    const int tid = vbk.tid, lane = tid & 63, wid = tid >> 6, wr = wid >> 1, wc = wid & 1, fr = lane & 15, fq = lane >> 4;
    char* sQ = smem;
    char* sK = smem + 16384;
    char* sP = smem + 32768;
    float* sL = (float*)(smem + 32768);
    float* totS = (float*)(smem + 65536);
    char* sG = smem + 40960;
    const int d = tid & 127, half = tid >> 7;
    const TrBase trb = tr16_base(lane);
    for (int u = vbk.vb; u < 1024; u += vbk.nvb) {
        const int bh = u >> 6, c = u & 63, b = bh >> 2, h = bh & 3;
        const size_t row0 = (size_t)b * S + c * 64;
        __syncthreads();
#pragma unroll
        for (int i = 0; i < 4; ++i) {
            const int idx = tid + 256 * i, r = idx >> 4, ch = idx & 15;
            *(u32x4*)(sQ + swz16(r, ch)) = *(const u32x4*)(p.proj() + (row0 + r) * INW + OFF_HQ + h * 128 + ch * 8);
        }
#pragma unroll
        for (int i = 0; i < 8; ++i) {
            const int idx = tid + 256 * i, r = idx >> 5, c4 = idx & 31;
            *(f32x4*)(sL + r * 128 + c4 * 4) = *(const f32x4*)(p.lgf() + (row0 + r) * 512 + h * 128 + c4 * 4);
        }
        u32x4 sv0[4], sv1[4], iv[4], gv[4];
#pragma unroll
        for (int i = 0; i < 4; ++i) {
            const int r8 = (tid + 256 * i) >> 3;
            sv0[i] = *(const u32x4*)(p.sst() + (size_t)u * 16384 + r8 * 128 + (tid & 7) * 8);
            sv1[i] = *(const u32x4*)(p.sst() + (size_t)u * 16384 + r8 * 128 + 64 + (tid & 7) * 8);
            const int idx = tid + 256 * i, r = idx >> 4, c16 = idx & 15;
            iv[i] = *(const u32x4*)(p.proj() + (row0 + r) * INW + OFF_HI + h * 128 + c16 * 8);
            gv[i] = *(const u32x4*)(p.proj() + (row0 + r) * INW + OFF_HG + h * 128 + c16 * 8);
        }
        __syncthreads();
        const float* lcol = sL + half * 32 * 128 + d;
        float tot = 0.f;
#pragma unroll
        for (int s = 0; s < 32; ++s) tot += lcol[s * 128];
        totS[half * 128 + d] = tot;
        __syncthreads();
        const float t0 = totS[d];
        float run = half ? t0 : 0.f;
#pragma unroll 8
        for (int s = 0; s < 32; ++s) {
            const float lv = lcol[s * 128];
            run += lv;
            const int o = swz16(half * 32 + s, d >> 3) + (d & 7) * 2;
            const float qm = bf2f(*(const bf16_t*)(sQ + o)) * __expf(run - t0);
            const float kh = (1.f - __expf(lv)) * __expf(t0 - run);
            *(bf16_t*)(sQ + o) = f2bf(qm);
            *(bf16_t*)(sK + o) = f2bf(kh);
        }
        __syncthreads();
        {
            f32x4 pa[2][2];
#pragma unroll
            for (int m = 0; m < 2; ++m)
#pragma unroll
                for (int n = 0; n < 2; ++n) pa[m][n] = f32x4{0.f, 0.f, 0.f, 0.f};
#pragma unroll
            for (int ks = 0; ks < 4; ++ks) {
                bf16x8 af[2], bfr[2];
#pragma unroll
                for (int m = 0; m < 2; ++m) af[m] = *(const bf16x8*)(sQ + swz16(wr * 32 + m * 16 + fr, ks * 4 + fq));
#pragma unroll
                for (int n = 0; n < 2; ++n) bfr[n] = *(const bf16x8*)(sK + swz16(wc * 32 + n * 16 + fr, ks * 4 + fq));
#pragma unroll
                for (int m = 0; m < 2; ++m)
#pragma unroll
                    for (int n = 0; n < 2; ++n) pa[m][n] = __builtin_amdgcn_mfma_f32_16x16x32_bf16(af[m], bfr[n], pa[m][n], 0, 0, 0);
            }
#pragma unroll
            for (int m = 0; m < 2; ++m)
#pragma unroll
                for (int n = 0; n < 2; ++n)
#pragma unroll
                    for (int j = 0; j < 4; ++j) {
                        const int t = wr * 32 + m * 16 + fq * 4 + j, s_ = wc * 32 + n * 16 + fr;
                        const float v = (s_ <= t) ? pa[m][n][j] : 0.f;
                        *(bf16_t*)(sP + swz(t, s_ >> 3) + (s_ & 7) * 2) = f2bf(v);
                    }
        }
        __syncthreads();
        f32x4 oa[8];
#pragma unroll
        for (int i = 0; i < 4; ++i) { const int idx = tid + 256 * i; *(u32x4*)(sG + (idx >> 4) * 256 + (idx & 15) * 16) = gv[i]; }
#pragma unroll
        for (int n = 0; n < 8; ++n) oa[n] = f32x4{0.f, 0.f, 0.f, 0.f};
        const int ch = tid & 7;
#pragma unroll
        for (int sub = 0; sub < 2; ++sub) {
            float sc[8];
#pragma unroll
            for (int j = 0; j < 8; ++j) sc[j] = __expf(totS[sub * 64 + ch * 8 + j]);
#pragma unroll
            for (int i = 0; i < 4; ++i) {
                const int r = (tid + 256 * i) >> 3;
                const u32x4 v = sub ? sv1[i] : sv0[i];
                u32x4 w;
                w.x = pack2(__uint_as_float(v.x << 16) * sc[0], __uint_as_float(v.x & 0xffff0000u) * sc[1]);
                w.y = pack2(__uint_as_float(v.y << 16) * sc[2], __uint_as_float(v.y & 0xffff0000u) * sc[3]);
                w.z = pack2(__uint_as_float(v.z << 16) * sc[4], __uint_as_float(v.z & 0xffff0000u) * sc[5]);
                w.w = pack2(__uint_as_float(v.w << 16) * sc[6], __uint_as_float(v.w & 0xffff0000u) * sc[7]);
                *(u32x4*)(sK + swz(r, ch)) = w;
            }
            __syncthreads();
#pragma unroll
            for (int ks = 0; ks < 2; ++ks) {
                const bf16x8 af = *(const bf16x8*)(sQ + swz16(wid * 16 + fr, sub * 8 + ks * 4 + fq));
#pragma unroll
                for (int n = 0; n < 8; ++n) {
                    const bf16x8 bfr = *(const bf16x8*)(sK + swz(n * 16 + fr, ks * 4 + fq));
                    oa[n] = __builtin_amdgcn_mfma_f32_16x16x32_bf16(af, bfr, oa[n], 0, 0, 0);
                }
            }
            __syncthreads();
        }
#pragma unroll
        for (int i = 0; i < 4; ++i) {
            const int idx = tid + 256 * i, r = idx >> 4, c16 = idx & 15;
            *(u32x4*)(sK + swz16(r, c16)) = iv[i];
        }
        __syncthreads();
#pragma unroll
        for (int ks = 0; ks < 2; ++ks) {
            const bf16x8 af = *(const bf16x8*)(sP + swz(wid * 16 + fr, ks * 4 + fq));
#pragma unroll
            for (int n = 0; n < 8; ++n) {
                const bf16x8 bfr = tr_frag16(sK, trb, ks, n);
                oa[n] = __builtin_amdgcn_mfma_f32_16x16x32_bf16(af, bfr, oa[n], 0, 0, 0);
            }
        }
        float ss[4] = {0.f, 0.f, 0.f, 0.f};
#pragma unroll
        for (int n = 0; n < 8; ++n)
#pragma unroll
            for (int j = 0; j < 4; ++j) ss[j] += oa[n][j] * oa[n][j];
#pragma unroll
        for (int j = 0; j < 4; ++j) {
            ss[j] += __shfl_xor(ss[j], 1, 64); ss[j] += __shfl_xor(ss[j], 2, 64); ss[j] += __shfl_xor(ss[j], 4, 64); ss[j] += __shfl_xor(ss[j], 8, 64);
        }
        {
            int lz = lane;
            asm volatile("" : "+v"(lz));
            const int odd = lz & 1, fr = lz & 15, fq = lz >> 4;
            float rstd[4];
#pragma unroll
            for (int j = 0; j < 4; ++j) rstd[j] = rsqrtf(ss[j] * (1.f / 128.f) + RMS_EPS);
#pragma unroll
            for (int n = 0; n < 8; ++n) {
                const int dv = n * 16 + fr;
                const float nw = p.hg_nw[h * 128 + dv];
                float y[4];
#pragma unroll
                for (int j = 0; j < 4; ++j) {
                    const float g = bf2f(*(const bf16_t*)(sG + (wid * 16 + fq * 4 + j) * 256 + dv * 2));
                    y[j] = oa[n][j] * rstd[j] * nw * (g / (1.f + __expf(-g)));
                }
#pragma unroll
                for (int jp = 0; jp < 2; ++jp) {
                    const float a = y[2 * jp], b2 = y[2 * jp + 1];
                    const float x = odd ? a : b2;
                    const float z = __shfl_xor(x, 1, 64);
                    const size_t row = row0 + wid * 16 + fq * 4 + 2 * jp + odd;
                    *(uint32_t*)(p.mixin() + row * 768 + h * 128 + n * 16 + (fr & ~1)) = odd ? pack2(z, b2) : pack2(a, z);
                }
            }
        }
    }
}

__device__ __forceinline__ TrBase tr8_base(int lane) {
    const int g = lane >> 4, q = (lane & 15) >> 2, pp = lane & 3;
    const int xl = 4 * (g & 1) + (q >> 1), h = pp >> 1;
    TrBase t;
    t.lo = (8 * g + q) * 128 + ((xl >> 1) << 5) + ((h ^ (xl & 1)) << 4) + 8 * (pp & 1);
    t.hi = (t.lo + 512) ^ 32;
    return t;
}
__device__ __forceinline__ bf16x8 tr_frag8(const char* tile, const TrBase& tb, int ks, int c) {
    int cx = c << 5;
    asm volatile("" : "+v"(cx));
    const v4s lo = __builtin_amdgcn_ds_read_tr16_b64_v4i16((LAS v4s*)(tile + ks * 4096 + (tb.lo ^ cx)));
    const v4s hi = __builtin_amdgcn_ds_read_tr16_b64_v4i16((LAS v4s*)(tile + ks * 4096 + (tb.hi ^ cx)));
    return bf16x8{lo[0], lo[1], lo[2], lo[3], hi[0], hi[1], hi[2], hi[3]};
}

__device__ __forceinline__ void ph_attn(const Params& p, char* smem0) {
    const VB vbk = make_vb(smem0);
    char* smem = vbk.smem;
    const int tid = vbk.tid, lane = tid & 63, wid = tid >> 6, fr = lane & 15, fq = lane >> 4;
    char* sQ = smem;
    char* sK = smem + 8192;
    char* sP = sK;
    char* sV = smem + 33792;
    float* sBias = (float*)(smem + 58368);
    const TrBase trb = tr8_base(lane);
    for (int u = vbk.vb; u < 3072; u += vbk.nvb) {
        const int ti = u & 63, gq = u >> 6, g = gq % 3, bhh = gq / 3, hh = bhh & 3, b = bhh >> 2;
        const int lsh = (g == 0) ? 0 : (g == 1 ? 2 : 4), dl = 1 << lsh;
        const int tpr = (S >> lsh) >> 6;
        const int r = ti / tpr, j0 = (ti % tpr) * 64;
        const bf16_t* base = p.proj() + (size_t)b * S * INW + (g * 4 + hh) * 64;
        __syncthreads();
#pragma unroll
        for (int i = 0; i < 2; ++i) {
            const int idx = tid + 256 * i, row = idx >> 3, ch = idx & 7;
            const int tok = (j0 + row) * dl + r;
            *(u32x4*)(sQ + swz(row, ch)) = *(const u32x4*)(base + (size_t)tok * INW + OFF_AQ + ch * 8);
        }
#pragma unroll
        for (int i = 0; i < 6; ++i) {
            const int idx = tid + 256 * i, row = idx >> 3, ch = idx & 7;
            const int j = j0 - 128 + row;
            u32x4 kx = {0u, 0u, 0u, 0u}, vx = {0u, 0u, 0u, 0u};
            if (j >= 0) {
                const size_t o = (size_t)(j * dl + r) * INW + ch * 8;
                kx = *(const u32x4*)(base + o + OFF_AK);
                vx = *(const u32x4*)(base + o + OFF_AV);
            }
            *(u32x4*)(sK + swz(row, ch)) = kx;
            *(u32x4*)(sV + swz(row, ch)) = vx;
        }
        if (tid < 129) sBias[tid] = p.biasT()[(g * 129 + tid) * 4 + hh];
        __syncthreads();
        f32x4 sa[12];
#pragma unroll
        for (int n = 0; n < 12; ++n) sa[n] = f32x4{0.f, 0.f, 0.f, 0.f};
#pragma unroll
        for (int ks = 0; ks < 2; ++ks) {
            const bf16x8 af = *(const bf16x8*)(sQ + swz(wid * 16 + fr, ks * 4 + fq));
#pragma unroll
            for (int n = 0; n < 12; ++n) {
                const bf16x8 bfr = *(const bf16x8*)(sK + swz(n * 16 + fr, ks * 4 + fq));
                sa[n] = __builtin_amdgcn_mfma_f32_16x16x32_bf16(af, bfr, sa[n], 0, 0, 0);
            }
        }
        float mx[4] = {-INFINITY, -INFINITY, -INFINITY, -INFINITY};
#pragma unroll
        for (int n = 0; n < 12; ++n)
#pragma unroll
            for (int j = 0; j < 4; ++j) {
                const int jj = wid * 16 + fq * 4 + j, kk = n * 16 + fr, m = jj + 128 - kk;
                const bool valid = (m >= 0) && (m <= 128) && (j0 - 128 + kk >= 0);
                const int mc = m < 0 ? 0 : (m > 128 ? 128 : m);
                const float v = valid ? sa[n][j] * 0.125f + sBias[mc] : -INFINITY;
                sa[n][j] = v;
                mx[j] = fmaxf(mx[j], v);
            }
#pragma unroll
        for (int j = 0; j < 4; ++j) {
            mx[j] = fmaxf(mx[j], __shfl_xor(mx[j], 1, 64)); mx[j] = fmaxf(mx[j], __shfl_xor(mx[j], 2, 64));
            mx[j] = fmaxf(mx[j], __shfl_xor(mx[j], 4, 64)); mx[j] = fmaxf(mx[j], __shfl_xor(mx[j], 8, 64));
        }
        float ls[4] = {0.f, 0.f, 0.f, 0.f};
#pragma unroll
        for (int n = 0; n < 12; ++n)
#pragma unroll
            for (int j = 0; j < 4; ++j) { const float pe = __expf(sa[n][j] - mx[j]); sa[n][j] = pe; ls[j] += pe; }
#pragma unroll
        for (int j = 0; j < 4; ++j) {
            ls[j] += __shfl_xor(ls[j], 1, 64); ls[j] += __shfl_xor(ls[j], 2, 64); ls[j] += __shfl_xor(ls[j], 4, 64); ls[j] += __shfl_xor(ls[j], 8, 64);
        }
        __syncthreads();
#pragma unroll
        for (int n = 0; n < 12; ++n)
#pragma unroll
            for (int j = 0; j < 4; ++j) *(bf16_t*)(sP + (wid * 16 + fq * 4 + j) * 400 + (n * 16 + fr) * 2) = f2bf(sa[n][j]);
        f32x4 oa[4];
#pragma unroll
        for (int n = 0; n < 4; ++n) oa[n] = f32x4{0.f, 0.f, 0.f, 0.f};
#pragma unroll
        for (int ks = 0; ks < 6; ++ks) {
            const bf16x8 af = *(const bf16x8*)(sP + (wid * 16 + fr) * 400 + (ks * 4 + fq) * 16);
#pragma unroll
            for (int n = 0; n < 4; ++n) {
                const bf16x8 bfr = tr_frag8(sV, trb, ks, n);
                oa[n] = __builtin_amdgcn_mfma_f32_16x16x32_bf16(af, bfr, oa[n], 0, 0, 0);
            }
        }
        {
            int lz = lane;
            asm volatile("" : "+v"(lz));
            const int odd = lz & 1, fr = lz & 15, fq = lz >> 4;
            float inv[4];
#pragma unroll
            for (int j = 0; j < 4; ++j) inv[j] = 1.f / ls[j];
#pragma unroll
            for (int jp = 0; jp < 2; ++jp) {
                const int jj = wid * 16 + fq * 4 + 2 * jp + odd;
                const size_t row = (size_t)g * T + (size_t)b * S + (j0 + jj) * dl + r;
#pragma unroll
                for (int n = 0; n < 4; ++n) {
                    const float a = oa[n][2 * jp] * inv[2 * jp], b2 = oa[n][2 * jp + 1] * inv[2 * jp + 1];
                    const float x = odd ? a : b2;
                    const float y = __shfl_xor(x, 1, 64);
                    *(uint32_t*)(p.ao() + row * 256 + hh * 64 + n * 16 + (fr & ~1)) = odd ? pack2(y, b2) : pack2(a, y);
                }
            }
#pragma unroll
            for (int j = 0; j < 4; ++j) {
                const int jj = wid * 16 + fq * 4 + j;
                const size_t row = (size_t)g * T + (size_t)b * S + (j0 + jj) * dl + r;
                if (fr == 0) p.alse()[row * 4 + hh] = mx[j] + __logf(ls[j]);
            }
        }
    }
}

__device__ __forceinline__ void ph_attn_merge(const Params& p) {
    const int tid = otid(), lane = tid & 63, wid = tid >> 6;
    for (int row = blockIdx.x * 8 + wid; row < T; row += gridDim.x * 8) {
        const int hh = lane >> 4;
        const float l0 = p.alse()[((size_t)0 * T + row) * 4 + hh], l1 = p.alse()[((size_t)1 * T + row) * 4 + hh], l2 = p.alse()[((size_t)2 * T + row) * 4 + hh];
        const float mxl = fmaxf(l0, fmaxf(l1, l2));
        float e0 = __expf(l0 - mxl), e1 = __expf(l1 - mxl), e2 = __expf(l2 - mxl);
        const float inv = 1.f / (e0 + e1 + e2);
        e0 *= inv; e1 *= inv; e2 *= inv;
        f32x4 a0, a1, a2;
        {
            const uint2 w0 = *(const uint2*)(p.ao() + ((size_t)0 * T + row) * 256 + lane * 4);
            const uint2 w1 = *(const uint2*)(p.ao() + ((size_t)1 * T + row) * 256 + lane * 4);
            const uint2 w2 = *(const uint2*)(p.ao() + ((size_t)2 * T + row) * 256 + lane * 4);
            a0[0] = __uint_as_float(w0.x << 16); a0[1] = __uint_as_float(w0.x & 0xffff0000u); a0[2] = __uint_as_float(w0.y << 16); a0[3] = __uint_as_float(w0.y & 0xffff0000u);
            a1[0] = __uint_as_float(w1.x << 16); a1[1] = __uint_as_float(w1.x & 0xffff0000u); a1[2] = __uint_as_float(w1.y << 16); a1[3] = __uint_as_float(w1.y & 0xffff0000u);
            a2[0] = __uint_as_float(w2.x << 16); a2[1] = __uint_as_float(w2.x & 0xffff0000u); a2[2] = __uint_as_float(w2.y << 16); a2[3] = __uint_as_float(w2.y & 0xffff0000u);
        }
        uint2 o;
        o.x = pack2(a0[0] * e0 + a1[0] * e1 + a2[0] * e2, a0[1] * e0 + a1[1] * e1 + a2[1] * e2);
        o.y = pack2(a0[2] * e0 + a1[2] * e1 + a2[2] * e2, a0[3] * e0 + a1[3] * e1 + a2[3] * e2);
        *(uint2*)(p.mixin() + (size_t)row * 768 + 512 + lane * 4) = o;
    }
}

__device__ __forceinline__ void ph_outproj(const Params& p, char* smem) {
    const int tid = otid(), lane = tid & 63, wid = tid >> 6, wr = wid >> 1, wc = wid & 1;
    const int xcd = blockIdx.x & 7, nbx = gridDim.x >> 3;
    for (int i = blockIdx.x >> 3; i < 32; i += nbx) {
        const int nt = i >> 3, mt = xcd * 8 + (i & 7);
        const bf16_t* A = p.mixin() + (size_t)mt * 256 * 768;
        const bf16_t* Bt = p.woutT() + (size_t)nt * 256 * 768;
        f32x4 acc[4][8];
        __syncthreads();
        gemm6(smem, 768, [&](int r) { return A + (size_t)r * 768; }, [&](int n) { return Bt + (size_t)n * 768; }, acc);
        const int b = (mt * 256) >> 12;
        const int colb = nt * 256 + wc * 128;
        const float* g1 = p.mod() + b * 6144 + 2048 + colb;
        char* wl = smem + wid * EPI_WAVE;
#pragma unroll
        for (int m = 0; m < 4; ++m) {
            const size_t rbase = (size_t)(mt * 256 + wr * 64 + m * 16) * D + colb;
            epi_f32(wl, lane, [&](int n, int j) { return acc[m][n][j]; },
                    [&](int row, int ch, f32x4 v) {
                        const f32x4 xv = *(const f32x4*)(p.x + rbase + (size_t)row * D + ch * 4);
                        const f32x4 gv = *(const f32x4*)(g1 + ch * 4);
                        f32x4 o;
                        o[0] = ALPHA * xv[0] + gv[0] * v[0]; o[1] = ALPHA * xv[1] + gv[1] * v[1];
                        o[2] = ALPHA * xv[2] + gv[2] * v[2]; o[3] = ALPHA * xv[3] + gv[3] * v[3];
                        *(f32x4*)(p.pre1() + rbase + (size_t)row * D + ch * 4) = o;
                    });
        }
    }
}

__device__ __forceinline__ void ph_ln1(const Params& p) {
    const int tid = otid(), lane = tid & 63, wid = tid >> 6;
    const int rstride = gridDim.x * 8;
    float4 nv[4];
    {
        const float4* xr = (const float4*)(p.pre1() + (size_t)(blockIdx.x * 8 + wid) * D);
#pragma unroll
        for (int i = 0; i < 4; ++i) nv[i] = xr[lane + 64 * i];
    }
    for (int row = blockIdx.x * 8 + wid; row < T; row += rstride) {
        float4 v[4];
        float s = 0.f;
#pragma unroll
        for (int i = 0; i < 4; ++i) { v[i] = nv[i]; s += v[i].x + v[i].y + v[i].z + v[i].w; }
        if (row + rstride < T) {
            const float4* xn = (const float4*)(p.pre1() + (size_t)(row + rstride) * D);
#pragma unroll
            for (int i = 0; i < 4; ++i) nv[i] = xn[lane + 64 * i];
        }
        float mean = wave_sum(s) * (1.f / D);
        float q = 0.f;
#pragma unroll
        for (int i = 0; i < 4; ++i) {
            v[i].x -= mean; v[i].y -= mean; v[i].z -= mean; v[i].w -= mean;
            q += v[i].x * v[i].x + v[i].y * v[i].y + v[i].z * v[i].z + v[i].w * v[i].w;
        }
        float rstd = rsqrtf(wave_sum(q) * (1.f / D) + LN_EPS);
        s = 0.f;
#pragma unroll
        for (int i = 0; i < 4; ++i) {
            const int col = (lane + 64 * i) * 4;
            const float4 g4 = *(const float4*)(p.ln1_g + col), b4 = *(const float4*)(p.ln1_b + col);
            v[i].x = v[i].x * rstd * g4.x + b4.x; v[i].y = v[i].y * rstd * g4.y + b4.y;
            v[i].z = v[i].z * rstd * g4.z + b4.z; v[i].w = v[i].w * rstd * g4.w + b4.w;
            { uint2 xo; xo.x = pack2(v[i].x, v[i].y); xo.y = pack2(v[i].z, v[i].w); *(uint2*)(p.x1() + (size_t)row * D + col) = xo; }
            s += v[i].x + v[i].y + v[i].z + v[i].w;
        }
        mean = wave_sum(s) * (1.f / D);
        q = 0.f;
#pragma unroll
        for (int i = 0; i < 4; ++i) {
            v[i].x -= mean; v[i].y -= mean; v[i].z -= mean; v[i].w -= mean;
            q += v[i].x * v[i].x + v[i].y * v[i].y + v[i].z * v[i].z + v[i].w * v[i].w;
        }
        rstd = rsqrtf(wave_sum(q) * (1.f / D) + LN_EPS);
        const int b = row >> 12;
        const float* sh = p.mod() + b * 6144 + 3072;
        const float* sc = sh + 1024;
#pragma unroll
        for (int i = 0; i < 4; ++i) {
            const int col = (lane + 64 * i) * 4;
            const float4 s4 = *(const float4*)(sc + col), h4 = *(const float4*)(sh + col);
            float4 y;
            y.x = v[i].x * rstd * (1.f + s4.x) + h4.x; y.y = v[i].y * rstd * (1.f + s4.y) + h4.y;
            y.z = v[i].z * rstd * (1.f + s4.z) + h4.z; y.w = v[i].w * rstd * (1.f + s4.w) + h4.w;
            uint2 o;
            o.x = pack2(y.x, y.y); o.y = pack2(y.z, y.w);
            *(uint2*)(p.h2() + (size_t)row * 2048 + col) = o;
            uint2 o2;
            o2.x = pack2h(y.x, y.y);
            o2.y = pack2h(y.z, y.w);
            *(uint2*)(p.h2() + (size_t)row * 2048 + 1024 + col) = o2;
        }
    }
}


__device__ __forceinline__ void topk4_lds(const Params& p, const float* lg, const int tok0, const int lane) {
    constexpr int TK = 4;
        float sc[TK][4], bv[TK][4];
#pragma unroll
    for (int t = 0; t < TK; ++t)
#pragma unroll
        for (int j = 0; j < 4; ++j) {
            const int e = j * 64 + lane;
            const float x = lg[t * NE + e];
            sc[t][j] = 1.f / (1.f + expf(-x));
            bv[t][j] = sc[t][j] + p.router_bias[e];
        }
    float gsum[TK][4];
#pragma unroll
    for (int j = 0; j < 4; ++j) {
        float m1[TK], m2[TK];
#pragma unroll
        for (int t = 0; t < TK; ++t) m1[t] = bv[t][j];
#pragma unroll
        for (int o = 16; o > 0; o >>= 1)
#pragma unroll
            for (int t = 0; t < TK; ++t) m1[t] = fmaxf(m1[t], __shfl_xor(m1[t], o, 64));
#pragma unroll
        for (int t = 0; t < TK; ++t) {
            const unsigned long long bal = __ballot(bv[t][j] == m1[t]);
            const unsigned hm = (unsigned)(bal >> (lane & 32));
            const int first = __ffs(hm) - 1;
            m2[t] = ((lane & 31) == first) ? -INFINITY : bv[t][j];
        }
#pragma unroll
        for (int o = 16; o > 0; o >>= 1)
#pragma unroll
            for (int t = 0; t < TK; ++t) m2[t] = fmaxf(m2[t], __shfl_xor(m2[t], o, 64));
#pragma unroll
        for (int t = 0; t < TK; ++t) gsum[t][j] = m1[t] + m2[t];
    }
    float cand[TK][4];
#pragma unroll
    for (int t = 0; t < TK; ++t) {
        float gs[8];
#pragma unroll
        for (int j = 0; j < 4; ++j) { gs[2 * j] = __shfl(gsum[t][j], 0, 64); gs[2 * j + 1] = __shfl(gsum[t][j], 32, 64); }
        unsigned gmask = 0u;
#pragma unroll
        for (int r = 0; r < 4; ++r) {
            float best = -INFINITY; int bi = 0;
#pragma unroll
            for (int g = 0; g < 8; ++g) {
                const bool ok = (((gmask >> g) & 1u) == 0u) && (gs[g] > best);
                best = ok ? gs[g] : best; bi = ok ? g : bi;
            }
            gmask |= 1u << bi;
        }
#pragma unroll
        for (int j = 0; j < 4; ++j) cand[t][j] = ((gmask >> (2 * j + (lane >> 5))) & 1u) ? bv[t][j] : -INFINITY;
    }
    float wsum[TK], myw[TK];
    int mye[TK];
#pragma unroll
    for (int t = 0; t < TK; ++t) { wsum[t] = 0.f; myw[t] = 0.f; mye[t] = 0; }
#pragma unroll
    for (int r = 0; r < 8; ++r) {
        float bvv[TK]; int be[TK];
#pragma unroll
        for (int t = 0; t < TK; ++t) {
            bvv[t] = cand[t][0]; be[t] = lane;
#pragma unroll
            for (int j = 1; j < 4; ++j) { const bool gt = cand[t][j] > bvv[t]; bvv[t] = gt ? cand[t][j] : bvv[t]; be[t] = gt ? j * 64 + lane : be[t]; }
        }
#pragma unroll
        for (int o = 32; o > 0; o >>= 1)
#pragma unroll
            for (int t = 0; t < TK; ++t) {
                const float ov = __shfl_xor(bvv[t], o, 64);
                const int oe = __shfl_xor(be[t], o, 64);
                const bool take = (ov > bvv[t]) | ((ov == bvv[t]) & (oe < be[t])); bvv[t] = take ? ov : bvv[t]; be[t] = take ? oe : be[t];
            }
#pragma unroll
        for (int t = 0; t < TK; ++t) {
            const int bj = be[t] >> 6;
            const float mysc = bj == 0 ? sc[t][0] : (bj == 1 ? sc[t][1] : (bj == 2 ? sc[t][2] : sc[t][3]));
            const float sval = __shfl(mysc, be[t] & 63, 64);
#pragma unroll
            for (int j = 0; j < 4; ++j) cand[t][j] = (be[t] == j * 64 + lane) ? -INFINITY : cand[t][j];
            wsum[t] += sval;
            myw[t] = (lane == r) ? sval : myw[t]; mye[t] = (lane == r) ? be[t] : mye[t];
        }
    }
    if (lane < 8) {
#pragma unroll
        for (int t = 0; t < TK; ++t) {
            const int a = (tok0 + t) * 8 + lane;
            p.topi()[a] = mye[t];
            p.topw()[a] = myw[t] * (2.5f / wsum[t]);
        }
    }
}

__device__ __forceinline__ void ph_router_topk(const Params& p, char* smem) {
    const int tid = otid(), lane = tid & 63, wid = tid >> 6, fr = lane & 15, fq = lane >> 4;
    float* lgs = (float*)smem;
    for (int mt = blockIdx.x; mt < T / 64; mt += gridDim.x) {
        const bf16_t* A = p.h2() + (size_t)mt * 64 * 2048;
        const int ra = 8 * wid + (lane >> 3);
        const bf16_t* ga = A + (size_t)ra * 2048 + 1024 + (((lane & 7) ^ ((ra >> 1) & 7)) * 8);
        const bf16_t* gb[4];
#pragma unroll
        for (int i = 0; i < 4; ++i) {
            const int r = 8 * (wid + 8 * i) + (lane >> 3);
            gb[i] = p.wrT() + (size_t)r * D + (((lane & 7) ^ ((r >> 1) & 7)) * 8);
        }
        f32x4 acc[4][2];
#pragma unroll
        for (int m = 0; m < 4; ++m) { acc[m][0] = f32x4{0.f, 0.f, 0.f, 0.f}; acc[m][1] = f32x4{0.f, 0.f, 0.f, 0.f}; }
        char* ldA = smem + wid * 1024 + lane * 16;
        char* ldB = smem + 8192 + wid * 1024 + lane * 16;
#define RT_ISSUE(slot, kt_) do { const int ao_ = (kt_) * 64; const int bo_ = (kt_) * 64; \
        __builtin_amdgcn_global_load_lds((const unsigned*)(ga + ao_), (LAS unsigned*)(ldA + (slot) * 40960), 16, 0, 0); \
        _Pragma("unroll") for (int i_ = 0; i_ < 4; ++i_) \
            __builtin_amdgcn_global_load_lds((const unsigned*)(gb[i_] + bo_), (LAS unsigned*)(ldB + (slot) * 40960 + i_ * 8192), 16, 0, 0); } while (0)
        __syncthreads();
        RT_ISSUE(0, 0);
        RT_ISSUE(1, 1);
        int slot = 0, slot2 = 2;
#pragma clang loop unroll(disable)
        for (int kt = 0; kt < 16; ++kt) {
            if (kt + 1 < 16) asm volatile("s_waitcnt vmcnt(5)" ::: "memory");
            else asm volatile("s_waitcnt vmcnt(0)" ::: "memory");
            __builtin_amdgcn_s_barrier();
            if (kt + 2 < 16) RT_ISSUE(slot2, kt + 2);
            const char* sA_ = smem + slot * 40960;
            const char* sB_ = sA_ + 8192;
#pragma unroll
            for (int ks = 0; ks < 2; ++ks) {
                f16x8 af[4];
#pragma unroll
                for (int m = 0; m < 4; ++m) af[m] = *(const f16x8*)(sA_ + swz(m * 16 + fr, ks * 4 + fq));
#pragma unroll
                for (int n = 0; n < 2; ++n) {
                    const f16x8 bfr = *(const f16x8*)(sB_ + swz((2 * wid + n) * 16 + fr, ks * 4 + fq));
#pragma unroll
                    for (int m = 0; m < 4; ++m) acc[m][n] = __builtin_amdgcn_mfma_f32_16x16x32_f16(af[m], bfr, acc[m][n], 0, 0, 0);
                }
            }
            slot = (slot == 2) ? 0 : slot + 1;
            slot2 = (slot2 == 2) ? 0 : slot2 + 1;
        }
#undef RT_ISSUE
        __syncthreads();
#pragma unroll
        for (int m = 0; m < 4; ++m)
#pragma unroll
            for (int n = 0; n < 2; ++n)
#pragma unroll
                for (int j = 0; j < 4; ++j) lgs[(m * 16 + fq * 4 + j) * NE + (2 * wid + n) * 16 + fr] = acc[m][n][j];
        __syncthreads();
        topk4_lds(p, lgs + (wid * 8) * NE, mt * 64 + wid * 8, lane);
        topk4_lds(p, lgs + (wid * 8 + 4) * NE, mt * 64 + wid * 8 + 4, lane);
    }
}


__device__ __forceinline__ void ph_lists(const Params& p, char* smem) {
    const int tid = otid(), lane = tid & 63, wid = tid >> 6;
    int* wtot = (int*)smem;
    for (int e = blockIdx.x; e < NE; e += gridDim.x) {
        __syncthreads();
        const int4* src = (const int4*)p.topi() + wid * 4096;
        int cntw = 0;
        for (int i = 0; i < 64; ++i) {
            const int4 v = src[i * 64 + lane];
            cntw += __popcll(__ballot(v.x == e)) + __popcll(__ballot(v.y == e)) + __popcll(__ballot(v.z == e)) + __popcll(__ballot(v.w == e));
        }
        if (lane == 0) wtot[wid] = cntw;
        __syncthreads();
        int base = 0, tot = 0;
        for (int w = 0; w < 8; ++w) { const int c = wtot[w]; if (w < wid) base += c; tot += c; }
        if (tid == 0) p.cnt()[e] = tot;
        int* dst = p.list() + (size_t)e * T;
        const unsigned long long lt = (1ull << lane) - 1ull;
        for (int i = 0; i < 64; ++i) {
            const int4 v = src[i * 64 + lane];
            const int a0 = (wid * 4096 + i * 64 + lane) * 4;
            unsigned long long m;
            m = __ballot(v.x == e); if (v.x == e) dst[base + __popcll(m & lt)] = a0;     base += __popcll(m);
            m = __ballot(v.y == e); if (v.y == e) dst[base + __popcll(m & lt)] = a0 + 1; base += __popcll(m);
            m = __ballot(v.z == e); if (v.z == e) dst[base + __popcll(m & lt)] = a0 + 2; base += __popcll(m);
            m = __ballot(v.w == e); if (v.w == e) dst[base + __popcll(m & lt)] = a0 + 3; base += __popcll(m);
        }
    }
}

struct ExpMap { int* cnt; int* off; int* tile; };
__device__ __forceinline__ ExpMap exp_map(const Params& p, char* smem) {
    ExpMap m;
    m.cnt = (int*)(smem + 98304); m.off = m.cnt + 256; m.tile = m.off + 256;
    const int tid = otid();
    __syncthreads();
    if (tid < NE) m.cnt[tid] = p.cnt()[tid];
    __syncthreads();
    if (tid == 0) {
        int off = 0, tl = 0;
        for (int e = 0; e < NE; ++e) { m.off[e] = off; m.tile[e] = tl; const int c = m.cnt[e]; off += c; tl += (c + 255) >> 8; }
        m.tile[NE] = tl;
    }
    __syncthreads();
    return m;
}
__device__ __forceinline__ int find_expert(const int* tile, int rt) {
    int lo = 0, hi = NE;
    while (hi - lo > 1) { const int mid = (lo + hi) >> 1; if (tile[mid] <= rt) lo = mid; else hi = mid; }
    return lo;
}
#define ROWA(smem) ((int*)((smem) + 98304 + 3328))
#define ROWW(smem) ((float*)((smem) + 98304 + 3328 + 1024))

__device__ __forceinline__ void ph_gateup(const Params& p, char* smem) {
    const int tid = otid(), lane = tid & 63, wid = tid >> 6, wr = wid >> 1, wc = wid & 1;
    const ExpMap em = exp_map(p, smem);
    int* rowA = ROWA(smem);
    const int ntile = em.tile[NE];
    const int U = (ntile + T / 256) * 2;
    const int xcd = blockIdx.x & 7, nbx = gridDim.x >> 3;
    const int lo = (int)(((long long)U * xcd) >> 3), hi = (int)(((long long)U * (xcd + 1)) >> 3);
    for (int u = lo + (blockIdx.x >> 3); u < hi; u += nbx) {
        const int rt = u >> 1, c0 = (u & 1) * 128;
        const float *Wg, *Wu;
        bf16_t* gdst;
        int nrow, tokv = -1;
        if (rt < ntile) {
            const int e = find_expert(em.tile, rt);
            const int r0 = (rt - em.tile[e]) * 256, ne = em.cnt[e];
            Wg = p.w_eg + (size_t)e * D * ED; Wu = p.w_eu + (size_t)e * D * ED;
            gdst = p.gbuf() + ((size_t)em.off[e] + r0) * ED + c0;
            nrow = ne - r0;
            if (tid < 256 && r0 + tid < ne) tokv = p.list()[(size_t)e * T + r0 + tid] >> 3;
        } else {
            const int tb = (rt - ntile) * 256;
            Wg = p.w_sg; Wu = p.w_su;
            gdst = p.gsh() + (size_t)tb * ED + c0;
            nrow = 256;
            tokv = tb + (tid & 255);
        }
        __syncthreads();
        if (tid < 256) rowA[tid] = tokv;
        __syncthreads();
        const int t0 = rowA[0];
        f32x4 acc[4][8];
        gemm5(smem, D,
              [&](int r) { const int t = rowA[r]; return p.h2() + (size_t)(t < 0 ? t0 : t) * 2048; },
              [&](int n) { const int t16 = n >> 4; return ((t16 & 1) ? Wu : Wg) + c0 + 16 * (t16 >> 1) + (n & 15); },
              ED, acc);
        if (wr * 64 < nrow) {
            char* wl = smem + wid * EPI_WAVE;
#pragma unroll
            for (int m = 0; m < 4; ++m) {
                const int rb = wr * 64 + m * 16;
                epi_bf16(wl, lane,
                         [&](int n, int j) { if (n >= 4) return 0.f; const float g = acc[m][2 * n][j], uu = acc[m][2 * n + 1][j]; return g / (1.f + __expf(-g)) * uu; },
                         [&](int row, int ch, u32x4 v) { if (ch < 8 && rb + row < nrow) *(u32x4*)(gdst + (size_t)(rb + row) * ED + wc * 64 + ch * 8) = v; });
            }
        }
    }
}

__device__ __forceinline__ void ph_down(const Params& p, char* smem) {
    const int tid = otid(), lane = tid & 63, wid = tid >> 6, wr = wid >> 1, wc = wid & 1;
    const ExpMap em = exp_map(p, smem);
    int* rowA = ROWA(smem);
    float* rowW = ROWW(smem);
    const int ntile = em.tile[NE];
    const int U = (ntile + T / 256) * 4;
    const int xcd = blockIdx.x & 7, nbx = gridDim.x >> 3;
    const int lo = (int)(((long long)U * xcd) >> 3), hi = (int)(((long long)U * (xcd + 1)) >> 3);
    for (int u = lo + (blockIdx.x >> 3); u < hi; u += nbx) {
        const int rt = u >> 2, nt = u & 3;
        const bf16_t* A;
        const float* W;
        int nrow, slot = -1;
        float wv = 0.f;
        if (rt < ntile) {
            const int e = find_expert(em.tile, rt);
            const int r0 = (rt - em.tile[e]) * 256, ne = em.cnt[e];
            A = p.gbuf() + ((size_t)em.off[e] + r0) * ED;
            W = p.w_ed + (size_t)e * ED * D + nt * 256;
            nrow = ne - r0;
            if (tid < 256 && r0 + tid < ne) {
                const int a = p.list()[(size_t)e * T + r0 + tid];
                slot = a;
                wv = p.topw()[a] * Y8_SCALE;
            }
        } else {
            const int tb = (rt - ntile) * 256;
            A = p.gsh() + (size_t)tb * ED;
            W = p.w_sd + nt * 256;
            nrow = 256;
            slot = tb + (tid & 255);
            wv = 1.f;
        }
        __syncthreads();
        if (tid < 256) { rowA[tid] = slot; rowW[tid] = wv; }
        __syncthreads();
        f32x4 acc[4][8];
        gemm5(smem, ED, [&](int r) { return A + (size_t)(r < nrow ? r : 0) * ED; }, [&](int n) { return W + n; }, D, acc);
        if (wr * 64 < nrow) {
            char* wl = smem + wid * EPI_WAVE;
#pragma unroll
            for (int m = 0; m < 4; ++m) {
                const int rb = wr * 64 + m * 16;
                float wj[4];
#pragma unroll
                for (int j = 0; j < 4; ++j) wj[j] = rowW[rb + (lane >> 4) * 4 + j];
                if (rt < ntile) {
                    epi_fp8(wl, lane, [&](int n, int j) { return __builtin_amdgcn_fmed3f(acc[m][n][j] * wj[j], -440.f, 440.f); },
                            [&](int row, int ch, u32x4 v) {
                                const int sl = rowA[rb + row];
                                if (sl >= 0) *(u32x4*)(p.ybuf() + (size_t)sl * D + nt * 256 + wc * 128 + ch * 16) = v;
                            });
                } else {
                    epi_bf16(wl, lane, [&](int n, int j) { return acc[m][n][j]; },
                             [&](int row, int ch, u32x4 v) {
                                 const int sl = rowA[rb + row];
                                 *(u32x4*)(p.ysh() + (size_t)sl * D + nt * 256 + wc * 128 + ch * 8) = v;
                             });
                }
            }
        }
    }
}

__device__ __forceinline__ void ph_final(const Params& p) {
    const int tid = otid(), lane = tid & 63, wid = tid >> 6;
    for (int row = blockIdx.x * 8 + wid; row < T; row += gridDim.x * 8) {
        const int b = row >> 12;
        const float* g2 = p.mod() + b * 6144 + 5120;
        float4 v[4];
        float s = 0.f;
#pragma unroll
        for (int i = 0; i < 4; ++i) {
            const int col = (lane + 64 * i) * 4;
            float f0 = 0.f, f1 = 0.f, f2 = 0.f, f3 = 0.f;
#pragma unroll
            for (int k = 0; k < 8; ++k) {
                const int w8 = *(const int*)(p.ybuf() + ((size_t)row * 8 + k) * D + col);
                const v2f_t lo = __builtin_amdgcn_cvt_pk_f32_fp8(w8, false), hi = __builtin_amdgcn_cvt_pk_f32_fp8(w8, true);
                f0 += lo[0]; f1 += lo[1]; f2 += hi[0]; f3 += hi[1];
            }
            f0 *= (1.f / Y8_SCALE); f1 *= (1.f / Y8_SCALE); f2 *= (1.f / Y8_SCALE); f3 *= (1.f / Y8_SCALE);
            {
                const uint2 w = *(const uint2*)(p.ysh() + (size_t)row * D + col);
                f0 += __uint_as_float(w.x << 16); f1 += __uint_as_float(w.x & 0xffff0000u);
                f2 += __uint_as_float(w.y << 16); f3 += __uint_as_float(w.y & 0xffff0000u);
            }
            float4 xv;
            { const uint2 xw = *(const uint2*)(p.x1() + (size_t)row * D + col);
              xv.x = __uint_as_float(xw.x << 16); xv.y = __uint_as_float(xw.x & 0xffff0000u); xv.z = __uint_as_float(xw.y << 16); xv.w = __uint_as_float(xw.y & 0xffff0000u); }
            const float4 g4 = *(const float4*)(g2 + col);
            v[i].x = ALPHA * xv.x + g4.x * f0; v[i].y = ALPHA * xv.y + g4.y * f1;
            v[i].z = ALPHA * xv.z + g4.z * f2; v[i].w = ALPHA * xv.w + g4.w * f3;
            s += v[i].x + v[i].y + v[i].z + v[i].w;
        }
        const float mean = wave_sum(s) * (1.f / D);
        float q = 0.f;
#pragma unroll
        for (int i = 0; i < 4; ++i) {
            v[i].x -= mean; v[i].y -= mean; v[i].z -= mean; v[i].w -= mean;
            q += v[i].x * v[i].x + v[i].y * v[i].y + v[i].z * v[i].z + v[i].w * v[i].w;
        }
        const float rstd = rsqrtf(wave_sum(q) * (1.f / D) + LN_EPS);
#pragma unroll
        for (int i = 0; i < 4; ++i) {
            const int col = (lane + 64 * i) * 4;
            const float4 g4 = *(const float4*)(p.ln2_g + col), b4 = *(const float4*)(p.ln2_b + col);
            float4 y;
            y.x = v[i].x * rstd * g4.x + b4.x; y.y = v[i].y * rstd * g4.y + b4.y;
            y.z = v[i].z * rstd * g4.z + b4.z; y.w = v[i].w * rstd * g4.w + b4.w;
            *(float4*)(p.out + (size_t)row * D + col) = y;
        }
    }
}

constexpr int LDS_BYTES = 2 * VB_LDS + 16;
constexpr int NPHASE = 13;

template <int PH>
__device__ __forceinline__ void run_phase(const Params& p, char* smem) {
    if (PH == 0) ph_mod(p, smem);
    if (PH == 1) ph_ln0(p);
    if (PH == 2) ph_inproj(p, smem);
    if (PH == 3) { ph_h1(p, smem); ph_attn(p, smem); }
    if (PH == 4) { ph_h2(p); ph_attn_merge(p); }
    if (PH == 5) ph_h3(p, smem);
    if (PH == 6) ph_outproj(p, smem);
    if (PH == 7) ph_ln1(p);
    if (PH == 8) ph_router_topk(p, smem);
    if (PH == 9) ph_lists(p, smem);
    if (PH == 10) ph_gateup(p, smem);
    if (PH == 11) ph_down(p, smem);
    if (PH == 12) ph_final(p);
}

template <int PH>
__global__ void __launch_bounds__(NTHREADS, 2) k_phase(Params p) {
    extern __shared__ __attribute__((aligned(16))) char smem[];
    run_phase<PH>(p, smem);
}

__global__ void __launch_bounds__(NTHREADS, 2) k_all(Params p) {
    extern __shared__ __attribute__((aligned(16))) char smem[];
    volatile LAS unsigned* st = (volatile LAS unsigned*)(smem + LDS_BYTES - 16);
    if (threadIdx.x == 0) { st[0] = 0u; st[1] = 0u; st[2] = 0u; st[3] = 0u; }
    __syncthreads();
    XcdBarrier bar = xcd_barrier_post(p.bar(), st);
    run_phase<0>(p, smem); xcd_barrier(bar);
    run_phase<1>(p, smem); xcd_barrier(bar);
    run_phase<2>(p, smem); xcd_barrier(bar);
    run_phase<3>(p, smem); xcd_barrier(bar);
    run_phase<4>(p, smem); xcd_barrier(bar);
    run_phase<5>(p, smem); xcd_barrier(bar);
    run_phase<6>(p, smem); xcd_barrier(bar);
    run_phase<7>(p, smem); xcd_barrier(bar);
    run_phase<8>(p, smem); xcd_barrier(bar);
    run_phase<9>(p, smem); xcd_barrier(bar);
    run_phase<10>(p, smem); xcd_barrier(bar);
    run_phase<11>(p, smem); xcd_barrier(bar);
    run_phase<12>(p, smem);
}

template <int PH>
static void launch_phase(const Params& p, int grid, hipStream_t stream) {
    static bool attr = false;
    if (!attr) { (void)hipFuncSetAttribute((const void*)k_phase<PH>, hipFuncAttributeMaxDynamicSharedMemorySize, LDS_BYTES); attr = true; }
    hipLaunchKernelGGL(k_phase<PH>, dim3(grid), dim3(NTHREADS), LDS_BYTES, stream, p);
}

extern "C" void kernel_launch(void* const* d_in, const int* in_sizes, int n_in, void* d_out, int out_size, void* d_ws, size_t ws_size,
                              hipStream_t stream) {
    (void)in_sizes; (void)n_in; (void)out_size;
    Params p{};
    const float** pin = (const float**)&p.x;
    for (int i = 0; i < 21; ++i) pin[i] = (const float*)d_in[i];
    p.out = (float*)d_out;
    p.ws = (char*)d_ws;
    char* ctl = p.ws + WO_ctl;
    if (WS_END > ws_size) { fprintf(stderr, "kernel_launch: workspace too small: need %zu have %zu\n", (size_t)WS_END, ws_size); return; }

    static int grid = 0;
    if (grid == 0) {
        int dev = 0, cus = 0, per_cu = 0;
        (void)hipGetDevice(&dev);
        (void)hipDeviceGetAttribute(&cus, hipDeviceAttributeMultiprocessorCount, dev);
        (void)hipFuncSetAttribute((const void*)k_all, hipFuncAttributeMaxDynamicSharedMemorySize, LDS_BYTES);
        (void)hipOccupancyMaxActiveBlocksPerMultiprocessor(&per_cu, (const void*)k_all, NTHREADS, LDS_BYTES);
        grid = cus;
        if (grid != 256) grid = 256;
        fprintf(stderr, "kernel_launch: cus %d per_cu %d grid %d ws need %zu have %zu\n", cus, per_cu, grid, (size_t)WS_END, ws_size);
    }
    (void)hipMemsetAsync(ctl, 0, 65536, stream);
#if ONE_LAUNCH
    hipLaunchKernelGGL(k_all, dim3(grid), dim3(NTHREADS), LDS_BYTES, stream, p);
#else
    launch_phase<0>(p, grid, stream); launch_phase<1>(p, grid, stream); launch_phase<2>(p, grid, stream); launch_phase<3>(p, grid, stream);
    launch_phase<4>(p, grid, stream); launch_phase<5>(p, grid, stream); launch_phase<6>(p, grid, stream); launch_phase<7>(p, grid, stream);
    launch_phase<8>(p, grid, stream); launch_phase<9>(p, grid, stream); launch_phase<10>(p, grid, stream); launch_phase<11>(p, grid, stream);
    launch_phase<12>(p, grid, stream);
#endif
}
```

```cpp
#include <hip/hip_runtime.h>
#include <stdint.h>
#include <stdio.h>

#ifndef ONE_LAUNCH
#define ONE_LAUNCH 1
#endif

constexpr int D = 1024, NBATCH = 4, S = 4096, T = NBATCH * S;
constexpr int INW = 4352;
constexpr int NE = 256, TOPK = 8, ED = 256;
constexpr int OFF_HQ = 0, OFF_HF = 512, OFF_HI = 1024, OFF_HG = 1536, OFF_AQ = 2048, OFF_AK = 2816, OFF_AV = 3584;
constexpr float ALPHA = 1.189207115002721f;
constexpr float LN_EPS = 1e-5f, RMS_EPS = 1e-6f;
constexpr int NTHREADS = 512;
constexpr int VB_LDS = 67584;

typedef unsigned short bf16_t;
using bf16x8 = __attribute__((ext_vector_type(8))) short;
using f32x4 = __attribute__((ext_vector_type(4))) float;
using u32x4 = __attribute__((ext_vector_type(4))) unsigned int;

typedef float v2f_t __attribute__((ext_vector_type(2)));
typedef __bf16 v2bf_t __attribute__((ext_vector_type(2)));
typedef short v4s __attribute__((ext_vector_type(4)));
typedef _Float16 v2h_t __attribute__((ext_vector_type(2)));
using f16x8 = __attribute__((ext_vector_type(8))) _Float16;
__device__ __forceinline__ uint32_t pack2h(float a, float b) { const v2f_t f = {a, b}; return __builtin_bit_cast(uint32_t, __builtin_convertvector(f, v2h_t)); }
__device__ __forceinline__ unsigned short f2bf(float f) { return __builtin_bit_cast(unsigned short, (__bf16)f); }
__device__ __forceinline__ float bf2f(unsigned short h) { return __uint_as_float(((uint32_t)h) << 16); }
__device__ __forceinline__ uint32_t pack2(float a, float b) {
    const v2f_t f = {a, b};
    return __builtin_bit_cast(uint32_t, __builtin_convertvector(f, v2bf_t));
}
__device__ __forceinline__ float sigmoidf_(float v) { return 1.f / (1.f + __expf(-v)); }

__device__ __forceinline__ int otid() { int t = threadIdx.x; asm volatile("" : "+v"(t)); return t; }

constexpr size_t al256(size_t x) { return (x + 255) & ~(size_t)255; }
constexpr size_t WO_ctl = 0;
constexpr size_t WO_mod = WO_ctl + al256(65536);
constexpr size_t WO_lbv = WO_mod + al256(4 * 6144 * 4);
constexpr size_t WO_biasT = WO_lbv + al256(512 * 4);
constexpr size_t WO_winT = WO_biasT + al256(3 * 129 * 4 * 4);
constexpr size_t WO_woutT = WO_winT + al256((size_t)INW * D * 2);
constexpr size_t WO_wrT = WO_woutT + al256((size_t)D * 768 * 2);
constexpr size_t WO_wsgT = WO_wrT + al256((size_t)2 * NE * D * 2);
constexpr size_t WO_wsuT = WO_wsgT + al256((size_t)ED * D * 2);
constexpr size_t WO_wsdT = WO_wsuT + al256((size_t)ED * D * 2);
constexpr size_t WO_h1 = WO_wsdT + al256((size_t)D * ED * 2);
constexpr size_t WO_proj = WO_h1 + al256((size_t)T * D * 2);
constexpr size_t WO_lgf = WO_proj + al256((size_t)T * INW * 2);
constexpr size_t WO_ao = WO_lgf + al256((size_t)T * 512 * 4);
constexpr size_t WO_alse = WO_ao + al256((size_t)3 * T * 256 * 4);
constexpr size_t WO_mixin = WO_alse + al256((size_t)3 * T * 4 * 4);
constexpr size_t WO_pre1 = WO_mixin + al256((size_t)T * 768 * 2);
constexpr size_t WO_x1 = WO_pre1 + al256((size_t)T * D * 4);
constexpr size_t WO_h2 = WO_x1 + al256((size_t)T * D * 2);
constexpr size_t WO_lgp = WO_h2 + al256((size_t)T * 2048 * 2);
constexpr size_t WO_topi = WO_lgp + al256((size_t)3 * T * NE * 4);
constexpr size_t WO_topw = WO_topi + al256((size_t)T * 8 * 4);
constexpr size_t WO_list = WO_topw + al256((size_t)T * 8 * 4);
constexpr size_t WO_gbuf = WO_list + al256((size_t)NE * T * 4);
constexpr size_t WO_gsh = WO_gbuf + al256((size_t)T * TOPK * ED * 2);
constexpr size_t WO_ybuf = WO_gsh + al256((size_t)T * ED * 2);
constexpr size_t WO_ysh = WO_ybuf + al256((size_t)T * 8 * D);
constexpr size_t WO_dec = WO_ysh + al256((size_t)T * D * 2);
constexpr size_t WS_END = WO_dec + al256((size_t)1024 * 128 * 4);
struct Params {
    const float *x, *c, *w_ada, *b_ada, *w_in, *hg_lb, *hg_nw, *rel_bias, *w_out, *ln1_g, *ln1_b, *w_router, *router_bias,
        *w_eg, *w_eu, *w_ed, *w_sg, *w_su, *w_sd, *ln2_g, *ln2_b;
    float* out;
    char* ws;
    __device__ __forceinline__ unsigned* bar() const { return (unsigned*)(ws + WO_ctl); }
    __device__ __forceinline__ int* cnt() const { return (int*)(ws + WO_ctl + 16384); }
    __device__ __forceinline__ bf16_t* kv() const { return (bf16_t*)(ws + WO_ybuf); }
    __device__ __forceinline__ bf16_t* sst() const { return (bf16_t*)(ws + WO_ybuf + (size_t)1024 * 16384 * 4); }
    __device__ __forceinline__ float* mod() const { return (float*)(ws + WO_mod); }
    __device__ __forceinline__ float* lbv() const { return (float*)(ws + WO_lbv); }
    __device__ __forceinline__ float* biasT() const { return (float*)(ws + WO_biasT); }
    __device__ __forceinline__ bf16_t* winT() const { return (bf16_t*)(ws + WO_winT); }
    __device__ __forceinline__ bf16_t* woutT() const { return (bf16_t*)(ws + WO_woutT); }
    __device__ __forceinline__ bf16_t* wrT() const { return (bf16_t*)(ws + WO_wrT); }
    __device__ __forceinline__ bf16_t* wsgT() const { return (bf16_t*)(ws + WO_wsgT); }
    __device__ __forceinline__ bf16_t* wsuT() const { return (bf16_t*)(ws + WO_wsuT); }
    __device__ __forceinline__ bf16_t* wsdT() const { return (bf16_t*)(ws + WO_wsdT); }
    __device__ __forceinline__ bf16_t* h1() const { return (bf16_t*)(ws + WO_h1); }
    __device__ __forceinline__ bf16_t* proj() const { return (bf16_t*)(ws + WO_proj); }
    __device__ __forceinline__ float* lgf() const { return (float*)(ws + WO_lgf); }
    __device__ __forceinline__ bf16_t* ao() const { return (bf16_t*)(ws + WO_ao); }
    __device__ __forceinline__ float* alse() const { return (float*)(ws + WO_alse); }
    __device__ __forceinline__ bf16_t* mixin() const { return (bf16_t*)(ws + WO_mixin); }
    __device__ __forceinline__ float* pre1() const { return (float*)(ws + WO_pre1); }
    __device__ __forceinline__ bf16_t* x1() const { return (bf16_t*)(ws + WO_x1); }
    __device__ __forceinline__ bf16_t* h2() const { return (bf16_t*)(ws + WO_h2); }
    __device__ __forceinline__ float* lgp() const { return (float*)(ws + WO_lgp); }
    __device__ __forceinline__ unsigned char* topi() const { return (unsigned char*)(ws + WO_topi); }
    __device__ __forceinline__ float* topw() const { return (float*)(ws + WO_topw); }
    __device__ __forceinline__ int* list() const { return (int*)(ws + WO_list); }
    __device__ __forceinline__ bf16_t* gbuf() const { return (bf16_t*)(ws + WO_gbuf); }
    __device__ __forceinline__ bf16_t* gsh() const { return (bf16_t*)(ws + WO_gsh); }
    __device__ __forceinline__ unsigned char* ybuf() const { return (unsigned char*)(ws + WO_ybuf); }
    __device__ __forceinline__ bf16_t* ysh() const { return (bf16_t*)(ws + WO_ysh); }
    __device__ __forceinline__ float* dec() const { return (float*)(ws + WO_dec); }
};

#define XB_TMO      128
#define XB_XCNT(j)  (256  + 64 * (j))
#define XB_XSUB(j)  (1280 + 64 * (j))
#define XB_XGEN(j)  (2304 + 64 * (j))
#define XB_TOP      3328
#define XB_TOPGEN   3392
#define XCD_BAR_WORDS 3456
#define XB_SPIN_CAP (1u << 18)
#define LAS __attribute__((address_space(3)))

__device__ __forceinline__ unsigned xb_ld(unsigned* p)              { return __hip_atomic_load(p, __ATOMIC_RELAXED, __HIP_MEMORY_SCOPE_AGENT); }
__device__ __forceinline__ unsigned xb_add(unsigned* p, unsigned v) { return __hip_atomic_fetch_add(p, v, __ATOMIC_RELAXED, __HIP_MEMORY_SCOPE_AGENT); }
__device__ __forceinline__ unsigned xb_xcc_id() { return (unsigned)__builtin_amdgcn_s_getreg((3 << 11) | 20) & 0xFu; }
#define XB_SPIN(cond, bar) do { unsigned _sp = 0; while (cond) { __builtin_amdgcn_s_sleep(1); \
    if ((++_sp & 255u) == 0u) { if (xb_ld(&(bar)[XB_TMO])) break; if (_sp > XB_SPIN_CAP) { atomicAdd(&(bar)[XB_TMO], 1u); break; } } } } while (0)

struct XcdBarrier {
    unsigned* bar; unsigned x;
    volatile LAS unsigned* st;
};
__device__ __forceinline__ XcdBarrier xcd_barrier_post(unsigned* bar, volatile LAS unsigned* st) {
    XcdBarrier b; b.bar = bar; b.x = xb_xcc_id(); b.st = st;
    if (threadIdx.x == 0) (void)xb_add(&bar[XB_XCNT(b.x)], 1u);
    return b;
}
__device__ __forceinline__ void xcd_barrier_complete(unsigned* bar, unsigned x, unsigned& nloc, unsigned& nx) {
    const unsigned G = gridDim.x * gridDim.y * gridDim.z;
    unsigned sum, cnt, mine, sp = 0u;
    for (;;) {
        sum = 0u; cnt = 0u; mine = 0u;
#pragma unroll
        for (unsigned j = 0; j < 16; ++j) { const unsigned c = xb_ld(&bar[XB_XCNT(j)]); sum += c; cnt += (c > 0u) ? 1u : 0u; mine = (j == x) ? c : mine; }
        if (sum == G) break;
        __builtin_amdgcn_s_sleep(1);
        if ((++sp & 255u) == 0u) { if (xb_ld(&bar[XB_TMO])) break; if (sp > XB_SPIN_CAP) { atomicAdd(&bar[XB_TMO], 1u); break; } }
    }
    nloc = mine > 0u ? mine : 1u; nx = cnt > 0u ? cnt : 1u;
}
__device__ __forceinline__ void xcd_barrier(const XcdBarrier& b) {
    asm volatile("s_waitcnt vmcnt(0)" ::: "memory");
    __syncthreads();
    if (threadIdx.x == 0) {
        unsigned* bar = b.bar;
        __builtin_amdgcn_s_waitcnt(0);
        unsigned nloc = b.st[0], nx = b.st[1];
        if (nloc == 0u) { xcd_barrier_complete(bar, b.x, nloc, nx); b.st[0] = nloc; b.st[1] = nx; }
        const unsigned old = xb_add(&bar[XB_XSUB(b.x)], 1u);
        const unsigned gen = old / nloc;
        if (old + 1u == (gen + 1u) * nloc) {
            __builtin_amdgcn_fence(__ATOMIC_RELEASE, "agent");
            asm volatile("s_waitcnt vmcnt(0)" ::: "memory");
            const unsigned og = xb_add(&bar[XB_TOP], 1u);
            const unsigned tg = og / nx;
            if (og + 1u == (tg + 1u) * nx) xb_add(&bar[XB_TOPGEN], 1u);
            else XB_SPIN(xb_ld(&bar[XB_TOPGEN]) == tg, bar);
            __builtin_amdgcn_fence(__ATOMIC_ACQUIRE, "agent");
            xb_add(&bar[XB_XGEN(b.x)], 1u);
            asm volatile("s_waitcnt vmcnt(0)" ::: "memory");
        } else {
            XB_SPIN(xb_ld(&bar[XB_XGEN(b.x)]) == gen, bar);
            __builtin_amdgcn_fence(__ATOMIC_ACQUIRE, "agent");
            asm volatile("s_waitcnt vmcnt(0)" ::: "memory");
        }
    }
    __syncthreads();
}

struct VB { int vb, nvb, tid; char* smem; };
__device__ __forceinline__ VB make_vb(char* smem) {
    const int t = otid();
    VB v; v.vb = (int)blockIdx.x * 2 + (t >> 8); v.nvb = (int)gridDim.x * 2; v.tid = t & 255; v.smem = smem + (t >> 8) * VB_LDS;
    return v;
}
__device__ __forceinline__ int swz(int row, int chunk) { return row * 128 + ((chunk ^ ((row >> 1) & 7)) << 4); }

__device__ __forceinline__ float wave_sum(float v) {
#pragma unroll
    for (int o = 32; o > 0; o >>= 1) v += __shfl_xor(v, o, 64);
    return v;
}

__device__ __forceinline__ int t5_bucket(int n) {
    if (n < 16) return n;
    const float v = logf((float)n / 16.f) / logf(128.f) * 16.f;
    int large = 16 + (int)v;
    return large < 31 ? large : 31;
}

__device__ __forceinline__ void tr_tile(const VB& v, const float* src, int ld, bf16_t* dst, bf16_t* dst2, int ldd, int k0, int n0) {
    float* t = (float*)v.smem;
    __syncthreads();
#pragma unroll
    for (int i = 0; i < 4; ++i) {
        const int r = (v.tid >> 4) + 16 * i, c4 = v.tid & 15;
        const f32x4 x = *(const f32x4*)(src + (size_t)(k0 + r) * ld + n0 + c4 * 4);
        t[r * 65 + c4 * 4 + 0] = x[0]; t[r * 65 + c4 * 4 + 1] = x[1]; t[r * 65 + c4 * 4 + 2] = x[2]; t[r * 65 + c4 * 4 + 3] = x[3];
    }
    __syncthreads();
    const int n = v.tid >> 2, kq = v.tid & 3;
    float f[16];
#pragma unroll
    for (int i = 0; i < 16; ++i) f[i] = t[(kq * 16 + i) * 65 + n];
    u32x4 a, b;
    a[0] = pack2(f[0], f[1]); a[1] = pack2(f[2], f[3]); a[2] = pack2(f[4], f[5]); a[3] = pack2(f[6], f[7]);
    b[0] = pack2(f[8], f[9]); b[1] = pack2(f[10], f[11]); b[2] = pack2(f[12], f[13]); b[3] = pack2(f[14], f[15]);
    bf16_t* d = dst + (size_t)(n0 + n) * ldd + k0 + kq * 16;
    *(u32x4*)d = a; *(u32x4*)(d + 8) = b;
    if (dst2) {
        u32x4 c, e;
#pragma unroll
        for (int i = 0; i < 4; ++i) { c[i] = pack2h(f[2 * i], f[2 * i + 1]); e[i] = pack2h(f[8 + 2 * i], f[8 + 2 * i + 1]); }
        bf16_t* d2 = dst2 + (size_t)(n0 + n) * ldd + k0 + kq * 16;
        *(u32x4*)d2 = c; *(u32x4*)(d2 + 8) = e;
    }
}

__device__ __forceinline__ void ph_mod(const Params& p, char* smem0) {
    const VB v = make_vb(smem0);
    const int tid = v.tid;
    float* cond = (float*)(v.smem + 20480);
    float* red = cond + 4096;
    for (int i = tid; i < 4096; i += 256) { const float x = p.c[i]; cond[i] = x / (1.f + __expf(-x)); }
    __syncthreads();
    const int NU = 194 + 1088 + 192 + 64 + 64 + 64 + 64;
    const int rounds = (NU + v.nvb - 1) / v.nvb;
    for (int it = 0; it < rounds; ++it) {
        int u = v.vb + it * v.nvb;
        if (u >= NU) u = NU - 1;
        if (u < 192) {
            const int c4 = tid & 7, kq = tid >> 3;
            f32x4 a0 = {0.f, 0.f, 0.f, 0.f}, a1 = a0, a2 = a0, a3 = a0;
            const float* wp = p.w_ada + u * 32 + c4 * 4;
#pragma unroll 8
            for (int k = kq; k < 1024; k += 32) {
                const f32x4 w = *(const f32x4*)(wp + (size_t)k * 6144);
                a0 += cond[k] * w; a1 += cond[1024 + k] * w; a2 += cond[2048 + k] * w; a3 += cond[3072 + k] * w;
            }
            *(f32x4*)(red + (kq * 4 + 0) * 32 + c4 * 4) = a0; *(f32x4*)(red + (kq * 4 + 1) * 32 + c4 * 4) = a1;
            *(f32x4*)(red + (kq * 4 + 2) * 32 + c4 * 4) = a2; *(f32x4*)(red + (kq * 4 + 3) * 32 + c4 * 4) = a3;
        }
        __syncthreads();
        if (u < 192) {
            if (tid < 128) {
                const int b = tid >> 5, c2 = tid & 31;
                float s = 0.f;
                for (int q = 0; q < 32; ++q) s += red[(q * 4 + b) * 32 + c2];
                p.mod()[b * 6144 + u * 32 + c2] = s + p.b_ada[u * 32 + c2];
            }
        } else if (u == 192) {
            for (int j = tid; j < 512; j += 256) {
                const float a = p.hg_lb[j], b = p.hg_lb[512 + j];
                const float m = fmaxf(a, b);
                const float ea = expf(a - m), eb = expf(b - m);
                p.lbv()[j] = ea / (ea + eb);
            }
        } else if (u == 193) {
            for (int i = tid; i < 3 * 129 * 4; i += 256) {
                const int g = i / (129 * 4), m = (i >> 2) % 129, hh = i & 3;
                const int dil = (g == 0) ? 1 : (g == 1 ? 4 : 16);
                p.biasT()[i] = p.rel_bias[t5_bucket(m * dil) * 12 + g * 4 + hh];
            }
        }
        {
            int w = u - 194;
            const float* src = p.w_out; int ld = D; bf16_t* dst = p.woutT(); bf16_t* dst2 = nullptr; int ldd = 768, k0 = 0, n0 = 0;
            if (w >= 0) {
                if (w < 1088) { src = p.w_in; ld = INW; dst = p.winT(); ldd = D; k0 = (w / 68) * 64; n0 = (w % 68) * 64; }
                else if ((w -= 1088) < 192) { k0 = (w >> 4) * 64; n0 = (w & 15) * 64; }
                else if ((w -= 192) < 64) { src = p.w_router; ld = NE; dst = p.wrT() + (size_t)NE * D; dst2 = p.wrT(); ldd = D; k0 = (w >> 2) * 64; n0 = (w & 3) * 64; }
                else if ((w -= 64) < 64) { src = p.w_sg; ld = ED; dst = p.wsgT(); ldd = D; k0 = (w >> 2) * 64; n0 = (w & 3) * 64; }
                else if ((w -= 64) < 64) { src = p.w_su; ld = ED; dst = p.wsuT(); ldd = D; k0 = (w >> 2) * 64; n0 = (w & 3) * 64; }
                else { w -= 64; src = p.w_sd; ld = D; dst = p.wsdT(); ldd = ED; k0 = (w >> 4) * 64; n0 = (w & 15) * 64; }
            }
            tr_tile(v, src, ld, dst, dst2, ldd, k0, n0);
        }
    }
}

__device__ __forceinline__ void ph_ln0(const Params& p) {
    const int tid = otid(), lane = tid & 63, wid = tid >> 6;
    const int rstride = gridDim.x * 8;
    float4 nv[4];
    {
        const float4* xr = (const float4*)(p.x + (size_t)(blockIdx.x * 8 + wid) * D);
#pragma unroll
        for (int i = 0; i < 4; ++i) nv[i] = xr[lane + 64 * i];
    }
    for (int row = blockIdx.x * 8 + wid; row < T; row += rstride) {
        float4 v[4];
        float s = 0.f;
#pragma unroll
        for (int i = 0; i < 4; ++i) { v[i] = nv[i]; s += v[i].x + v[i].y + v[i].z + v[i].w; }
        if (row + rstride < T) {
            const float4* xn = (const float4*)(p.x + (size_t)(row + rstride) * D);
#pragma unroll
            for (int i = 0; i < 4; ++i) nv[i] = xn[lane + 64 * i];
        }
        const float mean = wave_sum(s) * (1.f / D);
        float q = 0.f;
#pragma unroll
        for (int i = 0; i < 4; ++i) {
            v[i].x -= mean; v[i].y -= mean; v[i].z -= mean; v[i].w -= mean;
            q += v[i].x * v[i].x + v[i].y * v[i].y + v[i].z * v[i].z + v[i].w * v[i].w;
        }
        const float rstd = rsqrtf(wave_sum(q) * (1.f / D) + LN_EPS);
        const int b = row >> 12;
        const float* sh = p.mod() + b * 6144;
        const float* sc = sh + 1024;
#pragma unroll
        for (int i = 0; i < 4; ++i) {
            const int col = (lane + 64 * i) * 4;
            const float4 s4 = *(const float4*)(sc + col), h4 = *(const float4*)(sh + col);
            uint2 o;
            o.x = pack2(v[i].x * rstd * (1.f + s4.x) + h4.x, v[i].y * rstd * (1.f + s4.y) + h4.y);
            o.y = pack2(v[i].z * rstd * (1.f + s4.z) + h4.z, v[i].w * rstd * (1.f + s4.w) + h4.w);
            *(uint2*)(p.h1() + (size_t)row * D + col) = o;
        }
    }
}

__device__ __forceinline__ int swz16(int row, int chunk) { return row * 256 + ((chunk ^ (row & 15)) << 4); }
struct TrBase { int lo, hi; };
__device__ __forceinline__ TrBase tr16_base(int lane) {
    const int g = lane >> 4, q = (lane & 15) >> 2, pp = lane & 3;
    const int xl = 8 * (g & 1) + q, h = pp >> 1;
    TrBase t;
    t.lo = (8 * g + q) * 256 + ((xl >> 1) << 5) + ((h ^ (xl & 1)) << 4) + 8 * (pp & 1);
    t.hi = (t.lo + 1024) ^ 64;
    return t;
}
__device__ __forceinline__ bf16x8 tr_frag16(const char* tile, const TrBase& tb, int ks, int c) {
    int cx = c << 5;
    asm volatile("" : "+v"(cx));
    const v4s lo = __builtin_amdgcn_ds_read_tr16_b64_v4i16((LAS v4s*)(tile + ks * 8192 + (tb.lo ^ cx)));
    const v4s hi = __builtin_amdgcn_ds_read_tr16_b64_v4i16((LAS v4s*)(tile + ks * 8192 + (tb.hi ^ cx)));
    return bf16x8{lo[0], lo[1], lo[2], lo[3], hi[0], hi[1], hi[2], hi[3]};
}


__device__ __forceinline__ int aoff(int row, int chunk) { return row * 64 + ((chunk ^ ((row >> 2) & 3)) << 4); }
__device__ __forceinline__ int boff(int row, int chunk) { return row * 512 + ((chunk ^ (((row & 3) << 1) | (((row >> 3) & 1) << 3))) << 4); }
__device__ __forceinline__ bf16x8 tr_pair(const char* p) {
    const v4s lo = __builtin_amdgcn_ds_read_tr16_b64_v4i16((LAS v4s*)(p));
    const v4s hi = __builtin_amdgcn_ds_read_tr16_b64_v4i16((LAS v4s*)(p + 2048));
    return bf16x8{lo[0], lo[1], lo[2], lo[3], hi[0], hi[1], hi[2], hi[3]};
}
constexpr int G3_STAGE = 32768;

template <int BMODE, class AF, class BF>
__device__ __forceinline__ void gemm3(char* smem, const int K, AF arow, BF bsrc, const int ldb, f32x4 (&acc)[4][8], const int nvalid = 256) {
    const int tid = otid(), lane = tid & 63, wid = tid >> 6, wr = wid >> 1, wc = wid & 1, fr = lane & 15, fq = lane >> 4;
    const bf16_t* ap[2];
#pragma unroll
    for (int i = 0; i < 2; ++i) ap[i] = arow((tid >> 2) + 128 * i) + (tid & 3) * 8;
    const float* bpf = nullptr;
    const bf16_t* bpb[2] = {nullptr, nullptr};
    if (BMODE == 0) bpf = (const float*)bsrc((tid & 63) * 4) + (size_t)(tid >> 6) * ldb;
    else {
#pragma unroll
        for (int i = 0; i < 2; ++i) bpb[i] = (const bf16_t*)bsrc((tid >> 2) + 128 * i) + (tid & 3) * 8;
    }
#pragma unroll
    for (int m = 0; m < 4; ++m)
#pragma unroll
        for (int n = 0; n < 8; ++n) acc[m][n] = f32x4{0.f, 0.f, 0.f, 0.f};
    const int trbase = (8 * fq + (fr >> 2)) * 512 + wc * 256 + (((fr >> 2) | ((fq & 1) << 2)) << 5) + ((fr & 3) >> 1) * 16 + (fr & 1) * 8;
    u32x4 ra0[2], ra1[2];
    f32x4 rf0[4], rf1[4];
    u32x4 rb0[2], rb1[2];
    const bool active = wr * 64 < nvalid;
#define G3_GLOAD(RA, RF, RB, k0) do { \
        _Pragma("unroll") for (int i = 0; i < 2; ++i) RA[i] = *(const u32x4*)(ap[i] + (k0)); \
        if (BMODE == 0) { _Pragma("unroll") for (int j = 0; j < 4; ++j) RF[j] = *(const f32x4*)(bpf + (size_t)((k0) + 8 * j) * ldb); } \
        else { _Pragma("unroll") for (int i = 0; i < 2; ++i) RB[i] = *(const u32x4*)(bpb[i] + (k0)); } } while (0)
#define G3_LWRITE(RA, RF, RB, st) do { \
        char* sA_ = (st); char* sB_ = (st) + 16384; \
        _Pragma("unroll") for (int i = 0; i < 2; ++i) *(u32x4*)(sA_ + aoff((tid >> 2) + 128 * i, tid & 3)) = RA[i]; \
        if (BMODE == 0) { _Pragma("unroll") for (int j = 0; j < 4; ++j) { uint2 w_; w_.x = pack2(RF[j][0], RF[j][1]); w_.y = pack2(RF[j][2], RF[j][3]); \
                *(uint2*)(sB_ + boff((tid >> 6) + 8 * j, (tid & 63) >> 1) + (tid & 1) * 8) = w_; } } \
        else { _Pragma("unroll") for (int i = 0; i < 2; ++i) *(u32x4*)(sB_ + aoff((tid >> 2) + 128 * i, tid & 3)) = RB[i]; } } while (0)
#define G3_COMPUTE(st) do { if (active) { \
        const char* sA_ = (st); const char* sB_ = (st) + 16384; \
        bf16x8 af[4]; \
        _Pragma("unroll") for (int m = 0; m < 4; ++m) af[m] = *(const bf16x8*)(sA_ + aoff(wr * 64 + m * 16 + fr, fq)); \
        _Pragma("unroll") for (int n = 0; n < 8; ++n) { \
            bf16x8 bfr; \
            if (BMODE == 0) bfr = tr_pair(sB_ + (trbase ^ (n << 5))); else bfr = *(const bf16x8*)(sB_ + aoff(wc * 128 + n * 16 + fr, fq)); \
            _Pragma("unroll") for (int m = 0; m < 4; ++m) acc[m][n] = __builtin_amdgcn_mfma_f32_16x16x32_bf16(af[m], bfr, acc[m][n], 0, 0, 0); } } } while (0)
    const int nk = K >> 5;
    char* st0 = smem;
    char* st1 = smem + G3_STAGE;
    G3_GLOAD(ra0, rf0, rb0, 0);
    G3_GLOAD(ra1, rf1, rb1, 32);
    G3_LWRITE(ra0, rf0, rb0, st0);
    if (nk > 2) G3_GLOAD(ra0, rf0, rb0, 64);
    __syncthreads();
    for (int kt = 0; kt < nk; kt += 2) {
        G3_LWRITE(ra1, rf1, rb1, st1);
        if (kt + 3 < nk) G3_GLOAD(ra1, rf1, rb1, (kt + 3) * 32);
        G3_COMPUTE(st0);
        __syncthreads();
        if (kt + 2 < nk) G3_LWRITE(ra0, rf0, rb0, st0);
        if (kt + 4 < nk) G3_GLOAD(ra0, rf0, rb0, (kt + 4) * 32);
        G3_COMPUTE(st1);
        __syncthreads();
    }
#undef G3_GLOAD
#undef G3_LWRITE
#undef G3_COMPUTE
}

template <class AF, class BF>
__device__ __forceinline__ void gemm4(char* smem, const int K, AF arow, BF brow, f32x4 (&acc)[4][8]) {
    const int tid = otid(), lane = tid & 63, wid = tid >> 6, wr = wid >> 1, wc = wid & 1, fr = lane & 15, fq = lane >> 4;
    const bf16_t* ga[2];
    const bf16_t* gb[2];
#pragma unroll
    for (int i = 0; i < 2; ++i) {
        const int r = 16 * (wid + 8 * i) + (lane >> 2), sc = ((lane & 3) ^ ((r >> 2) & 3)) * 8;
        ga[i] = arow(r) + sc;
        gb[i] = brow(r) + sc;
    }
#pragma unroll
    for (int m = 0; m < 4; ++m)
#pragma unroll
        for (int n = 0; n < 8; ++n) acc[m][n] = f32x4{0.f, 0.f, 0.f, 0.f};
    char* ldst = smem + wid * 1024 + lane * 16;
#define G4_ISSUE(slot, k0) do { \
        char* d_ = ldst + (slot) * 32768; \
        __builtin_amdgcn_global_load_lds((const unsigned*)(ga[0] + (k0)), (LAS unsigned*)(d_), 16, 0, 0); \
        __builtin_amdgcn_global_load_lds((const unsigned*)(ga[1] + (k0)), (LAS unsigned*)(d_ + 8192), 16, 0, 0); \
        __builtin_amdgcn_global_load_lds((const unsigned*)(gb[0] + (k0)), (LAS unsigned*)(d_ + 16384), 16, 0, 0); \
        __builtin_amdgcn_global_load_lds((const unsigned*)(gb[1] + (k0)), (LAS unsigned*)(d_ + 16384 + 8192), 16, 0, 0); } while (0)
    const int nk = K >> 5;
    G4_ISSUE(0, 0);
    G4_ISSUE(1, 32);
    int slot = 0, slot2 = 2;
    for (int kt = 0; kt < nk; ++kt) {
        if (kt + 1 < nk) asm volatile("s_waitcnt vmcnt(4)" ::: "memory");
        else asm volatile("s_waitcnt vmcnt(0)" ::: "memory");
        __builtin_amdgcn_s_barrier();
        if (kt + 2 < nk) G4_ISSUE(slot2, (kt + 2) * 32);
        const char* sA_ = smem + slot * 32768;
        const char* sB_ = sA_ + 16384;
        bf16x8 af[4];
#pragma unroll
        for (int m = 0; m < 4; ++m) af[m] = *(const bf16x8*)(sA_ + aoff(wr * 64 + m * 16 + fr, fq));
#pragma unroll
        for (int n = 0; n < 8; ++n) {
            const bf16x8 bfr = *(const bf16x8*)(sB_ + aoff(wc * 128 + n * 16 + fr, fq));
#pragma unroll
            for (int m = 0; m < 4; ++m) acc[m][n] = __builtin_amdgcn_mfma_f32_16x16x32_bf16(af[m], bfr, acc[m][n], 0, 0, 0);
        }
        slot = (slot == 2) ? 0 : slot + 1;
        slot2 = (slot2 == 2) ? 0 : slot2 + 1;
    }
#undef G4_ISSUE
    __syncthreads();
}


constexpr int G5_B0 = 49152;
template <class AF, class BF>
__device__ __forceinline__ void gemm5(char* smem, const int K, AF arow, BF bsrc, const int ldb, f32x4 (&acc)[4][8]) {
    const int tid = otid(), lane = tid & 63, wid = tid >> 6, wr = wid >> 1, wc = wid & 1, fr = lane & 15, fq = lane >> 4;
    const bf16_t* ga[2];
#pragma unroll
    for (int i = 0; i < 2; ++i) {
        const int r = 16 * (wid + 8 * i) + (lane >> 2);
        ga[i] = arow(r) + (((lane & 3) ^ ((r >> 2) & 3)) * 8);
    }
    const float* bpf = (const float*)bsrc((tid & 63) * 4) + (size_t)(tid >> 6) * ldb;
#pragma unroll
    for (int m = 0; m < 4; ++m)
#pragma unroll
        for (int n = 0; n < 8; ++n) acc[m][n] = f32x4{0.f, 0.f, 0.f, 0.f};
    const int trbase = (8 * fq + (fr >> 2)) * 512 + wc * 256 + (((fr >> 2) | ((fq & 1) << 2)) << 5) + ((fr & 3) >> 1) * 16 + (fr & 1) * 8;
    char* ldst = smem + wid * 1024 + lane * 16;
    const unsigned lds0 = (unsigned)(size_t)smem;
    unsigned bwoff[4];
#pragma unroll
    for (int j = 0; j < 4; ++j) bwoff[j] = boff((tid >> 6) + 8 * j, (tid & 63) >> 1) + (tid & 1) * 8;
    f32x4 rf0[4], rf1[4];
    const int klast = K - 32;
#define G5_ADMA(slot, k0) do { \
        char* d_ = ldst + (slot) * 16384; \
        __builtin_amdgcn_global_load_lds((const unsigned*)(ga[0] + (k0)), (LAS unsigned*)(d_), 16, 0, 0); \
        __builtin_amdgcn_global_load_lds((const unsigned*)(ga[1] + (k0)), (LAS unsigned*)(d_ + 8192), 16, 0, 0); } while (0)
#define G5_BLOAD(RF, k0) do { const float* q0_ = bpf + (size_t)(k0) * ldb; const float* q1_ = q0_ + (size_t)8 * ldb; const float* q2_ = q0_ + (size_t)16 * ldb; const float* q3_ = q0_ + (size_t)24 * ldb; \
        asm volatile("global_load_dwordx4 %0, %4, off\n\tglobal_load_dwordx4 %1, %5, off\n\tglobal_load_dwordx4 %2, %6, off\n\tglobal_load_dwordx4 %3, %7, off" \
                     : "=&v"(RF[0]), "=&v"(RF[1]), "=&v"(RF[2]), "=&v"(RF[3]) : "v"(q0_), "v"(q1_), "v"(q2_), "v"(q3_) : "memory"); } while (0)
#define G5_BWAIT(RF, N) asm volatile("s_waitcnt vmcnt(" #N ")" : "+v"(RF[0]), "+v"(RF[1]), "+v"(RF[2]), "+v"(RF[3]) :: "memory")
#define G5_BWRITE(RF, st) do { const unsigned sB_ = lds0 + G5_B0 + (st) * 16384; \
        _Pragma("unroll") for (int j = 0; j < 4; ++j) { \
            const unsigned long long w_ = (unsigned long long)pack2(RF[j][0], RF[j][1]) | ((unsigned long long)pack2(RF[j][2], RF[j][3]) << 32); \
            asm volatile("ds_write_b64 %0, %1" :: "v"(sB_ + bwoff[j]), "v"(w_) : "memory"); } } while (0)
#define G5_TRB(n0) do { \
        _Pragma("unroll") for (int n = 0; n < 4; ++n) { const unsigned a_ = sBa_ + (unsigned)(trbase ^ (((n0) + n) << 5)); \
            asm volatile("ds_read_b64_tr_b16 %0, %2\n\tds_read_b64_tr_b16 %1, %2 offset:2048" : "=&v"(tl[n]), "=&v"(th[n]) : "v"(a_) : "memory"); } } while (0)
#define G5_TRW() asm volatile("s_waitcnt lgkmcnt(0)" : "+v"(tl[0]), "+v"(tl[1]), "+v"(tl[2]), "+v"(tl[3]), "+v"(th[0]), "+v"(th[1]), "+v"(th[2]), "+v"(th[3]) :: "memory")
#define G5_MM(n0) do { _Pragma("unroll") for (int n = 0; n < 4; ++n) { \
            const bf16x8 bfr = bf16x8{tl[n][0], tl[n][1], tl[n][2], tl[n][3], th[n][0], th[n][1], th[n][2], th[n][3]}; \
            _Pragma("unroll") for (int m = 0; m < 4; ++m) acc[m][(n0) + n] = __builtin_amdgcn_mfma_f32_16x16x32_bf16(af[m], bfr, acc[m][(n0) + n], 0, 0, 0); } } while (0)
#define G5_COMPUTE(aslot, bst) do { \
        const char* sA_ = smem + (aslot) * 16384; const unsigned sBa_ = lds0 + G5_B0 + (bst) * 16384; \
        v4s tl[4], th[4]; \
        G5_TRB(0); \
        bf16x8 af[4]; \
        _Pragma("unroll") for (int m = 0; m < 4; ++m) af[m] = *(const bf16x8*)(sA_ + aoff(wr * 64 + m * 16 + fr, fq)); \
        G5_TRW(); G5_MM(0); \
        G5_TRB(4); G5_TRW(); G5_MM(4); } while (0)
#define G5_KC(k) ((k) < klast ? (k) : klast)
    const int nk = K >> 5;
    G5_BLOAD(rf0, 0);
    G5_ADMA(0, 0);
    G5_BLOAD(rf1, 32);
    G5_BWAIT(rf0, 6);
    G5_BWRITE(rf0, 0);
    G5_ADMA(1, 32);
    G5_BLOAD(rf0, G5_KC(64));
    int as0 = 0, as2 = 2;
    for (int kt = 0; kt < nk; kt += 2) {
        asm volatile("s_waitcnt vmcnt(10) lgkmcnt(0)" ::: "memory");
        __builtin_amdgcn_s_barrier();
        G5_ADMA(as2, G5_KC((kt + 2) * 32));
        G5_BWAIT(rf1, 8);
        G5_BWRITE(rf1, 1);
        G5_BLOAD(rf1, G5_KC((kt + 3) * 32));
        G5_COMPUTE(as0, 0);
        as0 = (as0 == 2) ? 0 : as0 + 1; as2 = (as2 == 2) ? 0 : as2 + 1;
        asm volatile("s_waitcnt vmcnt(10) lgkmcnt(0)" ::: "memory");
        __builtin_amdgcn_s_barrier();
        G5_ADMA(as2, G5_KC((kt + 3) * 32));
        G5_BWAIT(rf0, 8);
        G5_BWRITE(rf0, 0);
        G5_BLOAD(rf0, G5_KC((kt + 4) * 32));
        G5_COMPUTE(as0, 1);
        as0 = (as0 == 2) ? 0 : as0 + 1; as2 = (as2 == 2) ? 0 : as2 + 1;
    }
    G5_BWAIT(rf0, 0);
    G5_BWAIT(rf1, 0);
    asm volatile("s_waitcnt lgkmcnt(0)" ::: "memory");
    __syncthreads();
#undef G5_ADMA
#undef G5_BLOAD
#undef G5_BWAIT
#undef G5_BWRITE
#undef G5_COMPUTE
#undef G5_TRB
#undef G5_TRW
#undef G5_MM
#undef G5_KC
}


template <class AF, class BF>
__device__ __forceinline__ void gemm6(char* smem, const int K, AF arow, BF brow, f32x4 (&acc)[4][8]) {
    const int tid = otid(), lane = tid & 63, wid = tid >> 6, wr = wid >> 1, wc = wid & 1, fr = lane & 15, fq = lane >> 4;
    const bf16_t* ga[4];
    const bf16_t* gb[4];
#pragma unroll
    for (int i = 0; i < 4; ++i) {
        const int r = 8 * (wid + 8 * i) + (lane >> 3), sc = ((lane & 7) ^ ((r >> 1) & 7)) * 8;
        ga[i] = arow(r) + sc;
        gb[i] = brow(r) + sc;
    }
#pragma unroll
    for (int m = 0; m < 4; ++m)
#pragma unroll
        for (int n = 0; n < 8; ++n) acc[m][n] = f32x4{0.f, 0.f, 0.f, 0.f};
    char* ldst = smem + wid * 1024 + lane * 16;
#define G6_ISSUE(slot, k0) do { char* d_ = ldst + (slot) * 65536; \
        _Pragma("unroll") for (int i_ = 0; i_ < 4; ++i_) { \
            __builtin_amdgcn_global_load_lds((const unsigned*)(ga[i_] + (k0)), (LAS unsigned*)(d_ + i_ * 8192), 16, 0, 0); \
            __builtin_amdgcn_global_load_lds((const unsigned*)(gb[i_] + (k0)), (LAS unsigned*)(d_ + 32768 + i_ * 8192), 16, 0, 0); } } while (0)
    const int nk = K >> 6;
    G6_ISSUE(0, 0);
    for (int kt = 0; kt < nk; ++kt) {
        asm volatile("s_waitcnt vmcnt(0)" ::: "memory");
        __builtin_amdgcn_s_barrier();
        if (kt + 1 < nk) G6_ISSUE((kt + 1) & 1, (kt + 1) * 64);
        const char* sA_ = smem + (kt & 1) * 65536;
        const char* sB_ = sA_ + 32768;
#pragma unroll
        for (int ks = 0; ks < 2; ++ks) {
            bf16x8 af[4];
#pragma unroll
            for (int m = 0; m < 4; ++m) af[m] = *(const bf16x8*)(sA_ + swz(wr * 64 + m * 16 + fr, ks * 4 + fq));
#pragma unroll
            for (int n = 0; n < 8; ++n) {
                const bf16x8 bfr = *(const bf16x8*)(sB_ + swz(wc * 128 + n * 16 + fr, ks * 4 + fq));
#pragma unroll
                for (int m = 0; m < 4; ++m) acc[m][n] = __builtin_amdgcn_mfma_f32_16x16x32_bf16(af[m], bfr, acc[m][n], 0, 0, 0);
            }
        }
    }
#undef G6_ISSUE
    __syncthreads();
}

constexpr int EPI_WAVE = 8704;
template <class VF, class SF>
__device__ __forceinline__ void epi_bf16(char* wl, const int lane, VF val, SF store) {
    const int fr = lane & 15, fq = lane >> 4, odd = lane & 1;
#pragma unroll
    for (int n = 0; n < 8; ++n)
#pragma unroll
        for (int jp = 0; jp < 2; ++jp) {
            const float a = val(n, 2 * jp), b = val(n, 2 * jp + 1);
            const float x = odd ? a : b;
            const float y = __shfl_xor(x, 1, 64);
            const uint32_t w = odd ? pack2(y, b) : pack2(a, y);
            *(uint32_t*)(wl + (fq * 4 + 2 * jp + odd) * 272 + (n * 16 + (fr & ~1)) * 2) = w;
        }
    int ln = lane;
    asm volatile("" : "+v"(ln));
#pragma unroll
    for (int i = 0; i < 4; ++i) {
        const int idx = ln + 64 * i, row = idx >> 4, ch = idx & 15;
        store(row, ch, *(const u32x4*)(wl + row * 272 + ch * 16));
    }
}
template <class VF, class SF>
__device__ __forceinline__ void epi_f32(char* wl, const int lane, VF val, SF store) {
    const int fr = lane & 15, fq = lane >> 4;
#pragma unroll
    for (int n = 0; n < 8; ++n)
#pragma unroll
        for (int j = 0; j < 4; ++j) *(float*)(wl + (fq * 4 + j) * 528 + (n * 16 + fr) * 4) = val(n, j);
    int ln = lane;
    asm volatile("" : "+v"(ln));
#pragma unroll
    for (int i = 0; i < 8; ++i) {
        const int idx = ln + 64 * i, row = idx >> 5, ch = idx & 31;
        store(row, ch, *(const f32x4*)(wl + row * 528 + ch * 16));
    }
}


constexpr float Y8_SCALE = 16.f;
template <class VF, class SF>
__device__ __forceinline__ void epi_fp8(char* wl, const int lane, VF val, SF store) {
    const int fr = lane & 15, fq = lane >> 4, odd = lane & 1;
#pragma unroll
    for (int n = 0; n < 8; ++n)
#pragma unroll
        for (int jp = 0; jp < 2; ++jp) {
            const float a = val(n, 2 * jp), b = val(n, 2 * jp + 1);
            const float x = odd ? a : b;
            const float y = __shfl_xor(x, 1, 64);
            const int w = odd ? __builtin_amdgcn_cvt_pk_fp8_f32(y, b, 0, false) : __builtin_amdgcn_cvt_pk_fp8_f32(a, y, 0, false);
            *(unsigned short*)(wl + (fq * 4 + 2 * jp + odd) * 144 + n * 16 + (fr & ~1)) = (unsigned short)w;
        }
    int ln = lane;
    asm volatile("" : "+v"(ln));
#pragma unroll
    for (int i = 0; i < 2; ++i) {
        const int idx = ln + 64 * i, row = idx >> 3, ch = idx & 7;
        store(row, ch, *(const u32x4*)(wl + row * 144 + ch * 16));
    }
}

__device__ __forceinline__ void ph_inproj(const Params& p, char* smem) {
    const int tid = otid(), lane = tid & 63, wid = tid >> 6, wr = wid >> 1, wc = wid & 1, fr = lane & 15;
    const int NTN = INW / 256;
    const int xcd = blockIdx.x & 7, nbx = gridDim.x >> 3;
    for (int i = blockIdx.x >> 3; i < 8 * NTN; i += nbx) {
        const int nt = i >> 3, mt = xcd * 8 + (i & 7);
        const bf16_t* A = p.h1() + (size_t)mt * 256 * D;
        const bf16_t* Bt = p.winT() + (size_t)nt * 256 * D;
        f32x4 acc[4][8];
        __syncthreads();
        gemm6(smem, D, [&](int r) { return A + (size_t)r * D; }, [&](int n) { return Bt + (size_t)n * D; }, acc);
        char* wl = smem + wid * EPI_WAVE;
        const int colb = nt * 256 + wc * 128;
        const int rowb = mt * 256 + wr * 64;
        if (colb >= OFF_HF && colb < OFF_HI) {
            float lbc[8];
#pragma unroll
            for (int n = 0; n < 8; ++n) lbc[n] = p.lbv()[colb - OFF_HF + n * 16 + fr];
#pragma unroll
            for (int m = 0; m < 4; ++m) {
                float* dst = p.lgf() + (size_t)(rowb + m * 16) * 512 + (colb - OFF_HF);
                epi_f32(wl, lane,
                        [&](int n, int j) { return __logf(lbc[n] + (1.f - lbc[n]) * (1.f / (1.f + __expf(-acc[m][n][j])))); },
                        [&](int row, int ch, f32x4 v) { *(f32x4*)(dst + (size_t)row * 512 + ch * 4) = v; });
            }
        } else {
#pragma unroll
            for (int m = 0; m < 4; ++m) {
                bf16_t* dst = p.proj() + (size_t)(rowb + m * 16) * INW + colb;
                epi_bf16(wl, lane, [&](int n, int j) { return acc[m][n][j]; },
                         [&](int row, int ch, u32x4 v) { *(u32x4*)(dst + (size_t)row * INW + ch * 8) = v; });
            }
        }
    }
}

__device__ __forceinline__ void ph_h1(const Params& p, char* smem0) {
    const VB vbk = make_vb(smem0);
    char* smem = vbk.smem;
    const int tid = vbk.tid, lane = tid & 63, wid = tid >> 6, wr = wid >> 1, wc = wid & 1, fr = lane & 15, fq = lane >> 4;
    char* sI = smem;
    char* sK = smem + 16384;
    float* sL = (float*)(smem + 32768);
    float* totS = (float*)(smem + 65536);
    const int d = tid & 127, half = tid >> 7;
    const TrBase trb = tr16_base(lane);
    for (int u = vbk.vb; u < 1024; u += vbk.nvb) {
        const int bh = u >> 6, c = u & 63, b = bh >> 2, h = bh & 3;
        const size_t row0 = (size_t)b * S + c * 64;
        __syncthreads();
#pragma unroll
        for (int i = 0; i < 4; ++i) {
            const int idx = tid + 256 * i, r = idx >> 4, ch = idx & 15;
            *(u32x4*)(sI + swz16(r, ch)) = *(const u32x4*)(p.proj() + (row0 + r) * INW + OFF_HI + h * 128 + ch * 8);
        }
#pragma unroll
        for (int i = 0; i < 8; ++i) {
            const int idx = tid + 256 * i, r = idx >> 5, c4 = idx & 31;
            *(f32x4*)(sL + r * 128 + c4 * 4) = *(const f32x4*)(p.lgf() + (row0 + r) * 512 + h * 128 + c4 * 4);
        }
        __syncthreads();
        const float* lcol = sL + half * 32 * 128 + d;
        float tot = 0.f;
#pragma unroll
        for (int s = 0; s < 32; ++s) tot += lcol[s * 128];
        totS[half * 128 + d] = tot;
        __syncthreads();
        const float t0 = totS[d], bl = t0 + totS[128 + d];
        float run = half ? t0 : 0.f;
#pragma unroll 8
        for (int s = 0; s < 32; ++s) {
            const float lv = lcol[s * 128];
            run += lv;
            const float kt = (1.f - __expf(lv)) * __expf(bl - run);
            *(bf16_t*)(sK + swz16(half * 32 + s, d >> 3) + (d & 7) * 2) = f2bf(kt);
        }
        if (half == 0) p.dec()[u * 128 + d] = __expf(bl);
        __syncthreads();
        f32x4 acc[4][4];
#pragma unroll
        for (int m = 0; m < 4; ++m)
#pragma unroll
            for (int n = 0; n < 4; ++n) acc[m][n] = f32x4{0.f, 0.f, 0.f, 0.f};
#pragma unroll
        for (int ks = 0; ks < 2; ++ks) {
            bf16x8 af[4], bfr[4];
#pragma unroll
            for (int m = 0; m < 4; ++m) af[m] = tr_frag16(sI, trb, ks, wr * 4 + m);
#pragma unroll
            for (int n = 0; n < 4; ++n) bfr[n] = tr_frag16(sK, trb, ks, wc * 4 + n);
#pragma unroll
            for (int m = 0; m < 4; ++m)
#pragma unroll
                for (int n = 0; n < 4; ++n) acc[m][n] = __builtin_amdgcn_mfma_f32_16x16x32_bf16(af[m], bfr[n], acc[m][n], 0, 0, 0);
        }
        __syncthreads();
        {
            int tz = tid;
            asm volatile("" : "+v"(tz));
            const int lz = tz & 63, odd = lz & 1;
            char* wbase = smem + ((tz >> 7) * 64 + (lz >> 4) * 4 + odd) * 272 + (((tz >> 6) & 1) * 64 + ((lz & 15) & ~1)) * 2;
#pragma unroll
            for (int m = 0; m < 4; ++m)
#pragma unroll
                for (int n = 0; n < 4; ++n)
#pragma unroll
                    for (int jp = 0; jp < 2; ++jp) {
                        const float a = acc[m][n][2 * jp], b2 = acc[m][n][2 * jp + 1];
                        const float x = odd ? a : b2;
                        const float y = __shfl_xor(x, 1, 64);
                        const uint32_t w = odd ? pack2(y, b2) : pack2(a, y);
                        *(uint32_t*)(wbase + (m * 16 + 2 * jp) * 272 + n * 32) = w;
                    }
            __syncthreads();
            bf16_t* kvu = p.kv() + (size_t)u * 16384;
            const int r0 = tz >> 4, ch = tz & 15;
#pragma unroll
            for (int i = 0; i < 8; ++i)
                *(u32x4*)(kvu + (r0 + 16 * i) * 128 + ch * 8) = *(const u32x4*)(smem + (r0 + 16 * i) * 272 + ch * 16);
        }
    }
}

__device__ __forceinline__ void ph_h2(const Params& p) {
    for (int it = blockIdx.x * NTHREADS + otid(); it < 16 * 8192; it += gridDim.x * NTHREADS) {
        const int bh = it >> 13, e2 = it & 8191, dv = e2 >> 6, dk = (e2 & 63) * 2;
        const size_t eoff = (size_t)dv * 128 + dk;
        float sx = 0.f, sy = 0.f;
        const bf16_t* kvp = p.kv() + (size_t)bh * 64 * 16384 + eoff;
        const float* dcp = p.dec() + (size_t)bh * 64 * 128 + dk;
        bf16_t* stp = p.sst() + (size_t)bh * 64 * 16384 + eoff;
        for (int c0 = 0; c0 < 64; c0 += 16) {
            uint32_t kvw[16];
            float2 dc[16];
#pragma unroll
            for (int i = 0; i < 16; ++i) {
                kvw[i] = *(const uint32_t*)(kvp + (size_t)(c0 + i) * 16384);
                dc[i] = *(const float2*)(dcp + (c0 + i) * 128);
            }
#pragma unroll
            for (int i = 0; i < 16; ++i) {
                *(uint32_t*)(stp + (size_t)(c0 + i) * 16384) = pack2(sx, sy);
                sx = dc[i].x * sx + __uint_as_float(kvw[i] << 16);
                sy = dc[i].y * sy + __uint_as_float(kvw[i] & 0xffff0000u);
            }
        }
    }
}

__device__ __forceinline__ void ph_h3(const Params& p, char* smem0) {
    const VB vbk = make_vb(smem0);
    char* smem = vbk.smem;
    const int tid = vbk.tid, lane = tid & 63, wid = tid >> 6, wr = wid >> 1, wc = wid & 1, fr = lane & 15, fq = lane >> 4;
    char* sQ = smem;
    char* sK = smem + 16384;
    char* sP = smem + 32768;
    float* sL = (float*)(smem + 32768);
    float* totS = (float*)(smem + 65536);
    char* sG = smem + 40960;
    const int d = tid & 127, half = tid >> 7;
    const TrBase trb = tr16_base(lane);
    for (int u = vbk.vb; u < 1024; u += vbk.nvb) {
        const int bh = u >> 6, c = u & 63, b = bh >> 2, h = bh & 3;
        const size_t row0 = (size_t)b * S + c * 64;
        __syncthreads();
#pragma unroll
        for (int i = 0; i < 4; ++i) {
            const int idx = tid + 256 * i, r = idx >> 4, ch = idx & 15;
            *(u32x4*)(sQ + swz16(r, ch)) = *(const u32x4*)(p.proj() + (row0 + r) * INW + OFF_HQ + h * 128 + ch * 8);
        }
#pragma unroll
        for (int i = 0; i < 8; ++i) {
            const int idx = tid + 256 * i, r = idx >> 5, c4 = idx & 31;
            *(f32x4*)(sL + r * 128 + c4 * 4) = *(const f32x4*)(p.lgf() + (row0 + r) * 512 + h * 128 + c4 * 4);
        }
        u32x4 sv0[4], sv1[4], iv[4], gv[4];
#pragma unroll
        for (int i = 0; i < 4; ++i) {
            const int r8 = (tid + 256 * i) >> 3;
            sv0[i] = *(const u32x4*)(p.sst() + (size_t)u * 16384 + r8 * 128 + (tid & 7) * 8);
            sv1[i] = *(const u32x4*)(p.sst() + (size_t)u * 16384 + r8 * 128 + 64 + (tid & 7) * 8);
            const int idx = tid + 256 * i, r = idx >> 4, c16 = idx & 15;
            iv[i] = *(const u32x4*)(p.proj() + (row0 + r) * INW + OFF_HI + h * 128 + c16 * 8);
            gv[i] = *(const u32x4*)(p.proj() + (row0 + r) * INW + OFF_HG + h * 128 + c16 * 8);
        }
        __syncthreads();
        const float* lcol = sL + half * 32 * 128 + d;
        float tot = 0.f;
#pragma unroll
        for (int s = 0; s < 32; ++s) tot += lcol[s * 128];
        totS[half * 128 + d] = tot;
        __syncthreads();
        const float t0 = totS[d];
        float run = half ? t0 : 0.f;
#pragma unroll 8
        for (int s = 0; s < 32; ++s) {
            const float lv = lcol[s * 128];
            run += lv;
            const int o = swz16(half * 32 + s, d >> 3) + (d & 7) * 2;
            const float qm = bf2f(*(const bf16_t*)(sQ + o)) * __expf(run - t0);
            const float kh = (1.f - __expf(lv)) * __expf(t0 - run);
            *(bf16_t*)(sQ + o) = f2bf(qm);
            *(bf16_t*)(sK + o) = f2bf(kh);
        }
        __syncthreads();
        {
            f32x4 pa[2][2];
#pragma unroll
            for (int m = 0; m < 2; ++m)
#pragma unroll
                for (int n = 0; n < 2; ++n) pa[m][n] = f32x4{0.f, 0.f, 0.f, 0.f};
#pragma unroll
            for (int ks = 0; ks < 4; ++ks) {
                bf16x8 af[2], bfr[2];
#pragma unroll
                for (int m = 0; m < 2; ++m) af[m] = *(const bf16x8*)(sQ + swz16(wr * 32 + m * 16 + fr, ks * 4 + fq));
#pragma unroll
                for (int n = 0; n < 2; ++n) bfr[n] = *(const bf16x8*)(sK + swz16(wc * 32 + n * 16 + fr, ks * 4 + fq));
#pragma unroll
                for (int m = 0; m < 2; ++m)
#pragma unroll
                    for (int n = 0; n < 2; ++n) pa[m][n] = __builtin_amdgcn_mfma_f32_16x16x32_bf16(af[m], bfr[n], pa[m][n], 0, 0, 0);
            }
#pragma unroll
            for (int m = 0; m < 2; ++m)
#pragma unroll
                for (int n = 0; n < 2; ++n)
#pragma unroll
                    for (int j = 0; j < 4; ++j) {
                        const int t = wr * 32 + m * 16 + fq * 4 + j, s_ = wc * 32 + n * 16 + fr;
                        const float v = (s_ <= t) ? pa[m][n][j] : 0.f;
                        *(bf16_t*)(sP + swz(t, s_ >> 3) + (s_ & 7) * 2) = f2bf(v);
                    }
        }
        __syncthreads();
        f32x4 oa[8];
#pragma unroll
        for (int i = 0; i < 4; ++i) { const int idx = tid + 256 * i; *(u32x4*)(sG + (idx >> 4) * 256 + (idx & 15) * 16) = gv[i]; }
#pragma unroll
        for (int n = 0; n < 8; ++n) oa[n] = f32x4{0.f, 0.f, 0.f, 0.f};
        const int ch = tid & 7;
#pragma unroll
        for (int sub = 0; sub < 2; ++sub) {
            float sc[8];
#pragma unroll
            for (int j = 0; j < 8; ++j) sc[j] = __expf(totS[sub * 64 + ch * 8 + j]);
#pragma unroll
            for (int i = 0; i < 4; ++i) {
                const int r = (tid + 256 * i) >> 3;
                const u32x4 v = sub ? sv1[i] : sv0[i];
                u32x4 w;
                w.x = pack2(__uint_as_float(v.x << 16) * sc[0], __uint_as_float(v.x & 0xffff0000u) * sc[1]);
                w.y = pack2(__uint_as_float(v.y << 16) * sc[2], __uint_as_float(v.y & 0xffff0000u) * sc[3]);
                w.z = pack2(__uint_as_float(v.z << 16) * sc[4], __uint_as_float(v.z & 0xffff0000u) * sc[5]);
                w.w = pack2(__uint_as_float(v.w << 16) * sc[6], __uint_as_float(v.w & 0xffff0000u) * sc[7]);
                *(u32x4*)(sK + swz(r, ch)) = w;
            }
            __syncthreads();
#pragma unroll
            for (int ks = 0; ks < 2; ++ks) {
                const bf16x8 af = *(const bf16x8*)(sQ + swz16(wid * 16 + fr, sub * 8 + ks * 4 + fq));
#pragma unroll
                for (int n = 0; n < 8; ++n) {
                    const bf16x8 bfr = *(const bf16x8*)(sK + swz(n * 16 + fr, ks * 4 + fq));
                    oa[n] = __builtin_amdgcn_mfma_f32_16x16x32_bf16(af, bfr, oa[n], 0, 0, 0);
                }
            }
            __syncthreads();
        }
#pragma unroll
        for (int i = 0; i < 4; ++i) {
            const int idx = tid + 256 * i, r = idx >> 4, c16 = idx & 15;
            *(u32x4*)(sK + swz16(r, c16)) = iv[i];
        }
        __syncthreads();
#pragma unroll
        for (int ks = 0; ks < 2; ++ks) {
            const bf16x8 af = *(const bf16x8*)(sP + swz(wid * 16 + fr, ks * 4 + fq));
#pragma unroll
            for (int n = 0; n < 8; ++n) {
                const bf16x8 bfr = tr_frag16(sK, trb, ks, n);
                oa[n] = __builtin_amdgcn_mfma_f32_16x16x32_bf16(af, bfr, oa[n], 0, 0, 0);
            }
        }
        float ss[4] = {0.f, 0.f, 0.f, 0.f};
#pragma unroll
        for (int n = 0; n < 8; ++n)
#pragma unroll
            for (int j = 0; j < 4; ++j) ss[j] += oa[n][j] * oa[n][j];
#pragma unroll
        for (int j = 0; j < 4; ++j) {
            ss[j] += __shfl_xor(ss[j], 1, 64); ss[j] += __shfl_xor(ss[j], 2, 64); ss[j] += __shfl_xor(ss[j], 4, 64); ss[j] += __shfl_xor(ss[j], 8, 64);
        }
        {
            int lz = lane;
            asm volatile("" : "+v"(lz));
            const int odd = lz & 1, fr = lz & 15, fq = lz >> 4;
            float rstd[4];
#pragma unroll
            for (int j = 0; j < 4; ++j) rstd[j] = rsqrtf(ss[j] * (1.f / 128.f) + RMS_EPS);
#pragma unroll
            for (int n = 0; n < 8; ++n) {
                const int dv = n * 16 + fr;
                const float nw = p.hg_nw[h * 128 + dv];
                float y[4];
#pragma unroll
                for (int j = 0; j < 4; ++j) {
                    const float g = bf2f(*(const bf16_t*)(sG + (wid * 16 + fq * 4 + j) * 256 + dv * 2));
                    y[j] = oa[n][j] * rstd[j] * nw * (g / (1.f + __expf(-g)));
                }
#pragma unroll
                for (int jp = 0; jp < 2; ++jp) {
                    const float a = y[2 * jp], b2 = y[2 * jp + 1];
                    const float x = odd ? a : b2;
                    const float z = __shfl_xor(x, 1, 64);
                    const size_t row = row0 + wid * 16 + fq * 4 + 2 * jp + odd;
                    *(uint32_t*)(p.mixin() + row * 768 + h * 128 + n * 16 + (fr & ~1)) = odd ? pack2(z, b2) : pack2(a, z);
                }
            }
        }
    }
}

__device__ __forceinline__ TrBase tr8_base(int lane) {
    const int g = lane >> 4, q = (lane & 15) >> 2, pp = lane & 3;
    const int xl = 4 * (g & 1) + (q >> 1), h = pp >> 1;
    TrBase t;
    t.lo = (8 * g + q) * 128 + ((xl >> 1) << 5) + ((h ^ (xl & 1)) << 4) + 8 * (pp & 1);
    t.hi = (t.lo + 512) ^ 32;
    return t;
}
__device__ __forceinline__ bf16x8 tr_frag8(const char* tile, const TrBase& tb, int ks, int c) {
    int cx = c << 5;
    asm volatile("" : "+v"(cx));
    const v4s lo = __builtin_amdgcn_ds_read_tr16_b64_v4i16((LAS v4s*)(tile + ks * 4096 + (tb.lo ^ cx)));
    const v4s hi = __builtin_amdgcn_ds_read_tr16_b64_v4i16((LAS v4s*)(tile + ks * 4096 + (tb.hi ^ cx)));
    return bf16x8{lo[0], lo[1], lo[2], lo[3], hi[0], hi[1], hi[2], hi[3]};
}

__device__ __forceinline__ void ph_attn(const Params& p, char* smem0) {
    const VB vbk = make_vb(smem0);
    char* smem = vbk.smem;
    const int tid = vbk.tid, lane = tid & 63, wid = tid >> 6, fr = lane & 15, fq = lane >> 4;
    char* sQ = smem;
    char* sK = smem + 8192;
    char* sP = sK;
    char* sV = smem + 33792;
    float* sBias = (float*)(smem + 58368);
    const TrBase trb = tr8_base(lane);
    for (int u = vbk.vb; u < 3072; u += vbk.nvb) {
        const int ti = u & 63, gq = u >> 6, g = gq % 3, bhh = gq / 3, hh = bhh & 3, b = bhh >> 2;
        const int lsh = (g == 0) ? 0 : (g == 1 ? 2 : 4), dl = 1 << lsh;
        const int tpr = (S >> lsh) >> 6;
        const int r = ti / tpr, j0 = (ti % tpr) * 64;
        const bf16_t* base = p.proj() + (size_t)b * S * INW + (g * 4 + hh) * 64;
        __syncthreads();
#pragma unroll
        for (int i = 0; i < 2; ++i) {
            const int idx = tid + 256 * i, row = idx >> 3, ch = idx & 7;
            const int tok = (j0 + row) * dl + r;
            *(u32x4*)(sQ + swz(row, ch)) = *(const u32x4*)(base + (size_t)tok * INW + OFF_AQ + ch * 8);
        }
#pragma unroll
        for (int i = 0; i < 6; ++i) {
            const int idx = tid + 256 * i, row = idx >> 3, ch = idx & 7;
            const int j = j0 - 128 + row;
            u32x4 kx = {0u, 0u, 0u, 0u}, vx = {0u, 0u, 0u, 0u};
            if (j >= 0) {
                const size_t o = (size_t)(j * dl + r) * INW + ch * 8;
                kx = *(const u32x4*)(base + o + OFF_AK);
                vx = *(const u32x4*)(base + o + OFF_AV);
            }
            *(u32x4*)(sK + swz(row, ch)) = kx;
            *(u32x4*)(sV + swz(row, ch)) = vx;
        }
        if (tid < 129) sBias[tid] = p.biasT()[(g * 129 + tid) * 4 + hh];
        __syncthreads();
        f32x4 sa[12];
#pragma unroll
        for (int n = 0; n < 12; ++n) sa[n] = f32x4{0.f, 0.f, 0.f, 0.f};
#pragma unroll
        for (int ks = 0; ks < 2; ++ks) {
            const bf16x8 af = *(const bf16x8*)(sQ + swz(wid * 16 + fr, ks * 4 + fq));
#pragma unroll
            for (int n = 0; n < 12; ++n) {
                const bf16x8 bfr = *(const bf16x8*)(sK + swz(n * 16 + fr, ks * 4 + fq));
                sa[n] = __builtin_amdgcn_mfma_f32_16x16x32_bf16(af, bfr, sa[n], 0, 0, 0);
            }
        }
        float mx[4] = {-INFINITY, -INFINITY, -INFINITY, -INFINITY};
#pragma unroll
        for (int n = 0; n < 12; ++n)
#pragma unroll
            for (int j = 0; j < 4; ++j) {
                const int jj = wid * 16 + fq * 4 + j, kk = n * 16 + fr, m = jj + 128 - kk;
                const bool valid = (m >= 0) && (m <= 128) && (j0 - 128 + kk >= 0);
                const int mc = m < 0 ? 0 : (m > 128 ? 128 : m);
                const float v = valid ? sa[n][j] * 0.125f + sBias[mc] : -INFINITY;
                sa[n][j] = v;
                mx[j] = fmaxf(mx[j], v);
            }
#pragma unroll
        for (int j = 0; j < 4; ++j) {
            mx[j] = fmaxf(mx[j], __shfl_xor(mx[j], 1, 64)); mx[j] = fmaxf(mx[j], __shfl_xor(mx[j], 2, 64));
            mx[j] = fmaxf(mx[j], __shfl_xor(mx[j], 4, 64)); mx[j] = fmaxf(mx[j], __shfl_xor(mx[j], 8, 64));
        }
        float ls[4] = {0.f, 0.f, 0.f, 0.f};
#pragma unroll
        for (int n = 0; n < 12; ++n)
#pragma unroll
            for (int j = 0; j < 4; ++j) { const float pe = __expf(sa[n][j] - mx[j]); sa[n][j] = pe; ls[j] += pe; }
#pragma unroll
        for (int j = 0; j < 4; ++j) {
            ls[j] += __shfl_xor(ls[j], 1, 64); ls[j] += __shfl_xor(ls[j], 2, 64); ls[j] += __shfl_xor(ls[j], 4, 64); ls[j] += __shfl_xor(ls[j], 8, 64);
        }
        __syncthreads();
#pragma unroll
        for (int n = 0; n < 12; ++n)
#pragma unroll
            for (int j = 0; j < 4; ++j) *(bf16_t*)(sP + (wid * 16 + fq * 4 + j) * 400 + (n * 16 + fr) * 2) = f2bf(sa[n][j]);
        f32x4 oa[4];
#pragma unroll
        for (int n = 0; n < 4; ++n) oa[n] = f32x4{0.f, 0.f, 0.f, 0.f};
#pragma unroll
        for (int ks = 0; ks < 6; ++ks) {
            const bf16x8 af = *(const bf16x8*)(sP + (wid * 16 + fr) * 400 + (ks * 4 + fq) * 16);
#pragma unroll
            for (int n = 0; n < 4; ++n) {
                const bf16x8 bfr = tr_frag8(sV, trb, ks, n);
                oa[n] = __builtin_amdgcn_mfma_f32_16x16x32_bf16(af, bfr, oa[n], 0, 0, 0);
            }
        }
        {
            int lz = lane;
            asm volatile("" : "+v"(lz));
            const int odd = lz & 1, fr = lz & 15, fq = lz >> 4;
            float inv[4];
#pragma unroll
            for (int j = 0; j < 4; ++j) inv[j] = 1.f / ls[j];
#pragma unroll
            for (int jp = 0; jp < 2; ++jp) {
                const int jj = wid * 16 + fq * 4 + 2 * jp + odd;
                const size_t row = (size_t)g * T + (size_t)b * S + (j0 + jj) * dl + r;
#pragma unroll
                for (int n = 0; n < 4; ++n) {
                    const float a = oa[n][2 * jp] * inv[2 * jp], b2 = oa[n][2 * jp + 1] * inv[2 * jp + 1];
                    const float x = odd ? a : b2;
                    const float y = __shfl_xor(x, 1, 64);
                    *(uint32_t*)(p.ao() + row * 256 + hh * 64 + n * 16 + (fr & ~1)) = odd ? pack2(y, b2) : pack2(a, y);
                }
            }
#pragma unroll
            for (int j = 0; j < 4; ++j) {
                const int jj = wid * 16 + fq * 4 + j;
                const size_t row = (size_t)g * T + (size_t)b * S + (j0 + jj) * dl + r;
                if (fr == 0) p.alse()[row * 4 + hh] = mx[j] + __logf(ls[j]);
            }
        }
    }
}

__device__ __forceinline__ void ph_attn_merge(const Params& p) {
    const int tid = otid(), lane = tid & 63, wid = tid >> 6, hh = lane >> 4;
    constexpr int RB = 4;
    for (int row0 = (blockIdx.x * 8 + wid) * RB; row0 < T; row0 += gridDim.x * 8 * RB) {
        float l[RB][3];
        uint2 w[RB][3];
#pragma unroll
        for (int r = 0; r < RB; ++r)
#pragma unroll
            for (int g = 0; g < 3; ++g) {
                l[r][g] = p.alse()[((size_t)g * T + row0 + r) * 4 + hh];
                w[r][g] = *(const uint2*)(p.ao() + ((size_t)g * T + row0 + r) * 256 + lane * 4);
            }
#pragma unroll
        for (int r = 0; r < RB; ++r) {
            const float mxl = fmaxf(l[r][0], fmaxf(l[r][1], l[r][2]));
            float e0 = __expf(l[r][0] - mxl), e1 = __expf(l[r][1] - mxl), e2 = __expf(l[r][2] - mxl);
            const float inv = 1.f / (e0 + e1 + e2);
            e0 *= inv; e1 *= inv; e2 *= inv;
            const uint2 w0 = w[r][0], w1 = w[r][1], w2 = w[r][2];
            uint2 o;
            o.x = pack2(__uint_as_float(w0.x << 16) * e0 + __uint_as_float(w1.x << 16) * e1 + __uint_as_float(w2.x << 16) * e2,
                        __uint_as_float(w0.x & 0xffff0000u) * e0 + __uint_as_float(w1.x & 0xffff0000u) * e1 + __uint_as_float(w2.x & 0xffff0000u) * e2);
            o.y = pack2(__uint_as_float(w0.y << 16) * e0 + __uint_as_float(w1.y << 16) * e1 + __uint_as_float(w2.y << 16) * e2,
                        __uint_as_float(w0.y & 0xffff0000u) * e0 + __uint_as_float(w1.y & 0xffff0000u) * e1 + __uint_as_float(w2.y & 0xffff0000u) * e2);
            *(uint2*)(p.mixin() + (size_t)(row0 + r) * 768 + 512 + lane * 4) = o;
        }
    }
}

__device__ __forceinline__ void ph_outproj(const Params& p, char* smem) {
    const int tid = otid(), lane = tid & 63, wid = tid >> 6, wr = wid >> 1, wc = wid & 1;
    const int xcd = blockIdx.x & 7, nbx = gridDim.x >> 3;
    for (int i = blockIdx.x >> 3; i < 32; i += nbx) {
        const int nt = i >> 3, mt = xcd * 8 + (i & 7);
        const bf16_t* A = p.mixin() + (size_t)mt * 256 * 768;
        const bf16_t* Bt = p.woutT() + (size_t)nt * 256 * 768;
        f32x4 acc[4][8];
        __syncthreads();
        gemm6(smem, 768, [&](int r) { return A + (size_t)r * 768; }, [&](int n) { return Bt + (size_t)n * 768; }, acc);
        const int b = (mt * 256) >> 12;
        const int colb = nt * 256 + wc * 128;
        const float* g1 = p.mod() + b * 6144 + 2048 + colb;
        char* wl = smem + wid * EPI_WAVE;
#pragma unroll
        for (int m = 0; m < 4; ++m) {
            const size_t rbase = (size_t)(mt * 256 + wr * 64 + m * 16) * D + colb;
            epi_f32(wl, lane, [&](int n, int j) { return acc[m][n][j]; },
                    [&](int row, int ch, f32x4 v) {
                        const f32x4 xv = *(const f32x4*)(p.x + rbase + (size_t)row * D + ch * 4);
                        const f32x4 gv = *(const f32x4*)(g1 + ch * 4);
                        f32x4 o;
                        o[0] = ALPHA * xv[0] + gv[0] * v[0]; o[1] = ALPHA * xv[1] + gv[1] * v[1];
                        o[2] = ALPHA * xv[2] + gv[2] * v[2]; o[3] = ALPHA * xv[3] + gv[3] * v[3];
                        *(f32x4*)(p.pre1() + rbase + (size_t)row * D + ch * 4) = o;
                    });
        }
    }
}

__device__ __forceinline__ void ph_ln1(const Params& p) {
    const int tid = otid(), lane = tid & 63, wid = tid >> 6;
    const int rstride = gridDim.x * 8;
    float4 nv[4];
    {
        const float4* xr = (const float4*)(p.pre1() + (size_t)(blockIdx.x * 8 + wid) * D);
#pragma unroll
        for (int i = 0; i < 4; ++i) nv[i] = xr[lane + 64 * i];
    }
    for (int row = blockIdx.x * 8 + wid; row < T; row += rstride) {
        float4 v[4];
        float s = 0.f;
#pragma unroll
        for (int i = 0; i < 4; ++i) { v[i] = nv[i]; s += v[i].x + v[i].y + v[i].z + v[i].w; }
        if (row + rstride < T) {
            const float4* xn = (const float4*)(p.pre1() + (size_t)(row + rstride) * D);
#pragma unroll
            for (int i = 0; i < 4; ++i) nv[i] = xn[lane + 64 * i];
        }
        float mean = wave_sum(s) * (1.f / D);
        float q = 0.f;
#pragma unroll
        for (int i = 0; i < 4; ++i) {
            v[i].x -= mean; v[i].y -= mean; v[i].z -= mean; v[i].w -= mean;
            q += v[i].x * v[i].x + v[i].y * v[i].y + v[i].z * v[i].z + v[i].w * v[i].w;
        }
        float rstd = rsqrtf(wave_sum(q) * (1.f / D) + LN_EPS);
        s = 0.f;
#pragma unroll
        for (int i = 0; i < 4; ++i) {
            const int col = (lane + 64 * i) * 4;
            const float4 g4 = *(const float4*)(p.ln1_g + col), b4 = *(const float4*)(p.ln1_b + col);
            v[i].x = v[i].x * rstd * g4.x + b4.x; v[i].y = v[i].y * rstd * g4.y + b4.y;
            v[i].z = v[i].z * rstd * g4.z + b4.z; v[i].w = v[i].w * rstd * g4.w + b4.w;
            { uint2 xo; xo.x = pack2(v[i].x, v[i].y); xo.y = pack2(v[i].z, v[i].w); *(uint2*)(p.x1() + (size_t)row * D + col) = xo; }
            s += v[i].x + v[i].y + v[i].z + v[i].w;
        }
        mean = wave_sum(s) * (1.f / D);
        q = 0.f;
#pragma unroll
        for (int i = 0; i < 4; ++i) {
            v[i].x -= mean; v[i].y -= mean; v[i].z -= mean; v[i].w -= mean;
            q += v[i].x * v[i].x + v[i].y * v[i].y + v[i].z * v[i].z + v[i].w * v[i].w;
        }
        rstd = rsqrtf(wave_sum(q) * (1.f / D) + LN_EPS);
        const int b = row >> 12;
        const float* sh = p.mod() + b * 6144 + 3072;
        const float* sc = sh + 1024;
#pragma unroll
        for (int i = 0; i < 4; ++i) {
            const int col = (lane + 64 * i) * 4;
            const float4 s4 = *(const float4*)(sc + col), h4 = *(const float4*)(sh + col);
            float4 y;
            y.x = v[i].x * rstd * (1.f + s4.x) + h4.x; y.y = v[i].y * rstd * (1.f + s4.y) + h4.y;
            y.z = v[i].z * rstd * (1.f + s4.z) + h4.z; y.w = v[i].w * rstd * (1.f + s4.w) + h4.w;
            uint2 o;
            o.x = pack2(y.x, y.y); o.y = pack2(y.z, y.w);
            *(uint2*)(p.h2() + (size_t)row * 2048 + col) = o;
            uint2 o2;
            o2.x = pack2h(y.x, y.y);
            o2.y = pack2h(y.z, y.w);
            *(uint2*)(p.h2() + (size_t)row * 2048 + 1024 + col) = o2;
        }
    }
}


__device__ __forceinline__ void topk4_lds(const Params& p, const float* lg, const int tok0, const int lane) {
    constexpr int TK = 4;
        float sc[TK][4], bv[TK][4];
#pragma unroll
    for (int t = 0; t < TK; ++t)
#pragma unroll
        for (int j = 0; j < 4; ++j) {
            const int e = j * 64 + lane;
            const float x = lg[t * NE + e];
            sc[t][j] = 1.f / (1.f + expf(-x));
            bv[t][j] = sc[t][j] + p.router_bias[e];
        }
    float gsum[TK][4];
#pragma unroll
    for (int j = 0; j < 4; ++j) {
        float m1[TK], m2[TK];
#pragma unroll
        for (int t = 0; t < TK; ++t) m1[t] = bv[t][j];
#pragma unroll
        for (int o = 16; o > 0; o >>= 1)
#pragma unroll
            for (int t = 0; t < TK; ++t) m1[t] = fmaxf(m1[t], __shfl_xor(m1[t], o, 64));
#pragma unroll
        for (int t = 0; t < TK; ++t) {
            const unsigned long long bal = __ballot(bv[t][j] == m1[t]);
            const unsigned hm = (unsigned)(bal >> (lane & 32));
            const int first = __ffs(hm) - 1;
            m2[t] = ((lane & 31) == first) ? -INFINITY : bv[t][j];
        }
#pragma unroll
        for (int o = 16; o > 0; o >>= 1)
#pragma unroll
            for (int t = 0; t < TK; ++t) m2[t] = fmaxf(m2[t], __shfl_xor(m2[t], o, 64));
#pragma unroll
        for (int t = 0; t < TK; ++t) gsum[t][j] = m1[t] + m2[t];
    }
    float cand[TK][4];
#pragma unroll
    for (int t = 0; t < TK; ++t) {
        float gs[8];
#pragma unroll
        for (int j = 0; j < 4; ++j) { gs[2 * j] = __shfl(gsum[t][j], 0, 64); gs[2 * j + 1] = __shfl(gsum[t][j], 32, 64); }
        unsigned gmask = 0u;
#pragma unroll
        for (int r = 0; r < 4; ++r) {
            float best = -INFINITY; int bi = 0;
#pragma unroll
            for (int g = 0; g < 8; ++g) {
                const bool ok = (((gmask >> g) & 1u) == 0u) && (gs[g] > best);
                best = ok ? gs[g] : best; bi = ok ? g : bi;
            }
            gmask |= 1u << bi;
        }
#pragma unroll
        for (int j = 0; j < 4; ++j) cand[t][j] = ((gmask >> (2 * j + (lane >> 5))) & 1u) ? bv[t][j] : -INFINITY;
    }
    float wsum[TK], myw[TK];
    int mye[TK];
#pragma unroll
    for (int t = 0; t < TK; ++t) { wsum[t] = 0.f; myw[t] = 0.f; mye[t] = 0; }
#pragma unroll
    for (int r = 0; r < 8; ++r) {
        float bvv[TK]; int be[TK];
#pragma unroll
        for (int t = 0; t < TK; ++t) {
            bvv[t] = cand[t][0]; be[t] = lane;
#pragma unroll
            for (int j = 1; j < 4; ++j) { const bool gt = cand[t][j] > bvv[t]; bvv[t] = gt ? cand[t][j] : bvv[t]; be[t] = gt ? j * 64 + lane : be[t]; }
        }
#pragma unroll
        for (int o = 32; o > 0; o >>= 1)
#pragma unroll
            for (int t = 0; t < TK; ++t) {
                const float ov = __shfl_xor(bvv[t], o, 64);
                const int oe = __shfl_xor(be[t], o, 64);
                const bool take = (ov > bvv[t]) | ((ov == bvv[t]) & (oe < be[t])); bvv[t] = take ? ov : bvv[t]; be[t] = take ? oe : be[t];
            }
#pragma unroll
        for (int t = 0; t < TK; ++t) {
            const int bj = be[t] >> 6;
            unsigned myb = 0u;
#pragma unroll
            for (int j = 0; j < 4; ++j) myb |= (unsigned)(-(int)(bj == j)) & __float_as_uint(sc[t][j]);
            const float mysc = __uint_as_float(myb);
            const float sval = __shfl(mysc, be[t] & 63, 64);
#pragma unroll
            for (int j = 0; j < 4; ++j) cand[t][j] = (be[t] == j * 64 + lane) ? -INFINITY : cand[t][j];
            wsum[t] += sval;
            myw[t] = (lane == r) ? sval : myw[t]; mye[t] = (lane == r) ? be[t] : mye[t];
        }
    }
    if (lane < 8) {
#pragma unroll
        for (int t = 0; t < TK; ++t) {
            const int a = (tok0 + t) * 8 + lane;
            p.topi()[a] = (unsigned char)mye[t];
            p.topw()[a] = myw[t] * (2.5f / wsum[t]);
        }
    }
}

__device__ __forceinline__ void ph_router_topk(const Params& p, char* smem) {
    const int tid = otid(), lane = tid & 63, wid = tid >> 6, fr = lane & 15, fq = lane >> 4;
    float* lgs = (float*)smem;
    for (int mt = blockIdx.x; mt < T / 64; mt += gridDim.x) {
        const bf16_t* A = p.h2() + (size_t)mt * 64 * 2048;
        const int ra = 8 * wid + (lane >> 3);
        const bf16_t* ga = A + (size_t)ra * 2048 + 1024 + (((lane & 7) ^ ((ra >> 1) & 7)) * 8);
        const bf16_t* gb[4];
#pragma unroll
        for (int i = 0; i < 4; ++i) {
            const int r = 8 * (wid + 8 * i) + (lane >> 3);
            gb[i] = p.wrT() + (size_t)r * D + (((lane & 7) ^ ((r >> 1) & 7)) * 8);
        }
        f32x4 acc[4][2];
#pragma unroll
        for (int m = 0; m < 4; ++m) { acc[m][0] = f32x4{0.f, 0.f, 0.f, 0.f}; acc[m][1] = f32x4{0.f, 0.f, 0.f, 0.f}; }
        char* ldA = smem + wid * 1024 + lane * 16;
        char* ldB = smem + 8192 + wid * 1024 + lane * 16;
#define RT_ISSUE(slot, kt_) do { const int ao_ = (kt_) * 64; const int bo_ = (kt_) * 64; \
        __builtin_amdgcn_global_load_lds((const unsigned*)(ga + ao_), (LAS unsigned*)(ldA + (slot) * 40960), 16, 0, 0); \
        _Pragma("unroll") for (int i_ = 0; i_ < 4; ++i_) \
            __builtin_amdgcn_global_load_lds((const unsigned*)(gb[i_] + bo_), (LAS unsigned*)(ldB + (slot) * 40960 + i_ * 8192), 16, 0, 0); } while (0)
        __syncthreads();
        RT_ISSUE(0, 0);
        RT_ISSUE(1, 1);
        int slot = 0, slot2 = 2;
#pragma clang loop unroll(disable)
        for (int kt = 0; kt < 16; ++kt) {
            if (kt + 1 < 16) asm volatile("s_waitcnt vmcnt(5)" ::: "memory");
            else asm volatile("s_waitcnt vmcnt(0)" ::: "memory");
            __builtin_amdgcn_s_barrier();
            if (kt + 2 < 16) RT_ISSUE(slot2, kt + 2);
            const char* sA_ = smem + slot * 40960;
            const char* sB_ = sA_ + 8192;
#pragma unroll
            for (int ks = 0; ks < 2; ++ks) {
                f16x8 af[4];
#pragma unroll
                for (int m = 0; m < 4; ++m) af[m] = *(const f16x8*)(sA_ + swz(m * 16 + fr, ks * 4 + fq));
#pragma unroll
                for (int n = 0; n < 2; ++n) {
                    const f16x8 bfr = *(const f16x8*)(sB_ + swz((2 * wid + n) * 16 + fr, ks * 4 + fq));
#pragma unroll
                    for (int m = 0; m < 4; ++m) acc[m][n] = __builtin_amdgcn_mfma_f32_16x16x32_f16(af[m], bfr, acc[m][n], 0, 0, 0);
                }
            }
            slot = (slot == 2) ? 0 : slot + 1;
            slot2 = (slot2 == 2) ? 0 : slot2 + 1;
        }
#undef RT_ISSUE
        __syncthreads();
#pragma unroll
        for (int m = 0; m < 4; ++m)
#pragma unroll
            for (int n = 0; n < 2; ++n)
#pragma unroll
                for (int j = 0; j < 4; ++j) lgs[(m * 16 + fq * 4 + j) * NE + (2 * wid + n) * 16 + fr] = acc[m][n][j];
        __syncthreads();
        topk4_lds(p, lgs + (wid * 8) * NE, mt * 64 + wid * 8, lane);
        topk4_lds(p, lgs + (wid * 8 + 4) * NE, mt * 64 + wid * 8 + 4, lane);
    }
}


__device__ __forceinline__ unsigned zero_bytes(unsigned x) { return ~(((x & 0x7f7f7f7fu) + 0x7f7f7f7fu) | x | 0x7f7f7f7fu); }
__device__ __forceinline__ void ph_lists(const Params& p, char* smem) {
    const int tid = otid(), lane = tid & 63, wid = tid >> 6;
    int* wtot = (int*)smem;
    for (int e = blockIdx.x; e < NE; e += gridDim.x) {
        __syncthreads();
        const uint4* src = (const uint4*)p.topi() + wid * 1024;
        const unsigned pat = (unsigned)e * 0x01010101u;
        int cl = 0;
        uint4 vv[16];
#pragma unroll
        for (int i = 0; i < 16; ++i) vv[i] = src[i * 64 + lane];
#pragma unroll
        for (int i = 0; i < 16; ++i) {
            const uint4 v = vv[i];
            cl += __popc(zero_bytes(v.x ^ pat)) + __popc(zero_bytes(v.y ^ pat)) + __popc(zero_bytes(v.z ^ pat)) + __popc(zero_bytes(v.w ^ pat));
        }
        const int cntw = (int)wave_sum((float)cl);
        if (lane == 0) wtot[wid] = cntw;
        __syncthreads();
        int base = 0, tot = 0;
        for (int w = 0; w < 8; ++w) { const int c = wtot[w]; if (w < wid) base += c; tot += c; }
        if (tid == 0) p.cnt()[e] = tot;
        int* dst = p.list() + (size_t)e * T;
        for (int i = 0; i < 16; ++i) {
            const uint4 v = src[i * 64 + lane];
            unsigned z[4] = {zero_bytes(v.x ^ pat), zero_bytes(v.y ^ pat), zero_bytes(v.z ^ pat), zero_bytes(v.w ^ pat)};
            const int c = __popc(z[0]) + __popc(z[1]) + __popc(z[2]) + __popc(z[3]);
            int inc = c;
#pragma unroll
            for (int o = 1; o < 64; o <<= 1) { const int t = __shfl_up(inc, o, 64); inc += (lane >= o) ? t : 0; }
            int pos = base + inc - c;
            const int a0 = (wid * 1024 + i * 64 + lane) * 16;
#pragma unroll
            for (int w = 0; w < 4; ++w) {
                unsigned zz = z[w];
                while (zz) {
                    const int b = (__ffs(zz) - 1) >> 3;
                    dst[pos++] = a0 + w * 4 + b;
                    zz &= zz - 1u;
                }
            }
            base += __shfl(inc, 63, 64);
        }
    }
}

struct ExpMap { int* cnt; int* off; int* tile; };
__device__ __forceinline__ ExpMap exp_map(const Params& p, char* smem) {
    ExpMap m;
    m.cnt = (int*)(smem + 98304); m.off = m.cnt + 256; m.tile = m.off + 256;
    const int tid = otid();
    __syncthreads();
    if (tid < NE) m.cnt[tid] = p.cnt()[tid];
    __syncthreads();
    if (tid == 0) {
        int off = 0, tl = 0;
        for (int e = 0; e < NE; ++e) { m.off[e] = off; m.tile[e] = tl; const int c = m.cnt[e]; off += c; tl += (c + 255) >> 8; }
        m.tile[NE] = tl;
    }
    __syncthreads();
    return m;
}
__device__ __forceinline__ int find_expert(const int* tile, int rt) {
    int lo = 0, hi = NE;
    while (hi - lo > 1) { const int mid = (lo + hi) >> 1; if (tile[mid] <= rt) lo = mid; else hi = mid; }
    return lo;
}
#define ROWA(smem) ((int*)((smem) + 98304 + 3328))
#define ROWW(smem) ((float*)((smem) + 98304 + 3328 + 1024))

__device__ __forceinline__ void ph_gateup(const Params& p, char* smem) {
    const int tid = otid(), lane = tid & 63, wid = tid >> 6, wr = wid >> 1, wc = wid & 1;
    const ExpMap em = exp_map(p, smem);
    int* rowA = ROWA(smem);
    const int ntile = em.tile[NE];
    const int U = (ntile + T / 256) * 2;
    const int xcd = blockIdx.x & 7, nbx = gridDim.x >> 3;
    const int lo = (int)(((long long)U * xcd) >> 3), hi = (int)(((long long)U * (xcd + 1)) >> 3);
    for (int u = lo + (blockIdx.x >> 3); u < hi; u += nbx) {
        const int rt = u >> 1, c0 = (u & 1) * 128;
        const float *Wg, *Wu;
        bf16_t* gdst;
        int nrow, tokv = -1;
        if (rt < ntile) {
            const int e = find_expert(em.tile, rt);
            const int r0 = (rt - em.tile[e]) * 256, ne = em.cnt[e];
            Wg = p.w_eg + (size_t)e * D * ED; Wu = p.w_eu + (size_t)e * D * ED;
            gdst = p.gbuf() + ((size_t)em.off[e] + r0) * ED + c0;
            nrow = ne - r0;
            if (tid < 256 && r0 + tid < ne) tokv = p.list()[(size_t)e * T + r0 + tid] >> 3;
        } else {
            const int tb = (rt - ntile) * 256;
            Wg = p.w_sg; Wu = p.w_su;
            gdst = p.gsh() + (size_t)tb * ED + c0;
            nrow = 256;
            tokv = tb + (tid & 255);
        }
        __syncthreads();
        if (tid < 256) rowA[tid] = tokv;
        __syncthreads();
        const int t0 = rowA[0];
        f32x4 acc[4][8];
        gemm5(smem, D,
              [&](int r) { const int t = rowA[r]; return p.h2() + (size_t)(t < 0 ? t0 : t) * 2048; },
              [&](int n) { const int t16 = n >> 4; return ((t16 & 1) ? Wu : Wg) + c0 + 16 * (t16 >> 1) + (n & 15); },
              ED, acc);
        if (wr * 64 < nrow) {
            char* wl = smem + wid * EPI_WAVE;
#pragma unroll
            for (int m = 0; m < 4; ++m) {
                const int rb = wr * 64 + m * 16;
                epi_bf16(wl, lane,
                         [&](int n, int j) { if (n >= 4) return 0.f; const float g = acc[m][2 * n][j], uu = acc[m][2 * n + 1][j]; return g / (1.f + __expf(-g)) * uu; },
                         [&](int row, int ch, u32x4 v) { if (ch < 8 && rb + row < nrow) *(u32x4*)(gdst + (size_t)(rb + row) * ED + wc * 64 + ch * 8) = v; });
            }
        }
    }
}

__device__ __forceinline__ void ph_down(const Params& p, char* smem) {
    const int tid = otid(), lane = tid & 63, wid = tid >> 6, wr = wid >> 1, wc = wid & 1;
    const ExpMap em = exp_map(p, smem);
    int* rowA = ROWA(smem);
    float* rowW = ROWW(smem);
    const int ntile = em.tile[NE];
    const int U = (ntile + T / 256) * 4;
    const int xcd = blockIdx.x & 7, nbx = gridDim.x >> 3;
    const int lo = (int)(((long long)U * xcd) >> 3), hi = (int)(((long long)U * (xcd + 1)) >> 3);
    for (int u = lo + (blockIdx.x >> 3); u < hi; u += nbx) {
        const int rt = u >> 2, nt = u & 3;
        const bf16_t* A;
        const float* W;
        int nrow, slot = -1;
        float wv = 0.f;
        if (rt < ntile) {
            const int e = find_expert(em.tile, rt);
            const int r0 = (rt - em.tile[e]) * 256, ne = em.cnt[e];
            A = p.gbuf() + ((size_t)em.off[e] + r0) * ED;
            W = p.w_ed + (size_t)e * ED * D + nt * 256;
            nrow = ne - r0;
            if (tid < 256 && r0 + tid < ne) {
                const int a = p.list()[(size_t)e * T + r0 + tid];
                slot = a;
                wv = p.topw()[a] * Y8_SCALE;
            }
        } else {
            const int tb = (rt - ntile) * 256;
            A = p.gsh() + (size_t)tb * ED;
            W = p.w_sd + nt * 256;
            nrow = 256;
            slot = tb + (tid & 255);
            wv = 1.f;
        }
        __syncthreads();
        if (tid < 256) { rowA[tid] = slot; rowW[tid] = wv; }
        __syncthreads();
        f32x4 acc[4][8];
        gemm5(smem, ED, [&](int r) { return A + (size_t)(r < nrow ? r : 0) * ED; }, [&](int n) { return W + n; }, D, acc);
        if (wr * 64 < nrow) {
            char* wl = smem + wid * EPI_WAVE;
#pragma unroll
            for (int m = 0; m < 4; ++m) {
                const int rb = wr * 64 + m * 16;
                float wj[4];
#pragma unroll
                for (int j = 0; j < 4; ++j) wj[j] = rowW[rb + (lane >> 4) * 4 + j];
                if (rt < ntile) {
                    epi_fp8(wl, lane, [&](int n, int j) { return __builtin_amdgcn_fmed3f(acc[m][n][j] * wj[j], -440.f, 440.f); },
                            [&](int row, int ch, u32x4 v) {
                                const int sl = rowA[rb + row];
                                if (sl >= 0) *(u32x4*)(p.ybuf() + (size_t)sl * D + nt * 256 + wc * 128 + ch * 16) = v;
                            });
                } else {
                    epi_bf16(wl, lane, [&](int n, int j) { return acc[m][n][j]; },
                             [&](int row, int ch, u32x4 v) {
                                 const int sl = rowA[rb + row];
                                 *(u32x4*)(p.ysh() + (size_t)sl * D + nt * 256 + wc * 128 + ch * 8) = v;
                             });
                }
            }
        }
    }
}

__device__ __forceinline__ void ph_final(const Params& p) {
    const int tid = otid(), lane = tid & 63, wid = tid >> 6;
    for (int row = blockIdx.x * 8 + wid; row < T; row += gridDim.x * 8) {
        const int b = row >> 12;
        const float* g2 = p.mod() + b * 6144 + 5120;
        float4 v[4];
        float s = 0.f;
#pragma unroll
        for (int i = 0; i < 4; ++i) {
            const int col = (lane + 64 * i) * 4;
            float f0 = 0.f, f1 = 0.f, f2 = 0.f, f3 = 0.f;
#pragma unroll
            for (int k = 0; k < 8; ++k) {
                const int w8 = *(const int*)(p.ybuf() + ((size_t)row * 8 + k) * D + col);
                const v2f_t lo = __builtin_amdgcn_cvt_pk_f32_fp8(w8, false), hi = __builtin_amdgcn_cvt_pk_f32_fp8(w8, true);
                f0 += lo[0]; f1 += lo[1]; f2 += hi[0]; f3 += hi[1];
            }
            f0 *= (1.f / Y8_SCALE); f1 *= (1.f / Y8_SCALE); f2 *= (1.f / Y8_SCALE); f3 *= (1.f / Y8_SCALE);
            {
                const uint2 w = *(const uint2*)(p.ysh() + (size_t)row * D + col);
                f0 += __uint_as_float(w.x << 16); f1 += __uint_as_float(w.x & 0xffff0000u);
                f2 += __uint_as_float(w.y << 16); f3 += __uint_as_float(w.y & 0xffff0000u);
            }
            float4 xv;
            { const uint2 xw = *(const uint2*)(p.x1() + (size_t)row * D + col);
              xv.x = __uint_as_float(xw.x << 16); xv.y = __uint_as_float(xw.x & 0xffff0000u); xv.z = __uint_as_float(xw.y << 16); xv.w = __uint_as_float(xw.y & 0xffff0000u); }
            const float4 g4 = *(const float4*)(g2 + col);
            v[i].x = ALPHA * xv.x + g4.x * f0; v[i].y = ALPHA * xv.y + g4.y * f1;
            v[i].z = ALPHA * xv.z + g4.z * f2; v[i].w = ALPHA * xv.w + g4.w * f3;
            s += v[i].x + v[i].y + v[i].z + v[i].w;
        }
        const float mean = wave_sum(s) * (1.f / D);
        float q = 0.f;
#pragma unroll
        for (int i = 0; i < 4; ++i) {
            v[i].x -= mean; v[i].y -= mean; v[i].z -= mean; v[i].w -= mean;
            q += v[i].x * v[i].x + v[i].y * v[i].y + v[i].z * v[i].z + v[i].w * v[i].w;
        }
        const float rstd = rsqrtf(wave_sum(q) * (1.f / D) + LN_EPS);
#pragma unroll
        for (int i = 0; i < 4; ++i) {
            const int col = (lane + 64 * i) * 4;
            const float4 g4 = *(const float4*)(p.ln2_g + col), b4 = *(const float4*)(p.ln2_b + col);
            float4 y;
            y.x = v[i].x * rstd * g4.x + b4.x; y.y = v[i].y * rstd * g4.y + b4.y;
            y.z = v[i].z * rstd * g4.z + b4.z; y.w = v[i].w * rstd * g4.w + b4.w;
            *(float4*)(p.out + (size_t)row * D + col) = y;
        }
    }
}

constexpr int LDS_BYTES = 2 * VB_LDS + 16;
constexpr int NPHASE = 13;

template <int PH>
__device__ __forceinline__ void run_phase(const Params& p, char* smem) {
    if (PH == 0) ph_mod(p, smem);
    if (PH == 1) ph_ln0(p);
    if (PH == 2) ph_inproj(p, smem);
    if (PH == 3) { ph_h1(p, smem); ph_attn(p, smem); }
    if (PH == 4) { ph_h2(p); ph_attn_merge(p); }
    if (PH == 5) ph_h3(p, smem);
    if (PH == 6) ph_outproj(p, smem);
    if (PH == 7) ph_ln1(p);
    if (PH == 8) ph_router_topk(p, smem);
    if (PH == 9) ph_lists(p, smem);
    if (PH == 10) ph_gateup(p, smem);
    if (PH == 11) ph_down(p, smem);
    if (PH == 12) ph_final(p);
}

template <int PH>
__global__ void __launch_bounds__(NTHREADS, 2) k_phase(Params p) {
    extern __shared__ __attribute__((aligned(16))) char smem[];
    run_phase<PH>(p, smem);
}

__global__ void __launch_bounds__(NTHREADS, 2) k_all(Params p) {
    extern __shared__ __attribute__((aligned(16))) char smem[];
    volatile LAS unsigned* st = (volatile LAS unsigned*)(smem + LDS_BYTES - 16);
    if (threadIdx.x == 0) { st[0] = 0u; st[1] = 0u; st[2] = 0u; st[3] = 0u; }
    __syncthreads();
    XcdBarrier bar = xcd_barrier_post(p.bar(), st);
    run_phase<0>(p, smem); xcd_barrier(bar);
    run_phase<1>(p, smem); xcd_barrier(bar);
    run_phase<2>(p, smem); xcd_barrier(bar);
    run_phase<3>(p, smem); xcd_barrier(bar);
    run_phase<4>(p, smem); xcd_barrier(bar);
    run_phase<5>(p, smem); xcd_barrier(bar);
    run_phase<6>(p, smem); xcd_barrier(bar);
    run_phase<7>(p, smem); xcd_barrier(bar);
    run_phase<8>(p, smem); xcd_barrier(bar);
    run_phase<9>(p, smem); xcd_barrier(bar);
    run_phase<10>(p, smem); xcd_barrier(bar);
    run_phase<11>(p, smem); xcd_barrier(bar);
    run_phase<12>(p, smem);
}

template <int PH>
static void launch_phase(const Params& p, int grid, hipStream_t stream) {
    static bool attr = false;
    if (!attr) { (void)hipFuncSetAttribute((const void*)k_phase<PH>, hipFuncAttributeMaxDynamicSharedMemorySize, LDS_BYTES); attr = true; }
    hipLaunchKernelGGL(k_phase<PH>, dim3(grid), dim3(NTHREADS), LDS_BYTES, stream, p);
}

extern "C" void kernel_launch(void* const* d_in, const int* in_sizes, int n_in, void* d_out, int out_size, void* d_ws, size_t ws_size,
                              hipStream_t stream) {
    (void)in_sizes; (void)n_in; (void)out_size;
    Params p{};
    const float** pin = (const float**)&p.x;
    for (int i = 0; i < 21; ++i) pin[i] = (const float*)d_in[i];
    p.out = (float*)d_out;
    p.ws = (char*)d_ws;
    char* ctl = p.ws + WO_ctl;
    if (WS_END > ws_size) { fprintf(stderr, "kernel_launch: workspace too small: need %zu have %zu\n", (size_t)WS_END, ws_size); return; }

    static int grid = 0;
    if (grid == 0) {
        int dev = 0, cus = 0, per_cu = 0;
        (void)hipGetDevice(&dev);
        (void)hipDeviceGetAttribute(&cus, hipDeviceAttributeMultiprocessorCount, dev);
        (void)hipFuncSetAttribute((const void*)k_all, hipFuncAttributeMaxDynamicSharedMemorySize, LDS_BYTES);
        (void)hipOccupancyMaxActiveBlocksPerMultiprocessor(&per_cu, (const void*)k_all, NTHREADS, LDS_BYTES);
        grid = cus;
        if (grid != 256) grid = 256;
        fprintf(stderr, "kernel_launch: cus %d per_cu %d grid %d ws need %zu have %zu\n", cus, per_cu, grid, (size_t)WS_END, ws_size);
    }
    (void)hipMemsetAsync(ctl, 0, 65536, stream);
#if ONE_LAUNCH
    hipLaunchKernelGGL(k_all, dim3(grid), dim3(NTHREADS), LDS_BYTES, stream, p);
#else
    launch_phase<0>(p, grid, stream); launch_phase<1>(p, grid, stream); launch_phase<2>(p, grid, stream); launch_phase<3>(p, grid, stream);
    launch_phase<4>(p, grid, stream); launch_phase<5>(p, grid, stream); launch_phase<6>(p, grid, stream); launch_phase<7>(p, grid, stream);
    launch_phase<8>(p, grid, stream); launch_phase<9>(p, grid, stream); launch_phase<10>(p, grid, stream); launch_phase<11>(p, grid, stream);
    launch_phase<12>(p, grid, stream);
#endif
}
```

```cpp
#include <hip/hip_runtime.h>
#include <stdint.h>
#include <stdio.h>

#ifndef ONE_LAUNCH
#define ONE_LAUNCH 1
#endif

constexpr int D = 1024, NBATCH = 4, S = 4096, T = NBATCH * S;
constexpr int INW = 4352;
constexpr int NE = 256, TOPK = 8, ED = 256;
constexpr int OFF_HQ = 0, OFF_HF = 512, OFF_HI = 1024, OFF_HG = 1536, OFF_AQ = 2048, OFF_AK = 2816, OFF_AV = 3584;
constexpr float ALPHA = 1.189207115002721f;
constexpr float LN_EPS = 1e-5f, RMS_EPS = 1e-6f;
constexpr int NTHREADS = 512;
constexpr int VB_LDS = 67584;

typedef unsigned short bf16_t;
using bf16x8 = __attribute__((ext_vector_type(8))) short;
using f32x4 = __attribute__((ext_vector_type(4))) float;
using u32x4 = __attribute__((ext_vector_type(4))) unsigned int;

typedef float v2f_t __attribute__((ext_vector_type(2)));
typedef __bf16 v2bf_t __attribute__((ext_vector_type(2)));
typedef short v4s __attribute__((ext_vector_type(4)));
typedef _Float16 v2h_t __attribute__((ext_vector_type(2)));
using f16x8 = __attribute__((ext_vector_type(8))) _Float16;
__device__ __forceinline__ uint32_t pack2h(float a, float b) { const v2f_t f = {a, b}; return __builtin_bit_cast(uint32_t, __builtin_convertvector(f, v2h_t)); }
__device__ __forceinline__ unsigned short f2bf(float f) { return __builtin_bit_cast(unsigned short, (__bf16)f); }
__device__ __forceinline__ float bf2f(unsigned short h) { return __uint_as_float(((uint32_t)h) << 16); }
__device__ __forceinline__ uint32_t pack2(float a, float b) {
    const v2f_t f = {a, b};
    return __builtin_bit_cast(uint32_t, __builtin_convertvector(f, v2bf_t));
}
__device__ __forceinline__ float sigmoidf_(float v) { return 1.f / (1.f + __expf(-v)); }

__device__ __forceinline__ int otid() { int t = threadIdx.x; asm volatile("" : "+v"(t)); return t; }

constexpr size_t al256(size_t x) { return (x + 255) & ~(size_t)255; }
constexpr size_t WO_ctl = 0;
constexpr size_t WO_mod = WO_ctl + al256(65536);
constexpr size_t WO_lbv = WO_mod + al256(4 * 6144 * 4);
constexpr size_t WO_biasT = WO_lbv + al256(512 * 4);
constexpr size_t WO_winT = WO_biasT + al256(3 * 129 * 4 * 4);
constexpr size_t WO_woutT = WO_winT + al256((size_t)INW * D * 2);
constexpr size_t WO_wrT = WO_woutT + al256((size_t)D * 768 * 2);
constexpr size_t WO_wsgT = WO_wrT + al256((size_t)2 * NE * D * 2);
constexpr size_t WO_wsuT = WO_wsgT + al256((size_t)ED * D * 2);
constexpr size_t WO_wsdT = WO_wsuT + al256((size_t)ED * D * 2);
constexpr size_t WO_h1 = WO_wsdT + al256((size_t)D * ED * 2);
constexpr size_t WO_proj = WO_h1 + al256((size_t)T * D * 2);
constexpr size_t WO_lgf = WO_proj + al256((size_t)T * INW * 2);
constexpr size_t WO_ao = WO_lgf + al256((size_t)T * 512 * 4);
constexpr size_t WO_alse = WO_ao + al256((size_t)3 * T * 256 * 4);
constexpr size_t WO_mixin = WO_alse + al256((size_t)3 * T * 4 * 4);
constexpr size_t WO_pre1 = WO_mixin + al256((size_t)T * 768 * 2);
constexpr size_t WO_x1 = WO_pre1 + al256((size_t)T * D * 4);
constexpr size_t WO_h2 = WO_x1 + al256((size_t)T * D * 2);
constexpr size_t WO_lgp = WO_h2 + al256((size_t)T * 2048 * 2);
constexpr size_t WO_topi = WO_lgp + al256((size_t)3 * T * NE * 4);
constexpr size_t WO_topw = WO_topi + al256((size_t)T * 8 * 4);
constexpr size_t WO_list = WO_topw + al256((size_t)T * 8 * 4);
constexpr size_t WO_gbuf = WO_list + al256((size_t)NE * T * 4);
constexpr size_t WO_gsh = WO_gbuf + al256((size_t)T * TOPK * ED * 2);
constexpr size_t WO_ybuf = WO_gsh + al256((size_t)T * ED * 2);
constexpr size_t WO_ysh = WO_ybuf + al256((size_t)T * 8 * D);
constexpr size_t WO_dec = WO_ysh + al256((size_t)T * D * 2);
constexpr size_t WS_END = WO_dec + al256((size_t)1024 * 128 * 4);
struct Params {
    const float *x, *c, *w_ada, *b_ada, *w_in, *hg_lb, *hg_nw, *rel_bias, *w_out, *ln1_g, *ln1_b, *w_router, *router_bias,
        *w_eg, *w_eu, *w_ed, *w_sg, *w_su, *w_sd, *ln2_g, *ln2_b;
    float* out;
    char* ws;
    __device__ __forceinline__ unsigned* bar() const { return (unsigned*)(ws + WO_ctl); }
    __device__ __forceinline__ int* cnt() const { return (int*)(ws + WO_ctl + 16384); }
    __device__ __forceinline__ bf16_t* kv() const { return (bf16_t*)(ws + WO_ybuf); }
    __device__ __forceinline__ bf16_t* sst() const { return (bf16_t*)(ws + WO_ybuf + (size_t)1024 * 16384 * 4); }
    __device__ __forceinline__ float* mod() const { return (float*)(ws + WO_mod); }
    __device__ __forceinline__ float* lbv() const { return (float*)(ws + WO_lbv); }
    __device__ __forceinline__ float* biasT() const { return (float*)(ws + WO_biasT); }
    __device__ __forceinline__ bf16_t* winT() const { return (bf16_t*)(ws + WO_winT); }
    __device__ __forceinline__ bf16_t* woutT() const { return (bf16_t*)(ws + WO_woutT); }
    __device__ __forceinline__ bf16_t* wrT() const { return (bf16_t*)(ws + WO_wrT); }
    __device__ __forceinline__ bf16_t* wsgT() const { return (bf16_t*)(ws + WO_wsgT); }
    __device__ __forceinline__ bf16_t* wsuT() const { return (bf16_t*)(ws + WO_wsuT); }
    __device__ __forceinline__ bf16_t* wsdT() const { return (bf16_t*)(ws + WO_wsdT); }
    __device__ __forceinline__ bf16_t* h1() const { return (bf16_t*)(ws + WO_h1); }
    __device__ __forceinline__ bf16_t* proj() const { return (bf16_t*)(ws + WO_proj); }
    __device__ __forceinline__ float* lgf() const { return (float*)(ws + WO_lgf); }
    __device__ __forceinline__ bf16_t* ao() const { return (bf16_t*)(ws + WO_ao); }
    __device__ __forceinline__ float* alse() const { return (float*)(ws + WO_alse); }
    __device__ __forceinline__ bf16_t* mixin() const { return (bf16_t*)(ws + WO_mixin); }
    __device__ __forceinline__ float* pre1() const { return (float*)(ws + WO_pre1); }
    __device__ __forceinline__ bf16_t* x1() const { return (bf16_t*)(ws + WO_x1); }
    __device__ __forceinline__ bf16_t* h2() const { return (bf16_t*)(ws + WO_h2); }
    __device__ __forceinline__ float* lgp() const { return (float*)(ws + WO_lgp); }
    __device__ __forceinline__ unsigned char* topi() const { return (unsigned char*)(ws + WO_topi); }
    __device__ __forceinline__ float* topw() const { return (float*)(ws + WO_topw); }
    __device__ __forceinline__ int* list() const { return (int*)(ws + WO_list); }
    __device__ __forceinline__ bf16_t* gbuf() const { return (bf16_t*)(ws + WO_gbuf); }
    __device__ __forceinline__ bf16_t* gsh() const { return (bf16_t*)(ws + WO_gsh); }
    __device__ __forceinline__ unsigned char* ybuf() const { return (unsigned char*)(ws + WO_ybuf); }
    __device__ __forceinline__ bf16_t* ysh() const { return (bf16_t*)(ws + WO_ysh); }
    __device__ __forceinline__ float* dec() const { return (float*)(ws + WO_dec); }
};

#define XB_TMO      128
#define XB_XCNT(j)  (256  + 64 * (j))
#define XB_XSUB(j)  (1280 + 64 * (j))
#define XB_XGEN(j)  (2304 + 64 * (j))
#define XB_TOP      3328
#define XB_TOPGEN   3392
#define XCD_BAR_WORDS 3456
#define XB_SPIN_CAP (1u << 18)
#define LAS __attribute__((address_space(3)))

__device__ __forceinline__ unsigned xb_ld(unsigned* p)              { return __hip_atomic_load(p, __ATOMIC_RELAXED, __HIP_MEMORY_SCOPE_AGENT); }
__device__ __forceinline__ unsigned xb_add(unsigned* p, unsigned v) { return __hip_atomic_fetch_add(p, v, __ATOMIC_RELAXED, __HIP_MEMORY_SCOPE_AGENT); }
__device__ __forceinline__ unsigned xb_xcc_id() { return (unsigned)__builtin_amdgcn_s_getreg((3 << 11) | 20) & 0xFu; }
#define XB_SPIN(cond, bar) do { unsigned _sp = 0; while (cond) { __builtin_amdgcn_s_sleep(1); \
    if ((++_sp & 255u) == 0u) { if (xb_ld(&(bar)[XB_TMO])) break; if (_sp > XB_SPIN_CAP) { atomicAdd(&(bar)[XB_TMO], 1u); break; } } } } while (0)

struct XcdBarrier {
    unsigned* bar; unsigned x;
    volatile LAS unsigned* st;
};
__device__ __forceinline__ XcdBarrier xcd_barrier_post(unsigned* bar, volatile LAS unsigned* st) {
    XcdBarrier b; b.bar = bar; b.x = xb_xcc_id(); b.st = st;
    if (threadIdx.x == 0) (void)xb_add(&bar[XB_XCNT(b.x)], 1u);
    return b;
}
__device__ __forceinline__ void xcd_barrier_complete(unsigned* bar, unsigned x, unsigned& nloc, unsigned& nx) {
    const unsigned G = gridDim.x * gridDim.y * gridDim.z;
    unsigned sum, cnt, mine, sp = 0u;
    for (;;) {
        sum = 0u; cnt = 0u; mine = 0u;
#pragma unroll
        for (unsigned j = 0; j < 16; ++j) { const unsigned c = xb_ld(&bar[XB_XCNT(j)]); sum += c; cnt += (c > 0u) ? 1u : 0u; mine = (j == x) ? c : mine; }
        if (sum == G) break;
        __builtin_amdgcn_s_sleep(1);
        if ((++sp & 255u) == 0u) { if (xb_ld(&bar[XB_TMO])) break; if (sp > XB_SPIN_CAP) { atomicAdd(&bar[XB_TMO], 1u); break; } }
    }
    nloc = mine > 0u ? mine : 1u; nx = cnt > 0u ? cnt : 1u;
}
__device__ __forceinline__ void xcd_barrier(const XcdBarrier& b) {
    asm volatile("s_waitcnt vmcnt(0)" ::: "memory");
    __syncthreads();
    if (threadIdx.x == 0) {
        unsigned* bar = b.bar;
        __builtin_amdgcn_s_waitcnt(0);
        unsigned nloc = b.st[0], nx = b.st[1];
        if (nloc == 0u) { xcd_barrier_complete(bar, b.x, nloc, nx); b.st[0] = nloc; b.st[1] = nx; }
        const unsigned old = xb_add(&bar[XB_XSUB(b.x)], 1u);
        const unsigned gen = old / nloc;
        if (old + 1u == (gen + 1u) * nloc) {
            __builtin_amdgcn_fence(__ATOMIC_RELEASE, "agent");
            asm volatile("s_waitcnt vmcnt(0)" ::: "memory");
            const unsigned og = xb_add(&bar[XB_TOP], 1u);
            const unsigned tg = og / nx;
            if (og + 1u == (tg + 1u) * nx) xb_add(&bar[XB_TOPGEN], 1u);
            else XB_SPIN(xb_ld(&bar[XB_TOPGEN]) == tg, bar);
            __builtin_amdgcn_fence(__ATOMIC_ACQUIRE, "agent");
            xb_add(&bar[XB_XGEN(b.x)], 1u);
            asm volatile("s_waitcnt vmcnt(0)" ::: "memory");
        } else {
            XB_SPIN(xb_ld(&bar[XB_XGEN(b.x)]) == gen, bar);
            __builtin_amdgcn_fence(__ATOMIC_ACQUIRE, "agent");
            asm volatile("s_waitcnt vmcnt(0)" ::: "memory");
        }
    }
    __syncthreads();
}

struct VB { int vb, nvb, tid; char* smem; };
__device__ __forceinline__ VB make_vb(char* smem) {
    const int t = otid();
    VB v; v.vb = (int)blockIdx.x * 2 + (t >> 8); v.nvb = (int)gridDim.x * 2; v.tid = t & 255; v.smem = smem + (t >> 8) * VB_LDS;
    return v;
}
__device__ __forceinline__ int swz(int row, int chunk) { return row * 128 + ((chunk ^ ((row >> 1) & 7)) << 4); }

__device__ __forceinline__ float wave_sum(float v) {
#pragma unroll
    for (int o = 32; o > 0; o >>= 1) v += __shfl_xor(v, o, 64);
    return v;
}

__device__ __forceinline__ int t5_bucket(int n) {
    if (n < 16) return n;
    const float v = logf((float)n / 16.f) / logf(128.f) * 16.f;
    int large = 16 + (int)v;
    return large < 31 ? large : 31;
}

__device__ __forceinline__ void tr_tile(const VB& v, const float* src, int ld, bf16_t* dst, bf16_t* dst2, int ldd, int k0, int n0) {
    float* t = (float*)v.smem;
    __syncthreads();
#pragma unroll
    for (int i = 0; i < 4; ++i) {
        const int r = (v.tid >> 4) + 16 * i, c4 = v.tid & 15;
        const f32x4 x = *(const f32x4*)(src + (size_t)(k0 + r) * ld + n0 + c4 * 4);
        t[r * 65 + c4 * 4 + 0] = x[0]; t[r * 65 + c4 * 4 + 1] = x[1]; t[r * 65 + c4 * 4 + 2] = x[2]; t[r * 65 + c4 * 4 + 3] = x[3];
    }
    __syncthreads();
    const int n = v.tid >> 2, kq = v.tid & 3;
    float f[16];
#pragma unroll
    for (int i = 0; i < 16; ++i) f[i] = t[(kq * 16 + i) * 65 + n];
    u32x4 a, b;
    a[0] = pack2(f[0], f[1]); a[1] = pack2(f[2], f[3]); a[2] = pack2(f[4], f[5]); a[3] = pack2(f[6], f[7]);
    b[0] = pack2(f[8], f[9]); b[1] = pack2(f[10], f[11]); b[2] = pack2(f[12], f[13]); b[3] = pack2(f[14], f[15]);
    bf16_t* d = dst + (size_t)(n0 + n) * ldd + k0 + kq * 16;
    *(u32x4*)d = a; *(u32x4*)(d + 8) = b;
    if (dst2) {
        u32x4 c, e;
#pragma unroll
        for (int i = 0; i < 4; ++i) { c[i] = pack2h(f[2 * i], f[2 * i + 1]); e[i] = pack2h(f[8 + 2 * i], f[8 + 2 * i + 1]); }
        bf16_t* d2 = dst2 + (size_t)(n0 + n) * ldd + k0 + kq * 16;
        *(u32x4*)d2 = c; *(u32x4*)(d2 + 8) = e;
    }
}

__device__ __forceinline__ void ph_mod(const Params& p, char* smem0) {
    const VB v = make_vb(smem0);
    const int tid = v.tid;
    float* cond = (float*)(v.smem + 20480);
    float* red = cond + 4096;
    for (int i = tid; i < 4096; i += 256) { const float x = p.c[i]; cond[i] = x / (1.f + __expf(-x)); }
    __syncthreads();
    const int NU = 194 + 1088 + 192 + 64 + 64 + 64 + 64;
    const int rounds = (NU + v.nvb - 1) / v.nvb;
    for (int it = 0; it < rounds; ++it) {
        int u = v.vb + it * v.nvb;
        if (u >= NU) u = NU - 1;
        if (u < 192) {
            const int c4 = tid & 7, kq = tid >> 3;
            f32x4 a0 = {0.f, 0.f, 0.f, 0.f}, a1 = a0, a2 = a0, a3 = a0;
            const float* wp = p.w_ada + u * 32 + c4 * 4;
#pragma unroll 8
            for (int k = kq; k < 1024; k += 32) {
                const f32x4 w = *(const f32x4*)(wp + (size_t)k * 6144);
                a0 += cond[k] * w; a1 += cond[1024 + k] * w; a2 += cond[2048 + k] * w; a3 += cond[3072 + k] * w;
            }
            *(f32x4*)(red + (kq * 4 + 0) * 32 + c4 * 4) = a0; *(f32x4*)(red + (kq * 4 + 1) * 32 + c4 * 4) = a1;
            *(f32x4*)(red + (kq * 4 + 2) * 32 + c4 * 4) = a2; *(f32x4*)(red + (kq * 4 + 3) * 32 + c4 * 4) = a3;
        }
        __syncthreads();
        if (u < 192) {
            if (tid < 128) {
                const int b = tid >> 5, c2 = tid & 31;
                float s = 0.f;
                for (int q = 0; q < 32; ++q) s += red[(q * 4 + b) * 32 + c2];
                p.mod()[b * 6144 + u * 32 + c2] = s + p.b_ada[u * 32 + c2];
            }
        } else if (u == 192) {
            for (int j = tid; j < 512; j += 256) {
                const float a = p.hg_lb[j], b = p.hg_lb[512 + j];
                const float m = fmaxf(a, b);
                const float ea = expf(a - m), eb = expf(b - m);
                p.lbv()[j] = ea / (ea + eb);
            }
        } else if (u == 193) {
            for (int i = tid; i < 3 * 129 * 4; i += 256) {
                const int g = i / (129 * 4), m = (i >> 2) % 129, hh = i & 3;
                const int dil = (g == 0) ? 1 : (g == 1 ? 4 : 16);
                p.biasT()[i] = p.rel_bias[t5_bucket(m * dil) * 12 + g * 4 + hh];
            }
        }
        {
            int w = u - 194;
            const float* src = p.w_out; int ld = D; bf16_t* dst = p.woutT(); bf16_t* dst2 = nullptr; int ldd = 768, k0 = 0, n0 = 0;
            if (w >= 0) {
                if (w < 1088) { src = p.w_in; ld = INW; dst = p.winT(); ldd = D; k0 = (w / 68) * 64; n0 = (w % 68) * 64; }
                else if ((w -= 1088) < 192) { k0 = (w >> 4) * 64; n0 = (w & 15) * 64; }
                else if ((w -= 192) < 64) { src = p.w_router; ld = NE; dst = p.wrT() + (size_t)NE * D; dst2 = p.wrT(); ldd = D; k0 = (w >> 2) * 64; n0 = (w & 3) * 64; }
                else if ((w -= 64) < 64) { src = p.w_sg; ld = ED; dst = p.wsgT(); ldd = D; k0 = (w >> 2) * 64; n0 = (w & 3) * 64; }
                else if ((w -= 64) < 64) { src = p.w_su; ld = ED; dst = p.wsuT(); ldd = D; k0 = (w >> 2) * 64; n0 = (w & 3) * 64; }
                else { w -= 64; src = p.w_sd; ld = D; dst = p.wsdT(); ldd = ED; k0 = (w >> 4) * 64; n0 = (w & 15) * 64; }
            }
            tr_tile(v, src, ld, dst, dst2, ldd, k0, n0);
        }
    }
}

__device__ __forceinline__ void ph_ln0(const Params& p) {
    const int tid = otid(), lane = tid & 63, wid = tid >> 6;
    const int rstride = gridDim.x * 8;
    float4 nv[4];
    {
        const float4* xr = (const float4*)(p.x + (size_t)(blockIdx.x * 8 + wid) * D);
#pragma unroll
        for (int i = 0; i < 4; ++i) nv[i] = xr[lane + 64 * i];
    }
    for (int row = blockIdx.x * 8 + wid; row < T; row += rstride) {
        float4 v[4];
        float s = 0.f;
#pragma unroll
        for (int i = 0; i < 4; ++i) { v[i] = nv[i]; s += v[i].x + v[i].y + v[i].z + v[i].w; }
        if (row + rstride < T) {
            const float4* xn = (const float4*)(p.x + (size_t)(row + rstride) * D);
#pragma unroll
            for (int i = 0; i < 4; ++i) nv[i] = xn[lane + 64 * i];
        }
        const float mean = wave_sum(s) * (1.f / D);
        float q = 0.f;
#pragma unroll
        for (int i = 0; i < 4; ++i) {
            v[i].x -= mean; v[i].y -= mean; v[i].z -= mean; v[i].w -= mean;
            q += v[i].x * v[i].x + v[i].y * v[i].y + v[i].z * v[i].z + v[i].w * v[i].w;
        }
        const float rstd = rsqrtf(wave_sum(q) * (1.f / D) + LN_EPS);
        const int b = row >> 12;
        const float* sh = p.mod() + b * 6144;
        const float* sc = sh + 1024;
#pragma unroll
        for (int i = 0; i < 4; ++i) {
            const int col = (lane + 64 * i) * 4;
            const float4 s4 = *(const float4*)(sc + col), h4 = *(const float4*)(sh + col);
            uint2 o;
            o.x = pack2(v[i].x * rstd * (1.f + s4.x) + h4.x, v[i].y * rstd * (1.f + s4.y) + h4.y);
            o.y = pack2(v[i].z * rstd * (1.f + s4.z) + h4.z, v[i].w * rstd * (1.f + s4.w) + h4.w);
            *(uint2*)(p.h1() + (size_t)row * D + col) = o;
        }
    }
}

__device__ __forceinline__ int swz16(int row, int chunk) { return row * 256 + ((chunk ^ (row & 15)) << 4); }
struct TrBase { int lo, hi; };
__device__ __forceinline__ TrBase tr16_base(int lane) {
    const int g = lane >> 4, q = (lane & 15) >> 2, pp = lane & 3;
    const int xl = 8 * (g & 1) + q, h = pp >> 1;
    TrBase t;
    t.lo = (8 * g + q) * 256 + ((xl >> 1) << 5) + ((h ^ (xl & 1)) << 4) + 8 * (pp & 1);
    t.hi = (t.lo + 1024) ^ 64;
    return t;
}
__device__ __forceinline__ bf16x8 tr_frag16(const char* tile, const TrBase& tb, int ks, int c) {
    int cx = c << 5;
    asm volatile("" : "+v"(cx));
    const v4s lo = __builtin_amdgcn_ds_read_tr16_b64_v4i16((LAS v4s*)(tile + ks * 8192 + (tb.lo ^ cx)));
    const v4s hi = __builtin_amdgcn_ds_read_tr16_b64_v4i16((LAS v4s*)(tile + ks * 8192 + (tb.hi ^ cx)));
    return bf16x8{lo[0], lo[1], lo[2], lo[3], hi[0], hi[1], hi[2], hi[3]};
}


__device__ __forceinline__ int aoff(int row, int chunk) { return row * 64 + ((chunk ^ ((row >> 2) & 3)) << 4); }
__device__ __forceinline__ int boff(int row, int chunk) { return row * 512 + ((chunk ^ (((row & 3) << 1) | (((row >> 3) & 1) << 3))) << 4); }
__device__ __forceinline__ bf16x8 tr_pair(const char* p) {
    const v4s lo = __builtin_amdgcn_ds_read_tr16_b64_v4i16((LAS v4s*)(p));
    const v4s hi = __builtin_amdgcn_ds_read_tr16_b64_v4i16((LAS v4s*)(p + 2048));
    return bf16x8{lo[0], lo[1], lo[2], lo[3], hi[0], hi[1], hi[2], hi[3]};
}
constexpr int G3_STAGE = 32768;

template <int BMODE, class AF, class BF>
__device__ __forceinline__ void gemm3(char* smem, const int K, AF arow, BF bsrc, const int ldb, f32x4 (&acc)[4][8], const int nvalid = 256) {
    const int tid = otid(), lane = tid & 63, wid = tid >> 6, wr = wid >> 1, wc = wid & 1, fr = lane & 15, fq = lane >> 4;
    const bf16_t* ap[2];
#pragma unroll
    for (int i = 0; i < 2; ++i) ap[i] = arow((tid >> 2) + 128 * i) + (tid & 3) * 8;
    const float* bpf = nullptr;
    const bf16_t* bpb[2] = {nullptr, nullptr};
    if (BMODE == 0) bpf = (const float*)bsrc((tid & 63) * 4) + (size_t)(tid >> 6) * ldb;
    else {
#pragma unroll
        for (int i = 0; i < 2; ++i) bpb[i] = (const bf16_t*)bsrc((tid >> 2) + 128 * i) + (tid & 3) * 8;
    }
#pragma unroll
    for (int m = 0; m < 4; ++m)
#pragma unroll
        for (int n = 0; n < 8; ++n) acc[m][n] = f32x4{0.f, 0.f, 0.f, 0.f};
    const int trbase = (8 * fq + (fr >> 2)) * 512 + wc * 256 + (((fr >> 2) | ((fq & 1) << 2)) << 5) + ((fr & 3) >> 1) * 16 + (fr & 1) * 8;
    u32x4 ra0[2], ra1[2];
    f32x4 rf0[4], rf1[4];
    u32x4 rb0[2], rb1[2];
    const bool active = wr * 64 < nvalid;
#define G3_GLOAD(RA, RF, RB, k0) do { \
        _Pragma("unroll") for (int i = 0; i < 2; ++i) RA[i] = *(const u32x4*)(ap[i] + (k0)); \
        if (BMODE == 0) { _Pragma("unroll") for (int j = 0; j < 4; ++j) RF[j] = *(const f32x4*)(bpf + (size_t)((k0) + 8 * j) * ldb); } \
        else { _Pragma("unroll") for (int i = 0; i < 2; ++i) RB[i] = *(const u32x4*)(bpb[i] + (k0)); } } while (0)
#define G3_LWRITE(RA, RF, RB, st) do { \
        char* sA_ = (st); char* sB_ = (st) + 16384; \
        _Pragma("unroll") for (int i = 0; i < 2; ++i) *(u32x4*)(sA_ + aoff((tid >> 2) + 128 * i, tid & 3)) = RA[i]; \
        if (BMODE == 0) { _Pragma("unroll") for (int j = 0; j < 4; ++j) { uint2 w_; w_.x = pack2(RF[j][0], RF[j][1]); w_.y = pack2(RF[j][2], RF[j][3]); \
                *(uint2*)(sB_ + boff((tid >> 6) + 8 * j, (tid & 63) >> 1) + (tid & 1) * 8) = w_; } } \
        else { _Pragma("unroll") for (int i = 0; i < 2; ++i) *(u32x4*)(sB_ + aoff((tid >> 2) + 128 * i, tid & 3)) = RB[i]; } } while (0)
#define G3_COMPUTE(st) do { if (active) { \
        const char* sA_ = (st); const char* sB_ = (st) + 16384; \
        bf16x8 af[4]; \
        _Pragma("unroll") for (int m = 0; m < 4; ++m) af[m] = *(const bf16x8*)(sA_ + aoff(wr * 64 + m * 16 + fr, fq)); \
        _Pragma("unroll") for (int n = 0; n < 8; ++n) { \
            bf16x8 bfr; \
            if (BMODE == 0) bfr = tr_pair(sB_ + (trbase ^ (n << 5))); else bfr = *(const bf16x8*)(sB_ + aoff(wc * 128 + n * 16 + fr, fq)); \
            _Pragma("unroll") for (int m = 0; m < 4; ++m) acc[m][n] = __builtin_amdgcn_mfma_f32_16x16x32_bf16(af[m], bfr, acc[m][n], 0, 0, 0); } } } while (0)
    const int nk = K >> 5;
    char* st0 = smem;
    char* st1 = smem + G3_STAGE;
    G3_GLOAD(ra0, rf0, rb0, 0);
    G3_GLOAD(ra1, rf1, rb1, 32);
    G3_LWRITE(ra0, rf0, rb0, st0);
    if (nk > 2) G3_GLOAD(ra0, rf0, rb0, 64);
    __syncthreads();
    for (int kt = 0; kt < nk; kt += 2) {
        G3_LWRITE(ra1, rf1, rb1, st1);
        if (kt + 3 < nk) G3_GLOAD(ra1, rf1, rb1, (kt + 3) * 32);
        G3_COMPUTE(st0);
        __syncthreads();
        if (kt + 2 < nk) G3_LWRITE(ra0, rf0, rb0, st0);
        if (kt + 4 < nk) G3_GLOAD(ra0, rf0, rb0, (kt + 4) * 32);
        G3_COMPUTE(st1);
        __syncthreads();
    }
#undef G3_GLOAD
#undef G3_LWRITE
#undef G3_COMPUTE
}

template <class AF, class BF>
__device__ __forceinline__ void gemm4(char* smem, const int K, AF arow, BF brow, f32x4 (&acc)[4][8]) {
    const int tid = otid(), lane = tid & 63, wid = tid >> 6, wr = wid >> 1, wc = wid & 1, fr = lane & 15, fq = lane >> 4;
    const bf16_t* ga[2];
    const bf16_t* gb[2];
#pragma unroll
    for (int i = 0; i < 2; ++i) {
        const int r = 16 * (wid + 8 * i) + (lane >> 2), sc = ((lane & 3) ^ ((r >> 2) & 3)) * 8;
        ga[i] = arow(r) + sc;
        gb[i] = brow(r) + sc;
    }
#pragma unroll
    for (int m = 0; m < 4; ++m)
#pragma unroll
        for (int n = 0; n < 8; ++n) acc[m][n] = f32x4{0.f, 0.f, 0.f, 0.f};
    char* ldst = smem + wid * 1024 + lane * 16;
#define G4_ISSUE(slot, k0) do { \
        char* d_ = ldst + (slot) * 32768; \
        __builtin_amdgcn_global_load_lds((const unsigned*)(ga[0] + (k0)), (LAS unsigned*)(d_), 16, 0, 0); \
        __builtin_amdgcn_global_load_lds((const unsigned*)(ga[1] + (k0)), (LAS unsigned*)(d_ + 8192), 16, 0, 0); \
        __builtin_amdgcn_global_load_lds((const unsigned*)(gb[0] + (k0)), (LAS unsigned*)(d_ + 16384), 16, 0, 0); \
        __builtin_amdgcn_global_load_lds((const unsigned*)(gb[1] + (k0)), (LAS unsigned*)(d_ + 16384 + 8192), 16, 0, 0); } while (0)
    const int nk = K >> 5;
    G4_ISSUE(0, 0);
    G4_ISSUE(1, 32);
    int slot = 0, slot2 = 2;
    for (int kt = 0; kt < nk; ++kt) {
        if (kt + 1 < nk) asm volatile("s_waitcnt vmcnt(4)" ::: "memory");
        else asm volatile("s_waitcnt vmcnt(0)" ::: "memory");
        __builtin_amdgcn_s_barrier();
        if (kt + 2 < nk) G4_ISSUE(slot2, (kt + 2) * 32);
        const char* sA_ = smem + slot * 32768;
        const char* sB_ = sA_ + 16384;
        bf16x8 af[4];
#pragma unroll
        for (int m = 0; m < 4; ++m) af[m] = *(const bf16x8*)(sA_ + aoff(wr * 64 + m * 16 + fr, fq));
#pragma unroll
        for (int n = 0; n < 8; ++n) {
            const bf16x8 bfr = *(const bf16x8*)(sB_ + aoff(wc * 128 + n * 16 + fr, fq));
#pragma unroll
            for (int m = 0; m < 4; ++m) acc[m][n] = __builtin_amdgcn_mfma_f32_16x16x32_bf16(af[m], bfr, acc[m][n], 0, 0, 0);
        }
        slot = (slot == 2) ? 0 : slot + 1;
        slot2 = (slot2 == 2) ? 0 : slot2 + 1;
    }
#undef G4_ISSUE
    __syncthreads();
}


constexpr int G5_B0 = 49152;
template <class AF, class BF>
__device__ __forceinline__ void gemm5(char* smem, const int K, AF arow, BF bsrc, const int ldb, f32x4 (&acc)[4][8]) {
    const int tid = otid(), lane = tid & 63, wid = tid >> 6, wr = wid >> 1, wc = wid & 1, fr = lane & 15, fq = lane >> 4;
    const bf16_t* ga[2];
#pragma unroll
    for (int i = 0; i < 2; ++i) {
        const int r = 16 * (wid + 8 * i) + (lane >> 2);
        ga[i] = arow(r) + (((lane & 3) ^ ((r >> 2) & 3)) * 8);
    }
    const float* bpf = (const float*)bsrc((tid & 63) * 4) + (size_t)(tid >> 6) * ldb;
#pragma unroll
    for (int m = 0; m < 4; ++m)
#pragma unroll
        for (int n = 0; n < 8; ++n) acc[m][n] = f32x4{0.f, 0.f, 0.f, 0.f};
    const int trbase = (8 * fq + (fr >> 2)) * 512 + wc * 256 + (((fr >> 2) | ((fq & 1) << 2)) << 5) + ((fr & 3) >> 1) * 16 + (fr & 1) * 8;
    char* ldst = smem + wid * 1024 + lane * 16;
    const unsigned lds0 = (unsigned)(size_t)smem;
    unsigned bwoff[4];
#pragma unroll
    for (int j = 0; j < 4; ++j) bwoff[j] = boff((tid >> 6) + 8 * j, (tid & 63) >> 1) + (tid & 1) * 8;
    f32x4 rf0[4], rf1[4];
    const int klast = K - 32;
#define G5_ADMA(slot, k0) do { \
        char* d_ = ldst + (slot) * 16384; \
        __builtin_amdgcn_global_load_lds((const unsigned*)(ga[0] + (k0)), (LAS unsigned*)(d_), 16, 0, 0); \
        __builtin_amdgcn_global_load_lds((const unsigned*)(ga[1] + (k0)), (LAS unsigned*)(d_ + 8192), 16, 0, 0); } while (0)
#define G5_BLOAD(RF, k0) do { const float* q0_ = bpf + (size_t)(k0) * ldb; const float* q1_ = q0_ + (size_t)8 * ldb; const float* q2_ = q0_ + (size_t)16 * ldb; const float* q3_ = q0_ + (size_t)24 * ldb; \
        asm volatile("global_load_dwordx4 %0, %4, off\n\tglobal_load_dwordx4 %1, %5, off\n\tglobal_load_dwordx4 %2, %6, off\n\tglobal_load_dwordx4 %3, %7, off" \
                     : "=&v"(RF[0]), "=&v"(RF[1]), "=&v"(RF[2]), "=&v"(RF[3]) : "v"(q0_), "v"(q1_), "v"(q2_), "v"(q3_) : "memory"); } while (0)
#define G5_BWAIT(RF, N) asm volatile("s_waitcnt vmcnt(" #N ")" : "+v"(RF[0]), "+v"(RF[1]), "+v"(RF[2]), "+v"(RF[3]) :: "memory")
#define G5_BWRITE(RF, st) do { const unsigned sB_ = lds0 + G5_B0 + (st) * 16384; \
        _Pragma("unroll") for (int j = 0; j < 4; ++j) { \
            const unsigned long long w_ = (unsigned long long)pack2(RF[j][0], RF[j][1]) | ((unsigned long long)pack2(RF[j][2], RF[j][3]) << 32); \
            asm volatile("ds_write_b64 %0, %1" :: "v"(sB_ + bwoff[j]), "v"(w_) : "memory"); } } while (0)
#define G5_TRB(n0) do { \
        _Pragma("unroll") for (int n = 0; n < 4; ++n) { const unsigned a_ = sBa_ + (unsigned)(trbase ^ (((n0) + n) << 5)); \
            asm volatile("ds_read_b64_tr_b16 %0, %2\n\tds_read_b64_tr_b16 %1, %2 offset:2048" : "=&v"(tl[n]), "=&v"(th[n]) : "v"(a_) : "memory"); } } while (0)
#define G5_TRW() asm volatile("s_waitcnt lgkmcnt(0)" : "+v"(tl[0]), "+v"(tl[1]), "+v"(tl[2]), "+v"(tl[3]), "+v"(th[0]), "+v"(th[1]), "+v"(th[2]), "+v"(th[3]) :: "memory")
#define G5_MM(n0) do { _Pragma("unroll") for (int n = 0; n < 4; ++n) { \
            const bf16x8 bfr = bf16x8{tl[n][0], tl[n][1], tl[n][2], tl[n][3], th[n][0], th[n][1], th[n][2], th[n][3]}; \
            _Pragma("unroll") for (int m = 0; m < 4; ++m) acc[m][(n0) + n] = __builtin_amdgcn_mfma_f32_16x16x32_bf16(af[m], bfr, acc[m][(n0) + n], 0, 0, 0); } } while (0)
#define G5_COMPUTE(aslot, bst) do { \
        const char* sA_ = smem + (aslot) * 16384; const unsigned sBa_ = lds0 + G5_B0 + (bst) * 16384; \
        v4s tl[4], th[4]; \
        G5_TRB(0); \
        bf16x8 af[4]; \
        _Pragma("unroll") for (int m = 0; m < 4; ++m) af[m] = *(const bf16x8*)(sA_ + aoff(wr * 64 + m * 16 + fr, fq)); \
        G5_TRW(); G5_MM(0); \
        G5_TRB(4); G5_TRW(); G5_MM(4); } while (0)
#define G5_KC(k) ((k) < klast ? (k) : klast)
    const int nk = K >> 5;
    G5_BLOAD(rf0, 0);
    G5_ADMA(0, 0);
    G5_BLOAD(rf1, 32);
    G5_BWAIT(rf0, 6);
    G5_BWRITE(rf0, 0);
    G5_ADMA(1, 32);
    G5_BLOAD(rf0, G5_KC(64));
    int as0 = 0, as2 = 2;
    for (int kt = 0; kt < nk; kt += 2) {
        asm volatile("s_waitcnt vmcnt(10) lgkmcnt(0)" ::: "memory");
        __builtin_amdgcn_s_barrier();
        G5_ADMA(as2, G5_KC((kt + 2) * 32));
        G5_BWAIT(rf1, 8);
        G5_BWRITE(rf1, 1);
        G5_BLOAD(rf1, G5_KC((kt + 3) * 32));
        G5_COMPUTE(as0, 0);
        as0 = (as0 == 2) ? 0 : as0 + 1; as2 = (as2 == 2) ? 0 : as2 + 1;
        asm volatile("s_waitcnt vmcnt(10) lgkmcnt(0)" ::: "memory");
        __builtin_amdgcn_s_barrier();
        G5_ADMA(as2, G5_KC((kt + 3) * 32));
        G5_BWAIT(rf0, 8);
        G5_BWRITE(rf0, 0);
        G5_BLOAD(rf0, G5_KC((kt + 4) * 32));
        G5_COMPUTE(as0, 1);
        as0 = (as0 == 2) ? 0 : as0 + 1; as2 = (as2 == 2) ? 0 : as2 + 1;
    }
    G5_BWAIT(rf0, 0);
    G5_BWAIT(rf1, 0);
    asm volatile("s_waitcnt lgkmcnt(0)" ::: "memory");
    __syncthreads();
#undef G5_ADMA
#undef G5_BLOAD
#undef G5_BWAIT
#undef G5_BWRITE
#undef G5_COMPUTE
#undef G5_TRB
#undef G5_TRW
#undef G5_MM
#undef G5_KC
}


template <class AF, class BF>
__device__ __forceinline__ void gemm6(char* smem, const int K, AF arow, BF brow, f32x4 (&acc)[4][8]) {
    const int tid = otid(), lane = tid & 63, wid = tid >> 6, wr = wid >> 1, wc = wid & 1, fr = lane & 15, fq = lane >> 4;
    const bf16_t* ga[4];
    const bf16_t* gb[4];
#pragma unroll
    for (int i = 0; i < 4; ++i) {
        const int r = 8 * (wid + 8 * i) + (lane >> 3), sc = ((lane & 7) ^ ((r >> 1) & 7)) * 8;
        ga[i] = arow(r) + sc;
        gb[i] = brow(r) + sc;
    }
#pragma unroll
    for (int m = 0; m < 4; ++m)
#pragma unroll
        for (int n = 0; n < 8; ++n) acc[m][n] = f32x4{0.f, 0.f, 0.f, 0.f};
    char* ldst = smem + wid * 1024 + lane * 16;
#define G6_ISSUE(slot, k0) do { char* d_ = ldst + (slot) * 65536; \
        _Pragma("unroll") for (int i_ = 0; i_ < 4; ++i_) { \
            __builtin_amdgcn_global_load_lds((const unsigned*)(ga[i_] + (k0)), (LAS unsigned*)(d_ + i_ * 8192), 16, 0, 0); \
            __builtin_amdgcn_global_load_lds((const unsigned*)(gb[i_] + (k0)), (LAS unsigned*)(d_ + 32768 + i_ * 8192), 16, 0, 0); } } while (0)
    const int nk = K >> 6;
    G6_ISSUE(0, 0);
    for (int kt = 0; kt < nk; ++kt) {
        asm volatile("s_waitcnt vmcnt(0)" ::: "memory");
        __builtin_amdgcn_s_barrier();
        if (kt + 1 < nk) G6_ISSUE((kt + 1) & 1, (kt + 1) * 64);
        const char* sA_ = smem + (kt & 1) * 65536;
        const char* sB_ = sA_ + 32768;
#pragma unroll
        for (int ks = 0; ks < 2; ++ks) {
            bf16x8 af[4];
#pragma unroll
            for (int m = 0; m < 4; ++m) af[m] = *(const bf16x8*)(sA_ + swz(wr * 64 + m * 16 + fr, ks * 4 + fq));
#pragma unroll
            for (int n = 0; n < 8; ++n) {
                const bf16x8 bfr = *(const bf16x8*)(sB_ + swz(wc * 128 + n * 16 + fr, ks * 4 + fq));
#pragma unroll
                for (int m = 0; m < 4; ++m) acc[m][n] = __builtin_amdgcn_mfma_f32_16x16x32_bf16(af[m], bfr, acc[m][n], 0, 0, 0);
            }
        }
    }
#undef G6_ISSUE
    __syncthreads();
}

constexpr int EPI_WAVE = 8704;
template <class VF, class SF>
__device__ __forceinline__ void epi_bf16(char* wl, const int lane, VF val, SF store) {
    const int fr = lane & 15, fq = lane >> 4, odd = lane & 1;
#pragma unroll
    for (int n = 0; n < 8; ++n)
#pragma unroll
        for (int jp = 0; jp < 2; ++jp) {
            const float a = val(n, 2 * jp), b = val(n, 2 * jp + 1);
            const float x = odd ? a : b;
            const float y = __shfl_xor(x, 1, 64);
            const uint32_t w = odd ? pack2(y, b) : pack2(a, y);
            *(uint32_t*)(wl + (fq * 4 + 2 * jp + odd) * 272 + (n * 16 + (fr & ~1)) * 2) = w;
        }
    int ln = lane;
    asm volatile("" : "+v"(ln));
#pragma unroll
    for (int i = 0; i < 4; ++i) {
        const int idx = ln + 64 * i, row = idx >> 4, ch = idx & 15;
        store(row, ch, *(const u32x4*)(wl + row * 272 + ch * 16));
    }
}
template <class VF, class SF>
__device__ __forceinline__ void epi_f32(char* wl, const int lane, VF val, SF store) {
    const int fr = lane & 15, fq = lane >> 4;
#pragma unroll
    for (int n = 0; n < 8; ++n)
#pragma unroll
        for (int j = 0; j < 4; ++j) *(float*)(wl + (fq * 4 + j) * 528 + (n * 16 + fr) * 4) = val(n, j);
    int ln = lane;
    asm volatile("" : "+v"(ln));
#pragma unroll
    for (int i = 0; i < 8; ++i) {
        const int idx = ln + 64 * i, row = idx >> 5, ch = idx & 31;
        store(row, ch, *(const f32x4*)(wl + row * 528 + ch * 16));
    }
}


constexpr float Y8_SCALE = 16.f;
template <class VF, class SF>
__device__ __forceinline__ void epi_fp8(char* wl, const int lane, VF val, SF store) {
    const int fr = lane & 15, fq = lane >> 4, odd = lane & 1;
#pragma unroll
    for (int n = 0; n < 8; ++n)
#pragma unroll
        for (int jp = 0; jp < 2; ++jp) {
            const float a = val(n, 2 * jp), b = val(n, 2 * jp + 1);
            const float x = odd ? a : b;
            const float y = __shfl_xor(x, 1, 64);
            const int w = odd ? __builtin_amdgcn_cvt_pk_fp8_f32(y, b, 0, false) : __builtin_amdgcn_cvt_pk_fp8_f32(a, y, 0, false);
            *(unsigned short*)(wl + (fq * 4 + 2 * jp + odd) * 144 + n * 16 + (fr & ~1)) = (unsigned short)w;
        }
    int ln = lane;
    asm volatile("" : "+v"(ln));
#pragma unroll
    for (int i = 0; i < 2; ++i) {
        const int idx = ln + 64 * i, row = idx >> 3, ch = idx & 7;
        store(row, ch, *(const u32x4*)(wl + row * 144 + ch * 16));
    }
}

__device__ __forceinline__ void ph_inproj(const Params& p, char* smem) {
    const int tid = otid(), lane = tid & 63, wid = tid >> 6, wr = wid >> 1, wc = wid & 1, fr = lane & 15;
    const int NTN = INW / 256;
    const int xcd = blockIdx.x & 7, nbx = gridDim.x >> 3;
    for (int i = blockIdx.x >> 3; i < 8 * NTN; i += nbx) {
        const int nt = i >> 3, mt = xcd * 8 + (i & 7);
        const bf16_t* A = p.h1() + (size_t)mt * 256 * D;
        const bf16_t* Bt = p.winT() + (size_t)nt * 256 * D;
        f32x4 acc[4][8];
        __syncthreads();
        gemm6(smem, D, [&](int r) { return A + (size_t)r * D; }, [&](int n) { return Bt + (size_t)n * D; }, acc);
        char* wl = smem + wid * EPI_WAVE;
        const int colb = nt * 256 + wc * 128;
        const int rowb = mt * 256 + wr * 64;
        if (colb >= OFF_HF && colb < OFF_HI) {
            float lbc[8];
#pragma unroll
            for (int n = 0; n < 8; ++n) lbc[n] = p.lbv()[colb - OFF_HF + n * 16 + fr];
#pragma unroll
            for (int m = 0; m < 4; ++m) {
                float* dst = p.lgf() + (size_t)(rowb + m * 16) * 512 + (colb - OFF_HF);
                epi_f32(wl, lane,
                        [&](int n, int j) { return __logf(lbc[n] + (1.f - lbc[n]) * (1.f / (1.f + __expf(-acc[m][n][j])))); },
                        [&](int row, int ch, f32x4 v) { *(f32x4*)(dst + (size_t)row * 512 + ch * 4) = v; });
            }
        } else {
#pragma unroll
            for (int m = 0; m < 4; ++m) {
                bf16_t* dst = p.proj() + (size_t)(rowb + m * 16) * INW + colb;
                epi_bf16(wl, lane, [&](int n, int j) { return acc[m][n][j]; },
                         [&](int row, int ch, u32x4 v) { *(u32x4*)(dst + (size_t)row * INW + ch * 8) = v; });
            }
        }
    }
}

__device__ __forceinline__ void ph_h1(const Params& p, char* smem0) {
    const VB vbk = make_vb(smem0);
    char* smem = vbk.smem;
    const int tid = vbk.tid, lane = tid & 63, wid = tid >> 6, wr = wid >> 1, wc = wid & 1, fr = lane & 15, fq = lane >> 4;
    char* sI = smem;
    char* sK = smem + 16384;
    float* sL = (float*)(smem + 32768);
    float* totS = (float*)(smem + 65536);
    const int d = tid & 127, half = tid >> 7;
    const TrBase trb = tr16_base(lane);
    for (int u = vbk.vb; u < 1024; u += vbk.nvb) {
        const int bh = u >> 6, c = u & 63, b = bh >> 2, h = bh & 3;
        const size_t row0 = (size_t)b * S + c * 64;
        __syncthreads();
#pragma unroll
        for (int i = 0; i < 4; ++i) {
            const int idx = tid + 256 * i, r = idx >> 4, ch = idx & 15;
            *(u32x4*)(sI + swz16(r, ch)) = *(const u32x4*)(p.proj() + (row0 + r) * INW + OFF_HI + h * 128 + ch * 8);
        }
#pragma unroll
        for (int i = 0; i < 8; ++i) {
            const int idx = tid + 256 * i, r = idx >> 5, c4 = idx & 31;
            *(f32x4*)(sL + r * 128 + c4 * 4) = *(const f32x4*)(p.lgf() + (row0 + r) * 512 + h * 128 + c4 * 4);
        }
        __syncthreads();
        const float* lcol = sL + half * 32 * 128 + d;
        float tot = 0.f;
#pragma unroll
        for (int s = 0; s < 32; ++s) tot += lcol[s * 128];
        totS[half * 128 + d] = tot;
        __syncthreads();
        const float t0 = totS[d], bl = t0 + totS[128 + d];
        float run = half ? t0 : 0.f;
#pragma unroll 8
        for (int s = 0; s < 32; ++s) {
            const float lv = lcol[s * 128];
            run += lv;
            const float kt = (1.f - __expf(lv)) * __expf(bl - run);
            *(bf16_t*)(sK + swz16(half * 32 + s, d >> 3) + (d & 7) * 2) = f2bf(kt);
        }
        if (half == 0) p.dec()[u * 128 + d] = __expf(bl);
        __syncthreads();
        f32x4 acc[4][4];
#pragma unroll
        for (int m = 0; m < 4; ++m)
#pragma unroll
            for (int n = 0; n < 4; ++n) acc[m][n] = f32x4{0.f, 0.f, 0.f, 0.f};
#pragma unroll
        for (int ks = 0; ks < 2; ++ks) {
            bf16x8 af[4], bfr[4];
#pragma unroll
            for (int m = 0; m < 4; ++m) af[m] = tr_frag16(sI, trb, ks, wr * 4 + m);
#pragma unroll
            for (int n = 0; n < 4; ++n) bfr[n] = tr_frag16(sK, trb, ks, wc * 4 + n);
#pragma unroll
            for (int m = 0; m < 4; ++m)
#pragma unroll
                for (int n = 0; n < 4; ++n) acc[m][n] = __builtin_amdgcn_mfma_f32_16x16x32_bf16(af[m], bfr[n], acc[m][n], 0, 0, 0);
        }
        __syncthreads();
        {
            int tz = tid;
            asm volatile("" : "+v"(tz));
            const int lz = tz & 63, odd = lz & 1;
            char* wbase = smem + ((tz >> 7) * 64 + (lz >> 4) * 4 + odd) * 272 + (((tz >> 6) & 1) * 64 + ((lz & 15) & ~1)) * 2;
#pragma unroll
            for (int m = 0; m < 4; ++m)
#pragma unroll
                for (int n = 0; n < 4; ++n)
#pragma unroll
                    for (int jp = 0; jp < 2; ++jp) {
                        const float a = acc[m][n][2 * jp], b2 = acc[m][n][2 * jp + 1];
                        const float x = odd ? a : b2;
                        const float y = __shfl_xor(x, 1, 64);
                        const uint32_t w = odd ? pack2(y, b2) : pack2(a, y);
                        *(uint32_t*)(wbase + (m * 16 + 2 * jp) * 272 + n * 32) = w;
                    }
            __syncthreads();
            bf16_t* kvu = p.kv() + (size_t)u * 16384;
            const int r0 = tz >> 4, ch = tz & 15;
#pragma unroll
            for (int i = 0; i < 8; ++i)
                *(u32x4*)(kvu + (r0 + 16 * i) * 128 + ch * 8) = *(const u32x4*)(smem + (r0 + 16 * i) * 272 + ch * 16);
        }
    }
}

__device__ __forceinline__ void ph_h2(const Params& p) {
    for (int it = blockIdx.x * NTHREADS + otid(); it < 16 * 8192; it += gridDim.x * NTHREADS) {
        const int bh = it >> 13, e2 = it & 8191, dv = e2 >> 6, dk = (e2 & 63) * 2;
        const size_t eoff = (size_t)dv * 128 + dk;
        float sx = 0.f, sy = 0.f;
        const bf16_t* kvp = p.kv() + (size_t)bh * 64 * 16384 + eoff;
        const float* dcp = p.dec() + (size_t)bh * 64 * 128 + dk;
        bf16_t* stp = p.sst() + (size_t)bh * 64 * 16384 + eoff;
        for (int c0 = 0; c0 < 64; c0 += 16) {
            uint32_t kvw[16];
            float2 dc[16];
#pragma unroll
            for (int i = 0; i < 16; ++i) {
                kvw[i] = *(const uint32_t*)(kvp + (size_t)(c0 + i) * 16384);
                dc[i] = *(const float2*)(dcp + (c0 + i) * 128);
            }
#pragma unroll
            for (int i = 0; i < 16; ++i) {
                *(uint32_t*)(stp + (size_t)(c0 + i) * 16384) = pack2(sx, sy);
                sx = dc[i].x * sx + __uint_as_float(kvw[i] << 16);
                sy = dc[i].y * sy + __uint_as_float(kvw[i] & 0xffff0000u);
            }
        }
    }
}

__device__ __forceinline__ void ph_h3(const Params& p, char* smem0) {
    const VB vbk = make_vb(smem0);
    char* smem = vbk.smem;
    const int tid = vbk.tid, lane = tid & 63, wid = tid >> 6, wr = wid >> 1, wc = wid & 1, fr = lane & 15, fq = lane >> 4;
    char* sQ = smem;
    char* sK = smem + 16384;
    char* sP = smem + 32768;
    float* sL = (float*)(smem + 32768);
    float* totS = (float*)(smem + 65536);
    char* sG = smem + 40960;
    const int d = tid & 127, half = tid >> 7;
    const TrBase trb = tr16_base(lane);
    for (int u = vbk.vb; u < 1024; u += vbk.nvb) {
        const int bh = u >> 6, c = u & 63, b = bh >> 2, h = bh & 3;
        const size_t row0 = (size_t)b * S + c * 64;
        __syncthreads();
#pragma unroll
        for (int i = 0; i < 4; ++i) {
            const int idx = tid + 256 * i, r = idx >> 4, ch = idx & 15;
            *(u32x4*)(sQ + swz16(r, ch)) = *(const u32x4*)(p.proj() + (row0 + r) * INW + OFF_HQ + h * 128 + ch * 8);
        }
#pragma unroll
        for (int i = 0; i < 8; ++i) {
            const int idx = tid + 256 * i, r = idx >> 5, c4 = idx & 31;
            *(f32x4*)(sL + r * 128 + c4 * 4) = *(const f32x4*)(p.lgf() + (row0 + r) * 512 + h * 128 + c4 * 4);
        }
        u32x4 sv0[4], sv1[4], iv[4], gv[4];
#pragma unroll
        for (int i = 0; i < 4; ++i) {
            const int r8 = (tid + 256 * i) >> 3;
            sv0[i] = *(const u32x4*)(p.sst() + (size_t)u * 16384 + r8 * 128 + (tid & 7) * 8);
            sv1[i] = *(const u32x4*)(p.sst() + (size_t)u * 16384 + r8 * 128 + 64 + (tid & 7) * 8);
            const int idx = tid + 256 * i, r = idx >> 4, c16 = idx & 15;
            iv[i] = *(const u32x4*)(p.proj() + (row0 + r) * INW + OFF_HI + h * 128 + c16 * 8);
            gv[i] = *(const u32x4*)(p.proj() + (row0 + r) * INW + OFF_HG + h * 128 + c16 * 8);
        }
        __syncthreads();
        const float* lcol = sL + half * 32 * 128 + d;
        float tot = 0.f;
#pragma unroll
        for (int s = 0; s < 32; ++s) tot += lcol[s * 128];
        totS[half * 128 + d] = tot;
        __syncthreads();
        const float t0 = totS[d];
        float run = half ? t0 : 0.f;
#pragma unroll 8
        for (int s = 0; s < 32; ++s) {
            const float lv = lcol[s * 128];
            run += lv;
            const int o = swz16(half * 32 + s, d >> 3) + (d & 7) * 2;
            const float qm = bf2f(*(const bf16_t*)(sQ + o)) * __expf(run - t0);
            const float kh = (1.f - __expf(lv)) * __expf(t0 - run);
            *(bf16_t*)(sQ + o) = f2bf(qm);
            *(bf16_t*)(sK + o) = f2bf(kh);
        }
        __syncthreads();
        {
            f32x4 pa[2][2];
#pragma unroll
            for (int m = 0; m < 2; ++m)
#pragma unroll
                for (int n = 0; n < 2; ++n) pa[m][n] = f32x4{0.f, 0.f, 0.f, 0.f};
#pragma unroll
            for (int ks = 0; ks < 4; ++ks) {
                bf16x8 af[2], bfr[2];
#pragma unroll
                for (int m = 0; m < 2; ++m) af[m] = *(const bf16x8*)(sQ + swz16(wr * 32 + m * 16 + fr, ks * 4 + fq));
#pragma unroll
                for (int n = 0; n < 2; ++n) bfr[n] = *(const bf16x8*)(sK + swz16(wc * 32 + n * 16 + fr, ks * 4 + fq));
#pragma unroll
                for (int m = 0; m < 2; ++m)
#pragma unroll
                    for (int n = 0; n < 2; ++n) pa[m][n] = __builtin_amdgcn_mfma_f32_16x16x32_bf16(af[m], bfr[n], pa[m][n], 0, 0, 0);
            }
#pragma unroll
            for (int m = 0; m < 2; ++m)
#pragma unroll
                for (int n = 0; n < 2; ++n)
#pragma unroll
                    for (int j = 0; j < 4; ++j) {
                        const int t = wr * 32 + m * 16 + fq * 4 + j, s_ = wc * 32 + n * 16 + fr;
                        const float v = (s_ <= t) ? pa[m][n][j] : 0.f;
                        *(bf16_t*)(sP + swz(t, s_ >> 3) + (s_ & 7) * 2) = f2bf(v);
                    }
        }
        __syncthreads();
        f32x4 oa[8];
#pragma unroll
        for (int i = 0; i < 4; ++i) { const int idx = tid + 256 * i; *(u32x4*)(sG + (idx >> 4) * 256 + (idx & 15) * 16) = gv[i]; }
#pragma unroll
        for (int n = 0; n < 8; ++n) oa[n] = f32x4{0.f, 0.f, 0.f, 0.f};
        const int ch = tid & 7;
#pragma unroll
        for (int sub = 0; sub < 2; ++sub) {
            float sc[8];
#pragma unroll
            for (int j = 0; j < 8; ++j) sc[j] = __expf(totS[sub * 64 + ch * 8 + j]);
#pragma unroll
            for (int i = 0; i < 4; ++i) {
                const int r = (tid + 256 * i) >> 3;
                const u32x4 v = sub ? sv1[i] : sv0[i];
                u32x4 w;
                w.x = pack2(__uint_as_float(v.x << 16) * sc[0], __uint_as_float(v.x & 0xffff0000u) * sc[1]);
                w.y = pack2(__uint_as_float(v.y << 16) * sc[2], __uint_as_float(v.y & 0xffff0000u) * sc[3]);
                w.z = pack2(__uint_as_float(v.z << 16) * sc[4], __uint_as_float(v.z & 0xffff0000u) * sc[5]);
                w.w = pack2(__uint_as_float(v.w << 16) * sc[6], __uint_as_float(v.w & 0xffff0000u) * sc[7]);
                *(u32x4*)(sK + swz(r, ch)) = w;
            }
            __syncthreads();
#pragma unroll
            for (int ks = 0; ks < 2; ++ks) {
                const bf16x8 af = *(const bf16x8*)(sQ + swz16(wid * 16 + fr, sub * 8 + ks * 4 + fq));
#pragma unroll
                for (int n = 0; n < 8; ++n) {
                    const bf16x8 bfr = *(const bf16x8*)(sK + swz(n * 16 + fr, ks * 4 + fq));
                    oa[n] = __builtin_amdgcn_mfma_f32_16x16x32_bf16(af, bfr, oa[n], 0, 0, 0);
                }
            }
            __syncthreads();
        }
#pragma unroll
        for (int i = 0; i < 4; ++i) {
            const int idx = tid + 256 * i, r = idx >> 4, c16 = idx & 15;
            *(u32x4*)(sK + swz16(r, c16)) = iv[i];
        }
        __syncthreads();
#pragma unroll
        for (int ks = 0; ks < 2; ++ks) {
            const bf16x8 af = *(const bf16x8*)(sP + swz(wid * 16 + fr, ks * 4 + fq));
#pragma unroll
            for (int n = 0; n < 8; ++n) {
                const bf16x8 bfr = tr_frag16(sK, trb, ks, n);
                oa[n] = __builtin_amdgcn_mfma_f32_16x16x32_bf16(af, bfr, oa[n], 0, 0, 0);
            }
        }
        float ss[4] = {0.f, 0.f, 0.f, 0.f};
#pragma unroll
        for (int n = 0; n < 8; ++n)
#pragma unroll
            for (int j = 0; j < 4; ++j) ss[j] += oa[n][j] * oa[n][j];
#pragma unroll
        for (int j = 0; j < 4; ++j) {
            ss[j] += __shfl_xor(ss[j], 1, 64); ss[j] += __shfl_xor(ss[j], 2, 64); ss[j] += __shfl_xor(ss[j], 4, 64); ss[j] += __shfl_xor(ss[j], 8, 64);
        }
        {
            int lz = lane;
            asm volatile("" : "+v"(lz));
            const int odd = lz & 1, fr = lz & 15, fq = lz >> 4;
            float rstd[4];
#pragma unroll
            for (int j = 0; j < 4; ++j) rstd[j] = rsqrtf(ss[j] * (1.f / 128.f) + RMS_EPS);
#pragma unroll
            for (int n = 0; n < 8; ++n) {
                const int dv = n * 16 + fr;
                const float nw = p.hg_nw[h * 128 + dv];
                float y[4];
#pragma unroll
                for (int j = 0; j < 4; ++j) {
                    const float g = bf2f(*(const bf16_t*)(sG + (wid * 16 + fq * 4 + j) * 256 + dv * 2));
                    y[j] = oa[n][j] * rstd[j] * nw * (g / (1.f + __expf(-g)));
                }
#pragma unroll
                for (int jp = 0; jp < 2; ++jp) {
                    const float a = y[2 * jp], b2 = y[2 * jp + 1];
                    const float x = odd ? a : b2;
                    const float z = __shfl_xor(x, 1, 64);
                    const size_t row = row0 + wid * 16 + fq * 4 + 2 * jp + odd;
                    *(uint32_t*)(p.mixin() + row * 768 + h * 128 + n * 16 + (fr & ~1)) = odd ? pack2(z, b2) : pack2(a, z);
                }
            }
        }
    }
}

__device__ __forceinline__ TrBase tr8_base(int lane) {
    const int g = lane >> 4, q = (lane & 15) >> 2, pp = lane & 3;
    const int xl = 4 * (g & 1) + (q >> 1), h = pp >> 1;
    TrBase t;
    t.lo = (8 * g + q) * 128 + ((xl >> 1) << 5) + ((h ^ (xl & 1)) << 4) + 8 * (pp & 1);
    t.hi = (t.lo + 512) ^ 32;
    return t;
}
__device__ __forceinline__ bf16x8 tr_frag8(const char* tile, const TrBase& tb, int ks, int c) {
    int cx = c << 5;
    asm volatile("" : "+v"(cx));
    const v4s lo = __builtin_amdgcn_ds_read_tr16_b64_v4i16((LAS v4s*)(tile + ks * 4096 + (tb.lo ^ cx)));
    const v4s hi = __builtin_amdgcn_ds_read_tr16_b64_v4i16((LAS v4s*)(tile + ks * 4096 + (tb.hi ^ cx)));
    return bf16x8{lo[0], lo[1], lo[2], lo[3], hi[0], hi[1], hi[2], hi[3]};
}

__device__ __forceinline__ void ph_attn(const Params& p, char* smem0) {
    const VB vbk = make_vb(smem0);
    char* smem = vbk.smem;
    const int tid = vbk.tid, lane = tid & 63, wid = tid >> 6, fr = lane & 15, fq = lane >> 4;
    char* sQ = smem;
    char* sK = smem + 8192;
    char* sP = sK;
    char* sV = smem + 33792;
    float* sBias = (float*)(smem + 58368);
    const TrBase trb = tr8_base(lane);
    for (int u = vbk.vb; u < 3072; u += vbk.nvb) {
        const int ti = u & 63, gq = u >> 6, g = gq % 3, bhh = gq / 3, hh = bhh & 3, b = bhh >> 2;
        const int lsh = (g == 0) ? 0 : (g == 1 ? 2 : 4), dl = 1 << lsh;
        const int tpr = (S >> lsh) >> 6;
        const int r = ti / tpr, j0 = (ti % tpr) * 64;
        const bf16_t* base = p.proj() + (size_t)b * S * INW + (g * 4 + hh) * 64;
        __syncthreads();
#pragma unroll
        for (int i = 0; i < 2; ++i) {
            const int idx = tid + 256 * i, row = idx >> 3, ch = idx & 7;
            const int tok = (j0 + row) * dl + r;
            *(u32x4*)(sQ + swz(row, ch)) = *(const u32x4*)(base + (size_t)tok * INW + OFF_AQ + ch * 8);
        }
#pragma unroll
        for (int i = 0; i < 6; ++i) {
            const int idx = tid + 256 * i, row = idx >> 3, ch = idx & 7;
            const int j = j0 - 128 + row;
            u32x4 kx = {0u, 0u, 0u, 0u}, vx = {0u, 0u, 0u, 0u};
            if (j >= 0) {
                const size_t o = (size_t)(j * dl + r) * INW + ch * 8;
                kx = *(const u32x4*)(base + o + OFF_AK);
                vx = *(const u32x4*)(base + o + OFF_AV);
            }
            *(u32x4*)(sK + swz(row, ch)) = kx;
            *(u32x4*)(sV + swz(row, ch)) = vx;
        }
        if (tid < 129) sBias[tid] = p.biasT()[(g * 129 + tid) * 4 + hh];
        __syncthreads();
        f32x4 sa[12];
#pragma unroll
        for (int n = 0; n < 12; ++n) sa[n] = f32x4{0.f, 0.f, 0.f, 0.f};
#pragma unroll
        for (int ks = 0; ks < 2; ++ks) {
            const bf16x8 af = *(const bf16x8*)(sQ + swz(wid * 16 + fr, ks * 4 + fq));
#pragma unroll
            for (int n = 0; n < 12; ++n) {
                const bf16x8 bfr = *(const bf16x8*)(sK + swz(n * 16 + fr, ks * 4 + fq));
                sa[n] = __builtin_amdgcn_mfma_f32_16x16x32_bf16(af, bfr, sa[n], 0, 0, 0);
            }
        }
        float mx[4] = {-INFINITY, -INFINITY, -INFINITY, -INFINITY};
#pragma unroll
        for (int n = 0; n < 12; ++n)
#pragma unroll
            for (int j = 0; j < 4; ++j) {
                const int jj = wid * 16 + fq * 4 + j, kk = n * 16 + fr, m = jj + 128 - kk;
                const bool valid = (m >= 0) && (m <= 128) && (j0 - 128 + kk >= 0);
                const int mc = m < 0 ? 0 : (m > 128 ? 128 : m);
                const float v = valid ? sa[n][j] * 0.125f + sBias[mc] : -INFINITY;
                sa[n][j] = v;
                mx[j] = fmaxf(mx[j], v);
            }
#pragma unroll
        for (int j = 0; j < 4; ++j) {
            mx[j] = fmaxf(mx[j], __shfl_xor(mx[j], 1, 64)); mx[j] = fmaxf(mx[j], __shfl_xor(mx[j], 2, 64));
            mx[j] = fmaxf(mx[j], __shfl_xor(mx[j], 4, 64)); mx[j] = fmaxf(mx[j], __shfl_xor(mx[j], 8, 64));
        }
        float ls[4] = {0.f, 0.f, 0.f, 0.f};
#pragma unroll
        for (int n = 0; n < 12; ++n)
#pragma unroll
            for (int j = 0; j < 4; ++j) { const float pe = __expf(sa[n][j] - mx[j]); sa[n][j] = pe; ls[j] += pe; }
#pragma unroll
        for (int j = 0; j < 4; ++j) {
            ls[j] += __shfl_xor(ls[j], 1, 64); ls[j] += __shfl_xor(ls[j], 2, 64); ls[j] += __shfl_xor(ls[j], 4, 64); ls[j] += __shfl_xor(ls[j], 8, 64);
        }
        __syncthreads();
#pragma unroll
        for (int n = 0; n < 12; ++n)
#pragma unroll
            for (int j = 0; j < 4; ++j) *(bf16_t*)(sP + (wid * 16 + fq * 4 + j) * 400 + (n * 16 + fr) * 2) = f2bf(sa[n][j]);
        f32x4 oa[4];
#pragma unroll
        for (int n = 0; n < 4; ++n) oa[n] = f32x4{0.f, 0.f, 0.f, 0.f};
#pragma unroll
        for (int ks = 0; ks < 6; ++ks) {
            const bf16x8 af = *(const bf16x8*)(sP + (wid * 16 + fr) * 400 + (ks * 4 + fq) * 16);
#pragma unroll
            for (int n = 0; n < 4; ++n) {
                const bf16x8 bfr = tr_frag8(sV, trb, ks, n);
                oa[n] = __builtin_amdgcn_mfma_f32_16x16x32_bf16(af, bfr, oa[n], 0, 0, 0);
            }
        }
        {
            int lz = lane;
            asm volatile("" : "+v"(lz));
            const int odd = lz & 1, fr = lz & 15, fq = lz >> 4;
            float inv[4];
#pragma unroll
            for (int j = 0; j < 4; ++j) inv[j] = 1.f / ls[j];
#pragma unroll
            for (int jp = 0; jp < 2; ++jp) {
                const int jj = wid * 16 + fq * 4 + 2 * jp + odd;
                const size_t row = (size_t)g * T + (size_t)b * S + (j0 + jj) * dl + r;
#pragma unroll
                for (int n = 0; n < 4; ++n) {
                    const float a = oa[n][2 * jp] * inv[2 * jp], b2 = oa[n][2 * jp + 1] * inv[2 * jp + 1];
                    const float x = odd ? a : b2;
                    const float y = __shfl_xor(x, 1, 64);
                    *(uint32_t*)(p.ao() + row * 256 + hh * 64 + n * 16 + (fr & ~1)) = odd ? pack2(y, b2) : pack2(a, y);
                }
            }
#pragma unroll
            for (int j = 0; j < 4; ++j) {
                const int jj = wid * 16 + fq * 4 + j;
                const size_t row = (size_t)g * T + (size_t)b * S + (j0 + jj) * dl + r;
                if (fr == 0) p.alse()[row * 4 + hh] = mx[j] + __logf(ls[j]);
            }
        }
    }
}

__device__ __forceinline__ void ph_attn_merge(const Params& p) {
    const int tid = otid(), lane = tid & 63, wid = tid >> 6;
    for (int row = blockIdx.x * 8 + wid; row < T; row += gridDim.x * 8) {
        const int hh = lane >> 4;
        const float l0 = p.alse()[((size_t)0 * T + row) * 4 + hh], l1 = p.alse()[((size_t)1 * T + row) * 4 + hh], l2 = p.alse()[((size_t)2 * T + row) * 4 + hh];
        const float mxl = fmaxf(l0, fmaxf(l1, l2));
        float e0 = __expf(l0 - mxl), e1 = __expf(l1 - mxl), e2 = __expf(l2 - mxl);
        const float inv = 1.f / (e0 + e1 + e2);
        e0 *= inv; e1 *= inv; e2 *= inv;
        f32x4 a0, a1, a2;
        {
            const uint2 w0 = *(const uint2*)(p.ao() + ((size_t)0 * T + row) * 256 + lane * 4);
            const uint2 w1 = *(const uint2*)(p.ao() + ((size_t)1 * T + row) * 256 + lane * 4);
            const uint2 w2 = *(const uint2*)(p.ao() + ((size_t)2 * T + row) * 256 + lane * 4);
            a0[0] = __uint_as_float(w0.x << 16); a0[1] = __uint_as_float(w0.x & 0xffff0000u); a0[2] = __uint_as_float(w0.y << 16); a0[3] = __uint_as_float(w0.y & 0xffff0000u);
            a1[0] = __uint_as_float(w1.x << 16); a1[1] = __uint_as_float(w1.x & 0xffff0000u); a1[2] = __uint_as_float(w1.y << 16); a1[3] = __uint_as_float(w1.y & 0xffff0000u);
            a2[0] = __uint_as_float(w2.x << 16); a2[1] = __uint_as_float(w2.x & 0xffff0000u); a2[2] = __uint_as_float(w2.y << 16); a2[3] = __uint_as_float(w2.y & 0xffff0000u);
        }
        uint2 o;
        o.x = pack2(a0[0] * e0 + a1[0] * e1 + a2[0] * e2, a0[1] * e0 + a1[1] * e1 + a2[1] * e2);
        o.y = pack2(a0[2] * e0 + a1[2] * e1 + a2[2] * e2, a0[3] * e0 + a1[3] * e1 + a2[3] * e2);
        *(uint2*)(p.mixin() + (size_t)row * 768 + 512 + lane * 4) = o;
    }
}

__device__ __forceinline__ void ph_outproj(const Params& p, char* smem) {
    const int tid = otid(), lane = tid & 63, wid = tid >> 6, wr = wid >> 1, wc = wid & 1;
    const int xcd = blockIdx.x & 7, nbx = gridDim.x >> 3;
    for (int i = blockIdx.x >> 3; i < 32; i += nbx) {
        const int nt = i >> 3, mt = xcd * 8 + (i & 7);
        const bf16_t* A = p.mixin() + (size_t)mt * 256 * 768;
        const bf16_t* Bt = p.woutT() + (size_t)nt * 256 * 768;
        f32x4 acc[4][8];
        __syncthreads();
        gemm6(smem, 768, [&](int r) { return A + (size_t)r * 768; }, [&](int n) { return Bt + (size_t)n * 768; }, acc);
        const int b = (mt * 256) >> 12;
        const int colb = nt * 256 + wc * 128;
        const float* g1 = p.mod() + b * 6144 + 2048 + colb;
        char* wl = smem + wid * EPI_WAVE;
#pragma unroll
        for (int m = 0; m < 4; ++m) {
            const size_t rbase = (size_t)(mt * 256 + wr * 64 + m * 16) * D + colb;
            epi_f32(wl, lane, [&](int n, int j) { return acc[m][n][j]; },
                    [&](int row, int ch, f32x4 v) {
                        const f32x4 xv = *(const f32x4*)(p.x + rbase + (size_t)row * D + ch * 4);
                        const f32x4 gv = *(const f32x4*)(g1 + ch * 4);
                        f32x4 o;
                        o[0] = ALPHA * xv[0] + gv[0] * v[0]; o[1] = ALPHA * xv[1] + gv[1] * v[1];
                        o[2] = ALPHA * xv[2] + gv[2] * v[2]; o[3] = ALPHA * xv[3] + gv[3] * v[3];
                        *(f32x4*)(p.pre1() + rbase + (size_t)row * D + ch * 4) = o;
                    });
        }
    }
}

__device__ __forceinline__ void ph_ln1(const Params& p) {
    const int tid = otid(), lane = tid & 63, wid = tid >> 6;
    const int rstride = gridDim.x * 8;
    float4 nv[4];
    {
        const float4* xr = (const float4*)(p.pre1() + (size_t)(blockIdx.x * 8 + wid) * D);
#pragma unroll
        for (int i = 0; i < 4; ++i) nv[i] = xr[lane + 64 * i];
    }
    for (int row = blockIdx.x * 8 + wid; row < T; row += rstride) {
        float4 v[4];
        float s = 0.f;
#pragma unroll
        for (int i = 0; i < 4; ++i) { v[i] = nv[i]; s += v[i].x + v[i].y + v[i].z + v[i].w; }
        if (row + rstride < T) {
            const float4* xn = (const float4*)(p.pre1() + (size_t)(row + rstride) * D);
#pragma unroll
            for (int i = 0; i < 4; ++i) nv[i] = xn[lane + 64 * i];
        }
        float mean = wave_sum(s) * (1.f / D);
        float q = 0.f;
#pragma unroll
        for (int i = 0; i < 4; ++i) {
            v[i].x -= mean; v[i].y -= mean; v[i].z -= mean; v[i].w -= mean;
            q += v[i].x * v[i].x + v[i].y * v[i].y + v[i].z * v[i].z + v[i].w * v[i].w;
        }
        float rstd = rsqrtf(wave_sum(q) * (1.f / D) + LN_EPS);
        s = 0.f;
#pragma unroll
        for (int i = 0; i < 4; ++i) {
            const int col = (lane + 64 * i) * 4;
            const float4 g4 = *(const float4*)(p.ln1_g + col), b4 = *(const float4*)(p.ln1_b + col);
            v[i].x = v[i].x * rstd * g4.x + b4.x; v[i].y = v[i].y * rstd * g4.y + b4.y;
            v[i].z = v[i].z * rstd * g4.z + b4.z; v[i].w = v[i].w * rstd * g4.w + b4.w;
            { uint2 xo; xo.x = pack2(v[i].x, v[i].y); xo.y = pack2(v[i].z, v[i].w); *(uint2*)(p.x1() + (size_t)row * D + col) = xo; }
            s += v[i].x + v[i].y + v[i].z + v[i].w;
        }
        mean = wave_sum(s) * (1.f / D);
        q = 0.f;
#pragma unroll
        for (int i = 0; i < 4; ++i) {
            v[i].x -= mean; v[i].y -= mean; v[i].z -= mean; v[i].w -= mean;
            q += v[i].x * v[i].x + v[i].y * v[i].y + v[i].z * v[i].z + v[i].w * v[i].w;
        }
        rstd = rsqrtf(wave_sum(q) * (1.f / D) + LN_EPS);
        const int b = row >> 12;
        const float* sh = p.mod() + b * 6144 + 3072;
        const float* sc = sh + 1024;
#pragma unroll
        for (int i = 0; i < 4; ++i) {
            const int col = (lane + 64 * i) * 4;
            const float4 s4 = *(const float4*)(sc + col), h4 = *(const float4*)(sh + col);
            float4 y;
            y.x = v[i].x * rstd * (1.f + s4.x) + h4.x; y.y = v[i].y * rstd * (1.f + s4.y) + h4.y;
            y.z = v[i].z * rstd * (1.f + s4.z) + h4.z; y.w = v[i].w * rstd * (1.f + s4.w) + h4.w;
            uint2 o;
            o.x = pack2(y.x, y.y); o.y = pack2(y.z, y.w);
            *(uint2*)(p.h2() + (size_t)row * 2048 + col) = o;
            uint2 o2;
            o2.x = pack2h(y.x, y.y);
            o2.y = pack2h(y.z, y.w);
            *(uint2*)(p.h2() + (size_t)row * 2048 + 1024 + col) = o2;
        }
    }
}


__device__ __forceinline__ void topk4_lds(const Params& p, const float* lg, const int tok0, const int lane) {
    constexpr int TK = 4;
        float sc[TK][4], bv[TK][4];
#pragma unroll
    for (int t = 0; t < TK; ++t)
#pragma unroll
        for (int j = 0; j < 4; ++j) {
            const int e = j * 64 + lane;
            const float x = lg[t * NE + e];
            sc[t][j] = 1.f / (1.f + expf(-x));
            bv[t][j] = sc[t][j] + p.router_bias[e];
        }
    float gsum[TK][4];
#pragma unroll
    for (int j = 0; j < 4; ++j) {
        float m1[TK], m2[TK];
#pragma unroll
        for (int t = 0; t < TK; ++t) m1[t] = bv[t][j];
#pragma unroll
        for (int o = 16; o > 0; o >>= 1)
#pragma unroll
            for (int t = 0; t < TK; ++t) m1[t] = fmaxf(m1[t], __shfl_xor(m1[t], o, 64));
#pragma unroll
        for (int t = 0; t < TK; ++t) {
            const unsigned long long bal = __ballot(bv[t][j] == m1[t]);
            const unsigned hm = (unsigned)(bal >> (lane & 32));
            const int first = __ffs(hm) - 1;
            m2[t] = ((lane & 31) == first) ? -INFINITY : bv[t][j];
        }
#pragma unroll
        for (int o = 16; o > 0; o >>= 1)
#pragma unroll
            for (int t = 0; t < TK; ++t) m2[t] = fmaxf(m2[t], __shfl_xor(m2[t], o, 64));
#pragma unroll
        for (int t = 0; t < TK; ++t) gsum[t][j] = m1[t] + m2[t];
    }
    float cand[TK][4];
#pragma unroll
    for (int t = 0; t < TK; ++t) {
        float gs[8];
#pragma unroll
        for (int j = 0; j < 4; ++j) { gs[2 * j] = __shfl(gsum[t][j], 0, 64); gs[2 * j + 1] = __shfl(gsum[t][j], 32, 64); }
        unsigned gmask = 0u;
#pragma unroll
        for (int r = 0; r < 4; ++r) {
            float best = -INFINITY; int bi = 0;
#pragma unroll
            for (int g = 0; g < 8; ++g) {
                const bool ok = (((gmask >> g) & 1u) == 0u) && (gs[g] > best);
                best = ok ? gs[g] : best; bi = ok ? g : bi;
            }
            gmask |= 1u << bi;
        }
#pragma unroll
        for (int j = 0; j < 4; ++j) cand[t][j] = ((gmask >> (2 * j + (lane >> 5))) & 1u) ? bv[t][j] : -INFINITY;
    }
    float wsum[TK], myw[TK];
    int mye[TK];
#pragma unroll
    for (int t = 0; t < TK; ++t) { wsum[t] = 0.f; myw[t] = 0.f; mye[t] = 0; }
#pragma unroll
    for (int r = 0; r < 8; ++r) {
        float bvv[TK]; int be[TK];
#pragma unroll
        for (int t = 0; t < TK; ++t) {
            bvv[t] = cand[t][0]; be[t] = lane;
#pragma unroll
            for (int j = 1; j < 4; ++j) { const bool gt = cand[t][j] > bvv[t]; bvv[t] = gt ? cand[t][j] : bvv[t]; be[t] = gt ? j * 64 + lane : be[t]; }
        }
#pragma unroll
        for (int o = 32; o > 0; o >>= 1)
#pragma unroll
            for (int t = 0; t < TK; ++t) {
                const float ov = __shfl_xor(bvv[t], o, 64);
                const int oe = __shfl_xor(be[t], o, 64);
                const bool take = (ov > bvv[t]) | ((ov == bvv[t]) & (oe < be[t])); bvv[t] = take ? ov : bvv[t]; be[t] = take ? oe : be[t];
            }
#pragma unroll
        for (int t = 0; t < TK; ++t) {
            const int bj = be[t] >> 6;
            unsigned myb = 0u;
#pragma unroll
            for (int j = 0; j < 4; ++j) myb |= (unsigned)(-(int)(bj == j)) & __float_as_uint(sc[t][j]);
            const float mysc = __uint_as_float(myb);
            const float sval = __shfl(mysc, be[t] & 63, 64);
#pragma unroll
            for (int j = 0; j < 4; ++j) cand[t][j] = (be[t] == j * 64 + lane) ? -INFINITY : cand[t][j];
            wsum[t] += sval;
            myw[t] = (lane == r) ? sval : myw[t]; mye[t] = (lane == r) ? be[t] : mye[t];
        }
    }
    if (lane < 8) {
#pragma unroll
        for (int t = 0; t < TK; ++t) {
            const int a = (tok0 + t) * 8 + lane;
            p.topi()[a] = (unsigned char)mye[t];
            p.topw()[a] = myw[t] * (2.5f / wsum[t]);
        }
    }
}

__device__ __forceinline__ void ph_router_topk(const Params& p, char* smem) {
    const int tid = otid(), lane = tid & 63, wid = tid >> 6, fr = lane & 15, fq = lane >> 4;
    float* lgs = (float*)smem;
    for (int mt = blockIdx.x; mt < T / 64; mt += gridDim.x) {
        const bf16_t* A = p.h2() + (size_t)mt * 64 * 2048;
        const int ra = 8 * wid + (lane >> 3);
        const bf16_t* ga = A + (size_t)ra * 2048 + 1024 + (((lane & 7) ^ ((ra >> 1) & 7)) * 8);
        const bf16_t* gb[4];
#pragma unroll
        for (int i = 0; i < 4; ++i) {
            const int r = 8 * (wid + 8 * i) + (lane >> 3);
            gb[i] = p.wrT() + (size_t)r * D + (((lane & 7) ^ ((r >> 1) & 7)) * 8);
        }
        f32x4 acc[4][2];
#pragma unroll
        for (int m = 0; m < 4; ++m) { acc[m][0] = f32x4{0.f, 0.f, 0.f, 0.f}; acc[m][1] = f32x4{0.f, 0.f, 0.f, 0.f}; }
        char* ldA = smem + wid * 1024 + lane * 16;
        char* ldB = smem + 8192 + wid * 1024 + lane * 16;
#define RT_ISSUE(slot, kt_) do { const int ao_ = (kt_) * 64; const int bo_ = (kt_) * 64; \
        __builtin_amdgcn_global_load_lds((const unsigned*)(ga + ao_), (LAS unsigned*)(ldA + (slot) * 40960), 16, 0, 0); \
        _Pragma("unroll") for (int i_ = 0; i_ < 4; ++i_) \
            __builtin_amdgcn_global_load_lds((const unsigned*)(gb[i_] + bo_), (LAS unsigned*)(ldB + (slot) * 40960 + i_ * 8192), 16, 0, 0); } while (0)
        __syncthreads();
        RT_ISSUE(0, 0);
        RT_ISSUE(1, 1);
        int slot = 0, slot2 = 2;
#pragma clang loop unroll(disable)
        for (int kt = 0; kt < 16; ++kt) {
            if (kt + 1 < 16) asm volatile("s_waitcnt vmcnt(5)" ::: "memory");
            else asm volatile("s_waitcnt vmcnt(0)" ::: "memory");
            __builtin_amdgcn_s_barrier();
            if (kt + 2 < 16) RT_ISSUE(slot2, kt + 2);
            const char* sA_ = smem + slot * 40960;
            const char* sB_ = sA_ + 8192;
#pragma unroll
            for (int ks = 0; ks < 2; ++ks) {
                f16x8 af[4];
#pragma unroll
                for (int m = 0; m < 4; ++m) af[m] = *(const f16x8*)(sA_ + swz(m * 16 + fr, ks * 4 + fq));
#pragma unroll
                for (int n = 0; n < 2; ++n) {
                    const f16x8 bfr = *(const f16x8*)(sB_ + swz((2 * wid + n) * 16 + fr, ks * 4 + fq));
#pragma unroll
                    for (int m = 0; m < 4; ++m) acc[m][n] = __builtin_amdgcn_mfma_f32_16x16x32_f16(af[m], bfr, acc[m][n], 0, 0, 0);
                }
            }
            slot = (slot == 2) ? 0 : slot + 1;
            slot2 = (slot2 == 2) ? 0 : slot2 + 1;
        }
#undef RT_ISSUE
        __syncthreads();
#pragma unroll
        for (int m = 0; m < 4; ++m)
#pragma unroll
            for (int n = 0; n < 2; ++n)
#pragma unroll
                for (int j = 0; j < 4; ++j) lgs[(m * 16 + fq * 4 + j) * NE + (2 * wid + n) * 16 + fr] = acc[m][n][j];
        __syncthreads();
        topk4_lds(p, lgs + (wid * 8) * NE, mt * 64 + wid * 8, lane);
        topk4_lds(p, lgs + (wid * 8 + 4) * NE, mt * 64 + wid * 8 + 4, lane);
    }
}


__device__ __forceinline__ unsigned zero_bytes(unsigned x) { return ~(((x & 0x7f7f7f7fu) + 0x7f7f7f7fu) | x | 0x7f7f7f7fu); }
__device__ __forceinline__ void ph_lists(const Params& p, char* smem) {
    const int tid = otid(), lane = tid & 63, wid = tid >> 6;
    int* wtot = (int*)smem;
    for (int e = blockIdx.x; e < NE; e += gridDim.x) {
        __syncthreads();
        const uint4* src = (const uint4*)p.topi() + wid * 1024;
        const unsigned pat = (unsigned)e * 0x01010101u;
        int cl = 0;
#pragma unroll 4
        for (int i = 0; i < 16; ++i) {
            const uint4 v = src[i * 64 + lane];
            cl += __popc(zero_bytes(v.x ^ pat)) + __popc(zero_bytes(v.y ^ pat)) + __popc(zero_bytes(v.z ^ pat)) + __popc(zero_bytes(v.w ^ pat));
        }
        const int cntw = (int)wave_sum((float)cl);
        if (lane == 0) wtot[wid] = cntw;
        __syncthreads();
        int base = 0, tot = 0;
        for (int w = 0; w < 8; ++w) { const int c = wtot[w]; if (w < wid) base += c; tot += c; }
        if (tid == 0) p.cnt()[e] = tot;
        int* dst = p.list() + (size_t)e * T;
        for (int i = 0; i < 16; ++i) {
            const uint4 v = src[i * 64 + lane];
            unsigned z[4] = {zero_bytes(v.x ^ pat), zero_bytes(v.y ^ pat), zero_bytes(v.z ^ pat), zero_bytes(v.w ^ pat)};
            const int c = __popc(z[0]) + __popc(z[1]) + __popc(z[2]) + __popc(z[3]);
            int inc = c;
#pragma unroll
            for (int o = 1; o < 64; o <<= 1) { const int t = __shfl_up(inc, o, 64); inc += (lane >= o) ? t : 0; }
            int pos = base + inc - c;
            const int a0 = (wid * 1024 + i * 64 + lane) * 16;
#pragma unroll
            for (int w = 0; w < 4; ++w) {
                unsigned zz = z[w];
                while (zz) {
                    const int b = (__ffs(zz) - 1) >> 3;
                    dst[pos++] = a0 + w * 4 + b;
                    zz &= zz - 1u;
                }
            }
            base += __shfl(inc, 63, 64);
        }
    }
}

struct ExpMap { int* cnt; int* off; int* tile; };
__device__ __forceinline__ ExpMap exp_map(const Params& p, char* smem) {
    ExpMap m;
    m.cnt = (int*)(smem + 98304); m.off = m.cnt + 256; m.tile = m.off + 256;
    int* wsum = m.tile + 260;
    const int tid = otid(), lane = tid & 63, wid = tid >> 6;
    __syncthreads();
    int c = 0, tl = 0, ic = 0, it = 0;
    if (tid < NE) {
        c = p.cnt()[tid]; tl = (c + 255) >> 8;
        ic = c; it = tl;
#pragma unroll
        for (int o = 1; o < 64; o <<= 1) {
            const int a = __shfl_up(ic, o, 64), b = __shfl_up(it, o, 64);
            ic += (lane >= o) ? a : 0; it += (lane >= o) ? b : 0;
        }
        m.cnt[tid] = c;
        if (lane == 63) { wsum[wid * 2] = ic; wsum[wid * 2 + 1] = it; }
    }
    __syncthreads();
    if (tid < NE) {
        int bo = 0, bt = 0;
        for (int w = 0; w < wid; ++w) { bo += wsum[w * 2]; bt += wsum[w * 2 + 1]; }
        m.off[tid] = bo + ic - c;
        m.tile[tid] = bt + it - tl;
        if (tid == NE - 1) m.tile[NE] = bt + it;
    }
    __syncthreads();
    return m;
}
__device__ __forceinline__ int find_expert(const int* tile, int rt) {
    int lo = 0, hi = NE;
    while (hi - lo > 1) { const int mid = (lo + hi) >> 1; if (tile[mid] <= rt) lo = mid; else hi = mid; }
    return lo;
}
#define ROWA(smem) ((int*)((smem) + 98304 + 3328))
#define ROWW(smem) ((float*)((smem) + 98304 + 3328 + 1024))

__device__ __forceinline__ void ph_gateup(const Params& p, char* smem) {
    const int tid = otid(), lane = tid & 63, wid = tid >> 6, wr = wid >> 1, wc = wid & 1;
    const ExpMap em = exp_map(p, smem);
    int* rowA = ROWA(smem);
    const int ntile = em.tile[NE];
    const int U = (ntile + T / 256) * 2;
    const int xcd = blockIdx.x & 7, nbx = gridDim.x >> 3;
    const int lo = (int)(((long long)U * xcd) >> 3), hi = (int)(((long long)U * (xcd + 1)) >> 3);
    for (int u = lo + (blockIdx.x >> 3); u < hi; u += nbx) {
        const int rt = u >> 1, c0 = (u & 1) * 128;
        const float *Wg, *Wu;
        bf16_t* gdst;
        int nrow, tokv = -1;
        if (rt < ntile) {
            const int e = find_expert(em.tile, rt);
            const int r0 = (rt - em.tile[e]) * 256, ne = em.cnt[e];
            Wg = p.w_eg + (size_t)e * D * ED; Wu = p.w_eu + (size_t)e * D * ED;
            gdst = p.gbuf() + ((size_t)em.off[e] + r0) * ED + c0;
            nrow = ne - r0;
            if (tid < 256 && r0 + tid < ne) tokv = p.list()[(size_t)e * T + r0 + tid] >> 3;
        } else {
            const int tb = (rt - ntile) * 256;
            Wg = p.w_sg; Wu = p.w_su;
            gdst = p.gsh() + (size_t)tb * ED + c0;
            nrow = 256;
            tokv = tb + (tid & 255);
        }
        __syncthreads();
        if (tid < 256) rowA[tid] = tokv;
        __syncthreads();
        const int t0 = rowA[0];
        f32x4 acc[4][8];
        gemm5(smem, D,
              [&](int r) { const int t = rowA[r]; return p.h2() + (size_t)(t < 0 ? t0 : t) * 2048; },
              [&](int n) { const int t16 = n >> 4; return ((t16 & 1) ? Wu : Wg) + c0 + 16 * (t16 >> 1) + (n & 15); },
              ED, acc);
        if (wr * 64 < nrow) {
            char* wl = smem + wid * EPI_WAVE;
#pragma unroll
            for (int m = 0; m < 4; ++m) {
                const int rb = wr * 64 + m * 16;
                epi_bf16(wl, lane,
                         [&](int n, int j) { if (n >= 4) return 0.f; const float g = acc[m][2 * n][j], uu = acc[m][2 * n + 1][j]; return g / (1.f + __expf(-g)) * uu; },
                         [&](int row, int ch, u32x4 v) { if (ch < 8 && rb + row < nrow) *(u32x4*)(gdst + (size_t)(rb + row) * ED + wc * 64 + ch * 8) = v; });
            }
        }
    }
}

__device__ __forceinline__ void ph_down(const Params& p, char* smem) {
    const int tid = otid(), lane = tid & 63, wid = tid >> 6, wr = wid >> 1, wc = wid & 1;
    const ExpMap em = exp_map(p, smem);
    int* rowA = ROWA(smem);
    float* rowW = ROWW(smem);
    const int ntile = em.tile[NE];
    const int U = (ntile + T / 256) * 4;
    const int xcd = blockIdx.x & 7, nbx = gridDim.x >> 3;
    const int lo = (int)(((long long)U * xcd) >> 3), hi = (int)(((long long)U * (xcd + 1)) >> 3);
    for (int u = lo + (blockIdx.x >> 3); u < hi; u += nbx) {
        const int rt = u >> 2, nt = u & 3;
        const bf16_t* A;
        const float* W;
        int nrow, slot = -1;
        float wv = 0.f;
        if (rt < ntile) {
            const int e = find_expert(em.tile, rt);
            const int r0 = (rt - em.tile[e]) * 256, ne = em.cnt[e];
            A = p.gbuf() + ((size_t)em.off[e] + r0) * ED;
            W = p.w_ed + (size_t)e * ED * D + nt * 256;
            nrow = ne - r0;
            if (tid < 256 && r0 + tid < ne) {
                const int a = p.list()[(size_t)e * T + r0 + tid];
                slot = a;
                wv = p.topw()[a] * Y8_SCALE;
            }
        } else {
            const int tb = (rt - ntile) * 256;
            A = p.gsh() + (size_t)tb * ED;
            W = p.w_sd + nt * 256;
            nrow = 256;
            slot = tb + (tid & 255);
            wv = 1.f;
        }
        __syncthreads();
        if (tid < 256) { rowA[tid] = slot; rowW[tid] = wv; }
        __syncthreads();
        f32x4 acc[4][8];
        gemm5(smem, ED, [&](int r) { return A + (size_t)(r < nrow ? r : 0) * ED; }, [&](int n) { return W + n; }, D, acc);
        if (wr * 64 < nrow) {
            char* wl = smem + wid * EPI_WAVE;
#pragma unroll
            for (int m = 0; m < 4; ++m) {
                const int rb = wr * 64 + m * 16;
                float wj[4];
#pragma unroll
                for (int j = 0; j < 4; ++j) wj[j] = rowW[rb + (lane >> 4) * 4 + j];
                if (rt < ntile) {
                    epi_fp8(wl, lane, [&](int n, int j) { return __builtin_amdgcn_fmed3f(acc[m][n][j] * wj[j], -440.f, 440.f); },
                            [&](int row, int ch, u32x4 v) {
                                const int sl = rowA[rb + row];
                                if (sl >= 0) *(u32x4*)(p.ybuf() + (size_t)sl * D + nt * 256 + wc * 128 + ch * 16) = v;
                            });
                } else {
                    epi_bf16(wl, lane, [&](int n, int j) { return acc[m][n][j]; },
                             [&](int row, int ch, u32x4 v) {
                                 const int sl = rowA[rb + row];
                                 *(u32x4*)(p.ysh() + (size_t)sl * D + nt * 256 + wc * 128 + ch * 8) = v;
                             });
                }
            }
        }
    }
}

__device__ __forceinline__ void ph_final(const Params& p) {
    const int tid = otid(), lane = tid & 63, wid = tid >> 6;
    for (int row = blockIdx.x * 8 + wid; row < T; row += gridDim.x * 8) {
        const int b = row >> 12;
        const float* g2 = p.mod() + b * 6144 + 5120;
        float4 v[4];
        float s = 0.f;
#pragma unroll
        for (int i = 0; i < 4; ++i) {
            const int col = (lane + 64 * i) * 4;
            float f0 = 0.f, f1 = 0.f, f2 = 0.f, f3 = 0.f;
#pragma unroll
            for (int k = 0; k < 8; ++k) {
                const int w8 = *(const int*)(p.ybuf() + ((size_t)row * 8 + k) * D + col);
                const v2f_t lo = __builtin_amdgcn_cvt_pk_f32_fp8(w8, false), hi = __builtin_amdgcn_cvt_pk_f32_fp8(w8, true);
                f0 += lo[0]; f1 += lo[1]; f2 += hi[0]; f3 += hi[1];
            }
            f0 *= (1.f / Y8_SCALE); f1 *= (1.f / Y8_SCALE); f2 *= (1.f / Y8_SCALE); f3 *= (1.f / Y8_SCALE);
            {
                const uint2 w = *(const uint2*)(p.ysh() + (size_t)row * D + col);
                f0 += __uint_as_float(w.x << 16); f1 += __uint_as_float(w.x & 0xffff0000u);
                f2 += __uint_as_float(w.y << 16); f3 += __uint_as_float(w.y & 0xffff0000u);
            }
            float4 xv;
            { const uint2 xw = *(const uint2*)(p.x1() + (size_t)row * D + col);
              xv.x = __uint_as_float(xw.x << 16); xv.y = __uint_as_float(xw.x & 0xffff0000u); xv.z = __uint_as_float(xw.y << 16); xv.w = __uint_as_float(xw.y & 0xffff0000u); }
            const float4 g4 = *(const float4*)(g2 + col);
            v[i].x = ALPHA * xv.x + g4.x * f0; v[i].y = ALPHA * xv.y + g4.y * f1;
            v[i].z = ALPHA * xv.z + g4.z * f2; v[i].w = ALPHA * xv.w + g4.w * f3;
            s += v[i].x + v[i].y + v[i].z + v[i].w;
        }
        const float mean = wave_sum(s) * (1.f / D);
        float q = 0.f;
#pragma unroll
        for (int i = 0; i < 4; ++i) {
            v[i].x -= mean; v[i].y -= mean; v[i].z -= mean; v[i].w -= mean;
            q += v[i].x * v[i].x + v[i].y * v[i].y + v[i].z * v[i].z + v[i].w * v[i].w;
        }
        const float rstd = rsqrtf(wave_sum(q) * (1.f / D) + LN_EPS);
#pragma unroll
        for (int i = 0; i < 4; ++i) {
            const int col = (lane + 64 * i) * 4;
            const float4 g4 = *(const float4*)(p.ln2_g + col), b4 = *(const float4*)(p.ln2_b + col);
            float4 y;
            y.x = v[i].x * rstd * g4.x + b4.x; y.y = v[i].y * rstd * g4.y + b4.y;
            y.z = v[i].z * rstd * g4.z + b4.z; y.w = v[i].w * rstd * g4.w + b4.w;
            *(float4*)(p.out + (size_t)row * D + col) = y;
        }
    }
}

constexpr int LDS_BYTES = 2 * VB_LDS + 16;
constexpr int NPHASE = 13;

template <int PH>
__device__ __forceinline__ void run_phase(const Params& p, char* smem) {
    if (PH == 0) ph_mod(p, smem);
    if (PH == 1) ph_ln0(p);
    if (PH == 2) ph_inproj(p, smem);
    if (PH == 3) { ph_h1(p, smem); ph_attn(p, smem); }
    if (PH == 4) { ph_h2(p); ph_attn_merge(p); }
    if (PH == 5) ph_h3(p, smem);
    if (PH == 6) ph_outproj(p, smem);
    if (PH == 7) ph_ln1(p);
    if (PH == 8) ph_router_topk(p, smem);
    if (PH == 9) ph_lists(p, smem);
    if (PH == 10) ph_gateup(p, smem);
    if (PH == 11) ph_down(p, smem);
    if (PH == 12) ph_final(p);
}

template <int PH>
__global__ void __launch_bounds__(NTHREADS, 2) k_phase(Params p) {
    extern __shared__ __attribute__((aligned(16))) char smem[];
    run_phase<PH>(p, smem);
}

__global__ void __launch_bounds__(NTHREADS, 2) k_all(Params p) {
    extern __shared__ __attribute__((aligned(16))) char smem[];
    volatile LAS unsigned* st = (volatile LAS unsigned*)(smem + LDS_BYTES - 16);
    if (threadIdx.x == 0) { st[0] = 0u; st[1] = 0u; st[2] = 0u; st[3] = 0u; }
    __syncthreads();
    XcdBarrier bar = xcd_barrier_post(p.bar(), st);
    run_phase<0>(p, smem); xcd_barrier(bar);
    run_phase<1>(p, smem); xcd_barrier(bar);
    run_phase<2>(p, smem); xcd_barrier(bar);
    run_phase<3>(p, smem); xcd_barrier(bar);
    run_phase<4>(p, smem); xcd_barrier(bar);
    run_phase<5>(p, smem); xcd_barrier(bar);
    run_phase<6>(p, smem); xcd_barrier(bar);
    run_phase<7>(p, smem); xcd_barrier(bar);
    run_phase<8>(p, smem); xcd_barrier(bar);
    run_phase<9>(p, smem); xcd_barrier(bar);
    run_phase<10>(p, smem); xcd_barrier(bar);
    run_phase<11>(p, smem); xcd_barrier(bar);
    run_phase<12>(p, smem);
}

template <int PH>
static void launch_phase(const Params& p, int grid, hipStream_t stream) {
    static bool attr = false;
    if (!attr) { (void)hipFuncSetAttribute((const void*)k_phase<PH>, hipFuncAttributeMaxDynamicSharedMemorySize, LDS_BYTES); attr = true; }
    hipLaunchKernelGGL(k_phase<PH>, dim3(grid), dim3(NTHREADS), LDS_BYTES, stream, p);
}

extern "C" void kernel_launch(void* const* d_in, const int* in_sizes, int n_in, void* d_out, int out_size, void* d_ws, size_t ws_size,
                              hipStream_t stream) {
    (void)in_sizes; (void)n_in; (void)out_size;
    Params p{};
    const float** pin = (const float**)&p.x;
    for (int i = 0; i < 21; ++i) pin[i] = (const float*)d_in[i];
    p.out = (float*)d_out;
    p.ws = (char*)d_ws;
    char* ctl = p.ws + WO_ctl;
    if (WS_END > ws_size) { fprintf(stderr, "kernel_launch: workspace too small: need %zu have %zu\n", (size_t)WS_END, ws_size); return; }

    static int grid = 0;
    if (grid == 0) {
        int dev = 0, cus = 0, per_cu = 0;
        (void)hipGetDevice(&dev);
        (void)hipDeviceGetAttribute(&cus, hipDeviceAttributeMultiprocessorCount, dev);
        (void)hipFuncSetAttribute((const void*)k_all, hipFuncAttributeMaxDynamicSharedMemorySize, LDS_BYTES);
        (void)hipOccupancyMaxActiveBlocksPerMultiprocessor(&per_cu, (const void*)k_all, NTHREADS, LDS_BYTES);
        grid = cus;
        if (grid != 256) grid = 256;
        fprintf(stderr, "kernel_launch: cus %d per_cu %d grid %d ws need %zu have %zu\n", cus, per_cu, grid, (size_t)WS_END, ws_size);
    }
    (void)hipMemsetAsync(ctl, 0, 65536, stream);
#if ONE_LAUNCH
    hipLaunchKernelGGL(k_all, dim3(grid), dim3(NTHREADS), LDS_BYTES, stream, p);
#else
    launch_phase<0>(p, grid, stream); launch_phase<1>(p, grid, stream); launch_phase<2>(p, grid, stream); launch_phase<3>(p, grid, stream);
    launch_phase<4>(p, grid, stream); launch_phase<5>(p, grid, stream); launch_phase<6>(p, grid, stream); launch_phase<7>(p, grid, stream);
    launch_phase<8>(p, grid, stream); launch_phase<9>(p, grid, stream); launch_phase<10>(p, grid, stream); launch_phase<11>(p, grid, stream);
    launch_phase<12>(p, grid, stream);
#endif
}
```

```cpp
#include <hip/hip_runtime.h>
#include <stdint.h>
#include <stdio.h>

#ifndef ONE_LAUNCH
#define ONE_LAUNCH 1
#endif

constexpr int D = 1024, NBATCH = 4, S = 4096, T = NBATCH * S;
constexpr int INW = 4352;
constexpr int NE = 256, TOPK = 8, ED = 256;
constexpr int OFF_HQ = 0, OFF_HF = 512, OFF_HI = 1024, OFF_HG = 1536, OFF_AQ = 2048, OFF_AK = 2816, OFF_AV = 3584;
constexpr float ALPHA = 1.189207115002721f;
constexpr float LN_EPS = 1e-5f, RMS_EPS = 1e-6f;
constexpr int NTHREADS = 512;
constexpr int VB_LDS = 67584;

typedef unsigned short bf16_t;
using bf16x8 = __attribute__((ext_vector_type(8))) short;
using f32x4 = __attribute__((ext_vector_type(4))) float;
using u32x4 = __attribute__((ext_vector_type(4))) unsigned int;

typedef float v2f_t __attribute__((ext_vector_type(2)));
typedef __bf16 v2bf_t __attribute__((ext_vector_type(2)));
typedef short v4s __attribute__((ext_vector_type(4)));
typedef _Float16 v2h_t __attribute__((ext_vector_type(2)));
using f16x8 = __attribute__((ext_vector_type(8))) _Float16;
__device__ __forceinline__ uint32_t pack2h(float a, float b) { const v2f_t f = {a, b}; return __builtin_bit_cast(uint32_t, __builtin_convertvector(f, v2h_t)); }
__device__ __forceinline__ unsigned short f2bf(float f) { return __builtin_bit_cast(unsigned short, (__bf16)f); }
__device__ __forceinline__ float bf2f(unsigned short h) { return __uint_as_float(((uint32_t)h) << 16); }
__device__ __forceinline__ uint32_t pack2(float a, float b) {
    const v2f_t f = {a, b};
    return __builtin_bit_cast(uint32_t, __builtin_convertvector(f, v2bf_t));
}
__device__ __forceinline__ float sigmoidf_(float v) { return 1.f / (1.f + __expf(-v)); }

__device__ __forceinline__ int otid() { int t = threadIdx.x; asm volatile("" : "+v"(t)); return t; }

constexpr size_t al256(size_t x) { return (x + 255) & ~(size_t)255; }
constexpr size_t WO_ctl = 0;
constexpr size_t WO_mod = WO_ctl + al256(65536);
constexpr size_t WO_lbv = WO_mod + al256(4 * 6144 * 4);
constexpr size_t WO_biasT = WO_lbv + al256(512 * 4);
constexpr size_t WO_winT = WO_biasT + al256(3 * 129 * 4 * 4);
constexpr size_t WO_woutT = WO_winT + al256((size_t)INW * D * 2);
constexpr size_t WO_wrT = WO_woutT + al256((size_t)D * 768 * 2);
constexpr size_t WO_wsgT = WO_wrT + al256((size_t)2 * NE * D * 2);
constexpr size_t WO_wsuT = WO_wsgT + al256((size_t)ED * D * 2);
constexpr size_t WO_wsdT = WO_wsuT + al256((size_t)ED * D * 2);
constexpr size_t WO_h1 = WO_wsdT + al256((size_t)D * ED * 2);
constexpr size_t WO_proj = WO_h1 + al256((size_t)T * D * 2);
constexpr size_t WO_lgf = WO_proj + al256((size_t)T * INW * 2);
constexpr size_t WO_ao = WO_lgf + al256((size_t)T * 512 * 4);
constexpr size_t WO_alse = WO_ao + al256((size_t)3 * T * 256 * 4);
constexpr size_t WO_mixin = WO_alse + al256((size_t)3 * T * 4 * 4);
constexpr size_t WO_pre1 = WO_mixin + al256((size_t)T * 768 * 2);
constexpr size_t WO_x1 = WO_pre1 + al256((size_t)T * D * 4);
constexpr size_t WO_h2 = WO_x1 + al256((size_t)T * D * 2);
constexpr size_t WO_lgp = WO_h2 + al256((size_t)T * 2048 * 2);
constexpr size_t WO_topi = WO_lgp + al256((size_t)3 * T * NE * 4);
constexpr size_t WO_topw = WO_topi + al256((size_t)T * 8 * 4);
constexpr size_t WO_list = WO_topw + al256((size_t)T * 8 * 4);
constexpr size_t WO_gbuf = WO_list + al256((size_t)NE * T * 4);
constexpr size_t WO_gsh = WO_gbuf + al256((size_t)T * TOPK * ED * 2);
constexpr size_t WO_ybuf = WO_gsh + al256((size_t)T * ED * 2);
constexpr size_t WO_ysh = WO_ybuf + al256((size_t)T * 8 * D);
constexpr size_t WO_dec = WO_ysh + al256((size_t)T * D * 2);
constexpr size_t WS_END = WO_dec + al256((size_t)1024 * 128 * 4);
struct Params {
    const float *x, *c, *w_ada, *b_ada, *w_in, *hg_lb, *hg_nw, *rel_bias, *w_out, *ln1_g, *ln1_b, *w_router, *router_bias,
        *w_eg, *w_eu, *w_ed, *w_sg, *w_su, *w_sd, *ln2_g, *ln2_b;
    float* out;
    char* ws;
    __device__ __forceinline__ unsigned* bar() const { return (unsigned*)(ws + WO_ctl); }
    __device__ __forceinline__ int* cnt() const { return (int*)(ws + WO_ctl + 16384); }
    __device__ __forceinline__ bf16_t* kv() const { return (bf16_t*)(ws + WO_ybuf); }
    __device__ __forceinline__ bf16_t* sst() const { return (bf16_t*)(ws + WO_ybuf + (size_t)1024 * 16384 * 4); }
    __device__ __forceinline__ float* mod() const { return (float*)(ws + WO_mod); }
    __device__ __forceinline__ float* lbv() const { return (float*)(ws + WO_lbv); }
    __device__ __forceinline__ float* biasT() const { return (float*)(ws + WO_biasT); }
    __device__ __forceinline__ bf16_t* winT() const { return (bf16_t*)(ws + WO_winT); }
    __device__ __forceinline__ bf16_t* woutT() const { return (bf16_t*)(ws + WO_woutT); }
    __device__ __forceinline__ bf16_t* wrT() const { return (bf16_t*)(ws + WO_wrT); }
    __device__ __forceinline__ bf16_t* wsgT() const { return (bf16_t*)(ws + WO_wsgT); }
    __device__ __forceinline__ bf16_t* wsuT() const { return (bf16_t*)(ws + WO_wsuT); }
    __device__ __forceinline__ bf16_t* wsdT() const { return (bf16_t*)(ws + WO_wsdT); }
    __device__ __forceinline__ bf16_t* h1() const { return (bf16_t*)(ws + WO_h1); }
    __device__ __forceinline__ bf16_t* proj() const { return (bf16_t*)(ws + WO_proj); }
    __device__ __forceinline__ float* lgf() const { return (float*)(ws + WO_lgf); }
    __device__ __forceinline__ bf16_t* ao() const { return (bf16_t*)(ws + WO_ao); }
    __device__ __forceinline__ float* alse() const { return (float*)(ws + WO_alse); }
    __device__ __forceinline__ bf16_t* mixin() const { return (bf16_t*)(ws + WO_mixin); }
    __device__ __forceinline__ float* pre1() const { return (float*)(ws + WO_pre1); }
    __device__ __forceinline__ bf16_t* x1() const { return (bf16_t*)(ws + WO_x1); }
    __device__ __forceinline__ bf16_t* h2() const { return (bf16_t*)(ws + WO_h2); }
    __device__ __forceinline__ float* lgp() const { return (float*)(ws + WO_lgp); }
    __device__ __forceinline__ unsigned char* topi() const { return (unsigned char*)(ws + WO_topi); }
    __device__ __forceinline__ float* topw() const { return (float*)(ws + WO_topw); }
    __device__ __forceinline__ int* list() const { return (int*)(ws + WO_list); }
    __device__ __forceinline__ bf16_t* gbuf() const { return (bf16_t*)(ws + WO_gbuf); }
    __device__ __forceinline__ bf16_t* gsh() const { return (bf16_t*)(ws + WO_gsh); }
    __device__ __forceinline__ unsigned char* ybuf() const { return (unsigned char*)(ws + WO_ybuf); }
    __device__ __forceinline__ bf16_t* ysh() const { return (bf16_t*)(ws + WO_ysh); }
    __device__ __forceinline__ float* dec() const { return (float*)(ws + WO_dec); }
};

#define XB_TMO      128
#define XB_XCNT(j)  (256  + 64 * (j))
#define XB_XSUB(j)  (1280 + 64 * (j))
#define XB_XGEN(j)  (2304 + 64 * (j))
#define XB_TOP      3328
#define XB_TOPGEN   3392
#define XCD_BAR_WORDS 3456
#define XB_SPIN_CAP (1u << 18)
#define LAS __attribute__((address_space(3)))

__device__ __forceinline__ unsigned xb_ld(unsigned* p)              { return __hip_atomic_load(p, __ATOMIC_RELAXED, __HIP_MEMORY_SCOPE_AGENT); }
__device__ __forceinline__ unsigned xb_add(unsigned* p, unsigned v) { return __hip_atomic_fetch_add(p, v, __ATOMIC_RELAXED, __HIP_MEMORY_SCOPE_AGENT); }
__device__ __forceinline__ unsigned xb_xcc_id() { return (unsigned)__builtin_amdgcn_s_getreg((3 << 11) | 20) & 0xFu; }
#define XB_SPIN(cond, bar) do { unsigned _sp = 0; while (cond) { __builtin_amdgcn_s_sleep(1); \
    if ((++_sp & 255u) == 0u) { if (xb_ld(&(bar)[XB_TMO])) break; if (_sp > XB_SPIN_CAP) { atomicAdd(&(bar)[XB_TMO], 1u); break; } } } } while (0)

struct XcdBarrier {
    unsigned* bar; unsigned x;
    volatile LAS unsigned* st;
};
__device__ __forceinline__ XcdBarrier xcd_barrier_post(unsigned* bar, volatile LAS unsigned* st) {
    XcdBarrier b; b.bar = bar; b.x = xb_xcc_id(); b.st = st;
    if (threadIdx.x == 0) (void)xb_add(&bar[XB_XCNT(b.x)], 1u);
    return b;
}
__device__ __forceinline__ void xcd_barrier_complete(unsigned* bar, unsigned x, unsigned& nloc, unsigned& nx) {
    const unsigned G = gridDim.x * gridDim.y * gridDim.z;
    unsigned sum, cnt, mine, sp = 0u;
    for (;;) {
        sum = 0u; cnt = 0u; mine = 0u;
#pragma unroll
        for (unsigned j = 0; j < 16; ++j) { const unsigned c = xb_ld(&bar[XB_XCNT(j)]); sum += c; cnt += (c > 0u) ? 1u : 0u; mine = (j == x) ? c : mine; }
        if (sum == G) break;
        __builtin_amdgcn_s_sleep(1);
        if ((++sp & 255u) == 0u) { if (xb_ld(&bar[XB_TMO])) break; if (sp > XB_SPIN_CAP) { atomicAdd(&bar[XB_TMO], 1u); break; } }
    }
    nloc = mine > 0u ? mine : 1u; nx = cnt > 0u ? cnt : 1u;
}
__device__ __forceinline__ void xcd_barrier(const XcdBarrier& b) {
    asm volatile("s_waitcnt vmcnt(0)" ::: "memory");
    __syncthreads();
    if (threadIdx.x == 0) {
        unsigned* bar = b.bar;
        __builtin_amdgcn_s_waitcnt(0);
        unsigned nloc = b.st[0], nx = b.st[1];
        if (nloc == 0u) { xcd_barrier_complete(bar, b.x, nloc, nx); b.st[0] = nloc; b.st[1] = nx; }
        const unsigned old = xb_add(&bar[XB_XSUB(b.x)], 1u);
        const unsigned gen = old / nloc;
        if (old + 1u == (gen + 1u) * nloc) {
            __builtin_amdgcn_fence(__ATOMIC_RELEASE, "agent");
            asm volatile("s_waitcnt vmcnt(0)" ::: "memory");
            const unsigned og = xb_add(&bar[XB_TOP], 1u);
            const unsigned tg = og / nx;
            if (og + 1u == (tg + 1u) * nx) xb_add(&bar[XB_TOPGEN], 1u);
            else XB_SPIN(xb_ld(&bar[XB_TOPGEN]) == tg, bar);
            __builtin_amdgcn_fence(__ATOMIC_ACQUIRE, "agent");
            xb_add(&bar[XB_XGEN(b.x)], 1u);
            asm volatile("s_waitcnt vmcnt(0)" ::: "memory");
        } else {
            XB_SPIN(xb_ld(&bar[XB_XGEN(b.x)]) == gen, bar);
            __builtin_amdgcn_fence(__ATOMIC_ACQUIRE, "agent");
            asm volatile("s_waitcnt vmcnt(0)" ::: "memory");
        }
    }
    __syncthreads();
}

struct VB { int vb, nvb, tid; char* smem; };
__device__ __forceinline__ VB make_vb(char* smem) {
    const int t = otid();
    VB v; v.vb = (int)blockIdx.x * 2 + (t >> 8); v.nvb = (int)gridDim.x * 2; v.tid = t & 255; v.smem = smem + (t >> 8) * VB_LDS;
    return v;
}
__device__ __forceinline__ int swz(int row, int chunk) { return row * 128 + ((chunk ^ ((row >> 1) & 7)) << 4); }

__device__ __forceinline__ float wave_sum(float v) {
#pragma unroll
    for (int o = 32; o > 0; o >>= 1) v += __shfl_xor(v, o, 64);
    return v;
}

__device__ __forceinline__ int t5_bucket(int n) {
    if (n < 16) return n;
    const float v = logf((float)n / 16.f) / logf(128.f) * 16.f;
    int large = 16 + (int)v;
    return large < 31 ? large : 31;
}

__device__ __forceinline__ void tr_tile(const VB& v, const float* src, int ld, bf16_t* dst, bf16_t* dst2, int ldd, int k0, int n0) {
    float* t = (float*)v.smem;
    __syncthreads();
#pragma unroll
    for (int i = 0; i < 4; ++i) {
        const int r = (v.tid >> 4) + 16 * i, c4 = v.tid & 15;
        const f32x4 x = *(const f32x4*)(src + (size_t)(k0 + r) * ld + n0 + c4 * 4);
        t[r * 65 + c4 * 4 + 0] = x[0]; t[r * 65 + c4 * 4 + 1] = x[1]; t[r * 65 + c4 * 4 + 2] = x[2]; t[r * 65 + c4 * 4 + 3] = x[3];
    }
    __syncthreads();
    const int n = v.tid >> 2, kq = v.tid & 3;
    float f[16];
#pragma unroll
    for (int i = 0; i < 16; ++i) f[i] = t[(kq * 16 + i) * 65 + n];
    u32x4 a, b;
    a[0] = pack2(f[0], f[1]); a[1] = pack2(f[2], f[3]); a[2] = pack2(f[4], f[5]); a[3] = pack2(f[6], f[7]);
    b[0] = pack2(f[8], f[9]); b[1] = pack2(f[10], f[11]); b[2] = pack2(f[12], f[13]); b[3] = pack2(f[14], f[15]);
    bf16_t* d = dst + (size_t)(n0 + n) * ldd + k0 + kq * 16;
    *(u32x4*)d = a; *(u32x4*)(d + 8) = b;
    if (dst2) {
        u32x4 c, e;
#pragma unroll
        for (int i = 0; i < 4; ++i) { c[i] = pack2h(f[2 * i], f[2 * i + 1]); e[i] = pack2h(f[8 + 2 * i], f[8 + 2 * i + 1]); }
        bf16_t* d2 = dst2 + (size_t)(n0 + n) * ldd + k0 + kq * 16;
        *(u32x4*)d2 = c; *(u32x4*)(d2 + 8) = e;
    }
}

__device__ __forceinline__ void ph_mod(const Params& p, char* smem0) {
    const VB v = make_vb(smem0);
    const int tid = v.tid;
    float* cond = (float*)(v.smem + 20480);
    float* red = cond + 4096;
    for (int i = tid; i < 4096; i += 256) { const float x = p.c[i]; cond[i] = x / (1.f + __expf(-x)); }
    __syncthreads();
    const int NU = 194 + 1088 + 192 + 64 + 64 + 64 + 64;
    const int rounds = (NU + v.nvb - 1) / v.nvb;
    for (int it = 0; it < rounds; ++it) {
        int u = v.vb + it * v.nvb;
        if (u >= NU) u = NU - 1;
        if (u < 192) {
            const int c4 = tid & 7, kq = tid >> 3;
            f32x4 a0 = {0.f, 0.f, 0.f, 0.f}, a1 = a0, a2 = a0, a3 = a0;
            const float* wp = p.w_ada + u * 32 + c4 * 4;
#pragma unroll 8
            for (int k = kq; k < 1024; k += 32) {
                const f32x4 w = *(const f32x4*)(wp + (size_t)k * 6144);
                a0 += cond[k] * w; a1 += cond[1024 + k] * w; a2 += cond[2048 + k] * w; a3 += cond[3072 + k] * w;
            }
            *(f32x4*)(red + (kq * 4 + 0) * 32 + c4 * 4) = a0; *(f32x4*)(red + (kq * 4 + 1) * 32 + c4 * 4) = a1;
            *(f32x4*)(red + (kq * 4 + 2) * 32 + c4 * 4) = a2; *(f32x4*)(red + (kq * 4 + 3) * 32 + c4 * 4) = a3;
        }
        __syncthreads();
        if (u < 192) {
            if (tid < 128) {
                const int b = tid >> 5, c2 = tid & 31;
                float s = 0.f;
                for (int q = 0; q < 32; ++q) s += red[(q * 4 + b) * 32 + c2];
                p.mod()[b * 6144 + u * 32 + c2] = s + p.b_ada[u * 32 + c2];
            }
        } else if (u == 192) {
            for (int j = tid; j < 512; j += 256) {
                const float a = p.hg_lb[j], b = p.hg_lb[512 + j];
                const float m = fmaxf(a, b);
                const float ea = expf(a - m), eb = expf(b - m);
                p.lbv()[j] = ea / (ea + eb);
            }
        } else if (u == 193) {
            for (int i = tid; i < 3 * 129 * 4; i += 256) {
                const int g = i / (129 * 4), m = (i >> 2) % 129, hh = i & 3;
                const int dil = (g == 0) ? 1 : (g == 1 ? 4 : 16);
                p.biasT()[i] = p.rel_bias[t5_bucket(m * dil) * 12 + g * 4 + hh];
            }
        }
        {
            int w = u - 194;
            const float* src = p.w_out; int ld = D; bf16_t* dst = p.woutT(); bf16_t* dst2 = nullptr; int ldd = 768, k0 = 0, n0 = 0;
            if (w >= 0) {
                if (w < 1088) { src = p.w_in; ld = INW; dst = p.winT(); ldd = D; k0 = (w / 68) * 64; n0 = (w % 68) * 64; }
                else if ((w -= 1088) < 192) { k0 = (w >> 4) * 64; n0 = (w & 15) * 64; }
                else if ((w -= 192) < 64) { src = p.w_router; ld = NE; dst = p.wrT() + (size_t)NE * D; dst2 = p.wrT(); ldd = D; k0 = (w >> 2) * 64; n0 = (w & 3) * 64; }
                else if ((w -= 64) < 64) { src = p.w_sg; ld = ED; dst = p.wsgT(); ldd = D; k0 = (w >> 2) * 64; n0 = (w & 3) * 64; }
                else if ((w -= 64) < 64) { src = p.w_su; ld = ED; dst = p.wsuT(); ldd = D; k0 = (w >> 2) * 64; n0 = (w & 3) * 64; }
                else { w -= 64; src = p.w_sd; ld = D; dst = p.wsdT(); ldd = ED; k0 = (w >> 4) * 64; n0 = (w & 15) * 64; }
            }
            tr_tile(v, src, ld, dst, dst2, ldd, k0, n0);
        }
    }
}

__device__ __forceinline__ void ph_ln0(const Params& p) {
    const int tid = otid(), lane = tid & 63, wid = tid >> 6;
    const int rstride = gridDim.x * 8;
    float4 nv[4];
    {
        const float4* xr = (const float4*)(p.x + (size_t)(blockIdx.x * 8 + wid) * D);
#pragma unroll
        for (int i = 0; i < 4; ++i) nv[i] = xr[lane + 64 * i];
    }
    for (int row = blockIdx.x * 8 + wid; row < T; row += rstride) {
        float4 v[4];
        float s = 0.f;
#pragma unroll
        for (int i = 0; i < 4; ++i) { v[i] = nv[i]; s += v[i].x + v[i].y + v[i].z + v[i].w; }
        if (row + rstride < T) {
            const float4* xn = (const float4*)(p.x + (size_t)(row + rstride) * D);
#pragma unroll
            for (int i = 0; i < 4; ++i) nv[i] = xn[lane + 64 * i];
        }
        const float mean = wave_sum(s) * (1.f / D);
        float q = 0.f;
#pragma unroll
        for (int i = 0; i < 4; ++i) {
            v[i].x -= mean; v[i].y -= mean; v[i].z -= mean; v[i].w -= mean;
            q += v[i].x * v[i].x + v[i].y * v[i].y + v[i].z * v[i].z + v[i].w * v[i].w;
        }
        const float rstd = rsqrtf(wave_sum(q) * (1.f / D) + LN_EPS);
        const int b = row >> 12;
        const float* sh = p.mod() + b * 6144;
        const float* sc = sh + 1024;
#pragma unroll
        for (int i = 0; i < 4; ++i) {
            const int col = (lane + 64 * i) * 4;
            const float4 s4 = *(const float4*)(sc + col), h4 = *(const float4*)(sh + col);
            uint2 o;
            o.x = pack2(v[i].x * rstd * (1.f + s4.x) + h4.x, v[i].y * rstd * (1.f + s4.y) + h4.y);
            o.y = pack2(v[i].z * rstd * (1.f + s4.z) + h4.z, v[i].w * rstd * (1.f + s4.w) + h4.w);
            *(uint2*)(p.h1() + (size_t)row * D + col) = o;
        }
    }
}

__device__ __forceinline__ int swz16(int row, int chunk) { return row * 256 + ((chunk ^ (row & 15)) << 4); }
struct TrBase { int lo, hi; };
__device__ __forceinline__ TrBase tr16_base(int lane) {
    const int g = lane >> 4, q = (lane & 15) >> 2, pp = lane & 3;
    const int xl = 8 * (g & 1) + q, h = pp >> 1;
    TrBase t;
    t.lo = (8 * g + q) * 256 + ((xl >> 1) << 5) + ((h ^ (xl & 1)) << 4) + 8 * (pp & 1);
    t.hi = (t.lo + 1024) ^ 64;
    return t;
}
__device__ __forceinline__ bf16x8 tr_frag16(const char* tile, const TrBase& tb, int ks, int c) {
    int cx = c << 5;
    asm volatile("" : "+v"(cx));
    const v4s lo = __builtin_amdgcn_ds_read_tr16_b64_v4i16((LAS v4s*)(tile + ks * 8192 + (tb.lo ^ cx)));
    const v4s hi = __builtin_amdgcn_ds_read_tr16_b64_v4i16((LAS v4s*)(tile + ks * 8192 + (tb.hi ^ cx)));
    return bf16x8{lo[0], lo[1], lo[2], lo[3], hi[0], hi[1], hi[2], hi[3]};
}


__device__ __forceinline__ int aoff(int row, int chunk) { return row * 64 + ((chunk ^ ((row >> 2) & 3)) << 4); }
__device__ __forceinline__ int boff(int row, int chunk) { return row * 512 + ((chunk ^ (((row & 3) << 1) | (((row >> 3) & 1) << 3))) << 4); }
__device__ __forceinline__ bf16x8 tr_pair(const char* p) {
    const v4s lo = __builtin_amdgcn_ds_read_tr16_b64_v4i16((LAS v4s*)(p));
    const v4s hi = __builtin_amdgcn_ds_read_tr16_b64_v4i16((LAS v4s*)(p + 2048));
    return bf16x8{lo[0], lo[1], lo[2], lo[3], hi[0], hi[1], hi[2], hi[3]};
}
constexpr int G3_STAGE = 32768;

template <int BMODE, class AF, class BF>
__device__ __forceinline__ void gemm3(char* smem, const int K, AF arow, BF bsrc, const int ldb, f32x4 (&acc)[4][8], const int nvalid = 256) {
    const int tid = otid(), lane = tid & 63, wid = tid >> 6, wr = wid >> 1, wc = wid & 1, fr = lane & 15, fq = lane >> 4;
    const bf16_t* ap[2];
#pragma unroll
    for (int i = 0; i < 2; ++i) ap[i] = arow((tid >> 2) + 128 * i) + (tid & 3) * 8;
    const float* bpf = nullptr;
    const bf16_t* bpb[2] = {nullptr, nullptr};
    if (BMODE == 0) bpf = (const float*)bsrc((tid & 63) * 4) + (size_t)(tid >> 6) * ldb;
    else {
#pragma unroll
        for (int i = 0; i < 2; ++i) bpb[i] = (const bf16_t*)bsrc((tid >> 2) + 128 * i) + (tid & 3) * 8;
    }
#pragma unroll
    for (int m = 0; m < 4; ++m)
#pragma unroll
        for (int n = 0; n < 8; ++n) acc[m][n] = f32x4{0.f, 0.f, 0.f, 0.f};
    const int trbase = (8 * fq + (fr >> 2)) * 512 + wc * 256 + (((fr >> 2) | ((fq & 1) << 2)) << 5) + ((fr & 3) >> 1) * 16 + (fr & 1) * 8;
    u32x4 ra0[2], ra1[2];
    f32x4 rf0[4], rf1[4];
    u32x4 rb0[2], rb1[2];
    const bool active = wr * 64 < nvalid;
#define G3_GLOAD(RA, RF, RB, k0) do { \
        _Pragma("unroll") for (int i = 0; i < 2; ++i) RA[i] = *(const u32x4*)(ap[i] + (k0)); \
        if (BMODE == 0) { _Pragma("unroll") for (int j = 0; j < 4; ++j) RF[j] = *(const f32x4*)(bpf + (size_t)((k0) + 8 * j) * ldb); } \
        else { _Pragma("unroll") for (int i = 0; i < 2; ++i) RB[i] = *(const u32x4*)(bpb[i] + (k0)); } } while (0)
#define G3_LWRITE(RA, RF, RB, st) do { \
        char* sA_ = (st); char* sB_ = (st) + 16384; \
        _Pragma("unroll") for (int i = 0; i < 2; ++i) *(u32x4*)(sA_ + aoff((tid >> 2) + 128 * i, tid & 3)) = RA[i]; \
        if (BMODE == 0) { _Pragma("unroll") for (int j = 0; j < 4; ++j) { uint2 w_; w_.x = pack2(RF[j][0], RF[j][1]); w_.y = pack2(RF[j][2], RF[j][3]); \
                *(uint2*)(sB_ + boff((tid >> 6) + 8 * j, (tid & 63) >> 1) + (tid & 1) * 8) = w_; } } \
        else { _Pragma("unroll") for (int i = 0; i < 2; ++i) *(u32x4*)(sB_ + aoff((tid >> 2) + 128 * i, tid & 3)) = RB[i]; } } while (0)
#define G3_COMPUTE(st) do { if (active) { \
        const char* sA_ = (st); const char* sB_ = (st) + 16384; \
        bf16x8 af[4]; \
        _Pragma("unroll") for (int m = 0; m < 4; ++m) af[m] = *(const bf16x8*)(sA_ + aoff(wr * 64 + m * 16 + fr, fq)); \
        _Pragma("unroll") for (int n = 0; n < 8; ++n) { \
            bf16x8 bfr; \
            if (BMODE == 0) bfr = tr_pair(sB_ + (trbase ^ (n << 5))); else bfr = *(const bf16x8*)(sB_ + aoff(wc * 128 + n * 16 + fr, fq)); \
            _Pragma("unroll") for (int m = 0; m < 4; ++m) acc[m][n] = __builtin_amdgcn_mfma_f32_16x16x32_bf16(af[m], bfr, acc[m][n], 0, 0, 0); } } } while (0)
    const int nk = K >> 5;
    char* st0 = smem;
    char* st1 = smem + G3_STAGE;
    G3_GLOAD(ra0, rf0, rb0, 0);
    G3_GLOAD(ra1, rf1, rb1, 32);
    G3_LWRITE(ra0, rf0, rb0, st0);
    if (nk > 2) G3_GLOAD(ra0, rf0, rb0, 64);
    __syncthreads();
    for (int kt = 0; kt < nk; kt += 2) {
        G3_LWRITE(ra1, rf1, rb1, st1);
        if (kt + 3 < nk) G3_GLOAD(ra1, rf1, rb1, (kt + 3) * 32);
        G3_COMPUTE(st0);
        __syncthreads();
        if (kt + 2 < nk) G3_LWRITE(ra0, rf0, rb0, st0);
        if (kt + 4 < nk) G3_GLOAD(ra0, rf0, rb0, (kt + 4) * 32);
        G3_COMPUTE(st1);
        __syncthreads();
    }
#undef G3_GLOAD
#undef G3_LWRITE
#undef G3_COMPUTE
}

template <class AF, class BF>
__device__ __forceinline__ void gemm4(char* smem, const int K, AF arow, BF brow, f32x4 (&acc)[4][8]) {
    const int tid = otid(), lane = tid & 63, wid = tid >> 6, wr = wid >> 1, wc = wid & 1, fr = lane & 15, fq = lane >> 4;
    const bf16_t* ga[2];
    const bf16_t* gb[2];
#pragma unroll
    for (int i = 0; i < 2; ++i) {
        const int r = 16 * (wid + 8 * i) + (lane >> 2), sc = ((lane & 3) ^ ((r >> 2) & 3)) * 8;
        ga[i] = arow(r) + sc;
        gb[i] = brow(r) + sc;
    }
#pragma unroll
    for (int m = 0; m < 4; ++m)
#pragma unroll
        for (int n = 0; n < 8; ++n) acc[m][n] = f32x4{0.f, 0.f, 0.f, 0.f};
    char* ldst = smem + wid * 1024 + lane * 16;
#define G4_ISSUE(slot, k0) do { \
        char* d_ = ldst + (slot) * 32768; \
        __builtin_amdgcn_global_load_lds((const unsigned*)(ga[0] + (k0)), (LAS unsigned*)(d_), 16, 0, 0); \
        __builtin_amdgcn_global_load_lds((const unsigned*)(ga[1] + (k0)), (LAS unsigned*)(d_ + 8192), 16, 0, 0); \
        __builtin_amdgcn_global_load_lds((const unsigned*)(gb[0] + (k0)), (LAS unsigned*)(d_ + 16384), 16, 0, 0); \
        __builtin_amdgcn_global_load_lds((const unsigned*)(gb[1] + (k0)), (LAS unsigned*)(d_ + 16384 + 8192), 16, 0, 0); } while (0)
    const int nk = K >> 5;
    G4_ISSUE(0, 0);
    G4_ISSUE(1, 32);
    int slot = 0, slot2 = 2;
    for (int kt = 0; kt < nk; ++kt) {
        if (kt + 1 < nk) asm volatile("s_waitcnt vmcnt(4)" ::: "memory");
        else asm volatile("s_waitcnt vmcnt(0)" ::: "memory");
        __builtin_amdgcn_s_barrier();
        if (kt + 2 < nk) G4_ISSUE(slot2, (kt + 2) * 32);
        const char* sA_ = smem + slot * 32768;
        const char* sB_ = sA_ + 16384;
        bf16x8 af[4];
#pragma unroll
        for (int m = 0; m < 4; ++m) af[m] = *(const bf16x8*)(sA_ + aoff(wr * 64 + m * 16 + fr, fq));
#pragma unroll
        for (int n = 0; n < 8; ++n) {
            const bf16x8 bfr = *(const bf16x8*)(sB_ + aoff(wc * 128 + n * 16 + fr, fq));
#pragma unroll
            for (int m = 0; m < 4; ++m) acc[m][n] = __builtin_amdgcn_mfma_f32_16x16x32_bf16(af[m], bfr, acc[m][n], 0, 0, 0);
        }
        slot = (slot == 2) ? 0 : slot + 1;
        slot2 = (slot2 == 2) ? 0 : slot2 + 1;
    }
#undef G4_ISSUE
    __syncthreads();
}


constexpr int G5_B0 = 49152;
template <class AF, class BF>
__device__ __forceinline__ void gemm5(char* smem, const int K, AF arow, BF bsrc, const int ldb, f32x4 (&acc)[4][8]) {
    const int tid = otid(), lane = tid & 63, wid = tid >> 6, wr = wid >> 1, wc = wid & 1, fr = lane & 15, fq = lane >> 4;
    const bf16_t* ga[2];
#pragma unroll
    for (int i = 0; i < 2; ++i) {
        const int r = 16 * (wid + 8 * i) + (lane >> 2);
        ga[i] = arow(r) + (((lane & 3) ^ ((r >> 2) & 3)) * 8);
    }
    const float* bpf = (const float*)bsrc((tid & 63) * 4) + (size_t)(tid >> 6) * ldb;
#pragma unroll
    for (int m = 0; m < 4; ++m)
#pragma unroll
        for (int n = 0; n < 8; ++n) acc[m][n] = f32x4{0.f, 0.f, 0.f, 0.f};
    const int trbase = (8 * fq + (fr >> 2)) * 512 + wc * 256 + (((fr >> 2) | ((fq & 1) << 2)) << 5) + ((fr & 3) >> 1) * 16 + (fr & 1) * 8;
    char* ldst = smem + wid * 1024 + lane * 16;
    const unsigned lds0 = (unsigned)(size_t)smem;
    unsigned bwoff[4];
#pragma unroll
    for (int j = 0; j < 4; ++j) bwoff[j] = boff((tid >> 6) + 8 * j, (tid & 63) >> 1) + (tid & 1) * 8;
    f32x4 rf0[4], rf1[4];
    const int klast = K - 32;
#define G5_ADMA(slot, k0) do { \
        char* d_ = ldst + (slot) * 16384; \
        __builtin_amdgcn_global_load_lds((const unsigned*)(ga[0] + (k0)), (LAS unsigned*)(d_), 16, 0, 0); \
        __builtin_amdgcn_global_load_lds((const unsigned*)(ga[1] + (k0)), (LAS unsigned*)(d_ + 8192), 16, 0, 0); } while (0)
#define G5_BLOAD(RF, k0) do { const float* q0_ = bpf + (size_t)(k0) * ldb; const float* q1_ = q0_ + (size_t)8 * ldb; const float* q2_ = q0_ + (size_t)16 * ldb; const float* q3_ = q0_ + (size_t)24 * ldb; \
        asm volatile("global_load_dwordx4 %0, %4, off\n\tglobal_load_dwordx4 %1, %5, off\n\tglobal_load_dwordx4 %2, %6, off\n\tglobal_load_dwordx4 %3, %7, off" \
                     : "=&v"(RF[0]), "=&v"(RF[1]), "=&v"(RF[2]), "=&v"(RF[3]) : "v"(q0_), "v"(q1_), "v"(q2_), "v"(q3_) : "memory"); } while (0)
#define G5_BWAIT(RF, N) asm volatile("s_waitcnt vmcnt(" #N ")" : "+v"(RF[0]), "+v"(RF[1]), "+v"(RF[2]), "+v"(RF[3]) :: "memory")
#define G5_BWRITE(RF, st) do { const unsigned sB_ = lds0 + G5_B0 + (st) * 16384; \
        _Pragma("unroll") for (int j = 0; j < 4; ++j) { \
            const unsigned long long w_ = (unsigned long long)pack2(RF[j][0], RF[j][1]) | ((unsigned long long)pack2(RF[j][2], RF[j][3]) << 32); \
            asm volatile("ds_write_b64 %0, %1" :: "v"(sB_ + bwoff[j]), "v"(w_) : "memory"); } } while (0)
#define G5_TRB(n0) do { \
        _Pragma("unroll") for (int n = 0; n < 4; ++n) { const unsigned a_ = sBa_ + (unsigned)(trbase ^ (((n0) + n) << 5)); \
            asm volatile("ds_read_b64_tr_b16 %0, %2\n\tds_read_b64_tr_b16 %1, %2 offset:2048" : "=&v"(tl[n]), "=&v"(th[n]) : "v"(a_) : "memory"); } } while (0)
#define G5_TRW() asm volatile("s_waitcnt lgkmcnt(0)" : "+v"(tl[0]), "+v"(tl[1]), "+v"(tl[2]), "+v"(tl[3]), "+v"(th[0]), "+v"(th[1]), "+v"(th[2]), "+v"(th[3]) :: "memory")
#define G5_MM(n0) do { _Pragma("unroll") for (int n = 0; n < 4; ++n) { \
            const bf16x8 bfr = bf16x8{tl[n][0], tl[n][1], tl[n][2], tl[n][3], th[n][0], th[n][1], th[n][2], th[n][3]}; \
            _Pragma("unroll") for (int m = 0; m < 4; ++m) acc[m][(n0) + n] = __builtin_amdgcn_mfma_f32_16x16x32_bf16(af[m], bfr, acc[m][(n0) + n], 0, 0, 0); } } while (0)
#define G5_COMPUTE(aslot, bst) do { \
        const char* sA_ = smem + (aslot) * 16384; const unsigned sBa_ = lds0 + G5_B0 + (bst) * 16384; \
        v4s tl[4], th[4]; \
        G5_TRB(0); \
        bf16x8 af[4]; \
        _Pragma("unroll") for (int m = 0; m < 4; ++m) af[m] = *(const bf16x8*)(sA_ + aoff(wr * 64 + m * 16 + fr, fq)); \
        G5_TRW(); G5_MM(0); \
        G5_TRB(4); G5_TRW(); G5_MM(4); } while (0)
#define G5_KC(k) ((k) < klast ? (k) : klast)
    const int nk = K >> 5;
    G5_BLOAD(rf0, 0);
    G5_ADMA(0, 0);
    G5_BLOAD(rf1, 32);
    G5_BWAIT(rf0, 6);
    G5_BWRITE(rf0, 0);
    G5_ADMA(1, 32);
    G5_BLOAD(rf0, G5_KC(64));
    int as0 = 0, as2 = 2;
    for (int kt = 0; kt < nk; kt += 2) {
        asm volatile("s_waitcnt vmcnt(10) lgkmcnt(0)" ::: "memory");
        __builtin_amdgcn_s_barrier();
        G5_ADMA(as2, G5_KC((kt + 2) * 32));
        G5_BWAIT(rf1, 8);
        G5_BWRITE(rf1, 1);
        G5_BLOAD(rf1, G5_KC((kt + 3) * 32));
        G5_COMPUTE(as0, 0);
        as0 = (as0 == 2) ? 0 : as0 + 1; as2 = (as2 == 2) ? 0 : as2 + 1;
        asm volatile("s_waitcnt vmcnt(10) lgkmcnt(0)" ::: "memory");
        __builtin_amdgcn_s_barrier();
        G5_ADMA(as2, G5_KC((kt + 3) * 32));
        G5_BWAIT(rf0, 8);
        G5_BWRITE(rf0, 0);
        G5_BLOAD(rf0, G5_KC((kt + 4) * 32));
        G5_COMPUTE(as0, 1);
        as0 = (as0 == 2) ? 0 : as0 + 1; as2 = (as2 == 2) ? 0 : as2 + 1;
    }
    G5_BWAIT(rf0, 0);
    G5_BWAIT(rf1, 0);
    asm volatile("s_waitcnt lgkmcnt(0)" ::: "memory");
    __syncthreads();
#undef G5_ADMA
#undef G5_BLOAD
#undef G5_BWAIT
#undef G5_BWRITE
#undef G5_COMPUTE
#undef G5_TRB
#undef G5_TRW
#undef G5_MM
#undef G5_KC
}


template <class AF, class BF>
__device__ __forceinline__ void gemm6(char* smem, const int K, AF arow, BF brow, f32x4 (&acc)[4][8]) {
    const int tid = otid(), lane = tid & 63, wid = tid >> 6, wr = wid >> 1, wc = wid & 1, fr = lane & 15, fq = lane >> 4;
    const bf16_t* ga[4];
    const bf16_t* gb[4];
#pragma unroll
    for (int i = 0; i < 4; ++i) {
        const int r = 8 * (wid + 8 * i) + (lane >> 3), sc = ((lane & 7) ^ ((r >> 1) & 7)) * 8;
        ga[i] = arow(r) + sc;
        gb[i] = brow(r) + sc;
    }
#pragma unroll
    for (int m = 0; m < 4; ++m)
#pragma unroll
        for (int n = 0; n < 8; ++n) acc[m][n] = f32x4{0.f, 0.f, 0.f, 0.f};
    char* ldst = smem + wid * 1024 + lane * 16;
#define G6_ISSUE(slot, k0) do { char* d_ = ldst + (slot) * 65536; \
        _Pragma("unroll") for (int i_ = 0; i_ < 4; ++i_) { \
            __builtin_amdgcn_global_load_lds((const unsigned*)(ga[i_] + (k0)), (LAS unsigned*)(d_ + i_ * 8192), 16, 0, 0); \
            __builtin_amdgcn_global_load_lds((const unsigned*)(gb[i_] + (k0)), (LAS unsigned*)(d_ + 32768 + i_ * 8192), 16, 0, 0); } } while (0)
    const int nk = K >> 6;
    G6_ISSUE(0, 0);
    for (int kt = 0; kt < nk; ++kt) {
        asm volatile("s_waitcnt vmcnt(0)" ::: "memory");
        __builtin_amdgcn_s_barrier();
        if (kt + 1 < nk) G6_ISSUE((kt + 1) & 1, (kt + 1) * 64);
        const char* sA_ = smem + (kt & 1) * 65536;
        const char* sB_ = sA_ + 32768;
#pragma unroll
        for (int ks = 0; ks < 2; ++ks) {
            bf16x8 af[4];
#pragma unroll
            for (int m = 0; m < 4; ++m) af[m] = *(const bf16x8*)(sA_ + swz(wr * 64 + m * 16 + fr, ks * 4 + fq));
#pragma unroll
            for (int n = 0; n < 8; ++n) {
                const bf16x8 bfr = *(const bf16x8*)(sB_ + swz(wc * 128 + n * 16 + fr, ks * 4 + fq));
#pragma unroll
                for (int m = 0; m < 4; ++m) acc[m][n] = __builtin_amdgcn_mfma_f32_16x16x32_bf16(af[m], bfr, acc[m][n], 0, 0, 0);
            }
        }
    }
#undef G6_ISSUE
    __syncthreads();
}

constexpr int EPI_WAVE = 8704;
template <class VF, class SF>
__device__ __forceinline__ void epi_bf16(char* wl, const int lane, VF val, SF store) {
    const int fr = lane & 15, fq = lane >> 4, odd = lane & 1;
#pragma unroll
    for (int n = 0; n < 8; ++n)
#pragma unroll
        for (int jp = 0; jp < 2; ++jp) {
            const float a = val(n, 2 * jp), b = val(n, 2 * jp + 1);
            const float x = odd ? a : b;
            const float y = __shfl_xor(x, 1, 64);
            const uint32_t w = odd ? pack2(y, b) : pack2(a, y);
            *(uint32_t*)(wl + (fq * 4 + 2 * jp + odd) * 272 + (n * 16 + (fr & ~1)) * 2) = w;
        }
    int ln = lane;
    asm volatile("" : "+v"(ln));
#pragma unroll
    for (int i = 0; i < 4; ++i) {
        const int idx = ln + 64 * i, row = idx >> 4, ch = idx & 15;
        store(row, ch, *(const u32x4*)(wl + row * 272 + ch * 16));
    }
}
template <class VF, class SF>
__device__ __forceinline__ void epi_f32(char* wl, const int lane, VF val, SF store) {
    const int fr = lane & 15, fq = lane >> 4;
#pragma unroll
    for (int n = 0; n < 8; ++n)
#pragma unroll
        for (int j = 0; j < 4; ++j) *(float*)(wl + (fq * 4 + j) * 528 + (n * 16 + fr) * 4) = val(n, j);
    int ln = lane;
    asm volatile("" : "+v"(ln));
#pragma unroll
    for (int i = 0; i < 8; ++i) {
        const int idx = ln + 64 * i, row = idx >> 5, ch = idx & 31;
        store(row, ch, *(const f32x4*)(wl + row * 528 + ch * 16));
    }
}


constexpr float Y8_SCALE = 16.f;
template <class VF, class SF>
__device__ __forceinline__ void epi_fp8(char* wl, const int lane, VF val, SF store) {
    const int fr = lane & 15, fq = lane >> 4, odd = lane & 1;
#pragma unroll
    for (int n = 0; n < 8; ++n)
#pragma unroll
        for (int jp = 0; jp < 2; ++jp) {
            const float a = val(n, 2 * jp), b = val(n, 2 * jp + 1);
            const float x = odd ? a : b;
            const float y = __shfl_xor(x, 1, 64);
            const int w = odd ? __builtin_amdgcn_cvt_pk_fp8_f32(y, b, 0, false) : __builtin_amdgcn_cvt_pk_fp8_f32(a, y, 0, false);
            *(unsigned short*)(wl + (fq * 4 + 2 * jp + odd) * 144 + n * 16 + (fr & ~1)) = (unsigned short)w;
        }
    int ln = lane;
    asm volatile("" : "+v"(ln));
#pragma unroll
    for (int i = 0; i < 2; ++i) {
        const int idx = ln + 64 * i, row = idx >> 3, ch = idx & 7;
        store(row, ch, *(const u32x4*)(wl + row * 144 + ch * 16));
    }
}

__device__ __forceinline__ void ph_inproj(const Params& p, char* smem) {
    const int tid = otid(), lane = tid & 63, wid = tid >> 6, wr = wid >> 1, wc = wid & 1, fr = lane & 15;
    const int NTN = INW / 256;
    const int xcd = blockIdx.x & 7, nbx = gridDim.x >> 3;
    for (int i = blockIdx.x >> 3; i < 8 * NTN; i += nbx) {
        const int nt = i >> 3, mt = xcd * 8 + (i & 7);
        const bf16_t* A = p.h1() + (size_t)mt * 256 * D;
        const bf16_t* Bt = p.winT() + (size_t)nt * 256 * D;
        f32x4 acc[4][8];
        __syncthreads();
        gemm6(smem, D, [&](int r) { return A + (size_t)r * D; }, [&](int n) { return Bt + (size_t)n * D; }, acc);
        char* wl = smem + wid * EPI_WAVE;
        const int colb = nt * 256 + wc * 128;
        const int rowb = mt * 256 + wr * 64;
        if (colb >= OFF_HF && colb < OFF_HI) {
            float lbc[8];
#pragma unroll
            for (int n = 0; n < 8; ++n) lbc[n] = p.lbv()[colb - OFF_HF + n * 16 + fr];
#pragma unroll
            for (int m = 0; m < 4; ++m) {
                float* dst = p.lgf() + (size_t)(rowb + m * 16) * 512 + (colb - OFF_HF);
                epi_f32(wl, lane,
                        [&](int n, int j) { return __logf(lbc[n] + (1.f - lbc[n]) * (1.f / (1.f + __expf(-acc[m][n][j])))); },
                        [&](int row, int ch, f32x4 v) { *(f32x4*)(dst + (size_t)row * 512 + ch * 4) = v; });
            }
        } else {
#pragma unroll
            for (int m = 0; m < 4; ++m) {
                bf16_t* dst = p.proj() + (size_t)(rowb + m * 16) * INW + colb;
                epi_bf16(wl, lane, [&](int n, int j) { return acc[m][n][j]; },
                         [&](int row, int ch, u32x4 v) { *(u32x4*)(dst + (size_t)row * INW + ch * 8) = v; });
            }
        }
    }
}

__device__ __forceinline__ void ph_h1(const Params& p, char* smem0) {
    const VB vbk = make_vb(smem0);
    char* smem = vbk.smem;
    const int tid = vbk.tid, lane = tid & 63, wid = tid >> 6, wr = wid >> 1, wc = wid & 1, fr = lane & 15, fq = lane >> 4;
    char* sI = smem;
    char* sK = smem + 16384;
    float* sL = (float*)(smem + 32768);
    float* totS = (float*)(smem + 65536);
    const int d = tid & 127, half = tid >> 7;
    const TrBase trb = tr16_base(lane);
    for (int u = vbk.vb; u < 1024; u += vbk.nvb) {
        const int bh = u >> 6, c = u & 63, b = bh >> 2, h = bh & 3;
        const size_t row0 = (size_t)b * S + c * 64;
        __syncthreads();
#pragma unroll
        for (int i = 0; i < 4; ++i) {
            const int idx = tid + 256 * i, r = idx >> 4, ch = idx & 15;
            *(u32x4*)(sI + swz16(r, ch)) = *(const u32x4*)(p.proj() + (row0 + r) * INW + OFF_HI + h * 128 + ch * 8);
        }
#pragma unroll
        for (int i = 0; i < 8; ++i) {
            const int idx = tid + 256 * i, r = idx >> 5, c4 = idx & 31;
            *(f32x4*)(sL + r * 128 + c4 * 4) = *(const f32x4*)(p.lgf() + (row0 + r) * 512 + h * 128 + c4 * 4);
        }
        __syncthreads();
        const float* lcol = sL + half * 32 * 128 + d;
        float tot = 0.f;
#pragma unroll
        for (int s = 0; s < 32; ++s) tot += lcol[s * 128];
        totS[half * 128 + d] = tot;
        __syncthreads();
        const float t0 = totS[d], bl = t0 + totS[128 + d];
        float run = half ? t0 : 0.f;
#pragma unroll 8
        for (int s = 0; s < 32; ++s) {
            const float lv = lcol[s * 128];
            run += lv;
            const float kt = (1.f - __expf(lv)) * __expf(bl - run);
            *(bf16_t*)(sK + swz16(half * 32 + s, d >> 3) + (d & 7) * 2) = f2bf(kt);
        }
        if (half == 0) p.dec()[u * 128 + d] = __expf(bl);
        __syncthreads();
        f32x4 acc[4][4];
#pragma unroll
        for (int m = 0; m < 4; ++m)
#pragma unroll
            for (int n = 0; n < 4; ++n) acc[m][n] = f32x4{0.f, 0.f, 0.f, 0.f};
#pragma unroll
        for (int ks = 0; ks < 2; ++ks) {
            bf16x8 af[4], bfr[4];
#pragma unroll
            for (int m = 0; m < 4; ++m) af[m] = tr_frag16(sI, trb, ks, wr * 4 + m);
#pragma unroll
            for (int n = 0; n < 4; ++n) bfr[n] = tr_frag16(sK, trb, ks, wc * 4 + n);
#pragma unroll
            for (int m = 0; m < 4; ++m)
#pragma unroll
                for (int n = 0; n < 4; ++n) acc[m][n] = __builtin_amdgcn_mfma_f32_16x16x32_bf16(af[m], bfr[n], acc[m][n], 0, 0, 0);
        }
        __syncthreads();
        {
            int tz = tid;
            asm volatile("" : "+v"(tz));
            const int lz = tz & 63, odd = lz & 1;
            char* wbase = smem + ((tz >> 7) * 64 + (lz >> 4) * 4 + odd) * 272 + (((tz >> 6) & 1) * 64 + ((lz & 15) & ~1)) * 2;
#pragma unroll
            for (int m = 0; m < 4; ++m)
#pragma unroll
                for (int n = 0; n < 4; ++n)
#pragma unroll
                    for (int jp = 0; jp < 2; ++jp) {
                        const float a = acc[m][n][2 * jp], b2 = acc[m][n][2 * jp + 1];
                        const float x = odd ? a : b2;
                        const float y = __shfl_xor(x, 1, 64);
                        const uint32_t w = odd ? pack2(y, b2) : pack2(a, y);
                        *(uint32_t*)(wbase + (m * 16 + 2 * jp) * 272 + n * 32) = w;
                    }
            __syncthreads();
            bf16_t* kvu = p.kv() + (size_t)u * 16384;
            const int r0 = tz >> 4, ch = tz & 15;
#pragma unroll
            for (int i = 0; i < 8; ++i)
                *(u32x4*)(kvu + (r0 + 16 * i) * 128 + ch * 8) = *(const u32x4*)(smem + (r0 + 16 * i) * 272 + ch * 16);
        }
    }
}

__device__ __forceinline__ void ph_h2(const Params& p) {
    for (int it = blockIdx.x * NTHREADS + otid(); it < 16 * 8192; it += gridDim.x * NTHREADS) {
        const int bh = it >> 13, e2 = it & 8191, dv = e2 >> 6, dk = (e2 & 63) * 2;
        const size_t eoff = (size_t)dv * 128 + dk;
        float sx = 0.f, sy = 0.f;
        const bf16_t* kvp = p.kv() + (size_t)bh * 64 * 16384 + eoff;
        const float* dcp = p.dec() + (size_t)bh * 64 * 128 + dk;
        bf16_t* stp = p.sst() + (size_t)bh * 64 * 16384 + eoff;
        for (int c0 = 0; c0 < 64; c0 += 16) {
            uint32_t kvw[16];
            float2 dc[16];
#pragma unroll
            for (int i = 0; i < 16; ++i) {
                kvw[i] = *(const uint32_t*)(kvp + (size_t)(c0 + i) * 16384);
                dc[i] = *(const float2*)(dcp + (c0 + i) * 128);
            }
#pragma unroll
            for (int i = 0; i < 16; ++i) {
                *(uint32_t*)(stp + (size_t)(c0 + i) * 16384) = pack2(sx, sy);
                sx = dc[i].x * sx + __uint_as_float(kvw[i] << 16);
                sy = dc[i].y * sy + __uint_as_float(kvw[i] & 0xffff0000u);
            }
        }
    }
}

__device__ __forceinline__ void ph_h3(const Params& p, char* smem0) {
    const VB vbk = make_vb(smem0);
    char* smem = vbk.smem;
    const int tid = vbk.tid, lane = tid & 63, wid = tid >> 6, wr = wid >> 1, wc = wid & 1, fr = lane & 15, fq = lane >> 4;
    char* sQ = smem;
    char* sK = smem + 16384;
    char* sP = smem + 32768;
    float* sL = (float*)(smem + 32768);
    float* totS = (float*)(smem + 65536);
    char* sG = smem + 40960;
    const int d = tid & 127, half = tid >> 7;
    const TrBase trb = tr16_base(lane);
    for (int u = vbk.vb; u < 1024; u += vbk.nvb) {
        const int bh = u >> 6, c = u & 63, b = bh >> 2, h = bh & 3;
        const size_t row0 = (size_t)b * S + c * 64;
        __syncthreads();
#pragma unroll
        for (int i = 0; i < 4; ++i) {
            const int idx = tid + 256 * i, r = idx >> 4, ch = idx & 15;
            *(u32x4*)(sQ + swz16(r, ch)) = *(const u32x4*)(p.proj() + (row0 + r) * INW + OFF_HQ + h * 128 + ch * 8);
        }
#pragma unroll
        for (int i = 0; i < 8; ++i) {
            const int idx = tid + 256 * i, r = idx >> 5, c4 = idx & 31;
            *(f32x4*)(sL + r * 128 + c4 * 4) = *(const f32x4*)(p.lgf() + (row0 + r) * 512 + h * 128 + c4 * 4);
        }
        u32x4 sv0[4], sv1[4], iv[4], gv[4];
#pragma unroll
        for (int i = 0; i < 4; ++i) {
            const int r8 = (tid + 256 * i) >> 3;
            sv0[i] = *(const u32x4*)(p.sst() + (size_t)u * 16384 + r8 * 128 + (tid & 7) * 8);
            sv1[i] = *(const u32x4*)(p.sst() + (size_t)u * 16384 + r8 * 128 + 64 + (tid & 7) * 8);
            const int idx = tid + 256 * i, r = idx >> 4, c16 = idx & 15;
            iv[i] = *(const u32x4*)(p.proj() + (row0 + r) * INW + OFF_HI + h * 128 + c16 * 8);
            gv[i] = *(const u32x4*)(p.proj() + (row0 + r) * INW + OFF_HG + h * 128 + c16 * 8);
        }
        __syncthreads();
        const float* lcol = sL + half * 32 * 128 + d;
        float tot = 0.f;
#pragma unroll
        for (int s = 0; s < 32; ++s) tot += lcol[s * 128];
        totS[half * 128 + d] = tot;
        __syncthreads();
        const float t0 = totS[d];
        float run = half ? t0 : 0.f;
#pragma unroll 8
        for (int s = 0; s < 32; ++s) {
            const float lv = lcol[s * 128];
            run += lv;
            const int o = swz16(half * 32 + s, d >> 3) + (d & 7) * 2;
            const float qm = bf2f(*(const bf16_t*)(sQ + o)) * __expf(run - t0);
            const float kh = (1.f - __expf(lv)) * __expf(t0 - run);
            *(bf16_t*)(sQ + o) = f2bf(qm);
            *(bf16_t*)(sK + o) = f2bf(kh);
        }
        __syncthreads();
        {
            f32x4 pa[2][2];
#pragma unroll
            for (int m = 0; m < 2; ++m)
#pragma unroll
                for (int n = 0; n < 2; ++n) pa[m][n] = f32x4{0.f, 0.f, 0.f, 0.f};
#pragma unroll
            for (int ks = 0; ks < 4; ++ks) {
                bf16x8 af[2], bfr[2];
#pragma unroll
                for (int m = 0; m < 2; ++m) af[m] = *(const bf16x8*)(sQ + swz16(wr * 32 + m * 16 + fr, ks * 4 + fq));
#pragma unroll
                for (int n = 0; n < 2; ++n) bfr[n] = *(const bf16x8*)(sK + swz16(wc * 32 + n * 16 + fr, ks * 4 + fq));
#pragma unroll
                for (int m = 0; m < 2; ++m)
#pragma unroll
                    for (int n = 0; n < 2; ++n) pa[m][n] = __builtin_amdgcn_mfma_f32_16x16x32_bf16(af[m], bfr[n], pa[m][n], 0, 0, 0);
            }
#pragma unroll
            for (int m = 0; m < 2; ++m)
#pragma unroll
                for (int n = 0; n < 2; ++n)
#pragma unroll
                    for (int j = 0; j < 4; ++j) {
                        const int t = wr * 32 + m * 16 + fq * 4 + j, s_ = wc * 32 + n * 16 + fr;
                        const float v = (s_ <= t) ? pa[m][n][j] : 0.f;
                        *(bf16_t*)(sP + swz(t, s_ >> 3) + (s_ & 7) * 2) = f2bf(v);
                    }
        }
        __syncthreads();
        f32x4 oa[8];
#pragma unroll
        for (int i = 0; i < 4; ++i) { const int idx = tid + 256 * i; *(u32x4*)(sG + (idx >> 4) * 256 + (idx & 15) * 16) = gv[i]; }
#pragma unroll
        for (int n = 0; n < 8; ++n) oa[n] = f32x4{0.f, 0.f, 0.f, 0.f};
        const int ch = tid & 7;
#pragma unroll
        for (int sub = 0; sub < 2; ++sub) {
            float sc[8];
#pragma unroll
            for (int j = 0; j < 8; ++j) sc[j] = __expf(totS[sub * 64 + ch * 8 + j]);
#pragma unroll
            for (int i = 0; i < 4; ++i) {
                const int r = (tid + 256 * i) >> 3;
                const u32x4 v = sub ? sv1[i] : sv0[i];
                u32x4 w;
                w.x = pack2(__uint_as_float(v.x << 16) * sc[0], __uint_as_float(v.x & 0xffff0000u) * sc[1]);
                w.y = pack2(__uint_as_float(v.y << 16) * sc[2], __uint_as_float(v.y & 0xffff0000u) * sc[3]);
                w.z = pack2(__uint_as_float(v.z << 16) * sc[4], __uint_as_float(v.z & 0xffff0000u) * sc[5]);
                w.w = pack2(__uint_as_float(v.w << 16) * sc[6], __uint_as_float(v.w & 0xffff0000u) * sc[7]);
                *(u32x4*)(sK + swz(r, ch)) = w;
            }
            __syncthreads();
#pragma unroll
            for (int ks = 0; ks < 2; ++ks) {
                const bf16x8 af = *(const bf16x8*)(sQ + swz16(wid * 16 + fr, sub * 8 + ks * 4 + fq));
#pragma unroll
                for (int n = 0; n < 8; ++n) {
                    const bf16x8 bfr = *(const bf16x8*)(sK + swz(n * 16 + fr, ks * 4 + fq));
                    oa[n] = __builtin_amdgcn_mfma_f32_16x16x32_bf16(af, bfr, oa[n], 0, 0, 0);
                }
            }
            __syncthreads();
        }
#pragma unroll
        for (int i = 0; i < 4; ++i) {
            const int idx = tid + 256 * i, r = idx >> 4, c16 = idx & 15;
            *(u32x4*)(sK + swz16(r, c16)) = iv[i];
        }
        __syncthreads();
#pragma unroll
        for (int ks = 0; ks < 2; ++ks) {
            const bf16x8 af = *(const bf16x8*)(sP + swz(wid * 16 + fr, ks * 4 + fq));
#pragma unroll
            for (int n = 0; n < 8; ++n) {
                const bf16x8 bfr = tr_frag16(sK, trb, ks, n);
                oa[n] = __builtin_amdgcn_mfma_f32_16x16x32_bf16(af, bfr, oa[n], 0, 0, 0);
            }
        }
        float ss[4] = {0.f, 0.f, 0.f, 0.f};
#pragma unroll
        for (int n = 0; n < 8; ++n)
#pragma unroll
            for (int j = 0; j < 4; ++j) ss[j] += oa[n][j] * oa[n][j];
#pragma unroll
        for (int j = 0; j < 4; ++j) {
            ss[j] += __shfl_xor(ss[j], 1, 64); ss[j] += __shfl_xor(ss[j], 2, 64); ss[j] += __shfl_xor(ss[j], 4, 64); ss[j] += __shfl_xor(ss[j], 8, 64);
        }
        {
            int lz = lane;
            asm volatile("" : "+v"(lz));
            const int odd = lz & 1, fr = lz & 15, fq = lz >> 4;
            float rstd[4];
#pragma unroll
            for (int j = 0; j < 4; ++j) rstd[j] = rsqrtf(ss[j] * (1.f / 128.f) + RMS_EPS);
#pragma unroll
            for (int n = 0; n < 8; ++n) {
                const int dv = n * 16 + fr;
                const float nw = p.hg_nw[h * 128 + dv];
                float y[4];
#pragma unroll
                for (int j = 0; j < 4; ++j) {
                    const float g = bf2f(*(const bf16_t*)(sG + (wid * 16 + fq * 4 + j) * 256 + dv * 2));
                    y[j] = oa[n][j] * rstd[j] * nw * (g / (1.f + __expf(-g)));
                }
#pragma unroll
                for (int jp = 0; jp < 2; ++jp) {
                    const float a = y[2 * jp], b2 = y[2 * jp + 1];
                    const float x = odd ? a : b2;
                    const float z = __shfl_xor(x, 1, 64);
                    const size_t row = row0 + wid * 16 + fq * 4 + 2 * jp + odd;
                    *(uint32_t*)(p.mixin() + row * 768 + h * 128 + n * 16 + (fr & ~1)) = odd ? pack2(z, b2) : pack2(a, z);
                }
            }
        }
    }
}

__device__ __forceinline__ TrBase tr8_base(int lane) {
    const int g = lane >> 4, q = (lane & 15) >> 2, pp = lane & 3;
    const int xl = 4 * (g & 1) + (q >> 1), h = pp >> 1;
    TrBase t;
    t.lo = (8 * g + q) * 128 + ((xl >> 1) << 5) + ((h ^ (xl & 1)) << 4) + 8 * (pp & 1);
    t.hi = (t.lo + 512) ^ 32;
    return t;
}
__device__ __forceinline__ bf16x8 tr_frag8(const char* tile, const TrBase& tb, int ks, int c) {
    int cx = c << 5;
    asm volatile("" : "+v"(cx));
    const v4s lo = __builtin_amdgcn_ds_read_tr16_b64_v4i16((LAS v4s*)(tile + ks * 4096 + (tb.lo ^ cx)));
    const v4s hi = __builtin_amdgcn_ds_read_tr16_b64_v4i16((LAS v4s*)(tile + ks * 4096 + (tb.hi ^ cx)));
    return bf16x8{lo[0], lo[1], lo[2], lo[3], hi[0], hi[1], hi[2], hi[3]};
}

__device__ __forceinline__ void ph_attn(const Params& p, char* smem0) {
    const VB vbk = make_vb(smem0);
    char* smem = vbk.smem;
    const int tid = vbk.tid, lane = tid & 63, wid = tid >> 6, fr = lane & 15, fq = lane >> 4;
    char* sQ = smem;
    char* sK = smem + 8192;
    char* sP = sK;
    char* sV = smem + 33792;
    float* sBias = (float*)(smem + 58368);
    const TrBase trb = tr8_base(lane);
    for (int u = vbk.vb; u < 3072; u += vbk.nvb) {
        const int ti = u & 63, gq = u >> 6, g = gq % 3, bhh = gq / 3, hh = bhh & 3, b = bhh >> 2;
        const int lsh = (g == 0) ? 0 : (g == 1 ? 2 : 4), dl = 1 << lsh;
        const int tpr = (S >> lsh) >> 6;
        const int r = ti / tpr, j0 = (ti % tpr) * 64;
        const bf16_t* base = p.proj() + (size_t)b * S * INW + (g * 4 + hh) * 64;
        __syncthreads();
#pragma unroll
        for (int i = 0; i < 2; ++i) {
            const int idx = tid + 256 * i, row = idx >> 3, ch = idx & 7;
            const int tok = (j0 + row) * dl + r;
            *(u32x4*)(sQ + swz(row, ch)) = *(const u32x4*)(base + (size_t)tok * INW + OFF_AQ + ch * 8);
        }
#pragma unroll
        for (int i = 0; i < 6; ++i) {
            const int idx = tid + 256 * i, row = idx >> 3, ch = idx & 7;
            const int j = j0 - 128 + row;
            u32x4 kx = {0u, 0u, 0u, 0u}, vx = {0u, 0u, 0u, 0u};
            if (j >= 0) {
                const size_t o = (size_t)(j * dl + r) * INW + ch * 8;
                kx = *(const u32x4*)(base + o + OFF_AK);
                vx = *(const u32x4*)(base + o + OFF_AV);
            }
            *(u32x4*)(sK + swz(row, ch)) = kx;
            *(u32x4*)(sV + swz(row, ch)) = vx;
        }
        if (tid < 129) sBias[tid] = p.biasT()[(g * 129 + tid) * 4 + hh];
        __syncthreads();
        f32x4 sa[12];
#pragma unroll
        for (int n = 0; n < 12; ++n) sa[n] = f32x4{0.f, 0.f, 0.f, 0.f};
#pragma unroll
        for (int ks = 0; ks < 2; ++ks) {
            const bf16x8 af = *(const bf16x8*)(sQ + swz(wid * 16 + fr, ks * 4 + fq));
#pragma unroll
            for (int n = 0; n < 12; ++n) {
                const bf16x8 bfr = *(const bf16x8*)(sK + swz(n * 16 + fr, ks * 4 + fq));
                sa[n] = __builtin_amdgcn_mfma_f32_16x16x32_bf16(af, bfr, sa[n], 0, 0, 0);
            }
        }
        float mx[4] = {-INFINITY, -INFINITY, -INFINITY, -INFINITY};
#pragma unroll
        for (int n = 0; n < 12; ++n)
#pragma unroll
            for (int j = 0; j < 4; ++j) {
                const int jj = wid * 16 + fq * 4 + j, kk = n * 16 + fr, m = jj + 128 - kk;
                const bool valid = (m >= 0) && (m <= 128) && (j0 - 128 + kk >= 0);
                const int mc = m < 0 ? 0 : (m > 128 ? 128 : m);
                const float v = valid ? sa[n][j] * 0.125f + sBias[mc] : -INFINITY;
                sa[n][j] = v;
                mx[j] = fmaxf(mx[j], v);
            }
#pragma unroll
        for (int j = 0; j < 4; ++j) {
            mx[j] = fmaxf(mx[j], __shfl_xor(mx[j], 1, 64)); mx[j] = fmaxf(mx[j], __shfl_xor(mx[j], 2, 64));
            mx[j] = fmaxf(mx[j], __shfl_xor(mx[j], 4, 64)); mx[j] = fmaxf(mx[j], __shfl_xor(mx[j], 8, 64));
        }
        float ls[4] = {0.f, 0.f, 0.f, 0.f};
#pragma unroll
        for (int n = 0; n < 12; ++n)
#pragma unroll
            for (int j = 0; j < 4; ++j) { const float pe = __expf(sa[n][j] - mx[j]); sa[n][j] = pe; ls[j] += pe; }
#pragma unroll
        for (int j = 0; j < 4; ++j) {
            ls[j] += __shfl_xor(ls[j], 1, 64); ls[j] += __shfl_xor(ls[j], 2, 64); ls[j] += __shfl_xor(ls[j], 4, 64); ls[j] += __shfl_xor(ls[j], 8, 64);
        }
        __syncthreads();
#pragma unroll
        for (int n = 0; n < 12; ++n)
#pragma unroll
            for (int j = 0; j < 4; ++j) *(bf16_t*)(sP + (wid * 16 + fq * 4 + j) * 400 + (n * 16 + fr) * 2) = f2bf(sa[n][j]);
        f32x4 oa[4];
#pragma unroll
        for (int n = 0; n < 4; ++n) oa[n] = f32x4{0.f, 0.f, 0.f, 0.f};
#pragma unroll
        for (int ks = 0; ks < 6; ++ks) {
            const bf16x8 af = *(const bf16x8*)(sP + (wid * 16 + fr) * 400 + (ks * 4 + fq) * 16);
#pragma unroll
            for (int n = 0; n < 4; ++n) {
                const bf16x8 bfr = tr_frag8(sV, trb, ks, n);
                oa[n] = __builtin_amdgcn_mfma_f32_16x16x32_bf16(af, bfr, oa[n], 0, 0, 0);
            }
        }
        {
            int lz = lane;
            asm volatile("" : "+v"(lz));
            const int odd = lz & 1, fr = lz & 15, fq = lz >> 4;
            float inv[4];
#pragma unroll
            for (int j = 0; j < 4; ++j) inv[j] = 1.f / ls[j];
#pragma unroll
            for (int jp = 0; jp < 2; ++jp) {
                const int jj = wid * 16 + fq * 4 + 2 * jp + odd;
                const size_t row = (size_t)g * T + (size_t)b * S + (j0 + jj) * dl + r;
#pragma unroll
                for (int n = 0; n < 4; ++n) {
                    const float a = oa[n][2 * jp] * inv[2 * jp], b2 = oa[n][2 * jp + 1] * inv[2 * jp + 1];
                    const float x = odd ? a : b2;
                    const float y = __shfl_xor(x, 1, 64);
                    *(uint32_t*)(p.ao() + row * 256 + hh * 64 + n * 16 + (fr & ~1)) = odd ? pack2(y, b2) : pack2(a, y);
                }
            }
#pragma unroll
            for (int j = 0; j < 4; ++j) {
                const int jj = wid * 16 + fq * 4 + j;
                const size_t row = (size_t)g * T + (size_t)b * S + (j0 + jj) * dl + r;
                if (fr == 0) p.alse()[row * 4 + hh] = mx[j] + __logf(ls[j]);
            }
        }
    }
}

__device__ __forceinline__ void ph_attn_merge(const Params& p) {
    const int tid = otid(), lane = tid & 63, wid = tid >> 6;
    for (int row = blockIdx.x * 8 + wid; row < T; row += gridDim.x * 8) {
        const int hh = lane >> 4;
        const float l0 = p.alse()[((size_t)0 * T + row) * 4 + hh], l1 = p.alse()[((size_t)1 * T + row) * 4 + hh], l2 = p.alse()[((size_t)2 * T + row) * 4 + hh];
        const float mxl = fmaxf(l0, fmaxf(l1, l2));
        float e0 = __expf(l0 - mxl), e1 = __expf(l1 - mxl), e2 = __expf(l2 - mxl);
        const float inv = 1.f / (e0 + e1 + e2);
        e0 *= inv; e1 *= inv; e2 *= inv;
        f32x4 a0, a1, a2;
        {
            const uint2 w0 = *(const uint2*)(p.ao() + ((size_t)0 * T + row) * 256 + lane * 4);
            const uint2 w1 = *(const uint2*)(p.ao() + ((size_t)1 * T + row) * 256 + lane * 4);
            const uint2 w2 = *(const uint2*)(p.ao() + ((size_t)2 * T + row) * 256 + lane * 4);
            a0[0] = __uint_as_float(w0.x << 16); a0[1] = __uint_as_float(w0.x & 0xffff0000u); a0[2] = __uint_as_float(w0.y << 16); a0[3] = __uint_as_float(w0.y & 0xffff0000u);
            a1[0] = __uint_as_float(w1.x << 16); a1[1] = __uint_as_float(w1.x & 0xffff0000u); a1[2] = __uint_as_float(w1.y << 16); a1[3] = __uint_as_float(w1.y & 0xffff0000u);
            a2[0] = __uint_as_float(w2.x << 16); a2[1] = __uint_as_float(w2.x & 0xffff0000u); a2[2] = __uint_as_float(w2.y << 16); a2[3] = __uint_as_float(w2.y & 0xffff0000u);
        }
        uint2 o;
        o.x = pack2(a0[0] * e0 + a1[0] * e1 + a2[0] * e2, a0[1] * e0 + a1[1] * e1 + a2[1] * e2);
        o.y = pack2(a0[2] * e0 + a1[2] * e1 + a2[2] * e2, a0[3] * e0 + a1[3] * e1 + a2[3] * e2);
        *(uint2*)(p.mixin() + (size_t)row * 768 + 512 + lane * 4) = o;
    }
}

__device__ __forceinline__ void ph_outproj(const Params& p, char* smem) {
    const int tid = otid(), lane = tid & 63, wid = tid >> 6, wr = wid >> 1, wc = wid & 1;
    const int xcd = blockIdx.x & 7, nbx = gridDim.x >> 3;
    for (int i = blockIdx.x >> 3; i < 32; i += nbx) {
        const int nt = i >> 3, mt = xcd * 8 + (i & 7);
        const bf16_t* A = p.mixin() + (size_t)mt * 256 * 768;
        const bf16_t* Bt = p.woutT() + (size_t)nt * 256 * 768;
        f32x4 acc[4][8];
        __syncthreads();
        gemm6(smem, 768, [&](int r) { return A + (size_t)r * 768; }, [&](int n) { return Bt + (size_t)n * 768; }, acc);
        const int b = (mt * 256) >> 12;
        const int colb = nt * 256 + wc * 128;
        const float* g1 = p.mod() + b * 6144 + 2048 + colb;
        char* wl = smem + wid * EPI_WAVE;
#pragma unroll
        for (int m = 0; m < 4; ++m) {
            const size_t rbase = (size_t)(mt * 256 + wr * 64 + m * 16) * D + colb;
            epi_f32(wl, lane, [&](int n, int j) { return acc[m][n][j]; },
                    [&](int row, int ch, f32x4 v) {
                        const f32x4 xv = *(const f32x4*)(p.x + rbase + (size_t)row * D + ch * 4);
                        const f32x4 gv = *(const f32x4*)(g1 + ch * 4);
                        f32x4 o;
                        o[0] = ALPHA * xv[0] + gv[0] * v[0]; o[1] = ALPHA * xv[1] + gv[1] * v[1];
                        o[2] = ALPHA * xv[2] + gv[2] * v[2]; o[3] = ALPHA * xv[3] + gv[3] * v[3];
                        *(f32x4*)(p.pre1() + rbase + (size_t)row * D + ch * 4) = o;
                    });
        }
    }
}

__device__ __forceinline__ void ph_ln1(const Params& p) {
    const int tid = otid(), lane = tid & 63, wid = tid >> 6;
    const int rstride = gridDim.x * 8;
    float4 nv[4];
    {
        const float4* xr = (const float4*)(p.pre1() + (size_t)(blockIdx.x * 8 + wid) * D);
#pragma unroll
        for (int i = 0; i < 4; ++i) nv[i] = xr[lane + 64 * i];
    }
    for (int row = blockIdx.x * 8 + wid; row < T; row += rstride) {
        float4 v[4];
        float s = 0.f;
#pragma unroll
        for (int i = 0; i < 4; ++i) { v[i] = nv[i]; s += v[i].x + v[i].y + v[i].z + v[i].w; }
        if (row + rstride < T) {
            const float4* xn = (const float4*)(p.pre1() + (size_t)(row + rstride) * D);
#pragma unroll
            for (int i = 0; i < 4; ++i) nv[i] = xn[lane + 64 * i];
        }
        float mean = wave_sum(s) * (1.f / D);
        float q = 0.f;
#pragma unroll
        for (int i = 0; i < 4; ++i) {
            v[i].x -= mean; v[i].y -= mean; v[i].z -= mean; v[i].w -= mean;
            q += v[i].x * v[i].x + v[i].y * v[i].y + v[i].z * v[i].z + v[i].w * v[i].w;
        }
        float rstd = rsqrtf(wave_sum(q) * (1.f / D) + LN_EPS);
        s = 0.f;
#pragma unroll
        for (int i = 0; i < 4; ++i) {
            const int col = (lane + 64 * i) * 4;
            const float4 g4 = *(const float4*)(p.ln1_g + col), b4 = *(const float4*)(p.ln1_b + col);
            v[i].x = v[i].x * rstd * g4.x + b4.x; v[i].y = v[i].y * rstd * g4.y + b4.y;
            v[i].z = v[i].z * rstd * g4.z + b4.z; v[i].w = v[i].w * rstd * g4.w + b4.w;
            { uint2 xo; xo.x = pack2(v[i].x, v[i].y); xo.y = pack2(v[i].z, v[i].w); *(uint2*)(p.x1() + (size_t)row * D + col) = xo; }
            s += v[i].x + v[i].y + v[i].z + v[i].w;
        }
        mean = wave_sum(s) * (1.f / D);
        q = 0.f;
#pragma unroll
        for (int i = 0; i < 4; ++i) {
            v[i].x -= mean; v[i].y -= mean; v[i].z -= mean; v[i].w -= mean;
            q += v[i].x * v[i].x + v[i].y * v[i].y + v[i].z * v[i].z + v[i].w * v[i].w;
        }
        rstd = rsqrtf(wave_sum(q) * (1.f / D) + LN_EPS);
        const int b = row >> 12;
        const float* sh = p.mod() + b * 6144 + 3072;
        const float* sc = sh + 1024;
#pragma unroll
        for (int i = 0; i < 4; ++i) {
            const int col = (lane + 64 * i) * 4;
            const float4 s4 = *(const float4*)(sc + col), h4 = *(const float4*)(sh + col);
            float4 y;
            y.x = v[i].x * rstd * (1.f + s4.x) + h4.x; y.y = v[i].y * rstd * (1.f + s4.y) + h4.y;
            y.z = v[i].z * rstd * (1.f + s4.z) + h4.z; y.w = v[i].w * rstd * (1.f + s4.w) + h4.w;
            uint2 o;
            o.x = pack2(y.x, y.y); o.y = pack2(y.z, y.w);
            *(uint2*)(p.h2() + (size_t)row * 2048 + col) = o;
            uint2 o2;
            o2.x = pack2h(y.x, y.y);
            o2.y = pack2h(y.z, y.w);
            *(uint2*)(p.h2() + (size_t)row * 2048 + 1024 + col) = o2;
        }
    }
}


__device__ __forceinline__ void topk4_lds(const Params& p, const float* lg, const int tok0, const int lane) {
    constexpr int TK = 4;
        float sc[TK][4], bv[TK][4];
#pragma unroll
    for (int t = 0; t < TK; ++t)
#pragma unroll
        for (int j = 0; j < 4; ++j) {
            const int e = j * 64 + lane;
            const float x = lg[t * NE + e];
            sc[t][j] = 1.f / (1.f + expf(-x));
            bv[t][j] = sc[t][j] + p.router_bias[e];
        }
    float gsum[TK][4];
#pragma unroll
    for (int j = 0; j < 4; ++j) {
        float m1[TK], m2[TK];
#pragma unroll
        for (int t = 0; t < TK; ++t) m1[t] = bv[t][j];
#pragma unroll
        for (int o = 16; o > 0; o >>= 1)
#pragma unroll
            for (int t = 0; t < TK; ++t) m1[t] = fmaxf(m1[t], __shfl_xor(m1[t], o, 64));
#pragma unroll
        for (int t = 0; t < TK; ++t) {
            const unsigned long long bal = __ballot(bv[t][j] == m1[t]);
            const unsigned hm = (unsigned)(bal >> (lane & 32));
            const int first = __ffs(hm) - 1;
            m2[t] = ((lane & 31) == first) ? -INFINITY : bv[t][j];
        }
#pragma unroll
        for (int o = 16; o > 0; o >>= 1)
#pragma unroll
            for (int t = 0; t < TK; ++t) m2[t] = fmaxf(m2[t], __shfl_xor(m2[t], o, 64));
#pragma unroll
        for (int t = 0; t < TK; ++t) gsum[t][j] = m1[t] + m2[t];
    }
    float cand[TK][4];
#pragma unroll
    for (int t = 0; t < TK; ++t) {
        float gs[8];
#pragma unroll
        for (int j = 0; j < 4; ++j) { gs[2 * j] = __shfl(gsum[t][j], 0, 64); gs[2 * j + 1] = __shfl(gsum[t][j], 32, 64); }
        unsigned gmask = 0u;
#pragma unroll
        for (int r = 0; r < 4; ++r) {
            float best = -INFINITY; int bi = 0;
#pragma unroll
            for (int g = 0; g < 8; ++g) {
                const bool ok = (((gmask >> g) & 1u) == 0u) && (gs[g] > best);
                best = ok ? gs[g] : best; bi = ok ? g : bi;
            }
            gmask |= 1u << bi;
        }
#pragma unroll
        for (int j = 0; j < 4; ++j) cand[t][j] = ((gmask >> (2 * j + (lane >> 5))) & 1u) ? bv[t][j] : -INFINITY;
    }
    float wsum[TK], myw[TK];
    int mye[TK];
#pragma unroll
    for (int t = 0; t < TK; ++t) { wsum[t] = 0.f; myw[t] = 0.f; mye[t] = 0; }
#pragma unroll
    for (int r = 0; r < 8; ++r) {
        float bvv[TK]; int be[TK];
#pragma unroll
        for (int t = 0; t < TK; ++t) {
            bvv[t] = cand[t][0]; be[t] = lane;
#pragma unroll
            for (int j = 1; j < 4; ++j) { const bool gt = cand[t][j] > bvv[t]; bvv[t] = gt ? cand[t][j] : bvv[t]; be[t] = gt ? j * 64 + lane : be[t]; }
        }
#pragma unroll
        for (int o = 32; o > 0; o >>= 1)
#pragma unroll
            for (int t = 0; t < TK; ++t) {
                const float ov = __shfl_xor(bvv[t], o, 64);
                const int oe = __shfl_xor(be[t], o, 64);
                const bool take = (ov > bvv[t]) | ((ov == bvv[t]) & (oe < be[t])); bvv[t] = take ? ov : bvv[t]; be[t] = take ? oe : be[t];
            }
#pragma unroll
        for (int t = 0; t < TK; ++t) {
            const int bj = be[t] >> 6;
            unsigned myb = 0u;
#pragma unroll
            for (int j = 0; j < 4; ++j) myb |= (unsigned)(-(int)(bj == j)) & __float_as_uint(sc[t][j]);
            const float mysc = __uint_as_float(myb);
            const float sval = __shfl(mysc, be[t] & 63, 64);
#pragma unroll
            for (int j = 0; j < 4; ++j) cand[t][j] = (be[t] == j * 64 + lane) ? -INFINITY : cand[t][j];
            wsum[t] += sval;
            myw[t] = (lane == r) ? sval : myw[t]; mye[t] = (lane == r) ? be[t] : mye[t];
        }
    }
    if (lane < 8) {
#pragma unroll
        for (int t = 0; t < TK; ++t) {
            const int a = (tok0 + t) * 8 + lane;
            p.topi()[a] = (unsigned char)mye[t];
            p.topw()[a] = myw[t] * (2.5f / wsum[t]);
        }
    }
}

__device__ __forceinline__ void ph_router_topk(const Params& p, char* smem) {
    const int tid = otid(), lane = tid & 63, wid = tid >> 6, fr = lane & 15, fq = lane >> 4;
    float* lgs = (float*)smem;
    for (int mt = blockIdx.x; mt < T / 64; mt += gridDim.x) {
        const bf16_t* A = p.h2() + (size_t)mt * 64 * 2048;
        const int ra = 8 * wid + (lane >> 3);
        const bf16_t* ga = A + (size_t)ra * 2048 + 1024 + (((lane & 7) ^ ((ra >> 1) & 7)) * 8);
        const bf16_t* gb[4];
#pragma unroll
        for (int i = 0; i < 4; ++i) {
            const int r = 8 * (wid + 8 * i) + (lane >> 3);
            gb[i] = p.wrT() + (size_t)r * D + (((lane & 7) ^ ((r >> 1) & 7)) * 8);
        }
        f32x4 acc[4][2];
#pragma unroll
        for (int m = 0; m < 4; ++m) { acc[m][0] = f32x4{0.f, 0.f, 0.f, 0.f}; acc[m][1] = f32x4{0.f, 0.f, 0.f, 0.f}; }
        char* ldA = smem + wid * 1024 + lane * 16;
        char* ldB = smem + 8192 + wid * 1024 + lane * 16;
#define RT_ISSUE(slot, kt_) do { const int ao_ = (kt_) * 64; const int bo_ = (kt_) * 64; \
        __builtin_amdgcn_global_load_lds((const unsigned*)(ga + ao_), (LAS unsigned*)(ldA + (slot) * 40960), 16, 0, 0); \
        _Pragma("unroll") for (int i_ = 0; i_ < 4; ++i_) \
            __builtin_amdgcn_global_load_lds((const unsigned*)(gb[i_] + bo_), (LAS unsigned*)(ldB + (slot) * 40960 + i_ * 8192), 16, 0, 0); } while (0)
        __syncthreads();
        RT_ISSUE(0, 0);
        RT_ISSUE(1, 1);
        int slot = 0, slot2 = 2;
#pragma clang loop unroll(disable)
        for (int kt = 0; kt < 16; ++kt) {
            if (kt + 1 < 16) asm volatile("s_waitcnt vmcnt(5)" ::: "memory");
            else asm volatile("s_waitcnt vmcnt(0)" ::: "memory");
            __builtin_amdgcn_s_barrier();
            if (kt + 2 < 16) RT_ISSUE(slot2, kt + 2);
            const char* sA_ = smem + slot * 40960;
            const char* sB_ = sA_ + 8192;
#pragma unroll
            for (int ks = 0; ks < 2; ++ks) {
                f16x8 af[4];
#pragma unroll
                for (int m = 0; m < 4; ++m) af[m] = *(const f16x8*)(sA_ + swz(m * 16 + fr, ks * 4 + fq));
#pragma unroll
                for (int n = 0; n < 2; ++n) {
                    const f16x8 bfr = *(const f16x8*)(sB_ + swz((2 * wid + n) * 16 + fr, ks * 4 + fq));
#pragma unroll
                    for (int m = 0; m < 4; ++m) acc[m][n] = __builtin_amdgcn_mfma_f32_16x16x32_f16(af[m], bfr, acc[m][n], 0, 0, 0);
                }
            }
            slot = (slot == 2) ? 0 : slot + 1;
            slot2 = (slot2 == 2) ? 0 : slot2 + 1;
        }
#undef RT_ISSUE
        __syncthreads();
#pragma unroll
        for (int m = 0; m < 4; ++m)
#pragma unroll
            for (int n = 0; n < 2; ++n)
#pragma unroll
                for (int j = 0; j < 4; ++j) lgs[(m * 16 + fq * 4 + j) * NE + (2 * wid + n) * 16 + fr] = acc[m][n][j];
        __syncthreads();
        topk4_lds(p, lgs + (wid * 8) * NE, mt * 64 + wid * 8, lane);
        topk4_lds(p, lgs + (wid * 8 + 4) * NE, mt * 64 + wid * 8 + 4, lane);
    }
}


__device__ __forceinline__ unsigned zero_bytes(unsigned x) { return ~(((x & 0x7f7f7f7fu) + 0x7f7f7f7fu) | x | 0x7f7f7f7fu); }
__device__ __forceinline__ void ph_lists(const Params& p, char* smem) {
    const int tid = otid(), lane = tid & 63, wid = tid >> 6;
    int* wtot = (int*)smem;
    for (int e = blockIdx.x; e < NE; e += gridDim.x) {
        __syncthreads();
        const uint4* src = (const uint4*)p.topi() + wid * 1024;
        const unsigned pat = (unsigned)e * 0x01010101u;
        int cl = 0;
#pragma unroll 4
        for (int i = 0; i < 16; ++i) {
            const uint4 v = src[i * 64 + lane];
            cl += __popc(zero_bytes(v.x ^ pat)) + __popc(zero_bytes(v.y ^ pat)) + __popc(zero_bytes(v.z ^ pat)) + __popc(zero_bytes(v.w ^ pat));
        }
        const int cntw = (int)wave_sum((float)cl);
        if (lane == 0) wtot[wid] = cntw;
        __syncthreads();
        int base = 0, tot = 0;
        for (int w = 0; w < 8; ++w) { const int c = wtot[w]; if (w < wid) base += c; tot += c; }
        if (tid == 0) p.cnt()[e] = tot;
        int* dst = p.list() + (size_t)e * T;
        int inc = cl;
#pragma unroll
        for (int o = 1; o < 64; o <<= 1) { const int t = __shfl_up(inc, o, 64); inc += (lane >= o) ? t : 0; }
        int pos = base + inc - cl;
#pragma unroll 4
        for (int i = 0; i < 16; ++i) {
            const uint4 v = src[i * 64 + lane];
            unsigned z[4] = {zero_bytes(v.x ^ pat), zero_bytes(v.y ^ pat), zero_bytes(v.z ^ pat), zero_bytes(v.w ^ pat)};
            const int a0 = (wid * 1024 + i * 64 + lane) * 16;
#pragma unroll
            for (int w = 0; w < 4; ++w) {
                unsigned zz = z[w];
                while (zz) {
                    const int b = (__ffs(zz) - 1) >> 3;
                    dst[pos++] = a0 + w * 4 + b;
                    zz &= zz - 1u;
                }
            }
        }
    }
}

struct ExpMap { int* cnt; int* off; int* tile; };
__device__ __forceinline__ ExpMap exp_map(const Params& p, char* smem) {
    ExpMap m;
    m.cnt = (int*)(smem + 98304); m.off = m.cnt + 256; m.tile = m.off + 256;
    int* wsum = m.tile + 260;
    const int tid = otid(), lane = tid & 63, wid = tid >> 6;
    __syncthreads();
    int c = 0, tl = 0, ic = 0, it = 0;
    if (tid < NE) {
        c = p.cnt()[tid]; tl = (c + 255) >> 8;
        ic = c; it = tl;
#pragma unroll
        for (int o = 1; o < 64; o <<= 1) {
            const int a = __shfl_up(ic, o, 64), b = __shfl_up(it, o, 64);
            ic += (lane >= o) ? a : 0; it += (lane >= o) ? b : 0;
        }
        m.cnt[tid] = c;
        if (lane == 63) { wsum[wid * 2] = ic; wsum[wid * 2 + 1] = it; }
    }
    __syncthreads();
    if (tid < NE) {
        int bo = 0, bt = 0;
        for (int w = 0; w < wid; ++w) { bo += wsum[w * 2]; bt += wsum[w * 2 + 1]; }
        m.off[tid] = bo + ic - c;
        m.tile[tid] = bt + it - tl;
        if (tid == NE - 1) m.tile[NE] = bt + it;
    }
    __syncthreads();
    return m;
}
__device__ __forceinline__ int find_expert(const int* tile, int rt) {
    int lo = 0, hi = NE;
    while (hi - lo > 1) { const int mid = (lo + hi) >> 1; if (tile[mid] <= rt) lo = mid; else hi = mid; }
    return lo;
}
#define ROWA(smem) ((int*)((smem) + 98304 + 3328))
#define ROWW(smem) ((float*)((smem) + 98304 + 3328 + 1024))

__device__ __forceinline__ void ph_gateup(const Params& p, char* smem) {
    const int tid = otid(), lane = tid & 63, wid = tid >> 6, wr = wid >> 1, wc = wid & 1;
    const ExpMap em = exp_map(p, smem);
    int* rowA = ROWA(smem);
    const int ntile = em.tile[NE];
    const int U = (ntile + T / 256) * 2;
    const int xcd = blockIdx.x & 7, nbx = gridDim.x >> 3;
    const int lo = (int)(((long long)U * xcd) >> 3), hi = (int)(((long long)U * (xcd + 1)) >> 3);
    for (int u = lo + (blockIdx.x >> 3); u < hi; u += nbx) {
        const int rt = u >> 1, c0 = (u & 1) * 128;
        const float *Wg, *Wu;
        bf16_t* gdst;
        int nrow, tokv = -1;
        if (rt < ntile) {
            const int e = find_expert(em.tile, rt);
            const int r0 = (rt - em.tile[e]) * 256, ne = em.cnt[e];
            Wg = p.w_eg + (size_t)e * D * ED; Wu = p.w_eu + (size_t)e * D * ED;
            gdst = p.gbuf() + ((size_t)em.off[e] + r0) * ED + c0;
            nrow = ne - r0;
            if (tid < 256 && r0 + tid < ne) tokv = p.list()[(size_t)e * T + r0 + tid] >> 3;
        } else {
            const int tb = (rt - ntile) * 256;
            Wg = p.w_sg; Wu = p.w_su;
            gdst = p.gsh() + (size_t)tb * ED + c0;
            nrow = 256;
            tokv = tb + (tid & 255);
        }
        __syncthreads();
        if (tid < 256) rowA[tid] = tokv;
        __syncthreads();
        const int t0 = rowA[0];
        f32x4 acc[4][8];
        gemm5(smem, D,
              [&](int r) { const int t = rowA[r]; return p.h2() + (size_t)(t < 0 ? t0 : t) * 2048; },
              [&](int n) { const int t16 = n >> 4; return ((t16 & 1) ? Wu : Wg) + c0 + 16 * (t16 >> 1) + (n & 15); },
              ED, acc);
        if (wr * 64 < nrow) {
            char* wl = smem + wid * EPI_WAVE;
#pragma unroll
            for (int m = 0; m < 4; ++m) {
                const int rb = wr * 64 + m * 16;
                epi_bf16(wl, lane,
                         [&](int n, int j) { if (n >= 4) return 0.f; const float g = acc[m][2 * n][j], uu = acc[m][2 * n + 1][j]; return g / (1.f + __expf(-g)) * uu; },
                         [&](int row, int ch, u32x4 v) { if (ch < 8 && rb + row < nrow) *(u32x4*)(gdst + (size_t)(rb + row) * ED + wc * 64 + ch * 8) = v; });
            }
        }
    }
}

__device__ __forceinline__ void ph_down(const Params& p, char* smem) {
    const int tid = otid(), lane = tid & 63, wid = tid >> 6, wr = wid >> 1, wc = wid & 1;
    const ExpMap em = exp_map(p, smem);
    int* rowA = ROWA(smem);
    float* rowW = ROWW(smem);
    const int ntile = em.tile[NE];
    const int U = (ntile + T / 256) * 4;
    const int xcd = blockIdx.x & 7, nbx = gridDim.x >> 3;
    const int lo = (int)(((long long)U * xcd) >> 3), hi = (int)(((long long)U * (xcd + 1)) >> 3);
    for (int u = lo + (blockIdx.x >> 3); u < hi; u += nbx) {
        const int rt = u >> 2, nt = u & 3;
        const bf16_t* A;
        const float* W;
        int nrow, slot = -1;
        float wv = 0.f;
        if (rt < ntile) {
            const int e = find_expert(em.tile, rt);
            const int r0 = (rt - em.tile[e]) * 256, ne = em.cnt[e];
            A = p.gbuf() + ((size_t)em.off[e] + r0) * ED;
            W = p.w_ed + (size_t)e * ED * D + nt * 256;
            nrow = ne - r0;
            if (tid < 256 && r0 + tid < ne) {
                const int a = p.list()[(size_t)e * T + r0 + tid];
                slot = a;
                wv = p.topw()[a] * Y8_SCALE;
            }
        } else {
            const int tb = (rt - ntile) * 256;
            A = p.gsh() + (size_t)tb * ED;
            W = p.w_sd + nt * 256;
            nrow = 256;
            slot = tb + (tid & 255);
            wv = 1.f;
        }
        __syncthreads();
        if (tid < 256) { rowA[tid] = slot; rowW[tid] = wv; }
        __syncthreads();
        f32x4 acc[4][8];
        gemm5(smem, ED, [&](int r) { return A + (size_t)(r < nrow ? r : 0) * ED; }, [&](int n) { return W + n; }, D, acc);
        if (wr * 64 < nrow) {
            char* wl = smem + wid * EPI_WAVE;
#pragma unroll
            for (int m = 0; m < 4; ++m) {
                const int rb = wr * 64 + m * 16;
                float wj[4];
#pragma unroll
                for (int j = 0; j < 4; ++j) wj[j] = rowW[rb + (lane >> 4) * 4 + j];
                if (rt < ntile) {
                    epi_fp8(wl, lane, [&](int n, int j) { return __builtin_amdgcn_fmed3f(acc[m][n][j] * wj[j], -440.f, 440.f); },
                            [&](int row, int ch, u32x4 v) {
                                const int sl = rowA[rb + row];
                                if (sl >= 0) *(u32x4*)(p.ybuf() + (size_t)sl * D + nt * 256 + wc * 128 + ch * 16) = v;
                            });
                } else {
                    epi_bf16(wl, lane, [&](int n, int j) { return acc[m][n][j]; },
                             [&](int row, int ch, u32x4 v) {
                                 const int sl = rowA[rb + row];
                                 *(u32x4*)(p.ysh() + (size_t)sl * D + nt * 256 + wc * 128 + ch * 8) = v;
                             });
                }
            }
        }
    }
}

__device__ __forceinline__ void ph_final(const Params& p) {
    const int tid = otid(), lane = tid & 63, wid = tid >> 6;
    for (int row = blockIdx.x * 8 + wid; row < T; row += gridDim.x * 8) {
        const int b = row >> 12;
        const float* g2 = p.mod() + b * 6144 + 5120;
        float4 v[4];
        float s = 0.f;
#pragma unroll
        for (int i = 0; i < 4; ++i) {
            const int col = (lane + 64 * i) * 4;
            float f0 = 0.f, f1 = 0.f, f2 = 0.f, f3 = 0.f;
#pragma unroll
            for (int k = 0; k < 8; ++k) {
                const int w8 = *(const int*)(p.ybuf() + ((size_t)row * 8 + k) * D + col);
                const v2f_t lo = __builtin_amdgcn_cvt_pk_f32_fp8(w8, false), hi = __builtin_amdgcn_cvt_pk_f32_fp8(w8, true);
                f0 += lo[0]; f1 += lo[1]; f2 += hi[0]; f3 += hi[1];
            }
            f0 *= (1.f / Y8_SCALE); f1 *= (1.f / Y8_SCALE); f2 *= (1.f / Y8_SCALE); f3 *= (1.f / Y8_SCALE);
            {
                const uint2 w = *(const uint2*)(p.ysh() + (size_t)row * D + col);
                f0 += __uint_as_float(w.x << 16); f1 += __uint_as_float(w.x & 0xffff0000u);
                f2 += __uint_as_float(w.y << 16); f3 += __uint_as_float(w.y & 0xffff0000u);
            }
            float4 xv;
            { const uint2 xw = *(const uint2*)(p.x1() + (size_t)row * D + col);
              xv.x = __uint_as_float(xw.x << 16); xv.y = __uint_as_float(xw.x & 0xffff0000u); xv.z = __uint_as_float(xw.y << 16); xv.w = __uint_as_float(xw.y & 0xffff0000u); }
            const float4 g4 = *(const float4*)(g2 + col);
            v[i].x = ALPHA * xv.x + g4.x * f0; v[i].y = ALPHA * xv.y + g4.y * f1;
            v[i].z = ALPHA * xv.z + g4.z * f2; v[i].w = ALPHA * xv.w + g4.w * f3;
            s += v[i].x + v[i].y + v[i].z + v[i].w;
        }
        const float mean = wave_sum(s) * (1.f / D);
        float q = 0.f;
#pragma unroll
        for (int i = 0; i < 4; ++i) {
            v[i].x -= mean; v[i].y -= mean; v[i].z -= mean; v[i].w -= mean;
            q += v[i].x * v[i].x + v[i].y * v[i].y + v[i].z * v[i].z + v[i].w * v[i].w;
        }
        const float rstd = rsqrtf(wave_sum(q) * (1.f / D) + LN_EPS);
#pragma unroll
        for (int i = 0; i < 4; ++i) {
            const int col = (lane + 64 * i) * 4;
            const float4 g4 = *(const float4*)(p.ln2_g + col), b4 = *(const float4*)(p.ln2_b + col);
            float4 y;
            y.x = v[i].x * rstd * g4.x + b4.x; y.y = v[i].y * rstd * g4.y + b4.y;
            y.z = v[i].z * rstd * g4.z + b4.z; y.w = v[i].w * rstd * g4.w + b4.w;
            *(float4*)(p.out + (size_t)row * D + col) = y;
        }
    }
}

constexpr int LDS_BYTES = 2 * VB_LDS + 16;
constexpr int NPHASE = 13;

template <int PH>
__device__ __forceinline__ void run_phase(const Params& p, char* smem) {
    if (PH == 0) ph_mod(p, smem);
    if (PH == 1) ph_ln0(p);
    if (PH == 2) ph_inproj(p, smem);
    if (PH == 3) { ph_h1(p, smem); ph_attn(p, smem); }
    if (PH == 4) { ph_h2(p); ph_attn_merge(p); }
    if (PH == 5) ph_h3(p, smem);
    if (PH == 6) ph_outproj(p, smem);
    if (PH == 7) ph_ln1(p);
    if (PH == 8) ph_router_topk(p, smem);
    if (PH == 9) ph_lists(p, smem);
    if (PH == 10) ph_gateup(p, smem);
    if (PH == 11) ph_down(p, smem);
    if (PH == 12) ph_final(p);
}

template <int PH>
__global__ void __launch_bounds__(NTHREADS, 2) k_phase(Params p) {
    extern __shared__ __attribute__((aligned(16))) char smem[];
    run_phase<PH>(p, smem);
}

__global__ void __launch_bounds__(NTHREADS, 2) k_all(Params p) {
    extern __shared__ __attribute__((aligned(16))) char smem[];
    volatile LAS unsigned* st = (volatile LAS unsigned*)(smem + LDS_BYTES - 16);
    if (threadIdx.x == 0) { st[0] = 0u; st[1] = 0u; st[2] = 0u; st[3] = 0u; }
    __syncthreads();
    XcdBarrier bar = xcd_barrier_post(p.bar(), st);
    run_phase<0>(p, smem); xcd_barrier(bar);
    run_phase<1>(p, smem); xcd_barrier(bar);
    run_phase<2>(p, smem); xcd_barrier(bar);
    run_phase<3>(p, smem); xcd_barrier(bar);
    run_phase<4>(p, smem); xcd_barrier(bar);
    run_phase<5>(p, smem); xcd_barrier(bar);
    run_phase<6>(p, smem); xcd_barrier(bar);
    run_phase<7>(p, smem); xcd_barrier(bar);
    run_phase<8>(p, smem); xcd_barrier(bar);
    run_phase<9>(p, smem); xcd_barrier(bar);
    run_phase<10>(p, smem); xcd_barrier(bar);
    run_phase<11>(p, smem); xcd_barrier(bar);
    run_phase<12>(p, smem);
}

template <int PH>
static void launch_phase(const Params& p, int grid, hipStream_t stream) {
    static bool attr = false;
    if (!attr) { (void)hipFuncSetAttribute((const void*)k_phase<PH>, hipFuncAttributeMaxDynamicSharedMemorySize, LDS_BYTES); attr = true; }
    hipLaunchKernelGGL(k_phase<PH>, dim3(grid), dim3(NTHREADS), LDS_BYTES, stream, p);
}

extern "C" void kernel_launch(void* const* d_in, const int* in_sizes, int n_in, void* d_out, int out_size, void* d_ws, size_t ws_size,
                              hipStream_t stream) {
    (void)in_sizes; (void)n_in; (void)out_size;
    Params p{};
    const float** pin = (const float**)&p.x;
    for (int i = 0; i < 21; ++i) pin[i] = (const float*)d_in[i];
    p.out = (float*)d_out;
    p.ws = (char*)d_ws;
    char* ctl = p.ws + WO_ctl;
    if (WS_END > ws_size) { fprintf(stderr, "kernel_launch: workspace too small: need %zu have %zu\n", (size_t)WS_END, ws_size); return; }

    static int grid = 0;
    if (grid == 0) {
        int dev = 0, cus = 0, per_cu = 0;
        (void)hipGetDevice(&dev);
        (void)hipDeviceGetAttribute(&cus, hipDeviceAttributeMultiprocessorCount, dev);
        (void)hipFuncSetAttribute((const void*)k_all, hipFuncAttributeMaxDynamicSharedMemorySize, LDS_BYTES);
        (void)hipOccupancyMaxActiveBlocksPerMultiprocessor(&per_cu, (const void*)k_all, NTHREADS, LDS_BYTES);
        grid = cus;
        if (grid != 256) grid = 256;
        fprintf(stderr, "kernel_launch: cus %d per_cu %d grid %d ws need %zu have %zu\n", cus, per_cu, grid, (size_t)WS_END, ws_size);
    }
    (void)hipMemsetAsync(ctl, 0, 65536, stream);
#if ONE_LAUNCH
    hipLaunchKernelGGL(k_all, dim3(grid), dim3(NTHREADS), LDS_BYTES, stream, p);
#else
    launch_phase<0>(p, grid, stream); launch_phase<1>(p, grid, stream); launch_phase<2>(p, grid, stream); launch_phase<3>(p, grid, stream);
    launch_phase<4>(p, grid, stream); launch_phase<5>(p, grid, stream); launch_phase<6>(p, grid, stream); launch_phase<7>(p, grid, stream);
    launch_phase<8>(p, grid, stream); launch_phase<9>(p, grid, stream); launch_phase<10>(p, grid, stream); launch_phase<11>(p, grid, stream);
    launch_phase<12>(p, grid, stream);
#endif
}
```
